# Optimizing an MI355X kernel written in HIP

```python
import math
import jax
import jax.numpy as jnp
from jax import lax
import numpy as np


D_MODEL = 1024
BATCH = 8
SEQ = 2048
DEPTH = 2

GRID_W = 64
CTX_LEN = 256
N_MIXERS = 2
EPS = 1e-6
DIFF_HEADS = 8
DIFF_HEAD_DIM = D_MODEL // (2 * DIFF_HEADS)
ROPE_THETA = 10000.0
ROPE_AXIS_DIM = DIFF_HEAD_DIM // 2
ROPE_FREQS = ROPE_AXIS_DIM // 2
Q_BLOCK = 128
D_RNN = D_MODEL
LRU_BLOCKS = 8
LRU_BW = D_RNN // LRU_BLOCKS
CONV_W = 4
LRU_C = 8.0
N_EXPERTS = 16
EC_CAPACITY = 2
D_EXPERT = 2816
N_ATTN = (DEPTH + 1) // 2
N_LRU = DEPTH // 2

kernel_name = 'hybrid_diffattn_rglru_ecmoe_dit'

F32 = jnp.float32


def rmsnorm(x, g):
    xf = x.astype(F32)
    y = xf * lax.rsqrt(jnp.mean(xf * xf, axis=-1, keepdims=True) + EPS)
    return (y * g.astype(F32)).astype(x.dtype)


def modulate(x, shift, scale):
    return x * (1.0 + scale) + shift


def axial_rope_tables(n):
    rows = n // GRID_W
    row = jnp.repeat(jnp.arange(rows), GRID_W).astype(F32)
    col = jnp.tile(jnp.arange(GRID_W), rows).astype(F32)
    inv = ROPE_THETA ** (-(jnp.arange(ROPE_FREQS, dtype=F32) * 2.0) / ROPE_AXIS_DIM)
    ang = jnp.concatenate([row[:, None] * inv, col[:, None] * inv], axis=-1)
    return jnp.cos(ang), jnp.sin(ang)


def apply_axial_rope(x, cos, sin):
    n = x.shape[1]
    xr = x.astype(F32).reshape(*x.shape[:-1], 2, 2, ROPE_FREQS)
    x1, x2 = xr[..., 0, :], xr[..., 1, :]
    c = cos.reshape(n, 1, 2, ROPE_FREQS)
    s = sin.reshape(n, 1, 2, ROPE_FREQS)
    out = jnp.stack([x1 * c - x2 * s, x2 * c + x1 * s], axis=-2)
    return out.reshape(x.shape).astype(x.dtype)


def diff_attn_core(q, k, v, lam):
    s = jnp.einsum('bqhd,bkhd->bhqk', q.astype(F32), k.astype(F32))
    p = jax.nn.softmax(s, axis=-1)
    b_, _, lq, lk = p.shape
    p = p.reshape(b_, DIFF_HEADS, 2, lq, lk)
    w = p[:, :, 0] - lam * p[:, :, 1]
    return jnp.einsum('bhqk,bkhe->bqhe', w, v.astype(F32))


def diff_attention(n_lat, n_ctx, w_qkv, lq1, lk1, lq2, lk2, subln_g, w_o, lambda_init, ctx_out):
    b_, n, _ = n_lat.shape
    H, dh = DIFF_HEADS, DIFF_HEAD_DIM
    lam = (jnp.exp(jnp.sum(lq1.astype(F32) * lk1.astype(F32)))
           - jnp.exp(jnp.sum(lq2.astype(F32) * lk2.astype(F32))) + lambda_init)

    def project(h):
        L = h.shape[1]
        q, k, v = jnp.split(h @ w_qkv, 3, axis=-1)
        return (q.reshape(b_, L, 2 * H, dh) * (dh ** -0.5),
                k.reshape(b_, L, 2 * H, dh),
                v.reshape(b_, L, H, 2 * dh))

    q_l, k_l, v_l = project(n_lat)
    q_c, k_c, v_c = project(n_ctx)
    cos, sin = axial_rope_tables(n)
    q_l = apply_axial_rope(q_l, cos, sin)
    k_l = apply_axial_rope(k_l, cos, sin)
    k_all = jnp.concatenate([k_l, k_c], axis=1)
    v_all = jnp.concatenate([v_l, v_c], axis=1)
    nb = n // Q_BLOCK
    q_blocks = q_l.reshape(b_, nb, Q_BLOCK, 2 * H, dh).swapaxes(0, 1)
    o_blocks = lax.map(lambda qb: diff_attn_core(qb, k_all, v_all, lam), q_blocks)
    o_l = o_blocks.swapaxes(0, 1).reshape(b_, n, H, 2 * dh)

    def finish(o):
        o = rmsnorm(o, subln_g) * (1.0 - lambda_init)
        return o.reshape(b_, o.shape[1], D_MODEL).astype(n_lat.dtype) @ w_o

    y_l = finish(o_l)
    y_c = finish(diff_attn_core(q_c, k_c, v_c, lam)) if ctx_out else None
    return y_l, y_c


def centred_depthwise_conv(x, w, b):
    left = CONV_W // 2
    right = CONV_W - 1 - left
    y = lax.conv_general_dilated(x, w[:, None, :].astype(x.dtype), window_strides=(1,),
                                 padding=[(left, right)],
                                 dimension_numbers=('NWC', 'WIO', 'NWC'),
                                 feature_group_count=x.shape[-1])
    return y + b.astype(x.dtype)


def linear_scan(a, b, h0):
    def combine(l, r):
        return l[0] * r[0], r[0] * l[1] + r[1]
    A, Bc = lax.associative_scan(combine, (a, b), axis=1)
    return A * h0[:, None, :] + Bc


def rglru_block(n_lat, n_ctx, w_in, b_in, conv_w, conv_b, w_gates, b_gates, lam_p, w_out, ctx_out):
    def gate_terms(xc, d):
        b_, L, _ = xc.shape
        xf = xc.astype(F32)
        g = jnp.einsum('blkc,kcd->blkd', xf.reshape(b_, L, LRU_BLOCKS, LRU_BW),
                       w_gates[d].astype(F32)) + b_gates[d].astype(F32)
        r = jax.nn.sigmoid(g[..., :LRU_BW]).reshape(b_, L, D_RNN)
        i = jax.nn.sigmoid(g[..., LRU_BW:]).reshape(b_, L, D_RNN)
        log_a = -LRU_C * r * jax.nn.softplus(-lam_p[d].astype(F32))
        a = jnp.exp(log_a)
        bt = jnp.sqrt(-jnp.expm1(2.0 * log_a)) * (i * xf)
        return a, bt

    y_l, xr_l = jnp.split(n_lat @ w_in + b_in, 2, axis=-1)
    x_l = centred_depthwise_conv(xr_l, conv_w, conv_b)
    if ctx_out:
        y_c, xr_c = jnp.split(n_ctx @ w_in + b_in, 2, axis=-1)
    else:
        xr_c = n_ctx @ w_in[:, D_RNN:] + b_in[D_RNN:]
    x_c = centred_depthwise_conv(xr_c, conv_w, conv_b)

    h_l = 0.0
    h_c = 0.0
    for d in range(2):
        a_c, b_c = gate_terms(x_c, d)
        a_l, b_l = gate_terms(x_l, d)
        if d == 1:
            a_c, b_c, a_l, b_l = (jnp.flip(t, axis=1) for t in (a_c, b_c, a_l, b_l))
        s_c = linear_scan(a_c, b_c, jnp.zeros_like(b_c[:, 0]))
        s_l = linear_scan(a_l, b_l, s_c[:, -1])
        if d == 1:
            s_l = jnp.flip(s_l, axis=1)
            s_c = jnp.flip(s_c, axis=1)
        h_l = h_l + s_l
        if ctx_out:
            h_c = h_c + s_c
    out_l = (jax.nn.gelu(y_l.astype(F32)) * h_l).astype(n_lat.dtype) @ w_out
    out_c = ((jax.nn.gelu(y_c.astype(F32)) * h_c).astype(n_ctx.dtype) @ w_out) if ctx_out else None
    return out_l, out_c


def expert_choice_moe(h, w_router, w_gate_up, w_down):
    b_, L, _ = h.shape
    cap = EC_CAPACITY * L // N_EXPERTS
    logits = jnp.einsum('bld,de->bel', h.astype(F32), w_router.astype(F32))
    probs = jax.nn.softmax(logits, axis=1)
    gate, idx = lax.top_k(probs, cap)
    bidx = jnp.arange(b_)[:, None, None]
    xg = h[bidx, idx]
    gu = jnp.einsum('becd,edf->becf', xg, w_gate_up)
    g_, u_ = jnp.split(gu, 2, axis=-1)
    y = jnp.einsum('becf,efd->becd', jax.nn.silu(g_) * u_, w_down)
    y = (y.astype(F32) * gate[..., None]).astype(h.dtype)
    return jnp.zeros_like(h).at[bidx, idx].add(y)


def setup_inputs(seed: int = 0) -> dict:
    key = jax.random.key(seed)
    ks = jax.random.split(key, 32)
    D = D_MODEL

    def nrm(k, shape, fan_in):
        return jax.random.normal(k, shape, F32) * (fan_in ** -0.5)

    def small(k, shape, s=0.02):
        return jax.random.normal(k, shape, F32) * s

    u = jax.random.uniform(ks[20], (N_LRU, 2, D_RNN), F32, minval=0.9, maxval=0.999)
    base = u ** (1.0 / LRU_C)
    lru_lambda = jnp.log(base) - jnp.log1p(-base)

    return {
        'x': jax.random.normal(ks[0], (BATCH, SEQ, D), F32),
        'c': jax.random.normal(ks[1], (BATCH, D), F32),
        'ctx': jax.random.normal(ks[2], (BATCH, CTX_LEN, D), F32),
        'c_ctx': jax.random.normal(ks[3], (D,), F32),
        'ada_w': nrm(ks[4], (DEPTH, D, 6 * D), D),
        'ada_b': small(ks[5], (DEPTH, 6 * D)),
        'norm1_g': 1.0 + small(ks[6], (DEPTH, D)),
        'norm2_g': 1.0 + small(ks[7], (DEPTH, D)),
        'final_g': 1.0 + small(ks[8], (D,)),
        'attn_w_qkv': nrm(ks[9], (N_ATTN, D, 3 * D), D),
        'attn_lq1': small(ks[10], (N_ATTN, DIFF_HEAD_DIM), 0.1),
        'attn_lk1': small(ks[11], (N_ATTN, DIFF_HEAD_DIM), 0.1),
        'attn_lq2': small(ks[12], (N_ATTN, DIFF_HEAD_DIM), 0.1),
        'attn_lk2': small(ks[13], (N_ATTN, DIFF_HEAD_DIM), 0.1),
        'attn_subln_g': 1.0 + small(ks[14], (N_ATTN, 2 * DIFF_HEAD_DIM)),
        'attn_w_o': nrm(ks[15], (N_ATTN, D, D), D),
        'lru_w_in': nrm(ks[16], (N_LRU, D, 2 * D_RNN), D),
        'lru_b_in': small(ks[17], (N_LRU, 2 * D_RNN)),
        'lru_conv_w': nrm(ks[18], (N_LRU, CONV_W, D_RNN), CONV_W),
        'lru_conv_b': small(ks[19], (N_LRU, D_RNN)),
        'lru_w_gates': nrm(ks[21], (N_LRU, 2, LRU_BLOCKS, LRU_BW, 2 * LRU_BW), LRU_BW),
        'lru_b_gates': small(ks[22], (N_LRU, 2, LRU_BLOCKS, 2 * LRU_BW)),
        'lru_lambda': lru_lambda,
        'lru_w_out': nrm(ks[23], (N_LRU, D_RNN, D), D_RNN),
        'moe_w_router': nrm(ks[24], (DEPTH, D, N_EXPERTS), D),
        'moe_w_gate_up': nrm(ks[25], (DEPTH, N_EXPERTS, D, 2 * D_EXPERT), D),
        'moe_w_down': nrm(ks[26], (DEPTH, N_EXPERTS, D_EXPERT, D), D_EXPERT),
    }


def reference(x, c, ctx, c_ctx, ada_w, ada_b, norm1_g, norm2_g, final_g,
              attn_w_qkv, attn_lq1, attn_lk1, attn_lq2, attn_lk2, attn_subln_g, attn_w_o,
              lru_w_in, lru_b_in, lru_conv_w, lru_conv_b, lru_w_gates, lru_b_gates, lru_lambda, lru_w_out,
              moe_w_router, moe_w_gate_up, moe_w_down):
    h_lat = x
    h_ctx = ctx
    for i in range(DEPTH):
        last = i == DEPTH - 1
        mod_l = (jax.nn.silu(c) @ ada_w[i] + ada_b[i])[:, None, :]
        mod_c = jax.nn.silu(c_ctx) @ ada_w[i] + ada_b[i]
        sh1, sc1, g1, sh2, sc2, g2 = jnp.split(mod_l, 6, axis=-1)
        csh1, csc1, cg1, csh2, csc2, cg2 = jnp.split(mod_c, 6, axis=-1)

        n_l = modulate(rmsnorm(h_lat, norm1_g[i]), sh1, sc1)
        n_c = modulate(rmsnorm(h_ctx, norm1_g[i]), csh1, csc1)
        j = i // N_MIXERS
        if i % N_MIXERS == 0:
            lambda_init = 0.8 - 0.6 * math.exp(-0.3 * i)
            y_l, y_c = diff_attention(n_l, n_c, attn_w_qkv[j], attn_lq1[j], attn_lk1[j],
                                      attn_lq2[j], attn_lk2[j], attn_subln_g[j], attn_w_o[j],
                                      lambda_init, not last)
        else:
            y_l, y_c = rglru_block(n_l, n_c, lru_w_in[j], lru_b_in[j], lru_conv_w[j], lru_conv_b[j],
                                   lru_w_gates[j], lru_b_gates[j], lru_lambda[j], lru_w_out[j], not last)
        h_lat = h_lat + (g1 * y_l).astype(h_lat.dtype)
        if not last:
            h_ctx = h_ctx + (cg1 * y_c).astype(h_ctx.dtype)

        m_l = modulate(rmsnorm(h_lat, norm2_g[i]), sh2, sc2)
        h_lat = h_lat + (g2 * expert_choice_moe(m_l, moe_w_router[i], moe_w_gate_up[i],
                                                moe_w_down[i])).astype(h_lat.dtype)
        if not last:
            m_c = modulate(rmsnorm(h_ctx, norm2_g[i]), csh2, csc2)
            h_ctx = h_ctx + (cg2 * expert_choice_moe(m_c, moe_w_router[i], moe_w_gate_up[i],
                                                    moe_w_down[i])).astype(h_ctx.dtype)
    return rmsnorm(h_lat, final_g)
```

```cpp
#define MK_ONE_LAUNCH 1
#define FAST_QKV 1
#define FAST_WO 1
#define FAST_GU 1
#define FAST_DN 1
#define FAST_WIN 1
#define FAST_WOUT 1
#define FAST_ATTN 1
#define FAST_GATES 1
#define FP8_MOE 1
#include <hip/hip_runtime.h>
#include <cstdio>
#include <cstdint>
#include <cmath>

#ifndef MK_ONE_LAUNCH
#define MK_ONE_LAUNCH 0
#endif
#ifndef FAST_QKV
#define FAST_QKV 0
#endif
#ifndef FAST_ATTN
#define FAST_ATTN 0
#endif
#ifndef FAST_WO
#define FAST_WO 0
#endif
#ifndef FAST_GU
#define FAST_GU 0
#endif
#ifndef FAST_DN
#define FAST_DN 0
#endif
#ifndef FAST_WIN
#define FAST_WIN 0
#endif
#ifndef FAST_GATES
#define FAST_GATES 0
#endif
#ifndef FAST_WOUT
#define FAST_WOUT 0
#endif
#ifndef FP8_MOE
#define FP8_MOE 0
#endif
#ifndef GU_ALIGN
#define GU_ALIGN true
#endif
#ifndef DN_ALIGN
#define DN_ALIGN true
#endif
#define ANY_FAST_GEMM (FAST_QKV || FAST_WO || FAST_GU || FAST_DN || FAST_WIN || FAST_GATES || FAST_WOUT)

namespace pg8 {
#define PG8_LAS __attribute__((address_space(3)))
typedef unsigned short bf16_t;
typedef short bf16x8 __attribute__((ext_vector_type(8)));
typedef float f32x4 __attribute__((ext_vector_type(4)));
typedef unsigned u32x4 __attribute__((ext_vector_type(4)));
constexpr int BM = 256, BK = 64, HALF = 128, HTB = HALF * BK * 2  , STAGE_BYTES = 8 * HTB, NXCD = 8, WGM = 8;

__host__ __device__ __forceinline__ int lds_byte(int r, int c) { const int st = (r >> 4) * 2 + (c >> 5), rr = r & 15, cc = c & 31, ob = rr * 64 + cc * 2; return st * 1024 + (ob ^ (((ob >> 9) & 1) << 5)); }
__host__ __device__ __forceinline__ void stage_rc(int b, int& R, int& C) { const int st = b / 1024, sb = b % 1024, swz = sb ^ (((sb >> 9) & 1) << 5); R = (st >> 1) * 16 + swz / 64; C = (st & 1) * 32 + (swz % 64) / 2; }
__host__ __device__ __forceinline__ int perm32(int rho) { const int n = rho >> 4, i = rho & 15; return 8 * (i >> 2) + 4 * n + (i & 3); }

struct Unit { int pm, pn; };
struct Gemm { const bf16_t* A; const bf16_t* Bt; int M, N, K; };
__device__ __forceinline__ unsigned cvt_pk_bf16(float lo, float hi) { unsigned r; asm volatile("v_cvt_pk_bf16_f32 %0, %1, %2" : "=v"(r) : "v"(lo), "v"(hi)); return r; }
typedef int v4i_t __attribute__((ext_vector_type(4)));
typedef int v8i_t __attribute__((ext_vector_type(8)));
__device__ __forceinline__ v8i_t cat8(bf16x8 lo, bf16x8 hi) { const v4i_t a = __builtin_bit_cast(v4i_t, lo), b = __builtin_bit_cast(v4i_t, hi); return __builtin_shufflevector(a, b, 0, 1, 2, 3, 4, 5, 6, 7); }
template <class Epi, class Sched, bool ALIGN_EPI = false, bool SP2 = false, int FP8SCALE = 0  >
__device__ __forceinline__ void gemm_phase(PG8_LAS unsigned char* lds, const Gemm g, const Sched& S, const Epi& E) {
    const int tid = threadIdx.x, wid = __builtin_amdgcn_readfirstlane(tid >> 6), lane = tid & 63, wr = wid >> 2, wc = wid & 3, fr = lane & 15, fq = lane >> 4;
    const int K = g.K, nt = K / BK;
    unsigned voffA[2], voffB[2];
#pragma unroll
    for (int i = 0; i < 2; ++i) { int R, C; stage_rc(tid * 16 + i * 8192, R, C); const int Rb = Epi::PERM ? ((R & ~31) + perm32(R & 31)) : R;
        voffA[i] = (unsigned)(R * K + C) * 2u; voffB[i] = (unsigned)(Rb * K + C) * 2u; }
    const size_t kstep = (size_t)(BK * 2);
    const size_t hstep = (size_t)HALF * K * 2;
    const size_t tstep = 2 * hstep;
    const unsigned ldsw = (unsigned)wid * 1024u;
    const int aoff = lds_byte(wr * 64 + fr, fq * 8), boff = lds_byte(wc * 32 + fr, fq * 8);
#define PG8_SA(b, h) (((b) * 2 + (h)) * HTB)
#define PG8_SB(b, h) ((4 + (b) * 2 + (h)) * HTB)
#define PG8_STAGE(bufoff, gbase, voff) do { _Pragma("unroll") for (int _i = 0; _i < 2; ++_i) \
        __builtin_amdgcn_global_load_lds((const unsigned*)((const char*)(gbase) + (voff)[_i]), (PG8_LAS unsigned*)(lds + (bufoff) + ldsw + _i * 8192), 16, 0, 0); } while (0)
#define PG8_LDA(dst, b, h) do { if constexpr (FP8SCALE == 0) { _Pragma("unroll") for (int m = 0; m < 4; ++m) _Pragma("unroll") for (int k = 0; k < 2; ++k) dst[m][k] = *(const PG8_LAS bf16x8*)(lds + PG8_SA(b, h) + aoff + m * 2048 + k * 1024); } \
        else { _Pragma("unroll") for (int m = 0; m < 4; ++m) { const v4i_t lo_ = *(const PG8_LAS v4i_t*)(lds + PG8_SA(b, h) + aoff + m * 2048), hi_ = *(const PG8_LAS v4i_t*)(lds + PG8_SA(b, h) + aoff + m * 2048 + 1024); dst##8[m] = __builtin_shufflevector(lo_, hi_, 0, 1, 2, 3, 4, 5, 6, 7); } } } while (0)
#define PG8_LDB(dst, b, h) do { if constexpr (FP8SCALE == 0) { _Pragma("unroll") for (int n = 0; n < 2; ++n) _Pragma("unroll") for (int k = 0; k < 2; ++k) dst[n][k] = *(const PG8_LAS bf16x8*)(lds + PG8_SB(b, h) + boff + n * 2048 + k * 1024); } \
        else { _Pragma("unroll") for (int n = 0; n < 2; ++n) { const v4i_t lo_ = *(const PG8_LAS v4i_t*)(lds + PG8_SB(b, h) + boff + n * 2048), hi_ = *(const PG8_LAS v4i_t*)(lds + PG8_SB(b, h) + boff + n * 2048 + 1024); dst##8[n] = __builtin_shufflevector(lo_, hi_, 0, 1, 2, 3, 4, 5, 6, 7); } } } while (0)
#define PG8_MMA(ai, bj, At, Bt) do { __builtin_amdgcn_s_setprio(1); \
        if constexpr (FP8SCALE == 0) { _Pragma("unroll") for (int m = 0; m < 4; ++m) _Pragma("unroll") for (int n = 0; n < 2; ++n) _Pragma("unroll") for (int k = 0; k < 2; ++k) \
            acc[ai][bj][m][n] = __builtin_amdgcn_mfma_f32_16x16x32_bf16(Bt[n][k], At[m][k], acc[ai][bj][m][n], 0, 0, 0); } \
        else { _Pragma("unroll") for (int m = 0; m < 4; ++m) _Pragma("unroll") for (int n = 0; n < 2; ++n) \
            asm volatile("v_mfma_scale_f32_16x16x128_f8f6f4 %0, %1, %2, %0, %3, %4 op_sel_hi:[0,0,0]" : "+v"(acc[ai][bj][m][n]) : "v"(Bt##8[n]), "v"(At##8[m]), "v"(sclW), "v"(sclA)); } \
        __builtin_amdgcn_s_setprio(0); } while (0)
#define PG8_WAIT_V(n) asm volatile("s_waitcnt vmcnt(" #n ")" ::: "memory")
#define PG8_WAIT_L(n) asm volatile("s_waitcnt lgkmcnt(" #n ")" ::: "memory")
#define PG8_BAR __builtin_amdgcn_s_barrier()
#define PG8_SCHED __builtin_amdgcn_sched_barrier(0)
    Unit cur, nxt; int ui = 0;
    if (!S.next(0, cur)) return;
    f32x4 acc[2][2][4][2];
#pragma unroll
    for (int a = 0; a < 2; ++a)
#pragma unroll
        for (int b = 0; b < 2; ++b)
#pragma unroll
            for (int m = 0; m < 4; ++m)
#pragma unroll
                for (int n = 0; n < 2; ++n) acc[a][b][m][n] = (f32x4){0.f, 0.f, 0.f, 0.f};
    bf16x8 At[4][2], B0[2][2], B1[2][2]; v8i_t At8[4], B08[2], B18[2]; const int sclW = FP8SCALE * 0x01010101, sclA = 0x7f7f7f7f;
    const char* cA = (const char*)g.A + (size_t)cur.pm * tstep; const char* cB = (const char*)g.Bt + (size_t)cur.pn * tstep;
    S.a_ready(cur);
    if constexpr (SP2) {
        PG8_STAGE(PG8_SB(0, 0), cB, voffB); PG8_STAGE(PG8_SB(0, 1), cB + hstep, voffB); PG8_STAGE(PG8_SA(0, 0), cA, voffA); PG8_STAGE(PG8_SA(0, 1), cA + hstep, voffA);
        if (wr == 1) PG8_BAR;
        PG8_WAIT_V(2); PG8_BAR;
        PG8_STAGE(PG8_SB(1, 0), cB + kstep, voffB); PG8_STAGE(PG8_SA(1, 0), cA + kstep, voffA); PG8_STAGE(PG8_SB(1, 1), cB + hstep + kstep, voffB);
        PG8_WAIT_V(6); PG8_BAR;
    } else {
        PG8_STAGE(PG8_SB(0, 0), cB, voffB); PG8_STAGE(PG8_SA(0, 0), cA, voffA); PG8_STAGE(PG8_SB(0, 1), cB + hstep, voffB); PG8_STAGE(PG8_SA(0, 1), cA + hstep, voffA);
        if (wr == 1) PG8_BAR;
        PG8_WAIT_V(4); PG8_BAR;
        PG8_STAGE(PG8_SB(1, 0), cB + kstep, voffB); PG8_STAGE(PG8_SA(1, 0), cA + kstep, voffA); PG8_STAGE(PG8_SB(1, 1), cB + hstep + kstep, voffB);
        PG8_WAIT_V(6); PG8_BAR;
    }
    for (;;) {
        const bool has_next = S.next(ui + 1, nxt);
        const char* nA = has_next ? (const char*)g.A + (size_t)nxt.pm * tstep : cA; const char* nB = has_next ? (const char*)g.Bt + (size_t)nxt.pn * tstep : cB;
        for (int t = 0; t < nt; t += 2) {
            const bool last = (t == nt - 2);
            const char* a1 = cA + (size_t)(t + 1) * kstep;
            const char* a2 = last ? nA : cA + (size_t)(t + 2) * kstep; const char* b2 = last ? nB : cB + (size_t)(t + 2) * kstep;
            const char* a3 = a2 + kstep; const char* b3 = b2 + kstep;
            if (last && has_next) S.a_ready(nxt);
            if constexpr (SP2) {
            PG8_LDB(B0, 0, 0); PG8_LDB(B1, 0, 1); PG8_SCHED; PG8_LDA(At, 0, 0); PG8_STAGE(PG8_SA(1, 1), a1 + hstep, voffA);
            PG8_WAIT_V(8); PG8_WAIT_L(0); PG8_BAR; PG8_MMA(0, 0, At, B0); PG8_MMA(0, 1, At, B1); PG8_BAR; PG8_SCHED;
            PG8_LDA(At, 0, 1); PG8_STAGE(PG8_SB(0, 0), b2, voffB); PG8_STAGE(PG8_SB(0, 1), b2 + hstep, voffB); PG8_STAGE(PG8_SA(0, 0), a2, voffA);
            PG8_WAIT_V(8); PG8_WAIT_L(0); PG8_BAR; PG8_MMA(1, 0, At, B0); PG8_MMA(1, 1, At, B1); PG8_BAR; PG8_SCHED;
            PG8_LDB(B0, 1, 0); PG8_LDB(B1, 1, 1); PG8_SCHED; PG8_LDA(At, 1, 0); PG8_STAGE(PG8_SA(0, 1), a2 + hstep, voffA);
            PG8_WAIT_V(8); PG8_WAIT_L(0); PG8_BAR; PG8_MMA(0, 0, At, B0); PG8_MMA(0, 1, At, B1); PG8_BAR; PG8_SCHED;
            PG8_LDA(At, 1, 1); PG8_STAGE(PG8_SB(1, 0), b3, voffB); PG8_STAGE(PG8_SB(1, 1), b3 + hstep, voffB); PG8_STAGE(PG8_SA(1, 0), a3, voffA);
            PG8_WAIT_V(8); PG8_WAIT_L(0); PG8_BAR; PG8_MMA(1, 0, At, B0); PG8_MMA(1, 1, At, B1); PG8_BAR; PG8_SCHED;
            } else {
            PG8_LDB(B0, 0, 0); PG8_SCHED; PG8_LDA(At, 0, 0); PG8_STAGE(PG8_SA(1, 1), a1 + hstep, voffA);
            PG8_WAIT_L(8); PG8_BAR; PG8_WAIT_L(0); PG8_MMA(0, 0, At, B0); PG8_BAR; PG8_SCHED;
            PG8_LDB(B1, 0, 1); PG8_STAGE(PG8_SB(0, 0), b2, voffB);
            PG8_BAR; PG8_WAIT_L(0); PG8_MMA(0, 1, At, B1); PG8_BAR;
            PG8_LDA(At, 0, 1); PG8_STAGE(PG8_SA(0, 0), a2, voffA);
            PG8_BAR; PG8_WAIT_L(0); PG8_MMA(1, 0, At, B0); PG8_BAR; PG8_SCHED;
            PG8_STAGE(PG8_SB(0, 1), b2 + hstep, voffB);
            PG8_WAIT_V(6); PG8_BAR; PG8_MMA(1, 1, At, B1); PG8_BAR;
            PG8_LDB(B0, 1, 0); PG8_SCHED; PG8_LDA(At, 1, 0); PG8_STAGE(PG8_SA(0, 1), a2 + hstep, voffA);
            PG8_WAIT_L(8); PG8_BAR; PG8_WAIT_L(0); PG8_MMA(0, 0, At, B0); PG8_BAR; PG8_SCHED;
            PG8_LDB(B1, 1, 1); PG8_STAGE(PG8_SB(1, 0), b3, voffB);
            PG8_BAR; PG8_WAIT_L(0); PG8_MMA(0, 1, At, B1); PG8_BAR;
            PG8_LDA(At, 1, 1); PG8_STAGE(PG8_SA(1, 0), a3, voffA);
            PG8_BAR; PG8_WAIT_L(0); PG8_MMA(1, 0, At, B0); PG8_BAR; PG8_SCHED;
            PG8_STAGE(PG8_SB(1, 1), b3 + hstep, voffB);
            PG8_WAIT_V(6); PG8_BAR; PG8_MMA(1, 1, At, B1); PG8_BAR;
            }
        }
        if constexpr (ALIGN_EPI) { if (wr == 0) PG8_BAR; }
        if constexpr (FP8SCALE != 0) asm volatile("s_nop 15\n\ts_nop 15" ::: "memory");
        if constexpr (!Epi::AFTER_DRAIN) { E(acc, cur, wr, wc, fr, fq); S.done(cur); }
        if (!has_next) break;
#pragma unroll
        for (int a = 0; a < 2; ++a)
#pragma unroll
            for (int b = 0; b < 2; ++b)
#pragma unroll
                for (int m = 0; m < 4; ++m)
#pragma unroll
                    for (int n = 0; n < 2; ++n) acc[a][b][m][n] = (f32x4){0.f, 0.f, 0.f, 0.f};
        cur = nxt; cA = nA; cB = nB; ++ui;
        if constexpr (ALIGN_EPI) { if (wr == 1) PG8_BAR; }
    }
    PG8_WAIT_V(0);
    if constexpr (!ALIGN_EPI) { if (wr == 0) PG8_BAR; }
    PG8_BAR;
    if constexpr (Epi::AFTER_DRAIN) { E.fused(acc, cur, wr, wc, fr, fq, lds, wid, lane); S.done(cur); }
#undef PG8_SA
#undef PG8_SB
#undef PG8_STAGE
#undef PG8_LDA
#undef PG8_LDB
#undef PG8_MMA
#undef PG8_WAIT_V
#undef PG8_WAIT_L
#undef PG8_BAR
#undef PG8_SCHED
}
}

#define LAS __attribute__((address_space(3)))
typedef unsigned short bf16_t;
typedef float f32x4 __attribute__((ext_vector_type(4)));
typedef float f32x2 __attribute__((ext_vector_type(2)));
typedef unsigned u32x4 __attribute__((ext_vector_type(4)));
typedef unsigned u32x2 __attribute__((ext_vector_type(2)));
typedef short bf16x8 __attribute__((ext_vector_type(8)));

constexpr int NB = 8, SEQ = 2048, CTXL = 256, D = 1024;
constexpr int RL = NB * SEQ, RC = NB * CTXL, RT = RL + RC;
constexpr int NE = 16, DE = 2816, CAPL = 256, CAPC = 32;
constexpr int RPE0 = NB * CAPL + NB * CAPC, RPE1 = NB * CAPL;
constexpr int NWAVES = 8, NTHREADS = 512;
constexpr float EPS = 1e-6f;
constexpr float QSCALE = 0.125f * 1.4426950408889634f;
constexpr float LAMBDA_INIT0 = 0.2f;
constexpr int M_SH1 = 0, M_SC1 = 1024, M_G1 = 2048, M_SH2 = 3072, M_SC2 = 4096, M_G2 = 5120;
constexpr int SCH = 64, NCH = (CTXL + SEQ) / SCH, NCH_CTX = CTXL / SCH;

constexpr size_t MiB = 1u << 20;
constexpr size_t WS_CTL = 0, CTL_ZERO_BYTES = 32768;
constexpr size_t WS_GTAB = 2 * MiB + 65536;
constexpr size_t WS_MOD = 1 * MiB, WS_ROPE = 2 * MiB, WS_PROBS = 3 * MiB, WS_GATE = 5 * MiB, WS_SEL = 6 * MiB, WS_CP = 8 * MiB, WS_CB = 11 * MiB;
constexpr size_t WS_WQKV = 16 * MiB, WS_WO = 22 * MiB, WS_WIN = 24 * MiB, WS_WOUT = 28 * MiB, WS_WG = 30 * MiB;
constexpr size_t WS_XN = 32 * MiB, WS_Q = 68 * MiB, WS_K = 104 * MiB, WS_V = 140 * MiB, WS_ATT = 176 * MiB, WS_H = 212 * MiB;
constexpr size_t WS_XG = 284 * MiB, WS_Y = 356 * MiB, WS_ACT = 428 * MiB, WS_WGU = 626 * MiB, WS_WDN = 978 * MiB;
constexpr size_t WS_YG = 68 * MiB, WS_XR = 104 * MiB, WS_HS = 140 * MiB;
constexpr size_t WS_LOGA = 1154 * MiB, WS_BT = 1226 * MiB;
constexpr size_t WS_TMPF = 1298 * MiB, WS_XC = 2090 * MiB, WS_END = 2126 * MiB;
constexpr size_t WGU_LAYER = (size_t)NE * 2 * DE * D * 2, WDN_LAYER = (size_t)NE * D * DE * 2;
constexpr int CW_BAR = 4096;

constexpr int LDS_BYTES = 147456;
constexpr int MISC_OFF = 131072 + 320;

struct Args { const float* in[27]; float* out; unsigned char* ws; int ph_lo, ph_hi; };
constexpr int ROPE_LDS = 131072 + 1024;
constexpr int ARGS_OFF = 131072 + 512;
struct Ctx {
    const LAS unsigned* la;
    __device__ __forceinline__ unsigned long long ld(int i) const { const unsigned lo = __builtin_amdgcn_readfirstlane(la[2 * i]), hi = __builtin_amdgcn_readfirstlane(la[2 * i + 1]); return ((unsigned long long)hi << 32) | lo; }
    __device__ __forceinline__ const float* in(int i) const { return (const float*)(const __attribute__((address_space(1))) float*)ld(i); }
    __device__ __forceinline__ float* out() const { return (float*)(__attribute__((address_space(1))) float*)ld(27); }
    __device__ __forceinline__ unsigned char* ws() const { return (unsigned char*)(__attribute__((address_space(1))) unsigned char*)ld(28); }
};

enum { I_X = 0, I_C, I_CTX, I_CCTX, I_ADAW, I_ADAB, I_N1G, I_N2G, I_FG, I_WQKV, I_LQ1, I_LK1, I_LQ2, I_LK2, I_SUBG, I_WO, I_WIN, I_BIN, I_CONVW, I_CONVB, I_WGATES, I_BGATES, I_LAM, I_WOUT, I_WR, I_WGU, I_WDN };

__device__ __forceinline__ float bf_lo(unsigned w) { return __uint_as_float(w << 16); }
__device__ __forceinline__ float bf_hi(unsigned w) { return __uint_as_float(w & 0xffff0000u); }
__device__ __forceinline__ float bf2f(bf16_t b) { return __uint_as_float(((unsigned)b) << 16); }
__device__ __forceinline__ unsigned f2bf(float f) { unsigned u = __float_as_uint(f); return (u + 0x7fffu + ((u >> 16) & 1u)) >> 16; }
__device__ __forceinline__ unsigned pk2(float lo, float hi) { unsigned r; asm("v_cvt_pk_bf16_f32 %0, %1, %2" : "=v"(r) : "v"(lo), "v"(hi)); return r; }
__device__ __forceinline__ float wave_sum(float v) {
#pragma unroll
    for (int o = 1; o < 64; o <<= 1) v += __shfl_xor(v, o);
    return v;
}
__device__ __forceinline__ float wave_max(float v) {
#pragma unroll
    for (int o = 1; o < 64; o <<= 1) v = fmaxf(v, __shfl_xor(v, o));
    return v;
}
__device__ __forceinline__ float sigmoidf_(float x) { return 1.f / (1.f + expf(-x)); }
__device__ __forceinline__ float gelu_tanh(float x) { const float u = 0.7978845608028654f * (x + 0.044715f * x * x * x); return x / (1.f + expf(-2.f * u)); }
__device__ __forceinline__ const float* mod_ptr(const Ctx& a, int layer, int r) { return (const float*)(a.ws() + WS_MOD) + (size_t)(layer * 9 + r) * 6144; }
__device__ __forceinline__ int mod_row(int row) { return row < RL ? (row >> 11) : 8; }

__device__ __forceinline__ void load_row(const float* p, int lane, f32x4 (&v)[4]) {
#pragma unroll
    for (int j = 0; j < 4; ++j) v[j] = *(const f32x4*)(p + 4 * lane + 256 * j);
}
__device__ __forceinline__ void load_row_bf16(const bf16_t* p, int lane, f32x4 (&v)[4]) {
#pragma unroll
    for (int j = 0; j < 4; ++j) { const u32x2 w = *(const u32x2*)(p + 4 * lane + 256 * j); v[j] = (f32x4){bf_lo(w.x), bf_hi(w.x), bf_lo(w.y), bf_hi(w.y)}; }
}
__device__ __forceinline__ void store_row_f32(float* p, int lane, const f32x4 (&v)[4]) {
#pragma unroll
    for (int j = 0; j < 4; ++j) *(f32x4*)(p + 4 * lane + 256 * j) = v[j];
}
__device__ __forceinline__ void store_row_bf16(bf16_t* p, int lane, const f32x4 (&v)[4]) {
#pragma unroll
    for (int j = 0; j < 4; ++j) { u32x2 w; w.x = pk2(v[j].x, v[j].y); w.y = pk2(v[j].z, v[j].w); *(u32x2*)(p + 4 * lane + 256 * j) = w; }
}
__device__ __forceinline__ void store_row_fp8(unsigned char* p, int lane, const f32x4 (&v)[4]) {
#pragma unroll
    for (int j = 0; j < 4; ++j) *(unsigned*)(p + 4 * lane + 256 * j) = __builtin_amdgcn_cvt_pk_fp8_f32(v[j].z, v[j].w, __builtin_amdgcn_cvt_pk_fp8_f32(v[j].x, v[j].y, 0u, false), true);
}
__device__ __forceinline__ void rms_mod(f32x4 (&v)[4], const float* g, const float* sh, const float* sc, int lane) {
    float ss = 0.f;
#pragma unroll
    for (int j = 0; j < 4; ++j) ss += (v[j].x * v[j].x + v[j].y * v[j].y) + (v[j].z * v[j].z + v[j].w * v[j].w);
    ss = wave_sum(ss);
    const float rstd = 1.0f / sqrtf(ss * (1.0f / D) + EPS);
#pragma unroll
    for (int j = 0; j < 4; ++j) {
        const int k = 4 * lane + 256 * j;
        const f32x4 gg = *(const f32x4*)(g + k);
        f32x4 y = v[j] * rstd * gg;
        if (sh) { const f32x4 s1 = *(const f32x4*)(sc + k), s0 = *(const f32x4*)(sh + k); y = y * (1.0f + s1) + s0; }
        v[j] = y;
    }
}

template <class F>
__device__ __forceinline__ void naive_tile(const bf16_t* A, int lda, const float* W, int ldw, int K, LAS unsigned char* lds, F f) {
    LAS float* As = (LAS float*)lds;
    LAS float* Bs = (LAS float*)(lds + 16 * 132 * 4);
    const int tid = threadIdx.x, ty = tid >> 4, tx = tid & 15;
    const int ar = tid >> 2, akq = tid & 3, bk = tid >> 5, bc = (tid & 31) * 2;
    float acc[4][4];
#pragma unroll
    for (int i = 0; i < 4; ++i)
#pragma unroll
        for (int j = 0; j < 4; ++j) acc[i][j] = 0.f;
    for (int k0 = 0; k0 < K; k0 += 16) {
        const u32x2 av = *(const u32x2*)(A + (size_t)ar * lda + k0 + akq * 4);
        const f32x2 bv = *(const f32x2*)(W + (size_t)(k0 + bk) * ldw + bc);
        __syncthreads();
        As[(akq * 4 + 0) * 132 + ar] = bf_lo(av.x); As[(akq * 4 + 1) * 132 + ar] = bf_hi(av.x);
        As[(akq * 4 + 2) * 132 + ar] = bf_lo(av.y); As[(akq * 4 + 3) * 132 + ar] = bf_hi(av.y);
        Bs[bk * 64 + bc] = bv.x; Bs[bk * 64 + bc + 1] = bv.y;
        __syncthreads();
#pragma unroll
        for (int kk = 0; kk < 16; ++kk) {
            const f32x4 a4 = *(const LAS f32x4*)(As + kk * 132 + ty * 4);
            const f32x4 b4 = *(const LAS f32x4*)(Bs + kk * 64 + tx * 4);
#pragma unroll
            for (int i = 0; i < 4; ++i)
#pragma unroll
                for (int j = 0; j < 4; ++j) acc[i][j] += a4[i] * b4[j];
        }
    }
#pragma unroll
    for (int i = 0; i < 4; ++i)
#pragma unroll
        for (int j = 0; j < 4; ++j) f(ty * 4 + i, tx * 4 + j, acc[i][j]);
    __syncthreads();
}

__device__ __forceinline__ void cvt_item(const float* W, int N, int k0, int n0, bf16_t* dst, int Kd, int gu_perm) {
    const int tid = threadIdx.x, lane = tid & 63, wave = tid >> 6;
    const float* p = W + (size_t)(k0 + 8 * wave) * N + n0 + 4 * lane;
    f32x4 v[8];
#pragma unroll
    for (int i = 0; i < 8; ++i) v[i] = *(const f32x4*)(p + (size_t)i * N);
#pragma unroll
    for (int j = 0; j < 4; ++j) {
        const int n = n0 + 4 * lane + j;
        const int row = gu_perm ? (((n % DE) >> 7) * 256 + (n / DE) * 128 + (n & 127)) : n;
        u32x4 o; o.x = pk2(v[0][j], v[1][j]); o.y = pk2(v[2][j], v[3][j]); o.z = pk2(v[4][j], v[5][j]); o.w = pk2(v[6][j], v[7][j]);
        *(u32x4*)(dst + (size_t)row * Kd + k0 + 8 * wave) = o;
    }
}
__device__ __forceinline__ unsigned pk4_fp8(float a, float b, float c, float d) { unsigned w = __builtin_amdgcn_cvt_pk_fp8_f32(a, b, 0u, false); return __builtin_amdgcn_cvt_pk_fp8_f32(c, d, w, true); }
constexpr float BT_SCALE = 64.0f, Y_SCALE = 16.0f;
constexpr float WGU_SCALE = 32.0f, WDN_SCALE = 64.0f;
__device__ __forceinline__ void cvt8_load(const float* W, int N, int k0, int n0, f32x4 (&v)[16]) {
    const int tid = threadIdx.x, lane = tid & 63, wave = tid >> 6;
    const float* p = W + (size_t)(k0 + 16 * wave) * N + n0 + 4 * lane;
#pragma unroll
    for (int i = 0; i < 16; ++i) v[i] = __builtin_nontemporal_load((const f32x4*)(p + (size_t)i * N));
}
__device__ __forceinline__ void cvt8_store(const f32x4 (&v)[16], int k0, int n0, unsigned char* dst, int Kd, int gu_perm, float scale, LAS unsigned char* T) {
    const int tid = threadIdx.x, lane = tid & 63, wave = tid >> 6;
#pragma unroll
    for (int j = 0; j < 4; ++j) {
        const int n = 4 * lane + j;
        u32x4 o;
        o.x = pk4_fp8(v[0][j] * scale, v[1][j] * scale, v[2][j] * scale, v[3][j] * scale); o.y = pk4_fp8(v[4][j] * scale, v[5][j] * scale, v[6][j] * scale, v[7][j] * scale);
        o.z = pk4_fp8(v[8][j] * scale, v[9][j] * scale, v[10][j] * scale, v[11][j] * scale); o.w = pk4_fp8(v[12][j] * scale, v[13][j] * scale, v[14][j] * scale, v[15][j] * scale);
        *(LAS u32x4*)(T + n * 128 + ((wave ^ (lane & 7)) << 4)) = o;
    }
    asm volatile("s_waitcnt lgkmcnt(0)" ::: "memory"); __builtin_amdgcn_s_barrier(); asm volatile("" ::: "memory");
#pragma unroll
    for (int i = 0; i < 4; ++i) {
        const int p = tid + NTHREADS * i, n = p >> 3, c = p & 7;
        const u32x4 x = *(const LAS u32x4*)(T + n * 128 + ((c ^ ((n >> 2) & 7)) << 4));
        const int ng = n0 + n;
        const int row = gu_perm ? (((ng % DE) >> 7) * 256 + (ng / DE) * 128 + (ng & 127)) : ng;
        *(u32x4*)(dst + (size_t)row * Kd + k0 + 16 * c) = x;
    }
}
constexpr int CV_GU = NE * 8 * 22, CV_DN = NE * 22 * 4, CV_ITEMS = CV_GU + CV_DN;
struct CvItem { const float* W; unsigned char* dst; int N, Kd, k0, n0, perm; float scale; };
__device__ __forceinline__ CvItem cv_decode(const float* wgu, const float* wdn, unsigned char* ws, int layer, int it) {
    CvItem c;
    if (it < CV_GU) { const int e = it / 176, q = it % 176, le = layer * NE + e; c.W = wgu + (size_t)le * D * 2 * DE; c.dst = ws + WS_WGU + (size_t)le * 2 * DE * D; c.N = 2 * DE; c.Kd = D; c.k0 = (q / 22) * 128; c.n0 = (q % 22) * 256; c.perm = 1; c.scale = WGU_SCALE; }
    else { const int r = it - CV_GU, e = r / 88, q = r % 88, le = layer * NE + e; c.W = wdn + (size_t)le * DE * D; c.dst = ws + WS_WDN + (size_t)le * D * DE; c.N = D; c.Kd = DE; c.k0 = (q / 4) * 128; c.n0 = (q % 4) * 256; c.perm = 0; c.scale = WDN_SCALE; }
    return c;
}
__device__ __forceinline__ void cvt8_run(const Ctx& a, int layer, int first, int stride, int end, LAS unsigned char* lds) {
    const float* wgu = a.in(I_WGU); const float* wdn = a.in(I_WDN); unsigned char* ws = a.ws();
    f32x4 va[16], vb[16];
    int it = first;
    if (it < end) { const CvItem c = cv_decode(wgu, wdn, ws, layer, it); cvt8_load(c.W, c.N, c.k0, c.n0, va); }
    while (it < end) {
        int nx = it + stride;
        if (nx < end) { const CvItem c = cv_decode(wgu, wdn, ws, layer, nx); cvt8_load(c.W, c.N, c.k0, c.n0, vb); }
        { const CvItem c = cv_decode(wgu, wdn, ws, layer, it); cvt8_store(va, c.k0, c.n0, c.dst, c.Kd, c.perm, c.scale, lds); }
        it = nx; if (it >= end) break;
        nx = it + stride;
        if (nx < end) { const CvItem c = cv_decode(wgu, wdn, ws, layer, nx); cvt8_load(c.W, c.N, c.k0, c.n0, va); }
        { const CvItem c = cv_decode(wgu, wdn, ws, layer, it); cvt8_store(vb, c.k0, c.n0, c.dst, c.Kd, c.perm, c.scale, lds + 32768); }
        it = nx;
    }
    __syncthreads();
}
#ifndef CVT_HIDE
#define CVT_HIDE 1
#endif
#ifndef CVT_DEDICATED
#define CVT_DEDICATED 0
#endif
#ifndef CVQ_QKV
#define CVQ_QKV 1280
#endif
#ifndef CVQ_WO
#define CVQ_WO 896
#endif
#ifndef CVQ_GU0
#define CVQ_GU0 480
#endif
#ifndef CVQ_DN0
#define CVQ_DN0 960
#endif
#ifndef CVQ_WIN
#define CVQ_WIN 896
#endif
#ifndef CVQ_GATES
#define CVQ_GATES 768
#endif
constexpr int CV0_QKV = 0, CV0_WO = CV0_QKV + CVQ_QKV, CV0_PRO = CVT_HIDE ? CV0_WO + CVQ_WO : 0;
constexpr int CV1_GU0 = 0, CV1_DN0 = CV1_GU0 + CVQ_GU0, CV1_WIN = CV1_DN0 + CVQ_DN0, CV1_GATES = CV1_WIN + CVQ_WIN, CV1_PRO = CVT_HIDE ? CV1_GATES + CVQ_GATES : 0;
static_assert(CV0_PRO <= CV_ITEMS && CV1_PRO <= CV_ITEMS, "conversion schedule");
__device__ __forceinline__ void cvt8_tail(const Ctx& a, LAS unsigned char* lds, int units, int G, int c, int layer, int base, int count) {
#if CVT_HIDE && FP8_MOE
    const int R = (units + G - 1) / G, first_idle = units - (R - 1) * G;
    if (first_idle >= G || count <= 0 || c < first_idle) return;
    cvt8_run(a, layer, base + (c - first_idle), G - first_idle, base + count, lds);
#endif
}
__device__ __forceinline__ int gemm_groups(int units, int G) {
#if CVT_HIDE && FP8_MOE && CVT_DEDICATED
    const int R = (units + G - 1) / G; int gp = ((units + R - 1) / R + 7) & ~7;
    return gp < G ? gp : G;
#else
    return G;
#endif
}
__device__ __forceinline__ void ph_prologue(const Ctx& a, LAS unsigned char* lds) {
    const int tid = threadIdx.x, lane = tid & 63, wave = tid >> 6;
    if (blockIdx.x == gridDim.x - 1) {
        float* rope = (float*)(a.ws() + WS_ROPE);
        for (int i = tid; i < 1024; i += NTHREADS) { const int pos = i >> 4, f = i & 15; const float inv = powf(10000.0f, -(float)f / 16.0f); const float ang = (float)pos * inv; rope[i] = cosf(ang); rope[1024 + i] = sinf(ang); }
    }
    if (blockIdx.x == gridDim.x - 2 || gridDim.x == 1) {
        float* gt = (float*)(a.ws() + WS_GTAB); const float* lamp = a.in(I_LAM); const float* bgp = a.in(I_BGATES);
        for (int i = tid; i < 2 * D; i += NTHREADS) {
            const int d = i >> 10, ch = i & 1023, kb = ch >> 7, cc = ch & 127;
            const float cl = -8.0f * log1pf(expf(-lamp[i]));
            gt[(d * 4 + 0) * D + ch] = cl * 1.4426950408889634f; gt[(d * 4 + 1) * D + ch] = 2.0f * cl * 1.4426950408889634f;
            gt[(d * 4 + 2) * D + ch] = -1.4426950408889634f * bgp[(d * 8 + kb) * 256 + cc]; gt[(d * 4 + 3) * D + ch] = -1.4426950408889634f * bgp[(d * 8 + kb) * 256 + 128 + cc];
        }
    }
    for (int u = blockIdx.x; u < 192; u += gridDim.x) {
        LAS float* sl = (LAS float*)lds;
        LAS float* red = (LAS float*)(lds + 49152);
        const int layer = u / 96, n0 = (u % 96) * 64;
        for (int i = tid; i < 9 * 1024; i += NTHREADS) { const int r = i >> 10, k = i & 1023; const float v = r < 8 ? a.in(I_C)[r * 1024 + k] : a.in(I_CCTX)[k]; sl[k * 12 + r] = v / (1.f + expf(-v)); }
        __syncthreads();
        const float* W = a.in(I_ADAW) + (size_t)layer * 1024 * 6144 + n0 + lane;
        float acc[9];
#pragma unroll
        for (int r = 0; r < 9; ++r) acc[r] = 0.f;
#pragma unroll 32
        for (int k = wave * 128; k < wave * 128 + 128; ++k) {
            const float w = W[(size_t)k * 6144];
            const f32x4 s0 = *(const LAS f32x4*)(sl + k * 12), s1 = *(const LAS f32x4*)(sl + k * 12 + 4); const float s8 = sl[k * 12 + 8];
            acc[0] += s0.x * w; acc[1] += s0.y * w; acc[2] += s0.z * w; acc[3] += s0.w * w;
            acc[4] += s1.x * w; acc[5] += s1.y * w; acc[6] += s1.z * w; acc[7] += s1.w * w; acc[8] += s8 * w;
        }
#pragma unroll
        for (int r = 0; r < 9; ++r) red[(wave * 9 + r) * 64 + lane] = acc[r];
        __syncthreads();
        float* MOD = (float*)(a.ws() + WS_MOD);
        for (int i = tid; i < 576; i += NTHREADS) {
            const int r = i >> 6, l = i & 63; float s = 0.f;
#pragma unroll
            for (int w = 0; w < 8; ++w) s += red[(w * 9 + r) * 64 + l];
            MOD[(size_t)(layer * 9 + r) * 6144 + n0 + l] = s + a.in(I_ADAB)[layer * 6144 + n0 + l];
        }
        __syncthreads();
    }
#if ANY_FAST_GEMM
    constexpr int IT_QKV = 16 * 12, IT_WO = 16 * 4, IT_WIN = 16 * 8, IT_WOUT = 16 * 4, IT_G = 32;
#if FP8_MOE
    cvt8_run(a, 0, CV0_PRO + (int)blockIdx.x, (int)gridDim.x, CV_ITEMS, lds);
    cvt8_run(a, 1, CV1_PRO + (int)blockIdx.x, (int)gridDim.x, CV_ITEMS, lds);
    constexpr int IT_GU = 0, IT_DN = 0;
#else
    constexpr int IT_GU1 = 16 * 22, IT_DN1 = 44 * 4;
    constexpr int IT_GU = 32 * IT_GU1, IT_DN = 32 * IT_DN1;
#endif
    constexpr int NITEMS = IT_GU + IT_DN + IT_QKV + IT_WO + IT_WIN + IT_WOUT + IT_G;
    for (int it = blockIdx.x; it < NITEMS; it += gridDim.x) {
        int r = it;
#if !FP8_MOE
        if (r < IT_GU) { const int le = r / IT_GU1, q = r % IT_GU1;
            cvt_item(a.in(I_WGU) + (size_t)le * D * 2 * DE, 2 * DE, (q / 22) * 64, (q % 22) * 256, (bf16_t*)(a.ws() + WS_WGU) + (size_t)le * 2 * DE * D, D, 1); continue; }
        r -= IT_GU;
        if (r < IT_DN) { const int le = r / IT_DN1, q = r % IT_DN1;
            cvt_item(a.in(I_WDN) + (size_t)le * DE * D, D, (q / 4) * 64, (q % 4) * 256, (bf16_t*)(a.ws() + WS_WDN) + (size_t)le * D * DE, DE, 0); continue; }
#endif
        r -= IT_DN;
        if (r < IT_QKV) { cvt_item(a.in(I_WQKV), 3 * D, (r / 12) * 64, (r % 12) * 256, (bf16_t*)(a.ws() + WS_WQKV), D, 0); continue; }
        r -= IT_QKV;
        if (r < IT_WO) { cvt_item(a.in(I_WO), D, (r / 4) * 64, (r % 4) * 256, (bf16_t*)(a.ws() + WS_WO), D, 0); continue; }
        r -= IT_WO;
        if (r < IT_WIN) { cvt_item(a.in(I_WIN), 2 * D, (r / 8) * 64, (r % 8) * 256, (bf16_t*)(a.ws() + WS_WIN), D, 0); continue; }
        r -= IT_WIN;
        if (r < IT_WOUT) { cvt_item(a.in(I_WOUT), D, (r / 4) * 64, (r % 4) * 256, (bf16_t*)(a.ws() + WS_WOUT), D, 0); continue; }
        r -= IT_WOUT;
        { const int m = r >> 1, kk = r & 1;
            cvt_item(a.in(I_WGATES) + (size_t)m * 128 * 256, 256, kk * 64, 0, (bf16_t*)(a.ws() + WS_WG) + (size_t)m * 256 * 128, 128, 0); }
    }
#endif
}

__device__ __forceinline__ void ph_norm1_l0(const Ctx& a) {
    const int lane = threadIdx.x & 63, gw = blockIdx.x * NWAVES + (threadIdx.x >> 6), NGW = gridDim.x * NWAVES;
    unsigned char* ws = a.ws();
    bf16_t* XN = (bf16_t*)(ws + WS_XN); const float* X = a.in(I_X); const float* CX = a.in(I_CTX); const float* n1g = a.in(I_N1G);
    f32x4 v[4], nx[4];
    int row = gw;
    if (row < RT) load_row(row < RL ? X + (size_t)row * D : CX + (size_t)(row - RL) * D, lane, v);
    for (; row < RT; row += NGW) {
        const int rn = row + NGW;
        if (rn < RT) load_row(rn < RL ? X + (size_t)rn * D : CX + (size_t)(rn - RL) * D, lane, nx);
        const float* mp = (const float*)(ws + WS_MOD) + (size_t)mod_row(row) * 6144;
        rms_mod(v, n1g, mp + M_SH1, mp + M_SC1, lane);
        store_row_bf16(XN + (size_t)row * D, lane, v);
#pragma unroll
        for (int j = 0; j < 4; ++j) v[j] = nx[j];
    }
}
__device__ __forceinline__ float rs16(float (&s)[16], int lane) {
    float r8[8], r4[4], r2[2];
    const bool b5 = lane & 32, b4 = lane & 16, b3 = lane & 8, b2 = lane & 4;
#pragma unroll
    for (int i = 0; i < 8; ++i) { const float send = b5 ? s[i] : s[i + 8], keep = b5 ? s[i + 8] : s[i]; r8[i] = keep + __shfl_xor(send, 32); }
#pragma unroll
    for (int i = 0; i < 4; ++i) { const float send = b4 ? r8[i] : r8[i + 4], keep = b4 ? r8[i + 4] : r8[i]; r4[i] = keep + __shfl_xor(send, 16); }
#pragma unroll
    for (int i = 0; i < 2; ++i) { const float send = b3 ? r4[i] : r4[i + 2], keep = b3 ? r4[i + 2] : r4[i]; r2[i] = keep + __shfl_xor(send, 8); }
    float r = (b2 ? r2[1] : r2[0]) + __shfl_xor(b2 ? r2[0] : r2[1], 4);
    r += __shfl_xor(r, 2); r += __shfl_xor(r, 1);
    return r;
}
__device__ __forceinline__ void ph_norm2_router(const Ctx& a, LAS unsigned char* lds, int layer, int nrows) {
    const int tid = threadIdx.x, lane = tid & 63, gw = blockIdx.x * NWAVES + (tid >> 6), NGW = gridDim.x * NWAVES;
    LAS float* wrT = (LAS float*)lds;
    const float* wr = a.in(I_WR) + (size_t)layer * D * NE;
    for (int i = tid; i < D * NE; i += NTHREADS) wrT[(i & 15) * 1024 + (i >> 4)] = wr[i];
    __syncthreads();
    unsigned char* ws = a.ws();
    bf16_t* XN = (bf16_t*)(ws + WS_XN); const bf16_t* H = (const bf16_t*)(ws + WS_H);
    float* PL = (float*)(ws + WS_PROBS); float* PC = PL + NB * NE * SEQ;
    const float* n2g = a.in(I_N2G) + layer * D;
    const int elane = ((lane >> 5) & 1) * 8 + ((lane >> 4) & 1) * 4 + ((lane >> 3) & 1) * 2 + ((lane >> 2) & 1);
    f32x4 v0[4], v1[4], n0[4], n1[4];
    int p = gw;
    if (p < nrows / 2) { load_row_bf16(H + (size_t)(2 * p) * D, lane, v0); load_row_bf16(H + (size_t)(2 * p + 1) * D, lane, v1); }
    for (; p < nrows / 2; p += NGW) {
        const int pn = p + NGW;
        if (pn < nrows / 2) { load_row_bf16(H + (size_t)(2 * pn) * D, lane, n0); load_row_bf16(H + (size_t)(2 * pn + 1) * D, lane, n1); }
        const int row = 2 * p;
        const float* mp = (const float*)(ws + WS_MOD) + (size_t)(layer * 9 + mod_row(row)) * 6144;
        rms_mod(v0, n2g, mp + M_SH2, mp + M_SC2, lane); rms_mod(v1, n2g, mp + M_SH2, mp + M_SC2, lane);
#if FP8_MOE
        store_row_fp8((unsigned char*)XN + (size_t)row * D, lane, v0); store_row_fp8((unsigned char*)XN + (size_t)(row + 1) * D, lane, v1);
#else
        store_row_bf16(XN + (size_t)row * D, lane, v0); store_row_bf16(XN + (size_t)(row + 1) * D, lane, v1);
#endif
        float s0[16], s1[16];
#pragma unroll
        for (int e = 0; e < 16; ++e) {
            float a0 = 0.f, a1 = 0.f;
#pragma unroll
            for (int j = 0; j < 4; ++j) { const f32x4 w = *(const LAS f32x4*)(wrT + e * 1024 + 4 * lane + 256 * j);
                a0 += (v0[j].x * w.x + v0[j].y * w.y) + (v0[j].z * w.z + v0[j].w * w.w); a1 += (v1[j].x * w.x + v1[j].y * w.y) + (v1[j].z * w.z + v1[j].w * w.w); }
            s0[e] = a0; s1[e] = a1;
            if ((e & 3) == 3) asm volatile("" ::: "memory");
        }
        const float l0 = rs16(s0, lane), l1 = rs16(s1, lane);
        const float m0 = wave_max(l0), m1 = wave_max(l1);
        const float e0 = expf(l0 - m0), e1 = expf(l1 - m1);
        const float q0 = e0 / (wave_sum(e0) * 0.25f), q1 = e1 / (wave_sum(e1) * 0.25f);
        if ((lane & 3) == 0) {
            if (row < RL) { float* d = PL + ((size_t)(row >> 11) * NE + elane) * SEQ + (row & 2047); *(f32x2*)d = (f32x2){q0, q1}; }
            else { const int rc = row - RL; float* d = PC + ((size_t)(rc >> 8) * NE + elane) * CTXL + (rc & 255); *(f32x2*)d = (f32x2){q0, q1}; }
        }
#pragma unroll
        for (int j = 0; j < 4; ++j) { v0[j] = n0[j]; v1[j] = n1[j]; }
    }
    __syncthreads();
}
template <int NI>
__device__ __forceinline__ void topk_select(const float* src, int cap, int rowbase, int e, int xgbase, int* SEL, float* GATE, LAS int* idxl, int lane) {
    unsigned v[NI];
#pragma unroll
    for (int i = 0; i < NI; ++i) v[i] = __float_as_uint(src[i * 64 + lane]);
    unsigned prefix = 0u;
#pragma unroll 1
    for (int bit = 30; bit >= 0; --bit) {
        const unsigned cand = prefix | (1u << bit); int cnt = 0;
#pragma unroll
        for (int i = 0; i < NI; ++i) cnt += __popcll(__ballot(v[i] >= cand));
        if (cnt >= cap) prefix = cand;
    }
    int cgt = 0;
#pragma unroll
    for (int i = 0; i < NI; ++i) cgt += __popcll(__ballot(v[i] > prefix));
    const int need = cap - cgt;
    const unsigned long long lt = (1ull << lane) - 1ull;
    int slotbase = 0, eqseen = 0;
#pragma unroll
    for (int i = 0; i < NI; ++i) {
        const bool gt = v[i] > prefix, eq = v[i] == prefix;
        const unsigned long long meq = __ballot(eq);
        const bool sel = gt || (eq && (eqseen + __popcll(meq & lt)) < need);
        const unsigned long long msel = __ballot(sel);
        const int slot = slotbase + __popcll(msel & lt), t = i * 64 + lane;
        SEL[(size_t)(rowbase + t) * NE + e] = sel ? slot : -1;
        if (sel) { idxl[slot] = t; GATE[xgbase + slot] = __uint_as_float(v[i]); }
        slotbase += __popcll(msel); eqseen += __popcll(meq);
    }
}
__device__ __forceinline__ void ph_topk_gather(const Ctx& a, LAS unsigned char* lds, int layer) {
    const int tid = threadIdx.x, lane = tid & 63, wave = tid >> 6;
    LAS int* idxl = (LAS int*)lds;
    unsigned char* ws = a.ws();
    const float* PL = (const float*)(ws + WS_PROBS); const float* PC = PL + NB * NE * SEQ;
    float* GATE = (float*)(ws + WS_GATE); int* SEL = (int*)(ws + WS_SEL);
    const bf16_t* XN = (const bf16_t*)(ws + WS_XN); bf16_t* XG = (bf16_t*)(ws + WS_XG);
    const int nunits = layer == 0 ? 256 : 128, rpe = layer == 0 ? RPE0 : RPE1;
    for (int u0 = blockIdx.x; u0 < nunits; u0 += gridDim.x) {
        const int u = layer == 0 ? ((u0 & 1) * 128 + (u0 >> 1)) : u0;
        const bool lat = u < 128; const int b = (u & 127) >> 4, e = u & 15;
        const int cap = lat ? CAPL : CAPC;
        const int rowbase = lat ? b * SEQ : RL + b * CTXL;
        const int xgbase = e * rpe + (lat ? b * CAPL : NB * CAPL + b * CAPC);
        if (wave == 0) {
            if (lat) topk_select<SEQ / 64>(PL + ((size_t)b * NE + e) * SEQ, cap, rowbase, e, xgbase, SEL, GATE, idxl, lane);
            else topk_select<CTXL / 64>(PC + ((size_t)b * NE + e) * CTXL, cap, rowbase, e, xgbase, SEL, GATE, idxl, lane);
        }
        __syncthreads();
        for (int slot = wave; slot < cap; slot += NWAVES) {
            const int t = idxl[slot];
#if FP8_MOE
            ((u32x4*)((unsigned char*)XG + (size_t)(xgbase + slot) * D))[lane] = ((const u32x4*)((const unsigned char*)XN + (size_t)(rowbase + t) * D))[lane];
#else
            const u32x4* s = (const u32x4*)(XN + (size_t)(rowbase + t) * D);
            u32x4* d = (u32x4*)(XG + (size_t)(xgbase + slot) * D);
            d[lane] = s[lane]; d[lane + 64] = s[lane + 64];
#endif
        }
        __syncthreads();
    }
}
template <int MODE>
__device__ __forceinline__ void ph_combine(const Ctx& a, int layer, int nrows) {
    const int lane = threadIdx.x & 63, gw = blockIdx.x * NWAVES + (threadIdx.x >> 6), NGW = gridDim.x * NWAVES;
    bf16_t* H = (bf16_t*)(a.ws() + WS_H); const int* SEL = (const int*)(a.ws() + WS_SEL); const unsigned char* Y = a.ws() + WS_Y;
    bf16_t* XN = (bf16_t*)(a.ws() + WS_XN);
    const int rpe = layer == 0 ? RPE0 : RPE1;
    f32x4 v[4], vn[4]; int sel = -1, seln = -1;
    if (gw < nrows) { load_row_bf16(H + (size_t)gw * D, lane, v); sel = SEL[(size_t)gw * NE + (lane & 15)]; }
    for (int row = gw; row < nrows; row += NGW) {
        const int rnx = row + NGW;
        if (rnx < nrows) { load_row_bf16(H + (size_t)rnx * D, lane, vn); seln = SEL[(size_t)rnx * NE + (lane & 15)]; }
        const int mr = mod_row(row);
        const float* mp = mod_ptr(a, layer, mr);
        const int off = row < RL ? (row >> 11) * CAPL : NB * CAPL + ((row - RL) >> 8) * CAPC;
        f32x4 acc[4];
#pragma unroll
        for (int j = 0; j < 4; ++j) acc[j] = (f32x4){0.f, 0.f, 0.f, 0.f};
        unsigned mask = (unsigned)(__ballot(sel >= 0) & 0xffffull);
        int yw[4][4];
#pragma unroll
        for (int k = 0; k < 4; ++k) {
            const bool on = mask != 0u; const int e = on ? __builtin_ctz(mask) : 0; mask = on ? (mask & (mask - 1u)) : 0u;
            const int sidx = __builtin_amdgcn_readlane(sel, e);
            const unsigned char* yr = Y + (size_t)(on ? (e * rpe + off + sidx) : 0) * D;
#pragma unroll
            for (int j = 0; j < 4; ++j) { const int w = *(const int*)(yr + 4 * lane + 256 * j); yw[k][j] = on ? w : 0; }
        }
#pragma unroll
        for (int k = 0; k < 4; ++k)
#pragma unroll
            for (int j = 0; j < 4; ++j) { const f32x2 lo = __builtin_amdgcn_cvt_pk_f32_fp8(yw[k][j], false), hi2 = __builtin_amdgcn_cvt_pk_f32_fp8(yw[k][j], true);
                acc[j].x += lo.x; acc[j].y += lo.y; acc[j].z += hi2.x; acc[j].w += hi2.y; }
        while (mask != 0u) {
            const int e = __builtin_ctz(mask); mask &= mask - 1u;
            const int sidx = __builtin_amdgcn_readlane(sel, e);
            const unsigned char* yr = Y + (size_t)(e * rpe + off + sidx) * D;
#pragma unroll
            for (int j = 0; j < 4; ++j) { const int w = *(const int*)(yr + 4 * lane + 256 * j); const f32x2 lo = __builtin_amdgcn_cvt_pk_f32_fp8(w, false), hi2 = __builtin_amdgcn_cvt_pk_f32_fp8(w, true);
                acc[j].x += lo.x; acc[j].y += lo.y; acc[j].z += hi2.x; acc[j].w += hi2.y; }
        }
#pragma unroll
        for (int j = 0; j < 4; ++j) { const f32x4 g2 = *(const f32x4*)(mp + M_G2 + 4 * lane + 256 * j); v[j] = v[j] + g2 * (acc[j] * (1.0f / Y_SCALE)); }
        if (MODE == 0) {
            store_row_bf16(H + (size_t)row * D, lane, v);
            const float* mp1 = mod_ptr(a, 1, mr);
            rms_mod(v, a.in(I_N1G) + D, mp1 + M_SH1, mp1 + M_SC1, lane);
            store_row_bf16(XN + (size_t)row * D, lane, v);
        } else {
            rms_mod(v, a.in(I_FG), nullptr, nullptr, lane);
            store_row_f32(a.out() + (size_t)row * D, lane, v);
        }
#pragma unroll
        for (int j = 0; j < 4; ++j) v[j] = vn[j];
        sel = seln;
    }
}

__device__ __forceinline__ void ph_qkv_naive(const Ctx& a, LAS unsigned char* lds) {
    const bf16_t* XN = (const bf16_t*)(a.ws() + WS_XN); float* T = (float*)(a.ws() + WS_TMPF);
    for (int t = blockIdx.x; t < (RT / 128) * 48; t += gridDim.x) {
        const int tm = t / 48, tn = t % 48;
        naive_tile(XN + (size_t)tm * 128 * D, D, a.in(I_WQKV) + tn * 64, 3 * D, D, lds,
                   [&](int r, int c, float v) { T[(size_t)(tm * 128 + r) * 3072 + tn * 64 + c] = v; });
    }
}
__device__ __forceinline__ void ph_rope_naive(const Ctx& a) {
    const float* T = (const float*)(a.ws() + WS_TMPF); const float* rope = (const float*)(a.ws() + WS_ROPE);
    bf16_t* Q = (bf16_t*)(a.ws() + WS_Q); bf16_t* Kb = (bf16_t*)(a.ws() + WS_K); bf16_t* V = (bf16_t*)(a.ws() + WS_V);
    const size_t total = (size_t)RT * 3072, nth = (size_t)gridDim.x * NTHREADS;
    for (size_t i = (size_t)blockIdx.x * NTHREADS + threadIdx.x; i < total; i += nth) {
        const int row = (int)(i / 3072), c = (int)(i % 3072);
        if (c >= 2048) { V[(size_t)row * D + (c - 2048)] = (bf16_t)f2bf(T[i]); continue; }
        const int d = c & 63; if ((d & 31) >= 16) continue;
        float x1 = T[i], x2 = T[i + 16];
        if (row < RL) {
            const int t = row & 2047, axis = d >> 5, f = d & 15, pos = axis == 0 ? (t >> 6) : (t & 63);
            const float cs = rope[pos * 16 + f], sn = rope[1024 + pos * 16 + f];
            const float o1 = x1 * cs - x2 * sn, o2 = x2 * cs + x1 * sn; x1 = o1; x2 = o2;
        }
        if (c < 1024) { Q[(size_t)row * D + c] = (bf16_t)f2bf(x1 * QSCALE); Q[(size_t)row * D + c + 16] = (bf16_t)f2bf(x2 * QSCALE); }
        else { Kb[(size_t)row * D + c - 1024] = (bf16_t)f2bf(x1); Kb[(size_t)row * D + c - 1024 + 16] = (bf16_t)f2bf(x2); }
    }
}
template <int NIT>
__device__ __forceinline__ void naive_attn_item(const Ctx& a, int row, int h, float lam, LAS float* qs, int lane) {
    const bf16_t* Q = (const bf16_t*)(a.ws() + WS_Q); const bf16_t* Kb = (const bf16_t*)(a.ws() + WS_K); const bf16_t* V = (const bf16_t*)(a.ws() + WS_V);
    bf16_t* ATT = (bf16_t*)(a.ws() + WS_ATT);
    const int b = row < RL ? (row >> 11) : ((row - RL) >> 8);
    const int lat0 = b * SEQ, ctx0 = RL + b * CTXL;
    { const unsigned qq = *(const unsigned*)(Q + (size_t)row * D + h * 128 + 2 * lane); qs[2 * lane] = bf_lo(qq); qs[2 * lane + 1] = bf_hi(qq); }
    __builtin_amdgcn_fence(__ATOMIC_RELEASE, "wavefront"); __builtin_amdgcn_wave_barrier(); __builtin_amdgcn_fence(__ATOMIC_ACQUIRE, "wavefront");
#define NA_SCORE(it, d0, d1) do { const int kk_ = (it) * 64 + lane; \
        const int krow_ = (NIT == 36) ? (kk_ < SEQ ? lat0 + kk_ : ctx0 + kk_ - SEQ) : ctx0 + kk_; \
        const u32x4* kp_ = (const u32x4*)(Kb + (size_t)krow_ * D + h * 128); d0 = 0.f; d1 = 0.f; \
        _Pragma("unroll 4") for (int c = 0; c < 16; ++c) { const u32x4 kv = kp_[c]; \
            const f32x4 qa = *(const LAS f32x4*)(qs + 8 * c), qb = *(const LAS f32x4*)(qs + 8 * c + 4); \
            const float dd = (qa.x * bf_lo(kv.x) + qa.y * bf_hi(kv.x)) + (qa.z * bf_lo(kv.y) + qa.w * bf_hi(kv.y)) \
                           + (qb.x * bf_lo(kv.z) + qb.y * bf_hi(kv.z)) + (qb.z * bf_lo(kv.w) + qb.w * bf_hi(kv.w)); \
            if (c < 8) d0 += dd; else d1 += dd; } } while (0)
    float m0 = -3.0e38f, m1 = -3.0e38f, l0 = 0.f, l1 = 0.f;
#pragma unroll 1
    for (int it = 0; it < NIT; ++it) {
        float d0, d1; NA_SCORE(it, d0, d1);
        const float n0 = fmaxf(m0, d0), n1 = fmaxf(m1, d1);
        l0 = l0 * exp2f(m0 - n0) + exp2f(d0 - n0); l1 = l1 * exp2f(m1 - n1) + exp2f(d1 - n1); m0 = n0; m1 = n1;
    }
    { const float g0 = wave_max(m0), g1 = wave_max(m1); l0 = wave_sum(l0 * exp2f(m0 - g0)); l1 = wave_sum(l1 * exp2f(m1 - g1)); m0 = g0; m1 = g1; }
    const float i0 = 1.f / l0, i1 = lam / l1;
    float o0 = 0.f, o1 = 0.f;
#pragma unroll 1
    for (int it = 0; it < NIT; ++it) {
        float d0, d1; NA_SCORE(it, d0, d1);
        const int wbits = __float_as_int(exp2f(d0 - m0) * i0 - exp2f(d1 - m1) * i1);
#pragma unroll 4
        for (int src = 0; src < 64; ++src) {
            const float wv = __int_as_float(__builtin_amdgcn_readlane(wbits, src));
            const int kk = it * 64 + src;
            const int krow = (NIT == 36) ? (kk < SEQ ? lat0 + kk : ctx0 + kk - SEQ) : ctx0 + kk;
            const unsigned vv = *(const unsigned*)(V + (size_t)krow * D + h * 128 + 2 * lane);
            o0 += wv * bf_lo(vv); o1 += wv * bf_hi(vv);
        }
    }
#undef NA_SCORE
    const float ss = wave_sum(o0 * o0 + o1 * o1);
    const float rstd = 1.0f / sqrtf(ss * (1.0f / 128.0f) + EPS);
    const float g0 = a.in(I_SUBG)[2 * lane], g1 = a.in(I_SUBG)[2 * lane + 1];
    *(unsigned*)(ATT + (size_t)row * D + h * 128 + 2 * lane) = pk2(o0 * rstd * g0 * (1.0f - LAMBDA_INIT0), o1 * rstd * g1 * (1.0f - LAMBDA_INIT0));
}
__device__ __forceinline__ float diff_lambda(const Ctx& a, int lane) {
    const float s1 = wave_sum(a.in(I_LQ1)[lane] * a.in(I_LK1)[lane]), s2 = wave_sum(a.in(I_LQ2)[lane] * a.in(I_LK2)[lane]);
    return expf(s1) - expf(s2) + LAMBDA_INIT0;
}
__device__ __forceinline__ void ph_attn_naive(const Ctx& a, LAS unsigned char* lds) {
    const int lane = threadIdx.x & 63, wave = threadIdx.x >> 6, gw = blockIdx.x * NWAVES + wave, NGW = gridDim.x * NWAVES;
    LAS float* qs = (LAS float*)lds + wave * 128;
    const float lam = diff_lambda(a, lane);
    for (int item = gw; item < RT * 8; item += NGW) {
        const int h = item / RT, row = item % RT;
        if (row < RL) naive_attn_item<36>(a, row, h, lam, qs, lane); else naive_attn_item<4>(a, row, h, lam, qs, lane);
    }
}
__device__ __forceinline__ void ph_wo_naive(const Ctx& a, LAS unsigned char* lds) {
    const bf16_t* ATT = (const bf16_t*)(a.ws() + WS_ATT); bf16_t* H = (bf16_t*)(a.ws() + WS_H);
    for (int t = blockIdx.x; t < (RT / 128) * 16; t += gridDim.x) {
        const int tm = t / 16, tn = t % 16;
        naive_tile(ATT + (size_t)tm * 128 * D, D, a.in(I_WO) + tn * 64, D, D, lds, [&](int r, int c, float v) {
            const int row = tm * 128 + r, col = tn * 64 + c;
            const float base = row < RL ? a.in(I_X)[(size_t)row * D + col] : a.in(I_CTX)[(size_t)(row - RL) * D + col];
            H[(size_t)row * D + col] = (bf16_t)f2bf(base + mod_ptr(a, 0, mod_row(row))[M_G1 + col] * v); });
    }
}
__device__ __forceinline__ void ph_gu_naive(const Ctx& a, LAS unsigned char* lds, int layer) {
    const int rpe = layer == 0 ? RPE0 : RPE1, tpe = (rpe / 128) * 88;
    const bf16_t* XG = (const bf16_t*)(a.ws() + WS_XG); float* T = (float*)(a.ws() + WS_TMPF);
    for (int t = blockIdx.x; t < NE * tpe; t += gridDim.x) {
        const int e = t / tpe, q = t % tpe, tm = q / 88, tn = q % 88;
        const size_t row0 = (size_t)e * rpe + tm * 128;
        naive_tile(XG + row0 * D, D, a.in(I_WGU) + (size_t)(layer * NE + e) * D * 2 * DE + tn * 64, 2 * DE, D, lds,
                   [&](int r, int c, float v) { T[(row0 + r) * (2 * DE) + tn * 64 + c] = v; });
    }
}
__device__ __forceinline__ void ph_swiglu_naive(const Ctx& a, int layer) {
    const int rpe = layer == 0 ? RPE0 : RPE1;
    const float* T = (const float*)(a.ws() + WS_TMPF); bf16_t* ACT = (bf16_t*)(a.ws() + WS_ACT);
    const size_t total = (size_t)NE * rpe * DE, nth = (size_t)gridDim.x * NTHREADS;
    for (size_t i = (size_t)blockIdx.x * NTHREADS + threadIdx.x; i < total; i += nth) {
        const size_t row = i / DE; const int j = (int)(i % DE);
        const float g = T[row * (2 * DE) + j], u = T[row * (2 * DE) + DE + j];
        ACT[i] = (bf16_t)f2bf(g / (1.f + expf(-g)) * u);
    }
}
__device__ __forceinline__ void ph_dn_naive(const Ctx& a, LAS unsigned char* lds, int layer) {
    const int rpe = layer == 0 ? RPE0 : RPE1, tpe = (rpe / 128) * 16;
    const bf16_t* ACT = (const bf16_t*)(a.ws() + WS_ACT); unsigned char* Y = a.ws() + WS_Y; const float* GATE = (const float*)(a.ws() + WS_GATE);
    for (int t = blockIdx.x; t < NE * tpe; t += gridDim.x) {
        const int e = t / tpe, q = t % tpe, tm = q / 16, tn = q % 16;
        const size_t row0 = (size_t)e * rpe + tm * 128;
        naive_tile(ACT + row0 * DE, DE, a.in(I_WDN) + (size_t)(layer * NE + e) * DE * D + tn * 64, D, DE, lds,
                   [&](int r, int c, float v) { Y[(row0 + r) * D + tn * 64 + c] = (unsigned char)(pk4_fp8(v * GATE[row0 + r] * Y_SCALE, 0.f, 0.f, 0.f) & 0xffu); });
    }
}
__device__ __forceinline__ void ph_win_naive(const Ctx& a, LAS unsigned char* lds) {
    const bf16_t* XN = (const bf16_t*)(a.ws() + WS_XN); bf16_t* YG = (bf16_t*)(a.ws() + WS_YG); bf16_t* XR = (bf16_t*)(a.ws() + WS_XR);
    const int TL = (RL / 128) * 32, TC = (RC / 128) * 16;
    for (int t = blockIdx.x; t < TL + TC; t += gridDim.x) {
        int tm, tn; if (t < TL) { tm = t / 32; tn = t % 32; } else { const int q = t - TL; tm = RL / 128 + q / 16; tn = 16 + q % 16; }
        naive_tile(XN + (size_t)tm * 128 * D, D, a.in(I_WIN) + tn * 64, 2 * D, D, lds, [&](int r, int c, float v) {
            const int row = tm * 128 + r, col = tn * 64 + c; const float x = v + a.in(I_BIN)[col];
            if (col < D) YG[(size_t)row * D + col] = (bf16_t)f2bf(gelu_tanh(x)); else XR[(size_t)row * D + col - D] = (bf16_t)f2bf(x); });
    }
}
__device__ __forceinline__ void ph_conv_naive(const Ctx& a) {
    const bf16_t* XR = (const bf16_t*)(a.ws() + WS_XR); bf16_t* XC = (bf16_t*)(a.ws() + WS_XC);
    const size_t total = (size_t)RT * D, nth = (size_t)gridDim.x * NTHREADS;
    for (size_t i = (size_t)blockIdx.x * NTHREADS + threadIdx.x; i < total; i += nth) {
        const int row = (int)(i >> 10), ch = (int)(i & 1023);
        const int t = row < RL ? (row & 2047) : ((row - RL) & 255), L = row < RL ? SEQ : CTXL;
        float v = a.in(I_CONVB)[ch];
#pragma unroll
        for (int j = 0; j < 4; ++j) { const int tt = t - 2 + j; if (tt >= 0 && tt < L) v += a.in(I_CONVW)[j * D + ch] * bf2f(XR[(size_t)(row - t + tt) * D + ch]); }
        XC[i] = (bf16_t)f2bf(v);
    }
}
__device__ __forceinline__ void ph_gates_naive(const Ctx& a, LAS unsigned char* lds) {
    const bf16_t* XC = (const bf16_t*)(a.ws() + WS_XC); float* T = (float*)(a.ws() + WS_TMPF);
    for (int t = blockIdx.x; t < 16 * (RT / 128) * 4; t += gridDim.x) {
        const int m = t / ((RT / 128) * 4), q = t % ((RT / 128) * 4), tm = q >> 2, tn = q & 3, d = m >> 3, kb = m & 7;
        naive_tile(XC + (size_t)tm * 128 * D + kb * 128, D, a.in(I_WGATES) + (size_t)m * 128 * 256 + tn * 64, 256, 128, lds,
                   [&](int r, int c, float v) { T[((size_t)d * RT + tm * 128 + r) * 2048 + kb * 256 + tn * 64 + c] = v; });
    }
}
__device__ __forceinline__ void ph_gate_elem_naive(const Ctx& a) {
    const float* T = (const float*)(a.ws() + WS_TMPF); const bf16_t* XC = (const bf16_t*)(a.ws() + WS_XC);
    bf16_t* LOGA = (bf16_t*)(a.ws() + WS_LOGA); unsigned char* BT = a.ws() + WS_BT;
    const size_t total = (size_t)2 * RT * D, nth = (size_t)gridDim.x * NTHREADS;
    for (size_t i = (size_t)blockIdx.x * NTHREADS + threadIdx.x; i < total; i += nth) {
        const int d = (int)(i / ((size_t)RT * D)); const size_t rc = i % ((size_t)RT * D); const int row = (int)(rc >> 10), ch = (int)(rc & 1023), kb = ch >> 7, cc = ch & 127;
        const float gr = T[((size_t)d * RT + row) * 2048 + kb * 256 + cc] + a.in(I_BGATES)[(d * 8 + kb) * 256 + cc];
        const float gi = T[((size_t)d * RT + row) * 2048 + kb * 256 + 128 + cc] + a.in(I_BGATES)[(d * 8 + kb) * 256 + 128 + cc];
        const float r = sigmoidf_(gr), ig = sigmoidf_(gi);
        const float lam = a.in(I_LAM)[d * D + ch];
        const float la = -8.0f * r * log1pf(expf(-lam));
        const float x = bf2f(XC[rc]);
        const float bt = sqrtf(-expm1f(2.0f * la)) * (ig * x);
        LOGA[i] = (bf16_t)f2bf(la * 1.4426950408889634f); BT[i] = (unsigned char)(pk4_fp8(bt * BT_SCALE, 0.f, 0.f, 0.f) & 0xffu);
    }
}
__device__ __forceinline__ void ph_wout_naive(const Ctx& a, LAS unsigned char* lds) {
    const bf16_t* HS = (const bf16_t*)(a.ws() + WS_HS); bf16_t* H = (bf16_t*)(a.ws() + WS_H);
    for (int t = blockIdx.x; t < (RL / 128) * 16; t += gridDim.x) {
        const int tm = t / 16, tn = t % 16;
        naive_tile(HS + (size_t)tm * 128 * D, D, a.in(I_WOUT) + tn * 64, D, D, lds, [&](int r, int c, float v) {
            const int row = tm * 128 + r, col = tn * 64 + c;
            H[(size_t)row * D + col] = (bf16_t)f2bf(bf2f(H[(size_t)row * D + col]) + mod_ptr(a, 1, row >> 11)[M_G1 + col] * v); });
    }
}

__device__ __forceinline__ int scan_row(int b, int dir, int c, int s) {
    const int p = c * SCH + s;
    if (dir == 0) return p < CTXL ? RL + b * CTXL + p : b * SEQ + (p - CTXL);
    return p < CTXL ? RL + b * CTXL + (CTXL - 1 - p) : b * SEQ + (SEQ - 1 - (p - CTXL));
}
__device__ __forceinline__ void ph_scan1(const Ctx& a) {
    const int lane = threadIdx.x & 63, gw = blockIdx.x * NWAVES + (threadIdx.x >> 6), NGW = gridDim.x * NWAVES;
    const bf16_t* LOGA = (const bf16_t*)(a.ws() + WS_LOGA); const unsigned char* BT = a.ws() + WS_BT;
    float* CP = (float*)(a.ws() + WS_CP); float* CB = (float*)(a.ws() + WS_CB);
    for (int item = gw; item < NB * 2 * NCH * 8; item += NGW) {
        const int cg = item & 7, c = (item >> 3) % NCH, bd = (item >> 3) / NCH, dir = bd & 1, b = bd >> 1;
        const int ch = cg * 128 + 2 * lane;
        float h0 = 0.f, h1 = 0.f, p0 = 0.f, p1 = 0.f;
#pragma unroll 1
        for (int sg = 0; sg < SCH; sg += 32) {
            unsigned la[32], bt[32];
#pragma unroll
            for (int i = 0; i < 32; ++i) { const size_t o = ((size_t)dir * RT + scan_row(b, dir, c, sg + i)) * D + ch; la[i] = *(const unsigned*)(LOGA + o); bt[i] = *(const unsigned short*)(BT + o); }
            asm volatile("" ::: "memory");
#pragma unroll
            for (int i = 0; i < 32; ++i) { const float l0 = bf_lo(la[i]), l1 = bf_hi(la[i]);
                const f32x2 bb = __builtin_amdgcn_cvt_pk_f32_fp8((int)bt[i], false);
                h0 = __builtin_amdgcn_exp2f(l0) * h0 + bb.x; h1 = __builtin_amdgcn_exp2f(l1) * h1 + bb.y; p0 += l0; p1 += l1; }
        }
        const size_t so = ((size_t)(b * 2 + dir) * NCH + c) * D + ch;
        *(f32x2*)(CP + so) = (f32x2){p0, p1}; *(f32x2*)(CB + so) = (f32x2){h0, h1};
    }
}
__device__ __forceinline__ void ph_scan2(const Ctx& a) {
    const int lane = threadIdx.x & 63, gw = blockIdx.x * NWAVES + (threadIdx.x >> 6), NGW = gridDim.x * NWAVES;
    const bf16_t* LOGA = (const bf16_t*)(a.ws() + WS_LOGA); const unsigned char* BT = a.ws() + WS_BT;
    const float* CP = (const float*)(a.ws() + WS_CP); const float* CB = (const float*)(a.ws() + WS_CB);
    const bf16_t* YG = (const bf16_t*)(a.ws() + WS_YG); bf16_t* HS = (bf16_t*)(a.ws() + WS_HS);
    constexpr int NLC = SEQ / SCH;
    for (int item = gw; item < NB * NLC * 8; item += NGW) {
        const int cg = item & 7, j = (item >> 3) % NLC, b = (item >> 3) / NLC;
        const int ch = cg * 128 + 2 * lane;
        const int cb = NCH_CTX + (NLC - 1 - j), cf = NCH_CTX + j;
        float hb0 = 0.f, hb1 = 0.f, hf0 = 0.f, hf1 = 0.f;
#pragma unroll 1
        for (int c0 = 0; c0 < NCH - 1; c0 += 12) {
            f32x2 pb[12], qb[12], pf[12], qf[12];
#pragma unroll
            for (int i = 0; i < 12; ++i) {
                const int c = c0 + i; const size_t sb_ = ((size_t)(b * 2 + 1) * NCH + c) * D + ch, sf_ = ((size_t)(b * 2 + 0) * NCH + c) * D + ch;
                const f32x2 z = (f32x2){0.f, 0.f};
                pb[i] = c < cb ? *(const f32x2*)(CP + sb_) : z; qb[i] = c < cb ? *(const f32x2*)(CB + sb_) : z;
                pf[i] = c < cf ? *(const f32x2*)(CP + sf_) : z; qf[i] = c < cf ? *(const f32x2*)(CB + sf_) : z;
            }
            asm volatile("" ::: "memory");
#pragma unroll
            for (int i = 0; i < 12; ++i) {
                hb0 = __builtin_amdgcn_exp2f(pb[i].x) * hb0 + qb[i].x; hb1 = __builtin_amdgcn_exp2f(pb[i].y) * hb1 + qb[i].y;
                hf0 = __builtin_amdgcn_exp2f(pf[i].x) * hf0 + qf[i].x; hf1 = __builtin_amdgcn_exp2f(pf[i].y) * hf1 + qf[i].y;
            }
        }
        float sb0[SCH], sb1[SCH];
#pragma unroll
        for (int sg = 0; sg < SCH; sg += 32) {
            unsigned la[32], bt[32];
#pragma unroll
            for (int i = 0; i < 32; ++i) { const size_t o = ((size_t)1 * RT + b * SEQ + j * SCH + (SCH - 1 - (sg + i))) * D + ch; la[i] = *(const unsigned*)(LOGA + o); bt[i] = *(const unsigned short*)(BT + o); }
            asm volatile("" ::: "memory");
#pragma unroll
            for (int i = 0; i < 32; ++i) {
                const f32x2 bb = __builtin_amdgcn_cvt_pk_f32_fp8((int)bt[i], false);
                hb0 = __builtin_amdgcn_exp2f(bf_lo(la[i])) * hb0 + bb.x; hb1 = __builtin_amdgcn_exp2f(bf_hi(la[i])) * hb1 + bb.y;
                sb0[SCH - 1 - (sg + i)] = hb0; sb1[SCH - 1 - (sg + i)] = hb1;
            }
        }
#pragma unroll
        for (int sg = 0; sg < SCH; sg += 16) {
            unsigned la[16], bt[16], yg[16];
#pragma unroll
            for (int i = 0; i < 16; ++i) { const size_t o = ((size_t)b * SEQ + j * SCH + sg + i) * D + ch; la[i] = *(const unsigned*)(LOGA + o); bt[i] = *(const unsigned short*)(BT + o); yg[i] = *(const unsigned*)(YG + o); }
            asm volatile("" ::: "memory");
#pragma unroll
            for (int i = 0; i < 16; ++i) {
                const size_t o = ((size_t)b * SEQ + j * SCH + sg + i) * D + ch;
                const f32x2 bb = __builtin_amdgcn_cvt_pk_f32_fp8((int)bt[i], false);
                hf0 = __builtin_amdgcn_exp2f(bf_lo(la[i])) * hf0 + bb.x; hf1 = __builtin_amdgcn_exp2f(bf_hi(la[i])) * hf1 + bb.y;
                *(unsigned*)(HS + o) = pk2(bf_lo(yg[i]) * ((hf0 + sb0[sg + i]) * (1.0f / BT_SCALE)), bf_hi(yg[i]) * ((hf1 + sb1[sg + i]) * (1.0f / BT_SCALE)));
            }
            asm volatile("" ::: "memory");
        }
    }
}
#define XB_TMO      128
#define XB_XCNT(j)  (256  + 64 * (j))
#define XB_XSUB(j)  (1280 + 64 * (j))
#define XB_XGEN(j)  (2304 + 64 * (j))
#define XB_TOP      3328
#define XB_TOPGEN   3392
#define XCD_BAR_WORDS 3456
#define XB_SPIN_CAP (1u << 18)

__device__ __forceinline__ unsigned xb_ld(unsigned* p)              { return __hip_atomic_load(p, __ATOMIC_RELAXED, __HIP_MEMORY_SCOPE_AGENT); }
__device__ __forceinline__ unsigned xb_add(unsigned* p, unsigned v) { return __hip_atomic_fetch_add(p, v, __ATOMIC_RELAXED, __HIP_MEMORY_SCOPE_AGENT); }
__device__ __forceinline__ unsigned xb_xcc_id() { return (unsigned)__builtin_amdgcn_s_getreg((3 << 11) | 20) & 0xFu; }
#define XB_SPIN(cond, bar) do { unsigned _sp = 0; while (cond) { __builtin_amdgcn_s_sleep(1); \
    if ((++_sp & 255u) == 0u) { if (xb_ld(&(bar)[XB_TMO])) break; if (_sp > XB_SPIN_CAP) { atomicAdd(&(bar)[XB_TMO], 1u); break; } } } } while (0)

struct XcdBarrier {
    unsigned* bar; unsigned x;
    volatile LAS unsigned* st;
};

__device__ __forceinline__ XcdBarrier xcd_barrier_post(unsigned* bar, volatile LAS unsigned* st) {
    XcdBarrier b; b.bar = bar; b.x = xb_xcc_id(); b.st = st;
    if (threadIdx.x == 0) (void)xb_add(&bar[XB_XCNT(b.x)], 1u);
    return b;
}
__device__ __forceinline__ void xcd_barrier_complete(unsigned* bar, unsigned x, unsigned& nloc, unsigned& nx) {
    const unsigned G = gridDim.x * gridDim.y * gridDim.z;
    unsigned sum, cnt, mine, sp = 0u;
    for (;;) {
        sum = 0u; cnt = 0u; mine = 0u;
#pragma unroll
        for (unsigned j = 0; j < 16; ++j) { const unsigned c = xb_ld(&bar[XB_XCNT(j)]); sum += c; cnt += (c > 0u) ? 1u : 0u; mine = (j == x) ? c : mine; }
        if (sum == G) break;
        __builtin_amdgcn_s_sleep(1);
        if ((++sp & 255u) == 0u) { if (xb_ld(&bar[XB_TMO])) break; if (sp > XB_SPIN_CAP) { atomicAdd(&bar[XB_TMO], 1u); break; } }
    }
    nloc = mine > 0u ? mine : 1u; nx = cnt > 0u ? cnt : 1u;
}

__device__ __forceinline__ void xcd_barrier(const XcdBarrier& b) {
    asm volatile("s_waitcnt vmcnt(0)" ::: "memory");
    __syncthreads();
    if (threadIdx.x == 0) {
        unsigned* bar = b.bar;
        __builtin_amdgcn_s_waitcnt(0);
        unsigned nloc = b.st[0], nx = b.st[1];
        if (nloc == 0u) { xcd_barrier_complete(bar, b.x, nloc, nx); b.st[0] = nloc; b.st[1] = nx; }
        const unsigned old = xb_add(&bar[XB_XSUB(b.x)], 1u);
        const unsigned gen = old / nloc;
        if (old + 1u == (gen + 1u) * nloc) {
            __builtin_amdgcn_fence(__ATOMIC_RELEASE, "agent");
            asm volatile("s_waitcnt vmcnt(0)" ::: "memory");
            const unsigned og = xb_add(&bar[XB_TOP], 1u);
            const unsigned tg = og / nx;
            if (og + 1u == (tg + 1u) * nx) xb_add(&bar[XB_TOPGEN], 1u);
            else XB_SPIN(xb_ld(&bar[XB_TOPGEN]) == tg, bar);
            __builtin_amdgcn_fence(__ATOMIC_ACQUIRE, "agent");
            xb_add(&bar[XB_XGEN(b.x)], 1u);
            asm volatile("s_waitcnt vmcnt(0)" ::: "memory");
        } else {
            XB_SPIN(xb_ld(&bar[XB_XGEN(b.x)]) == gen, bar);
            __builtin_amdgcn_fence(__ATOMIC_ACQUIRE, "agent");
            asm volatile("s_waitcnt vmcnt(0)" ::: "memory");
        }
    }
    __syncthreads();
}

__device__ __forceinline__ int xcd_remap(long L, int n) { const int q = n / 8, r = n % 8, xcd = (int)(L % 8), off = (int)(L / 8); return (xcd < r ? xcd * (q + 1) : r * (q + 1) + (xcd - r) * q) + off; }
template <class Map> struct ListOrder {
    int nunits, G, c; Map map;
    __device__ __forceinline__ bool next(int i, pg8::Unit& u) const { const long L = (long)i * G + c; if (L >= nunits) return false; map(xcd_remap(L, nunits), u); return true; }
    __device__ __forceinline__ void a_ready(const pg8::Unit&) const {}
    __device__ __forceinline__ void done(const pg8::Unit&) const {}
};
struct MapGrid { int nN; __device__ __forceinline__ void operator()(int w, pg8::Unit& u) const { const int nig = 8 * nN; u.pm = (w / nig) * 8 + (w % nig) % 8; u.pn = (w % nig) / 8; } };
struct MapMoe { int PM, NT; __device__ __forceinline__ void operator()(int w, pg8::Unit& u) const { const int per = PM * NT, e = w / per, rem = w % per; u.pm = e * PM + rem % PM; u.pn = e * NT + rem / PM; } };
struct MapWin { __device__ __forceinline__ void operator()(int w, pg8::Unit& u) const { if (w < 512) { u.pm = (w / 64) * 8 + (w % 64) % 8; u.pn = (w % 64) / 8; } else { const int q = w - 512; u.pm = 64 + q % 8; u.pn = 4 + q / 8; } } };

typedef pg8::f32x4 pf4;
__device__ __forceinline__ float fast_exp(float x) { return __builtin_amdgcn_exp2f(x * 1.4426950408889634f); }

struct EpiQKV {
    static constexpr bool PERM = true, AFTER_DRAIN = false;
    bf16_t* Q; const LAS float* rope;
    __device__ __forceinline__ void operator()(const pf4 (&acc)[2][2][4][2], const pg8::Unit& u, int wr, int wc, int fr, int fq) const {
        const int sec = u.pn >> 2; bf16_t* base = Q + (size_t)sec * ((WS_K - WS_Q) / 2);
        const bool lat = u.pm < 64, dorope = sec < 2 && lat; const int axis = wc & 1;
        const bool upper = fq >= 2;
        const int row0 = u.pm * 256 + wr * 64 + fr, col0 = (u.pn & 3) * 256 + wc * 32 + 8 * fq;
        const float sc = sec == 0 ? QSCALE : 1.0f;
#pragma unroll
        for (int ai = 0; ai < 2; ++ai)
#pragma unroll
            for (int m = 0; m < 4; ++m) {
                const int row = row0 + ai * 128 + m * 16;
                pf4 cs[2], sn[2];
#pragma unroll
                for (int n = 0; n < 2; ++n) { cs[n] = (pf4){1.f, 1.f, 1.f, 1.f}; sn[n] = (pf4){0.f, 0.f, 0.f, 0.f}; }
                if (dorope) { const int t = row & 2047, pos = axis ? (t & 63) : (t >> 6); const LAS float* rp = rope + pos * 16 + 8 * (fq & 1);
#pragma unroll
                    for (int n = 0; n < 2; ++n) { cs[n] = *(const LAS pf4*)(rp + 4 * n); sn[n] = *(const LAS pf4*)(rp + 1024 + 4 * n); } }
#pragma unroll
                for (int bj = 0; bj < 2; ++bj) {
                    pf4 o[2];
#pragma unroll
                    for (int n = 0; n < 2; ++n)
#pragma unroll
                        for (int j = 0; j < 4; ++j) {
                            const float own = acc[ai][bj][m][n][j];
                            float v = own;
                            if (dorope) {
                                const auto rr = __builtin_amdgcn_permlane32_swap(__float_as_uint(own), __float_as_uint(own), false, false);
                                const float other = __uint_as_float(upper ? rr[0] : rr[1]);
                                v = upper ? (own * cs[n][j] + other * sn[n][j]) : (own * cs[n][j] - other * sn[n][j]);
                            }
                            o[n][j] = v * sc;
                        }
                    u32x4 w; w.x = pk2(o[0][0], o[0][1]); w.y = pk2(o[0][2], o[0][3]); w.z = pk2(o[1][0], o[1][1]); w.w = pk2(o[1][2], o[1][3]);
                    *(u32x4*)(base + (size_t)row * D + col0 + bj * 128) = w;
                }
            }
    }
};
struct EpiResid {
    static constexpr bool PERM = true, AFTER_DRAIN = false;
    bf16_t* H; const float* x; const float* ctx; const float* mod; int layer;
    __device__ __forceinline__ void operator()(const pf4 (&acc)[2][2][4][2], const pg8::Unit& u, int wr, int wc, int fr, int fq) const {
        const bool lat = u.pm < 64;
        const float* xb = lat ? x + (size_t)u.pm * 256 * D : ctx + (size_t)(u.pm - 64) * 256 * D;
        const float* g = mod + (size_t)(layer * 9 + (lat ? (u.pm >> 3) : 8)) * 6144 + M_G1;
        bf16_t* out = H + (size_t)u.pm * 256 * D;
        const int r0 = wr * 64 + fr, col0 = u.pn * 256 + wc * 32 + 8 * fq;
        pf4 gv[2][2];
#pragma unroll
        for (int bj = 0; bj < 2; ++bj)
#pragma unroll
            for (int n = 0; n < 2; ++n) gv[bj][n] = *(const pf4*)(g + col0 + bj * 128 + 4 * n);
#pragma unroll
        for (int it = 0; it < 8; ++it) {
            const int ai = it >> 2, m = it & 3;
            const size_t ro = (size_t)(r0 + ai * 128 + m * 16) * D + col0;
#pragma unroll
            for (int bj = 0; bj < 2; ++bj) {
                pf4 b0, b1;
                if (layer == 0) { b0 = *(const pf4*)(xb + ro + bj * 128); b1 = *(const pf4*)(xb + ro + bj * 128 + 4); }
                else { const u32x4 hb = *(const u32x4*)(out + ro + bj * 128); b0 = (pf4){bf_lo(hb.x), bf_hi(hb.x), bf_lo(hb.y), bf_hi(hb.y)}; b1 = (pf4){bf_lo(hb.z), bf_hi(hb.z), bf_lo(hb.w), bf_hi(hb.w)}; }
                const pf4 o0 = b0 + gv[bj][0] * acc[ai][bj][m][0], o1 = b1 + gv[bj][1] * acc[ai][bj][m][1];
                u32x4 w; w.x = pk2(o0[0], o0[1]); w.y = pk2(o0[2], o0[3]); w.z = pk2(o1[0], o1[1]); w.w = pk2(o1[2], o1[3]);
                *(u32x4*)(out + ro + bj * 128) = w;
            }
        }
    }
};
struct EpiSwiGLU {
    static constexpr bool PERM = true, AFTER_DRAIN = false;
    bf16_t* ACT;
    __device__ __forceinline__ void operator()(const pf4 (&acc)[2][2][4][2], const pg8::Unit& u, int wr, int wc, int fr, int fq) const {
        const int ct = u.pn % 22;
        bf16_t* p0 = ACT + (size_t)(u.pm * 256 + wr * 64 + fr) * DE + ct * 128 + wc * 32 + 8 * fq;
#pragma unroll
        for (int ai = 0; ai < 2; ++ai)
#pragma unroll
            for (int m = 0; m < 4; ++m) {
                float o[8];
#pragma unroll
                for (int n = 0; n < 2; ++n)
#pragma unroll
                    for (int j = 0; j < 4; ++j) { const float g = acc[ai][0][m][n][j], uu = acc[ai][1][m][n][j]; o[n * 4 + j] = g * __builtin_amdgcn_rcpf(1.0f + fast_exp(-g)) * uu; }
                u32x4 w; w.x = pk2(o[0], o[1]); w.y = pk2(o[2], o[3]); w.z = pk2(o[4], o[5]); w.w = pk2(o[6], o[7]);
                *(u32x4*)(p0 + (size_t)(ai * 128 + m * 16) * DE) = w;
            }
    }
};
struct EpiDown {
    static constexpr bool PERM = true, AFTER_DRAIN = false;
    unsigned char* Y; const float* GATE;
    __device__ __forceinline__ void operator()(const pf4 (&acc)[2][2][4][2], const pg8::Unit& u, int wr, int wc, int fr, int fq) const {
        const int row0 = u.pm * 256 + wr * 64 + fr, col0 = (u.pn & 3) * 256 + wc * 32 + 8 * fq;
        float gts[8];
#pragma unroll
        for (int i = 0; i < 8; ++i) gts[i] = GATE[row0 + (i >> 2) * 128 + (i & 3) * 16] * Y_SCALE;
#pragma unroll
        for (int ai = 0; ai < 2; ++ai)
#pragma unroll
            for (int m = 0; m < 4; ++m) {
                const int row = row0 + ai * 128 + m * 16; const float gt = gts[ai * 4 + m];
#pragma unroll
                for (int bj = 0; bj < 2; ++bj) {
                    const pf4 v0 = acc[ai][bj][m][0] * gt, v1 = acc[ai][bj][m][1] * gt;
                    u32x2 w; w.x = pk4_fp8(v0[0], v0[1], v0[2], v0[3]); w.y = pk4_fp8(v1[0], v1[1], v1[2], v1[3]);
                    *(u32x2*)(Y + (size_t)row * D + col0 + bj * 128) = w;
                }
            }
    }
};
struct EpiWin {
    static constexpr bool PERM = true, AFTER_DRAIN = false;
    bf16_t *YG, *XR; const float* bin;
    __device__ __forceinline__ void operator()(const pf4 (&acc)[2][2][4][2], const pg8::Unit& u, int wr, int wc, int fr, int fq) const {
        const bool yb = u.pn < 4; bf16_t* base = yb ? YG : XR;
        const int row0 = u.pm * 256 + wr * 64 + fr, colg = u.pn * 256 + wc * 32 + 8 * fq, col0 = (u.pn & 3) * 256 + wc * 32 + 8 * fq;
        pf4 bv[2][2];
#pragma unroll
        for (int bj = 0; bj < 2; ++bj)
#pragma unroll
            for (int n = 0; n < 2; ++n) bv[bj][n] = *(const pf4*)(bin + colg + bj * 128 + 4 * n);
#pragma unroll
        for (int ai = 0; ai < 2; ++ai)
#pragma unroll
            for (int m = 0; m < 4; ++m) {
                const int row = row0 + ai * 128 + m * 16;
#pragma unroll
                for (int bj = 0; bj < 2; ++bj) {
                    pf4 v0 = acc[ai][bj][m][0] + bv[bj][0], v1 = acc[ai][bj][m][1] + bv[bj][1];
                    if (yb) {
#pragma unroll
                        for (int j = 0; j < 4; ++j) {
                            { const float x = v0[j], uu = 0.7978845608028654f * (x + 0.044715f * x * x * x); v0[j] = x * __builtin_amdgcn_rcpf(1.0f + fast_exp(-2.0f * uu)); }
                            { const float x = v1[j], uu = 0.7978845608028654f * (x + 0.044715f * x * x * x); v1[j] = x * __builtin_amdgcn_rcpf(1.0f + fast_exp(-2.0f * uu)); }
                        }
                    }
                    u32x4 w; w.x = pk2(v0[0], v0[1]); w.y = pk2(v0[2], v0[3]); w.z = pk2(v1[0], v1[1]); w.w = pk2(v1[2], v1[3]);
                    *(u32x4*)(base + (size_t)row * D + col0 + bj * 128) = w;
                }
            }
    }
};

#ifndef DENSE_ALIGN
#define DENSE_ALIGN true
#endif
#ifndef DENSE_SP2
#define DENSE_SP2 true
#endif
#define PG8_RUN(EPI, SCHED, g, S, E) pg8::gemm_phase<EPI, SCHED, DENSE_ALIGN, DENSE_SP2>((PG8_LAS unsigned char*)lds, g, S, E)

__device__ __forceinline__ void ph_qkv_fast(const Ctx& a, LAS unsigned char* lds) {
    unsigned char* ws = a.ws();
    pg8::Gemm g{(const bf16_t*)(ws + WS_XN), (const bf16_t*)(ws + WS_WQKV), RT, 3 * D, D};
    const int Gq = gemm_groups(72 * 12, (int)gridDim.x);
    if ((int)blockIdx.x >= Gq) { cvt8_run(a, 0, CV0_QKV + ((int)blockIdx.x - Gq), (int)gridDim.x - Gq, CV0_QKV + CVQ_QKV, lds); return; }
    ListOrder<MapGrid> S{72 * 12, Gq, (int)blockIdx.x, MapGrid{12}};
    static_assert(WS_V - WS_K == WS_K - WS_Q, "Q|K|V spacing");
    LAS float* rl = (LAS float*)(lds + ROPE_LDS);
    { const float* rg = (const float*)(ws + WS_ROPE); for (int i = threadIdx.x; i < 2048; i += NTHREADS) rl[i] = rg[i]; }
    __syncthreads();
    EpiQKV E{(bf16_t*)(ws + WS_Q), rl};
    PG8_RUN(EpiQKV, ListOrder<MapGrid>, g, S, E);
    if (Gq == (int)gridDim.x) cvt8_tail(a, lds, 72 * 12, Gq, (int)blockIdx.x, 0, CV0_QKV, CVQ_QKV);
}
__device__ __forceinline__ void ph_wo_fast(const Ctx& a, LAS unsigned char* lds) {
    unsigned char* ws = a.ws();
    pg8::Gemm g{(const bf16_t*)(ws + WS_ATT), (const bf16_t*)(ws + WS_WO), RT, D, D};
    const int Gq = gemm_groups(72 * 4, (int)gridDim.x);
    if ((int)blockIdx.x >= Gq) { cvt8_run(a, 0, CV0_WO + ((int)blockIdx.x - Gq), (int)gridDim.x - Gq, CV0_WO + CVQ_WO, lds); return; }
    ListOrder<MapGrid> S{72 * 4, Gq, (int)blockIdx.x, MapGrid{4}};
    EpiResid E{(bf16_t*)(ws + WS_H), a.in(I_X), a.in(I_CTX), (const float*)(ws + WS_MOD), 0};
    PG8_RUN(EpiResid, ListOrder<MapGrid>, g, S, E);
    if (Gq == (int)gridDim.x) cvt8_tail(a, lds, 72 * 4, Gq, (int)blockIdx.x, 0, CV0_WO, CVQ_WO);
}
__device__ __forceinline__ void ph_wout_fast(const Ctx& a, LAS unsigned char* lds) {
    unsigned char* ws = a.ws();
    pg8::Gemm g{(const bf16_t*)(ws + WS_HS), (const bf16_t*)(ws + WS_WOUT), RL, D, D};
    ListOrder<MapGrid> S{64 * 4, (int)gridDim.x, (int)blockIdx.x, MapGrid{4}};
    EpiResid E{(bf16_t*)(ws + WS_H), nullptr, nullptr, (const float*)(ws + WS_MOD), 1};
    PG8_RUN(EpiResid, ListOrder<MapGrid>, g, S, E);
}
#if FP8_MOE
struct EpiSwiGLU8 {
    static constexpr bool PERM = true, AFTER_DRAIN = false;
    unsigned char* ACT;
    __device__ __forceinline__ void operator()(const pf4 (&acc)[2][2][4][2], const pg8::Unit& u, int wr, int wc, int fr, int fq) const {
        const int ct = u.pn % 22;
        unsigned char* p0 = ACT + (size_t)(u.pm * 256 + wr * 64 + fr) * DE + ct * 128 + wc * 32 + 8 * fq;
#pragma unroll
        for (int ai = 0; ai < 2; ++ai)
#pragma unroll
            for (int m = 0; m < 4; ++m) {
                float o[8];
#pragma unroll
                for (int n = 0; n < 2; ++n)
#pragma unroll
                    for (int j = 0; j < 4; ++j) { const float g = acc[ai][0][m][n][j], uu = acc[ai][1][m][n][j]; o[n * 4 + j] = g * __builtin_amdgcn_rcpf(1.0f + fast_exp(-g)) * uu; }
                u32x2 w; w.x = pk4_fp8(o[0], o[1], o[2], o[3]); w.y = pk4_fp8(o[4], o[5], o[6], o[7]);
                *(u32x2*)(p0 + (size_t)(ai * 128 + m * 16) * DE) = w;
            }
    }
};
__device__ __forceinline__ void ph_gu_fast(const Ctx& a, LAS unsigned char* lds, int layer) {
    unsigned char* ws = a.ws(); const int PM = (layer == 0 ? RPE0 : RPE1) / 256;
    pg8::Gemm g{(const bf16_t*)(ws + WS_XG), (const bf16_t*)(ws + WS_WGU + (size_t)layer * (WGU_LAYER / 2)), NE * PM * 256, NE * 2 * DE, D / 2};
    ListOrder<MapMoe> S{NE * PM * 22, (int)gridDim.x, (int)blockIdx.x, MapMoe{PM, 22}};
    EpiSwiGLU8 E{ws + WS_ACT};
    pg8::gemm_phase<EpiSwiGLU8, ListOrder<MapMoe>, GU_ALIGN, true, 122>((PG8_LAS unsigned char*)lds, g, S, E);
    if (layer == 0) cvt8_tail(a, lds, NE * PM * 22, (int)gridDim.x, (int)blockIdx.x, 1, CV1_GU0, CVQ_GU0);
}
__device__ __forceinline__ void ph_dn_fast(const Ctx& a, LAS unsigned char* lds, int layer) {
    unsigned char* ws = a.ws(); const int PM = (layer == 0 ? RPE0 : RPE1) / 256;
    pg8::Gemm g{(const bf16_t*)(ws + WS_ACT), (const bf16_t*)(ws + WS_WDN + (size_t)layer * (WDN_LAYER / 2)), NE * PM * 256, NE * D, DE / 2};
    const int Gq = layer == 0 ? gemm_groups(NE * PM * 4, (int)gridDim.x) : (int)gridDim.x;
    if ((int)blockIdx.x >= Gq) { cvt8_run(a, 1, CV1_DN0 + ((int)blockIdx.x - Gq), (int)gridDim.x - Gq, CV1_DN0 + CVQ_DN0, lds); return; }
    ListOrder<MapMoe> S{NE * PM * 4, Gq, (int)blockIdx.x, MapMoe{PM, 4}};
    EpiDown E{ws + WS_Y, (const float*)(ws + WS_GATE)};
    pg8::gemm_phase<EpiDown, ListOrder<MapMoe>, DN_ALIGN, true, 121>((PG8_LAS unsigned char*)lds, g, S, E);
    if (layer == 0 && Gq == (int)gridDim.x) cvt8_tail(a, lds, NE * PM * 4, Gq, (int)blockIdx.x, 1, CV1_DN0, CVQ_DN0);
}
#else
__device__ __forceinline__ void ph_gu_fast(const Ctx& a, LAS unsigned char* lds, int layer) {
    unsigned char* ws = a.ws(); const int PM = (layer == 0 ? RPE0 : RPE1) / 256;
    pg8::Gemm g{(const bf16_t*)(ws + WS_XG), (const bf16_t*)(ws + WS_WGU + (size_t)layer * WGU_LAYER), NE * PM * 256, NE * 2 * DE, D};
    ListOrder<MapMoe> S{NE * PM * 22, (int)gridDim.x, (int)blockIdx.x, MapMoe{PM, 22}};
    EpiSwiGLU E{(bf16_t*)(ws + WS_ACT)};
    PG8_RUN(EpiSwiGLU, ListOrder<MapMoe>, g, S, E);
}
__device__ __forceinline__ void ph_dn_fast(const Ctx& a, LAS unsigned char* lds, int layer) {
    unsigned char* ws = a.ws(); const int PM = (layer == 0 ? RPE0 : RPE1) / 256;
    pg8::Gemm g{(const bf16_t*)(ws + WS_ACT), (const bf16_t*)(ws + WS_WDN + (size_t)layer * WDN_LAYER), NE * PM * 256, NE * D, DE};
    const int Gq = layer == 0 ? gemm_groups(NE * PM * 4, (int)gridDim.x) : (int)gridDim.x;
    if ((int)blockIdx.x >= Gq) { cvt8_run(a, 1, CV1_DN0 + ((int)blockIdx.x - Gq), (int)gridDim.x - Gq, CV1_DN0 + CVQ_DN0, lds); return; }
    ListOrder<MapMoe> S{NE * PM * 4, Gq, (int)blockIdx.x, MapMoe{PM, 4}};
    EpiDown E{ws + WS_Y, (const float*)(ws + WS_GATE)};
    PG8_RUN(EpiDown, ListOrder<MapMoe>, g, S, E);
}
#endif
__device__ __forceinline__ void ph_win_fast(const Ctx& a, LAS unsigned char* lds) {
    unsigned char* ws = a.ws();
    pg8::Gemm g{(const bf16_t*)(ws + WS_XN), (const bf16_t*)(ws + WS_WIN), RT, 2 * D, D};
    const int Gq = gemm_groups(512 + 32, (int)gridDim.x);
    if ((int)blockIdx.x >= Gq) { cvt8_run(a, 1, CV1_WIN + ((int)blockIdx.x - Gq), (int)gridDim.x - Gq, CV1_WIN + CVQ_WIN, lds); return; }
    ListOrder<MapWin> S{512 + 32, Gq, (int)blockIdx.x, MapWin{}};
    EpiWin E{(bf16_t*)(ws + WS_YG), (bf16_t*)(ws + WS_XR), a.in(I_BIN)};
    PG8_RUN(EpiWin, ListOrder<MapWin>, g, S, E);
    if (Gq == (int)gridDim.x) cvt8_tail(a, lds, 512 + 32, Gq, (int)blockIdx.x, 1, CV1_WIN, CVQ_WIN);
}

namespace fa {
using bf16x8 = __attribute__((ext_vector_type(8))) short;
using s16x4  = __attribute__((ext_vector_type(4))) short;
using f32x16 = __attribute__((ext_vector_type(16))) float;
using u32x4v = __attribute__((ext_vector_type(4))) unsigned;
constexpr int SHM_V = 64 * 128 * 2, SHM_K = 64 * 128 * 2;
constexpr float THR_L2 = 11.5f;
#define KSWZ(row, colB) ((row) * 256 + ((colB) ^ (((row) & 7) << 4)))
#define SBAR() __builtin_amdgcn_sched_barrier(0)
__device__ __forceinline__ int crow(int r, int hi) { return (r & 3) + 8 * (r >> 2) + 4 * hi; }
__device__ __forceinline__ unsigned cvtpk(float lo, float hi) { unsigned r; asm volatile("v_cvt_pk_bf16_f32 %0, %1, %2" : "=v"(r) : "v"(lo), "v"(hi)); return r; }
__device__ __forceinline__ void partialSM(f32x16& p0, f32x16& p1, float& m_reg, float& mn, float& alpha) {
  float pmax = p0[0];
#pragma unroll
  for (int r = 1; r < 16; ++r) pmax = fmaxf(pmax, p0[r]);
#pragma unroll
  for (int r = 0; r < 16; ++r) pmax = fmaxf(pmax, p1[r]);
  { auto rr = __builtin_amdgcn_permlane32_swap(__float_as_uint(pmax), __float_as_uint(pmax), false, false);
    pmax = fmaxf(__uint_as_float(rr[0]), __uint_as_float(rr[1])); }
  if (__builtin_expect(__all(pmax - m_reg <= THR_L2), 1)) { mn = m_reg; alpha = 1.f; }
  else { mn = fmaxf(m_reg, pmax); alpha = __builtin_amdgcn_exp2f(m_reg - mn); m_reg = mn; }
  { typedef float f2_t __attribute__((ext_vector_type(2))); const f2_t mn2 = {mn, mn};
#pragma unroll
    for (int r = 0; r < 16; r += 2) { const f2_t a_ = (f2_t){p0[r], p0[r + 1]} - mn2; p0[r] = a_.x; p0[r + 1] = a_.y; const f2_t b_ = (f2_t){p1[r], p1[r + 1]} - mn2; p1[r] = b_.x; p1[r + 1] = b_.y; } }
#pragma unroll
  for (int r = 0; r < 16; ++r) p0[r] = __builtin_amdgcn_exp2f(p0[r]);
}
__device__ __forceinline__ void finishSM(f32x16& p0, f32x16& p1, float alpha, float& l_reg, bf16x8& pa0, bf16x8& pa1, bf16x8& pa2, bf16x8& pa3) {
#pragma unroll
  for (int r = 0; r < 16; ++r) p1[r] = __builtin_amdgcn_exp2f(p1[r]);
  float ps = 0;
#pragma unroll
  for (int r = 0; r < 16; ++r) ps += p0[r];
#pragma unroll
  for (int r = 0; r < 16; ++r) ps += p1[r];
  { auto rr = __builtin_amdgcn_permlane32_swap(__float_as_uint(ps), __float_as_uint(ps), false, false);
    ps = __uint_as_float(rr[0]) + __uint_as_float(rr[1]); }
  l_reg = l_reg * alpha + ps;
#define PK4(P, BASE, OUT) do { unsigned a0 = cvtpk(P[BASE + 0], P[BASE + 1]), a1 = cvtpk(P[BASE + 2], P[BASE + 3]);   \
    unsigned b0 = cvtpk(P[BASE + 4], P[BASE + 5]), b1 = cvtpk(P[BASE + 6], P[BASE + 7]);                              \
    auto r0 = __builtin_amdgcn_permlane32_swap(a0, b0, false, false); auto r1 = __builtin_amdgcn_permlane32_swap(a1, b1, false, false); \
    u32x4v w = {r0[0], r1[0], r0[1], r1[1]}; OUT = *reinterpret_cast<bf16x8*>(&w); } while (0)
  PK4(p0, 0, pa0); PK4(p0, 8, pa1); PK4(p1, 0, pa2); PK4(p1, 8, pa3);
#undef PK4
}
__device__ __forceinline__ void qkt(f32x16& p0, f32x16& p1, const LAS char* Ks, const bf16x8* qr, int r32, int hi, int s) {
  p0 = f32x16{}; p1 = f32x16{};
#pragma unroll
  for (int d0 = 0; d0 < 4; ++d0) { const int cb = (s * 64 + d0 * 16 + hi * 8) * 2;
    const bf16x8 b0 = *reinterpret_cast<const LAS bf16x8*>(Ks + KSWZ(r32, cb));
    const bf16x8 b1 = *reinterpret_cast<const LAS bf16x8*>(Ks + KSWZ(32 + r32, cb));
    p0 = __builtin_amdgcn_mfma_f32_32x32x16_bf16(b0, qr[d0], p0, 0, 0, 0);
    p1 = __builtin_amdgcn_mfma_f32_32x32x16_bf16(b1, qr[d0], p1, 0, 0, 0); }
}
__device__ __forceinline__ int v_st(int k, int c) { const int kk = (k & ~0xC) | ((k & 4) << 1) | ((k & 8) >> 1); return ((kk >> 3) * 4 + (c >> 5)) * 512 + ((kk & 7) * 32 + (c & 31)) * 2; }
__device__ __forceinline__ int v_rd_base(int lane) { return ((lane & 3) << 3) | (((lane >> 2) & 3) << 6) | (((lane >> 4) & 1) << 5) | (((lane >> 5) & 1) << 8); }
constexpr int v_rd_off(int d0, int ks, int half) { return d0 * 512 + ks * 4096 + half * 2048; }
template <int OFF> __device__ __forceinline__ s16x4 tr_read(int vb) {
  s16x4 r; asm volatile("ds_read_b64_tr_b16 %0, %1 offset:%2" : "=&v"(r) : "v"(vb), "i"(OFF) : "memory"); return r;
}
template <int D0> __device__ __forceinline__ void pv_one(f32x16& od, int vb, bf16x8 pa0, bf16x8 pa1, bf16x8 pa2, bf16x8 pa3) {
  const s16x4 l0 = tr_read<v_rd_off(D0, 0, 0)>(vb), h0 = tr_read<v_rd_off(D0, 0, 1)>(vb), l1 = tr_read<v_rd_off(D0, 1, 0)>(vb), h1 = tr_read<v_rd_off(D0, 1, 1)>(vb);
  const s16x4 l2 = tr_read<v_rd_off(D0, 2, 0)>(vb), h2 = tr_read<v_rd_off(D0, 2, 1)>(vb), l3 = tr_read<v_rd_off(D0, 3, 0)>(vb), h3 = tr_read<v_rd_off(D0, 3, 1)>(vb);
  asm volatile("s_waitcnt lgkmcnt(0)" ::: "memory"); SBAR();
#define PK(L, H) (bf16x8){L[0], L[1], L[2], L[3], H[0], H[1], H[2], H[3]}
  od = __builtin_amdgcn_mfma_f32_32x32x16_bf16(pa0, PK(l0, h0), od, 0, 0, 0);
  od = __builtin_amdgcn_mfma_f32_32x32x16_bf16(pa1, PK(l1, h1), od, 0, 0, 0);
  od = __builtin_amdgcn_mfma_f32_32x32x16_bf16(pa2, PK(l2, h2), od, 0, 0, 0);
  od = __builtin_amdgcn_mfma_f32_32x32x16_bf16(pa3, PK(l3, h3), od, 0, 0, 0);
#undef PK
}
__device__ __forceinline__ void pv_d0(f32x16* o, int vb, bf16x8 pa0, bf16x8 pa1, bf16x8 pa2, bf16x8 pa3) {
  pv_one<0>(o[0], vb, pa0, pa1, pa2, pa3); pv_one<1>(o[1], vb, pa0, pa1, pa2, pa3); pv_one<2>(o[2], vb, pa0, pa1, pa2, pa3); pv_one<3>(o[3], vb, pa0, pa1, pa2, pa3);
}

__device__ __forceinline__ int tile_row(bool latq, int b, int j) { return latq ? (j < 32 ? b * SEQ + 64 * j : RL + b * CTXL + 64 * (j - 32)) : RL + b * CTXL + 64 * j; }

__device__ __forceinline__ void attn_unit(const bf16_t* __restrict__ Qg, const bf16_t* __restrict__ Kg, const bf16_t* __restrict__ Vg, bf16_t* __restrict__ ATT,
                                          const float* subg, float lam, bool latq, int b, int h, int qrow0, LAS unsigned char* lds) {
  const int tid = threadIdx.x, wid = __builtin_amdgcn_readfirstlane(tid >> 6), lane = tid & 63, r32 = lane & 31, hi = lane >> 5, rg = wid >> 1, s = wid & 1;
  LAS char* V_lds = (LAS char*)lds; LAS char* K_lds = (LAS char*)lds + 2 * SHM_V;
  LAS float* ws = (LAS float*)(lds + 65536) + wid * 64; LAS float* li_l = ws; LAS float* al_l = ws + 32;
  const int NT = latq ? 36 : 4;
  float m_reg = -1e30f, l_reg = 0; f32x16 o[4] = {}; bf16x8 qr[4];
  const bf16_t* Qw = Qg + (size_t)(qrow0 + rg * 32 + r32) * D + h * 128 + s * 64 + hi * 8;
#pragma unroll
  for (int d0 = 0; d0 < 4; ++d0) qr[d0] = *reinterpret_cast<const bf16x8*>(Qw + d0 * 16);
  const int sr = tid >> 4, sc = (tid & 15) * 8, vst0 = v_st(sr, sc), vst1 = v_st(32 + sr, sc);
  const int vb0 = (int)(unsigned)(size_t)V_lds + v_rd_base(lane);
  const size_t hoff = (size_t)h * 128 + sc;
  struct { bf16x8 vs0, vs1, ks0, ks1; } sr_[2];
#define SLOAD(i, j) do { const size_t ro_ = (size_t)(tile_row(latq, b, (j)) + sr) * D + hoff; \
    sr_[i].vs0 = *reinterpret_cast<const bf16x8*>(Vg + ro_); sr_[i].vs1 = *reinterpret_cast<const bf16x8*>(Vg + ro_ + 32 * D); \
    sr_[i].ks0 = *reinterpret_cast<const bf16x8*>(Kg + ro_); sr_[i].ks1 = *reinterpret_cast<const bf16x8*>(Kg + ro_ + 32 * D); } while (0)
#define SWRITE(bb, i) do { *(LAS bf16x8*)(V_lds + (bb) * SHM_V + vst0) = sr_[i].vs0; *(LAS bf16x8*)(V_lds + (bb) * SHM_V + vst1) = sr_[i].vs1; const int kc = sc * 2; \
    *(LAS bf16x8*)(K_lds + (bb) * SHM_K + KSWZ(sr, kc)) = sr_[i].ks0; *(LAS bf16x8*)(K_lds + (bb) * SHM_K + KSWZ(32 + sr, kc)) = sr_[i].ks1; } while (0)
#define SWAIT() asm volatile("s_waitcnt vmcnt(4)" ::: "memory")
#define RESC(a_) do { if (__any((a_) < 1.f)) { if (hi == 0) al_l[r32] = (a_); asm volatile("s_waitcnt lgkmcnt(0)" ::: "memory"); \
    _Pragma("unroll") for (int d = 0; d < 4; ++d) _Pragma("unroll") for (int r = 0; r < 16; ++r) o[d][r] *= al_l[crow(r, hi)]; } } while (0)
  f32x16 pA0, pA1, pB0, pB1; float mnA, mnB, alA, alB; bf16x8 pa0, pa1, pa2, pa3;
  constexpr int SE = 0, SO = 1;
  SLOAD(SE, 0); asm volatile("s_waitcnt vmcnt(0)" ::: "memory"); SWRITE(0, SE); __syncthreads();
  qkt(pA0, pA1, K_lds, qr, r32, hi, s); partialSM(pA0, pA1, m_reg, mnA, alA);
  SLOAD(SO, 1); if (2 < NT) SLOAD(SE, 2);
  SWAIT(); SWRITE(1, SO); __syncthreads();
  for (int j = 1; j + 1 < NT; j += 2) {
    SBAR(); qkt(pB0, pB1, K_lds + SHM_K, qr, r32, hi, s);
    finishSM(pA0, pA1, alA, l_reg, pa0, pa1, pa2, pa3); SBAR();
    SLOAD(SO, j + 2); SBAR();
    pv_d0(o, vb0, pa0, pa1, pa2, pa3); partialSM(pB0, pB1, m_reg, mnB, alB);
    __syncthreads(); SWAIT(); SWRITE(0, SE);
    RESC(alB); __syncthreads();
    SBAR(); qkt(pA0, pA1, K_lds, qr, r32, hi, s);
    finishSM(pB0, pB1, alB, l_reg, pa0, pa1, pa2, pa3); SBAR();
    if (j + 3 < NT) SLOAD(SE, j + 3); SBAR();
    pv_d0(o, vb0 + SHM_V, pa0, pa1, pa2, pa3); partialSM(pA0, pA1, m_reg, mnA, alA);
    __syncthreads(); SWAIT(); SWRITE(1, SO);
    RESC(alA); __syncthreads();
  }
  SBAR(); qkt(pB0, pB1, K_lds + SHM_K, qr, r32, hi, s);
  finishSM(pA0, pA1, alA, l_reg, pa0, pa1, pa2, pa3); SBAR();
  pv_d0(o, vb0, pa0, pa1, pa2, pa3); partialSM(pB0, pB1, m_reg, mnB, alB);
  __syncthreads(); RESC(alB);
  finishSM(pB0, pB1, alB, l_reg, pa0, pa1, pa2, pa3); SBAR();
  pv_d0(o, vb0 + SHM_V, pa0, pa1, pa2, pa3);
#undef SLOAD
#undef SWRITE
#undef SWAIT
#undef RESC
  if (hi == 0) li_l[r32] = l_reg;
  asm volatile("s_waitcnt lgkmcnt(0)" ::: "memory");
  float rli[16];
#pragma unroll
  for (int r = 0; r < 16; ++r) rli[r] = __builtin_amdgcn_rcpf(li_l[crow(r, hi)]);
  __syncthreads();
  LAS float* X = (LAS float*)lds + rg * 4096;
  if (s == 1) {
#pragma unroll
    for (int r = 0; r < 16; ++r)
#pragma unroll
      for (int d0 = 0; d0 < 4; ++d0) X[crow(r, hi) * 128 + d0 * 32 + r32] = o[d0][r] * (rli[r] * lam);
  }
  __syncthreads();
  if (s == 0) {
    float rstd[16];
#pragma unroll
    for (int r = 0; r < 16; ++r) {
      float acc = 0.f;
#pragma unroll
      for (int d0 = 0; d0 < 4; ++d0) { const float v = o[d0][r] * rli[r] - X[crow(r, hi) * 128 + d0 * 32 + r32]; o[d0][r] = v; acc += v * v; }
#pragma unroll
      for (int off = 1; off < 32; off <<= 1) acc += __shfl_xor(acc, off);
      rstd[r] = 1.0f / sqrtf(acc * (1.0f / 128.0f) + EPS);
    }
    LAS bf16_t* stg = (LAS bf16_t*)(lds + 65536 + 2048) + rg * 4096;
    float gsc[4];
#pragma unroll
    for (int d0 = 0; d0 < 4; ++d0) gsc[d0] = subg[d0 * 32 + r32] * (1.0f - LAMBDA_INIT0);
#pragma unroll
    for (int r = 0; r < 16; ++r)
#pragma unroll
      for (int d0 = 0; d0 < 4; ++d0) stg[crow(r, hi) * 128 + d0 * 32 + r32] = (bf16_t)f2bf(o[d0][r] * rstd[r] * gsc[d0]);
    asm volatile("s_waitcnt lgkmcnt(0)" ::: "memory");
    bf16_t* Ow = ATT + (size_t)(qrow0 + rg * 32) * D + h * 128;
#pragma unroll
    for (int i = 0; i < 8; ++i) { const int row = i * 4 + (lane >> 4), ch = lane & 15; const u32x4v v = *(const LAS u32x4v*)(stg + row * 128 + ch * 8); *(u32x4v*)(Ow + (size_t)row * D + ch * 8) = v; }
  }
  __syncthreads();
}
#undef KSWZ
#undef SBAR
}

__device__ __forceinline__ void ph_attn_fast(const Ctx& a, LAS unsigned char* lds) {
    unsigned char* ws = a.ws();
    const bf16_t* Q = (const bf16_t*)(ws + WS_Q); const bf16_t* Kb = (const bf16_t*)(ws + WS_K); const bf16_t* V = (const bf16_t*)(ws + WS_V);
    bf16_t* ATT = (bf16_t*)(ws + WS_ATT); const float* subg = a.in(I_SUBG);
    const float lam = diff_lambda(a, threadIdx.x & 63);
    const int G = gridDim.x, c = blockIdx.x;
    for (int i = 0;; ++i) {
        const long L = (long)i * G + c; if (L >= 1024) break;
        const int w = xcd_remap(L, 1024), bh = w >> 4, qb = w & 15, b = bh >> 3, h = bh & 7;
        fa::attn_unit(Q, Kb, V, ATT, subg, lam, true, b, h, b * SEQ + qb * 128, lds);
    }
    for (int L = c; L < 128; L += G) {
        const int bh = L >> 1, qb = L & 1, b = bh >> 3, h = bh & 7;
        fa::attn_unit(Q, Kb, V, ATT, subg, lam, false, b, h, RL + b * CTXL + qb * 128, lds);
    }
}


__device__ __forceinline__ void ph_gates_fast(const Ctx& a, LAS unsigned char* lds) {
    unsigned char* ws = a.ws();
    const bf16_t* XR = (const bf16_t*)(ws + WS_XR); const bf16_t* WG = (const bf16_t*)(ws + WS_WG);
    bf16_t* LOGA = (bf16_t*)(ws + WS_LOGA); unsigned char* BT = ws + WS_BT;
    const float* convw = a.in(I_CONVW); const float* convb = a.in(I_CONVB); const float* gtab = (const float*)(ws + WS_GTAB);
    const int tid = threadIdx.x, wid = __builtin_amdgcn_readfirstlane(tid >> 6), lane = tid & 63, wr = wid >> 2, wc = wid & 3, fr = lane & 15, fq = lane >> 4;
    constexpr int HTB = pg8::HTB;
    const int aoff = pg8::lds_byte(wr * 64 + fr, fq * 8), boff = pg8::lds_byte(wc * 32 + fr, fq * 8);
    const int sc = tid & 15, rg8 = tid >> 4;
    unsigned bsrc[2];
#pragma unroll
    for (int i = 0; i < 2; ++i) { int R, C; pg8::stage_rc(tid * 16 + i * 8192, R, C); bsrc[i] = (unsigned)(((R & ~31) + pg8::perm32(R & 31)) * 128 + C) * 2u; }
    const unsigned ldsw = (unsigned)wid * 1024u;
#define GT_DMA_B(d_) do { const char* wb_ = (const char*)(WG + (size_t)((d_) * 8 + kb) * 256 * 128); \
        _Pragma("unroll") for (int kt_ = 0; kt_ < 2; ++kt_) _Pragma("unroll") for (int h_ = 0; h_ < 2; ++h_) _Pragma("unroll") for (int i_ = 0; i_ < 2; ++i_) \
            __builtin_amdgcn_global_load_lds((const unsigned*)(wb_ + (size_t)h_ * 128 * 256 + kt_ * 128 + bsrc[i_]), (LAS unsigned*)(lds + (4 + kt_ * 2 + h_) * HTB + ldsw + i_ * 8192), 16, 0, 0); } while (0)
    const int Gq = gemm_groups(72 * 8, (int)gridDim.x);
    if ((int)blockIdx.x >= Gq) { cvt8_run(a, 1, CV1_GATES + ((int)blockIdx.x - Gq), (int)gridDim.x - Gq, CV1_GATES + CVQ_GATES, lds); return; }
    for (int u = blockIdx.x; u < 72 * 8; u += Gq) {
        const int kb = u & 7, rt = u >> 3;
        const bool lat = rt < 64; const int bsm = lat ? (rt >> 3) : (rt - 64), t0 = lat ? (rt & 7) * 256 : 0, L = lat ? SEQ : CTXL;
        const int seqbase = lat ? bsm * SEQ : RL + bsm * CTXL;
        GT_DMA_B(0);
        {
            const int ch0 = kb * 128 + sc * 8, r0 = rg8 * 8;
            u32x4 xin[11];
#pragma unroll
            for (int i = 0; i < 11; ++i) { const int tt = t0 + r0 - 2 + i; xin[i] = (tt >= 0 && tt < L) ? *(const u32x4*)(XR + (size_t)(seqbase + tt) * D + ch0) : (u32x4){0u, 0u, 0u, 0u}; }
            f32x4 cw[4][2], cb[2];
#pragma unroll
            for (int j = 0; j < 4; ++j) { cw[j][0] = *(const f32x4*)(convw + j * D + ch0); cw[j][1] = *(const f32x4*)(convw + j * D + ch0 + 4); }
            cb[0] = *(const f32x4*)(convb + ch0); cb[1] = *(const f32x4*)(convb + ch0 + 4);
#pragma unroll
            for (int k = 0; k < 8; ++k) {
                f32x4 o0 = cb[0], o1 = cb[1];
#pragma unroll
                for (int j = 0; j < 4; ++j) { const u32x4 x = xin[k + j];
                    o0 += cw[j][0] * (f32x4){bf_lo(x.x), bf_hi(x.x), bf_lo(x.y), bf_hi(x.y)}; o1 += cw[j][1] * (f32x4){bf_lo(x.z), bf_hi(x.z), bf_lo(x.w), bf_hi(x.w)}; }
                const int r = r0 + k;
                u32x4 w; w.x = pk2(o0[0], o0[1]); w.y = pk2(o0[2], o0[3]); w.z = pk2(o1[0], o1[1]); w.w = pk2(o1[2], o1[3]);
                *(LAS u32x4*)(lds + ((sc >> 3) * 2 + (r >> 7)) * HTB + pg8::lds_byte(r & 127, (sc & 7) * 8)) = w;
            }
        }
#pragma unroll 1
        for (int d = 0; d < 2; ++d) {
            asm volatile("s_waitcnt vmcnt(0)" ::: "memory");
            __syncthreads();
            pf4 acc[2][2][4][2];
#pragma unroll
            for (int ai = 0; ai < 2; ++ai)
#pragma unroll
                for (int bj = 0; bj < 2; ++bj)
#pragma unroll
                    for (int m = 0; m < 4; ++m)
#pragma unroll
                        for (int n = 0; n < 2; ++n) acc[ai][bj][m][n] = (pf4){0.f, 0.f, 0.f, 0.f};
#pragma unroll 1
            for (int kt = 0; kt < 2; ++kt)
#pragma unroll
                for (int ai = 0; ai < 2; ++ai) {
                    __builtin_amdgcn_sched_barrier(0);
                    pg8::bf16x8 At[4][2];
#pragma unroll
                    for (int m = 0; m < 4; ++m)
#pragma unroll
                        for (int k = 0; k < 2; ++k) At[m][k] = *(const LAS pg8::bf16x8*)(lds + (kt * 2 + ai) * HTB + aoff + m * 2048 + k * 1024);
#pragma unroll
                    for (int bj = 0; bj < 2; ++bj) {
                        pg8::bf16x8 Bf[2][2];
#pragma unroll
                        for (int n = 0; n < 2; ++n)
#pragma unroll
                            for (int k = 0; k < 2; ++k) Bf[n][k] = *(const LAS pg8::bf16x8*)(lds + (4 + kt * 2 + bj) * HTB + boff + n * 2048 + k * 1024);
#pragma unroll
                        for (int m = 0; m < 4; ++m)
#pragma unroll
                            for (int n = 0; n < 2; ++n)
#pragma unroll
                                for (int k = 0; k < 2; ++k) acc[ai][bj][m][n] = __builtin_amdgcn_mfma_f32_16x16x32_bf16(Bf[n][k], At[m][k], acc[ai][bj][m][n], 0, 0, 0);
                        __builtin_amdgcn_sched_barrier(0);
                    }
                }
            if (d == 0) { __syncthreads(); GT_DMA_B(1); }
            const int cc0 = wc * 32 + fq * 8;
            pf4 cl[2], c2[2], brn[2], bin[2];
#pragma unroll
            for (int n = 0; n < 2; ++n) { const float* g = gtab + (size_t)(d * 4) * D + kb * 128 + cc0 + 4 * n;
                cl[n] = *(const pf4*)g; c2[n] = *(const pf4*)(g + D); brn[n] = *(const pf4*)(g + 2 * D); bin[n] = *(const pf4*)(g + 3 * D); }
#pragma unroll
            for (int ai = 0; ai < 2; ++ai)
#pragma unroll
                for (int m = 0; m < 4; ++m) {
                    const int rl = wr * 64 + m * 16 + fr;
                    const int grow = seqbase + t0 + ai * 128 + rl;
                    float la[8], bt[8];
#pragma unroll
                    for (int n = 0; n < 2; ++n) {
                        const int cc = cc0 + 4 * n;
                        const u32x2 xw = *(const LAS u32x2*)(lds + ((cc >> 6) * 2 + ai) * HTB + pg8::lds_byte(rl, cc & 63));
                        const float xv[4] = {bf_lo(xw.x), bf_hi(xw.x), bf_lo(xw.y), bf_hi(xw.y)};
#pragma unroll
                        for (int j = 0; j < 4; ++j) {
                            const float r = __builtin_amdgcn_rcpf(1.0f + __builtin_amdgcn_exp2f(fmaf(acc[ai][0][m][n][j], -1.4426950408889634f, brn[n][j])));
                            const float ig = __builtin_amdgcn_rcpf(1.0f + __builtin_amdgcn_exp2f(fmaf(acc[ai][1][m][n][j], -1.4426950408889634f, bin[n][j])));
                            const float om = 1.0f - __builtin_amdgcn_exp2f(r * c2[n][j]);
                            la[n * 4 + j] = r * cl[n][j]; bt[n * 4 + j] = __builtin_amdgcn_sqrtf(om) * (ig * xv[j]) * BT_SCALE;
                        }
                    }
                    const size_t o = ((size_t)d * RT + grow) * D + kb * 128 + cc0;
                    u32x4 w; w.x = pk2(la[0], la[1]); w.y = pk2(la[2], la[3]); w.z = pk2(la[4], la[5]); w.w = pk2(la[6], la[7]);
                    *(u32x4*)(LOGA + o) = w;
                    u32x2 wb; wb.x = pk4_fp8(bt[0], bt[1], bt[2], bt[3]); wb.y = pk4_fp8(bt[4], bt[5], bt[6], bt[7]);
                    *(u32x2*)(BT + o) = wb;
                }
        }
        __syncthreads();
    }
#undef GT_DMA_B
    if (Gq == (int)gridDim.x) cvt8_tail(a, lds, 72 * 8, Gq, (int)blockIdx.x, 1, CV1_GATES, CVQ_GATES);
}

constexpr int NPHASES = 25;
__host__ __device__ constexpr bool phase_enabled(int p) {
    return !((p == 3 && FAST_QKV) || (p == 9 && FAST_GU) || (p == 22 && FAST_GU) || (p == 13 && FAST_GATES) || (p == 15 && FAST_GATES));
}

__global__ void __launch_bounds__(NTHREADS, 2) hybrid_fwd(Args args) {
    extern __shared__ __attribute__((aligned(16))) unsigned char lds_raw[];
    LAS unsigned char* lds = (LAS unsigned char*)lds_raw;
    volatile LAS unsigned* MISC = (volatile LAS unsigned*)(lds + MISC_OFF);
    const int lo = args.ph_lo, hi = args.ph_hi;
    if (threadIdx.x == 0) {
        LAS unsigned long long* la64 = (LAS unsigned long long*)(lds + ARGS_OFF);
#pragma unroll
        for (int i = 0; i < 27; ++i) la64[i] = (unsigned long long)args.in[i];
        la64[27] = (unsigned long long)args.out; la64[28] = (unsigned long long)args.ws;
    }
    Ctx ctx; ctx.la = (const LAS unsigned*)(lds + ARGS_OFF);
    if (threadIdx.x < 16) MISC[threadIdx.x] = 0u;
    __syncthreads();
#if MK_ONE_LAUNCH
    XcdBarrier bar = xcd_barrier_post((unsigned*)(ctx.ws() + WS_CTL) + CW_BAR, MISC + 8);
#define GRID_BAR() xcd_barrier(bar)
#else
#define GRID_BAR() do { } while (0)
#endif
#ifndef REP_MASK
#define REP_MASK 0u
#endif
#define RUN(k, call) do { call; if constexpr (((REP_MASK) >> (k)) & 1u) { __syncthreads(); call; } } while (0)
#define IN(k) (lo <= (k) && (k) < hi)
#define SEAM(k) do { if ((k) + 1 < hi) GRID_BAR(); } while (0)

    if (IN(0)) { RUN(0, ph_prologue(ctx, lds)); SEAM(0); }
    if (IN(1)) { RUN(1, ph_norm1_l0(ctx)); SEAM(1); }
    if (IN(2)) {
#if FAST_QKV
        RUN(2, ph_qkv_fast(ctx, lds));
#else
        RUN(2, ph_qkv_naive(ctx, lds));
#endif
        SEAM(2); }
#if !FAST_QKV
    if (IN(3)) { RUN(3, ph_rope_naive(ctx)); SEAM(3); }
#endif
    if (IN(4)) {
#if FAST_ATTN
        RUN(4, ph_attn_fast(ctx, lds));
#else
        RUN(4, ph_attn_naive(ctx, lds));
#endif
        SEAM(4); }
    if (IN(5)) {
#if FAST_WO
        RUN(5, ph_wo_fast(ctx, lds));
#else
        RUN(5, ph_wo_naive(ctx, lds));
#endif
        SEAM(5); }
    if (IN(6)) { RUN(6, ph_norm2_router(ctx, lds, 0, RT)); SEAM(6); }
    if (IN(7)) { RUN(7, ph_topk_gather(ctx, lds, 0)); SEAM(7); }
    if (IN(8)) {
#if FAST_GU
        RUN(8, ph_gu_fast(ctx, lds, 0));
#else
        RUN(8, ph_gu_naive(ctx, lds, 0));
#endif
        SEAM(8); }
#if !FAST_GU
    if (IN(9)) { RUN(9, ph_swiglu_naive(ctx, 0)); SEAM(9); }
#endif
    if (IN(10)) {
#if FAST_DN
        RUN(10, ph_dn_fast(ctx, lds, 0));
#else
        RUN(10, ph_dn_naive(ctx, lds, 0));
#endif
        SEAM(10); }
    if (IN(11)) { RUN(11, ph_combine<0>(ctx, 0, RT)); SEAM(11); }
    if (IN(12)) {
#if FAST_WIN
        RUN(12, ph_win_fast(ctx, lds));
#else
        RUN(12, ph_win_naive(ctx, lds));
#endif
        SEAM(12); }
#if !FAST_GATES
    if (IN(13)) { RUN(13, ph_conv_naive(ctx)); SEAM(13); }
#endif
    if (IN(14)) {
#if FAST_GATES
        RUN(14, ph_gates_fast(ctx, lds));
#else
        RUN(14, ph_gates_naive(ctx, lds));
#endif
        SEAM(14); }
#if !FAST_GATES
    if (IN(15)) { RUN(15, ph_gate_elem_naive(ctx)); SEAM(15); }
#endif
    if (IN(16)) { RUN(16, ph_scan1(ctx)); SEAM(16); }
    if (IN(17)) { RUN(17, ph_scan2(ctx)); SEAM(17); }
    if (IN(18)) {
#if FAST_WOUT
        RUN(18, ph_wout_fast(ctx, lds));
#else
        RUN(18, ph_wout_naive(ctx, lds));
#endif
        SEAM(18); }
    if (IN(19)) { RUN(19, ph_norm2_router(ctx, lds, 1, RL)); SEAM(19); }
    if (IN(20)) { RUN(20, ph_topk_gather(ctx, lds, 1)); SEAM(20); }
    if (IN(21)) {
#if FAST_GU
        RUN(21, ph_gu_fast(ctx, lds, 1));
#else
        RUN(21, ph_gu_naive(ctx, lds, 1));
#endif
        SEAM(21); }
#if !FAST_GU
    if (IN(22)) { RUN(22, ph_swiglu_naive(ctx, 1)); SEAM(22); }
#endif
    if (IN(23)) {
#if FAST_DN
        RUN(23, ph_dn_fast(ctx, lds, 1));
#else
        RUN(23, ph_dn_naive(ctx, lds, 1));
#endif
        SEAM(23); }
    if (IN(24)) { RUN(24, ph_combine<1>(ctx, 1, RL)); }
#undef IN
#undef SEAM
#undef GRID_BAR
}

extern "C" void kernel_launch(void* const* d_in, const int* in_sizes, int n_in, void* d_out, int out_size, void* d_ws, size_t ws_size, hipStream_t stream) {
    static int grid = 0;
    if (grid == 0) {
        if (n_in != 27 || out_size != RL * D || ws_size < WS_END) { fprintf(stderr, "kernel_launch: unexpected shapes (n_in %d out %d ws %zu)\n", n_in, out_size, ws_size); grid = -1; return; }
        int dev = 0, cus = 0, per_cu = 0;
        if (hipGetDevice(&dev) != hipSuccess || hipDeviceGetAttribute(&cus, hipDeviceAttributeMultiprocessorCount, dev) != hipSuccess) { grid = -1; return; }
        if (hipFuncSetAttribute((const void*)hybrid_fwd, hipFuncAttributeMaxDynamicSharedMemorySize, LDS_BYTES) != hipSuccess) { fprintf(stderr, "kernel_launch: hipFuncSetAttribute failed\n"); grid = -1; return; }
        if (hipOccupancyMaxActiveBlocksPerMultiprocessor(&per_cu, (const void*)hybrid_fwd, NTHREADS, LDS_BYTES) != hipSuccess || per_cu < 1) { fprintf(stderr, "kernel_launch: occupancy query says %d\n", per_cu); }
        (void)hipGetLastError();
        grid = cus > 0 ? cus : 256;
    }
    if (grid < 0) return;
    if (hipMemsetAsync((char*)d_ws + WS_CTL, 0, CTL_ZERO_BYTES, stream) != hipSuccess) return;
    Args a{};
    for (int i = 0; i < 27; ++i) a.in[i] = (const float*)d_in[i];
    a.out = (float*)d_out; a.ws = (unsigned char*)d_ws;
#if MK_ONE_LAUNCH
    a.ph_lo = 0; a.ph_hi = NPHASES;
    hipLaunchKernelGGL(hybrid_fwd, dim3(grid), dim3(NTHREADS), LDS_BYTES, stream, a);
#else
    for (int p = 0; p < NPHASES; ++p) {
        if (!phase_enabled(p)) continue;
        a.ph_lo = p; a.ph_hi = p + 1;
        hipLaunchKernelGGL(hybrid_fwd, dim3(grid), dim3(NTHREADS), LDS_BYTES, stream, a);
    }
#endif
    const hipError_t le = hipPeekAtLastError();
    if (le != hipSuccess) fprintf(stderr, "kernel_launch: launch failed: %s\n", hipGetErrorName(le));
}
```

```cpp
#define MK_ONE_LAUNCH 1
#define FAST_QKV 1
#define FAST_WO 1
#define FAST_GU 1
#define FAST_DN 1
#define FAST_WIN 1
#define FAST_WOUT 1
#define FAST_ATTN 1
#define FAST_GATES 1
#define FP8_MOE 1
#include <hip/hip_runtime.h>
#include <cstdio>
#include <cstdint>
#include <cmath>

#ifndef MK_ONE_LAUNCH
#define MK_ONE_LAUNCH 0
#endif
#ifndef FAST_QKV
#define FAST_QKV 0
#endif
#ifndef FAST_ATTN
#define FAST_ATTN 0
#endif
#ifndef FAST_WO
#define FAST_WO 0
#endif
#ifndef FAST_GU
#define FAST_GU 0
#endif
#ifndef FAST_DN
#define FAST_DN 0
#endif
#ifndef FAST_WIN
#define FAST_WIN 0
#endif
#ifndef FAST_GATES
#define FAST_GATES 0
#endif
#ifndef FAST_WOUT
#define FAST_WOUT 0
#endif
#ifndef FP8_MOE
#define FP8_MOE 0
#endif
#ifndef GU_ALIGN
#define GU_ALIGN true
#endif
#ifndef DN_ALIGN
#define DN_ALIGN true
#endif
#ifndef FUSE_SCAN1
#define FUSE_SCAN1 1
#endif
#define ANY_FAST_GEMM (FAST_QKV || FAST_WO || FAST_GU || FAST_DN || FAST_WIN || FAST_GATES || FAST_WOUT)

namespace pg8 {
#define PG8_LAS __attribute__((address_space(3)))
typedef unsigned short bf16_t;
typedef short bf16x8 __attribute__((ext_vector_type(8)));
typedef float f32x4 __attribute__((ext_vector_type(4)));
typedef unsigned u32x4 __attribute__((ext_vector_type(4)));
constexpr int BM = 256, BK = 64, HALF = 128, HTB = HALF * BK * 2  , STAGE_BYTES = 8 * HTB, NXCD = 8, WGM = 8;

__host__ __device__ __forceinline__ int lds_byte(int r, int c) { const int st = (r >> 4) * 2 + (c >> 5), rr = r & 15, cc = c & 31, ob = rr * 64 + cc * 2; return st * 1024 + (ob ^ (((ob >> 9) & 1) << 5)); }
__host__ __device__ __forceinline__ void stage_rc(int b, int& R, int& C) { const int st = b / 1024, sb = b % 1024, swz = sb ^ (((sb >> 9) & 1) << 5); R = (st >> 1) * 16 + swz / 64; C = (st & 1) * 32 + (swz % 64) / 2; }
__host__ __device__ __forceinline__ int perm32(int rho) { const int n = rho >> 4, i = rho & 15; return 8 * (i >> 2) + 4 * n + (i & 3); }

struct Unit { int pm, pn; };
struct Gemm { const bf16_t* A; const bf16_t* Bt; int M, N, K; };
__device__ __forceinline__ unsigned cvt_pk_bf16(float lo, float hi) { unsigned r; asm volatile("v_cvt_pk_bf16_f32 %0, %1, %2" : "=v"(r) : "v"(lo), "v"(hi)); return r; }
typedef int v4i_t __attribute__((ext_vector_type(4)));
typedef int v8i_t __attribute__((ext_vector_type(8)));
__device__ __forceinline__ v8i_t cat8(bf16x8 lo, bf16x8 hi) { const v4i_t a = __builtin_bit_cast(v4i_t, lo), b = __builtin_bit_cast(v4i_t, hi); return __builtin_shufflevector(a, b, 0, 1, 2, 3, 4, 5, 6, 7); }
template <class Epi, class Sched, bool ALIGN_EPI = false, bool SP2 = false, int FP8SCALE = 0  >
__device__ __forceinline__ void gemm_phase(PG8_LAS unsigned char* lds, const Gemm g, const Sched& S, const Epi& E) {
    const int tid = threadIdx.x, wid = __builtin_amdgcn_readfirstlane(tid >> 6), lane = tid & 63, wr = wid >> 2, wc = wid & 3, fr = lane & 15, fq = lane >> 4;
    const int K = g.K, nt = K / BK;
    unsigned voffA[2], voffB[2];
#pragma unroll
    for (int i = 0; i < 2; ++i) { int R, C; stage_rc(tid * 16 + i * 8192, R, C); const int Rb = Epi::PERM ? ((R & ~31) + perm32(R & 31)) : R;
        voffA[i] = (unsigned)(R * K + C) * 2u; voffB[i] = (unsigned)(Rb * K + C) * 2u; }
    const size_t kstep = (size_t)(BK * 2);
    const size_t hstep = (size_t)HALF * K * 2;
    const size_t tstep = 2 * hstep;
    const unsigned ldsw = (unsigned)wid * 1024u;
    const int aoff = lds_byte(wr * 64 + fr, fq * 8), boff = lds_byte(wc * 32 + fr, fq * 8);
#define PG8_SA(b, h) (((b) * 2 + (h)) * HTB)
#define PG8_SB(b, h) ((4 + (b) * 2 + (h)) * HTB)
#ifndef PG8_B_AUX
#define PG8_B_AUX 0
#endif
#define PG8_STAGE(bufoff, gbase, voff) do { _Pragma("unroll") for (int _i = 0; _i < 2; ++_i) { \
        if constexpr (FP8SCALE != 0 && PG8_B_AUX != 0) { if ((bufoff) >= 4 * HTB) __builtin_amdgcn_global_load_lds((const unsigned*)((const char*)(gbase) + (voff)[_i]), (PG8_LAS unsigned*)(lds + (bufoff) + ldsw + _i * 8192), 16, 0, PG8_B_AUX); \
            else __builtin_amdgcn_global_load_lds((const unsigned*)((const char*)(gbase) + (voff)[_i]), (PG8_LAS unsigned*)(lds + (bufoff) + ldsw + _i * 8192), 16, 0, 0); } \
        else __builtin_amdgcn_global_load_lds((const unsigned*)((const char*)(gbase) + (voff)[_i]), (PG8_LAS unsigned*)(lds + (bufoff) + ldsw + _i * 8192), 16, 0, 0); } } while (0)
#define PG8_LDA(dst, b, h) do { if constexpr (FP8SCALE == 0) { _Pragma("unroll") for (int m = 0; m < 4; ++m) _Pragma("unroll") for (int k = 0; k < 2; ++k) dst[m][k] = *(const PG8_LAS bf16x8*)(lds + PG8_SA(b, h) + aoff + m * 2048 + k * 1024); } \
        else { _Pragma("unroll") for (int m = 0; m < 4; ++m) { const v4i_t lo_ = *(const PG8_LAS v4i_t*)(lds + PG8_SA(b, h) + aoff + m * 2048), hi_ = *(const PG8_LAS v4i_t*)(lds + PG8_SA(b, h) + aoff + m * 2048 + 1024); dst##8[m] = __builtin_shufflevector(lo_, hi_, 0, 1, 2, 3, 4, 5, 6, 7); } } } while (0)
#define PG8_LDB(dst, b, h) do { if constexpr (FP8SCALE == 0) { _Pragma("unroll") for (int n = 0; n < 2; ++n) _Pragma("unroll") for (int k = 0; k < 2; ++k) dst[n][k] = *(const PG8_LAS bf16x8*)(lds + PG8_SB(b, h) + boff + n * 2048 + k * 1024); } \
        else { _Pragma("unroll") for (int n = 0; n < 2; ++n) { const v4i_t lo_ = *(const PG8_LAS v4i_t*)(lds + PG8_SB(b, h) + boff + n * 2048), hi_ = *(const PG8_LAS v4i_t*)(lds + PG8_SB(b, h) + boff + n * 2048 + 1024); dst##8[n] = __builtin_shufflevector(lo_, hi_, 0, 1, 2, 3, 4, 5, 6, 7); } } } while (0)
#define PG8_MMA(ai, bj, At, Bt) do { __builtin_amdgcn_s_setprio(1); \
        if constexpr (FP8SCALE == 0) { _Pragma("unroll") for (int m = 0; m < 4; ++m) _Pragma("unroll") for (int n = 0; n < 2; ++n) _Pragma("unroll") for (int k = 0; k < 2; ++k) \
            acc[ai][bj][m][n] = __builtin_amdgcn_mfma_f32_16x16x32_bf16(Bt[n][k], At[m][k], acc[ai][bj][m][n], 0, 0, 0); } \
        else { _Pragma("unroll") for (int m = 0; m < 4; ++m) _Pragma("unroll") for (int n = 0; n < 2; ++n) \
            asm volatile("v_mfma_scale_f32_16x16x128_f8f6f4 %0, %1, %2, %0, %3, %4 op_sel_hi:[0,0,0]" : "+v"(acc[ai][bj][m][n]) : "v"(Bt##8[n]), "v"(At##8[m]), "v"(sclW), "v"(sclA)); } \
        __builtin_amdgcn_s_setprio(0); } while (0)
#define PG8_WAIT_V(n) asm volatile("s_waitcnt vmcnt(" #n ")" ::: "memory")
#define PG8_WAIT_L(n) asm volatile("s_waitcnt lgkmcnt(" #n ")" ::: "memory")
#define PG8_BAR __builtin_amdgcn_s_barrier()
#define PG8_SCHED __builtin_amdgcn_sched_barrier(0)
    Unit cur, nxt; int ui = 0;
    if (!S.next(0, cur)) return;
    f32x4 acc[2][2][4][2];
#pragma unroll
    for (int a = 0; a < 2; ++a)
#pragma unroll
        for (int b = 0; b < 2; ++b)
#pragma unroll
            for (int m = 0; m < 4; ++m)
#pragma unroll
                for (int n = 0; n < 2; ++n) acc[a][b][m][n] = (f32x4){0.f, 0.f, 0.f, 0.f};
    bf16x8 At[4][2], B0[2][2], B1[2][2]; v8i_t At8[4], B08[2], B18[2]; const int sclW = FP8SCALE * 0x01010101, sclA = 0x7f7f7f7f;
    const char* cA = (const char*)g.A + (size_t)cur.pm * tstep; const char* cB = (const char*)g.Bt + (size_t)cur.pn * tstep;
    S.a_ready(cur);
    if constexpr (SP2) {
        PG8_STAGE(PG8_SB(0, 0), cB, voffB); PG8_STAGE(PG8_SB(0, 1), cB + hstep, voffB); PG8_STAGE(PG8_SA(0, 0), cA, voffA); PG8_STAGE(PG8_SA(0, 1), cA + hstep, voffA);
        if (wr == 1) PG8_BAR;
        PG8_WAIT_V(2); PG8_BAR;
        PG8_STAGE(PG8_SB(1, 0), cB + kstep, voffB); PG8_STAGE(PG8_SA(1, 0), cA + kstep, voffA); PG8_STAGE(PG8_SB(1, 1), cB + hstep + kstep, voffB);
        PG8_WAIT_V(6); PG8_BAR;
    } else {
        PG8_STAGE(PG8_SB(0, 0), cB, voffB); PG8_STAGE(PG8_SA(0, 0), cA, voffA); PG8_STAGE(PG8_SB(0, 1), cB + hstep, voffB); PG8_STAGE(PG8_SA(0, 1), cA + hstep, voffA);
        if (wr == 1) PG8_BAR;
        PG8_WAIT_V(4); PG8_BAR;
        PG8_STAGE(PG8_SB(1, 0), cB + kstep, voffB); PG8_STAGE(PG8_SA(1, 0), cA + kstep, voffA); PG8_STAGE(PG8_SB(1, 1), cB + hstep + kstep, voffB);
        PG8_WAIT_V(6); PG8_BAR;
    }
    for (;;) {
        const bool has_next = S.next(ui + 1, nxt);
        const char* nA = has_next ? (const char*)g.A + (size_t)nxt.pm * tstep : cA; const char* nB = has_next ? (const char*)g.Bt + (size_t)nxt.pn * tstep : cB;
        for (int t = 0; t < nt; t += 2) {
            const bool last = (t == nt - 2);
            const char* a1 = cA + (size_t)(t + 1) * kstep;
            const char* a2 = last ? nA : cA + (size_t)(t + 2) * kstep; const char* b2 = last ? nB : cB + (size_t)(t + 2) * kstep;
            const char* a3 = a2 + kstep; const char* b3 = b2 + kstep;
            if (last && has_next) S.a_ready(nxt);
            if constexpr (SP2) {
            PG8_LDB(B0, 0, 0); PG8_LDB(B1, 0, 1); PG8_SCHED; PG8_LDA(At, 0, 0); PG8_STAGE(PG8_SA(1, 1), a1 + hstep, voffA);
            PG8_WAIT_V(8); PG8_WAIT_L(0); PG8_BAR; PG8_MMA(0, 0, At, B0); PG8_MMA(0, 1, At, B1); PG8_BAR; PG8_SCHED;
            PG8_LDA(At, 0, 1); PG8_STAGE(PG8_SB(0, 0), b2, voffB); PG8_STAGE(PG8_SB(0, 1), b2 + hstep, voffB); PG8_STAGE(PG8_SA(0, 0), a2, voffA);
            PG8_WAIT_V(8); PG8_WAIT_L(0); PG8_BAR; PG8_MMA(1, 0, At, B0); PG8_MMA(1, 1, At, B1); PG8_BAR; PG8_SCHED;
            PG8_LDB(B0, 1, 0); PG8_LDB(B1, 1, 1); PG8_SCHED; PG8_LDA(At, 1, 0); PG8_STAGE(PG8_SA(0, 1), a2 + hstep, voffA);
            PG8_WAIT_V(8); PG8_WAIT_L(0); PG8_BAR; PG8_MMA(0, 0, At, B0); PG8_MMA(0, 1, At, B1); PG8_BAR; PG8_SCHED;
            PG8_LDA(At, 1, 1); PG8_STAGE(PG8_SB(1, 0), b3, voffB); PG8_STAGE(PG8_SB(1, 1), b3 + hstep, voffB); PG8_STAGE(PG8_SA(1, 0), a3, voffA);
            PG8_WAIT_V(8); PG8_WAIT_L(0); PG8_BAR; PG8_MMA(1, 0, At, B0); PG8_MMA(1, 1, At, B1); PG8_BAR; PG8_SCHED;
            } else {
            PG8_LDB(B0, 0, 0); PG8_SCHED; PG8_LDA(At, 0, 0); PG8_STAGE(PG8_SA(1, 1), a1 + hstep, voffA);
            PG8_WAIT_L(8); PG8_BAR; PG8_WAIT_L(0); PG8_MMA(0, 0, At, B0); PG8_BAR; PG8_SCHED;
            PG8_LDB(B1, 0, 1); PG8_STAGE(PG8_SB(0, 0), b2, voffB);
            PG8_BAR; PG8_WAIT_L(0); PG8_MMA(0, 1, At, B1); PG8_BAR;
            PG8_LDA(At, 0, 1); PG8_STAGE(PG8_SA(0, 0), a2, voffA);
            PG8_BAR; PG8_WAIT_L(0); PG8_MMA(1, 0, At, B0); PG8_BAR; PG8_SCHED;
            PG8_STAGE(PG8_SB(0, 1), b2 + hstep, voffB);
            PG8_WAIT_V(6); PG8_BAR; PG8_MMA(1, 1, At, B1); PG8_BAR;
            PG8_LDB(B0, 1, 0); PG8_SCHED; PG8_LDA(At, 1, 0); PG8_STAGE(PG8_SA(0, 1), a2 + hstep, voffA);
            PG8_WAIT_L(8); PG8_BAR; PG8_WAIT_L(0); PG8_MMA(0, 0, At, B0); PG8_BAR; PG8_SCHED;
            PG8_LDB(B1, 1, 1); PG8_STAGE(PG8_SB(1, 0), b3, voffB);
            PG8_BAR; PG8_WAIT_L(0); PG8_MMA(0, 1, At, B1); PG8_BAR;
            PG8_LDA(At, 1, 1); PG8_STAGE(PG8_SA(1, 0), a3, voffA);
            PG8_BAR; PG8_WAIT_L(0); PG8_MMA(1, 0, At, B0); PG8_BAR; PG8_SCHED;
            PG8_STAGE(PG8_SB(1, 1), b3 + hstep, voffB);
            PG8_WAIT_V(6); PG8_BAR; PG8_MMA(1, 1, At, B1); PG8_BAR;
            }
        }
        if constexpr (ALIGN_EPI) { if (wr == 0) PG8_BAR; }
        if constexpr (FP8SCALE != 0) asm volatile("s_nop 15\n\ts_nop 15" ::: "memory");
        if constexpr (!Epi::AFTER_DRAIN) { E(acc, cur, wr, wc, fr, fq); S.done(cur); }
        if (!has_next) break;
#pragma unroll
        for (int a = 0; a < 2; ++a)
#pragma unroll
            for (int b = 0; b < 2; ++b)
#pragma unroll
                for (int m = 0; m < 4; ++m)
#pragma unroll
                    for (int n = 0; n < 2; ++n) acc[a][b][m][n] = (f32x4){0.f, 0.f, 0.f, 0.f};
        cur = nxt; cA = nA; cB = nB; ++ui;
        if constexpr (ALIGN_EPI) { if (wr == 1) PG8_BAR; }
    }
    PG8_WAIT_V(0);
    if constexpr (!ALIGN_EPI) { if (wr == 0) PG8_BAR; }
    PG8_BAR;
    if constexpr (Epi::AFTER_DRAIN) { E.fused(acc, cur, wr, wc, fr, fq, lds, wid, lane); S.done(cur); }
#undef PG8_SA
#undef PG8_SB
#undef PG8_STAGE
#undef PG8_LDA
#undef PG8_LDB
#undef PG8_MMA
#undef PG8_WAIT_V
#undef PG8_WAIT_L
#undef PG8_BAR
#undef PG8_SCHED
}
}

#define LAS __attribute__((address_space(3)))
typedef unsigned short bf16_t;
typedef float f32x4 __attribute__((ext_vector_type(4)));
typedef float f32x2 __attribute__((ext_vector_type(2)));
typedef unsigned u32x4 __attribute__((ext_vector_type(4)));
typedef unsigned u32x2 __attribute__((ext_vector_type(2)));
typedef short bf16x8 __attribute__((ext_vector_type(8)));

constexpr int NB = 8, SEQ = 2048, CTXL = 256, D = 1024;
constexpr int RL = NB * SEQ, RC = NB * CTXL, RT = RL + RC;
constexpr int NE = 16, DE = 2816, CAPL = 256, CAPC = 32;
constexpr int RPE0 = NB * CAPL + NB * CAPC, RPE1 = NB * CAPL;
constexpr int NWAVES = 8, NTHREADS = 512;
constexpr float EPS = 1e-6f;
constexpr float QSCALE = 0.125f * 1.4426950408889634f;
constexpr float LAMBDA_INIT0 = 0.2f;
constexpr int M_SH1 = 0, M_SC1 = 1024, M_G1 = 2048, M_SH2 = 3072, M_SC2 = 4096, M_G2 = 5120;
constexpr int SCH = 64, NCH = (CTXL + SEQ) / SCH, NCH_CTX = CTXL / SCH;

constexpr size_t MiB = 1u << 20;
constexpr size_t WS_CTL = 0, CTL_ZERO_BYTES = 32768;
constexpr size_t WS_GTAB = 2 * MiB + 65536;
constexpr size_t WS_MOD = 1 * MiB, WS_ROPE = 2 * MiB, WS_PROBS = 3 * MiB, WS_GATE = 5 * MiB, WS_SEL = 6 * MiB, WS_CP = 8 * MiB, WS_CB = 11 * MiB;
constexpr size_t WS_WQKV = 16 * MiB, WS_WO = 22 * MiB, WS_WIN = 24 * MiB, WS_WOUT = 28 * MiB, WS_WG = 30 * MiB;
constexpr size_t WS_XN = 32 * MiB, WS_Q = 68 * MiB, WS_K = 104 * MiB, WS_V = 140 * MiB, WS_ATT = 176 * MiB, WS_H = 212 * MiB;
constexpr size_t WS_XG = 284 * MiB, WS_Y = 356 * MiB, WS_ACT = 428 * MiB, WS_WGU = 626 * MiB, WS_WDN = 978 * MiB;
constexpr size_t WS_YG = 68 * MiB, WS_XR = 104 * MiB, WS_HS = 140 * MiB;
constexpr size_t WS_LOGA = 1154 * MiB, WS_BT = 1226 * MiB;
constexpr size_t WS_TMPF = 1298 * MiB, WS_XC = 2090 * MiB, WS_END = 2126 * MiB;
constexpr size_t WGU_LAYER = (size_t)NE * 2 * DE * D * 2, WDN_LAYER = (size_t)NE * D * DE * 2;
constexpr int CW_BAR = 4096;

constexpr int LDS_BYTES = 147456;
constexpr int MISC_OFF = 131072 + 320;

struct Args { const float* in[27]; float* out; unsigned char* ws; int ph_lo, ph_hi; };
constexpr int ROPE_LDS = 131072 + 1024;
constexpr int ARGS_OFF = 131072 + 512;
struct Ctx {
    const LAS unsigned* la;
    __device__ __forceinline__ unsigned long long ld(int i) const { const unsigned lo = __builtin_amdgcn_readfirstlane(la[2 * i]), hi = __builtin_amdgcn_readfirstlane(la[2 * i + 1]); return ((unsigned long long)hi << 32) | lo; }
    __device__ __forceinline__ const float* in(int i) const { return (const float*)(const __attribute__((address_space(1))) float*)ld(i); }
    __device__ __forceinline__ float* out() const { return (float*)(__attribute__((address_space(1))) float*)ld(27); }
    __device__ __forceinline__ unsigned char* ws() const { return (unsigned char*)(__attribute__((address_space(1))) unsigned char*)ld(28); }
};

enum { I_X = 0, I_C, I_CTX, I_CCTX, I_ADAW, I_ADAB, I_N1G, I_N2G, I_FG, I_WQKV, I_LQ1, I_LK1, I_LQ2, I_LK2, I_SUBG, I_WO, I_WIN, I_BIN, I_CONVW, I_CONVB, I_WGATES, I_BGATES, I_LAM, I_WOUT, I_WR, I_WGU, I_WDN };

__device__ __forceinline__ float bf_lo(unsigned w) { return __uint_as_float(w << 16); }
__device__ __forceinline__ float bf_hi(unsigned w) { return __uint_as_float(w & 0xffff0000u); }
__device__ __forceinline__ float bf2f(bf16_t b) { return __uint_as_float(((unsigned)b) << 16); }
__device__ __forceinline__ unsigned f2bf(float f) { unsigned u = __float_as_uint(f); return (u + 0x7fffu + ((u >> 16) & 1u)) >> 16; }
__device__ __forceinline__ unsigned pk2(float lo, float hi) { unsigned r; asm("v_cvt_pk_bf16_f32 %0, %1, %2" : "=v"(r) : "v"(lo), "v"(hi)); return r; }
#ifndef EPI_WT
#define EPI_WT 0
#endif
__device__ __forceinline__ void st16_wt(void* p, u32x4 v) {
#if EPI_WT
    asm volatile("global_store_dwordx4 %0, %1, off sc1" :: "v"(p), "v"(v) : "memory");
#else
    *(u32x4*)p = v;
#endif
}
__device__ __forceinline__ void st8_wt(void* p, u32x2 v) {
#if EPI_WT
    asm volatile("global_store_dwordx2 %0, %1, off sc1" :: "v"(p), "v"(v) : "memory");
#else
    *(u32x2*)p = v;
#endif
}
__device__ __forceinline__ float wave_sum(float v) {
#pragma unroll
    for (int o = 1; o < 64; o <<= 1) v += __shfl_xor(v, o);
    return v;
}
__device__ __forceinline__ float wave_max(float v) {
#pragma unroll
    for (int o = 1; o < 64; o <<= 1) v = fmaxf(v, __shfl_xor(v, o));
    return v;
}
__device__ __forceinline__ float sigmoidf_(float x) { return 1.f / (1.f + expf(-x)); }
__device__ __forceinline__ float gelu_tanh(float x) { const float u = 0.7978845608028654f * (x + 0.044715f * x * x * x); return x / (1.f + expf(-2.f * u)); }
__device__ __forceinline__ const float* mod_ptr(const Ctx& a, int layer, int r) { return (const float*)(a.ws() + WS_MOD) + (size_t)(layer * 9 + r) * 6144; }
__device__ __forceinline__ int mod_row(int row) { return row < RL ? (row >> 11) : 8; }

__device__ __forceinline__ void load_row(const float* p, int lane, f32x4 (&v)[4]) {
#pragma unroll
    for (int j = 0; j < 4; ++j) v[j] = *(const f32x4*)(p + 4 * lane + 256 * j);
}
__device__ __forceinline__ void load_row_bf16(const bf16_t* p, int lane, f32x4 (&v)[4]) {
#pragma unroll
    for (int j = 0; j < 4; ++j) { const u32x2 w = *(const u32x2*)(p + 4 * lane + 256 * j); v[j] = (f32x4){bf_lo(w.x), bf_hi(w.x), bf_lo(w.y), bf_hi(w.y)}; }
}
__device__ __forceinline__ void store_row_f32(float* p, int lane, const f32x4 (&v)[4]) {
#pragma unroll
    for (int j = 0; j < 4; ++j) *(f32x4*)(p + 4 * lane + 256 * j) = v[j];
}
__device__ __forceinline__ void store_row_bf16(bf16_t* p, int lane, const f32x4 (&v)[4]) {
#pragma unroll
    for (int j = 0; j < 4; ++j) { u32x2 w; w.x = pk2(v[j].x, v[j].y); w.y = pk2(v[j].z, v[j].w); *(u32x2*)(p + 4 * lane + 256 * j) = w; }
}
__device__ __forceinline__ void store_row_fp8(unsigned char* p, int lane, const f32x4 (&v)[4]) {
#pragma unroll
    for (int j = 0; j < 4; ++j) *(unsigned*)(p + 4 * lane + 256 * j) = __builtin_amdgcn_cvt_pk_fp8_f32(v[j].z, v[j].w, __builtin_amdgcn_cvt_pk_fp8_f32(v[j].x, v[j].y, 0u, false), true);
}
__device__ __forceinline__ void rms_mod(f32x4 (&v)[4], const float* g, const float* sh, const float* sc, int lane) {
    float ss = 0.f;
#pragma unroll
    for (int j = 0; j < 4; ++j) ss += (v[j].x * v[j].x + v[j].y * v[j].y) + (v[j].z * v[j].z + v[j].w * v[j].w);
    ss = wave_sum(ss);
    const float rstd = 1.0f / sqrtf(ss * (1.0f / D) + EPS);
#pragma unroll
    for (int j = 0; j < 4; ++j) {
        const int k = 4 * lane + 256 * j;
        const f32x4 gg = *(const f32x4*)(g + k);
        f32x4 y = v[j] * rstd * gg;
        if (sh) { const f32x4 s1 = *(const f32x4*)(sc + k), s0 = *(const f32x4*)(sh + k); y = y * (1.0f + s1) + s0; }
        v[j] = y;
    }
}

template <class F>
__device__ __forceinline__ void naive_tile(const bf16_t* A, int lda, const float* W, int ldw, int K, LAS unsigned char* lds, F f) {
    LAS float* As = (LAS float*)lds;
    LAS float* Bs = (LAS float*)(lds + 16 * 132 * 4);
    const int tid = threadIdx.x, ty = tid >> 4, tx = tid & 15;
    const int ar = tid >> 2, akq = tid & 3, bk = tid >> 5, bc = (tid & 31) * 2;
    float acc[4][4];
#pragma unroll
    for (int i = 0; i < 4; ++i)
#pragma unroll
        for (int j = 0; j < 4; ++j) acc[i][j] = 0.f;
    for (int k0 = 0; k0 < K; k0 += 16) {
        const u32x2 av = *(const u32x2*)(A + (size_t)ar * lda + k0 + akq * 4);
        const f32x2 bv = *(const f32x2*)(W + (size_t)(k0 + bk) * ldw + bc);
        __syncthreads();
        As[(akq * 4 + 0) * 132 + ar] = bf_lo(av.x); As[(akq * 4 + 1) * 132 + ar] = bf_hi(av.x);
        As[(akq * 4 + 2) * 132 + ar] = bf_lo(av.y); As[(akq * 4 + 3) * 132 + ar] = bf_hi(av.y);
        Bs[bk * 64 + bc] = bv.x; Bs[bk * 64 + bc + 1] = bv.y;
        __syncthreads();
#pragma unroll
        for (int kk = 0; kk < 16; ++kk) {
            const f32x4 a4 = *(const LAS f32x4*)(As + kk * 132 + ty * 4);
            const f32x4 b4 = *(const LAS f32x4*)(Bs + kk * 64 + tx * 4);
#pragma unroll
            for (int i = 0; i < 4; ++i)
#pragma unroll
                for (int j = 0; j < 4; ++j) acc[i][j] += a4[i] * b4[j];
        }
    }
#pragma unroll
    for (int i = 0; i < 4; ++i)
#pragma unroll
        for (int j = 0; j < 4; ++j) f(ty * 4 + i, tx * 4 + j, acc[i][j]);
    __syncthreads();
}

__device__ __forceinline__ void cvt_item(const float* W, int N, int k0, int n0, bf16_t* dst, int Kd, int gu_perm) {
    const int tid = threadIdx.x, lane = tid & 63, wave = tid >> 6;
    const float* p = W + (size_t)(k0 + 8 * wave) * N + n0 + 4 * lane;
    f32x4 v[8];
#pragma unroll
    for (int i = 0; i < 8; ++i) v[i] = *(const f32x4*)(p + (size_t)i * N);
#pragma unroll
    for (int j = 0; j < 4; ++j) {
        const int n = n0 + 4 * lane + j;
        const int row = gu_perm ? (((n % DE) >> 7) * 256 + (n / DE) * 128 + (n & 127)) : n;
        u32x4 o; o.x = pk2(v[0][j], v[1][j]); o.y = pk2(v[2][j], v[3][j]); o.z = pk2(v[4][j], v[5][j]); o.w = pk2(v[6][j], v[7][j]);
        *(u32x4*)(dst + (size_t)row * Kd + k0 + 8 * wave) = o;
    }
}
__device__ __forceinline__ unsigned pk4_fp8(float a, float b, float c, float d) { unsigned w = __builtin_amdgcn_cvt_pk_fp8_f32(a, b, 0u, false); return __builtin_amdgcn_cvt_pk_fp8_f32(c, d, w, true); }
constexpr float BT_SCALE = 64.0f, Y_SCALE = 16.0f;
constexpr float WGU_SCALE = 32.0f, WDN_SCALE = 64.0f;
__device__ __forceinline__ void cvt8_load(const float* W, int N, int k0, int n0, f32x4 (&v)[16]) {
    const int tid = threadIdx.x, lane = tid & 63, wave = tid >> 6;
    const float* p = W + (size_t)(k0 + 16 * wave) * N + n0 + 4 * lane;
#pragma unroll
    for (int i = 0; i < 16; ++i) v[i] = __builtin_nontemporal_load((const f32x4*)(p + (size_t)i * N));
}
__device__ __forceinline__ void cvt8_store(const f32x4 (&v)[16], int k0, int n0, unsigned char* dst, int Kd, int gu_perm, float scale, LAS unsigned char* T) {
    const int tid = threadIdx.x, lane = tid & 63, wave = tid >> 6;
#pragma unroll
    for (int j = 0; j < 4; ++j) {
        const int n = 4 * lane + j;
        u32x4 o;
        o.x = pk4_fp8(v[0][j] * scale, v[1][j] * scale, v[2][j] * scale, v[3][j] * scale); o.y = pk4_fp8(v[4][j] * scale, v[5][j] * scale, v[6][j] * scale, v[7][j] * scale);
        o.z = pk4_fp8(v[8][j] * scale, v[9][j] * scale, v[10][j] * scale, v[11][j] * scale); o.w = pk4_fp8(v[12][j] * scale, v[13][j] * scale, v[14][j] * scale, v[15][j] * scale);
        *(LAS u32x4*)(T + n * 128 + ((wave ^ (lane & 7)) << 4)) = o;
    }
    asm volatile("s_waitcnt lgkmcnt(0)" ::: "memory"); __builtin_amdgcn_s_barrier(); asm volatile("" ::: "memory");
#pragma unroll
    for (int i = 0; i < 4; ++i) {
        const int p = tid + NTHREADS * i, n = p >> 3, c = p & 7;
        const u32x4 x = *(const LAS u32x4*)(T + n * 128 + ((c ^ ((n >> 2) & 7)) << 4));
        const int ng = n0 + n;
        const int row = gu_perm ? (((ng % DE) >> 7) * 256 + (ng / DE) * 128 + (ng & 127)) : ng;
        __builtin_nontemporal_store(x, (u32x4*)(dst + (size_t)row * Kd + k0 + 16 * c));
    }
}
constexpr int CV_GU = NE * 8 * 22, CV_DN = NE * 22 * 4, CV_ITEMS = CV_GU + CV_DN;
struct CvItem { const float* W; unsigned char* dst; int N, Kd, k0, n0, perm; float scale; };
__device__ __forceinline__ CvItem cv_decode(const float* wgu, const float* wdn, unsigned char* ws, int layer, int it) {
    CvItem c;
    if (it < CV_GU) { const int e = it / 176, q = it % 176, le = layer * NE + e; c.W = wgu + (size_t)le * D * 2 * DE; c.dst = ws + WS_WGU + (size_t)le * 2 * DE * D; c.N = 2 * DE; c.Kd = D; c.k0 = (q / 22) * 128; c.n0 = (q % 22) * 256; c.perm = 1; c.scale = WGU_SCALE; }
    else { const int r = it - CV_GU, e = r / 88, q = r % 88, le = layer * NE + e; c.W = wdn + (size_t)le * DE * D; c.dst = ws + WS_WDN + (size_t)le * D * DE; c.N = D; c.Kd = DE; c.k0 = (q / 4) * 128; c.n0 = (q % 4) * 256; c.perm = 0; c.scale = WDN_SCALE; }
    return c;
}
__device__ __forceinline__ void cvt8_run(const Ctx& a, int layer, int first, int stride, int end, LAS unsigned char* lds) {
    const float* wgu = a.in(I_WGU); const float* wdn = a.in(I_WDN); unsigned char* ws = a.ws();
    f32x4 va[16], vb[16];
    int it = first;
    if (it < end) { const CvItem c = cv_decode(wgu, wdn, ws, layer, it); cvt8_load(c.W, c.N, c.k0, c.n0, va); }
    while (it < end) {
        int nx = it + stride;
        if (nx < end) { const CvItem c = cv_decode(wgu, wdn, ws, layer, nx); cvt8_load(c.W, c.N, c.k0, c.n0, vb); }
        { const CvItem c = cv_decode(wgu, wdn, ws, layer, it); cvt8_store(va, c.k0, c.n0, c.dst, c.Kd, c.perm, c.scale, lds); }
        it = nx; if (it >= end) break;
        nx = it + stride;
        if (nx < end) { const CvItem c = cv_decode(wgu, wdn, ws, layer, nx); cvt8_load(c.W, c.N, c.k0, c.n0, va); }
        { const CvItem c = cv_decode(wgu, wdn, ws, layer, it); cvt8_store(vb, c.k0, c.n0, c.dst, c.Kd, c.perm, c.scale, lds + 32768); }
        it = nx;
    }
    __syncthreads();
}
#ifndef CVT_HIDE
#define CVT_HIDE 1
#endif
#ifndef CVT_DEDICATED
#define CVT_DEDICATED 0
#endif
#ifndef CVQ_QKV
#define CVQ_QKV 1280
#endif
#ifndef CVQ_WO
#define CVQ_WO 896
#endif
#ifndef CVQ_GU0
#define CVQ_GU0 480
#endif
#ifndef CVQ_DN0
#define CVQ_DN0 960
#endif
#ifndef CVQ_WIN
#define CVQ_WIN 896
#endif
#ifndef CVQ_GATES
#define CVQ_GATES 768
#endif
constexpr int CV0_QKV = 0, CV0_WO = CV0_QKV + CVQ_QKV, CV0_PRO = CVT_HIDE ? CV0_WO + CVQ_WO : 0;
constexpr int CV1_GU0 = 0, CV1_DN0 = CV1_GU0 + CVQ_GU0, CV1_WIN = CV1_DN0 + CVQ_DN0, CV1_GATES = CV1_WIN + CVQ_WIN, CV1_PRO = CVT_HIDE ? CV1_GATES + CVQ_GATES : 0;
static_assert(CV0_PRO <= CV_ITEMS && CV1_PRO <= CV_ITEMS, "conversion schedule");
__device__ __forceinline__ void cvt8_tail(const Ctx& a, LAS unsigned char* lds, int units, int G, int c, int layer, int base, int count) {
#if CVT_HIDE && FP8_MOE
    const int R = (units + G - 1) / G, first_idle = units - (R - 1) * G;
    if (first_idle >= G || count <= 0 || c < first_idle) return;
    cvt8_run(a, layer, base + (c - first_idle), G - first_idle, base + count, lds);
#endif
}
__device__ __forceinline__ int gemm_groups(int units, int G) {
#if CVT_HIDE && FP8_MOE && CVT_DEDICATED
    const int R = (units + G - 1) / G; int gp = ((units + R - 1) / R + 7) & ~7;
    return gp < G ? gp : G;
#else
    return G;
#endif
}
__device__ __forceinline__ void ph_prologue(const Ctx& a, LAS unsigned char* lds) {
    const int tid = threadIdx.x, lane = tid & 63, wave = tid >> 6;
    if (blockIdx.x == gridDim.x - 1) {
        float* rope = (float*)(a.ws() + WS_ROPE);
        for (int i = tid; i < 1024; i += NTHREADS) { const int pos = i >> 4, f = i & 15; const float inv = powf(10000.0f, -(float)f / 16.0f); const float ang = (float)pos * inv; rope[i] = cosf(ang); rope[1024 + i] = sinf(ang); }
    }
    if (blockIdx.x == gridDim.x - 2 || gridDim.x == 1) {
        float* gt = (float*)(a.ws() + WS_GTAB); const float* lamp = a.in(I_LAM); const float* bgp = a.in(I_BGATES);
        for (int i = tid; i < 2 * D; i += NTHREADS) {
            const int d = i >> 10, ch = i & 1023, kb = ch >> 7, cc = ch & 127;
            const float cl = -8.0f * log1pf(expf(-lamp[i]));
            gt[(d * 4 + 0) * D + ch] = cl * 1.4426950408889634f; gt[(d * 4 + 1) * D + ch] = 2.0f * cl * 1.4426950408889634f;
            gt[(d * 4 + 2) * D + ch] = -1.4426950408889634f * bgp[(d * 8 + kb) * 256 + cc]; gt[(d * 4 + 3) * D + ch] = -1.4426950408889634f * bgp[(d * 8 + kb) * 256 + 128 + cc];
        }
    }
    for (int u = blockIdx.x; u < 192; u += gridDim.x) {
        LAS float* sl = (LAS float*)lds;
        LAS float* red = (LAS float*)(lds + 49152);
        const int layer = u / 96, n0 = (u % 96) * 64;
        for (int i = tid; i < 9 * 1024; i += NTHREADS) { const int r = i >> 10, k = i & 1023; const float v = r < 8 ? a.in(I_C)[r * 1024 + k] : a.in(I_CCTX)[k]; sl[k * 12 + r] = v / (1.f + expf(-v)); }
        __syncthreads();
        const float* W = a.in(I_ADAW) + (size_t)layer * 1024 * 6144 + n0 + lane;
        float acc[9];
#pragma unroll
        for (int r = 0; r < 9; ++r) acc[r] = 0.f;
#pragma unroll 32
        for (int k = wave * 128; k < wave * 128 + 128; ++k) {
            const float w = __builtin_nontemporal_load(W + (size_t)k * 6144);
            const f32x4 s0 = *(const LAS f32x4*)(sl + k * 12), s1 = *(const LAS f32x4*)(sl + k * 12 + 4); const float s8 = sl[k * 12 + 8];
            acc[0] += s0.x * w; acc[1] += s0.y * w; acc[2] += s0.z * w; acc[3] += s0.w * w;
            acc[4] += s1.x * w; acc[5] += s1.y * w; acc[6] += s1.z * w; acc[7] += s1.w * w; acc[8] += s8 * w;
        }
#pragma unroll
        for (int r = 0; r < 9; ++r) red[(wave * 9 + r) * 64 + lane] = acc[r];
        __syncthreads();
        float* MOD = (float*)(a.ws() + WS_MOD);
        for (int i = tid; i < 576; i += NTHREADS) {
            const int r = i >> 6, l = i & 63; float s = 0.f;
#pragma unroll
            for (int w = 0; w < 8; ++w) s += red[(w * 9 + r) * 64 + l];
            MOD[(size_t)(layer * 9 + r) * 6144 + n0 + l] = s + a.in(I_ADAB)[layer * 6144 + n0 + l];
        }
        __syncthreads();
    }
#if ANY_FAST_GEMM
    constexpr int IT_QKV = 16 * 12, IT_WO = 16 * 4, IT_WIN = 16 * 8, IT_WOUT = 16 * 4, IT_G = 32;
#if FP8_MOE
    cvt8_run(a, 0, CV0_PRO + (int)blockIdx.x, (int)gridDim.x, CV_ITEMS, lds);
    cvt8_run(a, 1, CV1_PRO + (int)blockIdx.x, (int)gridDim.x, CV_ITEMS, lds);
    constexpr int IT_GU = 0, IT_DN = 0;
#else
    constexpr int IT_GU1 = 16 * 22, IT_DN1 = 44 * 4;
    constexpr int IT_GU = 32 * IT_GU1, IT_DN = 32 * IT_DN1;
#endif
    constexpr int NITEMS = IT_GU + IT_DN + IT_QKV + IT_WO + IT_WIN + IT_WOUT + IT_G;
    for (int it = blockIdx.x; it < NITEMS; it += gridDim.x) {
        int r = it;
#if !FP8_MOE
        if (r < IT_GU) { const int le = r / IT_GU1, q = r % IT_GU1;
            cvt_item(a.in(I_WGU) + (size_t)le * D * 2 * DE, 2 * DE, (q / 22) * 64, (q % 22) * 256, (bf16_t*)(a.ws() + WS_WGU) + (size_t)le * 2 * DE * D, D, 1); continue; }
        r -= IT_GU;
        if (r < IT_DN) { const int le = r / IT_DN1, q = r % IT_DN1;
            cvt_item(a.in(I_WDN) + (size_t)le * DE * D, D, (q / 4) * 64, (q % 4) * 256, (bf16_t*)(a.ws() + WS_WDN) + (size_t)le * D * DE, DE, 0); continue; }
#endif
        r -= IT_DN;
        if (r < IT_QKV) { cvt_item(a.in(I_WQKV), 3 * D, (r / 12) * 64, (r % 12) * 256, (bf16_t*)(a.ws() + WS_WQKV), D, 0); continue; }
        r -= IT_QKV;
        if (r < IT_WO) { cvt_item(a.in(I_WO), D, (r / 4) * 64, (r % 4) * 256, (bf16_t*)(a.ws() + WS_WO), D, 0); continue; }
        r -= IT_WO;
        if (r < IT_WIN) { cvt_item(a.in(I_WIN), 2 * D, (r / 8) * 64, (r % 8) * 256, (bf16_t*)(a.ws() + WS_WIN), D, 0); continue; }
        r -= IT_WIN;
        if (r < IT_WOUT) { cvt_item(a.in(I_WOUT), D, (r / 4) * 64, (r % 4) * 256, (bf16_t*)(a.ws() + WS_WOUT), D, 0); continue; }
        r -= IT_WOUT;
        { const int m = r >> 1, kk = r & 1;
            cvt_item(a.in(I_WGATES) + (size_t)m * 128 * 256, 256, kk * 64, 0, (bf16_t*)(a.ws() + WS_WG) + (size_t)m * 256 * 128, 128, 0); }
    }
#endif
}

__device__ __forceinline__ void ph_norm1_l0(const Ctx& a) {
    const int lane = threadIdx.x & 63, gw = blockIdx.x * NWAVES + (threadIdx.x >> 6), NGW = gridDim.x * NWAVES;
    unsigned char* ws = a.ws();
    bf16_t* XN = (bf16_t*)(ws + WS_XN); const float* X = a.in(I_X); const float* CX = a.in(I_CTX); const float* n1g = a.in(I_N1G);
    f32x4 v[4], nx[4];
    int row = gw;
    if (row < RT) load_row(row < RL ? X + (size_t)row * D : CX + (size_t)(row - RL) * D, lane, v);
    for (; row < RT; row += NGW) {
        const int rn = row + NGW;
        if (rn < RT) load_row(rn < RL ? X + (size_t)rn * D : CX + (size_t)(rn - RL) * D, lane, nx);
        const float* mp = (const float*)(ws + WS_MOD) + (size_t)mod_row(row) * 6144;
        rms_mod(v, n1g, mp + M_SH1, mp + M_SC1, lane);
        store_row_bf16(XN + (size_t)row * D, lane, v);
#pragma unroll
        for (int j = 0; j < 4; ++j) v[j] = nx[j];
    }
}
__device__ __forceinline__ float rs16(float (&s)[16], int lane) {
    float r8[8], r4[4], r2[2];
    const bool b5 = lane & 32, b4 = lane & 16, b3 = lane & 8, b2 = lane & 4;
#pragma unroll
    for (int i = 0; i < 8; ++i) { const float send = b5 ? s[i] : s[i + 8], keep = b5 ? s[i + 8] : s[i]; r8[i] = keep + __shfl_xor(send, 32); }
#pragma unroll
    for (int i = 0; i < 4; ++i) { const float send = b4 ? r8[i] : r8[i + 4], keep = b4 ? r8[i + 4] : r8[i]; r4[i] = keep + __shfl_xor(send, 16); }
#pragma unroll
    for (int i = 0; i < 2; ++i) { const float send = b3 ? r4[i] : r4[i + 2], keep = b3 ? r4[i + 2] : r4[i]; r2[i] = keep + __shfl_xor(send, 8); }
    float r = (b2 ? r2[1] : r2[0]) + __shfl_xor(b2 ? r2[0] : r2[1], 4);
    r += __shfl_xor(r, 2); r += __shfl_xor(r, 1);
    return r;
}
__device__ __forceinline__ void ph_norm2_router(const Ctx& a, LAS unsigned char* lds, int layer, int nrows) {
    const int tid = threadIdx.x, lane = tid & 63, gw = blockIdx.x * NWAVES + (tid >> 6), NGW = gridDim.x * NWAVES;
    LAS float* wrT = (LAS float*)lds;
    const float* wr = a.in(I_WR) + (size_t)layer * D * NE;
    for (int i = tid; i < D * NE; i += NTHREADS) wrT[(i & 15) * 1024 + (i >> 4)] = wr[i];
    __syncthreads();
    unsigned char* ws = a.ws();
    bf16_t* XN = (bf16_t*)(ws + WS_XN); const bf16_t* H = (const bf16_t*)(ws + WS_H);
    float* PL = (float*)(ws + WS_PROBS); float* PC = PL + NB * NE * SEQ;
    const float* n2g = a.in(I_N2G) + layer * D;
    const int elane = ((lane >> 5) & 1) * 8 + ((lane >> 4) & 1) * 4 + ((lane >> 3) & 1) * 2 + ((lane >> 2) & 1);
    f32x4 v0[4], v1[4], n0[4], n1[4];
    int p = gw;
    if (p < nrows / 2) { load_row_bf16(H + (size_t)(2 * p) * D, lane, v0); load_row_bf16(H + (size_t)(2 * p + 1) * D, lane, v1); }
    for (; p < nrows / 2; p += NGW) {
        const int pn = p + NGW;
        if (pn < nrows / 2) { load_row_bf16(H + (size_t)(2 * pn) * D, lane, n0); load_row_bf16(H + (size_t)(2 * pn + 1) * D, lane, n1); }
        const int row = 2 * p;
        const float* mp = (const float*)(ws + WS_MOD) + (size_t)(layer * 9 + mod_row(row)) * 6144;
        rms_mod(v0, n2g, mp + M_SH2, mp + M_SC2, lane); rms_mod(v1, n2g, mp + M_SH2, mp + M_SC2, lane);
#if FP8_MOE
        store_row_fp8((unsigned char*)XN + (size_t)row * D, lane, v0); store_row_fp8((unsigned char*)XN + (size_t)(row + 1) * D, lane, v1);
#else
        store_row_bf16(XN + (size_t)row * D, lane, v0); store_row_bf16(XN + (size_t)(row + 1) * D, lane, v1);
#endif
        float s0[16], s1[16];
#pragma unroll
        for (int e = 0; e < 16; ++e) {
            float a0 = 0.f, a1 = 0.f;
#pragma unroll
            for (int j = 0; j < 4; ++j) { const f32x4 w = *(const LAS f32x4*)(wrT + e * 1024 + 4 * lane + 256 * j);
                a0 += (v0[j].x * w.x + v0[j].y * w.y) + (v0[j].z * w.z + v0[j].w * w.w); a1 += (v1[j].x * w.x + v1[j].y * w.y) + (v1[j].z * w.z + v1[j].w * w.w); }
            s0[e] = a0; s1[e] = a1;
            if ((e & 3) == 3) asm volatile("" ::: "memory");
        }
        const float l0 = rs16(s0, lane), l1 = rs16(s1, lane);
        const float m0 = wave_max(l0), m1 = wave_max(l1);
        const float e0 = expf(l0 - m0), e1 = expf(l1 - m1);
        const float q0 = e0 / (wave_sum(e0) * 0.25f), q1 = e1 / (wave_sum(e1) * 0.25f);
        if ((lane & 3) == 0) {
            if (row < RL) { float* d = PL + ((size_t)(row >> 11) * NE + elane) * SEQ + (row & 2047); *(f32x2*)d = (f32x2){q0, q1}; }
            else { const int rc = row - RL; float* d = PC + ((size_t)(rc >> 8) * NE + elane) * CTXL + (rc & 255); *(f32x2*)d = (f32x2){q0, q1}; }
        }
#pragma unroll
        for (int j = 0; j < 4; ++j) { v0[j] = n0[j]; v1[j] = n1[j]; }
    }
    __syncthreads();
}
__device__ __forceinline__ void ph_topk_gather(const Ctx& a, LAS unsigned char* lds, int layer) {
    const int tid = threadIdx.x, lane = tid & 63, wave = tid >> 6;
    LAS int* idxl = (LAS int*)lds;
    LAS int* cnt = (LAS int*)(lds + 1024);
    unsigned char* ws = a.ws();
    const float* PL = (const float*)(ws + WS_PROBS); const float* PC = PL + NB * NE * SEQ;
    float* GATE = (float*)(ws + WS_GATE); int* SEL = (int*)(ws + WS_SEL);
    const bf16_t* XN = (const bf16_t*)(ws + WS_XN); bf16_t* XG = (bf16_t*)(ws + WS_XG);
    const int nunits = layer == 0 ? 256 : 128, rpe = layer == 0 ? RPE0 : RPE1;
    const unsigned long long lt = (1ull << lane) - 1ull;
    for (int u0 = blockIdx.x; u0 < nunits; u0 += gridDim.x) {
        const int u = layer == 0 ? ((u0 & 1) * 128 + (u0 >> 1)) : u0;
        const bool lat = u < 128; const int b = (u & 127) >> 4, e = u & 15;
        const int n = lat ? SEQ : CTXL, cap = lat ? CAPL : CAPC;
        const float* src = lat ? PL + ((size_t)b * NE + e) * SEQ : PC + ((size_t)b * NE + e) * CTXL;
        const int rowbase = lat ? b * SEQ : RL + b * CTXL;
        const int xgbase = e * rpe + (lat ? b * CAPL : NB * CAPL + b * CAPC);
        unsigned v[4];
#pragma unroll
        for (int i = 0; i < 4; ++i) { const int t = wave * 256 + i * 64 + lane; v[i] = t < n ? __float_as_uint(src[t]) : 0u; }
        unsigned prefix = 0u;
#pragma unroll 1
        for (int bit = 30; bit >= 0; --bit) {
            const unsigned cand = prefix | (1u << bit); int c = 0;
#pragma unroll
            for (int i = 0; i < 4; ++i) c += __popcll(__ballot(v[i] >= cand));
            LAS int* slot = cnt + (bit & 1) * 8;
            if (lane == 0) slot[wave] = c;
            __syncthreads();
            int tot = 0;
#pragma unroll
            for (int w = 0; w < 8; ++w) tot += slot[w];
            if (tot >= cap) prefix = cand;
        }
        int mg = 0, me = 0;
#pragma unroll
        for (int i = 0; i < 4; ++i) { mg += __popcll(__ballot(v[i] > prefix)); me += __popcll(__ballot(v[i] == prefix)); }
        if (lane == 0) { cnt[16 + wave] = mg; cnt[24 + wave] = me; }
        __syncthreads();
        int tg = 0, eqb = 0;
#pragma unroll
        for (int w = 0; w < 8; ++w) { tg += cnt[16 + w]; eqb += (w < wave) ? cnt[24 + w] : 0; }
        const int need = cap - tg;
        bool sel[4]; int ms = 0, eqseen = eqb;
#pragma unroll
        for (int i = 0; i < 4; ++i) {
            const bool gt = v[i] > prefix, eq = v[i] == prefix;
            const unsigned long long meq = __ballot(eq);
            sel[i] = gt || (eq && (eqseen + __popcll(meq & lt)) < need);
            ms += __popcll(__ballot(sel[i])); eqseen += __popcll(meq);
        }
        if (lane == 0) cnt[32 + wave] = ms;
        __syncthreads();
        int slotbase = 0;
#pragma unroll
        for (int w = 0; w < 8; ++w) slotbase += (w < wave) ? cnt[32 + w] : 0;
#pragma unroll
        for (int i = 0; i < 4; ++i) {
            const unsigned long long msel = __ballot(sel[i]);
            const int slot = slotbase + __popcll(msel & lt), t = wave * 256 + i * 64 + lane;
            if (t < n) SEL[(size_t)(rowbase + t) * NE + e] = sel[i] ? slot : -1;
            if (sel[i]) { idxl[slot] = t; GATE[xgbase + slot] = __uint_as_float(v[i]); }
            slotbase += __popcll(msel);
        }
        __syncthreads();
        for (int slot = wave; slot < cap; slot += NWAVES) {
            const int t = idxl[slot];
#if FP8_MOE
            ((u32x4*)((unsigned char*)XG + (size_t)(xgbase + slot) * D))[lane] = ((const u32x4*)((const unsigned char*)XN + (size_t)(rowbase + t) * D))[lane];
#else
            const u32x4* s = (const u32x4*)(XN + (size_t)(rowbase + t) * D);
            u32x4* d = (u32x4*)(XG + (size_t)(xgbase + slot) * D);
            d[lane] = s[lane]; d[lane + 64] = s[lane + 64];
#endif
        }
        __syncthreads();
    }
}
template <int MODE>
__device__ __forceinline__ void ph_combine(const Ctx& a, int layer, int nrows) {
    const int lane = threadIdx.x & 63, gw = blockIdx.x * NWAVES + (threadIdx.x >> 6), NGW = gridDim.x * NWAVES;
    bf16_t* H = (bf16_t*)(a.ws() + WS_H); const int* SEL = (const int*)(a.ws() + WS_SEL); const unsigned char* Y = a.ws() + WS_Y;
    bf16_t* XN = (bf16_t*)(a.ws() + WS_XN);
    const int rpe = layer == 0 ? RPE0 : RPE1;
    f32x4 v[4], vn[4]; int sel = -1, seln = -1;
    if (gw < nrows) { load_row_bf16(H + (size_t)gw * D, lane, v); sel = SEL[(size_t)gw * NE + (lane & 15)]; }
    for (int row = gw; row < nrows; row += NGW) {
        const int rnx = row + NGW;
        if (rnx < nrows) { load_row_bf16(H + (size_t)rnx * D, lane, vn); seln = SEL[(size_t)rnx * NE + (lane & 15)]; }
        const int mr = mod_row(row);
        const float* mp = mod_ptr(a, layer, mr);
        const int off = row < RL ? (row >> 11) * CAPL : NB * CAPL + ((row - RL) >> 8) * CAPC;
        f32x4 acc[4];
#pragma unroll
        for (int j = 0; j < 4; ++j) acc[j] = (f32x4){0.f, 0.f, 0.f, 0.f};
        unsigned mask = (unsigned)(__ballot(sel >= 0) & 0xffffull);
        int yw[4][4];
#pragma unroll
        for (int k = 0; k < 4; ++k) {
            const bool on = mask != 0u; const int e = on ? __builtin_ctz(mask) : 0; mask = on ? (mask & (mask - 1u)) : 0u;
            const int sidx = __builtin_amdgcn_readlane(sel, e);
            const unsigned char* yr = Y + (size_t)(on ? (e * rpe + off + sidx) : 0) * D;
#pragma unroll
            for (int j = 0; j < 4; ++j) { const int w = __builtin_nontemporal_load((const int*)(yr + 4 * lane + 256 * j)); yw[k][j] = on ? w : 0; }
        }
#pragma unroll
        for (int k = 0; k < 4; ++k)
#pragma unroll
            for (int j = 0; j < 4; ++j) { const f32x2 lo = __builtin_amdgcn_cvt_pk_f32_fp8(yw[k][j], false), hi2 = __builtin_amdgcn_cvt_pk_f32_fp8(yw[k][j], true);
                acc[j].x += lo.x; acc[j].y += lo.y; acc[j].z += hi2.x; acc[j].w += hi2.y; }
        while (mask != 0u) {
            const int e = __builtin_ctz(mask); mask &= mask - 1u;
            const int sidx = __builtin_amdgcn_readlane(sel, e);
            const unsigned char* yr = Y + (size_t)(e * rpe + off + sidx) * D;
#pragma unroll
            for (int j = 0; j < 4; ++j) { const int w = *(const int*)(yr + 4 * lane + 256 * j); const f32x2 lo = __builtin_amdgcn_cvt_pk_f32_fp8(w, false), hi2 = __builtin_amdgcn_cvt_pk_f32_fp8(w, true);
                acc[j].x += lo.x; acc[j].y += lo.y; acc[j].z += hi2.x; acc[j].w += hi2.y; }
        }
#pragma unroll
        for (int j = 0; j < 4; ++j) { const f32x4 g2 = *(const f32x4*)(mp + M_G2 + 4 * lane + 256 * j); v[j] = v[j] + g2 * (acc[j] * (1.0f / Y_SCALE)); }
        if (MODE == 0) {
            store_row_bf16(H + (size_t)row * D, lane, v);
            const float* mp1 = mod_ptr(a, 1, mr);
            rms_mod(v, a.in(I_N1G) + D, mp1 + M_SH1, mp1 + M_SC1, lane);
            store_row_bf16(XN + (size_t)row * D, lane, v);
        } else {
            rms_mod(v, a.in(I_FG), nullptr, nullptr, lane);
            { float* po = a.out() + (size_t)row * D;
#pragma unroll
              for (int j = 0; j < 4; ++j) __builtin_nontemporal_store(v[j], (f32x4*)(po + 4 * lane + 256 * j)); }
        }
#pragma unroll
        for (int j = 0; j < 4; ++j) v[j] = vn[j];
        sel = seln;
    }
}

__device__ __forceinline__ void ph_qkv_naive(const Ctx& a, LAS unsigned char* lds) {
    const bf16_t* XN = (const bf16_t*)(a.ws() + WS_XN); float* T = (float*)(a.ws() + WS_TMPF);
    for (int t = blockIdx.x; t < (RT / 128) * 48; t += gridDim.x) {
        const int tm = t / 48, tn = t % 48;
        naive_tile(XN + (size_t)tm * 128 * D, D, a.in(I_WQKV) + tn * 64, 3 * D, D, lds,
                   [&](int r, int c, float v) { T[(size_t)(tm * 128 + r) * 3072 + tn * 64 + c] = v; });
    }
}
__device__ __forceinline__ void ph_rope_naive(const Ctx& a) {
    const float* T = (const float*)(a.ws() + WS_TMPF); const float* rope = (const float*)(a.ws() + WS_ROPE);
    bf16_t* Q = (bf16_t*)(a.ws() + WS_Q); bf16_t* Kb = (bf16_t*)(a.ws() + WS_K); bf16_t* V = (bf16_t*)(a.ws() + WS_V);
    const size_t total = (size_t)RT * 3072, nth = (size_t)gridDim.x * NTHREADS;
    for (size_t i = (size_t)blockIdx.x * NTHREADS + threadIdx.x; i < total; i += nth) {
        const int row = (int)(i / 3072), c = (int)(i % 3072);
        if (c >= 2048) { V[(size_t)row * D + (c - 2048)] = (bf16_t)f2bf(T[i]); continue; }
        const int d = c & 63; if ((d & 31) >= 16) continue;
        float x1 = T[i], x2 = T[i + 16];
        if (row < RL) {
            const int t = row & 2047, axis = d >> 5, f = d & 15, pos = axis == 0 ? (t >> 6) : (t & 63);
            const float cs = rope[pos * 16 + f], sn = rope[1024 + pos * 16 + f];
            const float o1 = x1 * cs - x2 * sn, o2 = x2 * cs + x1 * sn; x1 = o1; x2 = o2;
        }
        if (c < 1024) { Q[(size_t)row * D + c] = (bf16_t)f2bf(x1 * QSCALE); Q[(size_t)row * D + c + 16] = (bf16_t)f2bf(x2 * QSCALE); }
        else { Kb[(size_t)row * D + c - 1024] = (bf16_t)f2bf(x1); Kb[(size_t)row * D + c - 1024 + 16] = (bf16_t)f2bf(x2); }
    }
}
template <int NIT>
__device__ __forceinline__ void naive_attn_item(const Ctx& a, int row, int h, float lam, LAS float* qs, int lane) {
    const bf16_t* Q = (const bf16_t*)(a.ws() + WS_Q); const bf16_t* Kb = (const bf16_t*)(a.ws() + WS_K); const bf16_t* V = (const bf16_t*)(a.ws() + WS_V);
    bf16_t* ATT = (bf16_t*)(a.ws() + WS_ATT);
    const int b = row < RL ? (row >> 11) : ((row - RL) >> 8);
    const int lat0 = b * SEQ, ctx0 = RL + b * CTXL;
    { const unsigned qq = *(const unsigned*)(Q + (size_t)row * D + h * 128 + 2 * lane); qs[2 * lane] = bf_lo(qq); qs[2 * lane + 1] = bf_hi(qq); }
    __builtin_amdgcn_fence(__ATOMIC_RELEASE, "wavefront"); __builtin_amdgcn_wave_barrier(); __builtin_amdgcn_fence(__ATOMIC_ACQUIRE, "wavefront");
#define NA_SCORE(it, d0, d1) do { const int kk_ = (it) * 64 + lane; \
        const int krow_ = (NIT == 36) ? (kk_ < SEQ ? lat0 + kk_ : ctx0 + kk_ - SEQ) : ctx0 + kk_; \
        const u32x4* kp_ = (const u32x4*)(Kb + (size_t)krow_ * D + h * 128); d0 = 0.f; d1 = 0.f; \
        _Pragma("unroll 4") for (int c = 0; c < 16; ++c) { const u32x4 kv = kp_[c]; \
            const f32x4 qa = *(const LAS f32x4*)(qs + 8 * c), qb = *(const LAS f32x4*)(qs + 8 * c + 4); \
            const float dd = (qa.x * bf_lo(kv.x) + qa.y * bf_hi(kv.x)) + (qa.z * bf_lo(kv.y) + qa.w * bf_hi(kv.y)) \
                           + (qb.x * bf_lo(kv.z) + qb.y * bf_hi(kv.z)) + (qb.z * bf_lo(kv.w) + qb.w * bf_hi(kv.w)); \
            if (c < 8) d0 += dd; else d1 += dd; } } while (0)
    float m0 = -3.0e38f, m1 = -3.0e38f, l0 = 0.f, l1 = 0.f;
#pragma unroll 1
    for (int it = 0; it < NIT; ++it) {
        float d0, d1; NA_SCORE(it, d0, d1);
        const float n0 = fmaxf(m0, d0), n1 = fmaxf(m1, d1);
        l0 = l0 * exp2f(m0 - n0) + exp2f(d0 - n0); l1 = l1 * exp2f(m1 - n1) + exp2f(d1 - n1); m0 = n0; m1 = n1;
    }
    { const float g0 = wave_max(m0), g1 = wave_max(m1); l0 = wave_sum(l0 * exp2f(m0 - g0)); l1 = wave_sum(l1 * exp2f(m1 - g1)); m0 = g0; m1 = g1; }
    const float i0 = 1.f / l0, i1 = lam / l1;
    float o0 = 0.f, o1 = 0.f;
#pragma unroll 1
    for (int it = 0; it < NIT; ++it) {
        float d0, d1; NA_SCORE(it, d0, d1);
        const int wbits = __float_as_int(exp2f(d0 - m0) * i0 - exp2f(d1 - m1) * i1);
#pragma unroll 4
        for (int src = 0; src < 64; ++src) {
            const float wv = __int_as_float(__builtin_amdgcn_readlane(wbits, src));
            const int kk = it * 64 + src;
            const int krow = (NIT == 36) ? (kk < SEQ ? lat0 + kk : ctx0 + kk - SEQ) : ctx0 + kk;
            const unsigned vv = *(const unsigned*)(V + (size_t)krow * D + h * 128 + 2 * lane);
            o0 += wv * bf_lo(vv); o1 += wv * bf_hi(vv);
        }
    }
#undef NA_SCORE
    const float ss = wave_sum(o0 * o0 + o1 * o1);
    const float rstd = 1.0f / sqrtf(ss * (1.0f / 128.0f) + EPS);
    const float g0 = a.in(I_SUBG)[2 * lane], g1 = a.in(I_SUBG)[2 * lane + 1];
    *(unsigned*)(ATT + (size_t)row * D + h * 128 + 2 * lane) = pk2(o0 * rstd * g0 * (1.0f - LAMBDA_INIT0), o1 * rstd * g1 * (1.0f - LAMBDA_INIT0));
}
__device__ __forceinline__ float diff_lambda(const Ctx& a, int lane) {
    const float s1 = wave_sum(a.in(I_LQ1)[lane] * a.in(I_LK1)[lane]), s2 = wave_sum(a.in(I_LQ2)[lane] * a.in(I_LK2)[lane]);
    return expf(s1) - expf(s2) + LAMBDA_INIT0;
}
__device__ __forceinline__ void ph_attn_naive(const Ctx& a, LAS unsigned char* lds) {
    const int lane = threadIdx.x & 63, wave = threadIdx.x >> 6, gw = blockIdx.x * NWAVES + wave, NGW = gridDim.x * NWAVES;
    LAS float* qs = (LAS float*)lds + wave * 128;
    const float lam = diff_lambda(a, lane);
    for (int item = gw; item < RT * 8; item += NGW) {
        const int h = item / RT, row = item % RT;
        if (row < RL) naive_attn_item<36>(a, row, h, lam, qs, lane); else naive_attn_item<4>(a, row, h, lam, qs, lane);
    }
}
__device__ __forceinline__ void ph_wo_naive(const Ctx& a, LAS unsigned char* lds) {
    const bf16_t* ATT = (const bf16_t*)(a.ws() + WS_ATT); bf16_t* H = (bf16_t*)(a.ws() + WS_H);
    for (int t = blockIdx.x; t < (RT / 128) * 16; t += gridDim.x) {
        const int tm = t / 16, tn = t % 16;
        naive_tile(ATT + (size_t)tm * 128 * D, D, a.in(I_WO) + tn * 64, D, D, lds, [&](int r, int c, float v) {
            const int row = tm * 128 + r, col = tn * 64 + c;
            const float base = row < RL ? a.in(I_X)[(size_t)row * D + col] : a.in(I_CTX)[(size_t)(row - RL) * D + col];
            H[(size_t)row * D + col] = (bf16_t)f2bf(base + mod_ptr(a, 0, mod_row(row))[M_G1 + col] * v); });
    }
}
__device__ __forceinline__ void ph_gu_naive(const Ctx& a, LAS unsigned char* lds, int layer) {
    const int rpe = layer == 0 ? RPE0 : RPE1, tpe = (rpe / 128) * 88;
    const bf16_t* XG = (const bf16_t*)(a.ws() + WS_XG); float* T = (float*)(a.ws() + WS_TMPF);
    for (int t = blockIdx.x; t < NE * tpe; t += gridDim.x) {
        const int e = t / tpe, q = t % tpe, tm = q / 88, tn = q % 88;
        const size_t row0 = (size_t)e * rpe + tm * 128;
        naive_tile(XG + row0 * D, D, a.in(I_WGU) + (size_t)(layer * NE + e) * D * 2 * DE + tn * 64, 2 * DE, D, lds,
                   [&](int r, int c, float v) { T[(row0 + r) * (2 * DE) + tn * 64 + c] = v; });
    }
}
__device__ __forceinline__ void ph_swiglu_naive(const Ctx& a, int layer) {
    const int rpe = layer == 0 ? RPE0 : RPE1;
    const float* T = (const float*)(a.ws() + WS_TMPF); bf16_t* ACT = (bf16_t*)(a.ws() + WS_ACT);
    const size_t total = (size_t)NE * rpe * DE, nth = (size_t)gridDim.x * NTHREADS;
    for (size_t i = (size_t)blockIdx.x * NTHREADS + threadIdx.x; i < total; i += nth) {
        const size_t row = i / DE; const int j = (int)(i % DE);
        const float g = T[row * (2 * DE) + j], u = T[row * (2 * DE) + DE + j];
        ACT[i] = (bf16_t)f2bf(g / (1.f + expf(-g)) * u);
    }
}
__device__ __forceinline__ void ph_dn_naive(const Ctx& a, LAS unsigned char* lds, int layer) {
    const int rpe = layer == 0 ? RPE0 : RPE1, tpe = (rpe / 128) * 16;
    const bf16_t* ACT = (const bf16_t*)(a.ws() + WS_ACT); unsigned char* Y = a.ws() + WS_Y; const float* GATE = (const float*)(a.ws() + WS_GATE);
    for (int t = blockIdx.x; t < NE * tpe; t += gridDim.x) {
        const int e = t / tpe, q = t % tpe, tm = q / 16, tn = q % 16;
        const size_t row0 = (size_t)e * rpe + tm * 128;
        naive_tile(ACT + row0 * DE, DE, a.in(I_WDN) + (size_t)(layer * NE + e) * DE * D + tn * 64, D, DE, lds,
                   [&](int r, int c, float v) { Y[(row0 + r) * D + tn * 64 + c] = (unsigned char)(pk4_fp8(v * GATE[row0 + r] * Y_SCALE, 0.f, 0.f, 0.f) & 0xffu); });
    }
}
__device__ __forceinline__ void ph_win_naive(const Ctx& a, LAS unsigned char* lds) {
    const bf16_t* XN = (const bf16_t*)(a.ws() + WS_XN); bf16_t* YG = (bf16_t*)(a.ws() + WS_YG); bf16_t* XR = (bf16_t*)(a.ws() + WS_XR);
    const int TL = (RL / 128) * 32, TC = (RC / 128) * 16;
    for (int t = blockIdx.x; t < TL + TC; t += gridDim.x) {
        int tm, tn; if (t < TL) { tm = t / 32; tn = t % 32; } else { const int q = t - TL; tm = RL / 128 + q / 16; tn = 16 + q % 16; }
        naive_tile(XN + (size_t)tm * 128 * D, D, a.in(I_WIN) + tn * 64, 2 * D, D, lds, [&](int r, int c, float v) {
            const int row = tm * 128 + r, col = tn * 64 + c; const float x = v + a.in(I_BIN)[col];
            if (col < D) YG[(size_t)row * D + col] = (bf16_t)f2bf(gelu_tanh(x)); else XR[(size_t)row * D + col - D] = (bf16_t)f2bf(x); });
    }
}
__device__ __forceinline__ void ph_conv_naive(const Ctx& a) {
    const bf16_t* XR = (const bf16_t*)(a.ws() + WS_XR); bf16_t* XC = (bf16_t*)(a.ws() + WS_XC);
    const size_t total = (size_t)RT * D, nth = (size_t)gridDim.x * NTHREADS;
    for (size_t i = (size_t)blockIdx.x * NTHREADS + threadIdx.x; i < total; i += nth) {
        const int row = (int)(i >> 10), ch = (int)(i & 1023);
        const int t = row < RL ? (row & 2047) : ((row - RL) & 255), L = row < RL ? SEQ : CTXL;
        float v = a.in(I_CONVB)[ch];
#pragma unroll
        for (int j = 0; j < 4; ++j) { const int tt = t - 2 + j; if (tt >= 0 && tt < L) v += a.in(I_CONVW)[j * D + ch] * bf2f(XR[(size_t)(row - t + tt) * D + ch]); }
        XC[i] = (bf16_t)f2bf(v);
    }
}
__device__ __forceinline__ void ph_gates_naive(const Ctx& a, LAS unsigned char* lds) {
    const bf16_t* XC = (const bf16_t*)(a.ws() + WS_XC); float* T = (float*)(a.ws() + WS_TMPF);
    for (int t = blockIdx.x; t < 16 * (RT / 128) * 4; t += gridDim.x) {
        const int m = t / ((RT / 128) * 4), q = t % ((RT / 128) * 4), tm = q >> 2, tn = q & 3, d = m >> 3, kb = m & 7;
        naive_tile(XC + (size_t)tm * 128 * D + kb * 128, D, a.in(I_WGATES) + (size_t)m * 128 * 256 + tn * 64, 256, 128, lds,
                   [&](int r, int c, float v) { T[((size_t)d * RT + tm * 128 + r) * 2048 + kb * 256 + tn * 64 + c] = v; });
    }
}
__device__ __forceinline__ void ph_gate_elem_naive(const Ctx& a) {
    const float* T = (const float*)(a.ws() + WS_TMPF); const bf16_t* XC = (const bf16_t*)(a.ws() + WS_XC);
    bf16_t* LOGA = (bf16_t*)(a.ws() + WS_LOGA); unsigned char* BT = a.ws() + WS_BT;
    const size_t total = (size_t)2 * RT * D, nth = (size_t)gridDim.x * NTHREADS;
    for (size_t i = (size_t)blockIdx.x * NTHREADS + threadIdx.x; i < total; i += nth) {
        const int d = (int)(i / ((size_t)RT * D)); const size_t rc = i % ((size_t)RT * D); const int row = (int)(rc >> 10), ch = (int)(rc & 1023), kb = ch >> 7, cc = ch & 127;
        const float gr = T[((size_t)d * RT + row) * 2048 + kb * 256 + cc] + a.in(I_BGATES)[(d * 8 + kb) * 256 + cc];
        const float gi = T[((size_t)d * RT + row) * 2048 + kb * 256 + 128 + cc] + a.in(I_BGATES)[(d * 8 + kb) * 256 + 128 + cc];
        const float r = sigmoidf_(gr), ig = sigmoidf_(gi);
        const float lam = a.in(I_LAM)[d * D + ch];
        const float la = -8.0f * r * log1pf(expf(-lam));
        const float x = bf2f(XC[rc]);
        const float bt = sqrtf(-expm1f(2.0f * la)) * (ig * x);
        LOGA[i] = (bf16_t)f2bf(la * 1.4426950408889634f); BT[i] = (unsigned char)(pk4_fp8(bt * BT_SCALE, 0.f, 0.f, 0.f) & 0xffu);
    }
}
__device__ __forceinline__ void ph_wout_naive(const Ctx& a, LAS unsigned char* lds) {
    const bf16_t* HS = (const bf16_t*)(a.ws() + WS_HS); bf16_t* H = (bf16_t*)(a.ws() + WS_H);
    for (int t = blockIdx.x; t < (RL / 128) * 16; t += gridDim.x) {
        const int tm = t / 16, tn = t % 16;
        naive_tile(HS + (size_t)tm * 128 * D, D, a.in(I_WOUT) + tn * 64, D, D, lds, [&](int r, int c, float v) {
            const int row = tm * 128 + r, col = tn * 64 + c;
            H[(size_t)row * D + col] = (bf16_t)f2bf(bf2f(H[(size_t)row * D + col]) + mod_ptr(a, 1, row >> 11)[M_G1 + col] * v); });
    }
}

__device__ __forceinline__ int scan_row(int b, int dir, int c, int s) {
    const int p = c * SCH + s;
    if (dir == 0) return p < CTXL ? RL + b * CTXL + p : b * SEQ + (p - CTXL);
    return p < CTXL ? RL + b * CTXL + (CTXL - 1 - p) : b * SEQ + (SEQ - 1 - (p - CTXL));
}
__device__ __forceinline__ void ph_scan1(const Ctx& a) {
    const int lane = threadIdx.x & 63, gw = blockIdx.x * NWAVES + (threadIdx.x >> 6), NGW = gridDim.x * NWAVES;
    const bf16_t* LOGA = (const bf16_t*)(a.ws() + WS_LOGA); const unsigned char* BT = a.ws() + WS_BT;
    float* CP = (float*)(a.ws() + WS_CP); float* CB = (float*)(a.ws() + WS_CB);
    for (int item = gw; item < NB * 2 * NCH * 8; item += NGW) {
        const int cg = item & 7, c = (item >> 3) % NCH, bd = (item >> 3) / NCH, dir = bd & 1, b = bd >> 1;
        const int ch = cg * 128 + 2 * lane;
        float h0 = 0.f, h1 = 0.f, p0 = 0.f, p1 = 0.f;
#pragma unroll 1
        for (int sg = 0; sg < SCH; sg += 32) {
            unsigned la[32], bt[32];
#pragma unroll
            for (int i = 0; i < 32; ++i) { const size_t o = ((size_t)dir * RT + scan_row(b, dir, c, sg + i)) * D + ch; la[i] = *(const unsigned*)(LOGA + o); bt[i] = *(const unsigned short*)(BT + o); }
            asm volatile("" ::: "memory");
#pragma unroll
            for (int i = 0; i < 32; ++i) { const float l0 = bf_lo(la[i]), l1 = bf_hi(la[i]);
                const f32x2 bb = __builtin_amdgcn_cvt_pk_f32_fp8((int)bt[i], false);
                h0 = __builtin_amdgcn_exp2f(l0) * h0 + bb.x; h1 = __builtin_amdgcn_exp2f(l1) * h1 + bb.y; p0 += l0; p1 += l1; }
        }
        const size_t so = ((size_t)(b * 2 + dir) * NCH + c) * D + ch;
        *(f32x2*)(CP + so) = (f32x2){p0, p1}; *(f32x2*)(CB + so) = (f32x2){h0, h1};
    }
}
__device__ __forceinline__ void ph_scan2(const Ctx& a) {
    const int lane = threadIdx.x & 63, gw = blockIdx.x * NWAVES + (threadIdx.x >> 6), NGW = gridDim.x * NWAVES;
    const bf16_t* LOGA = (const bf16_t*)(a.ws() + WS_LOGA); const unsigned char* BT = a.ws() + WS_BT;
    const float* CP = (const float*)(a.ws() + WS_CP); const float* CB = (const float*)(a.ws() + WS_CB);
    const bf16_t* YG = (const bf16_t*)(a.ws() + WS_YG); bf16_t* HS = (bf16_t*)(a.ws() + WS_HS);
    constexpr int NLC = SEQ / SCH;
    for (int item = gw; item < NB * NLC * 8; item += NGW) {
        const int cg = item & 7, j = (item >> 3) % NLC, b = (item >> 3) / NLC;
        const int ch = cg * 128 + 2 * lane;
        const int cb = NCH_CTX + (NLC - 1 - j), cf = NCH_CTX + j;
        float hb0 = 0.f, hb1 = 0.f, hf0 = 0.f, hf1 = 0.f;
#pragma unroll 1
        for (int c0 = 0; c0 < NCH - 1; c0 += 12) {
            f32x2 pb[12], qb[12], pf[12], qf[12];
#pragma unroll
            for (int i = 0; i < 12; ++i) {
                const int c = c0 + i; const size_t sb_ = ((size_t)(b * 2 + 1) * NCH + c) * D + ch, sf_ = ((size_t)(b * 2 + 0) * NCH + c) * D + ch;
                const f32x2 z = (f32x2){0.f, 0.f};
                pb[i] = c < cb ? *(const f32x2*)(CP + sb_) : z; qb[i] = c < cb ? *(const f32x2*)(CB + sb_) : z;
                pf[i] = c < cf ? *(const f32x2*)(CP + sf_) : z; qf[i] = c < cf ? *(const f32x2*)(CB + sf_) : z;
            }
            asm volatile("" ::: "memory");
#pragma unroll
            for (int i = 0; i < 12; ++i) {
                hb0 = __builtin_amdgcn_exp2f(pb[i].x) * hb0 + qb[i].x; hb1 = __builtin_amdgcn_exp2f(pb[i].y) * hb1 + qb[i].y;
                hf0 = __builtin_amdgcn_exp2f(pf[i].x) * hf0 + qf[i].x; hf1 = __builtin_amdgcn_exp2f(pf[i].y) * hf1 + qf[i].y;
            }
        }
        float sb0[SCH], sb1[SCH];
#pragma unroll
        for (int sg = 0; sg < SCH; sg += 32) {
            unsigned la[32], bt[32];
#pragma unroll
            for (int i = 0; i < 32; ++i) { const size_t o = ((size_t)1 * RT + b * SEQ + j * SCH + (SCH - 1 - (sg + i))) * D + ch; la[i] = *(const unsigned*)(LOGA + o); bt[i] = *(const unsigned short*)(BT + o); }
            asm volatile("" ::: "memory");
#pragma unroll
            for (int i = 0; i < 32; ++i) {
                const f32x2 bb = __builtin_amdgcn_cvt_pk_f32_fp8((int)bt[i], false);
                hb0 = __builtin_amdgcn_exp2f(bf_lo(la[i])) * hb0 + bb.x; hb1 = __builtin_amdgcn_exp2f(bf_hi(la[i])) * hb1 + bb.y;
                sb0[SCH - 1 - (sg + i)] = hb0; sb1[SCH - 1 - (sg + i)] = hb1;
            }
        }
#pragma unroll
        for (int sg = 0; sg < SCH; sg += 16) {
            unsigned la[16], bt[16], yg[16];
#pragma unroll
            for (int i = 0; i < 16; ++i) { const size_t o = ((size_t)b * SEQ + j * SCH + sg + i) * D + ch; la[i] = __builtin_nontemporal_load((const unsigned*)(LOGA + o)); bt[i] = __builtin_nontemporal_load((const unsigned short*)(BT + o)); yg[i] = __builtin_nontemporal_load((const unsigned*)(YG + o)); }
            asm volatile("" ::: "memory");
#pragma unroll
            for (int i = 0; i < 16; ++i) {
                const size_t o = ((size_t)b * SEQ + j * SCH + sg + i) * D + ch;
                const f32x2 bb = __builtin_amdgcn_cvt_pk_f32_fp8((int)bt[i], false);
                hf0 = __builtin_amdgcn_exp2f(bf_lo(la[i])) * hf0 + bb.x; hf1 = __builtin_amdgcn_exp2f(bf_hi(la[i])) * hf1 + bb.y;
                *(unsigned*)(HS + o) = pk2(bf_lo(yg[i]) * ((hf0 + sb0[sg + i]) * (1.0f / BT_SCALE)), bf_hi(yg[i]) * ((hf1 + sb1[sg + i]) * (1.0f / BT_SCALE)));
            }
            asm volatile("" ::: "memory");
        }
    }
}
#define XB_TMO      128
#define XB_XCNT(j)  (256  + 64 * (j))
#define XB_XSUB(j)  (1280 + 64 * (j))
#define XB_XGEN(j)  (2304 + 64 * (j))
#define XB_TOP      3328
#define XB_TOPGEN   3392
#define XCD_BAR_WORDS 3456
#define XB_SPIN_CAP (1u << 18)

__device__ __forceinline__ unsigned xb_ld(unsigned* p)              { return __hip_atomic_load(p, __ATOMIC_RELAXED, __HIP_MEMORY_SCOPE_AGENT); }
__device__ __forceinline__ unsigned xb_add(unsigned* p, unsigned v) { return __hip_atomic_fetch_add(p, v, __ATOMIC_RELAXED, __HIP_MEMORY_SCOPE_AGENT); }
__device__ __forceinline__ unsigned xb_xcc_id() { return (unsigned)__builtin_amdgcn_s_getreg((3 << 11) | 20) & 0xFu; }
#define XB_SPIN(cond, bar) do { unsigned _sp = 0; while (cond) { __builtin_amdgcn_s_sleep(1); \
    if ((++_sp & 255u) == 0u) { if (xb_ld(&(bar)[XB_TMO])) break; if (_sp > XB_SPIN_CAP) { atomicAdd(&(bar)[XB_TMO], 1u); break; } } } } while (0)

struct XcdBarrier {
    unsigned* bar; unsigned x;
    volatile LAS unsigned* st;
};

__device__ __forceinline__ XcdBarrier xcd_barrier_post(unsigned* bar, volatile LAS unsigned* st) {
    XcdBarrier b; b.bar = bar; b.x = xb_xcc_id(); b.st = st;
    if (threadIdx.x == 0) (void)xb_add(&bar[XB_XCNT(b.x)], 1u);
    return b;
}
__device__ __forceinline__ void xcd_barrier_complete(unsigned* bar, unsigned x, unsigned& nloc, unsigned& nx) {
    const unsigned G = gridDim.x * gridDim.y * gridDim.z;
    unsigned sum, cnt, mine, sp = 0u;
    for (;;) {
        sum = 0u; cnt = 0u; mine = 0u;
#pragma unroll
        for (unsigned j = 0; j < 16; ++j) { const unsigned c = xb_ld(&bar[XB_XCNT(j)]); sum += c; cnt += (c > 0u) ? 1u : 0u; mine = (j == x) ? c : mine; }
        if (sum == G) break;
        __builtin_amdgcn_s_sleep(1);
        if ((++sp & 255u) == 0u) { if (xb_ld(&bar[XB_TMO])) break; if (sp > XB_SPIN_CAP) { atomicAdd(&bar[XB_TMO], 1u); break; } }
    }
    nloc = mine > 0u ? mine : 1u; nx = cnt > 0u ? cnt : 1u;
}

__device__ __forceinline__ void xcd_barrier(const XcdBarrier& b) {
    asm volatile("s_waitcnt vmcnt(0)" ::: "memory");
    __syncthreads();
    if (threadIdx.x == 0) {
        unsigned* bar = b.bar;
        __builtin_amdgcn_s_waitcnt(0);
        unsigned nloc = b.st[0], nx = b.st[1];
        if (nloc == 0u) { xcd_barrier_complete(bar, b.x, nloc, nx); b.st[0] = nloc; b.st[1] = nx; }
        const unsigned old = xb_add(&bar[XB_XSUB(b.x)], 1u);
        const unsigned gen = old / nloc;
        if (old + 1u == (gen + 1u) * nloc) {
            __builtin_amdgcn_fence(__ATOMIC_RELEASE, "agent");
            asm volatile("s_waitcnt vmcnt(0)" ::: "memory");
            const unsigned og = xb_add(&bar[XB_TOP], 1u);
            const unsigned tg = og / nx;
            if (og + 1u == (tg + 1u) * nx) xb_add(&bar[XB_TOPGEN], 1u);
            else XB_SPIN(xb_ld(&bar[XB_TOPGEN]) == tg, bar);
            __builtin_amdgcn_fence(__ATOMIC_ACQUIRE, "agent");
            xb_add(&bar[XB_XGEN(b.x)], 1u);
            asm volatile("s_waitcnt vmcnt(0)" ::: "memory");
        } else {
            XB_SPIN(xb_ld(&bar[XB_XGEN(b.x)]) == gen, bar);
            __builtin_amdgcn_fence(__ATOMIC_ACQUIRE, "agent");
            asm volatile("s_waitcnt vmcnt(0)" ::: "memory");
        }
    }
    __syncthreads();
}

__device__ __forceinline__ int xcd_remap(long L, int n) { const int q = n / 8, r = n % 8, xcd = (int)(L % 8), off = (int)(L / 8); return (xcd < r ? xcd * (q + 1) : r * (q + 1) + (xcd - r) * q) + off; }
template <class Map> struct ListOrder {
    int nunits, G, c; Map map;
    __device__ __forceinline__ bool next(int i, pg8::Unit& u) const { const long L = (long)i * G + c; if (L >= nunits) return false; map(xcd_remap(L, nunits), u); return true; }
    __device__ __forceinline__ void a_ready(const pg8::Unit&) const {}
    __device__ __forceinline__ void done(const pg8::Unit&) const {}
};
#ifndef WGMG
#define WGMG 8
#endif
struct MapGrid { int nN; __device__ __forceinline__ void operator()(int w, pg8::Unit& u) const { const int nig = WGMG * nN; u.pm = (w / nig) * WGMG + (w % nig) % WGMG; u.pn = (w % nig) / WGMG; } };
struct MapMoe { int PM, NT; __device__ __forceinline__ void operator()(int w, pg8::Unit& u) const { const int per = PM * NT, e = w / per, rem = w % per; u.pm = e * PM + rem % PM; u.pn = e * NT + rem / PM; } };
struct MapWin { __device__ __forceinline__ void operator()(int w, pg8::Unit& u) const { if (w < 512) { u.pm = (w / 64) * 8 + (w % 64) % 8; u.pn = (w % 64) / 8; } else { const int q = w - 512; u.pm = 64 + q % 8; u.pn = 4 + q / 8; } } };

typedef pg8::f32x4 pf4;
__device__ __forceinline__ float fast_exp(float x) { return __builtin_amdgcn_exp2f(x * 1.4426950408889634f); }

struct EpiQKV {
    static constexpr bool PERM = true, AFTER_DRAIN = false;
    bf16_t* Q; const LAS float* rope;
    __device__ __forceinline__ void operator()(const pf4 (&acc)[2][2][4][2], const pg8::Unit& u, int wr, int wc, int fr, int fq) const {
        const int sec = u.pn >> 2; bf16_t* base = Q + (size_t)sec * ((WS_K - WS_Q) / 2);
        const bool lat = u.pm < 64, dorope = sec < 2 && lat; const int axis = wc & 1;
        const bool upper = fq >= 2;
        const int row0 = u.pm * 256 + wr * 64 + fr, col0 = (u.pn & 3) * 256 + wc * 32 + 8 * fq;
        const float sc = sec == 0 ? QSCALE : 1.0f;
#pragma unroll
        for (int ai = 0; ai < 2; ++ai)
#pragma unroll
            for (int m = 0; m < 4; ++m) {
                const int row = row0 + ai * 128 + m * 16;
                pf4 cs[2], sn[2];
#pragma unroll
                for (int n = 0; n < 2; ++n) { cs[n] = (pf4){1.f, 1.f, 1.f, 1.f}; sn[n] = (pf4){0.f, 0.f, 0.f, 0.f}; }
                if (dorope) { const int t = row & 2047, pos = axis ? (t & 63) : (t >> 6); const LAS float* rp = rope + pos * 16 + 8 * (fq & 1);
#pragma unroll
                    for (int n = 0; n < 2; ++n) { cs[n] = *(const LAS pf4*)(rp + 4 * n); sn[n] = *(const LAS pf4*)(rp + 1024 + 4 * n); } }
#pragma unroll
                for (int bj = 0; bj < 2; ++bj) {
                    pf4 o[2];
#pragma unroll
                    for (int n = 0; n < 2; ++n)
#pragma unroll
                        for (int j = 0; j < 4; ++j) {
                            const float own = acc[ai][bj][m][n][j];
                            float v = own;
                            if (dorope) {
                                const auto rr = __builtin_amdgcn_permlane32_swap(__float_as_uint(own), __float_as_uint(own), false, false);
                                const float other = __uint_as_float(upper ? rr[0] : rr[1]);
                                v = upper ? (own * cs[n][j] + other * sn[n][j]) : (own * cs[n][j] - other * sn[n][j]);
                            }
                            o[n][j] = v * sc;
                        }
                    u32x4 w; w.x = pk2(o[0][0], o[0][1]); w.y = pk2(o[0][2], o[0][3]); w.z = pk2(o[1][0], o[1][1]); w.w = pk2(o[1][2], o[1][3]);
                    st16_wt(base + (size_t)row * D + col0 + bj * 128, w);
                }
            }
    }
};
struct EpiResid {
    static constexpr bool PERM = true, AFTER_DRAIN = false;
    bf16_t* H; const float* x; const float* ctx; const float* mod; int layer;
    __device__ __forceinline__ void operator()(const pf4 (&acc)[2][2][4][2], const pg8::Unit& u, int wr, int wc, int fr, int fq) const {
        const bool lat = u.pm < 64;
        const float* xb = lat ? x + (size_t)u.pm * 256 * D : ctx + (size_t)(u.pm - 64) * 256 * D;
        const float* g = mod + (size_t)(layer * 9 + (lat ? (u.pm >> 3) : 8)) * 6144 + M_G1;
        bf16_t* out = H + (size_t)u.pm * 256 * D;
        const int r0 = wr * 64 + fr, col0 = u.pn * 256 + wc * 32 + 8 * fq;
        pf4 gv[2][2];
#pragma unroll
        for (int bj = 0; bj < 2; ++bj)
#pragma unroll
            for (int n = 0; n < 2; ++n) gv[bj][n] = *(const pf4*)(g + col0 + bj * 128 + 4 * n);
#pragma unroll
        for (int it = 0; it < 8; ++it) {
            const int ai = it >> 2, m = it & 3;
            const size_t ro = (size_t)(r0 + ai * 128 + m * 16) * D + col0;
#pragma unroll
            for (int bj = 0; bj < 2; ++bj) {
                pf4 b0, b1;
                if (layer == 0) { b0 = *(const pf4*)(xb + ro + bj * 128); b1 = *(const pf4*)(xb + ro + bj * 128 + 4); }
                else { const u32x4 hb = *(const u32x4*)(out + ro + bj * 128); b0 = (pf4){bf_lo(hb.x), bf_hi(hb.x), bf_lo(hb.y), bf_hi(hb.y)}; b1 = (pf4){bf_lo(hb.z), bf_hi(hb.z), bf_lo(hb.w), bf_hi(hb.w)}; }
                const pf4 o0 = b0 + gv[bj][0] * acc[ai][bj][m][0], o1 = b1 + gv[bj][1] * acc[ai][bj][m][1];
                u32x4 w; w.x = pk2(o0[0], o0[1]); w.y = pk2(o0[2], o0[3]); w.z = pk2(o1[0], o1[1]); w.w = pk2(o1[2], o1[3]);
                st16_wt(out + ro + bj * 128, w);
            }
        }
    }
};
struct EpiSwiGLU {
    static constexpr bool PERM = true, AFTER_DRAIN = false;
    bf16_t* ACT;
    __device__ __forceinline__ void operator()(const pf4 (&acc)[2][2][4][2], const pg8::Unit& u, int wr, int wc, int fr, int fq) const {
        const int ct = u.pn % 22;
        bf16_t* p0 = ACT + (size_t)(u.pm * 256 + wr * 64 + fr) * DE + ct * 128 + wc * 32 + 8 * fq;
#pragma unroll
        for (int ai = 0; ai < 2; ++ai)
#pragma unroll
            for (int m = 0; m < 4; ++m) {
                float o[8];
#pragma unroll
                for (int n = 0; n < 2; ++n)
#pragma unroll
                    for (int j = 0; j < 4; ++j) { const float g = acc[ai][0][m][n][j], uu = acc[ai][1][m][n][j]; o[n * 4 + j] = g * __builtin_amdgcn_rcpf(1.0f + fast_exp(-g)) * uu; }
                u32x4 w; w.x = pk2(o[0], o[1]); w.y = pk2(o[2], o[3]); w.z = pk2(o[4], o[5]); w.w = pk2(o[6], o[7]);
                *(u32x4*)(p0 + (size_t)(ai * 128 + m * 16) * DE) = w;
            }
    }
};
struct EpiDown {
    static constexpr bool PERM = true, AFTER_DRAIN = false;
    unsigned char* Y; const float* GATE;
    __device__ __forceinline__ void operator()(const pf4 (&acc)[2][2][4][2], const pg8::Unit& u, int wr, int wc, int fr, int fq) const {
        const int row0 = u.pm * 256 + wr * 64 + fr, col0 = (u.pn & 3) * 256 + wc * 32 + 8 * fq;
        float gts[8];
#pragma unroll
        for (int i = 0; i < 8; ++i) gts[i] = GATE[row0 + (i >> 2) * 128 + (i & 3) * 16] * Y_SCALE;
#pragma unroll
        for (int ai = 0; ai < 2; ++ai)
#pragma unroll
            for (int m = 0; m < 4; ++m) {
                const int row = row0 + ai * 128 + m * 16; const float gt = gts[ai * 4 + m];
#pragma unroll
                for (int bj = 0; bj < 2; ++bj) {
                    const pf4 v0 = acc[ai][bj][m][0] * gt, v1 = acc[ai][bj][m][1] * gt;
                    u32x2 w; w.x = pk4_fp8(v0[0], v0[1], v0[2], v0[3]); w.y = pk4_fp8(v1[0], v1[1], v1[2], v1[3]);
                    st8_wt(Y + (size_t)row * D + col0 + bj * 128, w);
                }
            }
    }
};
struct EpiWin {
    static constexpr bool PERM = true, AFTER_DRAIN = false;
    bf16_t *YG, *XR; const float* bin;
    __device__ __forceinline__ void operator()(const pf4 (&acc)[2][2][4][2], const pg8::Unit& u, int wr, int wc, int fr, int fq) const {
        const bool yb = u.pn < 4; bf16_t* base = yb ? YG : XR;
        const int row0 = u.pm * 256 + wr * 64 + fr, colg = u.pn * 256 + wc * 32 + 8 * fq, col0 = (u.pn & 3) * 256 + wc * 32 + 8 * fq;
        pf4 bv[2][2];
#pragma unroll
        for (int bj = 0; bj < 2; ++bj)
#pragma unroll
            for (int n = 0; n < 2; ++n) bv[bj][n] = *(const pf4*)(bin + colg + bj * 128 + 4 * n);
#pragma unroll
        for (int ai = 0; ai < 2; ++ai)
#pragma unroll
            for (int m = 0; m < 4; ++m) {
                const int row = row0 + ai * 128 + m * 16;
#pragma unroll
                for (int bj = 0; bj < 2; ++bj) {
                    pf4 v0 = acc[ai][bj][m][0] + bv[bj][0], v1 = acc[ai][bj][m][1] + bv[bj][1];
                    if (yb) {
#pragma unroll
                        for (int j = 0; j < 4; ++j) {
                            { const float x = v0[j], uu = 0.7978845608028654f * (x + 0.044715f * x * x * x); v0[j] = x * __builtin_amdgcn_rcpf(1.0f + fast_exp(-2.0f * uu)); }
                            { const float x = v1[j], uu = 0.7978845608028654f * (x + 0.044715f * x * x * x); v1[j] = x * __builtin_amdgcn_rcpf(1.0f + fast_exp(-2.0f * uu)); }
                        }
                    }
                    u32x4 w; w.x = pk2(v0[0], v0[1]); w.y = pk2(v0[2], v0[3]); w.z = pk2(v1[0], v1[1]); w.w = pk2(v1[2], v1[3]);
                    st16_wt(base + (size_t)row * D + col0 + bj * 128, w);
                }
            }
    }
};

#ifndef DENSE_ALIGN
#define DENSE_ALIGN true
#endif
#ifndef DENSE_SP2
#define DENSE_SP2 true
#endif
__device__ __forceinline__ void stagger_start(int ticks) {
    if (ticks > 0 && ((blockIdx.x >> 3) & 1)) { const unsigned long long t0 = __builtin_amdgcn_s_memrealtime(); while (__builtin_amdgcn_s_memrealtime() - t0 < (unsigned long long)ticks) __builtin_amdgcn_s_sleep(8); }
}
#ifndef STG_QKV
#define STG_QKV 0
#endif
#ifndef STG_GU
#define STG_GU 0
#endif
#ifndef STG_DN
#define STG_DN 0
#endif
#ifndef STG_WIN
#define STG_WIN 0
#endif
#ifndef STG_WO
#define STG_WO 0
#endif
#define PG8_RUN(EPI, SCHED, g, S, E) pg8::gemm_phase<EPI, SCHED, DENSE_ALIGN, DENSE_SP2>((PG8_LAS unsigned char*)lds, g, S, E)

__device__ __forceinline__ void ph_qkv_fast(const Ctx& a, LAS unsigned char* lds) {
    unsigned char* ws = a.ws();
    pg8::Gemm g{(const bf16_t*)(ws + WS_XN), (const bf16_t*)(ws + WS_WQKV), RT, 3 * D, D};
    const int Gq = gemm_groups(72 * 12, (int)gridDim.x);
    if ((int)blockIdx.x >= Gq) { cvt8_run(a, 0, CV0_QKV + ((int)blockIdx.x - Gq), (int)gridDim.x - Gq, CV0_QKV + CVQ_QKV, lds); return; }
    ListOrder<MapGrid> S{72 * 12, Gq, (int)blockIdx.x, MapGrid{12}};
    static_assert(WS_V - WS_K == WS_K - WS_Q, "Q|K|V spacing");
    LAS float* rl = (LAS float*)(lds + ROPE_LDS);
    { const float* rg = (const float*)(ws + WS_ROPE); for (int i = threadIdx.x; i < 2048; i += NTHREADS) rl[i] = rg[i]; }
    __syncthreads();
    EpiQKV E{(bf16_t*)(ws + WS_Q), rl};
    stagger_start(STG_QKV);
    PG8_RUN(EpiQKV, ListOrder<MapGrid>, g, S, E);
    if (Gq == (int)gridDim.x) cvt8_tail(a, lds, 72 * 12, Gq, (int)blockIdx.x, 0, CV0_QKV, CVQ_QKV);
}
__device__ __forceinline__ void ph_wo_fast(const Ctx& a, LAS unsigned char* lds) {
    unsigned char* ws = a.ws();
    pg8::Gemm g{(const bf16_t*)(ws + WS_ATT), (const bf16_t*)(ws + WS_WO), RT, D, D};
    const int Gq = gemm_groups(72 * 4, (int)gridDim.x);
    if ((int)blockIdx.x >= Gq) { cvt8_run(a, 0, CV0_WO + ((int)blockIdx.x - Gq), (int)gridDim.x - Gq, CV0_WO + CVQ_WO, lds); return; }
    ListOrder<MapGrid> S{72 * 4, Gq, (int)blockIdx.x, MapGrid{4}};
    EpiResid E{(bf16_t*)(ws + WS_H), a.in(I_X), a.in(I_CTX), (const float*)(ws + WS_MOD), 0};
    stagger_start(STG_WO);
    PG8_RUN(EpiResid, ListOrder<MapGrid>, g, S, E);
    if (Gq == (int)gridDim.x) cvt8_tail(a, lds, 72 * 4, Gq, (int)blockIdx.x, 0, CV0_WO, CVQ_WO);
}
__device__ __forceinline__ void ph_wout_fast(const Ctx& a, LAS unsigned char* lds) {
    unsigned char* ws = a.ws();
    pg8::Gemm g{(const bf16_t*)(ws + WS_HS), (const bf16_t*)(ws + WS_WOUT), RL, D, D};
    ListOrder<MapGrid> S{64 * 4, (int)gridDim.x, (int)blockIdx.x, MapGrid{4}};
    EpiResid E{(bf16_t*)(ws + WS_H), nullptr, nullptr, (const float*)(ws + WS_MOD), 1};
    PG8_RUN(EpiResid, ListOrder<MapGrid>, g, S, E);
}
#if FP8_MOE
struct EpiSwiGLU8 {
    static constexpr bool PERM = true, AFTER_DRAIN = false;
    unsigned char* ACT;
    __device__ __forceinline__ void operator()(const pf4 (&acc)[2][2][4][2], const pg8::Unit& u, int wr, int wc, int fr, int fq) const {
        const int ct = u.pn % 22;
        unsigned char* p0 = ACT + (size_t)(u.pm * 256 + wr * 64 + fr) * DE + ct * 128 + wc * 32 + 8 * fq;
#pragma unroll
        for (int ai = 0; ai < 2; ++ai)
#pragma unroll
            for (int m = 0; m < 4; ++m) {
                float o[8];
#pragma unroll
                for (int n = 0; n < 2; ++n)
#pragma unroll
                    for (int j = 0; j < 4; ++j) { const float g = acc[ai][0][m][n][j], uu = acc[ai][1][m][n][j]; o[n * 4 + j] = g * __builtin_amdgcn_rcpf(1.0f + fast_exp(-g)) * uu; }
                u32x2 w; w.x = pk4_fp8(o[0], o[1], o[2], o[3]); w.y = pk4_fp8(o[4], o[5], o[6], o[7]);
                st8_wt(p0 + (size_t)(ai * 128 + m * 16) * DE, w);
            }
    }
};
__device__ __forceinline__ void ph_gu_fast(const Ctx& a, LAS unsigned char* lds, int layer) {
    unsigned char* ws = a.ws(); const int PM = (layer == 0 ? RPE0 : RPE1) / 256;
    pg8::Gemm g{(const bf16_t*)(ws + WS_XG), (const bf16_t*)(ws + WS_WGU + (size_t)layer * (WGU_LAYER / 2)), NE * PM * 256, NE * 2 * DE, D / 2};
    ListOrder<MapMoe> S{NE * PM * 22, (int)gridDim.x, (int)blockIdx.x, MapMoe{PM, 22}};
    EpiSwiGLU8 E{ws + WS_ACT};
    stagger_start(STG_GU);
    pg8::gemm_phase<EpiSwiGLU8, ListOrder<MapMoe>, GU_ALIGN, true, 122>((PG8_LAS unsigned char*)lds, g, S, E);
    if (layer == 0) cvt8_tail(a, lds, NE * PM * 22, (int)gridDim.x, (int)blockIdx.x, 1, CV1_GU0, CVQ_GU0);
}
__device__ __forceinline__ void ph_dn_fast(const Ctx& a, LAS unsigned char* lds, int layer) {
    unsigned char* ws = a.ws(); const int PM = (layer == 0 ? RPE0 : RPE1) / 256;
    pg8::Gemm g{(const bf16_t*)(ws + WS_ACT), (const bf16_t*)(ws + WS_WDN + (size_t)layer * (WDN_LAYER / 2)), NE * PM * 256, NE * D, DE / 2};
    const int Gq = layer == 0 ? gemm_groups(NE * PM * 4, (int)gridDim.x) : (int)gridDim.x;
    if ((int)blockIdx.x >= Gq) { cvt8_run(a, 1, CV1_DN0 + ((int)blockIdx.x - Gq), (int)gridDim.x - Gq, CV1_DN0 + CVQ_DN0, lds); return; }
    ListOrder<MapMoe> S{NE * PM * 4, Gq, (int)blockIdx.x, MapMoe{PM, 4}};
    EpiDown E{ws + WS_Y, (const float*)(ws + WS_GATE)};
    stagger_start(STG_DN);
    pg8::gemm_phase<EpiDown, ListOrder<MapMoe>, DN_ALIGN, true, 121>((PG8_LAS unsigned char*)lds, g, S, E);
    if (layer == 0 && Gq == (int)gridDim.x) cvt8_tail(a, lds, NE * PM * 4, Gq, (int)blockIdx.x, 1, CV1_DN0, CVQ_DN0);
}
#else
__device__ __forceinline__ void ph_gu_fast(const Ctx& a, LAS unsigned char* lds, int layer) {
    unsigned char* ws = a.ws(); const int PM = (layer == 0 ? RPE0 : RPE1) / 256;
    pg8::Gemm g{(const bf16_t*)(ws + WS_XG), (const bf16_t*)(ws + WS_WGU + (size_t)layer * WGU_LAYER), NE * PM * 256, NE * 2 * DE, D};
    ListOrder<MapMoe> S{NE * PM * 22, (int)gridDim.x, (int)blockIdx.x, MapMoe{PM, 22}};
    EpiSwiGLU E{(bf16_t*)(ws + WS_ACT)};
    PG8_RUN(EpiSwiGLU, ListOrder<MapMoe>, g, S, E);
}
__device__ __forceinline__ void ph_dn_fast(const Ctx& a, LAS unsigned char* lds, int layer) {
    unsigned char* ws = a.ws(); const int PM = (layer == 0 ? RPE0 : RPE1) / 256;
    pg8::Gemm g{(const bf16_t*)(ws + WS_ACT), (const bf16_t*)(ws + WS_WDN + (size_t)layer * WDN_LAYER), NE * PM * 256, NE * D, DE};
    const int Gq = layer == 0 ? gemm_groups(NE * PM * 4, (int)gridDim.x) : (int)gridDim.x;
    if ((int)blockIdx.x >= Gq) { cvt8_run(a, 1, CV1_DN0 + ((int)blockIdx.x - Gq), (int)gridDim.x - Gq, CV1_DN0 + CVQ_DN0, lds); return; }
    ListOrder<MapMoe> S{NE * PM * 4, Gq, (int)blockIdx.x, MapMoe{PM, 4}};
    EpiDown E{ws + WS_Y, (const float*)(ws + WS_GATE)};
    PG8_RUN(EpiDown, ListOrder<MapMoe>, g, S, E);
}
#endif
__device__ __forceinline__ void ph_win_fast(const Ctx& a, LAS unsigned char* lds) {
    unsigned char* ws = a.ws();
    pg8::Gemm g{(const bf16_t*)(ws + WS_XN), (const bf16_t*)(ws + WS_WIN), RT, 2 * D, D};
    const int Gq = gemm_groups(512 + 32, (int)gridDim.x);
    if ((int)blockIdx.x >= Gq) { cvt8_run(a, 1, CV1_WIN + ((int)blockIdx.x - Gq), (int)gridDim.x - Gq, CV1_WIN + CVQ_WIN, lds); return; }
    ListOrder<MapWin> S{512 + 32, Gq, (int)blockIdx.x, MapWin{}};
    EpiWin E{(bf16_t*)(ws + WS_YG), (bf16_t*)(ws + WS_XR), a.in(I_BIN)};
    stagger_start(STG_WIN);
    PG8_RUN(EpiWin, ListOrder<MapWin>, g, S, E);
    if (Gq == (int)gridDim.x) cvt8_tail(a, lds, 512 + 32, Gq, (int)blockIdx.x, 1, CV1_WIN, CVQ_WIN);
}

namespace fa {
using bf16x8 = __attribute__((ext_vector_type(8))) short;
using s16x4  = __attribute__((ext_vector_type(4))) short;
using f32x16 = __attribute__((ext_vector_type(16))) float;
using u32x4v = __attribute__((ext_vector_type(4))) unsigned;
constexpr int SHM_V = 64 * 128 * 2, SHM_K = 64 * 128 * 2;
#ifndef ATT_THR
#define ATT_THR 11.5f
#endif
constexpr float THR_L2 = ATT_THR;
#define KSWZ(row, colB) ((row) * 256 + ((colB) ^ (((row) & 7) << 4)))
#define SBAR() __builtin_amdgcn_sched_barrier(0)
__device__ __forceinline__ int crow(int r, int hi) { return (r & 3) + 8 * (r >> 2) + 4 * hi; }
__device__ __forceinline__ unsigned cvtpk(float lo, float hi) { unsigned r; asm volatile("v_cvt_pk_bf16_f32 %0, %1, %2" : "=v"(r) : "v"(lo), "v"(hi)); return r; }
__device__ __forceinline__ void partialSM(f32x16& p0, f32x16& p1, float& m_reg, float& mn, float& alpha) {
  float pmax = p0[0];
#pragma unroll
  for (int r = 1; r < 16; ++r) pmax = fmaxf(pmax, p0[r]);
#pragma unroll
  for (int r = 0; r < 16; ++r) pmax = fmaxf(pmax, p1[r]);
  { auto rr = __builtin_amdgcn_permlane32_swap(__float_as_uint(pmax), __float_as_uint(pmax), false, false);
    pmax = fmaxf(__uint_as_float(rr[0]), __uint_as_float(rr[1])); }
  if (__builtin_expect(__all(pmax - m_reg <= THR_L2), 1)) { mn = m_reg; alpha = 1.f; }
  else { mn = fmaxf(m_reg, pmax); alpha = __builtin_amdgcn_exp2f(m_reg - mn); m_reg = mn; }
  { typedef float f2_t __attribute__((ext_vector_type(2))); const f2_t mn2 = {mn, mn};
#pragma unroll
    for (int r = 0; r < 16; r += 2) { const f2_t a_ = (f2_t){p0[r], p0[r + 1]} - mn2; p0[r] = a_.x; p0[r + 1] = a_.y; const f2_t b_ = (f2_t){p1[r], p1[r + 1]} - mn2; p1[r] = b_.x; p1[r + 1] = b_.y; } }
#pragma unroll
  for (int r = 0; r < 16; ++r) p0[r] = __builtin_amdgcn_exp2f(p0[r]);
}
__device__ __forceinline__ void finishSM(f32x16& p0, f32x16& p1, float alpha, float& l_reg, bf16x8& pa0, bf16x8& pa1, bf16x8& pa2, bf16x8& pa3) {
#pragma unroll
  for (int r = 0; r < 16; ++r) p1[r] = __builtin_amdgcn_exp2f(p1[r]);
  float ps = 0;
#pragma unroll
  for (int r = 0; r < 16; ++r) ps += p0[r];
#pragma unroll
  for (int r = 0; r < 16; ++r) ps += p1[r];
  { auto rr = __builtin_amdgcn_permlane32_swap(__float_as_uint(ps), __float_as_uint(ps), false, false);
    ps = __uint_as_float(rr[0]) + __uint_as_float(rr[1]); }
  l_reg = l_reg * alpha + ps;
#define PK4(P, BASE, OUT) do { unsigned a0 = cvtpk(P[BASE + 0], P[BASE + 1]), a1 = cvtpk(P[BASE + 2], P[BASE + 3]);   \
    unsigned b0 = cvtpk(P[BASE + 4], P[BASE + 5]), b1 = cvtpk(P[BASE + 6], P[BASE + 7]);                              \
    auto r0 = __builtin_amdgcn_permlane32_swap(a0, b0, false, false); auto r1 = __builtin_amdgcn_permlane32_swap(a1, b1, false, false); \
    u32x4v w = {r0[0], r1[0], r0[1], r1[1]}; OUT = *reinterpret_cast<bf16x8*>(&w); } while (0)
  PK4(p0, 0, pa0); PK4(p0, 8, pa1); PK4(p1, 0, pa2); PK4(p1, 8, pa3);
#undef PK4
}
__device__ __forceinline__ void qkt(f32x16& p0, f32x16& p1, const LAS char* Ks, const bf16x8* qr, int r32, int hi, int s) {
  p0 = f32x16{}; p1 = f32x16{};
#pragma unroll
  for (int d0 = 0; d0 < 4; ++d0) { const int cb = (s * 64 + d0 * 16 + hi * 8) * 2;
    const bf16x8 b0 = *reinterpret_cast<const LAS bf16x8*>(Ks + KSWZ(r32, cb));
    const bf16x8 b1 = *reinterpret_cast<const LAS bf16x8*>(Ks + KSWZ(32 + r32, cb));
    p0 = __builtin_amdgcn_mfma_f32_32x32x16_bf16(b0, qr[d0], p0, 0, 0, 0);
    p1 = __builtin_amdgcn_mfma_f32_32x32x16_bf16(b1, qr[d0], p1, 0, 0, 0); }
}
__device__ __forceinline__ int v_st(int k, int c) { const int kk = (k & ~0xC) | ((k & 4) << 1) | ((k & 8) >> 1); return ((kk >> 3) * 4 + (c >> 5)) * 512 + ((kk & 7) * 32 + (c & 31)) * 2; }
__device__ __forceinline__ int v_rd_base(int lane) { return ((lane & 3) << 3) | (((lane >> 2) & 3) << 6) | (((lane >> 4) & 1) << 5) | (((lane >> 5) & 1) << 8); }
constexpr int v_rd_off(int d0, int ks, int half) { return d0 * 512 + ks * 4096 + half * 2048; }
template <int OFF> __device__ __forceinline__ s16x4 tr_read(int vb) {
  s16x4 r; asm volatile("ds_read_b64_tr_b16 %0, %1 offset:%2" : "=&v"(r) : "v"(vb), "i"(OFF) : "memory"); return r;
}
template <int D0> __device__ __forceinline__ void pv_one(f32x16& od, int vb, bf16x8 pa0, bf16x8 pa1, bf16x8 pa2, bf16x8 pa3) {
  const s16x4 l0 = tr_read<v_rd_off(D0, 0, 0)>(vb), h0 = tr_read<v_rd_off(D0, 0, 1)>(vb), l1 = tr_read<v_rd_off(D0, 1, 0)>(vb), h1 = tr_read<v_rd_off(D0, 1, 1)>(vb);
  const s16x4 l2 = tr_read<v_rd_off(D0, 2, 0)>(vb), h2 = tr_read<v_rd_off(D0, 2, 1)>(vb), l3 = tr_read<v_rd_off(D0, 3, 0)>(vb), h3 = tr_read<v_rd_off(D0, 3, 1)>(vb);
  asm volatile("s_waitcnt lgkmcnt(0)" ::: "memory"); SBAR();
#define PK(L, H) (bf16x8){L[0], L[1], L[2], L[3], H[0], H[1], H[2], H[3]}
  od = __builtin_amdgcn_mfma_f32_32x32x16_bf16(pa0, PK(l0, h0), od, 0, 0, 0);
  od = __builtin_amdgcn_mfma_f32_32x32x16_bf16(pa1, PK(l1, h1), od, 0, 0, 0);
  od = __builtin_amdgcn_mfma_f32_32x32x16_bf16(pa2, PK(l2, h2), od, 0, 0, 0);
  od = __builtin_amdgcn_mfma_f32_32x32x16_bf16(pa3, PK(l3, h3), od, 0, 0, 0);
#undef PK
}
__device__ __forceinline__ void pv_d0(f32x16* o, int vb, bf16x8 pa0, bf16x8 pa1, bf16x8 pa2, bf16x8 pa3) {
  pv_one<0>(o[0], vb, pa0, pa1, pa2, pa3); pv_one<1>(o[1], vb, pa0, pa1, pa2, pa3); pv_one<2>(o[2], vb, pa0, pa1, pa2, pa3); pv_one<3>(o[3], vb, pa0, pa1, pa2, pa3);
}

__device__ __forceinline__ int tile_row(bool latq, int b, int j) { return latq ? (j < 32 ? b * SEQ + 64 * j : RL + b * CTXL + 64 * (j - 32)) : RL + b * CTXL + 64 * j; }

__device__ __forceinline__ void attn_unit(const bf16_t* __restrict__ Qg, const bf16_t* __restrict__ Kg, const bf16_t* __restrict__ Vg, bf16_t* __restrict__ ATT,
                                          const float* subg, float lam, bool latq, int b, int h, int qrow0, LAS unsigned char* lds) {
  const int tid = threadIdx.x, wid = __builtin_amdgcn_readfirstlane(tid >> 6), lane = tid & 63, r32 = lane & 31, hi = lane >> 5, rg = wid >> 1, s = wid & 1;
  LAS char* V_lds = (LAS char*)lds; LAS char* K_lds = (LAS char*)lds + 2 * SHM_V;
  LAS float* ws = (LAS float*)(lds + 65536) + wid * 64; LAS float* li_l = ws; LAS float* al_l = ws + 32;
  const int NT = latq ? 36 : 4;
  float m_reg = -1e30f, l_reg = 0; f32x16 o[4] = {}; bf16x8 qr[4];
  const bf16_t* Qw = Qg + (size_t)(qrow0 + rg * 32 + r32) * D + h * 128 + s * 64 + hi * 8;
#pragma unroll
  for (int d0 = 0; d0 < 4; ++d0) qr[d0] = *reinterpret_cast<const bf16x8*>(Qw + d0 * 16);
  const int sr = tid >> 4, sc = (tid & 15) * 8, vst0 = v_st(sr, sc), vst1 = v_st(32 + sr, sc);
  const int vb0 = (int)(unsigned)(size_t)V_lds + v_rd_base(lane);
  const size_t hoff = (size_t)h * 128 + sc;
  struct { bf16x8 vs0, vs1, ks0, ks1; } sr_[2];
#define SLOAD(i, j) do { const size_t ro_ = (size_t)(tile_row(latq, b, (j)) + sr) * D + hoff; \
    sr_[i].vs0 = *reinterpret_cast<const bf16x8*>(Vg + ro_); sr_[i].vs1 = *reinterpret_cast<const bf16x8*>(Vg + ro_ + 32 * D); \
    sr_[i].ks0 = *reinterpret_cast<const bf16x8*>(Kg + ro_); sr_[i].ks1 = *reinterpret_cast<const bf16x8*>(Kg + ro_ + 32 * D); } while (0)
#define SWRITE(bb, i) do { *(LAS bf16x8*)(V_lds + (bb) * SHM_V + vst0) = sr_[i].vs0; *(LAS bf16x8*)(V_lds + (bb) * SHM_V + vst1) = sr_[i].vs1; const int kc = sc * 2; \
    *(LAS bf16x8*)(K_lds + (bb) * SHM_K + KSWZ(sr, kc)) = sr_[i].ks0; *(LAS bf16x8*)(K_lds + (bb) * SHM_K + KSWZ(32 + sr, kc)) = sr_[i].ks1; } while (0)
#define SWAIT() asm volatile("s_waitcnt vmcnt(4)" ::: "memory")
#define RESC(a_) do { if (__any((a_) < 1.f)) { if (hi == 0) al_l[r32] = (a_); asm volatile("s_waitcnt lgkmcnt(0)" ::: "memory"); \
    _Pragma("unroll") for (int d = 0; d < 4; ++d) _Pragma("unroll") for (int r = 0; r < 16; ++r) o[d][r] *= al_l[crow(r, hi)]; } } while (0)
  f32x16 pA0, pA1, pB0, pB1; float mnA, mnB, alA, alB; bf16x8 pa0, pa1, pa2, pa3;
  constexpr int SE = 0, SO = 1;
  SLOAD(SE, 0); asm volatile("s_waitcnt vmcnt(0)" ::: "memory"); SWRITE(0, SE); __syncthreads();
  qkt(pA0, pA1, K_lds, qr, r32, hi, s); partialSM(pA0, pA1, m_reg, mnA, alA);
  SLOAD(SO, 1); if (2 < NT) SLOAD(SE, 2);
  SWAIT(); SWRITE(1, SO); __syncthreads();
  for (int j = 1; j + 1 < NT; j += 2) {
    SBAR(); qkt(pB0, pB1, K_lds + SHM_K, qr, r32, hi, s);
    finishSM(pA0, pA1, alA, l_reg, pa0, pa1, pa2, pa3); SBAR();
    SLOAD(SO, j + 2); SBAR();
    pv_d0(o, vb0, pa0, pa1, pa2, pa3); partialSM(pB0, pB1, m_reg, mnB, alB);
    __syncthreads(); SWAIT(); SWRITE(0, SE);
    RESC(alB); __syncthreads();
    SBAR(); qkt(pA0, pA1, K_lds, qr, r32, hi, s);
    finishSM(pB0, pB1, alB, l_reg, pa0, pa1, pa2, pa3); SBAR();
    if (j + 3 < NT) SLOAD(SE, j + 3); SBAR();
    pv_d0(o, vb0 + SHM_V, pa0, pa1, pa2, pa3); partialSM(pA0, pA1, m_reg, mnA, alA);
    __syncthreads(); SWAIT(); SWRITE(1, SO);
    RESC(alA); __syncthreads();
  }
  SBAR(); qkt(pB0, pB1, K_lds + SHM_K, qr, r32, hi, s);
  finishSM(pA0, pA1, alA, l_reg, pa0, pa1, pa2, pa3); SBAR();
  pv_d0(o, vb0, pa0, pa1, pa2, pa3); partialSM(pB0, pB1, m_reg, mnB, alB);
  __syncthreads(); RESC(alB);
  finishSM(pB0, pB1, alB, l_reg, pa0, pa1, pa2, pa3); SBAR();
  pv_d0(o, vb0 + SHM_V, pa0, pa1, pa2, pa3);
#undef SLOAD
#undef SWRITE
#undef SWAIT
#undef RESC
  if (hi == 0) li_l[r32] = l_reg;
  asm volatile("s_waitcnt lgkmcnt(0)" ::: "memory");
  float rli[16];
#pragma unroll
  for (int r = 0; r < 16; ++r) rli[r] = __builtin_amdgcn_rcpf(li_l[crow(r, hi)]);
  __syncthreads();
  LAS float* X = (LAS float*)lds + rg * 4096;
  if (s == 1) {
#pragma unroll
    for (int r = 0; r < 16; ++r)
#pragma unroll
      for (int d0 = 0; d0 < 4; ++d0) X[crow(r, hi) * 128 + d0 * 32 + r32] = o[d0][r] * (rli[r] * lam);
  }
  __syncthreads();
  if (s == 0) {
    float rstd[16];
#pragma unroll
    for (int r = 0; r < 16; ++r) {
      float acc = 0.f;
#pragma unroll
      for (int d0 = 0; d0 < 4; ++d0) { const float v = o[d0][r] * rli[r] - X[crow(r, hi) * 128 + d0 * 32 + r32]; o[d0][r] = v; acc += v * v; }
#pragma unroll
      for (int off = 1; off < 32; off <<= 1) acc += __shfl_xor(acc, off);
      rstd[r] = 1.0f / sqrtf(acc * (1.0f / 128.0f) + EPS);
    }
    LAS bf16_t* stg = (LAS bf16_t*)(lds + 65536 + 2048) + rg * 4096;
    float gsc[4];
#pragma unroll
    for (int d0 = 0; d0 < 4; ++d0) gsc[d0] = subg[d0 * 32 + r32] * (1.0f - LAMBDA_INIT0);
#pragma unroll
    for (int r = 0; r < 16; ++r)
#pragma unroll
      for (int d0 = 0; d0 < 4; ++d0) stg[crow(r, hi) * 128 + d0 * 32 + r32] = (bf16_t)f2bf(o[d0][r] * rstd[r] * gsc[d0]);
    asm volatile("s_waitcnt lgkmcnt(0)" ::: "memory");
    bf16_t* Ow = ATT + (size_t)(qrow0 + rg * 32) * D + h * 128;
#pragma unroll
    for (int i = 0; i < 8; ++i) { const int row = i * 4 + (lane >> 4), ch = lane & 15; const u32x4v v = *(const LAS u32x4v*)(stg + row * 128 + ch * 8); *(u32x4v*)(Ow + (size_t)row * D + ch * 8) = v; }
  }
  __syncthreads();
}
#undef KSWZ
#undef SBAR
}

__device__ __forceinline__ void ph_attn_fast(const Ctx& a, LAS unsigned char* lds) {
    unsigned char* ws = a.ws();
    const bf16_t* Q = (const bf16_t*)(ws + WS_Q); const bf16_t* Kb = (const bf16_t*)(ws + WS_K); const bf16_t* V = (const bf16_t*)(ws + WS_V);
    bf16_t* ATT = (bf16_t*)(ws + WS_ATT); const float* subg = a.in(I_SUBG);
    const float lam = diff_lambda(a, threadIdx.x & 63);
    const int G = gridDim.x, c = blockIdx.x;
    for (int i = 0;; ++i) {
        const long L = (long)i * G + c; if (L >= 1024) break;
        const int w = xcd_remap(L, 1024), bh = w >> 4, qb = w & 15, b = bh >> 3, h = bh & 7;
        fa::attn_unit(Q, Kb, V, ATT, subg, lam, true, b, h, b * SEQ + qb * 128, lds);
    }
    for (int L = c; L < 128; L += G) {
        const int bh = L >> 1, qb = L & 1, b = bh >> 3, h = bh & 7;
        fa::attn_unit(Q, Kb, V, ATT, subg, lam, false, b, h, RL + b * CTXL + qb * 128, lds);
    }
}


__device__ __forceinline__ void ph_gates_fast(const Ctx& a, LAS unsigned char* lds) {
    unsigned char* ws = a.ws();
    const bf16_t* XR = (const bf16_t*)(ws + WS_XR); const bf16_t* WG = (const bf16_t*)(ws + WS_WG);
    bf16_t* LOGA = (bf16_t*)(ws + WS_LOGA); unsigned char* BT = ws + WS_BT;
    const float* convw = a.in(I_CONVW); const float* convb = a.in(I_CONVB); const float* gtab = (const float*)(ws + WS_GTAB);
    const int tid = threadIdx.x, wid = __builtin_amdgcn_readfirstlane(tid >> 6), lane = tid & 63, wr = wid >> 2, wc = wid & 3, fr = lane & 15, fq = lane >> 4;
    constexpr int HTB = pg8::HTB;
    const int aoff = pg8::lds_byte(wr * 64 + fr, fq * 8), boff = pg8::lds_byte(wc * 32 + fr, fq * 8);
    const int sc = tid & 15, rg8 = tid >> 4;
    unsigned bsrc[2];
#pragma unroll
    for (int i = 0; i < 2; ++i) { int R, C; pg8::stage_rc(tid * 16 + i * 8192, R, C); bsrc[i] = (unsigned)(((R & ~31) + pg8::perm32(R & 31)) * 128 + C) * 2u; }
    const unsigned ldsw = (unsigned)wid * 1024u;
#define GT_DMA_B(d_) do { const char* wb_ = (const char*)(WG + (size_t)((d_) * 8 + kb) * 256 * 128); \
        _Pragma("unroll") for (int kt_ = 0; kt_ < 2; ++kt_) _Pragma("unroll") for (int h_ = 0; h_ < 2; ++h_) _Pragma("unroll") for (int i_ = 0; i_ < 2; ++i_) \
            __builtin_amdgcn_global_load_lds((const unsigned*)(wb_ + (size_t)h_ * 128 * 256 + kt_ * 128 + bsrc[i_]), (LAS unsigned*)(lds + (4 + kt_ * 2 + h_) * HTB + ldsw + i_ * 8192), 16, 0, 0); } while (0)
    const int Gq = gemm_groups(72 * 8, (int)gridDim.x);
    if ((int)blockIdx.x >= Gq) { cvt8_run(a, 1, CV1_GATES + ((int)blockIdx.x - Gq), (int)gridDim.x - Gq, CV1_GATES + CVQ_GATES, lds); return; }
    for (int u = blockIdx.x; u < 72 * 8; u += Gq) {
        const int kb = u & 7, rt = u >> 3;
        const bool lat = rt < 64; const int bsm = lat ? (rt >> 3) : (rt - 64), t0 = lat ? (rt & 7) * 256 : 0, L = lat ? SEQ : CTXL;
        const int seqbase = lat ? bsm * SEQ : RL + bsm * CTXL;
        GT_DMA_B(0);
        {
            const int ch0 = kb * 128 + sc * 8, r0 = rg8 * 8;
            u32x4 xin[11];
#pragma unroll
            for (int i = 0; i < 11; ++i) { const int tt = t0 + r0 - 2 + i; xin[i] = (tt >= 0 && tt < L) ? *(const u32x4*)(XR + (size_t)(seqbase + tt) * D + ch0) : (u32x4){0u, 0u, 0u, 0u}; }
            f32x4 cw[4][2], cb[2];
#pragma unroll
            for (int j = 0; j < 4; ++j) { cw[j][0] = *(const f32x4*)(convw + j * D + ch0); cw[j][1] = *(const f32x4*)(convw + j * D + ch0 + 4); }
            cb[0] = *(const f32x4*)(convb + ch0); cb[1] = *(const f32x4*)(convb + ch0 + 4);
#pragma unroll
            for (int k = 0; k < 8; ++k) {
                f32x4 o0 = cb[0], o1 = cb[1];
#pragma unroll
                for (int j = 0; j < 4; ++j) { const u32x4 x = xin[k + j];
                    o0 += cw[j][0] * (f32x4){bf_lo(x.x), bf_hi(x.x), bf_lo(x.y), bf_hi(x.y)}; o1 += cw[j][1] * (f32x4){bf_lo(x.z), bf_hi(x.z), bf_lo(x.w), bf_hi(x.w)}; }
                const int r = r0 + k;
                u32x4 w; w.x = pk2(o0[0], o0[1]); w.y = pk2(o0[2], o0[3]); w.z = pk2(o1[0], o1[1]); w.w = pk2(o1[2], o1[3]);
                *(LAS u32x4*)(lds + ((sc >> 3) * 2 + (r >> 7)) * HTB + pg8::lds_byte(r & 127, (sc & 7) * 8)) = w;
            }
        }
#pragma unroll 1
        for (int d = 0; d < 2; ++d) {
            asm volatile("s_waitcnt vmcnt(0)" ::: "memory");
            __syncthreads();
            pf4 acc[2][2][4][2];
#pragma unroll
            for (int ai = 0; ai < 2; ++ai)
#pragma unroll
                for (int bj = 0; bj < 2; ++bj)
#pragma unroll
                    for (int m = 0; m < 4; ++m)
#pragma unroll
                        for (int n = 0; n < 2; ++n) acc[ai][bj][m][n] = (pf4){0.f, 0.f, 0.f, 0.f};
#pragma unroll 1
            for (int kt = 0; kt < 2; ++kt)
#pragma unroll
                for (int ai = 0; ai < 2; ++ai) {
                    __builtin_amdgcn_sched_barrier(0);
                    pg8::bf16x8 At[4][2];
#pragma unroll
                    for (int m = 0; m < 4; ++m)
#pragma unroll
                        for (int k = 0; k < 2; ++k) At[m][k] = *(const LAS pg8::bf16x8*)(lds + (kt * 2 + ai) * HTB + aoff + m * 2048 + k * 1024);
#pragma unroll
                    for (int bj = 0; bj < 2; ++bj) {
                        pg8::bf16x8 Bf[2][2];
#pragma unroll
                        for (int n = 0; n < 2; ++n)
#pragma unroll
                            for (int k = 0; k < 2; ++k) Bf[n][k] = *(const LAS pg8::bf16x8*)(lds + (4 + kt * 2 + bj) * HTB + boff + n * 2048 + k * 1024);
#pragma unroll
                        for (int m = 0; m < 4; ++m)
#pragma unroll
                            for (int n = 0; n < 2; ++n)
#pragma unroll
                                for (int k = 0; k < 2; ++k) acc[ai][bj][m][n] = __builtin_amdgcn_mfma_f32_16x16x32_bf16(Bf[n][k], At[m][k], acc[ai][bj][m][n], 0, 0, 0);
                        __builtin_amdgcn_sched_barrier(0);
                    }
                }
            if (d == 0) { __syncthreads(); GT_DMA_B(1); }
            const int cc0 = wc * 32 + fq * 8;
            pf4 cl[2], c2[2], brn[2], bin[2];
#pragma unroll
            for (int n = 0; n < 2; ++n) { const float* g = gtab + (size_t)(d * 4) * D + kb * 128 + cc0 + 4 * n;
                cl[n] = *(const pf4*)g; c2[n] = *(const pf4*)(g + D); brn[n] = *(const pf4*)(g + 2 * D); bin[n] = *(const pf4*)(g + 3 * D); }
#pragma unroll
            for (int ai = 0; ai < 2; ++ai)
#pragma unroll
                for (int m = 0; m < 4; ++m) {
                    const int rl = wr * 64 + m * 16 + fr;
                    const int grow = seqbase + t0 + ai * 128 + rl;
                    float la[8], bt[8];
#pragma unroll
                    for (int n = 0; n < 2; ++n) {
                        const int cc = cc0 + 4 * n;
                        const u32x2 xw = *(const LAS u32x2*)(lds + ((cc >> 6) * 2 + ai) * HTB + pg8::lds_byte(rl, cc & 63));
                        const float xv[4] = {bf_lo(xw.x), bf_hi(xw.x), bf_lo(xw.y), bf_hi(xw.y)};
#pragma unroll
                        for (int j = 0; j < 4; ++j) {
                            const float r = __builtin_amdgcn_rcpf(1.0f + __builtin_amdgcn_exp2f(fmaf(acc[ai][0][m][n][j], -1.4426950408889634f, brn[n][j])));
                            const float ig = __builtin_amdgcn_rcpf(1.0f + __builtin_amdgcn_exp2f(fmaf(acc[ai][1][m][n][j], -1.4426950408889634f, bin[n][j])));
                            const float om = 1.0f - __builtin_amdgcn_exp2f(r * c2[n][j]);
                            la[n * 4 + j] = r * cl[n][j]; bt[n * 4 + j] = __builtin_amdgcn_sqrtf(om) * (ig * xv[j]) * BT_SCALE;
                        }
                    }
                    const size_t o = ((size_t)d * RT + grow) * D + kb * 128 + cc0;
                    u32x4 w; w.x = pk2(la[0], la[1]); w.y = pk2(la[2], la[3]); w.z = pk2(la[4], la[5]); w.w = pk2(la[6], la[7]);
                    *(u32x4*)(LOGA + o) = w;
                    u32x2 wb; wb.x = pk4_fp8(bt[0], bt[1], bt[2], bt[3]); wb.y = pk4_fp8(bt[4], bt[5], bt[6], bt[7]);
                    *(u32x2*)(BT + o) = wb;
                }
        }
#if FUSE_SCAN1
        asm volatile("s_waitcnt vmcnt(0)" ::: "memory");
        __syncthreads();
        {
            const int dir = wid >> 2, lc = wid & 3, kc = (t0 >> 6) + lc;
            const int c = dir == 0 ? (lat ? NCH_CTX + kc : kc) : (lat ? NCH - 1 - kc : NCH_CTX - 1 - kc);
            const int ch = kb * 128 + 2 * lane;
            float* CP = (float*)(ws + WS_CP); float* CB = (float*)(ws + WS_CB);
            float h0 = 0.f, h1 = 0.f, p0 = 0.f, p1 = 0.f;
#pragma unroll 1
            for (int sg = 0; sg < SCH; sg += 32) {
                unsigned la[32], bt[32];
#pragma unroll
                for (int i = 0; i < 32; ++i) { const size_t o = ((size_t)dir * RT + scan_row(bsm, dir, c, sg + i)) * D + ch; la[i] = *(const unsigned*)(LOGA + o); bt[i] = *(const unsigned short*)(BT + o); }
                asm volatile("" ::: "memory");
#pragma unroll
                for (int i = 0; i < 32; ++i) { const float l0 = bf_lo(la[i]), l1 = bf_hi(la[i]); const f32x2 bb = __builtin_amdgcn_cvt_pk_f32_fp8((int)bt[i], false);
                    h0 = __builtin_amdgcn_exp2f(l0) * h0 + bb.x; h1 = __builtin_amdgcn_exp2f(l1) * h1 + bb.y; p0 += l0; p1 += l1; }
            }
            const size_t so = ((size_t)(bsm * 2 + dir) * NCH + c) * D + ch;
            *(f32x2*)(CP + so) = (f32x2){p0, p1}; *(f32x2*)(CB + so) = (f32x2){h0, h1};
        }
#endif
        __syncthreads();
    }
#undef GT_DMA_B
    if (Gq == (int)gridDim.x) cvt8_tail(a, lds, 72 * 8, Gq, (int)blockIdx.x, 1, CV1_GATES, CVQ_GATES);
}

constexpr int NPHASES = 25;
__host__ __device__ constexpr bool phase_enabled(int p) {
    return !((p == 3 && FAST_QKV) || (p == 9 && FAST_GU) || (p == 22 && FAST_GU) || (p == 13 && FAST_GATES) || (p == 15 && FAST_GATES) || (p == 16 && FAST_GATES && FUSE_SCAN1));
}

__global__ void __launch_bounds__(NTHREADS, 2) hybrid_fwd(Args args) {
    extern __shared__ __attribute__((aligned(16))) unsigned char lds_raw[];
    LAS unsigned char* lds = (LAS unsigned char*)lds_raw;
    volatile LAS unsigned* MISC = (volatile LAS unsigned*)(lds + MISC_OFF);
    const int lo = args.ph_lo, hi = args.ph_hi;
    if (threadIdx.x == 0) {
        LAS unsigned long long* la64 = (LAS unsigned long long*)(lds + ARGS_OFF);
#pragma unroll
        for (int i = 0; i < 27; ++i) la64[i] = (unsigned long long)args.in[i];
        la64[27] = (unsigned long long)args.out; la64[28] = (unsigned long long)args.ws;
    }
    Ctx ctx; ctx.la = (const LAS unsigned*)(lds + ARGS_OFF);
    if (threadIdx.x < 16) MISC[threadIdx.x] = 0u;
    __syncthreads();
#if MK_ONE_LAUNCH
    XcdBarrier bar = xcd_barrier_post((unsigned*)(ctx.ws() + WS_CTL) + CW_BAR, MISC + 8);
#define GRID_BAR() xcd_barrier(bar)
#else
#define GRID_BAR() do { } while (0)
#endif
#ifndef REP_MASK
#define REP_MASK 0u
#endif
#define RUN(k, call) do { call; if constexpr (((REP_MASK) >> (k)) & 1u) { __syncthreads(); call; } } while (0)
#define IN(k) (lo <= (k) && (k) < hi)
#define SEAM(k) do { if ((k) + 1 < hi) GRID_BAR(); } while (0)

    if (IN(0)) { RUN(0, ph_prologue(ctx, lds)); SEAM(0); }
    if (IN(1)) { RUN(1, ph_norm1_l0(ctx)); SEAM(1); }
    if (IN(2)) {
#if FAST_QKV
        RUN(2, ph_qkv_fast(ctx, lds));
#else
        RUN(2, ph_qkv_naive(ctx, lds));
#endif
        SEAM(2); }
#if !FAST_QKV
    if (IN(3)) { RUN(3, ph_rope_naive(ctx)); SEAM(3); }
#endif
    if (IN(4)) {
#if FAST_ATTN
        RUN(4, ph_attn_fast(ctx, lds));
#else
        RUN(4, ph_attn_naive(ctx, lds));
#endif
        SEAM(4); }
    if (IN(5)) {
#if FAST_WO
        RUN(5, ph_wo_fast(ctx, lds));
#else
        RUN(5, ph_wo_naive(ctx, lds));
#endif
        SEAM(5); }
    if (IN(6)) { RUN(6, ph_norm2_router(ctx, lds, 0, RT)); SEAM(6); }
    if (IN(7)) { RUN(7, ph_topk_gather(ctx, lds, 0)); SEAM(7); }
    if (IN(8)) {
#if FAST_GU
        RUN(8, ph_gu_fast(ctx, lds, 0));
#else
        RUN(8, ph_gu_naive(ctx, lds, 0));
#endif
        SEAM(8); }
#if !FAST_GU
    if (IN(9)) { RUN(9, ph_swiglu_naive(ctx, 0)); SEAM(9); }
#endif
    if (IN(10)) {
#if FAST_DN
        RUN(10, ph_dn_fast(ctx, lds, 0));
#else
        RUN(10, ph_dn_naive(ctx, lds, 0));
#endif
        SEAM(10); }
    if (IN(11)) { RUN(11, ph_combine<0>(ctx, 0, RT)); SEAM(11); }
    if (IN(12)) {
#if FAST_WIN
        RUN(12, ph_win_fast(ctx, lds));
#else
        RUN(12, ph_win_naive(ctx, lds));
#endif
        SEAM(12); }
#if !FAST_GATES
    if (IN(13)) { RUN(13, ph_conv_naive(ctx)); SEAM(13); }
#endif
    if (IN(14)) {
#if FAST_GATES
        RUN(14, ph_gates_fast(ctx, lds));
#else
        RUN(14, ph_gates_naive(ctx, lds));
#endif
        SEAM(14); }
#if !FAST_GATES
    if (IN(15)) { RUN(15, ph_gate_elem_naive(ctx)); SEAM(15); }
#endif
#if !(FUSE_SCAN1 && FAST_GATES)
    if (IN(16)) { RUN(16, ph_scan1(ctx)); SEAM(16); }
#endif
    if (IN(17)) { RUN(17, ph_scan2(ctx)); SEAM(17); }
    if (IN(18)) {
#if FAST_WOUT
        RUN(18, ph_wout_fast(ctx, lds));
#else
        RUN(18, ph_wout_naive(ctx, lds));
#endif
        SEAM(18); }
    if (IN(19)) { RUN(19, ph_norm2_router(ctx, lds, 1, RL)); SEAM(19); }
    if (IN(20)) { RUN(20, ph_topk_gather(ctx, lds, 1)); SEAM(20); }
    if (IN(21)) {
#if FAST_GU
        RUN(21, ph_gu_fast(ctx, lds, 1));
#else
        RUN(21, ph_gu_naive(ctx, lds, 1));
#endif
        SEAM(21); }
#if !FAST_GU
    if (IN(22)) { RUN(22, ph_swiglu_naive(ctx, 1)); SEAM(22); }
#endif
    if (IN(23)) {
#if FAST_DN
        RUN(23, ph_dn_fast(ctx, lds, 1));
#else
        RUN(23, ph_dn_naive(ctx, lds, 1));
#endif
        SEAM(23); }
    if (IN(24)) { RUN(24, ph_combine<1>(ctx, 1, RL)); }
#undef IN
#undef SEAM
#undef GRID_BAR
}

extern "C" void kernel_launch(void* const* d_in, const int* in_sizes, int n_in, void* d_out, int out_size, void* d_ws, size_t ws_size, hipStream_t stream) {
    static int grid = 0;
    if (grid == 0) {
        if (n_in != 27 || out_size != RL * D || ws_size < WS_END) { fprintf(stderr, "kernel_launch: unexpected shapes (n_in %d out %d ws %zu)\n", n_in, out_size, ws_size); grid = -1; return; }
        int dev = 0, cus = 0, per_cu = 0;
        if (hipGetDevice(&dev) != hipSuccess || hipDeviceGetAttribute(&cus, hipDeviceAttributeMultiprocessorCount, dev) != hipSuccess) { grid = -1; return; }
        if (hipFuncSetAttribute((const void*)hybrid_fwd, hipFuncAttributeMaxDynamicSharedMemorySize, LDS_BYTES) != hipSuccess) { fprintf(stderr, "kernel_launch: hipFuncSetAttribute failed\n"); grid = -1; return; }
        if (hipOccupancyMaxActiveBlocksPerMultiprocessor(&per_cu, (const void*)hybrid_fwd, NTHREADS, LDS_BYTES) != hipSuccess || per_cu < 1) { fprintf(stderr, "kernel_launch: occupancy query says %d\n", per_cu); }
        (void)hipGetLastError();
        grid = cus > 0 ? cus : 256;
    }
    if (grid < 0) return;
    if (hipMemsetAsync((char*)d_ws + WS_CTL, 0, CTL_ZERO_BYTES, stream) != hipSuccess) return;
    Args a{};
    for (int i = 0; i < 27; ++i) a.in[i] = (const float*)d_in[i];
    a.out = (float*)d_out; a.ws = (unsigned char*)d_ws;
#if MK_ONE_LAUNCH
    a.ph_lo = 0; a.ph_hi = NPHASES;
    hipLaunchKernelGGL(hybrid_fwd, dim3(grid), dim3(NTHREADS), LDS_BYTES, stream, a);
#else
    for (int p = 0; p < NPHASES; ++p) {
        if (!phase_enabled(p)) continue;
        a.ph_lo = p; a.ph_hi = p + 1;
        hipLaunchKernelGGL(hybrid_fwd, dim3(grid), dim3(NTHREADS), LDS_BYTES, stream, a);
    }
#endif
    const hipError_t le = hipPeekAtLastError();
    if (le != hipSuccess) fprintf(stderr, "kernel_launch: launch failed: %s\n", hipGetErrorName(le));
}
```

```cpp
#define MK_ONE_LAUNCH 1
#define FAST_QKV 1
#define FAST_WO 1
#define FAST_GU 1
#define FAST_DN 1
#define FAST_WIN 1
#define FAST_WOUT 1
#define FAST_ATTN 1
#define FAST_GATES 1
#define FP8_MOE 1
#define CVQ_GATES 1120
#include <hip/hip_runtime.h>
#include <cstdio>
#include <cstdint>
#include <cmath>

#ifndef MK_ONE_LAUNCH
#define MK_ONE_LAUNCH 0
#endif
#ifndef FAST_QKV
#define FAST_QKV 0
#endif
#ifndef FAST_ATTN
#define FAST_ATTN 0
#endif
#ifndef FAST_WO
#define FAST_WO 0
#endif
#ifndef FAST_GU
#define FAST_GU 0
#endif
#ifndef FAST_DN
#define FAST_DN 0
#endif
#ifndef FAST_WIN
#define FAST_WIN 0
#endif
#ifndef FAST_GATES
#define FAST_GATES 0
#endif
#ifndef FAST_WOUT
#define FAST_WOUT 0
#endif
#ifndef FP8_MOE
#define FP8_MOE 0
#endif
#ifndef GU_ALIGN
#define GU_ALIGN true
#endif
#ifndef DN_ALIGN
#define DN_ALIGN true
#endif
#ifndef FUSE_SCAN1
#define FUSE_SCAN1 1
#endif
#define ANY_FAST_GEMM (FAST_QKV || FAST_WO || FAST_GU || FAST_DN || FAST_WIN || FAST_GATES || FAST_WOUT)

namespace pg8 {
#define PG8_LAS __attribute__((address_space(3)))
typedef unsigned short bf16_t;
typedef short bf16x8 __attribute__((ext_vector_type(8)));
typedef float f32x4 __attribute__((ext_vector_type(4)));
typedef unsigned u32x4 __attribute__((ext_vector_type(4)));
constexpr int BM = 256, BK = 64, HALF = 128, HTB = HALF * BK * 2  , STAGE_BYTES = 8 * HTB, NXCD = 8, WGM = 8;

__host__ __device__ __forceinline__ int lds_byte(int r, int c) { const int st = (r >> 4) * 2 + (c >> 5), rr = r & 15, cc = c & 31, ob = rr * 64 + cc * 2; return st * 1024 + (ob ^ (((ob >> 9) & 1) << 5)); }
__host__ __device__ __forceinline__ void stage_rc(int b, int& R, int& C) { const int st = b / 1024, sb = b % 1024, swz = sb ^ (((sb >> 9) & 1) << 5); R = (st >> 1) * 16 + swz / 64; C = (st & 1) * 32 + (swz % 64) / 2; }
__host__ __device__ __forceinline__ int perm32(int rho) { const int n = rho >> 4, i = rho & 15; return 8 * (i >> 2) + 4 * n + (i & 3); }

struct Unit { int pm, pn; };
struct Gemm { const bf16_t* A; const bf16_t* Bt; int M, N, K; };
__device__ __forceinline__ unsigned cvt_pk_bf16(float lo, float hi) { unsigned r; asm volatile("v_cvt_pk_bf16_f32 %0, %1, %2" : "=v"(r) : "v"(lo), "v"(hi)); return r; }
typedef int v4i_t __attribute__((ext_vector_type(4)));
typedef int v8i_t __attribute__((ext_vector_type(8)));
__device__ __forceinline__ v8i_t cat8(bf16x8 lo, bf16x8 hi) { const v4i_t a = __builtin_bit_cast(v4i_t, lo), b = __builtin_bit_cast(v4i_t, hi); return __builtin_shufflevector(a, b, 0, 1, 2, 3, 4, 5, 6, 7); }
template <class Epi, class Sched, bool ALIGN_EPI = false, bool SP2 = false, int FP8SCALE = 0  >
__device__ __forceinline__ void gemm_phase(PG8_LAS unsigned char* lds, const Gemm g, const Sched& S, const Epi& E) {
    const int tid = threadIdx.x, wid = __builtin_amdgcn_readfirstlane(tid >> 6), lane = tid & 63, wr = wid >> 2, wc = wid & 3, fr = lane & 15, fq = lane >> 4;
    const int K = g.K, nt = K / BK;
    unsigned voffA[2], voffB[2];
#pragma unroll
    for (int i = 0; i < 2; ++i) { int R, C; stage_rc(tid * 16 + i * 8192, R, C); const int Rb = Epi::PERM ? ((R & ~31) + perm32(R & 31)) : R;
        voffA[i] = (unsigned)(R * K + C) * 2u; voffB[i] = (unsigned)(Rb * K + C) * 2u; }
    const size_t kstep = (size_t)(BK * 2);
    const size_t hstep = (size_t)HALF * K * 2;
    const size_t tstep = 2 * hstep;
    const unsigned ldsw = (unsigned)wid * 1024u;
    const int aoff = lds_byte(wr * 64 + fr, fq * 8), boff = lds_byte(wc * 32 + fr, fq * 8);
#define PG8_SA(b, h) (((b) * 2 + (h)) * HTB)
#define PG8_SB(b, h) ((4 + (b) * 2 + (h)) * HTB)
#ifndef PG8_B_AUX
#define PG8_B_AUX 0
#endif
#define PG8_STAGE(bufoff, gbase, voff) do { _Pragma("unroll") for (int _i = 0; _i < 2; ++_i) { \
        if constexpr (FP8SCALE != 0 && PG8_B_AUX != 0) { if ((bufoff) >= 4 * HTB) __builtin_amdgcn_global_load_lds((const unsigned*)((const char*)(gbase) + (voff)[_i]), (PG8_LAS unsigned*)(lds + (bufoff) + ldsw + _i * 8192), 16, 0, PG8_B_AUX); \
            else __builtin_amdgcn_global_load_lds((const unsigned*)((const char*)(gbase) + (voff)[_i]), (PG8_LAS unsigned*)(lds + (bufoff) + ldsw + _i * 8192), 16, 0, 0); } \
        else __builtin_amdgcn_global_load_lds((const unsigned*)((const char*)(gbase) + (voff)[_i]), (PG8_LAS unsigned*)(lds + (bufoff) + ldsw + _i * 8192), 16, 0, 0); } } while (0)
#define PG8_LDA(dst, b, h) do { if constexpr (FP8SCALE == 0) { _Pragma("unroll") for (int m = 0; m < 4; ++m) _Pragma("unroll") for (int k = 0; k < 2; ++k) dst[m][k] = *(const PG8_LAS bf16x8*)(lds + PG8_SA(b, h) + aoff + m * 2048 + k * 1024); } \
        else { _Pragma("unroll") for (int m = 0; m < 4; ++m) { const v4i_t lo_ = *(const PG8_LAS v4i_t*)(lds + PG8_SA(b, h) + aoff + m * 2048), hi_ = *(const PG8_LAS v4i_t*)(lds + PG8_SA(b, h) + aoff + m * 2048 + 1024); dst##8[m] = __builtin_shufflevector(lo_, hi_, 0, 1, 2, 3, 4, 5, 6, 7); } } } while (0)
#define PG8_LDB(dst, b, h) do { if constexpr (FP8SCALE == 0) { _Pragma("unroll") for (int n = 0; n < 2; ++n) _Pragma("unroll") for (int k = 0; k < 2; ++k) dst[n][k] = *(const PG8_LAS bf16x8*)(lds + PG8_SB(b, h) + boff + n * 2048 + k * 1024); } \
        else { _Pragma("unroll") for (int n = 0; n < 2; ++n) { const v4i_t lo_ = *(const PG8_LAS v4i_t*)(lds + PG8_SB(b, h) + boff + n * 2048), hi_ = *(const PG8_LAS v4i_t*)(lds + PG8_SB(b, h) + boff + n * 2048 + 1024); dst##8[n] = __builtin_shufflevector(lo_, hi_, 0, 1, 2, 3, 4, 5, 6, 7); } } } while (0)
#define PG8_MMA(ai, bj, At, Bt) do { __builtin_amdgcn_s_setprio(1); \
        if constexpr (FP8SCALE == 0) { _Pragma("unroll") for (int m = 0; m < 4; ++m) _Pragma("unroll") for (int n = 0; n < 2; ++n) _Pragma("unroll") for (int k = 0; k < 2; ++k) \
            acc[ai][bj][m][n] = __builtin_amdgcn_mfma_f32_16x16x32_bf16(Bt[n][k], At[m][k], acc[ai][bj][m][n], 0, 0, 0); } \
        else { _Pragma("unroll") for (int m = 0; m < 4; ++m) _Pragma("unroll") for (int n = 0; n < 2; ++n) \
            asm volatile("v_mfma_scale_f32_16x16x128_f8f6f4 %0, %1, %2, %0, %3, %4 op_sel_hi:[0,0,0]" : "+v"(acc[ai][bj][m][n]) : "v"(Bt##8[n]), "v"(At##8[m]), "v"(sclW), "v"(sclA)); } \
        __builtin_amdgcn_s_setprio(0); } while (0)
#define PG8_WAIT_V(n) asm volatile("s_waitcnt vmcnt(" #n ")" ::: "memory")
#define PG8_WAIT_L(n) asm volatile("s_waitcnt lgkmcnt(" #n ")" ::: "memory")
#define PG8_BAR __builtin_amdgcn_s_barrier()
#define PG8_SCHED __builtin_amdgcn_sched_barrier(0)
    Unit cur, nxt; int ui = 0;
    if (!S.next(0, cur)) return;
    f32x4 acc[2][2][4][2];
#pragma unroll
    for (int a = 0; a < 2; ++a)
#pragma unroll
        for (int b = 0; b < 2; ++b)
#pragma unroll
            for (int m = 0; m < 4; ++m)
#pragma unroll
                for (int n = 0; n < 2; ++n) acc[a][b][m][n] = (f32x4){0.f, 0.f, 0.f, 0.f};
    bf16x8 At[4][2], B0[2][2], B1[2][2]; v8i_t At8[4], B08[2], B18[2]; const int sclW = FP8SCALE * 0x01010101, sclA = 0x7f7f7f7f;
    const char* cA = (const char*)g.A + (size_t)cur.pm * tstep; const char* cB = (const char*)g.Bt + (size_t)cur.pn * tstep;
    S.a_ready(cur);
    if constexpr (SP2) {
        PG8_STAGE(PG8_SB(0, 0), cB, voffB); PG8_STAGE(PG8_SB(0, 1), cB + hstep, voffB); PG8_STAGE(PG8_SA(0, 0), cA, voffA); PG8_STAGE(PG8_SA(0, 1), cA + hstep, voffA);
        if (wr == 1) PG8_BAR;
        PG8_WAIT_V(2); PG8_BAR;
        PG8_STAGE(PG8_SB(1, 0), cB + kstep, voffB); PG8_STAGE(PG8_SA(1, 0), cA + kstep, voffA); PG8_STAGE(PG8_SB(1, 1), cB + hstep + kstep, voffB);
        PG8_WAIT_V(6); PG8_BAR;
    } else {
        PG8_STAGE(PG8_SB(0, 0), cB, voffB); PG8_STAGE(PG8_SA(0, 0), cA, voffA); PG8_STAGE(PG8_SB(0, 1), cB + hstep, voffB); PG8_STAGE(PG8_SA(0, 1), cA + hstep, voffA);
        if (wr == 1) PG8_BAR;
        PG8_WAIT_V(4); PG8_BAR;
        PG8_STAGE(PG8_SB(1, 0), cB + kstep, voffB); PG8_STAGE(PG8_SA(1, 0), cA + kstep, voffA); PG8_STAGE(PG8_SB(1, 1), cB + hstep + kstep, voffB);
        PG8_WAIT_V(6); PG8_BAR;
    }
    for (;;) {
        const bool has_next = S.next(ui + 1, nxt);
        const char* nA = has_next ? (const char*)g.A + (size_t)nxt.pm * tstep : cA; const char* nB = has_next ? (const char*)g.Bt + (size_t)nxt.pn * tstep : cB;
        for (int t = 0; t < nt; t += 2) {
            const bool last = (t == nt - 2);
            const char* a1 = cA + (size_t)(t + 1) * kstep;
            const char* a2 = last ? nA : cA + (size_t)(t + 2) * kstep; const char* b2 = last ? nB : cB + (size_t)(t + 2) * kstep;
            const char* a3 = a2 + kstep; const char* b3 = b2 + kstep;
            if (last && has_next) S.a_ready(nxt);
            if constexpr (SP2) {
            PG8_LDB(B0, 0, 0); PG8_LDB(B1, 0, 1); PG8_SCHED; PG8_LDA(At, 0, 0); PG8_STAGE(PG8_SA(1, 1), a1 + hstep, voffA);
            PG8_WAIT_V(8); PG8_WAIT_L(0); PG8_BAR; PG8_MMA(0, 0, At, B0); PG8_MMA(0, 1, At, B1); PG8_BAR; PG8_SCHED;
            PG8_LDA(At, 0, 1); PG8_STAGE(PG8_SB(0, 0), b2, voffB); PG8_STAGE(PG8_SB(0, 1), b2 + hstep, voffB); PG8_STAGE(PG8_SA(0, 0), a2, voffA);
            PG8_WAIT_V(8); PG8_WAIT_L(0); PG8_BAR; PG8_MMA(1, 0, At, B0); PG8_MMA(1, 1, At, B1); PG8_BAR; PG8_SCHED;
            PG8_LDB(B0, 1, 0); PG8_LDB(B1, 1, 1); PG8_SCHED; PG8_LDA(At, 1, 0); PG8_STAGE(PG8_SA(0, 1), a2 + hstep, voffA);
            PG8_WAIT_V(8); PG8_WAIT_L(0); PG8_BAR; PG8_MMA(0, 0, At, B0); PG8_MMA(0, 1, At, B1); PG8_BAR; PG8_SCHED;
            PG8_LDA(At, 1, 1); PG8_STAGE(PG8_SB(1, 0), b3, voffB); PG8_STAGE(PG8_SB(1, 1), b3 + hstep, voffB); PG8_STAGE(PG8_SA(1, 0), a3, voffA);
            PG8_WAIT_V(8); PG8_WAIT_L(0); PG8_BAR; PG8_MMA(1, 0, At, B0); PG8_MMA(1, 1, At, B1); PG8_BAR; PG8_SCHED;
            } else {
            PG8_LDB(B0, 0, 0); PG8_SCHED; PG8_LDA(At, 0, 0); PG8_STAGE(PG8_SA(1, 1), a1 + hstep, voffA);
            PG8_WAIT_L(8); PG8_BAR; PG8_WAIT_L(0); PG8_MMA(0, 0, At, B0); PG8_BAR; PG8_SCHED;
            PG8_LDB(B1, 0, 1); PG8_STAGE(PG8_SB(0, 0), b2, voffB);
            PG8_BAR; PG8_WAIT_L(0); PG8_MMA(0, 1, At, B1); PG8_BAR;
            PG8_LDA(At, 0, 1); PG8_STAGE(PG8_SA(0, 0), a2, voffA);
            PG8_BAR; PG8_WAIT_L(0); PG8_MMA(1, 0, At, B0); PG8_BAR; PG8_SCHED;
            PG8_STAGE(PG8_SB(0, 1), b2 + hstep, voffB);
            PG8_WAIT_V(6); PG8_BAR; PG8_MMA(1, 1, At, B1); PG8_BAR;
            PG8_LDB(B0, 1, 0); PG8_SCHED; PG8_LDA(At, 1, 0); PG8_STAGE(PG8_SA(0, 1), a2 + hstep, voffA);
            PG8_WAIT_L(8); PG8_BAR; PG8_WAIT_L(0); PG8_MMA(0, 0, At, B0); PG8_BAR; PG8_SCHED;
            PG8_LDB(B1, 1, 1); PG8_STAGE(PG8_SB(1, 0), b3, voffB);
            PG8_BAR; PG8_WAIT_L(0); PG8_MMA(0, 1, At, B1); PG8_BAR;
            PG8_LDA(At, 1, 1); PG8_STAGE(PG8_SA(1, 0), a3, voffA);
            PG8_BAR; PG8_WAIT_L(0); PG8_MMA(1, 0, At, B0); PG8_BAR; PG8_SCHED;
            PG8_STAGE(PG8_SB(1, 1), b3 + hstep, voffB);
            PG8_WAIT_V(6); PG8_BAR; PG8_MMA(1, 1, At, B1); PG8_BAR;
            }
        }
        if constexpr (ALIGN_EPI) { if (wr == 0) PG8_BAR; }
        if constexpr (FP8SCALE != 0) asm volatile("s_nop 15\n\ts_nop 15" ::: "memory");
        if constexpr (!Epi::AFTER_DRAIN) { E(acc, cur, wr, wc, fr, fq); S.done(cur); }
        if (!has_next) break;
#pragma unroll
        for (int a = 0; a < 2; ++a)
#pragma unroll
            for (int b = 0; b < 2; ++b)
#pragma unroll
                for (int m = 0; m < 4; ++m)
#pragma unroll
                    for (int n = 0; n < 2; ++n) acc[a][b][m][n] = (f32x4){0.f, 0.f, 0.f, 0.f};
        cur = nxt; cA = nA; cB = nB; ++ui;
        if constexpr (ALIGN_EPI) { if (wr == 1) PG8_BAR; }
    }
    PG8_WAIT_V(0);
    if constexpr (!ALIGN_EPI) { if (wr == 0) PG8_BAR; }
    PG8_BAR;
    if constexpr (Epi::AFTER_DRAIN) { E.fused(acc, cur, wr, wc, fr, fq, lds, wid, lane); S.done(cur); }
#undef PG8_SA
#undef PG8_SB
#undef PG8_STAGE
#undef PG8_LDA
#undef PG8_LDB
#undef PG8_MMA
#undef PG8_WAIT_V
#undef PG8_WAIT_L
#undef PG8_BAR
#undef PG8_SCHED
}
}

#define LAS __attribute__((address_space(3)))
typedef unsigned short bf16_t;
typedef float f32x4 __attribute__((ext_vector_type(4)));
typedef float f32x2 __attribute__((ext_vector_type(2)));
typedef unsigned u32x4 __attribute__((ext_vector_type(4)));
typedef unsigned u32x2 __attribute__((ext_vector_type(2)));
typedef short bf16x8 __attribute__((ext_vector_type(8)));

constexpr int NB = 8, SEQ = 2048, CTXL = 256, D = 1024;
constexpr int RL = NB * SEQ, RC = NB * CTXL, RT = RL + RC;
constexpr int NE = 16, DE = 2816, CAPL = 256, CAPC = 32;
constexpr int RPE0 = NB * CAPL + NB * CAPC, RPE1 = NB * CAPL;
constexpr int NWAVES = 8, NTHREADS = 512;
constexpr float EPS = 1e-6f;
constexpr float QSCALE = 0.125f * 1.4426950408889634f;
constexpr float LAMBDA_INIT0 = 0.2f;
constexpr int M_SH1 = 0, M_SC1 = 1024, M_G1 = 2048, M_SH2 = 3072, M_SC2 = 4096, M_G2 = 5120;
constexpr int SCH = 64, NCH = (CTXL + SEQ) / SCH, NCH_CTX = CTXL / SCH;

constexpr size_t MiB = 1u << 20;
constexpr size_t WS_CTL = 0, CTL_ZERO_BYTES = 32768;
constexpr size_t WS_GTAB = 2 * MiB + 65536;
constexpr size_t WS_MOD = 1 * MiB, WS_ROPE = 2 * MiB, WS_PROBS = 3 * MiB, WS_GATE = 5 * MiB, WS_SEL = 6 * MiB, WS_CP = 8 * MiB, WS_CB = 11 * MiB;
constexpr size_t WS_WQKV = 16 * MiB, WS_WO = 22 * MiB, WS_WIN = 24 * MiB, WS_WOUT = 28 * MiB, WS_WG = 30 * MiB;
constexpr size_t WS_XN = 32 * MiB, WS_Q = 68 * MiB, WS_K = 104 * MiB, WS_V = 140 * MiB, WS_ATT = 176 * MiB, WS_H = 212 * MiB;
constexpr size_t WS_XG = 284 * MiB, WS_Y = 356 * MiB, WS_ACT = 428 * MiB, WS_WGU = 626 * MiB, WS_WDN = 978 * MiB;
constexpr size_t WS_YG = 68 * MiB, WS_XR = 104 * MiB, WS_HS = 140 * MiB;
constexpr size_t WS_LOGA = 1154 * MiB, WS_BT = 1226 * MiB;
constexpr size_t WS_TMPF = 1298 * MiB, WS_XC = 2090 * MiB, WS_END = 2126 * MiB;
constexpr size_t WGU_LAYER = (size_t)NE * 2 * DE * D * 2, WDN_LAYER = (size_t)NE * D * DE * 2;
constexpr int CW_BAR = 4096;

constexpr int LDS_BYTES = 147456;
constexpr int MISC_OFF = 131072 + 320;

struct Args { const float* in[27]; float* out; unsigned char* ws; int ph_lo, ph_hi; };
constexpr int ROPE_LDS = 131072 + 1024;
constexpr int ARGS_OFF = 131072 + 512;
struct Ctx {
    const LAS unsigned* la;
    __device__ __forceinline__ unsigned long long ld(int i) const { const unsigned lo = __builtin_amdgcn_readfirstlane(la[2 * i]), hi = __builtin_amdgcn_readfirstlane(la[2 * i + 1]); return ((unsigned long long)hi << 32) | lo; }
    __device__ __forceinline__ const float* in(int i) const { return (const float*)(const __attribute__((address_space(1))) float*)ld(i); }
    __device__ __forceinline__ float* out() const { return (float*)(__attribute__((address_space(1))) float*)ld(27); }
    __device__ __forceinline__ unsigned char* ws() const { return (unsigned char*)(__attribute__((address_space(1))) unsigned char*)ld(28); }
};

enum { I_X = 0, I_C, I_CTX, I_CCTX, I_ADAW, I_ADAB, I_N1G, I_N2G, I_FG, I_WQKV, I_LQ1, I_LK1, I_LQ2, I_LK2, I_SUBG, I_WO, I_WIN, I_BIN, I_CONVW, I_CONVB, I_WGATES, I_BGATES, I_LAM, I_WOUT, I_WR, I_WGU, I_WDN };

__device__ __forceinline__ float bf_lo(unsigned w) { return __uint_as_float(w << 16); }
__device__ __forceinline__ float bf_hi(unsigned w) { return __uint_as_float(w & 0xffff0000u); }
__device__ __forceinline__ float bf2f(bf16_t b) { return __uint_as_float(((unsigned)b) << 16); }
__device__ __forceinline__ unsigned f2bf(float f) { unsigned u = __float_as_uint(f); return (u + 0x7fffu + ((u >> 16) & 1u)) >> 16; }
__device__ __forceinline__ unsigned pk2(float lo, float hi) { unsigned r; asm("v_cvt_pk_bf16_f32 %0, %1, %2" : "=v"(r) : "v"(lo), "v"(hi)); return r; }
#ifndef EPI_WT
#define EPI_WT 0
#endif
__device__ __forceinline__ void st16_wt(void* p, u32x4 v) {
#if EPI_WT
    asm volatile("global_store_dwordx4 %0, %1, off sc1" :: "v"(p), "v"(v) : "memory");
#else
    *(u32x4*)p = v;
#endif
}
__device__ __forceinline__ void st8_wt(void* p, u32x2 v) {
#if EPI_WT
    asm volatile("global_store_dwordx2 %0, %1, off sc1" :: "v"(p), "v"(v) : "memory");
#else
    *(u32x2*)p = v;
#endif
}
__device__ __forceinline__ float wave_sum(float v) {
#pragma unroll
    for (int o = 1; o < 64; o <<= 1) v += __shfl_xor(v, o);
    return v;
}
__device__ __forceinline__ float wave_max(float v) {
#pragma unroll
    for (int o = 1; o < 64; o <<= 1) v = fmaxf(v, __shfl_xor(v, o));
    return v;
}
__device__ __forceinline__ float sigmoidf_(float x) { return 1.f / (1.f + expf(-x)); }
__device__ __forceinline__ float gelu_tanh(float x) { const float u = 0.7978845608028654f * (x + 0.044715f * x * x * x); return x / (1.f + expf(-2.f * u)); }
__device__ __forceinline__ const float* mod_ptr(const Ctx& a, int layer, int r) { return (const float*)(a.ws() + WS_MOD) + (size_t)(layer * 9 + r) * 6144; }
__device__ __forceinline__ int mod_row(int row) { return row < RL ? (row >> 11) : 8; }

__device__ __forceinline__ void load_row(const float* p, int lane, f32x4 (&v)[4]) {
#pragma unroll
    for (int j = 0; j < 4; ++j) v[j] = *(const f32x4*)(p + 4 * lane + 256 * j);
}
__device__ __forceinline__ void load_row_bf16(const bf16_t* p, int lane, f32x4 (&v)[4]) {
#pragma unroll
    for (int j = 0; j < 4; ++j) { const u32x2 w = *(const u32x2*)(p + 4 * lane + 256 * j); v[j] = (f32x4){bf_lo(w.x), bf_hi(w.x), bf_lo(w.y), bf_hi(w.y)}; }
}
__device__ __forceinline__ void store_row_f32(float* p, int lane, const f32x4 (&v)[4]) {
#pragma unroll
    for (int j = 0; j < 4; ++j) *(f32x4*)(p + 4 * lane + 256 * j) = v[j];
}
__device__ __forceinline__ void store_row_bf16(bf16_t* p, int lane, const f32x4 (&v)[4]) {
#pragma unroll
    for (int j = 0; j < 4; ++j) { u32x2 w; w.x = pk2(v[j].x, v[j].y); w.y = pk2(v[j].z, v[j].w); *(u32x2*)(p + 4 * lane + 256 * j) = w; }
}
__device__ __forceinline__ void store_row_fp8(unsigned char* p, int lane, const f32x4 (&v)[4]) {
#pragma unroll
    for (int j = 0; j < 4; ++j) *(unsigned*)(p + 4 * lane + 256 * j) = __builtin_amdgcn_cvt_pk_fp8_f32(v[j].z, v[j].w, __builtin_amdgcn_cvt_pk_fp8_f32(v[j].x, v[j].y, 0u, false), true);
}
__device__ __forceinline__ void rms_mod(f32x4 (&v)[4], const float* g, const float* sh, const float* sc, int lane) {
    float ss = 0.f;
#pragma unroll
    for (int j = 0; j < 4; ++j) ss += (v[j].x * v[j].x + v[j].y * v[j].y) + (v[j].z * v[j].z + v[j].w * v[j].w);
    ss = wave_sum(ss);
    const float rstd = 1.0f / sqrtf(ss * (1.0f / D) + EPS);
#pragma unroll
    for (int j = 0; j < 4; ++j) {
        const int k = 4 * lane + 256 * j;
        const f32x4 gg = *(const f32x4*)(g + k);
        f32x4 y = v[j] * rstd * gg;
        if (sh) { const f32x4 s1 = *(const f32x4*)(sc + k), s0 = *(const f32x4*)(sh + k); y = y * (1.0f + s1) + s0; }
        v[j] = y;
    }
}

template <class F>
__device__ __forceinline__ void naive_tile(const bf16_t* A, int lda, const float* W, int ldw, int K, LAS unsigned char* lds, F f) {
    LAS float* As = (LAS float*)lds;
    LAS float* Bs = (LAS float*)(lds + 16 * 132 * 4);
    const int tid = threadIdx.x, ty = tid >> 4, tx = tid & 15;
    const int ar = tid >> 2, akq = tid & 3, bk = tid >> 5, bc = (tid & 31) * 2;
    float acc[4][4];
#pragma unroll
    for (int i = 0; i < 4; ++i)
#pragma unroll
        for (int j = 0; j < 4; ++j) acc[i][j] = 0.f;
    for (int k0 = 0; k0 < K; k0 += 16) {
        const u32x2 av = *(const u32x2*)(A + (size_t)ar * lda + k0 + akq * 4);
        const f32x2 bv = *(const f32x2*)(W + (size_t)(k0 + bk) * ldw + bc);
        __syncthreads();
        As[(akq * 4 + 0) * 132 + ar] = bf_lo(av.x); As[(akq * 4 + 1) * 132 + ar] = bf_hi(av.x);
        As[(akq * 4 + 2) * 132 + ar] = bf_lo(av.y); As[(akq * 4 + 3) * 132 + ar] = bf_hi(av.y);
        Bs[bk * 64 + bc] = bv.x; Bs[bk * 64 + bc + 1] = bv.y;
        __syncthreads();
#pragma unroll
        for (int kk = 0; kk < 16; ++kk) {
            const f32x4 a4 = *(const LAS f32x4*)(As + kk * 132 + ty * 4);
            const f32x4 b4 = *(const LAS f32x4*)(Bs + kk * 64 + tx * 4);
#pragma unroll
            for (int i = 0; i < 4; ++i)
#pragma unroll
                for (int j = 0; j < 4; ++j) acc[i][j] += a4[i] * b4[j];
        }
    }
#pragma unroll
    for (int i = 0; i < 4; ++i)
#pragma unroll
        for (int j = 0; j < 4; ++j) f(ty * 4 + i, tx * 4 + j, acc[i][j]);
    __syncthreads();
}

__device__ __forceinline__ void cvt_item(const float* W, int N, int k0, int n0, bf16_t* dst, int Kd, int gu_perm) {
    const int tid = threadIdx.x, lane = tid & 63, wave = tid >> 6;
    const float* p = W + (size_t)(k0 + 8 * wave) * N + n0 + 4 * lane;
    f32x4 v[8];
#pragma unroll
    for (int i = 0; i < 8; ++i) v[i] = *(const f32x4*)(p + (size_t)i * N);
#pragma unroll
    for (int j = 0; j < 4; ++j) {
        const int n = n0 + 4 * lane + j;
        const int row = gu_perm ? (((n % DE) >> 7) * 256 + (n / DE) * 128 + (n & 127)) : n;
        u32x4 o; o.x = pk2(v[0][j], v[1][j]); o.y = pk2(v[2][j], v[3][j]); o.z = pk2(v[4][j], v[5][j]); o.w = pk2(v[6][j], v[7][j]);
        *(u32x4*)(dst + (size_t)row * Kd + k0 + 8 * wave) = o;
    }
}
__device__ __forceinline__ unsigned pk4_fp8(float a, float b, float c, float d) { unsigned w = __builtin_amdgcn_cvt_pk_fp8_f32(a, b, 0u, false); return __builtin_amdgcn_cvt_pk_fp8_f32(c, d, w, true); }
constexpr float BT_SCALE = 64.0f, Y_SCALE = 16.0f;
constexpr float WGU_SCALE = 32.0f, WDN_SCALE = 64.0f;
__device__ __forceinline__ void cvt8_load(const float* W, int N, int k0, int n0, f32x4 (&v)[16]) {
    const int tid = threadIdx.x, lane = tid & 63, wave = tid >> 6;
    const float* p = W + (size_t)(k0 + 16 * wave) * N + n0 + 4 * lane;
#pragma unroll
    for (int i = 0; i < 16; ++i) v[i] = __builtin_nontemporal_load((const f32x4*)(p + (size_t)i * N));
}
__device__ __forceinline__ void cvt8_store(const f32x4 (&v)[16], int k0, int n0, unsigned char* dst, int Kd, int gu_perm, float scale, LAS unsigned char* T) {
    const int tid = threadIdx.x, lane = tid & 63, wave = tid >> 6;
#pragma unroll
    for (int j = 0; j < 4; ++j) {
        const int n = 4 * lane + j;
        u32x4 o;
        o.x = pk4_fp8(v[0][j] * scale, v[1][j] * scale, v[2][j] * scale, v[3][j] * scale); o.y = pk4_fp8(v[4][j] * scale, v[5][j] * scale, v[6][j] * scale, v[7][j] * scale);
        o.z = pk4_fp8(v[8][j] * scale, v[9][j] * scale, v[10][j] * scale, v[11][j] * scale); o.w = pk4_fp8(v[12][j] * scale, v[13][j] * scale, v[14][j] * scale, v[15][j] * scale);
        *(LAS u32x4*)(T + n * 128 + ((wave ^ (lane & 7)) << 4)) = o;
    }
    asm volatile("s_waitcnt lgkmcnt(0)" ::: "memory"); __builtin_amdgcn_s_barrier(); asm volatile("" ::: "memory");
#pragma unroll
    for (int i = 0; i < 4; ++i) {
        const int p = tid + NTHREADS * i, n = p >> 3, c = p & 7;
        const u32x4 x = *(const LAS u32x4*)(T + n * 128 + ((c ^ ((n >> 2) & 7)) << 4));
        const int ng = n0 + n;
        const int row = gu_perm ? (((ng % DE) >> 7) * 256 + (ng / DE) * 128 + (ng & 127)) : ng;
        __builtin_nontemporal_store(x, (u32x4*)(dst + (size_t)row * Kd + k0 + 16 * c));
    }
}
constexpr int CV_GU = NE * 8 * 22, CV_DN = NE * 22 * 4, CV_ITEMS = CV_GU + CV_DN;
struct CvItem { const float* W; unsigned char* dst; int N, Kd, k0, n0, perm; float scale; };
__device__ __forceinline__ CvItem cv_decode(const float* wgu, const float* wdn, unsigned char* ws, int layer, int it) {
    CvItem c;
    if (it < CV_GU) { const int e = it / 176, q = it % 176, le = layer * NE + e; c.W = wgu + (size_t)le * D * 2 * DE; c.dst = ws + WS_WGU + (size_t)le * 2 * DE * D; c.N = 2 * DE; c.Kd = D; c.k0 = (q / 22) * 128; c.n0 = (q % 22) * 256; c.perm = 1; c.scale = WGU_SCALE; }
    else { const int r = it - CV_GU, e = r / 88, q = r % 88, le = layer * NE + e; c.W = wdn + (size_t)le * DE * D; c.dst = ws + WS_WDN + (size_t)le * D * DE; c.N = D; c.Kd = DE; c.k0 = (q / 4) * 128; c.n0 = (q % 4) * 256; c.perm = 0; c.scale = WDN_SCALE; }
    return c;
}
__device__ __forceinline__ void cvt8_run(const Ctx& a, int layer, int first, int stride, int end, LAS unsigned char* lds) {
    const float* wgu = a.in(I_WGU); const float* wdn = a.in(I_WDN); unsigned char* ws = a.ws();
    f32x4 va[16], vb[16];
    int it = first;
    if (it < end) { const CvItem c = cv_decode(wgu, wdn, ws, layer, it); cvt8_load(c.W, c.N, c.k0, c.n0, va); }
    while (it < end) {
        int nx = it + stride;
        if (nx < end) { const CvItem c = cv_decode(wgu, wdn, ws, layer, nx); cvt8_load(c.W, c.N, c.k0, c.n0, vb); }
        { const CvItem c = cv_decode(wgu, wdn, ws, layer, it); cvt8_store(va, c.k0, c.n0, c.dst, c.Kd, c.perm, c.scale, lds); }
        it = nx; if (it >= end) break;
        nx = it + stride;
        if (nx < end) { const CvItem c = cv_decode(wgu, wdn, ws, layer, nx); cvt8_load(c.W, c.N, c.k0, c.n0, va); }
        { const CvItem c = cv_decode(wgu, wdn, ws, layer, it); cvt8_store(vb, c.k0, c.n0, c.dst, c.Kd, c.perm, c.scale, lds + 32768); }
        it = nx;
    }
    __syncthreads();
}
#ifndef CVT_HIDE
#define CVT_HIDE 1
#endif
#ifndef CVT_DEDICATED
#define CVT_DEDICATED 0
#endif
#ifndef CVQ_QKV
#define CVQ_QKV 1280
#endif
#ifndef CVQ_WO
#define CVQ_WO 896
#endif
#ifndef CVQ_GU0
#define CVQ_GU0 480
#endif
#ifndef CVQ_DN0
#define CVQ_DN0 960
#endif
#ifndef CVQ_WIN
#define CVQ_WIN 896
#endif
#ifndef CVQ_GATES
#define CVQ_GATES 768
#endif
constexpr int CV0_QKV = 0, CV0_WO = CV0_QKV + CVQ_QKV, CV0_PRO = CVT_HIDE ? CV0_WO + CVQ_WO : 0;
constexpr int CV1_GU0 = 0, CV1_DN0 = CV1_GU0 + CVQ_GU0, CV1_WIN = CV1_DN0 + CVQ_DN0, CV1_GATES = CV1_WIN + CVQ_WIN, CV1_PRO = CVT_HIDE ? CV1_GATES + CVQ_GATES : 0;
static_assert(CV0_PRO <= CV_ITEMS && CV1_PRO <= CV_ITEMS, "conversion schedule");
__device__ __forceinline__ void cvt8_tail(const Ctx& a, LAS unsigned char* lds, int units, int G, int c, int layer, int base, int count) {
#if CVT_HIDE && FP8_MOE
    const int R = (units + G - 1) / G, first_idle = units - (R - 1) * G;
    if (first_idle >= G || count <= 0 || c < first_idle) return;
    cvt8_run(a, layer, base + (c - first_idle), G - first_idle, base + count, lds);
#endif
}
__device__ __forceinline__ int gemm_groups(int units, int G) {
#if CVT_HIDE && FP8_MOE && CVT_DEDICATED
    const int R = (units + G - 1) / G; int gp = ((units + R - 1) / R + 7) & ~7;
    return gp < G ? gp : G;
#else
    return G;
#endif
}
__device__ __forceinline__ void ph_prologue(const Ctx& a, LAS unsigned char* lds) {
    const int tid = threadIdx.x, lane = tid & 63, wave = tid >> 6;
    if (blockIdx.x == gridDim.x - 1) {
        float* rope = (float*)(a.ws() + WS_ROPE);
        for (int i = tid; i < 1024; i += NTHREADS) { const int pos = i >> 4, f = i & 15; const float inv = powf(10000.0f, -(float)f / 16.0f); const float ang = (float)pos * inv; rope[i] = cosf(ang); rope[1024 + i] = sinf(ang); }
    }
    if (blockIdx.x == gridDim.x - 2 || gridDim.x == 1) {
        float* gt = (float*)(a.ws() + WS_GTAB); const float* lamp = a.in(I_LAM); const float* bgp = a.in(I_BGATES);
        for (int i = tid; i < 2 * D; i += NTHREADS) {
            const int d = i >> 10, ch = i & 1023, kb = ch >> 7, cc = ch & 127;
            const float cl = -8.0f * log1pf(expf(-lamp[i]));
            gt[(d * 4 + 0) * D + ch] = cl * 1.4426950408889634f; gt[(d * 4 + 1) * D + ch] = 2.0f * cl * 1.4426950408889634f;
            gt[(d * 4 + 2) * D + ch] = -1.4426950408889634f * bgp[(d * 8 + kb) * 256 + cc]; gt[(d * 4 + 3) * D + ch] = -1.4426950408889634f * bgp[(d * 8 + kb) * 256 + 128 + cc];
        }
    }
    for (int u = blockIdx.x; u < 192; u += gridDim.x) {
        LAS float* sl = (LAS float*)lds;
        LAS float* red = (LAS float*)(lds + 49152);
        const int layer = u / 96, n0 = (u % 96) * 64;
        for (int i = tid; i < 9 * 1024; i += NTHREADS) { const int r = i >> 10, k = i & 1023; const float v = r < 8 ? a.in(I_C)[r * 1024 + k] : a.in(I_CCTX)[k]; sl[k * 12 + r] = v / (1.f + expf(-v)); }
        __syncthreads();
        const float* W = a.in(I_ADAW) + (size_t)layer * 1024 * 6144 + n0 + lane;
        float acc[9];
#pragma unroll
        for (int r = 0; r < 9; ++r) acc[r] = 0.f;
#pragma unroll 32
        for (int k = wave * 128; k < wave * 128 + 128; ++k) {
            const float w = __builtin_nontemporal_load(W + (size_t)k * 6144);
            const f32x4 s0 = *(const LAS f32x4*)(sl + k * 12), s1 = *(const LAS f32x4*)(sl + k * 12 + 4); const float s8 = sl[k * 12 + 8];
            acc[0] += s0.x * w; acc[1] += s0.y * w; acc[2] += s0.z * w; acc[3] += s0.w * w;
            acc[4] += s1.x * w; acc[5] += s1.y * w; acc[6] += s1.z * w; acc[7] += s1.w * w; acc[8] += s8 * w;
        }
#pragma unroll
        for (int r = 0; r < 9; ++r) red[(wave * 9 + r) * 64 + lane] = acc[r];
        __syncthreads();
        float* MOD = (float*)(a.ws() + WS_MOD);
        for (int i = tid; i < 576; i += NTHREADS) {
            const int r = i >> 6, l = i & 63; float s = 0.f;
#pragma unroll
            for (int w = 0; w < 8; ++w) s += red[(w * 9 + r) * 64 + l];
            MOD[(size_t)(layer * 9 + r) * 6144 + n0 + l] = s + a.in(I_ADAB)[layer * 6144 + n0 + l];
        }
        __syncthreads();
    }
#if ANY_FAST_GEMM
    constexpr int IT_QKV = 16 * 12, IT_WO = 16 * 4, IT_WIN = 16 * 8, IT_WOUT = 16 * 4, IT_G = 32;
#if FP8_MOE
    cvt8_run(a, 0, CV0_PRO + (int)blockIdx.x, (int)gridDim.x, CV_ITEMS, lds);
    cvt8_run(a, 1, CV1_PRO + (int)blockIdx.x, (int)gridDim.x, CV_ITEMS, lds);
    constexpr int IT_GU = 0, IT_DN = 0;
#else
    constexpr int IT_GU1 = 16 * 22, IT_DN1 = 44 * 4;
    constexpr int IT_GU = 32 * IT_GU1, IT_DN = 32 * IT_DN1;
#endif
    constexpr int NITEMS = IT_GU + IT_DN + IT_QKV + IT_WO + IT_WIN + IT_WOUT + IT_G;
    for (int it = blockIdx.x; it < NITEMS; it += gridDim.x) {
        int r = it;
#if !FP8_MOE
        if (r < IT_GU) { const int le = r / IT_GU1, q = r % IT_GU1;
            cvt_item(a.in(I_WGU) + (size_t)le * D * 2 * DE, 2 * DE, (q / 22) * 64, (q % 22) * 256, (bf16_t*)(a.ws() + WS_WGU) + (size_t)le * 2 * DE * D, D, 1); continue; }
        r -= IT_GU;
        if (r < IT_DN) { const int le = r / IT_DN1, q = r % IT_DN1;
            cvt_item(a.in(I_WDN) + (size_t)le * DE * D, D, (q / 4) * 64, (q % 4) * 256, (bf16_t*)(a.ws() + WS_WDN) + (size_t)le * D * DE, DE, 0); continue; }
#endif
        r -= IT_DN;
        if (r < IT_QKV) { cvt_item(a.in(I_WQKV), 3 * D, (r / 12) * 64, (r % 12) * 256, (bf16_t*)(a.ws() + WS_WQKV), D, 0); continue; }
        r -= IT_QKV;
        if (r < IT_WO) { cvt_item(a.in(I_WO), D, (r / 4) * 64, (r % 4) * 256, (bf16_t*)(a.ws() + WS_WO), D, 0); continue; }
        r -= IT_WO;
        if (r < IT_WIN) { cvt_item(a.in(I_WIN), 2 * D, (r / 8) * 64, (r % 8) * 256, (bf16_t*)(a.ws() + WS_WIN), D, 0); continue; }
        r -= IT_WIN;
        if (r < IT_WOUT) { cvt_item(a.in(I_WOUT), D, (r / 4) * 64, (r % 4) * 256, (bf16_t*)(a.ws() + WS_WOUT), D, 0); continue; }
        r -= IT_WOUT;
        { const int m = r >> 1, kk = r & 1;
            cvt_item(a.in(I_WGATES) + (size_t)m * 128 * 256, 256, kk * 64, 0, (bf16_t*)(a.ws() + WS_WG) + (size_t)m * 256 * 128, 128, 0); }
    }
#endif
}

__device__ __forceinline__ void ph_norm1_l0(const Ctx& a) {
    const int lane = threadIdx.x & 63, gw = blockIdx.x * NWAVES + (threadIdx.x >> 6), NGW = gridDim.x * NWAVES;
    unsigned char* ws = a.ws();
    bf16_t* XN = (bf16_t*)(ws + WS_XN); const float* X = a.in(I_X); const float* CX = a.in(I_CTX); const float* n1g = a.in(I_N1G);
    f32x4 v[4], nx[4];
    int row = gw;
    if (row < RT) load_row(row < RL ? X + (size_t)row * D : CX + (size_t)(row - RL) * D, lane, v);
    for (; row < RT; row += NGW) {
        const int rn = row + NGW;
        if (rn < RT) load_row(rn < RL ? X + (size_t)rn * D : CX + (size_t)(rn - RL) * D, lane, nx);
        const float* mp = (const float*)(ws + WS_MOD) + (size_t)mod_row(row) * 6144;
        rms_mod(v, n1g, mp + M_SH1, mp + M_SC1, lane);
        store_row_bf16(XN + (size_t)row * D, lane, v);
#pragma unroll
        for (int j = 0; j < 4; ++j) v[j] = nx[j];
    }
}
__device__ __forceinline__ float rs16(float (&s)[16], int lane) {
    float r8[8], r4[4], r2[2];
    const bool b5 = lane & 32, b4 = lane & 16, b3 = lane & 8, b2 = lane & 4;
#pragma unroll
    for (int i = 0; i < 8; ++i) { const float send = b5 ? s[i] : s[i + 8], keep = b5 ? s[i + 8] : s[i]; r8[i] = keep + __shfl_xor(send, 32); }
#pragma unroll
    for (int i = 0; i < 4; ++i) { const float send = b4 ? r8[i] : r8[i + 4], keep = b4 ? r8[i + 4] : r8[i]; r4[i] = keep + __shfl_xor(send, 16); }
#pragma unroll
    for (int i = 0; i < 2; ++i) { const float send = b3 ? r4[i] : r4[i + 2], keep = b3 ? r4[i + 2] : r4[i]; r2[i] = keep + __shfl_xor(send, 8); }
    float r = (b2 ? r2[1] : r2[0]) + __shfl_xor(b2 ? r2[0] : r2[1], 4);
    r += __shfl_xor(r, 2); r += __shfl_xor(r, 1);
    return r;
}
__device__ __forceinline__ void ph_norm2_router(const Ctx& a, LAS unsigned char* lds, int layer, int nrows) {
    const int tid = threadIdx.x, lane = tid & 63, gw = blockIdx.x * NWAVES + (tid >> 6), NGW = gridDim.x * NWAVES;
    LAS float* wrT = (LAS float*)lds;
    const float* wr = a.in(I_WR) + (size_t)layer * D * NE;
    for (int i = tid; i < D * NE; i += NTHREADS) wrT[(i & 15) * 1024 + (i >> 4)] = wr[i];
    __syncthreads();
    unsigned char* ws = a.ws();
    bf16_t* XN = (bf16_t*)(ws + WS_XN); const bf16_t* H = (const bf16_t*)(ws + WS_H);
    float* PL = (float*)(ws + WS_PROBS); float* PC = PL + NB * NE * SEQ;
    const float* n2g = a.in(I_N2G) + layer * D;
    const int elane = ((lane >> 5) & 1) * 8 + ((lane >> 4) & 1) * 4 + ((lane >> 3) & 1) * 2 + ((lane >> 2) & 1);
    f32x4 v0[4], v1[4], n0[4], n1[4];
    int p = gw;
    if (p < nrows / 2) { load_row_bf16(H + (size_t)(2 * p) * D, lane, v0); load_row_bf16(H + (size_t)(2 * p + 1) * D, lane, v1); }
    for (; p < nrows / 2; p += NGW) {
        const int pn = p + NGW;
        if (pn < nrows / 2) { load_row_bf16(H + (size_t)(2 * pn) * D, lane, n0); load_row_bf16(H + (size_t)(2 * pn + 1) * D, lane, n1); }
        const int row = 2 * p;
        const float* mp = (const float*)(ws + WS_MOD) + (size_t)(layer * 9 + mod_row(row)) * 6144;
        rms_mod(v0, n2g, mp + M_SH2, mp + M_SC2, lane); rms_mod(v1, n2g, mp + M_SH2, mp + M_SC2, lane);
#if FP8_MOE
        store_row_fp8((unsigned char*)XN + (size_t)row * D, lane, v0); store_row_fp8((unsigned char*)XN + (size_t)(row + 1) * D, lane, v1);
#else
        store_row_bf16(XN + (size_t)row * D, lane, v0); store_row_bf16(XN + (size_t)(row + 1) * D, lane, v1);
#endif
        float s0[16], s1[16];
#pragma unroll
        for (int e = 0; e < 16; ++e) {
            float a0 = 0.f, a1 = 0.f;
#pragma unroll
            for (int j = 0; j < 4; ++j) { const f32x4 w = *(const LAS f32x4*)(wrT + e * 1024 + 4 * lane + 256 * j);
                a0 += (v0[j].x * w.x + v0[j].y * w.y) + (v0[j].z * w.z + v0[j].w * w.w); a1 += (v1[j].x * w.x + v1[j].y * w.y) + (v1[j].z * w.z + v1[j].w * w.w); }
            s0[e] = a0; s1[e] = a1;
            if ((e & 3) == 3) asm volatile("" ::: "memory");
        }
        const float l0 = rs16(s0, lane), l1 = rs16(s1, lane);
        const float m0 = wave_max(l0), m1 = wave_max(l1);
        const float e0 = expf(l0 - m0), e1 = expf(l1 - m1);
        const float q0 = e0 / (wave_sum(e0) * 0.25f), q1 = e1 / (wave_sum(e1) * 0.25f);
        if ((lane & 3) == 0) {
            if (row < RL) { float* d = PL + ((size_t)(row >> 11) * NE + elane) * SEQ + (row & 2047); *(f32x2*)d = (f32x2){q0, q1}; }
            else { const int rc = row - RL; float* d = PC + ((size_t)(rc >> 8) * NE + elane) * CTXL + (rc & 255); *(f32x2*)d = (f32x2){q0, q1}; }
        }
#pragma unroll
        for (int j = 0; j < 4; ++j) { v0[j] = n0[j]; v1[j] = n1[j]; }
    }
    __syncthreads();
}
__device__ __forceinline__ void ph_topk_gather(const Ctx& a, LAS unsigned char* lds, int layer) {
    const int tid = threadIdx.x, lane = tid & 63, wave = tid >> 6;
    LAS int* idxl = (LAS int*)lds;
    LAS int* cnt = (LAS int*)(lds + 1024);
    unsigned char* ws = a.ws();
    const float* PL = (const float*)(ws + WS_PROBS); const float* PC = PL + NB * NE * SEQ;
    float* GATE = (float*)(ws + WS_GATE); int* SEL = (int*)(ws + WS_SEL);
    const bf16_t* XN = (const bf16_t*)(ws + WS_XN); bf16_t* XG = (bf16_t*)(ws + WS_XG);
    const int nunits = layer == 0 ? 256 : 128, rpe = layer == 0 ? RPE0 : RPE1;
    const unsigned long long lt = (1ull << lane) - 1ull;
    for (int u0 = blockIdx.x; u0 < nunits; u0 += gridDim.x) {
        const int u = layer == 0 ? ((u0 & 1) * 128 + (u0 >> 1)) : u0;
        const bool lat = u < 128; const int b = (u & 127) >> 4, e = u & 15;
        const int n = lat ? SEQ : CTXL, cap = lat ? CAPL : CAPC;
        const float* src = lat ? PL + ((size_t)b * NE + e) * SEQ : PC + ((size_t)b * NE + e) * CTXL;
        const int rowbase = lat ? b * SEQ : RL + b * CTXL;
        const int xgbase = e * rpe + (lat ? b * CAPL : NB * CAPL + b * CAPC);
        unsigned v[4];
#pragma unroll
        for (int i = 0; i < 4; ++i) { const int t = wave * 256 + i * 64 + lane; v[i] = t < n ? __float_as_uint(src[t]) : 0u; }
        unsigned prefix = 0u;
#pragma unroll 1
        for (int bit = 30; bit >= 0; --bit) {
            const unsigned cand = prefix | (1u << bit); int c = 0;
#pragma unroll
            for (int i = 0; i < 4; ++i) c += __popcll(__ballot(v[i] >= cand));
            LAS int* slot = cnt + (bit & 1) * 8;
            if (lane == 0) slot[wave] = c;
            __syncthreads();
            int tot = 0;
#pragma unroll
            for (int w = 0; w < 8; ++w) tot += slot[w];
            if (tot >= cap) prefix = cand;
        }
        int mg = 0, me = 0;
#pragma unroll
        for (int i = 0; i < 4; ++i) { mg += __popcll(__ballot(v[i] > prefix)); me += __popcll(__ballot(v[i] == prefix)); }
        if (lane == 0) { cnt[16 + wave] = mg; cnt[24 + wave] = me; }
        __syncthreads();
        int tg = 0, eqb = 0;
#pragma unroll
        for (int w = 0; w < 8; ++w) { tg += cnt[16 + w]; eqb += (w < wave) ? cnt[24 + w] : 0; }
        const int need = cap - tg;
        bool sel[4]; int ms = 0, eqseen = eqb;
#pragma unroll
        for (int i = 0; i < 4; ++i) {
            const bool gt = v[i] > prefix, eq = v[i] == prefix;
            const unsigned long long meq = __ballot(eq);
            sel[i] = gt || (eq && (eqseen + __popcll(meq & lt)) < need);
            ms += __popcll(__ballot(sel[i])); eqseen += __popcll(meq);
        }
        if (lane == 0) cnt[32 + wave] = ms;
        __syncthreads();
        int slotbase = 0;
#pragma unroll
        for (int w = 0; w < 8; ++w) slotbase += (w < wave) ? cnt[32 + w] : 0;
#pragma unroll
        for (int i = 0; i < 4; ++i) {
            const unsigned long long msel = __ballot(sel[i]);
            const int slot = slotbase + __popcll(msel & lt), t = wave * 256 + i * 64 + lane;
            if (t < n) SEL[(size_t)(rowbase + t) * NE + e] = sel[i] ? slot : -1;
            if (sel[i]) { idxl[slot] = t; GATE[xgbase + slot] = __uint_as_float(v[i]); }
            slotbase += __popcll(msel);
        }
        __syncthreads();
        for (int slot = wave; slot < cap; slot += NWAVES) {
            const int t = idxl[slot];
#if FP8_MOE
            ((u32x4*)((unsigned char*)XG + (size_t)(xgbase + slot) * D))[lane] = ((const u32x4*)((const unsigned char*)XN + (size_t)(rowbase + t) * D))[lane];
#else
            const u32x4* s = (const u32x4*)(XN + (size_t)(rowbase + t) * D);
            u32x4* d = (u32x4*)(XG + (size_t)(xgbase + slot) * D);
            d[lane] = s[lane]; d[lane + 64] = s[lane + 64];
#endif
        }
        __syncthreads();
    }
}
template <int MODE>
__device__ __forceinline__ void ph_combine(const Ctx& a, int layer, int nrows) {
    const int lane = threadIdx.x & 63, gw = blockIdx.x * NWAVES + (threadIdx.x >> 6), NGW = gridDim.x * NWAVES;
    bf16_t* H = (bf16_t*)(a.ws() + WS_H); const int* SEL = (const int*)(a.ws() + WS_SEL); const unsigned char* Y = a.ws() + WS_Y;
    bf16_t* XN = (bf16_t*)(a.ws() + WS_XN);
    const int rpe = layer == 0 ? RPE0 : RPE1;
    f32x4 v[4], vn[4]; int sel = -1, seln = -1;
    if (gw < nrows) { load_row_bf16(H + (size_t)gw * D, lane, v); sel = SEL[(size_t)gw * NE + (lane & 15)]; }
    for (int row = gw; row < nrows; row += NGW) {
        const int rnx = row + NGW;
        if (rnx < nrows) { load_row_bf16(H + (size_t)rnx * D, lane, vn); seln = SEL[(size_t)rnx * NE + (lane & 15)]; }
        const int mr = mod_row(row);
        const float* mp = mod_ptr(a, layer, mr);
        const int off = row < RL ? (row >> 11) * CAPL : NB * CAPL + ((row - RL) >> 8) * CAPC;
        f32x4 acc[4];
#pragma unroll
        for (int j = 0; j < 4; ++j) acc[j] = (f32x4){0.f, 0.f, 0.f, 0.f};
        unsigned mask = (unsigned)(__ballot(sel >= 0) & 0xffffull);
        int yw[4][4];
#pragma unroll
        for (int k = 0; k < 4; ++k) {
            const bool on = mask != 0u; const int e = on ? __builtin_ctz(mask) : 0; mask = on ? (mask & (mask - 1u)) : 0u;
            const int sidx = __builtin_amdgcn_readlane(sel, e);
            const unsigned char* yr = Y + (size_t)(on ? (e * rpe + off + sidx) : 0) * D;
#pragma unroll
            for (int j = 0; j < 4; ++j) { const int w = __builtin_nontemporal_load((const int*)(yr + 4 * lane + 256 * j)); yw[k][j] = on ? w : 0; }
        }
#pragma unroll
        for (int k = 0; k < 4; ++k)
#pragma unroll
            for (int j = 0; j < 4; ++j) { const f32x2 lo = __builtin_amdgcn_cvt_pk_f32_fp8(yw[k][j], false), hi2 = __builtin_amdgcn_cvt_pk_f32_fp8(yw[k][j], true);
                acc[j].x += lo.x; acc[j].y += lo.y; acc[j].z += hi2.x; acc[j].w += hi2.y; }
        while (mask != 0u) {
            const int e = __builtin_ctz(mask); mask &= mask - 1u;
            const int sidx = __builtin_amdgcn_readlane(sel, e);
            const unsigned char* yr = Y + (size_t)(e * rpe + off + sidx) * D;
#pragma unroll
            for (int j = 0; j < 4; ++j) { const int w = *(const int*)(yr + 4 * lane + 256 * j); const f32x2 lo = __builtin_amdgcn_cvt_pk_f32_fp8(w, false), hi2 = __builtin_amdgcn_cvt_pk_f32_fp8(w, true);
                acc[j].x += lo.x; acc[j].y += lo.y; acc[j].z += hi2.x; acc[j].w += hi2.y; }
        }
#pragma unroll
        for (int j = 0; j < 4; ++j) { const f32x4 g2 = *(const f32x4*)(mp + M_G2 + 4 * lane + 256 * j); v[j] = v[j] + g2 * (acc[j] * (1.0f / Y_SCALE)); }
        if (MODE == 0) {
            store_row_bf16(H + (size_t)row * D, lane, v);
            const float* mp1 = mod_ptr(a, 1, mr);
            rms_mod(v, a.in(I_N1G) + D, mp1 + M_SH1, mp1 + M_SC1, lane);
            store_row_bf16(XN + (size_t)row * D, lane, v);
        } else {
            rms_mod(v, a.in(I_FG), nullptr, nullptr, lane);
            { float* po = a.out() + (size_t)row * D;
#pragma unroll
              for (int j = 0; j < 4; ++j) __builtin_nontemporal_store(v[j], (f32x4*)(po + 4 * lane + 256 * j)); }
        }
#pragma unroll
        for (int j = 0; j < 4; ++j) v[j] = vn[j];
        sel = seln;
    }
}

__device__ __forceinline__ void ph_qkv_naive(const Ctx& a, LAS unsigned char* lds) {
    const bf16_t* XN = (const bf16_t*)(a.ws() + WS_XN); float* T = (float*)(a.ws() + WS_TMPF);
    for (int t = blockIdx.x; t < (RT / 128) * 48; t += gridDim.x) {
        const int tm = t / 48, tn = t % 48;
        naive_tile(XN + (size_t)tm * 128 * D, D, a.in(I_WQKV) + tn * 64, 3 * D, D, lds,
                   [&](int r, int c, float v) { T[(size_t)(tm * 128 + r) * 3072 + tn * 64 + c] = v; });
    }
}
__device__ __forceinline__ void ph_rope_naive(const Ctx& a) {
    const float* T = (const float*)(a.ws() + WS_TMPF); const float* rope = (const float*)(a.ws() + WS_ROPE);
    bf16_t* Q = (bf16_t*)(a.ws() + WS_Q); bf16_t* Kb = (bf16_t*)(a.ws() + WS_K); bf16_t* V = (bf16_t*)(a.ws() + WS_V);
    const size_t total = (size_t)RT * 3072, nth = (size_t)gridDim.x * NTHREADS;
    for (size_t i = (size_t)blockIdx.x * NTHREADS + threadIdx.x; i < total; i += nth) {
        const int row = (int)(i / 3072), c = (int)(i % 3072);
        if (c >= 2048) { V[(size_t)row * D + (c - 2048)] = (bf16_t)f2bf(T[i]); continue; }
        const int d = c & 63; if ((d & 31) >= 16) continue;
        float x1 = T[i], x2 = T[i + 16];
        if (row < RL) {
            const int t = row & 2047, axis = d >> 5, f = d & 15, pos = axis == 0 ? (t >> 6) : (t & 63);
            const float cs = rope[pos * 16 + f], sn = rope[1024 + pos * 16 + f];
            const float o1 = x1 * cs - x2 * sn, o2 = x2 * cs + x1 * sn; x1 = o1; x2 = o2;
        }
        if (c < 1024) { Q[(size_t)row * D + c] = (bf16_t)f2bf(x1 * QSCALE); Q[(size_t)row * D + c + 16] = (bf16_t)f2bf(x2 * QSCALE); }
        else { Kb[(size_t)row * D + c - 1024] = (bf16_t)f2bf(x1); Kb[(size_t)row * D + c - 1024 + 16] = (bf16_t)f2bf(x2); }
    }
}
template <int NIT>
__device__ __forceinline__ void naive_attn_item(const Ctx& a, int row, int h, float lam, LAS float* qs, int lane) {
    const bf16_t* Q = (const bf16_t*)(a.ws() + WS_Q); const bf16_t* Kb = (const bf16_t*)(a.ws() + WS_K); const bf16_t* V = (const bf16_t*)(a.ws() + WS_V);
    bf16_t* ATT = (bf16_t*)(a.ws() + WS_ATT);
    const int b = row < RL ? (row >> 11) : ((row - RL) >> 8);
    const int lat0 = b * SEQ, ctx0 = RL + b * CTXL;
    { const unsigned qq = *(const unsigned*)(Q + (size_t)row * D + h * 128 + 2 * lane); qs[2 * lane] = bf_lo(qq); qs[2 * lane + 1] = bf_hi(qq); }
    __builtin_amdgcn_fence(__ATOMIC_RELEASE, "wavefront"); __builtin_amdgcn_wave_barrier(); __builtin_amdgcn_fence(__ATOMIC_ACQUIRE, "wavefront");
#define NA_SCORE(it, d0, d1) do { const int kk_ = (it) * 64 + lane; \
        const int krow_ = (NIT == 36) ? (kk_ < SEQ ? lat0 + kk_ : ctx0 + kk_ - SEQ) : ctx0 + kk_; \
        const u32x4* kp_ = (const u32x4*)(Kb + (size_t)krow_ * D + h * 128); d0 = 0.f; d1 = 0.f; \
        _Pragma("unroll 4") for (int c = 0; c < 16; ++c) { const u32x4 kv = kp_[c]; \
            const f32x4 qa = *(const LAS f32x4*)(qs + 8 * c), qb = *(const LAS f32x4*)(qs + 8 * c + 4); \
            const float dd = (qa.x * bf_lo(kv.x) + qa.y * bf_hi(kv.x)) + (qa.z * bf_lo(kv.y) + qa.w * bf_hi(kv.y)) \
                           + (qb.x * bf_lo(kv.z) + qb.y * bf_hi(kv.z)) + (qb.z * bf_lo(kv.w) + qb.w * bf_hi(kv.w)); \
            if (c < 8) d0 += dd; else d1 += dd; } } while (0)
    float m0 = -3.0e38f, m1 = -3.0e38f, l0 = 0.f, l1 = 0.f;
#pragma unroll 1
    for (int it = 0; it < NIT; ++it) {
        float d0, d1; NA_SCORE(it, d0, d1);
        const float n0 = fmaxf(m0, d0), n1 = fmaxf(m1, d1);
        l0 = l0 * exp2f(m0 - n0) + exp2f(d0 - n0); l1 = l1 * exp2f(m1 - n1) + exp2f(d1 - n1); m0 = n0; m1 = n1;
    }
    { const float g0 = wave_max(m0), g1 = wave_max(m1); l0 = wave_sum(l0 * exp2f(m0 - g0)); l1 = wave_sum(l1 * exp2f(m1 - g1)); m0 = g0; m1 = g1; }
    const float i0 = 1.f / l0, i1 = lam / l1;
    float o0 = 0.f, o1 = 0.f;
#pragma unroll 1
    for (int it = 0; it < NIT; ++it) {
        float d0, d1; NA_SCORE(it, d0, d1);
        const int wbits = __float_as_int(exp2f(d0 - m0) * i0 - exp2f(d1 - m1) * i1);
#pragma unroll 4
        for (int src = 0; src < 64; ++src) {
            const float wv = __int_as_float(__builtin_amdgcn_readlane(wbits, src));
            const int kk = it * 64 + src;
            const int krow = (NIT == 36) ? (kk < SEQ ? lat0 + kk : ctx0 + kk - SEQ) : ctx0 + kk;
            const unsigned vv = *(const unsigned*)(V + (size_t)krow * D + h * 128 + 2 * lane);
            o0 += wv * bf_lo(vv); o1 += wv * bf_hi(vv);
        }
    }
#undef NA_SCORE
    const float ss = wave_sum(o0 * o0 + o1 * o1);
    const float rstd = 1.0f / sqrtf(ss * (1.0f / 128.0f) + EPS);
    const float g0 = a.in(I_SUBG)[2 * lane], g1 = a.in(I_SUBG)[2 * lane + 1];
    *(unsigned*)(ATT + (size_t)row * D + h * 128 + 2 * lane) = pk2(o0 * rstd * g0 * (1.0f - LAMBDA_INIT0), o1 * rstd * g1 * (1.0f - LAMBDA_INIT0));
}
__device__ __forceinline__ float diff_lambda(const Ctx& a, int lane) {
    const float s1 = wave_sum(a.in(I_LQ1)[lane] * a.in(I_LK1)[lane]), s2 = wave_sum(a.in(I_LQ2)[lane] * a.in(I_LK2)[lane]);
    return expf(s1) - expf(s2) + LAMBDA_INIT0;
}
__device__ __forceinline__ void ph_attn_naive(const Ctx& a, LAS unsigned char* lds) {
    const int lane = threadIdx.x & 63, wave = threadIdx.x >> 6, gw = blockIdx.x * NWAVES + wave, NGW = gridDim.x * NWAVES;
    LAS float* qs = (LAS float*)lds + wave * 128;
    const float lam = diff_lambda(a, lane);
    for (int item = gw; item < RT * 8; item += NGW) {
        const int h = item / RT, row = item % RT;
        if (row < RL) naive_attn_item<36>(a, row, h, lam, qs, lane); else naive_attn_item<4>(a, row, h, lam, qs, lane);
    }
}
__device__ __forceinline__ void ph_wo_naive(const Ctx& a, LAS unsigned char* lds) {
    const bf16_t* ATT = (const bf16_t*)(a.ws() + WS_ATT); bf16_t* H = (bf16_t*)(a.ws() + WS_H);
    for (int t = blockIdx.x; t < (RT / 128) * 16; t += gridDim.x) {
        const int tm = t / 16, tn = t % 16;
        naive_tile(ATT + (size_t)tm * 128 * D, D, a.in(I_WO) + tn * 64, D, D, lds, [&](int r, int c, float v) {
            const int row = tm * 128 + r, col = tn * 64 + c;
            const float base = row < RL ? a.in(I_X)[(size_t)row * D + col] : a.in(I_CTX)[(size_t)(row - RL) * D + col];
            H[(size_t)row * D + col] = (bf16_t)f2bf(base + mod_ptr(a, 0, mod_row(row))[M_G1 + col] * v); });
    }
}
__device__ __forceinline__ void ph_gu_naive(const Ctx& a, LAS unsigned char* lds, int layer) {
    const int rpe = layer == 0 ? RPE0 : RPE1, tpe = (rpe / 128) * 88;
    const bf16_t* XG = (const bf16_t*)(a.ws() + WS_XG); float* T = (float*)(a.ws() + WS_TMPF);
    for (int t = blockIdx.x; t < NE * tpe; t += gridDim.x) {
        const int e = t / tpe, q = t % tpe, tm = q / 88, tn = q % 88;
        const size_t row0 = (size_t)e * rpe + tm * 128;
        naive_tile(XG + row0 * D, D, a.in(I_WGU) + (size_t)(layer * NE + e) * D * 2 * DE + tn * 64, 2 * DE, D, lds,
                   [&](int r, int c, float v) { T[(row0 + r) * (2 * DE) + tn * 64 + c] = v; });
    }
}
__device__ __forceinline__ void ph_swiglu_naive(const Ctx& a, int layer) {
    const int rpe = layer == 0 ? RPE0 : RPE1;
    const float* T = (const float*)(a.ws() + WS_TMPF); bf16_t* ACT = (bf16_t*)(a.ws() + WS_ACT);
    const size_t total = (size_t)NE * rpe * DE, nth = (size_t)gridDim.x * NTHREADS;
    for (size_t i = (size_t)blockIdx.x * NTHREADS + threadIdx.x; i < total; i += nth) {
        const size_t row = i / DE; const int j = (int)(i % DE);
        const float g = T[row * (2 * DE) + j], u = T[row * (2 * DE) + DE + j];
        ACT[i] = (bf16_t)f2bf(g / (1.f + expf(-g)) * u);
    }
}
__device__ __forceinline__ void ph_dn_naive(const Ctx& a, LAS unsigned char* lds, int layer) {
    const int rpe = layer == 0 ? RPE0 : RPE1, tpe = (rpe / 128) * 16;
    const bf16_t* ACT = (const bf16_t*)(a.ws() + WS_ACT); unsigned char* Y = a.ws() + WS_Y; const float* GATE = (const float*)(a.ws() + WS_GATE);
    for (int t = blockIdx.x; t < NE * tpe; t += gridDim.x) {
        const int e = t / tpe, q = t % tpe, tm = q / 16, tn = q % 16;
        const size_t row0 = (size_t)e * rpe + tm * 128;
        naive_tile(ACT + row0 * DE, DE, a.in(I_WDN) + (size_t)(layer * NE + e) * DE * D + tn * 64, D, DE, lds,
                   [&](int r, int c, float v) { Y[(row0 + r) * D + tn * 64 + c] = (unsigned char)(pk4_fp8(v * GATE[row0 + r] * Y_SCALE, 0.f, 0.f, 0.f) & 0xffu); });
    }
}
__device__ __forceinline__ void ph_win_naive(const Ctx& a, LAS unsigned char* lds) {
    const bf16_t* XN = (const bf16_t*)(a.ws() + WS_XN); bf16_t* YG = (bf16_t*)(a.ws() + WS_YG); bf16_t* XR = (bf16_t*)(a.ws() + WS_XR);
    const int TL = (RL / 128) * 32, TC = (RC / 128) * 16;
    for (int t = blockIdx.x; t < TL + TC; t += gridDim.x) {
        int tm, tn; if (t < TL) { tm = t / 32; tn = t % 32; } else { const int q = t - TL; tm = RL / 128 + q / 16; tn = 16 + q % 16; }
        naive_tile(XN + (size_t)tm * 128 * D, D, a.in(I_WIN) + tn * 64, 2 * D, D, lds, [&](int r, int c, float v) {
            const int row = tm * 128 + r, col = tn * 64 + c; const float x = v + a.in(I_BIN)[col];
            if (col < D) YG[(size_t)row * D + col] = (bf16_t)f2bf(gelu_tanh(x)); else XR[(size_t)row * D + col - D] = (bf16_t)f2bf(x); });
    }
}
__device__ __forceinline__ void ph_conv_naive(const Ctx& a) {
    const bf16_t* XR = (const bf16_t*)(a.ws() + WS_XR); bf16_t* XC = (bf16_t*)(a.ws() + WS_XC);
    const size_t total = (size_t)RT * D, nth = (size_t)gridDim.x * NTHREADS;
    for (size_t i = (size_t)blockIdx.x * NTHREADS + threadIdx.x; i < total; i += nth) {
        const int row = (int)(i >> 10), ch = (int)(i & 1023);
        const int t = row < RL ? (row & 2047) : ((row - RL) & 255), L = row < RL ? SEQ : CTXL;
        float v = a.in(I_CONVB)[ch];
#pragma unroll
        for (int j = 0; j < 4; ++j) { const int tt = t - 2 + j; if (tt >= 0 && tt < L) v += a.in(I_CONVW)[j * D + ch] * bf2f(XR[(size_t)(row - t + tt) * D + ch]); }
        XC[i] = (bf16_t)f2bf(v);
    }
}
__device__ __forceinline__ void ph_gates_naive(const Ctx& a, LAS unsigned char* lds) {
    const bf16_t* XC = (const bf16_t*)(a.ws() + WS_XC); float* T = (float*)(a.ws() + WS_TMPF);
    for (int t = blockIdx.x; t < 16 * (RT / 128) * 4; t += gridDim.x) {
        const int m = t / ((RT / 128) * 4), q = t % ((RT / 128) * 4), tm = q >> 2, tn = q & 3, d = m >> 3, kb = m & 7;
        naive_tile(XC + (size_t)tm * 128 * D + kb * 128, D, a.in(I_WGATES) + (size_t)m * 128 * 256 + tn * 64, 256, 128, lds,
                   [&](int r, int c, float v) { T[((size_t)d * RT + tm * 128 + r) * 2048 + kb * 256 + tn * 64 + c] = v; });
    }
}
__device__ __forceinline__ void ph_gate_elem_naive(const Ctx& a) {
    const float* T = (const float*)(a.ws() + WS_TMPF); const bf16_t* XC = (const bf16_t*)(a.ws() + WS_XC);
    bf16_t* LOGA = (bf16_t*)(a.ws() + WS_LOGA); unsigned char* BT = a.ws() + WS_BT;
    const size_t total = (size_t)2 * RT * D, nth = (size_t)gridDim.x * NTHREADS;
    for (size_t i = (size_t)blockIdx.x * NTHREADS + threadIdx.x; i < total; i += nth) {
        const int d = (int)(i / ((size_t)RT * D)); const size_t rc = i % ((size_t)RT * D); const int row = (int)(rc >> 10), ch = (int)(rc & 1023), kb = ch >> 7, cc = ch & 127;
        const float gr = T[((size_t)d * RT + row) * 2048 + kb * 256 + cc] + a.in(I_BGATES)[(d * 8 + kb) * 256 + cc];
        const float gi = T[((size_t)d * RT + row) * 2048 + kb * 256 + 128 + cc] + a.in(I_BGATES)[(d * 8 + kb) * 256 + 128 + cc];
        const float r = sigmoidf_(gr), ig = sigmoidf_(gi);
        const float lam = a.in(I_LAM)[d * D + ch];
        const float la = -8.0f * r * log1pf(expf(-lam));
        const float x = bf2f(XC[rc]);
        const float bt = sqrtf(-expm1f(2.0f * la)) * (ig * x);
        LOGA[i] = (bf16_t)f2bf(la * 1.4426950408889634f); BT[i] = (unsigned char)(pk4_fp8(bt * BT_SCALE, 0.f, 0.f, 0.f) & 0xffu);
    }
}
__device__ __forceinline__ void ph_wout_naive(const Ctx& a, LAS unsigned char* lds) {
    const bf16_t* HS = (const bf16_t*)(a.ws() + WS_HS); bf16_t* H = (bf16_t*)(a.ws() + WS_H);
    for (int t = blockIdx.x; t < (RL / 128) * 16; t += gridDim.x) {
        const int tm = t / 16, tn = t % 16;
        naive_tile(HS + (size_t)tm * 128 * D, D, a.in(I_WOUT) + tn * 64, D, D, lds, [&](int r, int c, float v) {
            const int row = tm * 128 + r, col = tn * 64 + c;
            H[(size_t)row * D + col] = (bf16_t)f2bf(bf2f(H[(size_t)row * D + col]) + mod_ptr(a, 1, row >> 11)[M_G1 + col] * v); });
    }
}

__device__ __forceinline__ int scan_row(int b, int dir, int c, int s) {
    const int p = c * SCH + s;
    if (dir == 0) return p < CTXL ? RL + b * CTXL + p : b * SEQ + (p - CTXL);
    return p < CTXL ? RL + b * CTXL + (CTXL - 1 - p) : b * SEQ + (SEQ - 1 - (p - CTXL));
}
__device__ __forceinline__ void ph_scan1(const Ctx& a) {
    const int lane = threadIdx.x & 63, gw = blockIdx.x * NWAVES + (threadIdx.x >> 6), NGW = gridDim.x * NWAVES;
    const bf16_t* LOGA = (const bf16_t*)(a.ws() + WS_LOGA); const unsigned char* BT = a.ws() + WS_BT;
    float* CP = (float*)(a.ws() + WS_CP); float* CB = (float*)(a.ws() + WS_CB);
    for (int item = gw; item < NB * 2 * NCH * 8; item += NGW) {
        const int cg = item & 7, c = (item >> 3) % NCH, bd = (item >> 3) / NCH, dir = bd & 1, b = bd >> 1;
        const int ch = cg * 128 + 2 * lane;
        float h0 = 0.f, h1 = 0.f, p0 = 0.f, p1 = 0.f;
#pragma unroll 1
        for (int sg = 0; sg < SCH; sg += 32) {
            unsigned la[32], bt[32];
#pragma unroll
            for (int i = 0; i < 32; ++i) { const size_t o = ((size_t)dir * RT + scan_row(b, dir, c, sg + i)) * D + ch; la[i] = *(const unsigned*)(LOGA + o); bt[i] = *(const unsigned short*)(BT + o); }
            asm volatile("" ::: "memory");
#pragma unroll
            for (int i = 0; i < 32; ++i) { const float l0 = bf_lo(la[i]), l1 = bf_hi(la[i]);
                const f32x2 bb = __builtin_amdgcn_cvt_pk_f32_fp8((int)bt[i], false);
                h0 = __builtin_amdgcn_exp2f(l0) * h0 + bb.x; h1 = __builtin_amdgcn_exp2f(l1) * h1 + bb.y; p0 += l0; p1 += l1; }
        }
        const size_t so = ((size_t)(b * 2 + dir) * NCH + c) * D + ch;
        *(f32x2*)(CP + so) = (f32x2){p0, p1}; *(f32x2*)(CB + so) = (f32x2){h0, h1};
    }
}
__device__ __forceinline__ void ph_scan2(const Ctx& a) {
    const int lane = threadIdx.x & 63, gw = blockIdx.x * NWAVES + (threadIdx.x >> 6), NGW = gridDim.x * NWAVES;
    const bf16_t* LOGA = (const bf16_t*)(a.ws() + WS_LOGA); const unsigned char* BT = a.ws() + WS_BT;
    const float* CP = (const float*)(a.ws() + WS_CP); const float* CB = (const float*)(a.ws() + WS_CB);
    const bf16_t* YG = (const bf16_t*)(a.ws() + WS_YG); bf16_t* HS = (bf16_t*)(a.ws() + WS_HS);
    constexpr int NLC = SEQ / SCH;
    for (int item = gw; item < NB * NLC * 8; item += NGW) {
        const int cg = item & 7, j = (item >> 3) % NLC, b = (item >> 3) / NLC;
        const int ch = cg * 128 + 2 * lane;
        const int cb = NCH_CTX + (NLC - 1 - j), cf = NCH_CTX + j;
        float hb0 = 0.f, hb1 = 0.f, hf0 = 0.f, hf1 = 0.f;
#pragma unroll 1
        for (int c0 = 0; c0 < NCH - 1; c0 += 12) {
            f32x2 pb[12], qb[12], pf[12], qf[12];
#pragma unroll
            for (int i = 0; i < 12; ++i) {
                const int c = c0 + i; const size_t sb_ = ((size_t)(b * 2 + 1) * NCH + c) * D + ch, sf_ = ((size_t)(b * 2 + 0) * NCH + c) * D + ch;
                const f32x2 z = (f32x2){0.f, 0.f};
                pb[i] = c < cb ? *(const f32x2*)(CP + sb_) : z; qb[i] = c < cb ? *(const f32x2*)(CB + sb_) : z;
                pf[i] = c < cf ? *(const f32x2*)(CP + sf_) : z; qf[i] = c < cf ? *(const f32x2*)(CB + sf_) : z;
            }
            asm volatile("" ::: "memory");
#pragma unroll
            for (int i = 0; i < 12; ++i) {
                hb0 = __builtin_amdgcn_exp2f(pb[i].x) * hb0 + qb[i].x; hb1 = __builtin_amdgcn_exp2f(pb[i].y) * hb1 + qb[i].y;
                hf0 = __builtin_amdgcn_exp2f(pf[i].x) * hf0 + qf[i].x; hf1 = __builtin_amdgcn_exp2f(pf[i].y) * hf1 + qf[i].y;
            }
        }
        float sb0[SCH], sb1[SCH];
#pragma unroll
        for (int sg = 0; sg < SCH; sg += 32) {
            unsigned la[32], bt[32];
#pragma unroll
            for (int i = 0; i < 32; ++i) { const size_t o = ((size_t)1 * RT + b * SEQ + j * SCH + (SCH - 1 - (sg + i))) * D + ch; la[i] = *(const unsigned*)(LOGA + o); bt[i] = *(const unsigned short*)(BT + o); }
            asm volatile("" ::: "memory");
#pragma unroll
            for (int i = 0; i < 32; ++i) {
                const f32x2 bb = __builtin_amdgcn_cvt_pk_f32_fp8((int)bt[i], false);
                hb0 = __builtin_amdgcn_exp2f(bf_lo(la[i])) * hb0 + bb.x; hb1 = __builtin_amdgcn_exp2f(bf_hi(la[i])) * hb1 + bb.y;
                sb0[SCH - 1 - (sg + i)] = hb0; sb1[SCH - 1 - (sg + i)] = hb1;
            }
        }
#pragma unroll
        for (int sg = 0; sg < SCH; sg += 16) {
            unsigned la[16], bt[16], yg[16];
#pragma unroll
            for (int i = 0; i < 16; ++i) { const size_t o = ((size_t)b * SEQ + j * SCH + sg + i) * D + ch; la[i] = __builtin_nontemporal_load((const unsigned*)(LOGA + o)); bt[i] = __builtin_nontemporal_load((const unsigned short*)(BT + o)); yg[i] = __builtin_nontemporal_load((const unsigned*)(YG + o)); }
            asm volatile("" ::: "memory");
#pragma unroll
            for (int i = 0; i < 16; ++i) {
                const size_t o = ((size_t)b * SEQ + j * SCH + sg + i) * D + ch;
                const f32x2 bb = __builtin_amdgcn_cvt_pk_f32_fp8((int)bt[i], false);
                hf0 = __builtin_amdgcn_exp2f(bf_lo(la[i])) * hf0 + bb.x; hf1 = __builtin_amdgcn_exp2f(bf_hi(la[i])) * hf1 + bb.y;
                *(unsigned*)(HS + o) = pk2(bf_lo(yg[i]) * ((hf0 + sb0[sg + i]) * (1.0f / BT_SCALE)), bf_hi(yg[i]) * ((hf1 + sb1[sg + i]) * (1.0f / BT_SCALE)));
            }
            asm volatile("" ::: "memory");
        }
    }
}
#define XB_TMO      128
#define XB_XCNT(j)  (256  + 64 * (j))
#define XB_XSUB(j)  (1280 + 64 * (j))
#define XB_XGEN(j)  (2304 + 64 * (j))
#define XB_TOP      3328
#define XB_TOPGEN   3392
#define XCD_BAR_WORDS 3456
#define XB_SPIN_CAP (1u << 18)

__device__ __forceinline__ unsigned xb_ld(unsigned* p)              { return __hip_atomic_load(p, __ATOMIC_RELAXED, __HIP_MEMORY_SCOPE_AGENT); }
__device__ __forceinline__ unsigned xb_add(unsigned* p, unsigned v) { return __hip_atomic_fetch_add(p, v, __ATOMIC_RELAXED, __HIP_MEMORY_SCOPE_AGENT); }
__device__ __forceinline__ unsigned xb_xcc_id() { return (unsigned)__builtin_amdgcn_s_getreg((3 << 11) | 20) & 0xFu; }
#define XB_SPIN(cond, bar) do { unsigned _sp = 0; while (cond) { __builtin_amdgcn_s_sleep(1); \
    if ((++_sp & 255u) == 0u) { if (xb_ld(&(bar)[XB_TMO])) break; if (_sp > XB_SPIN_CAP) { atomicAdd(&(bar)[XB_TMO], 1u); break; } } } } while (0)

struct XcdBarrier {
    unsigned* bar; unsigned x;
    volatile LAS unsigned* st;
};

__device__ __forceinline__ XcdBarrier xcd_barrier_post(unsigned* bar, volatile LAS unsigned* st) {
    XcdBarrier b; b.bar = bar; b.x = xb_xcc_id(); b.st = st;
    if (threadIdx.x == 0) (void)xb_add(&bar[XB_XCNT(b.x)], 1u);
    return b;
}
__device__ __forceinline__ void xcd_barrier_complete(unsigned* bar, unsigned x, unsigned& nloc, unsigned& nx) {
    const unsigned G = gridDim.x * gridDim.y * gridDim.z;
    unsigned sum, cnt, mine, sp = 0u;
    for (;;) {
        sum = 0u; cnt = 0u; mine = 0u;
#pragma unroll
        for (unsigned j = 0; j < 16; ++j) { const unsigned c = xb_ld(&bar[XB_XCNT(j)]); sum += c; cnt += (c > 0u) ? 1u : 0u; mine = (j == x) ? c : mine; }
        if (sum == G) break;
        __builtin_amdgcn_s_sleep(1);
        if ((++sp & 255u) == 0u) { if (xb_ld(&bar[XB_TMO])) break; if (sp > XB_SPIN_CAP) { atomicAdd(&bar[XB_TMO], 1u); break; } }
    }
    nloc = mine > 0u ? mine : 1u; nx = cnt > 0u ? cnt : 1u;
}

__device__ __forceinline__ void xcd_barrier(const XcdBarrier& b) {
    asm volatile("s_waitcnt vmcnt(0)" ::: "memory");
    __syncthreads();
    if (threadIdx.x == 0) {
        unsigned* bar = b.bar;
        __builtin_amdgcn_s_waitcnt(0);
        unsigned nloc = b.st[0], nx = b.st[1];
        if (nloc == 0u) { xcd_barrier_complete(bar, b.x, nloc, nx); b.st[0] = nloc; b.st[1] = nx; }
        const unsigned old = xb_add(&bar[XB_XSUB(b.x)], 1u);
        const unsigned gen = old / nloc;
        if (old + 1u == (gen + 1u) * nloc) {
            __builtin_amdgcn_fence(__ATOMIC_RELEASE, "agent");
            asm volatile("s_waitcnt vmcnt(0)" ::: "memory");
            const unsigned og = xb_add(&bar[XB_TOP], 1u);
            const unsigned tg = og / nx;
            if (og + 1u == (tg + 1u) * nx) xb_add(&bar[XB_TOPGEN], 1u);
            else XB_SPIN(xb_ld(&bar[XB_TOPGEN]) == tg, bar);
            __builtin_amdgcn_fence(__ATOMIC_ACQUIRE, "agent");
            xb_add(&bar[XB_XGEN(b.x)], 1u);
            asm volatile("s_waitcnt vmcnt(0)" ::: "memory");
        } else {
            XB_SPIN(xb_ld(&bar[XB_XGEN(b.x)]) == gen, bar);
            __builtin_amdgcn_fence(__ATOMIC_ACQUIRE, "agent");
            asm volatile("s_waitcnt vmcnt(0)" ::: "memory");
        }
    }
    __syncthreads();
}

__device__ __forceinline__ int xcd_remap(long L, int n) { const int q = n / 8, r = n % 8, xcd = (int)(L % 8), off = (int)(L / 8); return (xcd < r ? xcd * (q + 1) : r * (q + 1) + (xcd - r) * q) + off; }
template <class Map> struct ListOrder {
    int nunits, G, c; Map map;
    __device__ __forceinline__ bool next(int i, pg8::Unit& u) const { const long L = (long)i * G + c; if (L >= nunits) return false; map(xcd_remap(L, nunits), u); return true; }
    __device__ __forceinline__ void a_ready(const pg8::Unit&) const {}
    __device__ __forceinline__ void done(const pg8::Unit&) const {}
};
#ifndef WGMG
#define WGMG 8
#endif
struct MapGrid { int nN; __device__ __forceinline__ void operator()(int w, pg8::Unit& u) const { const int nig = WGMG * nN; u.pm = (w / nig) * WGMG + (w % nig) % WGMG; u.pn = (w % nig) / WGMG; } };
struct MapMoe { int PM, NT; __device__ __forceinline__ void operator()(int w, pg8::Unit& u) const { const int per = PM * NT, e = w / per, rem = w % per; u.pm = e * PM + rem % PM; u.pn = e * NT + rem / PM; } };
struct MapWin { __device__ __forceinline__ void operator()(int w, pg8::Unit& u) const { if (w < 512) { u.pm = (w / 64) * 8 + (w % 64) % 8; u.pn = (w % 64) / 8; } else { const int q = w - 512; u.pm = 64 + q % 8; u.pn = 4 + q / 8; } } };

typedef pg8::f32x4 pf4;
__device__ __forceinline__ float fast_exp(float x) { return __builtin_amdgcn_exp2f(x * 1.4426950408889634f); }

struct EpiQKV {
    static constexpr bool PERM = true, AFTER_DRAIN = false;
    bf16_t* Q; const LAS float* rope;
    __device__ __forceinline__ void operator()(const pf4 (&acc)[2][2][4][2], const pg8::Unit& u, int wr, int wc, int fr, int fq) const {
        const int sec = u.pn >> 2; bf16_t* base = Q + (size_t)sec * ((WS_K - WS_Q) / 2);
        const bool lat = u.pm < 64, dorope = sec < 2 && lat; const int axis = wc & 1;
        const bool upper = fq >= 2;
        const int row0 = u.pm * 256 + wr * 64 + fr, col0 = (u.pn & 3) * 256 + wc * 32 + 8 * fq;
        const float sc = sec == 0 ? QSCALE : 1.0f;
#pragma unroll
        for (int ai = 0; ai < 2; ++ai)
#pragma unroll
            for (int m = 0; m < 4; ++m) {
                const int row = row0 + ai * 128 + m * 16;
                pf4 cs[2], sn[2];
#pragma unroll
                for (int n = 0; n < 2; ++n) { cs[n] = (pf4){1.f, 1.f, 1.f, 1.f}; sn[n] = (pf4){0.f, 0.f, 0.f, 0.f}; }
                if (dorope) { const int t = row & 2047, pos = axis ? (t & 63) : (t >> 6); const LAS float* rp = rope + pos * 16 + 8 * (fq & 1);
#pragma unroll
                    for (int n = 0; n < 2; ++n) { cs[n] = *(const LAS pf4*)(rp + 4 * n); sn[n] = *(const LAS pf4*)(rp + 1024 + 4 * n); } }
#pragma unroll
                for (int bj = 0; bj < 2; ++bj) {
                    pf4 o[2];
#pragma unroll
                    for (int n = 0; n < 2; ++n)
#pragma unroll
                        for (int j = 0; j < 4; ++j) {
                            const float own = acc[ai][bj][m][n][j];
                            float v = own;
                            if (dorope) {
                                const auto rr = __builtin_amdgcn_permlane32_swap(__float_as_uint(own), __float_as_uint(own), false, false);
                                const float other = __uint_as_float(upper ? rr[0] : rr[1]);
                                v = upper ? (own * cs[n][j] + other * sn[n][j]) : (own * cs[n][j] - other * sn[n][j]);
                            }
                            o[n][j] = v * sc;
                        }
                    u32x4 w; w.x = pk2(o[0][0], o[0][1]); w.y = pk2(o[0][2], o[0][3]); w.z = pk2(o[1][0], o[1][1]); w.w = pk2(o[1][2], o[1][3]);
                    st16_wt(base + (size_t)row * D + col0 + bj * 128, w);
                }
            }
    }
};
struct EpiResid {
    static constexpr bool PERM = true, AFTER_DRAIN = false;
    bf16_t* H; const float* x; const float* ctx; const float* mod; int layer;
    __device__ __forceinline__ void operator()(const pf4 (&acc)[2][2][4][2], const pg8::Unit& u, int wr, int wc, int fr, int fq) const {
        const bool lat = u.pm < 64;
        const float* xb = lat ? x + (size_t)u.pm * 256 * D : ctx + (size_t)(u.pm - 64) * 256 * D;
        const float* g = mod + (size_t)(layer * 9 + (lat ? (u.pm >> 3) : 8)) * 6144 + M_G1;
        bf16_t* out = H + (size_t)u.pm * 256 * D;
        const int r0 = wr * 64 + fr, col0 = u.pn * 256 + wc * 32 + 8 * fq;
        pf4 gv[2][2];
#pragma unroll
        for (int bj = 0; bj < 2; ++bj)
#pragma unroll
            for (int n = 0; n < 2; ++n) gv[bj][n] = *(const pf4*)(g + col0 + bj * 128 + 4 * n);
#pragma unroll
        for (int it = 0; it < 8; ++it) {
            const int ai = it >> 2, m = it & 3;
            const size_t ro = (size_t)(r0 + ai * 128 + m * 16) * D + col0;
#pragma unroll
            for (int bj = 0; bj < 2; ++bj) {
                pf4 b0, b1;
                if (layer == 0) { b0 = *(const pf4*)(xb + ro + bj * 128); b1 = *(const pf4*)(xb + ro + bj * 128 + 4); }
                else { const u32x4 hb = *(const u32x4*)(out + ro + bj * 128); b0 = (pf4){bf_lo(hb.x), bf_hi(hb.x), bf_lo(hb.y), bf_hi(hb.y)}; b1 = (pf4){bf_lo(hb.z), bf_hi(hb.z), bf_lo(hb.w), bf_hi(hb.w)}; }
                const pf4 o0 = b0 + gv[bj][0] * acc[ai][bj][m][0], o1 = b1 + gv[bj][1] * acc[ai][bj][m][1];
                u32x4 w; w.x = pk2(o0[0], o0[1]); w.y = pk2(o0[2], o0[3]); w.z = pk2(o1[0], o1[1]); w.w = pk2(o1[2], o1[3]);
                st16_wt(out + ro + bj * 128, w);
            }
        }
    }
};
struct EpiSwiGLU {
    static constexpr bool PERM = true, AFTER_DRAIN = false;
    bf16_t* ACT;
    __device__ __forceinline__ void operator()(const pf4 (&acc)[2][2][4][2], const pg8::Unit& u, int wr, int wc, int fr, int fq) const {
        const int ct = u.pn % 22;
        bf16_t* p0 = ACT + (size_t)(u.pm * 256 + wr * 64 + fr) * DE + ct * 128 + wc * 32 + 8 * fq;
#pragma unroll
        for (int ai = 0; ai < 2; ++ai)
#pragma unroll
            for (int m = 0; m < 4; ++m) {
                float o[8];
#pragma unroll
                for (int n = 0; n < 2; ++n)
#pragma unroll
                    for (int j = 0; j < 4; ++j) { const float g = acc[ai][0][m][n][j], uu = acc[ai][1][m][n][j]; o[n * 4 + j] = g * __builtin_amdgcn_rcpf(1.0f + fast_exp(-g)) * uu; }
                u32x4 w; w.x = pk2(o[0], o[1]); w.y = pk2(o[2], o[3]); w.z = pk2(o[4], o[5]); w.w = pk2(o[6], o[7]);
                *(u32x4*)(p0 + (size_t)(ai * 128 + m * 16) * DE) = w;
            }
    }
};
struct EpiDown {
    static constexpr bool PERM = true, AFTER_DRAIN = false;
    unsigned char* Y; const float* GATE;
    __device__ __forceinline__ void operator()(const pf4 (&acc)[2][2][4][2], const pg8::Unit& u, int wr, int wc, int fr, int fq) const {
        const int row0 = u.pm * 256 + wr * 64 + fr, col0 = (u.pn & 3) * 256 + wc * 32 + 8 * fq;
        float gts[8];
#pragma unroll
        for (int i = 0; i < 8; ++i) gts[i] = GATE[row0 + (i >> 2) * 128 + (i & 3) * 16] * Y_SCALE;
#pragma unroll
        for (int ai = 0; ai < 2; ++ai)
#pragma unroll
            for (int m = 0; m < 4; ++m) {
                const int row = row0 + ai * 128 + m * 16; const float gt = gts[ai * 4 + m];
#pragma unroll
                for (int bj = 0; bj < 2; ++bj) {
                    const pf4 v0 = acc[ai][bj][m][0] * gt, v1 = acc[ai][bj][m][1] * gt;
                    u32x2 w; w.x = pk4_fp8(v0[0], v0[1], v0[2], v0[3]); w.y = pk4_fp8(v1[0], v1[1], v1[2], v1[3]);
                    st8_wt(Y + (size_t)row * D + col0 + bj * 128, w);
                }
            }
    }
};
struct EpiWin {
    static constexpr bool PERM = true, AFTER_DRAIN = false;
    bf16_t *YG, *XR; const float* bin;
    __device__ __forceinline__ void operator()(const pf4 (&acc)[2][2][4][2], const pg8::Unit& u, int wr, int wc, int fr, int fq) const {
        const bool yb = u.pn < 4; bf16_t* base = yb ? YG : XR;
        const int row0 = u.pm * 256 + wr * 64 + fr, colg = u.pn * 256 + wc * 32 + 8 * fq, col0 = (u.pn & 3) * 256 + wc * 32 + 8 * fq;
        pf4 bv[2][2];
#pragma unroll
        for (int bj = 0; bj < 2; ++bj)
#pragma unroll
            for (int n = 0; n < 2; ++n) bv[bj][n] = *(const pf4*)(bin + colg + bj * 128 + 4 * n);
#pragma unroll
        for (int ai = 0; ai < 2; ++ai)
#pragma unroll
            for (int m = 0; m < 4; ++m) {
                const int row = row0 + ai * 128 + m * 16;
#pragma unroll
                for (int bj = 0; bj < 2; ++bj) {
                    pf4 v0 = acc[ai][bj][m][0] + bv[bj][0], v1 = acc[ai][bj][m][1] + bv[bj][1];
                    if (yb) {
#pragma unroll
                        for (int j = 0; j < 4; ++j) {
                            { const float x = v0[j], uu = 0.7978845608028654f * (x + 0.044715f * x * x * x); v0[j] = x * __builtin_amdgcn_rcpf(1.0f + fast_exp(-2.0f * uu)); }
                            { const float x = v1[j], uu = 0.7978845608028654f * (x + 0.044715f * x * x * x); v1[j] = x * __builtin_amdgcn_rcpf(1.0f + fast_exp(-2.0f * uu)); }
                        }
                    }
                    u32x4 w; w.x = pk2(v0[0], v0[1]); w.y = pk2(v0[2], v0[3]); w.z = pk2(v1[0], v1[1]); w.w = pk2(v1[2], v1[3]);
                    st16_wt(base + (size_t)row * D + col0 + bj * 128, w);
                }
            }
    }
};

#ifndef DENSE_ALIGN
#define DENSE_ALIGN true
#endif
#ifndef DENSE_SP2
#define DENSE_SP2 true
#endif
__device__ __forceinline__ void stagger_start(int ticks) {
    if (ticks > 0 && ((blockIdx.x >> 3) & 1)) { const unsigned long long t0 = __builtin_amdgcn_s_memrealtime(); while (__builtin_amdgcn_s_memrealtime() - t0 < (unsigned long long)ticks) __builtin_amdgcn_s_sleep(8); }
}
#ifndef STG_QKV
#define STG_QKV 0
#endif
#ifndef STG_GU
#define STG_GU 0
#endif
#ifndef STG_DN
#define STG_DN 0
#endif
#ifndef STG_WIN
#define STG_WIN 0
#endif
#ifndef STG_WO
#define STG_WO 0
#endif
#define PG8_RUN(EPI, SCHED, g, S, E) pg8::gemm_phase<EPI, SCHED, DENSE_ALIGN, DENSE_SP2>((PG8_LAS unsigned char*)lds, g, S, E)

__device__ __forceinline__ void ph_qkv_fast(const Ctx& a, LAS unsigned char* lds) {
    unsigned char* ws = a.ws();
    pg8::Gemm g{(const bf16_t*)(ws + WS_XN), (const bf16_t*)(ws + WS_WQKV), RT, 3 * D, D};
    const int Gq = gemm_groups(72 * 12, (int)gridDim.x);
    if ((int)blockIdx.x >= Gq) { cvt8_run(a, 0, CV0_QKV + ((int)blockIdx.x - Gq), (int)gridDim.x - Gq, CV0_QKV + CVQ_QKV, lds); return; }
    ListOrder<MapGrid> S{72 * 12, Gq, (int)blockIdx.x, MapGrid{12}};
    static_assert(WS_V - WS_K == WS_K - WS_Q, "Q|K|V spacing");
    LAS float* rl = (LAS float*)(lds + ROPE_LDS);
    { const float* rg = (const float*)(ws + WS_ROPE); for (int i = threadIdx.x; i < 2048; i += NTHREADS) rl[i] = rg[i]; }
    __syncthreads();
    EpiQKV E{(bf16_t*)(ws + WS_Q), rl};
    stagger_start(STG_QKV);
    PG8_RUN(EpiQKV, ListOrder<MapGrid>, g, S, E);
    if (Gq == (int)gridDim.x) cvt8_tail(a, lds, 72 * 12, Gq, (int)blockIdx.x, 0, CV0_QKV, CVQ_QKV);
}
__device__ __forceinline__ void ph_wo_fast(const Ctx& a, LAS unsigned char* lds) {
    unsigned char* ws = a.ws();
    pg8::Gemm g{(const bf16_t*)(ws + WS_ATT), (const bf16_t*)(ws + WS_WO), RT, D, D};
    const int Gq = gemm_groups(72 * 4, (int)gridDim.x);
    if ((int)blockIdx.x >= Gq) { cvt8_run(a, 0, CV0_WO + ((int)blockIdx.x - Gq), (int)gridDim.x - Gq, CV0_WO + CVQ_WO, lds); return; }
    ListOrder<MapGrid> S{72 * 4, Gq, (int)blockIdx.x, MapGrid{4}};
    EpiResid E{(bf16_t*)(ws + WS_H), a.in(I_X), a.in(I_CTX), (const float*)(ws + WS_MOD), 0};
    stagger_start(STG_WO);
    PG8_RUN(EpiResid, ListOrder<MapGrid>, g, S, E);
    if (Gq == (int)gridDim.x) cvt8_tail(a, lds, 72 * 4, Gq, (int)blockIdx.x, 0, CV0_WO, CVQ_WO);
}
__device__ __forceinline__ void ph_wout_fast(const Ctx& a, LAS unsigned char* lds) {
    unsigned char* ws = a.ws();
    pg8::Gemm g{(const bf16_t*)(ws + WS_HS), (const bf16_t*)(ws + WS_WOUT), RL, D, D};
    ListOrder<MapGrid> S{64 * 4, (int)gridDim.x, (int)blockIdx.x, MapGrid{4}};
    EpiResid E{(bf16_t*)(ws + WS_H), nullptr, nullptr, (const float*)(ws + WS_MOD), 1};
    PG8_RUN(EpiResid, ListOrder<MapGrid>, g, S, E);
}
#if FP8_MOE
struct EpiSwiGLU8 {
    static constexpr bool PERM = true, AFTER_DRAIN = false;
    unsigned char* ACT;
    __device__ __forceinline__ void operator()(const pf4 (&acc)[2][2][4][2], const pg8::Unit& u, int wr, int wc, int fr, int fq) const {
        const int ct = u.pn % 22;
        unsigned char* p0 = ACT + (size_t)(u.pm * 256 + wr * 64 + fr) * DE + ct * 128 + wc * 32 + 8 * fq;
#pragma unroll
        for (int ai = 0; ai < 2; ++ai)
#pragma unroll
            for (int m = 0; m < 4; ++m) {
                float o[8];
#pragma unroll
                for (int n = 0; n < 2; ++n)
#pragma unroll
                    for (int j = 0; j < 4; ++j) { const float g = acc[ai][0][m][n][j], uu = acc[ai][1][m][n][j]; o[n * 4 + j] = g * __builtin_amdgcn_rcpf(1.0f + fast_exp(-g)) * uu; }
                u32x2 w; w.x = pk4_fp8(o[0], o[1], o[2], o[3]); w.y = pk4_fp8(o[4], o[5], o[6], o[7]);
                st8_wt(p0 + (size_t)(ai * 128 + m * 16) * DE, w);
            }
    }
};
__device__ __forceinline__ void ph_gu_fast(const Ctx& a, LAS unsigned char* lds, int layer) {
    unsigned char* ws = a.ws(); const int PM = (layer == 0 ? RPE0 : RPE1) / 256;
    pg8::Gemm g{(const bf16_t*)(ws + WS_XG), (const bf16_t*)(ws + WS_WGU + (size_t)layer * (WGU_LAYER / 2)), NE * PM * 256, NE * 2 * DE, D / 2};
    ListOrder<MapMoe> S{NE * PM * 22, (int)gridDim.x, (int)blockIdx.x, MapMoe{PM, 22}};
    EpiSwiGLU8 E{ws + WS_ACT};
    stagger_start(STG_GU);
    pg8::gemm_phase<EpiSwiGLU8, ListOrder<MapMoe>, GU_ALIGN, true, 122>((PG8_LAS unsigned char*)lds, g, S, E);
    if (layer == 0) cvt8_tail(a, lds, NE * PM * 22, (int)gridDim.x, (int)blockIdx.x, 1, CV1_GU0, CVQ_GU0);
}
__device__ __forceinline__ void ph_dn_fast(const Ctx& a, LAS unsigned char* lds, int layer) {
    unsigned char* ws = a.ws(); const int PM = (layer == 0 ? RPE0 : RPE1) / 256;
    pg8::Gemm g{(const bf16_t*)(ws + WS_ACT), (const bf16_t*)(ws + WS_WDN + (size_t)layer * (WDN_LAYER / 2)), NE * PM * 256, NE * D, DE / 2};
    const int Gq = layer == 0 ? gemm_groups(NE * PM * 4, (int)gridDim.x) : (int)gridDim.x;
    if ((int)blockIdx.x >= Gq) { cvt8_run(a, 1, CV1_DN0 + ((int)blockIdx.x - Gq), (int)gridDim.x - Gq, CV1_DN0 + CVQ_DN0, lds); return; }
    ListOrder<MapMoe> S{NE * PM * 4, Gq, (int)blockIdx.x, MapMoe{PM, 4}};
    EpiDown E{ws + WS_Y, (const float*)(ws + WS_GATE)};
    stagger_start(STG_DN);
    pg8::gemm_phase<EpiDown, ListOrder<MapMoe>, DN_ALIGN, true, 121>((PG8_LAS unsigned char*)lds, g, S, E);
    if (layer == 0 && Gq == (int)gridDim.x) cvt8_tail(a, lds, NE * PM * 4, Gq, (int)blockIdx.x, 1, CV1_DN0, CVQ_DN0);
}
#else
__device__ __forceinline__ void ph_gu_fast(const Ctx& a, LAS unsigned char* lds, int layer) {
    unsigned char* ws = a.ws(); const int PM = (layer == 0 ? RPE0 : RPE1) / 256;
    pg8::Gemm g{(const bf16_t*)(ws + WS_XG), (const bf16_t*)(ws + WS_WGU + (size_t)layer * WGU_LAYER), NE * PM * 256, NE * 2 * DE, D};
    ListOrder<MapMoe> S{NE * PM * 22, (int)gridDim.x, (int)blockIdx.x, MapMoe{PM, 22}};
    EpiSwiGLU E{(bf16_t*)(ws + WS_ACT)};
    PG8_RUN(EpiSwiGLU, ListOrder<MapMoe>, g, S, E);
}
__device__ __forceinline__ void ph_dn_fast(const Ctx& a, LAS unsigned char* lds, int layer) {
    unsigned char* ws = a.ws(); const int PM = (layer == 0 ? RPE0 : RPE1) / 256;
    pg8::Gemm g{(const bf16_t*)(ws + WS_ACT), (const bf16_t*)(ws + WS_WDN + (size_t)layer * WDN_LAYER), NE * PM * 256, NE * D, DE};
    const int Gq = layer == 0 ? gemm_groups(NE * PM * 4, (int)gridDim.x) : (int)gridDim.x;
    if ((int)blockIdx.x >= Gq) { cvt8_run(a, 1, CV1_DN0 + ((int)blockIdx.x - Gq), (int)gridDim.x - Gq, CV1_DN0 + CVQ_DN0, lds); return; }
    ListOrder<MapMoe> S{NE * PM * 4, Gq, (int)blockIdx.x, MapMoe{PM, 4}};
    EpiDown E{ws + WS_Y, (const float*)(ws + WS_GATE)};
    PG8_RUN(EpiDown, ListOrder<MapMoe>, g, S, E);
}
#endif
__device__ __forceinline__ void ph_win_fast(const Ctx& a, LAS unsigned char* lds) {
    unsigned char* ws = a.ws();
    pg8::Gemm g{(const bf16_t*)(ws + WS_XN), (const bf16_t*)(ws + WS_WIN), RT, 2 * D, D};
    const int Gq = gemm_groups(512 + 32, (int)gridDim.x);
    if ((int)blockIdx.x >= Gq) { cvt8_run(a, 1, CV1_WIN + ((int)blockIdx.x - Gq), (int)gridDim.x - Gq, CV1_WIN + CVQ_WIN, lds); return; }
    ListOrder<MapWin> S{512 + 32, Gq, (int)blockIdx.x, MapWin{}};
    EpiWin E{(bf16_t*)(ws + WS_YG), (bf16_t*)(ws + WS_XR), a.in(I_BIN)};
    stagger_start(STG_WIN);
    PG8_RUN(EpiWin, ListOrder<MapWin>, g, S, E);
    if (Gq == (int)gridDim.x) cvt8_tail(a, lds, 512 + 32, Gq, (int)blockIdx.x, 1, CV1_WIN, CVQ_WIN);
}

namespace fa {
using bf16x8 = __attribute__((ext_vector_type(8))) short;
using s16x4  = __attribute__((ext_vector_type(4))) short;
using f32x16 = __attribute__((ext_vector_type(16))) float;
using u32x4v = __attribute__((ext_vector_type(4))) unsigned;
constexpr int SHM_V = 64 * 128 * 2, SHM_K = 64 * 128 * 2;
#ifndef ATT_THR
#define ATT_THR 11.5f
#endif
constexpr float THR_L2 = ATT_THR;
#define KSWZ(row, colB) ((row) * 256 + ((colB) ^ (((row) & 7) << 4)))
#define SBAR() __builtin_amdgcn_sched_barrier(0)
__device__ __forceinline__ int crow(int r, int hi) { return (r & 3) + 8 * (r >> 2) + 4 * hi; }
__device__ __forceinline__ unsigned cvtpk(float lo, float hi) { unsigned r; asm volatile("v_cvt_pk_bf16_f32 %0, %1, %2" : "=v"(r) : "v"(lo), "v"(hi)); return r; }
__device__ __forceinline__ void partialSM(f32x16& p0, f32x16& p1, float& m_reg, float& mn, float& alpha) {
  float pmax = p0[0];
#pragma unroll
  for (int r = 1; r < 16; ++r) pmax = fmaxf(pmax, p0[r]);
#pragma unroll
  for (int r = 0; r < 16; ++r) pmax = fmaxf(pmax, p1[r]);
  { auto rr = __builtin_amdgcn_permlane32_swap(__float_as_uint(pmax), __float_as_uint(pmax), false, false);
    pmax = fmaxf(__uint_as_float(rr[0]), __uint_as_float(rr[1])); }
  if (__builtin_expect(__all(pmax - m_reg <= THR_L2), 1)) { mn = m_reg; alpha = 1.f; }
  else { mn = fmaxf(m_reg, pmax); alpha = __builtin_amdgcn_exp2f(m_reg - mn); m_reg = mn; }
  { typedef float f2_t __attribute__((ext_vector_type(2))); const f2_t mn2 = {mn, mn};
#pragma unroll
    for (int r = 0; r < 16; r += 2) { const f2_t a_ = (f2_t){p0[r], p0[r + 1]} - mn2; p0[r] = a_.x; p0[r + 1] = a_.y; const f2_t b_ = (f2_t){p1[r], p1[r + 1]} - mn2; p1[r] = b_.x; p1[r + 1] = b_.y; } }
#pragma unroll
  for (int r = 0; r < 16; ++r) p0[r] = __builtin_amdgcn_exp2f(p0[r]);
}
__device__ __forceinline__ void finishSM(f32x16& p0, f32x16& p1, float alpha, float& l_reg, bf16x8& pa0, bf16x8& pa1, bf16x8& pa2, bf16x8& pa3) {
#pragma unroll
  for (int r = 0; r < 16; ++r) p1[r] = __builtin_amdgcn_exp2f(p1[r]);
  float ps = 0;
#pragma unroll
  for (int r = 0; r < 16; ++r) ps += p0[r];
#pragma unroll
  for (int r = 0; r < 16; ++r) ps += p1[r];
  { auto rr = __builtin_amdgcn_permlane32_swap(__float_as_uint(ps), __float_as_uint(ps), false, false);
    ps = __uint_as_float(rr[0]) + __uint_as_float(rr[1]); }
  l_reg = l_reg * alpha + ps;
#define PK4(P, BASE, OUT) do { unsigned a0 = cvtpk(P[BASE + 0], P[BASE + 1]), a1 = cvtpk(P[BASE + 2], P[BASE + 3]);   \
    unsigned b0 = cvtpk(P[BASE + 4], P[BASE + 5]), b1 = cvtpk(P[BASE + 6], P[BASE + 7]);                              \
    auto r0 = __builtin_amdgcn_permlane32_swap(a0, b0, false, false); auto r1 = __builtin_amdgcn_permlane32_swap(a1, b1, false, false); \
    u32x4v w = {r0[0], r1[0], r0[1], r1[1]}; OUT = *reinterpret_cast<bf16x8*>(&w); } while (0)
  PK4(p0, 0, pa0); PK4(p0, 8, pa1); PK4(p1, 0, pa2); PK4(p1, 8, pa3);
#undef PK4
}
__device__ __forceinline__ void qkt(f32x16& p0, f32x16& p1, const LAS char* Ks, const bf16x8* qr, int r32, int hi, int s) {
  p0 = f32x16{}; p1 = f32x16{};
#pragma unroll
  for (int d0 = 0; d0 < 4; ++d0) { const int cb = (s * 64 + d0 * 16 + hi * 8) * 2;
    const bf16x8 b0 = *reinterpret_cast<const LAS bf16x8*>(Ks + KSWZ(r32, cb));
    const bf16x8 b1 = *reinterpret_cast<const LAS bf16x8*>(Ks + KSWZ(32 + r32, cb));
    p0 = __builtin_amdgcn_mfma_f32_32x32x16_bf16(b0, qr[d0], p0, 0, 0, 0);
    p1 = __builtin_amdgcn_mfma_f32_32x32x16_bf16(b1, qr[d0], p1, 0, 0, 0); }
}
__device__ __forceinline__ int v_st(int k, int c) { const int kk = (k & ~0xC) | ((k & 4) << 1) | ((k & 8) >> 1); return ((kk >> 3) * 4 + (c >> 5)) * 512 + ((kk & 7) * 32 + (c & 31)) * 2; }
__device__ __forceinline__ int v_rd_base(int lane) { return ((lane & 3) << 3) | (((lane >> 2) & 3) << 6) | (((lane >> 4) & 1) << 5) | (((lane >> 5) & 1) << 8); }
constexpr int v_rd_off(int d0, int ks, int half) { return d0 * 512 + ks * 4096 + half * 2048; }
template <int OFF> __device__ __forceinline__ s16x4 tr_read(int vb) {
  s16x4 r; asm volatile("ds_read_b64_tr_b16 %0, %1 offset:%2" : "=&v"(r) : "v"(vb), "i"(OFF) : "memory"); return r;
}
template <int D0> __device__ __forceinline__ void pv_one(f32x16& od, int vb, bf16x8 pa0, bf16x8 pa1, bf16x8 pa2, bf16x8 pa3) {
  const s16x4 l0 = tr_read<v_rd_off(D0, 0, 0)>(vb), h0 = tr_read<v_rd_off(D0, 0, 1)>(vb), l1 = tr_read<v_rd_off(D0, 1, 0)>(vb), h1 = tr_read<v_rd_off(D0, 1, 1)>(vb);
  const s16x4 l2 = tr_read<v_rd_off(D0, 2, 0)>(vb), h2 = tr_read<v_rd_off(D0, 2, 1)>(vb), l3 = tr_read<v_rd_off(D0, 3, 0)>(vb), h3 = tr_read<v_rd_off(D0, 3, 1)>(vb);
  asm volatile("s_waitcnt lgkmcnt(0)" ::: "memory"); SBAR();
#define PK(L, H) (bf16x8){L[0], L[1], L[2], L[3], H[0], H[1], H[2], H[3]}
  od = __builtin_amdgcn_mfma_f32_32x32x16_bf16(pa0, PK(l0, h0), od, 0, 0, 0);
  od = __builtin_amdgcn_mfma_f32_32x32x16_bf16(pa1, PK(l1, h1), od, 0, 0, 0);
  od = __builtin_amdgcn_mfma_f32_32x32x16_bf16(pa2, PK(l2, h2), od, 0, 0, 0);
  od = __builtin_amdgcn_mfma_f32_32x32x16_bf16(pa3, PK(l3, h3), od, 0, 0, 0);
#undef PK
}
__device__ __forceinline__ void pv_d0(f32x16* o, int vb, bf16x8 pa0, bf16x8 pa1, bf16x8 pa2, bf16x8 pa3) {
  pv_one<0>(o[0], vb, pa0, pa1, pa2, pa3); pv_one<1>(o[1], vb, pa0, pa1, pa2, pa3); pv_one<2>(o[2], vb, pa0, pa1, pa2, pa3); pv_one<3>(o[3], vb, pa0, pa1, pa2, pa3);
}

__device__ __forceinline__ int tile_row(bool latq, int b, int j) { return latq ? (j < 32 ? b * SEQ + 64 * j : RL + b * CTXL + 64 * (j - 32)) : RL + b * CTXL + 64 * j; }

__device__ __forceinline__ void attn_unit(const bf16_t* __restrict__ Qg, const bf16_t* __restrict__ Kg, const bf16_t* __restrict__ Vg, bf16_t* __restrict__ ATT,
                                          const float* subg, float lam, bool latq, int b, int h, int qrow0, LAS unsigned char* lds) {
  const int tid = threadIdx.x, wid = __builtin_amdgcn_readfirstlane(tid >> 6), lane = tid & 63, r32 = lane & 31, hi = lane >> 5, rg = wid >> 1, s = wid & 1;
  LAS char* V_lds = (LAS char*)lds; LAS char* K_lds = (LAS char*)lds + 2 * SHM_V;
  LAS float* ws = (LAS float*)(lds + 65536) + wid * 64; LAS float* li_l = ws; LAS float* al_l = ws + 32;
  const int NT = latq ? 36 : 4;
  float m_reg = -1e30f, l_reg = 0; f32x16 o[4] = {}; bf16x8 qr[4];
  const bf16_t* Qw = Qg + (size_t)(qrow0 + rg * 32 + r32) * D + h * 128 + s * 64 + hi * 8;
#pragma unroll
  for (int d0 = 0; d0 < 4; ++d0) qr[d0] = *reinterpret_cast<const bf16x8*>(Qw + d0 * 16);
  const int sr = tid >> 4, sc = (tid & 15) * 8, vst0 = v_st(sr, sc), vst1 = v_st(32 + sr, sc);
  const int vb0 = (int)(unsigned)(size_t)V_lds + v_rd_base(lane);
  const size_t hoff = (size_t)h * 128 + sc;
  struct { bf16x8 vs0, vs1, ks0, ks1; } sr_[2];
#define SLOAD(i, j) do { const size_t ro_ = (size_t)(tile_row(latq, b, (j)) + sr) * D + hoff; \
    sr_[i].vs0 = *reinterpret_cast<const bf16x8*>(Vg + ro_); sr_[i].vs1 = *reinterpret_cast<const bf16x8*>(Vg + ro_ + 32 * D); \
    sr_[i].ks0 = *reinterpret_cast<const bf16x8*>(Kg + ro_); sr_[i].ks1 = *reinterpret_cast<const bf16x8*>(Kg + ro_ + 32 * D); } while (0)
#define SWRITE(bb, i) do { *(LAS bf16x8*)(V_lds + (bb) * SHM_V + vst0) = sr_[i].vs0; *(LAS bf16x8*)(V_lds + (bb) * SHM_V + vst1) = sr_[i].vs1; const int kc = sc * 2; \
    *(LAS bf16x8*)(K_lds + (bb) * SHM_K + KSWZ(sr, kc)) = sr_[i].ks0; *(LAS bf16x8*)(K_lds + (bb) * SHM_K + KSWZ(32 + sr, kc)) = sr_[i].ks1; } while (0)
#define SWAIT() asm volatile("s_waitcnt vmcnt(4)" ::: "memory")
#define RESC(a_) do { if (__any((a_) < 1.f)) { if (hi == 0) al_l[r32] = (a_); asm volatile("s_waitcnt lgkmcnt(0)" ::: "memory"); \
    _Pragma("unroll") for (int d = 0; d < 4; ++d) _Pragma("unroll") for (int r = 0; r < 16; ++r) o[d][r] *= al_l[crow(r, hi)]; } } while (0)
  f32x16 pA0, pA1, pB0, pB1; float mnA, mnB, alA, alB; bf16x8 pa0, pa1, pa2, pa3;
  constexpr int SE = 0, SO = 1;
  SLOAD(SE, 0); asm volatile("s_waitcnt vmcnt(0)" ::: "memory"); SWRITE(0, SE); __syncthreads();
  qkt(pA0, pA1, K_lds, qr, r32, hi, s); partialSM(pA0, pA1, m_reg, mnA, alA);
  SLOAD(SO, 1); if (2 < NT) SLOAD(SE, 2);
  SWAIT(); SWRITE(1, SO); __syncthreads();
  for (int j = 1; j + 1 < NT; j += 2) {
    SBAR(); qkt(pB0, pB1, K_lds + SHM_K, qr, r32, hi, s);
    finishSM(pA0, pA1, alA, l_reg, pa0, pa1, pa2, pa3); SBAR();
    SLOAD(SO, j + 2); SBAR();
    pv_d0(o, vb0, pa0, pa1, pa2, pa3); partialSM(pB0, pB1, m_reg, mnB, alB);
    __syncthreads(); SWAIT(); SWRITE(0, SE);
    RESC(alB); __syncthreads();
    SBAR(); qkt(pA0, pA1, K_lds, qr, r32, hi, s);
    finishSM(pB0, pB1, alB, l_reg, pa0, pa1, pa2, pa3); SBAR();
    if (j + 3 < NT) SLOAD(SE, j + 3); SBAR();
    pv_d0(o, vb0 + SHM_V, pa0, pa1, pa2, pa3); partialSM(pA0, pA1, m_reg, mnA, alA);
    __syncthreads(); SWAIT(); SWRITE(1, SO);
    RESC(alA); __syncthreads();
  }
  SBAR(); qkt(pB0, pB1, K_lds + SHM_K, qr, r32, hi, s);
  finishSM(pA0, pA1, alA, l_reg, pa0, pa1, pa2, pa3); SBAR();
  pv_d0(o, vb0, pa0, pa1, pa2, pa3); partialSM(pB0, pB1, m_reg, mnB, alB);
  __syncthreads(); RESC(alB);
  finishSM(pB0, pB1, alB, l_reg, pa0, pa1, pa2, pa3); SBAR();
  pv_d0(o, vb0 + SHM_V, pa0, pa1, pa2, pa3);
#undef SLOAD
#undef SWRITE
#undef SWAIT
#undef RESC
  if (hi == 0) li_l[r32] = l_reg;
  asm volatile("s_waitcnt lgkmcnt(0)" ::: "memory");
  float rli[16];
#pragma unroll
  for (int r = 0; r < 16; ++r) rli[r] = __builtin_amdgcn_rcpf(li_l[crow(r, hi)]);
  __syncthreads();
  LAS float* X = (LAS float*)lds + rg * 4096;
  if (s == 1) {
#pragma unroll
    for (int r = 0; r < 16; ++r)
#pragma unroll
      for (int d0 = 0; d0 < 4; ++d0) X[crow(r, hi) * 128 + d0 * 32 + r32] = o[d0][r] * (rli[r] * lam);
  }
  __syncthreads();
  if (s == 0) {
    float rstd[16];
#pragma unroll
    for (int r = 0; r < 16; ++r) {
      float acc = 0.f;
#pragma unroll
      for (int d0 = 0; d0 < 4; ++d0) { const float v = o[d0][r] * rli[r] - X[crow(r, hi) * 128 + d0 * 32 + r32]; o[d0][r] = v; acc += v * v; }
#pragma unroll
      for (int off = 1; off < 32; off <<= 1) acc += __shfl_xor(acc, off);
      rstd[r] = 1.0f / sqrtf(acc * (1.0f / 128.0f) + EPS);
    }
    LAS bf16_t* stg = (LAS bf16_t*)(lds + 65536 + 2048) + rg * 4096;
    float gsc[4];
#pragma unroll
    for (int d0 = 0; d0 < 4; ++d0) gsc[d0] = subg[d0 * 32 + r32] * (1.0f - LAMBDA_INIT0);
#pragma unroll
    for (int r = 0; r < 16; ++r)
#pragma unroll
      for (int d0 = 0; d0 < 4; ++d0) stg[crow(r, hi) * 128 + d0 * 32 + r32] = (bf16_t)f2bf(o[d0][r] * rstd[r] * gsc[d0]);
    asm volatile("s_waitcnt lgkmcnt(0)" ::: "memory");
    bf16_t* Ow = ATT + (size_t)(qrow0 + rg * 32) * D + h * 128;
#pragma unroll
    for (int i = 0; i < 8; ++i) { const int row = i * 4 + (lane >> 4), ch = lane & 15; const u32x4v v = *(const LAS u32x4v*)(stg + row * 128 + ch * 8); *(u32x4v*)(Ow + (size_t)row * D + ch * 8) = v; }
  }
  __syncthreads();
}
#undef KSWZ
#undef SBAR
}

__device__ __forceinline__ void ph_attn_fast(const Ctx& a, LAS unsigned char* lds) {
    unsigned char* ws = a.ws();
    const bf16_t* Q = (const bf16_t*)(ws + WS_Q); const bf16_t* Kb = (const bf16_t*)(ws + WS_K); const bf16_t* V = (const bf16_t*)(ws + WS_V);
    bf16_t* ATT = (bf16_t*)(ws + WS_ATT); const float* subg = a.in(I_SUBG);
    const float lam = diff_lambda(a, threadIdx.x & 63);
    const int G = gridDim.x, c = blockIdx.x;
    for (int i = 0;; ++i) {
        const long L = (long)i * G + c; if (L >= 1024) break;
        const int w = xcd_remap(L, 1024), bh = w >> 4, qb = w & 15, b = bh >> 3, h = bh & 7;
        fa::attn_unit(Q, Kb, V, ATT, subg, lam, true, b, h, b * SEQ + qb * 128, lds);
    }
    for (int L = c; L < 128; L += G) {
        const int bh = L >> 1, qb = L & 1, b = bh >> 3, h = bh & 7;
        fa::attn_unit(Q, Kb, V, ATT, subg, lam, false, b, h, RL + b * CTXL + qb * 128, lds);
    }
}


__device__ __forceinline__ void ph_gates_fast(const Ctx& a, LAS unsigned char* lds) {
    unsigned char* ws = a.ws();
    const bf16_t* XR = (const bf16_t*)(ws + WS_XR); const bf16_t* WG = (const bf16_t*)(ws + WS_WG);
    bf16_t* LOGA = (bf16_t*)(ws + WS_LOGA); unsigned char* BT = ws + WS_BT;
    const float* convw = a.in(I_CONVW); const float* convb = a.in(I_CONVB); const float* gtab = (const float*)(ws + WS_GTAB);
    const int tid = threadIdx.x, wid = __builtin_amdgcn_readfirstlane(tid >> 6), lane = tid & 63, wr = wid >> 2, wc = wid & 3, fr = lane & 15, fq = lane >> 4;
    constexpr int HTB = pg8::HTB;
    const int aoff = pg8::lds_byte(wr * 64 + fr, fq * 8), boff = pg8::lds_byte(wc * 32 + fr, fq * 8);
    const int sc = tid & 15, rg8 = tid >> 4;
    unsigned bsrc[2];
#pragma unroll
    for (int i = 0; i < 2; ++i) { int R, C; pg8::stage_rc(tid * 16 + i * 8192, R, C); bsrc[i] = (unsigned)(((R & ~31) + pg8::perm32(R & 31)) * 128 + C) * 2u; }
    const unsigned ldsw = (unsigned)wid * 1024u;
#define GT_DMA_B(d_) do { const char* wb_ = (const char*)(WG + (size_t)((d_) * 8 + kb) * 256 * 128); \
        _Pragma("unroll") for (int kt_ = 0; kt_ < 2; ++kt_) _Pragma("unroll") for (int h_ = 0; h_ < 2; ++h_) _Pragma("unroll") for (int i_ = 0; i_ < 2; ++i_) \
            __builtin_amdgcn_global_load_lds((const unsigned*)(wb_ + (size_t)h_ * 128 * 256 + kt_ * 128 + bsrc[i_]), (LAS unsigned*)(lds + (4 + kt_ * 2 + h_) * HTB + ldsw + i_ * 8192), 16, 0, 0); } while (0)
    const int Gq = gemm_groups(72 * 8, (int)gridDim.x);
    if ((int)blockIdx.x >= Gq) { cvt8_run(a, 1, CV1_GATES + ((int)blockIdx.x - Gq), (int)gridDim.x - Gq, CV1_GATES + CVQ_GATES, lds); return; }
    for (int u = blockIdx.x; u < 72 * 8; u += Gq) {
        const int kb = u & 7, rt = u >> 3;
        const bool lat = rt < 64; const int bsm = lat ? (rt >> 3) : (rt - 64), t0 = lat ? (rt & 7) * 256 : 0, L = lat ? SEQ : CTXL;
        const int seqbase = lat ? bsm * SEQ : RL + bsm * CTXL;
        GT_DMA_B(0);
        {
            const int ch0 = kb * 128 + sc * 8, r0 = rg8 * 8;
            u32x4 xin[11];
#pragma unroll
            for (int i = 0; i < 11; ++i) { const int tt = t0 + r0 - 2 + i; xin[i] = (tt >= 0 && tt < L) ? *(const u32x4*)(XR + (size_t)(seqbase + tt) * D + ch0) : (u32x4){0u, 0u, 0u, 0u}; }
            f32x4 cw[4][2], cb[2];
#pragma unroll
            for (int j = 0; j < 4; ++j) { cw[j][0] = *(const f32x4*)(convw + j * D + ch0); cw[j][1] = *(const f32x4*)(convw + j * D + ch0 + 4); }
            cb[0] = *(const f32x4*)(convb + ch0); cb[1] = *(const f32x4*)(convb + ch0 + 4);
#pragma unroll
            for (int k = 0; k < 8; ++k) {
                f32x4 o0 = cb[0], o1 = cb[1];
#pragma unroll
                for (int j = 0; j < 4; ++j) { const u32x4 x = xin[k + j];
                    o0 += cw[j][0] * (f32x4){bf_lo(x.x), bf_hi(x.x), bf_lo(x.y), bf_hi(x.y)}; o1 += cw[j][1] * (f32x4){bf_lo(x.z), bf_hi(x.z), bf_lo(x.w), bf_hi(x.w)}; }
                const int r = r0 + k;
                u32x4 w; w.x = pk2(o0[0], o0[1]); w.y = pk2(o0[2], o0[3]); w.z = pk2(o1[0], o1[1]); w.w = pk2(o1[2], o1[3]);
                *(LAS u32x4*)(lds + ((sc >> 3) * 2 + (r >> 7)) * HTB + pg8::lds_byte(r & 127, (sc & 7) * 8)) = w;
            }
        }
#pragma unroll 1
        for (int d = 0; d < 2; ++d) {
            asm volatile("s_waitcnt vmcnt(0)" ::: "memory");
            __syncthreads();
            pf4 acc[2][2][4][2];
#pragma unroll
            for (int ai = 0; ai < 2; ++ai)
#pragma unroll
                for (int bj = 0; bj < 2; ++bj)
#pragma unroll
                    for (int m = 0; m < 4; ++m)
#pragma unroll
                        for (int n = 0; n < 2; ++n) acc[ai][bj][m][n] = (pf4){0.f, 0.f, 0.f, 0.f};
#pragma unroll 1
            for (int kt = 0; kt < 2; ++kt)
#pragma unroll
                for (int ai = 0; ai < 2; ++ai) {
                    __builtin_amdgcn_sched_barrier(0);
                    pg8::bf16x8 At[4][2];
#pragma unroll
                    for (int m = 0; m < 4; ++m)
#pragma unroll
                        for (int k = 0; k < 2; ++k) At[m][k] = *(const LAS pg8::bf16x8*)(lds + (kt * 2 + ai) * HTB + aoff + m * 2048 + k * 1024);
#pragma unroll
                    for (int bj = 0; bj < 2; ++bj) {
                        pg8::bf16x8 Bf[2][2];
#pragma unroll
                        for (int n = 0; n < 2; ++n)
#pragma unroll
                            for (int k = 0; k < 2; ++k) Bf[n][k] = *(const LAS pg8::bf16x8*)(lds + (4 + kt * 2 + bj) * HTB + boff + n * 2048 + k * 1024);
#pragma unroll
                        for (int m = 0; m < 4; ++m)
#pragma unroll
                            for (int n = 0; n < 2; ++n)
#pragma unroll
                                for (int k = 0; k < 2; ++k) acc[ai][bj][m][n] = __builtin_amdgcn_mfma_f32_16x16x32_bf16(Bf[n][k], At[m][k], acc[ai][bj][m][n], 0, 0, 0);
                        __builtin_amdgcn_sched_barrier(0);
                    }
                }
            if (d == 0) { __syncthreads(); GT_DMA_B(1); }
            const int cc0 = wc * 32 + fq * 8;
            pf4 cl[2], c2[2], brn[2], bin[2];
#pragma unroll
            for (int n = 0; n < 2; ++n) { const float* g = gtab + (size_t)(d * 4) * D + kb * 128 + cc0 + 4 * n;
                cl[n] = *(const pf4*)g; c2[n] = *(const pf4*)(g + D); brn[n] = *(const pf4*)(g + 2 * D); bin[n] = *(const pf4*)(g + 3 * D); }
#pragma unroll
            for (int ai = 0; ai < 2; ++ai)
#pragma unroll
                for (int m = 0; m < 4; ++m) {
                    const int rl = wr * 64 + m * 16 + fr;
                    const int grow = seqbase + t0 + ai * 128 + rl;
                    float la[8], bt[8];
#pragma unroll
                    for (int n = 0; n < 2; ++n) {
                        const int cc = cc0 + 4 * n;
                        const u32x2 xw = *(const LAS u32x2*)(lds + ((cc >> 6) * 2 + ai) * HTB + pg8::lds_byte(rl, cc & 63));
                        const float xv[4] = {bf_lo(xw.x), bf_hi(xw.x), bf_lo(xw.y), bf_hi(xw.y)};
#pragma unroll
                        for (int j = 0; j < 4; ++j) {
                            const float r = __builtin_amdgcn_rcpf(1.0f + __builtin_amdgcn_exp2f(fmaf(acc[ai][0][m][n][j], -1.4426950408889634f, brn[n][j])));
                            const float ig = __builtin_amdgcn_rcpf(1.0f + __builtin_amdgcn_exp2f(fmaf(acc[ai][1][m][n][j], -1.4426950408889634f, bin[n][j])));
                            const float om = 1.0f - __builtin_amdgcn_exp2f(r * c2[n][j]);
                            la[n * 4 + j] = r * cl[n][j]; bt[n * 4 + j] = __builtin_amdgcn_sqrtf(om) * (ig * xv[j]) * BT_SCALE;
                        }
                    }
                    const size_t o = ((size_t)d * RT + grow) * D + kb * 128 + cc0;
                    u32x4 w; w.x = pk2(la[0], la[1]); w.y = pk2(la[2], la[3]); w.z = pk2(la[4], la[5]); w.w = pk2(la[6], la[7]);
                    *(u32x4*)(LOGA + o) = w;
                    u32x2 wb; wb.x = pk4_fp8(bt[0], bt[1], bt[2], bt[3]); wb.y = pk4_fp8(bt[4], bt[5], bt[6], bt[7]);
                    *(u32x2*)(BT + o) = wb;
                }
        }
#if FUSE_SCAN1
        asm volatile("s_waitcnt vmcnt(0)" ::: "memory");
        __syncthreads();
        {
            const int dir = wid >> 2, lc = wid & 3, kc = (t0 >> 6) + lc;
            const int c = dir == 0 ? (lat ? NCH_CTX + kc : kc) : (lat ? NCH - 1 - kc : NCH_CTX - 1 - kc);
            const int ch = kb * 128 + 2 * lane;
            float* CP = (float*)(ws + WS_CP); float* CB = (float*)(ws + WS_CB);
            float h0 = 0.f, h1 = 0.f, p0 = 0.f, p1 = 0.f;
#pragma unroll 1
            for (int sg = 0; sg < SCH; sg += 32) {
                unsigned la[32], bt[32];
#pragma unroll
                for (int i = 0; i < 32; ++i) { const size_t o = ((size_t)dir * RT + scan_row(bsm, dir, c, sg + i)) * D + ch; la[i] = *(const unsigned*)(LOGA + o); bt[i] = *(const unsigned short*)(BT + o); }
                asm volatile("" ::: "memory");
#pragma unroll
                for (int i = 0; i < 32; ++i) { const float l0 = bf_lo(la[i]), l1 = bf_hi(la[i]); const f32x2 bb = __builtin_amdgcn_cvt_pk_f32_fp8((int)bt[i], false);
                    h0 = __builtin_amdgcn_exp2f(l0) * h0 + bb.x; h1 = __builtin_amdgcn_exp2f(l1) * h1 + bb.y; p0 += l0; p1 += l1; }
            }
            const size_t so = ((size_t)(bsm * 2 + dir) * NCH + c) * D + ch;
            *(f32x2*)(CP + so) = (f32x2){p0, p1}; *(f32x2*)(CB + so) = (f32x2){h0, h1};
        }
#endif
        __syncthreads();
    }
#undef GT_DMA_B
    if (Gq == (int)gridDim.x) cvt8_tail(a, lds, 72 * 8, Gq, (int)blockIdx.x, 1, CV1_GATES, CVQ_GATES);
}

constexpr int NPHASES = 25;
__host__ __device__ constexpr bool phase_enabled(int p) {
    return !((p == 3 && FAST_QKV) || (p == 9 && FAST_GU) || (p == 22 && FAST_GU) || (p == 13 && FAST_GATES) || (p == 15 && FAST_GATES) || (p == 16 && FAST_GATES && FUSE_SCAN1));
}

__global__ void __launch_bounds__(NTHREADS, 2) hybrid_fwd(Args args) {
    extern __shared__ __attribute__((aligned(16))) unsigned char lds_raw[];
    LAS unsigned char* lds = (LAS unsigned char*)lds_raw;
    volatile LAS unsigned* MISC = (volatile LAS unsigned*)(lds + MISC_OFF);
    const int lo = args.ph_lo, hi = args.ph_hi;
    if (threadIdx.x == 0) {
        LAS unsigned long long* la64 = (LAS unsigned long long*)(lds + ARGS_OFF);
#pragma unroll
        for (int i = 0; i < 27; ++i) la64[i] = (unsigned long long)args.in[i];
        la64[27] = (unsigned long long)args.out; la64[28] = (unsigned long long)args.ws;
    }
    Ctx ctx; ctx.la = (const LAS unsigned*)(lds + ARGS_OFF);
    if (threadIdx.x < 16) MISC[threadIdx.x] = 0u;
    __syncthreads();
#if MK_ONE_LAUNCH
    XcdBarrier bar = xcd_barrier_post((unsigned*)(ctx.ws() + WS_CTL) + CW_BAR, MISC + 8);
#define GRID_BAR() xcd_barrier(bar)
#else
#define GRID_BAR() do { } while (0)
#endif
#ifndef REP_MASK
#define REP_MASK 0u
#endif
#define RUN(k, call) do { call; if constexpr (((REP_MASK) >> (k)) & 1u) { __syncthreads(); call; } } while (0)
#define IN(k) (lo <= (k) && (k) < hi)
#define SEAM(k) do { if ((k) + 1 < hi) GRID_BAR(); } while (0)

    if (IN(0)) { RUN(0, ph_prologue(ctx, lds)); SEAM(0); }
    if (IN(1)) { RUN(1, ph_norm1_l0(ctx)); SEAM(1); }
    if (IN(2)) {
#if FAST_QKV
        RUN(2, ph_qkv_fast(ctx, lds));
#else
        RUN(2, ph_qkv_naive(ctx, lds));
#endif
        SEAM(2); }
#if !FAST_QKV
    if (IN(3)) { RUN(3, ph_rope_naive(ctx)); SEAM(3); }
#endif
    if (IN(4)) {
#if FAST_ATTN
        RUN(4, ph_attn_fast(ctx, lds));
#else
        RUN(4, ph_attn_naive(ctx, lds));
#endif
        SEAM(4); }
    if (IN(5)) {
#if FAST_WO
        RUN(5, ph_wo_fast(ctx, lds));
#else
        RUN(5, ph_wo_naive(ctx, lds));
#endif
        SEAM(5); }
    if (IN(6)) { RUN(6, ph_norm2_router(ctx, lds, 0, RT)); SEAM(6); }
    if (IN(7)) { RUN(7, ph_topk_gather(ctx, lds, 0)); SEAM(7); }
    if (IN(8)) {
#if FAST_GU
        RUN(8, ph_gu_fast(ctx, lds, 0));
#else
        RUN(8, ph_gu_naive(ctx, lds, 0));
#endif
        SEAM(8); }
#if !FAST_GU
    if (IN(9)) { RUN(9, ph_swiglu_naive(ctx, 0)); SEAM(9); }
#endif
    if (IN(10)) {
#if FAST_DN
        RUN(10, ph_dn_fast(ctx, lds, 0));
#else
        RUN(10, ph_dn_naive(ctx, lds, 0));
#endif
        SEAM(10); }
    if (IN(11)) { RUN(11, ph_combine<0>(ctx, 0, RT)); SEAM(11); }
    if (IN(12)) {
#if FAST_WIN
        RUN(12, ph_win_fast(ctx, lds));
#else
        RUN(12, ph_win_naive(ctx, lds));
#endif
        SEAM(12); }
#if !FAST_GATES
    if (IN(13)) { RUN(13, ph_conv_naive(ctx)); SEAM(13); }
#endif
    if (IN(14)) {
#if FAST_GATES
        RUN(14, ph_gates_fast(ctx, lds));
#else
        RUN(14, ph_gates_naive(ctx, lds));
#endif
        SEAM(14); }
#if !FAST_GATES
    if (IN(15)) { RUN(15, ph_gate_elem_naive(ctx)); SEAM(15); }
#endif
#if !(FUSE_SCAN1 && FAST_GATES)
    if (IN(16)) { RUN(16, ph_scan1(ctx)); SEAM(16); }
#endif
    if (IN(17)) { RUN(17, ph_scan2(ctx)); SEAM(17); }
    if (IN(18)) {
#if FAST_WOUT
        RUN(18, ph_wout_fast(ctx, lds));
#else
        RUN(18, ph_wout_naive(ctx, lds));
#endif
        SEAM(18); }
    if (IN(19)) { RUN(19, ph_norm2_router(ctx, lds, 1, RL)); SEAM(19); }
    if (IN(20)) { RUN(20, ph_topk_gather(ctx, lds, 1)); SEAM(20); }
    if (IN(21)) {
#if FAST_GU
        RUN(21, ph_gu_fast(ctx, lds, 1));
#else
        RUN(21, ph_gu_naive(ctx, lds, 1));
#endif
        SEAM(21); }
#if !FAST_GU
    if (IN(22)) { RUN(22, ph_swiglu_naive(ctx, 1)); SEAM(22); }
#endif
    if (IN(23)) {
#if FAST_DN
        RUN(23, ph_dn_fast(ctx, lds, 1));
#else
        RUN(23, ph_dn_naive(ctx, lds, 1));
#endif
        SEAM(23); }
    if (IN(24)) { RUN(24, ph_combine<1>(ctx, 1, RL)); }
#undef IN
#undef SEAM
#undef GRID_BAR
}

extern "C" void kernel_launch(void* const* d_in, const int* in_sizes, int n_in, void* d_out, int out_size, void* d_ws, size_t ws_size, hipStream_t stream) {
    static int grid = 0;
    if (grid == 0) {
        if (n_in != 27 || out_size != RL * D || ws_size < WS_END) { fprintf(stderr, "kernel_launch: unexpected shapes (n_in %d out %d ws %zu)\n", n_in, out_size, ws_size); grid = -1; return; }
        int dev = 0, cus = 0, per_cu = 0;
        if (hipGetDevice(&dev) != hipSuccess || hipDeviceGetAttribute(&cus, hipDeviceAttributeMultiprocessorCount, dev) != hipSuccess) { grid = -1; return; }
        if (hipFuncSetAttribute((const void*)hybrid_fwd, hipFuncAttributeMaxDynamicSharedMemorySize, LDS_BYTES) != hipSuccess) { fprintf(stderr, "kernel_launch: hipFuncSetAttribute failed\n"); grid = -1; return; }
        if (hipOccupancyMaxActiveBlocksPerMultiprocessor(&per_cu, (const void*)hybrid_fwd, NTHREADS, LDS_BYTES) != hipSuccess || per_cu < 1) { fprintf(stderr, "kernel_launch: occupancy query says %d\n", per_cu); }
        (void)hipGetLastError();
        grid = cus > 0 ? cus : 256;
    }
    if (grid < 0) return;
    if (hipMemsetAsync((char*)d_ws + WS_CTL, 0, CTL_ZERO_BYTES, stream) != hipSuccess) return;
    Args a{};
    for (int i = 0; i < 27; ++i) a.in[i] = (const float*)d_in[i];
    a.out = (float*)d_out; a.ws = (unsigned char*)d_ws;
#if MK_ONE_LAUNCH
    a.ph_lo = 0; a.ph_hi = NPHASES;
    hipLaunchKernelGGL(hybrid_fwd, dim3(grid), dim3(NTHREADS), LDS_BYTES, stream, a);
#else
    for (int p = 0; p < NPHASES; ++p) {
        if (!phase_enabled(p)) continue;
        a.ph_lo = p; a.ph_hi = p + 1;
        hipLaunchKernelGGL(hybrid_fwd, dim3(grid), dim3(NTHREADS), LDS_BYTES, stream, a);
    }
#endif
    const hipError_t le = hipPeekAtLastError();
    if (le != hipSuccess) fprintf(stderr, "kernel_launch: launch failed: %s\n", hipGetErrorName(le));
}
```

```cpp
#define MK_ONE_LAUNCH 1
#define FAST_QKV 1
#define FAST_WO 1
#define FAST_GU 1
#define FAST_DN 1
#define FAST_WIN 1
#define FAST_WOUT 1
#define FAST_ATTN 1
#define FAST_GATES 1
#define FP8_MOE 1
#include <hip/hip_runtime.h>
#include <cstdio>
#include <cstdint>
#include <cmath>

#ifndef MK_ONE_LAUNCH
#define MK_ONE_LAUNCH 0
#endif
#ifndef FAST_QKV
#define FAST_QKV 0
#endif
#ifndef FAST_ATTN
#define FAST_ATTN 0
#endif
#ifndef FAST_WO
#define FAST_WO 0
#endif
#ifndef FAST_GU
#define FAST_GU 0
#endif
#ifndef FAST_DN
#define FAST_DN 0
#endif
#ifndef FAST_WIN
#define FAST_WIN 0
#endif
#ifndef FAST_GATES
#define FAST_GATES 0
#endif
#ifndef FAST_WOUT
#define FAST_WOUT 0
#endif
#ifndef FP8_MOE
#define FP8_MOE 0
#endif
#ifndef GU_ALIGN
#define GU_ALIGN true
#endif
#ifndef DN_ALIGN
#define DN_ALIGN true
#endif
#ifndef FUSE_SCAN1
#define FUSE_SCAN1 1
#endif
#define ANY_FAST_GEMM (FAST_QKV || FAST_WO || FAST_GU || FAST_DN || FAST_WIN || FAST_GATES || FAST_WOUT)

namespace pg8 {
#define PG8_LAS __attribute__((address_space(3)))
typedef unsigned short bf16_t;
typedef short bf16x8 __attribute__((ext_vector_type(8)));
typedef float f32x4 __attribute__((ext_vector_type(4)));
typedef unsigned u32x4 __attribute__((ext_vector_type(4)));
constexpr int BM = 256, BK = 64, HALF = 128, HTB = HALF * BK * 2  , STAGE_BYTES = 8 * HTB, NXCD = 8, WGM = 8;

__host__ __device__ __forceinline__ int lds_byte(int r, int c) { const int st = (r >> 4) * 2 + (c >> 5), rr = r & 15, cc = c & 31, ob = rr * 64 + cc * 2; return st * 1024 + (ob ^ (((ob >> 9) & 1) << 5)); }
__host__ __device__ __forceinline__ void stage_rc(int b, int& R, int& C) { const int st = b / 1024, sb = b % 1024, swz = sb ^ (((sb >> 9) & 1) << 5); R = (st >> 1) * 16 + swz / 64; C = (st & 1) * 32 + (swz % 64) / 2; }
__host__ __device__ __forceinline__ int perm32(int rho) { const int n = rho >> 4, i = rho & 15; return 8 * (i >> 2) + 4 * n + (i & 3); }

struct Unit { int pm, pn; };
struct Gemm { const bf16_t* A; const bf16_t* Bt; int M, N, K; };
__device__ __forceinline__ unsigned cvt_pk_bf16(float lo, float hi) { unsigned r; asm volatile("v_cvt_pk_bf16_f32 %0, %1, %2" : "=v"(r) : "v"(lo), "v"(hi)); return r; }
typedef int v4i_t __attribute__((ext_vector_type(4)));
typedef int v8i_t __attribute__((ext_vector_type(8)));
__device__ __forceinline__ v8i_t cat8(bf16x8 lo, bf16x8 hi) { const v4i_t a = __builtin_bit_cast(v4i_t, lo), b = __builtin_bit_cast(v4i_t, hi); return __builtin_shufflevector(a, b, 0, 1, 2, 3, 4, 5, 6, 7); }
template <class Epi, class Sched, bool ALIGN_EPI = false, bool SP2 = false, int FP8SCALE = 0  >
__device__ __forceinline__ void gemm_phase(PG8_LAS unsigned char* lds, const Gemm g, const Sched& S, const Epi& E) {
    const int tid = threadIdx.x, wid = __builtin_amdgcn_readfirstlane(tid >> 6), lane = tid & 63, wr = wid >> 2, wc = wid & 3, fr = lane & 15, fq = lane >> 4;
    const int K = g.K, nt = K / BK;
    unsigned voffA[2], voffB[2];
#pragma unroll
    for (int i = 0; i < 2; ++i) { int R, C; stage_rc(tid * 16 + i * 8192, R, C); const int Rb = Epi::PERM ? ((R & ~31) + perm32(R & 31)) : R;
        voffA[i] = (unsigned)(R * K + C) * 2u; voffB[i] = (unsigned)(Rb * K + C) * 2u; }
    const size_t kstep = (size_t)(BK * 2);
    const size_t hstep = (size_t)HALF * K * 2;
    const size_t tstep = 2 * hstep;
    const unsigned ldsw = (unsigned)wid * 1024u;
    const int aoff = lds_byte(wr * 64 + fr, fq * 8), boff = lds_byte(wc * 32 + fr, fq * 8);
#define PG8_SA(b, h) (((b) * 2 + (h)) * HTB)
#define PG8_SB(b, h) ((4 + (b) * 2 + (h)) * HTB)
#ifndef PG8_B_AUX
#define PG8_B_AUX 0
#endif
#define PG8_STAGE(bufoff, gbase, voff) do { _Pragma("unroll") for (int _i = 0; _i < 2; ++_i) { \
        if constexpr (FP8SCALE != 0 && PG8_B_AUX != 0) { if ((bufoff) >= 4 * HTB) __builtin_amdgcn_global_load_lds((const unsigned*)((const char*)(gbase) + (voff)[_i]), (PG8_LAS unsigned*)(lds + (bufoff) + ldsw + _i * 8192), 16, 0, PG8_B_AUX); \
            else __builtin_amdgcn_global_load_lds((const unsigned*)((const char*)(gbase) + (voff)[_i]), (PG8_LAS unsigned*)(lds + (bufoff) + ldsw + _i * 8192), 16, 0, 0); } \
        else __builtin_amdgcn_global_load_lds((const unsigned*)((const char*)(gbase) + (voff)[_i]), (PG8_LAS unsigned*)(lds + (bufoff) + ldsw + _i * 8192), 16, 0, 0); } } while (0)
#define PG8_LDA(dst, b, h) do { if constexpr (FP8SCALE == 0) { _Pragma("unroll") for (int m = 0; m < 4; ++m) _Pragma("unroll") for (int k = 0; k < 2; ++k) dst[m][k] = *(const PG8_LAS bf16x8*)(lds + PG8_SA(b, h) + aoff + m * 2048 + k * 1024); } \
        else { _Pragma("unroll") for (int m = 0; m < 4; ++m) { const v4i_t lo_ = *(const PG8_LAS v4i_t*)(lds + PG8_SA(b, h) + aoff + m * 2048), hi_ = *(const PG8_LAS v4i_t*)(lds + PG8_SA(b, h) + aoff + m * 2048 + 1024); dst##8[m] = __builtin_shufflevector(lo_, hi_, 0, 1, 2, 3, 4, 5, 6, 7); } } } while (0)
#define PG8_LDB(dst, b, h) do { if constexpr (FP8SCALE == 0) { _Pragma("unroll") for (int n = 0; n < 2; ++n) _Pragma("unroll") for (int k = 0; k < 2; ++k) dst[n][k] = *(const PG8_LAS bf16x8*)(lds + PG8_SB(b, h) + boff + n * 2048 + k * 1024); } \
        else { _Pragma("unroll") for (int n = 0; n < 2; ++n) { const v4i_t lo_ = *(const PG8_LAS v4i_t*)(lds + PG8_SB(b, h) + boff + n * 2048), hi_ = *(const PG8_LAS v4i_t*)(lds + PG8_SB(b, h) + boff + n * 2048 + 1024); dst##8[n] = __builtin_shufflevector(lo_, hi_, 0, 1, 2, 3, 4, 5, 6, 7); } } } while (0)
#define PG8_MMA(ai, bj, At, Bt) do { __builtin_amdgcn_s_setprio(1); \
        if constexpr (FP8SCALE == 0) { _Pragma("unroll") for (int m = 0; m < 4; ++m) _Pragma("unroll") for (int n = 0; n < 2; ++n) _Pragma("unroll") for (int k = 0; k < 2; ++k) \
            acc[ai][bj][m][n] = __builtin_amdgcn_mfma_f32_16x16x32_bf16(Bt[n][k], At[m][k], acc[ai][bj][m][n], 0, 0, 0); } \
        else { _Pragma("unroll") for (int m = 0; m < 4; ++m) _Pragma("unroll") for (int n = 0; n < 2; ++n) \
            asm volatile("v_mfma_scale_f32_16x16x128_f8f6f4 %0, %1, %2, %0, %3, %4 op_sel_hi:[0,0,0]" : "+v"(acc[ai][bj][m][n]) : "v"(Bt##8[n]), "v"(At##8[m]), "v"(sclW), "v"(sclA)); } \
        __builtin_amdgcn_s_setprio(0); } while (0)
#define PG8_WAIT_V(n) asm volatile("s_waitcnt vmcnt(" #n ")" ::: "memory")
#define PG8_WAIT_L(n) asm volatile("s_waitcnt lgkmcnt(" #n ")" ::: "memory")
#define PG8_BAR __builtin_amdgcn_s_barrier()
#define PG8_SCHED __builtin_amdgcn_sched_barrier(0)
    Unit cur, nxt; int ui = 0;
    if (!S.next(0, cur)) return;
    f32x4 acc[2][2][4][2];
#pragma unroll
    for (int a = 0; a < 2; ++a)
#pragma unroll
        for (int b = 0; b < 2; ++b)
#pragma unroll
            for (int m = 0; m < 4; ++m)
#pragma unroll
                for (int n = 0; n < 2; ++n) acc[a][b][m][n] = (f32x4){0.f, 0.f, 0.f, 0.f};
    bf16x8 At[4][2], B0[2][2], B1[2][2]; v8i_t At8[4], B08[2], B18[2]; const int sclW = FP8SCALE * 0x01010101, sclA = 0x7f7f7f7f;
    const char* cA = (const char*)g.A + (size_t)cur.pm * tstep; const char* cB = (const char*)g.Bt + (size_t)cur.pn * tstep;
    S.a_ready(cur);
    if constexpr (SP2) {
        PG8_STAGE(PG8_SB(0, 0), cB, voffB); PG8_STAGE(PG8_SB(0, 1), cB + hstep, voffB); PG8_STAGE(PG8_SA(0, 0), cA, voffA); PG8_STAGE(PG8_SA(0, 1), cA + hstep, voffA);
        if (wr == 1) PG8_BAR;
        PG8_WAIT_V(2); PG8_BAR;
        PG8_STAGE(PG8_SB(1, 0), cB + kstep, voffB); PG8_STAGE(PG8_SA(1, 0), cA + kstep, voffA); PG8_STAGE(PG8_SB(1, 1), cB + hstep + kstep, voffB);
        PG8_WAIT_V(6); PG8_BAR;
    } else {
        PG8_STAGE(PG8_SB(0, 0), cB, voffB); PG8_STAGE(PG8_SA(0, 0), cA, voffA); PG8_STAGE(PG8_SB(0, 1), cB + hstep, voffB); PG8_STAGE(PG8_SA(0, 1), cA + hstep, voffA);
        if (wr == 1) PG8_BAR;
        PG8_WAIT_V(4); PG8_BAR;
        PG8_STAGE(PG8_SB(1, 0), cB + kstep, voffB); PG8_STAGE(PG8_SA(1, 0), cA + kstep, voffA); PG8_STAGE(PG8_SB(1, 1), cB + hstep + kstep, voffB);
        PG8_WAIT_V(6); PG8_BAR;
    }
    for (;;) {
        const bool has_next = S.next(ui + 1, nxt);
        const char* nA = has_next ? (const char*)g.A + (size_t)nxt.pm * tstep : cA; const char* nB = has_next ? (const char*)g.Bt + (size_t)nxt.pn * tstep : cB;
        for (int t = 0; t < nt; t += 2) {
            const bool last = (t == nt - 2);
            const char* a1 = cA + (size_t)(t + 1) * kstep;
            const char* a2 = last ? nA : cA + (size_t)(t + 2) * kstep; const char* b2 = last ? nB : cB + (size_t)(t + 2) * kstep;
            const char* a3 = a2 + kstep; const char* b3 = b2 + kstep;
            if (last && has_next) S.a_ready(nxt);
            if constexpr (SP2) {
            PG8_LDB(B0, 0, 0); PG8_LDB(B1, 0, 1); PG8_SCHED; PG8_LDA(At, 0, 0); PG8_STAGE(PG8_SA(1, 1), a1 + hstep, voffA);
            PG8_WAIT_V(8); PG8_WAIT_L(0); PG8_BAR; PG8_MMA(0, 0, At, B0); PG8_MMA(0, 1, At, B1); PG8_BAR; PG8_SCHED;
            PG8_LDA(At, 0, 1); PG8_STAGE(PG8_SB(0, 0), b2, voffB); PG8_STAGE(PG8_SB(0, 1), b2 + hstep, voffB); PG8_STAGE(PG8_SA(0, 0), a2, voffA);
            PG8_WAIT_V(8); PG8_WAIT_L(0); PG8_BAR; PG8_MMA(1, 0, At, B0); PG8_MMA(1, 1, At, B1); PG8_BAR; PG8_SCHED;
            PG8_LDB(B0, 1, 0); PG8_LDB(B1, 1, 1); PG8_SCHED; PG8_LDA(At, 1, 0); PG8_STAGE(PG8_SA(0, 1), a2 + hstep, voffA);
            PG8_WAIT_V(8); PG8_WAIT_L(0); PG8_BAR; PG8_MMA(0, 0, At, B0); PG8_MMA(0, 1, At, B1); PG8_BAR; PG8_SCHED;
            PG8_LDA(At, 1, 1); PG8_STAGE(PG8_SB(1, 0), b3, voffB); PG8_STAGE(PG8_SB(1, 1), b3 + hstep, voffB); PG8_STAGE(PG8_SA(1, 0), a3, voffA);
            PG8_WAIT_V(8); PG8_WAIT_L(0); PG8_BAR; PG8_MMA(1, 0, At, B0); PG8_MMA(1, 1, At, B1); PG8_BAR; PG8_SCHED;
            } else {
            PG8_LDB(B0, 0, 0); PG8_SCHED; PG8_LDA(At, 0, 0); PG8_STAGE(PG8_SA(1, 1), a1 + hstep, voffA);
            PG8_WAIT_L(8); PG8_BAR; PG8_WAIT_L(0); PG8_MMA(0, 0, At, B0); PG8_BAR; PG8_SCHED;
            PG8_LDB(B1, 0, 1); PG8_STAGE(PG8_SB(0, 0), b2, voffB);
            PG8_BAR; PG8_WAIT_L(0); PG8_MMA(0, 1, At, B1); PG8_BAR;
            PG8_LDA(At, 0, 1); PG8_STAGE(PG8_SA(0, 0), a2, voffA);
            PG8_BAR; PG8_WAIT_L(0); PG8_MMA(1, 0, At, B0); PG8_BAR; PG8_SCHED;
            PG8_STAGE(PG8_SB(0, 1), b2 + hstep, voffB);
            PG8_WAIT_V(6); PG8_BAR; PG8_MMA(1, 1, At, B1); PG8_BAR;
            PG8_LDB(B0, 1, 0); PG8_SCHED; PG8_LDA(At, 1, 0); PG8_STAGE(PG8_SA(0, 1), a2 + hstep, voffA);
            PG8_WAIT_L(8); PG8_BAR; PG8_WAIT_L(0); PG8_MMA(0, 0, At, B0); PG8_BAR; PG8_SCHED;
            PG8_LDB(B1, 1, 1); PG8_STAGE(PG8_SB(1, 0), b3, voffB);
            PG8_BAR; PG8_WAIT_L(0); PG8_MMA(0, 1, At, B1); PG8_BAR;
            PG8_LDA(At, 1, 1); PG8_STAGE(PG8_SA(1, 0), a3, voffA);
            PG8_BAR; PG8_WAIT_L(0); PG8_MMA(1, 0, At, B0); PG8_BAR; PG8_SCHED;
            PG8_STAGE(PG8_SB(1, 1), b3 + hstep, voffB);
            PG8_WAIT_V(6); PG8_BAR; PG8_MMA(1, 1, At, B1); PG8_BAR;
            }
        }
        if constexpr (ALIGN_EPI) { if (wr == 0) PG8_BAR; }
        if constexpr (FP8SCALE != 0) asm volatile("s_nop 15\n\ts_nop 15" ::: "memory");
        if constexpr (!Epi::AFTER_DRAIN) { E(acc, cur, wr, wc, fr, fq); S.done(cur); }
        if (!has_next) break;
#pragma unroll
        for (int a = 0; a < 2; ++a)
#pragma unroll
            for (int b = 0; b < 2; ++b)
#pragma unroll
                for (int m = 0; m < 4; ++m)
#pragma unroll
                    for (int n = 0; n < 2; ++n) acc[a][b][m][n] = (f32x4){0.f, 0.f, 0.f, 0.f};
        cur = nxt; cA = nA; cB = nB; ++ui;
        if constexpr (ALIGN_EPI) { if (wr == 1) PG8_BAR; }
    }
    PG8_WAIT_V(0);
    if constexpr (!ALIGN_EPI) { if (wr == 0) PG8_BAR; }
    PG8_BAR;
    if constexpr (Epi::AFTER_DRAIN) { E.fused(acc, cur, wr, wc, fr, fq, lds, wid, lane); S.done(cur); }
#undef PG8_SA
#undef PG8_SB
#undef PG8_STAGE
#undef PG8_LDA
#undef PG8_LDB
#undef PG8_MMA
#undef PG8_WAIT_V
#undef PG8_WAIT_L
#undef PG8_BAR
#undef PG8_SCHED
}
}

#define LAS __attribute__((address_space(3)))
typedef unsigned short bf16_t;
typedef float f32x4 __attribute__((ext_vector_type(4)));
typedef float f32x2 __attribute__((ext_vector_type(2)));
typedef unsigned u32x4 __attribute__((ext_vector_type(4)));
typedef unsigned u32x2 __attribute__((ext_vector_type(2)));
typedef short bf16x8 __attribute__((ext_vector_type(8)));

constexpr int NB = 8, SEQ = 2048, CTXL = 256, D = 1024;
constexpr int RL = NB * SEQ, RC = NB * CTXL, RT = RL + RC;
constexpr int NE = 16, DE = 2816, CAPL = 256, CAPC = 32;
constexpr int RPE0 = NB * CAPL + NB * CAPC, RPE1 = NB * CAPL;
constexpr int NWAVES = 8, NTHREADS = 512;
constexpr float EPS = 1e-6f;
constexpr float QSCALE = 0.125f * 1.4426950408889634f;
constexpr float LAMBDA_INIT0 = 0.2f;
constexpr int M_SH1 = 0, M_SC1 = 1024, M_G1 = 2048, M_SH2 = 3072, M_SC2 = 4096, M_G2 = 5120;
constexpr int SCH = 64, NCH = (CTXL + SEQ) / SCH, NCH_CTX = CTXL / SCH;

constexpr size_t MiB = 1u << 20;
constexpr size_t WS_CTL = 0, CTL_ZERO_BYTES = 32768;
constexpr size_t WS_GTAB = 2 * MiB + 65536;
constexpr size_t WS_MOD = 1 * MiB, WS_ROPE = 2 * MiB, WS_PROBS = 3 * MiB, WS_GATE = 5 * MiB, WS_SEL = 6 * MiB, WS_CP = 8 * MiB, WS_CB = 11 * MiB;
constexpr size_t WS_WQKV = 16 * MiB, WS_WO = 22 * MiB, WS_WIN = 24 * MiB, WS_WOUT = 28 * MiB, WS_WG = 30 * MiB;
constexpr size_t WS_XN = 32 * MiB, WS_Q = 68 * MiB, WS_K = 104 * MiB, WS_V = 140 * MiB, WS_ATT = 176 * MiB, WS_H = 212 * MiB;
constexpr size_t WS_XG = 284 * MiB, WS_Y = 356 * MiB, WS_ACT = 428 * MiB, WS_WGU = 626 * MiB, WS_WDN = 978 * MiB;
constexpr size_t WS_YG = 68 * MiB, WS_XR = 104 * MiB, WS_HS = 140 * MiB;
constexpr size_t WS_LOGA = 1154 * MiB, WS_BT = 1226 * MiB;
constexpr size_t WS_TMPF = 1298 * MiB, WS_XC = 2090 * MiB, WS_END = 2126 * MiB;
constexpr size_t WGU_LAYER = (size_t)NE * 2 * DE * D * 2, WDN_LAYER = (size_t)NE * D * DE * 2;
constexpr int CW_BAR = 4096;

constexpr int LDS_BYTES = 147456;
constexpr int MISC_OFF = 131072 + 320;

struct Args { const float* in[27]; float* out; unsigned char* ws; int ph_lo, ph_hi; };
constexpr int ROPE_LDS = 131072 + 1024;
constexpr int ARGS_OFF = 131072 + 512;
struct Ctx {
    const LAS unsigned* la;
    __device__ __forceinline__ unsigned long long ld(int i) const { const unsigned lo = __builtin_amdgcn_readfirstlane(la[2 * i]), hi = __builtin_amdgcn_readfirstlane(la[2 * i + 1]); return ((unsigned long long)hi << 32) | lo; }
    __device__ __forceinline__ const float* in(int i) const { return (const float*)(const __attribute__((address_space(1))) float*)ld(i); }
    __device__ __forceinline__ float* out() const { return (float*)(__attribute__((address_space(1))) float*)ld(27); }
    __device__ __forceinline__ unsigned char* ws() const { return (unsigned char*)(__attribute__((address_space(1))) unsigned char*)ld(28); }
};

enum { I_X = 0, I_C, I_CTX, I_CCTX, I_ADAW, I_ADAB, I_N1G, I_N2G, I_FG, I_WQKV, I_LQ1, I_LK1, I_LQ2, I_LK2, I_SUBG, I_WO, I_WIN, I_BIN, I_CONVW, I_CONVB, I_WGATES, I_BGATES, I_LAM, I_WOUT, I_WR, I_WGU, I_WDN };

__device__ __forceinline__ float bf_lo(unsigned w) { return __uint_as_float(w << 16); }
__device__ __forceinline__ float bf_hi(unsigned w) { return __uint_as_float(w & 0xffff0000u); }
__device__ __forceinline__ float bf2f(bf16_t b) { return __uint_as_float(((unsigned)b) << 16); }
__device__ __forceinline__ unsigned f2bf(float f) { unsigned u = __float_as_uint(f); return (u + 0x7fffu + ((u >> 16) & 1u)) >> 16; }
__device__ __forceinline__ unsigned pk2(float lo, float hi) { unsigned r; asm("v_cvt_pk_bf16_f32 %0, %1, %2" : "=v"(r) : "v"(lo), "v"(hi)); return r; }
#ifndef EPI_WT
#define EPI_WT 0
#endif
__device__ __forceinline__ void st16_wt(void* p, u32x4 v) {
#if EPI_WT
    asm volatile("global_store_dwordx4 %0, %1, off sc1" :: "v"(p), "v"(v) : "memory");
#else
    *(u32x4*)p = v;
#endif
}
__device__ __forceinline__ void st8_wt(void* p, u32x2 v) {
#if EPI_WT
    asm volatile("global_store_dwordx2 %0, %1, off sc1" :: "v"(p), "v"(v) : "memory");
#else
    *(u32x2*)p = v;
#endif
}
__device__ __forceinline__ float wave_sum(float v) {
#pragma unroll
    for (int o = 1; o < 64; o <<= 1) v += __shfl_xor(v, o);
    return v;
}
__device__ __forceinline__ float wave_max(float v) {
#pragma unroll
    for (int o = 1; o < 64; o <<= 1) v = fmaxf(v, __shfl_xor(v, o));
    return v;
}
__device__ __forceinline__ float sigmoidf_(float x) { return 1.f / (1.f + expf(-x)); }
__device__ __forceinline__ float gelu_tanh(float x) { const float u = 0.7978845608028654f * (x + 0.044715f * x * x * x); return x / (1.f + expf(-2.f * u)); }
__device__ __forceinline__ const float* mod_ptr(const Ctx& a, int layer, int r) { return (const float*)(a.ws() + WS_MOD) + (size_t)(layer * 9 + r) * 6144; }
__device__ __forceinline__ int mod_row(int row) { return row < RL ? (row >> 11) : 8; }

__device__ __forceinline__ void load_row(const float* p, int lane, f32x4 (&v)[4]) {
#pragma unroll
    for (int j = 0; j < 4; ++j) v[j] = *(const f32x4*)(p + 4 * lane + 256 * j);
}
__device__ __forceinline__ void load_row_bf16(const bf16_t* p, int lane, f32x4 (&v)[4]) {
#pragma unroll
    for (int j = 0; j < 4; ++j) { const u32x2 w = *(const u32x2*)(p + 4 * lane + 256 * j); v[j] = (f32x4){bf_lo(w.x), bf_hi(w.x), bf_lo(w.y), bf_hi(w.y)}; }
}
__device__ __forceinline__ void store_row_f32(float* p, int lane, const f32x4 (&v)[4]) {
#pragma unroll
    for (int j = 0; j < 4; ++j) *(f32x4*)(p + 4 * lane + 256 * j) = v[j];
}
__device__ __forceinline__ void store_row_bf16(bf16_t* p, int lane, const f32x4 (&v)[4]) {
#pragma unroll
    for (int j = 0; j < 4; ++j) { u32x2 w; w.x = pk2(v[j].x, v[j].y); w.y = pk2(v[j].z, v[j].w); *(u32x2*)(p + 4 * lane + 256 * j) = w; }
}
__device__ __forceinline__ void store_row_fp8(unsigned char* p, int lane, const f32x4 (&v)[4]) {
#pragma unroll
    for (int j = 0; j < 4; ++j) *(unsigned*)(p + 4 * lane + 256 * j) = __builtin_amdgcn_cvt_pk_fp8_f32(v[j].z, v[j].w, __builtin_amdgcn_cvt_pk_fp8_f32(v[j].x, v[j].y, 0u, false), true);
}
__device__ __forceinline__ void rms_mod(f32x4 (&v)[4], const float* g, const float* sh, const float* sc, int lane) {
    float ss = 0.f;
#pragma unroll
    for (int j = 0; j < 4; ++j) ss += (v[j].x * v[j].x + v[j].y * v[j].y) + (v[j].z * v[j].z + v[j].w * v[j].w);
    ss = wave_sum(ss);
    const float rstd = 1.0f / sqrtf(ss * (1.0f / D) + EPS);
#pragma unroll
    for (int j = 0; j < 4; ++j) {
        const int k = 4 * lane + 256 * j;
        const f32x4 gg = *(const f32x4*)(g + k);
        f32x4 y = v[j] * rstd * gg;
        if (sh) { const f32x4 s1 = *(const f32x4*)(sc + k), s0 = *(const f32x4*)(sh + k); y = y * (1.0f + s1) + s0; }
        v[j] = y;
    }
}

template <class F>
__device__ __forceinline__ void naive_tile(const bf16_t* A, int lda, const float* W, int ldw, int K, LAS unsigned char* lds, F f) {
    LAS float* As = (LAS float*)lds;
    LAS float* Bs = (LAS float*)(lds + 16 * 132 * 4);
    const int tid = threadIdx.x, ty = tid >> 4, tx = tid & 15;
    const int ar = tid >> 2, akq = tid & 3, bk = tid >> 5, bc = (tid & 31) * 2;
    float acc[4][4];
#pragma unroll
    for (int i = 0; i < 4; ++i)
#pragma unroll
        for (int j = 0; j < 4; ++j) acc[i][j] = 0.f;
    for (int k0 = 0; k0 < K; k0 += 16) {
        const u32x2 av = *(const u32x2*)(A + (size_t)ar * lda + k0 + akq * 4);
        const f32x2 bv = *(const f32x2*)(W + (size_t)(k0 + bk) * ldw + bc);
        __syncthreads();
        As[(akq * 4 + 0) * 132 + ar] = bf_lo(av.x); As[(akq * 4 + 1) * 132 + ar] = bf_hi(av.x);
        As[(akq * 4 + 2) * 132 + ar] = bf_lo(av.y); As[(akq * 4 + 3) * 132 + ar] = bf_hi(av.y);
        Bs[bk * 64 + bc] = bv.x; Bs[bk * 64 + bc + 1] = bv.y;
        __syncthreads();
#pragma unroll
        for (int kk = 0; kk < 16; ++kk) {
            const f32x4 a4 = *(const LAS f32x4*)(As + kk * 132 + ty * 4);
            const f32x4 b4 = *(const LAS f32x4*)(Bs + kk * 64 + tx * 4);
#pragma unroll
            for (int i = 0; i < 4; ++i)
#pragma unroll
                for (int j = 0; j < 4; ++j) acc[i][j] += a4[i] * b4[j];
        }
    }
#pragma unroll
    for (int i = 0; i < 4; ++i)
#pragma unroll
        for (int j = 0; j < 4; ++j) f(ty * 4 + i, tx * 4 + j, acc[i][j]);
    __syncthreads();
}

__device__ __forceinline__ void cvt_item(const float* W, int N, int k0, int n0, bf16_t* dst, int Kd, int gu_perm) {
    const int tid = threadIdx.x, lane = tid & 63, wave = tid >> 6;
    const float* p = W + (size_t)(k0 + 8 * wave) * N + n0 + 4 * lane;
    f32x4 v[8];
#pragma unroll
    for (int i = 0; i < 8; ++i) v[i] = *(const f32x4*)(p + (size_t)i * N);
#pragma unroll
    for (int j = 0; j < 4; ++j) {
        const int n = n0 + 4 * lane + j;
        const int row = gu_perm ? (((n % DE) >> 7) * 256 + (n / DE) * 128 + (n & 127)) : n;
        u32x4 o; o.x = pk2(v[0][j], v[1][j]); o.y = pk2(v[2][j], v[3][j]); o.z = pk2(v[4][j], v[5][j]); o.w = pk2(v[6][j], v[7][j]);
        *(u32x4*)(dst + (size_t)row * Kd + k0 + 8 * wave) = o;
    }
}
__device__ __forceinline__ unsigned pk4_fp8(float a, float b, float c, float d) { unsigned w = __builtin_amdgcn_cvt_pk_fp8_f32(a, b, 0u, false); return __builtin_amdgcn_cvt_pk_fp8_f32(c, d, w, true); }
constexpr float BT_SCALE = 64.0f, Y_SCALE = 16.0f;
constexpr float WGU_SCALE = 32.0f, WDN_SCALE = 64.0f;
__device__ __forceinline__ void cvt8_load(const float* W, int N, int k0, int n0, f32x4 (&v)[16]) {
    const int tid = threadIdx.x, lane = tid & 63, wave = tid >> 6;
    const float* p = W + (size_t)(k0 + 16 * wave) * N + n0 + 4 * lane;
#pragma unroll
    for (int i = 0; i < 16; ++i) v[i] = __builtin_nontemporal_load((const f32x4*)(p + (size_t)i * N));
}
__device__ __forceinline__ void cvt8_store(const f32x4 (&v)[16], int k0, int n0, unsigned char* dst, int Kd, int gu_perm, float scale, LAS unsigned char* T) {
    const int tid = threadIdx.x, lane = tid & 63, wave = tid >> 6;
#pragma unroll
    for (int j = 0; j < 4; ++j) {
        const int n = 4 * lane + j;
        u32x4 o;
        o.x = pk4_fp8(v[0][j] * scale, v[1][j] * scale, v[2][j] * scale, v[3][j] * scale); o.y = pk4_fp8(v[4][j] * scale, v[5][j] * scale, v[6][j] * scale, v[7][j] * scale);
        o.z = pk4_fp8(v[8][j] * scale, v[9][j] * scale, v[10][j] * scale, v[11][j] * scale); o.w = pk4_fp8(v[12][j] * scale, v[13][j] * scale, v[14][j] * scale, v[15][j] * scale);
        *(LAS u32x4*)(T + n * 128 + ((wave ^ (lane & 7)) << 4)) = o;
    }
    asm volatile("s_waitcnt lgkmcnt(0)" ::: "memory"); __builtin_amdgcn_s_barrier(); asm volatile("" ::: "memory");
#pragma unroll
    for (int i = 0; i < 4; ++i) {
        const int p = tid + NTHREADS * i, n = p >> 3, c = p & 7;
        const u32x4 x = *(const LAS u32x4*)(T + n * 128 + ((c ^ ((n >> 2) & 7)) << 4));
        const int ng = n0 + n;
        const int row = gu_perm ? (((ng % DE) >> 7) * 256 + (ng / DE) * 128 + (ng & 127)) : ng;
        __builtin_nontemporal_store(x, (u32x4*)(dst + (size_t)row * Kd + k0 + 16 * c));
    }
}
constexpr int CV_GU = NE * 8 * 22, CV_DN = NE * 22 * 4, CV_ITEMS = CV_GU + CV_DN;
struct CvItem { const float* W; unsigned char* dst; int N, Kd, k0, n0, perm; float scale; };
__device__ __forceinline__ CvItem cv_decode(const float* wgu, const float* wdn, unsigned char* ws, int layer, int it) {
    CvItem c;
    if (it < CV_GU) { const int e = it / 176, q = it % 176, le = layer * NE + e; c.W = wgu + (size_t)le * D * 2 * DE; c.dst = ws + WS_WGU + (size_t)le * 2 * DE * D; c.N = 2 * DE; c.Kd = D; c.k0 = (q / 22) * 128; c.n0 = (q % 22) * 256; c.perm = 1; c.scale = WGU_SCALE; }
    else { const int r = it - CV_GU, e = r / 88, q = r % 88, le = layer * NE + e; c.W = wdn + (size_t)le * DE * D; c.dst = ws + WS_WDN + (size_t)le * D * DE; c.N = D; c.Kd = DE; c.k0 = (q / 4) * 128; c.n0 = (q % 4) * 256; c.perm = 0; c.scale = WDN_SCALE; }
    return c;
}
__device__ __forceinline__ void cvt8_run(const Ctx& a, int layer, int first, int stride, int end, LAS unsigned char* lds) {
    const float* wgu = a.in(I_WGU); const float* wdn = a.in(I_WDN); unsigned char* ws = a.ws();
    f32x4 va[16], vb[16];
    int it = first;
    if (it < end) { const CvItem c = cv_decode(wgu, wdn, ws, layer, it); cvt8_load(c.W, c.N, c.k0, c.n0, va); }
    while (it < end) {
        int nx = it + stride;
        if (nx < end) { const CvItem c = cv_decode(wgu, wdn, ws, layer, nx); cvt8_load(c.W, c.N, c.k0, c.n0, vb); }
        { const CvItem c = cv_decode(wgu, wdn, ws, layer, it); cvt8_store(va, c.k0, c.n0, c.dst, c.Kd, c.perm, c.scale, lds); }
        it = nx; if (it >= end) break;
        nx = it + stride;
        if (nx < end) { const CvItem c = cv_decode(wgu, wdn, ws, layer, nx); cvt8_load(c.W, c.N, c.k0, c.n0, va); }
        { const CvItem c = cv_decode(wgu, wdn, ws, layer, it); cvt8_store(vb, c.k0, c.n0, c.dst, c.Kd, c.perm, c.scale, lds + 32768); }
        it = nx;
    }
    __syncthreads();
}
#ifndef CVT_HIDE
#define CVT_HIDE 1
#endif
#ifndef CVT_DEDICATED
#define CVT_DEDICATED 0
#endif
#ifndef CVQ_QKV
#define CVQ_QKV 1280
#endif
#ifndef CVQ_WO
#define CVQ_WO 896
#endif
#ifndef CVQ_GU0
#define CVQ_GU0 480
#endif
#ifndef CVQ_DN0
#define CVQ_DN0 960
#endif
#ifndef CVQ_WIN
#define CVQ_WIN 896
#endif
#ifndef CVQ_GATES
#define CVQ_GATES 1120
#endif
constexpr int CV0_QKV = 0, CV0_WO = CV0_QKV + CVQ_QKV, CV0_PRO = CVT_HIDE ? CV0_WO + CVQ_WO : 0;
constexpr int CV1_GU0 = 0, CV1_DN0 = CV1_GU0 + CVQ_GU0, CV1_WIN = CV1_DN0 + CVQ_DN0, CV1_GATES = CV1_WIN + CVQ_WIN, CV1_PRO = CVT_HIDE ? CV1_GATES + CVQ_GATES : 0;
static_assert(CV0_PRO <= CV_ITEMS && CV1_PRO <= CV_ITEMS, "conversion schedule");
__device__ __forceinline__ void cvt8_tail(const Ctx& a, LAS unsigned char* lds, int units, int G, int c, int layer, int base, int count) {
#if CVT_HIDE && FP8_MOE
    const int R = (units + G - 1) / G, first_idle = units - (R - 1) * G;
    if (first_idle >= G || count <= 0 || c < first_idle) return;
    cvt8_run(a, layer, base + (c - first_idle), G - first_idle, base + count, lds);
#endif
}
__device__ __forceinline__ int gemm_groups(int units, int G) {
#if CVT_HIDE && FP8_MOE && CVT_DEDICATED
    const int R = (units + G - 1) / G; int gp = ((units + R - 1) / R + 7) & ~7;
    return gp < G ? gp : G;
#else
    return G;
#endif
}
#ifndef DENSE_LATE
#define DENSE_LATE 1
#endif
constexpr int IT_DENSE_REST = 16 * 4 + 16 * 8 + 16 * 4 + 32;
__device__ __forceinline__ void cvt_dense_rest_item(const Ctx& a, int r) {
    constexpr int IT_WO = 16 * 4, IT_WIN = 16 * 8, IT_WOUT = 16 * 4;
    if (r < IT_WO) { cvt_item(a.in(I_WO), D, (r / 4) * 64, (r % 4) * 256, (bf16_t*)(a.ws() + WS_WO), D, 0); return; }
    r -= IT_WO;
    if (r < IT_WIN) { cvt_item(a.in(I_WIN), 2 * D, (r / 8) * 64, (r % 8) * 256, (bf16_t*)(a.ws() + WS_WIN), D, 0); return; }
    r -= IT_WIN;
    if (r < IT_WOUT) { cvt_item(a.in(I_WOUT), D, (r / 4) * 64, (r % 4) * 256, (bf16_t*)(a.ws() + WS_WOUT), D, 0); return; }
    r -= IT_WOUT;
    { const int m = r >> 1, kk = r & 1;
        cvt_item(a.in(I_WGATES) + (size_t)m * 128 * 256, 256, kk * 64, 0, (bf16_t*)(a.ws() + WS_WG) + (size_t)m * 256 * 128, 128, 0); }
}
__device__ __forceinline__ void ph_prologue(const Ctx& a, LAS unsigned char* lds) {
    const int tid = threadIdx.x, lane = tid & 63, wave = tid >> 6;
    if (blockIdx.x == gridDim.x - 1) {
        float* rope = (float*)(a.ws() + WS_ROPE);
        for (int i = tid; i < 1024; i += NTHREADS) { const int pos = i >> 4, f = i & 15; const float inv = powf(10000.0f, -(float)f / 16.0f); const float ang = (float)pos * inv; rope[i] = cosf(ang); rope[1024 + i] = sinf(ang); }
    }
    if (blockIdx.x == gridDim.x - 2 || gridDim.x == 1) {
        float* gt = (float*)(a.ws() + WS_GTAB); const float* lamp = a.in(I_LAM); const float* bgp = a.in(I_BGATES);
        for (int i = tid; i < 2 * D; i += NTHREADS) {
            const int d = i >> 10, ch = i & 1023, kb = ch >> 7, cc = ch & 127;
            const float cl = -8.0f * log1pf(expf(-lamp[i]));
            gt[(d * 4 + 0) * D + ch] = cl * 1.4426950408889634f; gt[(d * 4 + 1) * D + ch] = 2.0f * cl * 1.4426950408889634f;
            gt[(d * 4 + 2) * D + ch] = -1.4426950408889634f * bgp[(d * 8 + kb) * 256 + cc]; gt[(d * 4 + 3) * D + ch] = -1.4426950408889634f * bgp[(d * 8 + kb) * 256 + 128 + cc];
        }
    }
    for (int u = blockIdx.x; u < 192; u += gridDim.x) {
        LAS float* sl = (LAS float*)lds;
        LAS float* red = (LAS float*)(lds + 49152);
        const int layer = u / 96, n0 = (u % 96) * 64;
        for (int i = tid; i < 9 * 1024; i += NTHREADS) { const int r = i >> 10, k = i & 1023; const float v = r < 8 ? a.in(I_C)[r * 1024 + k] : a.in(I_CCTX)[k]; sl[k * 12 + r] = v / (1.f + expf(-v)); }
        __syncthreads();
        const float* W = a.in(I_ADAW) + (size_t)layer * 1024 * 6144 + n0 + lane;
        float acc[9];
#pragma unroll
        for (int r = 0; r < 9; ++r) acc[r] = 0.f;
#pragma unroll 32
        for (int k = wave * 128; k < wave * 128 + 128; ++k) {
            const float w = __builtin_nontemporal_load(W + (size_t)k * 6144);
            const f32x4 s0 = *(const LAS f32x4*)(sl + k * 12), s1 = *(const LAS f32x4*)(sl + k * 12 + 4); const float s8 = sl[k * 12 + 8];
            acc[0] += s0.x * w; acc[1] += s0.y * w; acc[2] += s0.z * w; acc[3] += s0.w * w;
            acc[4] += s1.x * w; acc[5] += s1.y * w; acc[6] += s1.z * w; acc[7] += s1.w * w; acc[8] += s8 * w;
        }
#pragma unroll
        for (int r = 0; r < 9; ++r) red[(wave * 9 + r) * 64 + lane] = acc[r];
        __syncthreads();
        float* MOD = (float*)(a.ws() + WS_MOD);
        for (int i = tid; i < 576; i += NTHREADS) {
            const int r = i >> 6, l = i & 63; float s = 0.f;
#pragma unroll
            for (int w = 0; w < 8; ++w) s += red[(w * 9 + r) * 64 + l];
            MOD[(size_t)(layer * 9 + r) * 6144 + n0 + l] = s + a.in(I_ADAB)[layer * 6144 + n0 + l];
        }
        __syncthreads();
    }
#if ANY_FAST_GEMM
    constexpr int IT_QKV = 16 * 12, IT_WO = 16 * 4, IT_WIN = 16 * 8, IT_WOUT = 16 * 4, IT_G = 32;
#if FP8_MOE
    cvt8_run(a, 0, CV0_PRO + (int)blockIdx.x, (int)gridDim.x, CV_ITEMS, lds);
    cvt8_run(a, 1, CV1_PRO + (int)blockIdx.x, (int)gridDim.x, CV_ITEMS, lds);
    constexpr int IT_GU = 0, IT_DN = 0;
#else
    constexpr int IT_GU1 = 16 * 22, IT_DN1 = 44 * 4;
    constexpr int IT_GU = 32 * IT_GU1, IT_DN = 32 * IT_DN1;
#endif
    constexpr int NITEMS = IT_GU + IT_DN + IT_QKV + ((DENSE_LATE && FAST_ATTN) ? 0 : IT_DENSE_REST);
    for (int it = blockIdx.x; it < NITEMS; it += gridDim.x) {
        int r = it;
#if !FP8_MOE
        if (r < IT_GU) { const int le = r / IT_GU1, q = r % IT_GU1;
            cvt_item(a.in(I_WGU) + (size_t)le * D * 2 * DE, 2 * DE, (q / 22) * 64, (q % 22) * 256, (bf16_t*)(a.ws() + WS_WGU) + (size_t)le * 2 * DE * D, D, 1); continue; }
        r -= IT_GU;
        if (r < IT_DN) { const int le = r / IT_DN1, q = r % IT_DN1;
            cvt_item(a.in(I_WDN) + (size_t)le * DE * D, D, (q / 4) * 64, (q % 4) * 256, (bf16_t*)(a.ws() + WS_WDN) + (size_t)le * D * DE, DE, 0); continue; }
#endif
        r -= IT_DN;
        if (r < IT_QKV) { cvt_item(a.in(I_WQKV), 3 * D, (r / 12) * 64, (r % 12) * 256, (bf16_t*)(a.ws() + WS_WQKV), D, 0); continue; }
        r -= IT_QKV;
#if !(DENSE_LATE && FAST_ATTN)
        cvt_dense_rest_item(a, r);
#endif
    }
#endif
}

__device__ __forceinline__ void ph_norm1_l0(const Ctx& a) {
    const int lane = threadIdx.x & 63, gw = blockIdx.x * NWAVES + (threadIdx.x >> 6), NGW = gridDim.x * NWAVES;
    unsigned char* ws = a.ws();
    bf16_t* XN = (bf16_t*)(ws + WS_XN); const float* X = a.in(I_X); const float* CX = a.in(I_CTX); const float* n1g = a.in(I_N1G);
    f32x4 v[4], nx[4];
    int row = gw;
    if (row < RT) load_row(row < RL ? X + (size_t)row * D : CX + (size_t)(row - RL) * D, lane, v);
    for (; row < RT; row += NGW) {
        const int rn = row + NGW;
        if (rn < RT) load_row(rn < RL ? X + (size_t)rn * D : CX + (size_t)(rn - RL) * D, lane, nx);
        const float* mp = (const float*)(ws + WS_MOD) + (size_t)mod_row(row) * 6144;
        rms_mod(v, n1g, mp + M_SH1, mp + M_SC1, lane);
        store_row_bf16(XN + (size_t)row * D, lane, v);
#pragma unroll
        for (int j = 0; j < 4; ++j) v[j] = nx[j];
    }
}
__device__ __forceinline__ float rs16(float (&s)[16], int lane) {
    float r8[8], r4[4], r2[2];
    const bool b5 = lane & 32, b4 = lane & 16, b3 = lane & 8, b2 = lane & 4;
#pragma unroll
    for (int i = 0; i < 8; ++i) { const float send = b5 ? s[i] : s[i + 8], keep = b5 ? s[i + 8] : s[i]; r8[i] = keep + __shfl_xor(send, 32); }
#pragma unroll
    for (int i = 0; i < 4; ++i) { const float send = b4 ? r8[i] : r8[i + 4], keep = b4 ? r8[i + 4] : r8[i]; r4[i] = keep + __shfl_xor(send, 16); }
#pragma unroll
    for (int i = 0; i < 2; ++i) { const float send = b3 ? r4[i] : r4[i + 2], keep = b3 ? r4[i + 2] : r4[i]; r2[i] = keep + __shfl_xor(send, 8); }
    float r = (b2 ? r2[1] : r2[0]) + __shfl_xor(b2 ? r2[0] : r2[1], 4);
    r += __shfl_xor(r, 2); r += __shfl_xor(r, 1);
    return r;
}
__device__ __forceinline__ void ph_norm2_router(const Ctx& a, LAS unsigned char* lds, int layer, int nrows) {
    const int tid = threadIdx.x, lane = tid & 63, gw = blockIdx.x * NWAVES + (tid >> 6), NGW = gridDim.x * NWAVES;
    LAS float* wrT = (LAS float*)lds;
    const float* wr = a.in(I_WR) + (size_t)layer * D * NE;
    for (int i = tid; i < D * NE; i += NTHREADS) wrT[(i & 15) * 1024 + (i >> 4)] = wr[i];
    __syncthreads();
    unsigned char* ws = a.ws();
    bf16_t* XN = (bf16_t*)(ws + WS_XN); const bf16_t* H = (const bf16_t*)(ws + WS_H);
    float* PL = (float*)(ws + WS_PROBS); float* PC = PL + NB * NE * SEQ;
    const float* n2g = a.in(I_N2G) + layer * D;
    const int elane = ((lane >> 5) & 1) * 8 + ((lane >> 4) & 1) * 4 + ((lane >> 3) & 1) * 2 + ((lane >> 2) & 1);
    f32x4 v0[4], v1[4], n0[4], n1[4];
    int p = gw;
    if (p < nrows / 2) { load_row_bf16(H + (size_t)(2 * p) * D, lane, v0); load_row_bf16(H + (size_t)(2 * p + 1) * D, lane, v1); }
    for (; p < nrows / 2; p += NGW) {
        const int pn = p + NGW;
        if (pn < nrows / 2) { load_row_bf16(H + (size_t)(2 * pn) * D, lane, n0); load_row_bf16(H + (size_t)(2 * pn + 1) * D, lane, n1); }
        const int row = 2 * p;
        const float* mp = (const float*)(ws + WS_MOD) + (size_t)(layer * 9 + mod_row(row)) * 6144;
        rms_mod(v0, n2g, mp + M_SH2, mp + M_SC2, lane); rms_mod(v1, n2g, mp + M_SH2, mp + M_SC2, lane);
#if FP8_MOE
        store_row_fp8((unsigned char*)XN + (size_t)row * D, lane, v0); store_row_fp8((unsigned char*)XN + (size_t)(row + 1) * D, lane, v1);
#else
        store_row_bf16(XN + (size_t)row * D, lane, v0); store_row_bf16(XN + (size_t)(row + 1) * D, lane, v1);
#endif
        float s0[16], s1[16];
#pragma unroll
        for (int e = 0; e < 16; ++e) {
            float a0 = 0.f, a1 = 0.f;
#pragma unroll
            for (int j = 0; j < 4; ++j) { const f32x4 w = *(const LAS f32x4*)(wrT + e * 1024 + 4 * lane + 256 * j);
                a0 += (v0[j].x * w.x + v0[j].y * w.y) + (v0[j].z * w.z + v0[j].w * w.w); a1 += (v1[j].x * w.x + v1[j].y * w.y) + (v1[j].z * w.z + v1[j].w * w.w); }
            s0[e] = a0; s1[e] = a1;
            if ((e & 3) == 3) asm volatile("" ::: "memory");
        }
        const float l0 = rs16(s0, lane), l1 = rs16(s1, lane);
        const float m0 = wave_max(l0), m1 = wave_max(l1);
        const float e0 = expf(l0 - m0), e1 = expf(l1 - m1);
        const float q0 = e0 / (wave_sum(e0) * 0.25f), q1 = e1 / (wave_sum(e1) * 0.25f);
        if ((lane & 3) == 0) {
            if (row < RL) { float* d = PL + ((size_t)(row >> 11) * NE + elane) * SEQ + (row & 2047); *(f32x2*)d = (f32x2){q0, q1}; }
            else { const int rc = row - RL; float* d = PC + ((size_t)(rc >> 8) * NE + elane) * CTXL + (rc & 255); *(f32x2*)d = (f32x2){q0, q1}; }
        }
#pragma unroll
        for (int j = 0; j < 4; ++j) { v0[j] = n0[j]; v1[j] = n1[j]; }
    }
    __syncthreads();
}
__device__ __forceinline__ void ph_topk_gather(const Ctx& a, LAS unsigned char* lds, int layer) {
    const int tid = threadIdx.x, lane = tid & 63, wave = tid >> 6;
    LAS int* idxl = (LAS int*)lds;
    LAS int* cnt = (LAS int*)(lds + 1024);
    unsigned char* ws = a.ws();
    const float* PL = (const float*)(ws + WS_PROBS); const float* PC = PL + NB * NE * SEQ;
    float* GATE = (float*)(ws + WS_GATE); int* SEL = (int*)(ws + WS_SEL);
    const bf16_t* XN = (const bf16_t*)(ws + WS_XN); bf16_t* XG = (bf16_t*)(ws + WS_XG);
    const int nunits = layer == 0 ? 256 : 128, rpe = layer == 0 ? RPE0 : RPE1;
    const unsigned long long lt = (1ull << lane) - 1ull;
    for (int u0 = blockIdx.x; u0 < nunits; u0 += gridDim.x) {
        const int u = layer == 0 ? ((u0 & 1) * 128 + (u0 >> 1)) : u0;
        const bool lat = u < 128; const int b = (u & 127) >> 4, e = u & 15;
        const int n = lat ? SEQ : CTXL, cap = lat ? CAPL : CAPC;
        const float* src = lat ? PL + ((size_t)b * NE + e) * SEQ : PC + ((size_t)b * NE + e) * CTXL;
        const int rowbase = lat ? b * SEQ : RL + b * CTXL;
        const int xgbase = e * rpe + (lat ? b * CAPL : NB * CAPL + b * CAPC);
        unsigned v[4];
#pragma unroll
        for (int i = 0; i < 4; ++i) { const int t = wave * 256 + i * 64 + lane; v[i] = t < n ? __float_as_uint(src[t]) : 0u; }
        unsigned prefix = 0u;
#pragma unroll 1
        for (int bit = 30; bit >= 0; --bit) {
            const unsigned cand = prefix | (1u << bit); int c = 0;
#pragma unroll
            for (int i = 0; i < 4; ++i) c += __popcll(__ballot(v[i] >= cand));
            LAS int* slot = cnt + (bit & 1) * 8;
            if (lane == 0) slot[wave] = c;
            __syncthreads();
            int tot = 0;
#pragma unroll
            for (int w = 0; w < 8; ++w) tot += slot[w];
            if (tot >= cap) prefix = cand;
        }
        int mg = 0, me = 0;
#pragma unroll
        for (int i = 0; i < 4; ++i) { mg += __popcll(__ballot(v[i] > prefix)); me += __popcll(__ballot(v[i] == prefix)); }
        if (lane == 0) { cnt[16 + wave] = mg; cnt[24 + wave] = me; }
        __syncthreads();
        int tg = 0, eqb = 0;
#pragma unroll
        for (int w = 0; w < 8; ++w) { tg += cnt[16 + w]; eqb += (w < wave) ? cnt[24 + w] : 0; }
        const int need = cap - tg;
        bool sel[4]; int ms = 0, eqseen = eqb;
#pragma unroll
        for (int i = 0; i < 4; ++i) {
            const bool gt = v[i] > prefix, eq = v[i] == prefix;
            const unsigned long long meq = __ballot(eq);
            sel[i] = gt || (eq && (eqseen + __popcll(meq & lt)) < need);
            ms += __popcll(__ballot(sel[i])); eqseen += __popcll(meq);
        }
        if (lane == 0) cnt[32 + wave] = ms;
        __syncthreads();
        int slotbase = 0;
#pragma unroll
        for (int w = 0; w < 8; ++w) slotbase += (w < wave) ? cnt[32 + w] : 0;
#pragma unroll
        for (int i = 0; i < 4; ++i) {
            const unsigned long long msel = __ballot(sel[i]);
            const int slot = slotbase + __popcll(msel & lt), t = wave * 256 + i * 64 + lane;
            if (t < n) SEL[(size_t)(rowbase + t) * NE + e] = sel[i] ? slot : -1;
            if (sel[i]) { idxl[slot] = t; GATE[xgbase + slot] = __uint_as_float(v[i]); }
            slotbase += __popcll(msel);
        }
        __syncthreads();
        for (int slot = wave; slot < cap; slot += NWAVES) {
            const int t = idxl[slot];
#if FP8_MOE
            ((u32x4*)((unsigned char*)XG + (size_t)(xgbase + slot) * D))[lane] = ((const u32x4*)((const unsigned char*)XN + (size_t)(rowbase + t) * D))[lane];
#else
            const u32x4* s = (const u32x4*)(XN + (size_t)(rowbase + t) * D);
            u32x4* d = (u32x4*)(XG + (size_t)(xgbase + slot) * D);
            d[lane] = s[lane]; d[lane + 64] = s[lane + 64];
#endif
        }
        __syncthreads();
    }
}
template <int MODE>
__device__ __forceinline__ void ph_combine(const Ctx& a, int layer, int nrows) {
    const int lane = threadIdx.x & 63, gw = blockIdx.x * NWAVES + (threadIdx.x >> 6), NGW = gridDim.x * NWAVES;
    bf16_t* H = (bf16_t*)(a.ws() + WS_H); const int* SEL = (const int*)(a.ws() + WS_SEL); const unsigned char* Y = a.ws() + WS_Y;
    bf16_t* XN = (bf16_t*)(a.ws() + WS_XN);
    const int rpe = layer == 0 ? RPE0 : RPE1;
    f32x4 v[4], vn[4]; int sel = -1, seln = -1;
    if (gw < nrows) { load_row_bf16(H + (size_t)gw * D, lane, v); sel = SEL[(size_t)gw * NE + (lane & 15)]; }
    for (int row = gw; row < nrows; row += NGW) {
        const int rnx = row + NGW;
        if (rnx < nrows) { load_row_bf16(H + (size_t)rnx * D, lane, vn); seln = SEL[(size_t)rnx * NE + (lane & 15)]; }
        const int mr = mod_row(row);
        const float* mp = mod_ptr(a, layer, mr);
        const int off = row < RL ? (row >> 11) * CAPL : NB * CAPL + ((row - RL) >> 8) * CAPC;
        f32x4 acc[4];
#pragma unroll
        for (int j = 0; j < 4; ++j) acc[j] = (f32x4){0.f, 0.f, 0.f, 0.f};
        unsigned mask = (unsigned)(__ballot(sel >= 0) & 0xffffull);
        int yw[4][4];
#pragma unroll
        for (int k = 0; k < 4; ++k) {
            const bool on = mask != 0u; const int e = on ? __builtin_ctz(mask) : 0; mask = on ? (mask & (mask - 1u)) : 0u;
            const int sidx = __builtin_amdgcn_readlane(sel, e);
            const unsigned char* yr = Y + (size_t)(on ? (e * rpe + off + sidx) : 0) * D;
#pragma unroll
            for (int j = 0; j < 4; ++j) { const int w = __builtin_nontemporal_load((const int*)(yr + 4 * lane + 256 * j)); yw[k][j] = on ? w : 0; }
        }
#pragma unroll
        for (int k = 0; k < 4; ++k)
#pragma unroll
            for (int j = 0; j < 4; ++j) { const f32x2 lo = __builtin_amdgcn_cvt_pk_f32_fp8(yw[k][j], false), hi2 = __builtin_amdgcn_cvt_pk_f32_fp8(yw[k][j], true);
                acc[j].x += lo.x; acc[j].y += lo.y; acc[j].z += hi2.x; acc[j].w += hi2.y; }
        while (mask != 0u) {
            const int e = __builtin_ctz(mask); mask &= mask - 1u;
            const int sidx = __builtin_amdgcn_readlane(sel, e);
            const unsigned char* yr = Y + (size_t)(e * rpe + off + sidx) * D;
#pragma unroll
            for (int j = 0; j < 4; ++j) { const int w = *(const int*)(yr + 4 * lane + 256 * j); const f32x2 lo = __builtin_amdgcn_cvt_pk_f32_fp8(w, false), hi2 = __builtin_amdgcn_cvt_pk_f32_fp8(w, true);
                acc[j].x += lo.x; acc[j].y += lo.y; acc[j].z += hi2.x; acc[j].w += hi2.y; }
        }
#pragma unroll
        for (int j = 0; j < 4; ++j) { const f32x4 g2 = *(const f32x4*)(mp + M_G2 + 4 * lane + 256 * j); v[j] = v[j] + g2 * (acc[j] * (1.0f / Y_SCALE)); }
        if (MODE == 0) {
            store_row_bf16(H + (size_t)row * D, lane, v);
            const float* mp1 = mod_ptr(a, 1, mr);
            rms_mod(v, a.in(I_N1G) + D, mp1 + M_SH1, mp1 + M_SC1, lane);
            store_row_bf16(XN + (size_t)row * D, lane, v);
        } else {
            rms_mod(v, a.in(I_FG), nullptr, nullptr, lane);
            { float* po = a.out() + (size_t)row * D;
#pragma unroll
              for (int j = 0; j < 4; ++j) __builtin_nontemporal_store(v[j], (f32x4*)(po + 4 * lane + 256 * j)); }
        }
#pragma unroll
        for (int j = 0; j < 4; ++j) v[j] = vn[j];
        sel = seln;
    }
}

__device__ __forceinline__ void ph_qkv_naive(const Ctx& a, LAS unsigned char* lds) {
    const bf16_t* XN = (const bf16_t*)(a.ws() + WS_XN); float* T = (float*)(a.ws() + WS_TMPF);
    for (int t = blockIdx.x; t < (RT / 128) * 48; t += gridDim.x) {
        const int tm = t / 48, tn = t % 48;
        naive_tile(XN + (size_t)tm * 128 * D, D, a.in(I_WQKV) + tn * 64, 3 * D, D, lds,
                   [&](int r, int c, float v) { T[(size_t)(tm * 128 + r) * 3072 + tn * 64 + c] = v; });
    }
}
__device__ __forceinline__ void ph_rope_naive(const Ctx& a) {
    const float* T = (const float*)(a.ws() + WS_TMPF); const float* rope = (const float*)(a.ws() + WS_ROPE);
    bf16_t* Q = (bf16_t*)(a.ws() + WS_Q); bf16_t* Kb = (bf16_t*)(a.ws() + WS_K); bf16_t* V = (bf16_t*)(a.ws() + WS_V);
    const size_t total = (size_t)RT * 3072, nth = (size_t)gridDim.x * NTHREADS;
    for (size_t i = (size_t)blockIdx.x * NTHREADS + threadIdx.x; i < total; i += nth) {
        const int row = (int)(i / 3072), c = (int)(i % 3072);
        if (c >= 2048) { V[(size_t)row * D + (c - 2048)] = (bf16_t)f2bf(T[i]); continue; }
        const int d = c & 63; if ((d & 31) >= 16) continue;
        float x1 = T[i], x2 = T[i + 16];
        if (row < RL) {
            const int t = row & 2047, axis = d >> 5, f = d & 15, pos = axis == 0 ? (t >> 6) : (t & 63);
            const float cs = rope[pos * 16 + f], sn = rope[1024 + pos * 16 + f];
            const float o1 = x1 * cs - x2 * sn, o2 = x2 * cs + x1 * sn; x1 = o1; x2 = o2;
        }
        if (c < 1024) { Q[(size_t)row * D + c] = (bf16_t)f2bf(x1 * QSCALE); Q[(size_t)row * D + c + 16] = (bf16_t)f2bf(x2 * QSCALE); }
        else { Kb[(size_t)row * D + c - 1024] = (bf16_t)f2bf(x1); Kb[(size_t)row * D + c - 1024 + 16] = (bf16_t)f2bf(x2); }
    }
}
template <int NIT>
__device__ __forceinline__ void naive_attn_item(const Ctx& a, int row, int h, float lam, LAS float* qs, int lane) {
    const bf16_t* Q = (const bf16_t*)(a.ws() + WS_Q); const bf16_t* Kb = (const bf16_t*)(a.ws() + WS_K); const bf16_t* V = (const bf16_t*)(a.ws() + WS_V);
    bf16_t* ATT = (bf16_t*)(a.ws() + WS_ATT);
    const int b = row < RL ? (row >> 11) : ((row - RL) >> 8);
    const int lat0 = b * SEQ, ctx0 = RL + b * CTXL;
    { const unsigned qq = *(const unsigned*)(Q + (size_t)row * D + h * 128 + 2 * lane); qs[2 * lane] = bf_lo(qq); qs[2 * lane + 1] = bf_hi(qq); }
    __builtin_amdgcn_fence(__ATOMIC_RELEASE, "wavefront"); __builtin_amdgcn_wave_barrier(); __builtin_amdgcn_fence(__ATOMIC_ACQUIRE, "wavefront");
#define NA_SCORE(it, d0, d1) do { const int kk_ = (it) * 64 + lane; \
        const int krow_ = (NIT == 36) ? (kk_ < SEQ ? lat0 + kk_ : ctx0 + kk_ - SEQ) : ctx0 + kk_; \
        const u32x4* kp_ = (const u32x4*)(Kb + (size_t)krow_ * D + h * 128); d0 = 0.f; d1 = 0.f; \
        _Pragma("unroll 4") for (int c = 0; c < 16; ++c) { const u32x4 kv = kp_[c]; \
            const f32x4 qa = *(const LAS f32x4*)(qs + 8 * c), qb = *(const LAS f32x4*)(qs + 8 * c + 4); \
            const float dd = (qa.x * bf_lo(kv.x) + qa.y * bf_hi(kv.x)) + (qa.z * bf_lo(kv.y) + qa.w * bf_hi(kv.y)) \
                           + (qb.x * bf_lo(kv.z) + qb.y * bf_hi(kv.z)) + (qb.z * bf_lo(kv.w) + qb.w * bf_hi(kv.w)); \
            if (c < 8) d0 += dd; else d1 += dd; } } while (0)
    float m0 = -3.0e38f, m1 = -3.0e38f, l0 = 0.f, l1 = 0.f;
#pragma unroll 1
    for (int it = 0; it < NIT; ++it) {
        float d0, d1; NA_SCORE(it, d0, d1);
        const float n0 = fmaxf(m0, d0), n1 = fmaxf(m1, d1);
        l0 = l0 * exp2f(m0 - n0) + exp2f(d0 - n0); l1 = l1 * exp2f(m1 - n1) + exp2f(d1 - n1); m0 = n0; m1 = n1;
    }
    { const float g0 = wave_max(m0), g1 = wave_max(m1); l0 = wave_sum(l0 * exp2f(m0 - g0)); l1 = wave_sum(l1 * exp2f(m1 - g1)); m0 = g0; m1 = g1; }
    const float i0 = 1.f / l0, i1 = lam / l1;
    float o0 = 0.f, o1 = 0.f;
#pragma unroll 1
    for (int it = 0; it < NIT; ++it) {
        float d0, d1; NA_SCORE(it, d0, d1);
        const int wbits = __float_as_int(exp2f(d0 - m0) * i0 - exp2f(d1 - m1) * i1);
#pragma unroll 4
        for (int src = 0; src < 64; ++src) {
            const float wv = __int_as_float(__builtin_amdgcn_readlane(wbits, src));
            const int kk = it * 64 + src;
            const int krow = (NIT == 36) ? (kk < SEQ ? lat0 + kk : ctx0 + kk - SEQ) : ctx0 + kk;
            const unsigned vv = *(const unsigned*)(V + (size_t)krow * D + h * 128 + 2 * lane);
            o0 += wv * bf_lo(vv); o1 += wv * bf_hi(vv);
        }
    }
#undef NA_SCORE
    const float ss = wave_sum(o0 * o0 + o1 * o1);
    const float rstd = 1.0f / sqrtf(ss * (1.0f / 128.0f) + EPS);
    const float g0 = a.in(I_SUBG)[2 * lane], g1 = a.in(I_SUBG)[2 * lane + 1];
    *(unsigned*)(ATT + (size_t)row * D + h * 128 + 2 * lane) = pk2(o0 * rstd * g0 * (1.0f - LAMBDA_INIT0), o1 * rstd * g1 * (1.0f - LAMBDA_INIT0));
}
__device__ __forceinline__ float diff_lambda(const Ctx& a, int lane) {
    const float s1 = wave_sum(a.in(I_LQ1)[lane] * a.in(I_LK1)[lane]), s2 = wave_sum(a.in(I_LQ2)[lane] * a.in(I_LK2)[lane]);
    return expf(s1) - expf(s2) + LAMBDA_INIT0;
}
__device__ __forceinline__ void ph_attn_naive(const Ctx& a, LAS unsigned char* lds) {
    const int lane = threadIdx.x & 63, wave = threadIdx.x >> 6, gw = blockIdx.x * NWAVES + wave, NGW = gridDim.x * NWAVES;
    LAS float* qs = (LAS float*)lds + wave * 128;
    const float lam = diff_lambda(a, lane);
    for (int item = gw; item < RT * 8; item += NGW) {
        const int h = item / RT, row = item % RT;
        if (row < RL) naive_attn_item<36>(a, row, h, lam, qs, lane); else naive_attn_item<4>(a, row, h, lam, qs, lane);
    }
}
__device__ __forceinline__ void ph_wo_naive(const Ctx& a, LAS unsigned char* lds) {
    const bf16_t* ATT = (const bf16_t*)(a.ws() + WS_ATT); bf16_t* H = (bf16_t*)(a.ws() + WS_H);
    for (int t = blockIdx.x; t < (RT / 128) * 16; t += gridDim.x) {
        const int tm = t / 16, tn = t % 16;
        naive_tile(ATT + (size_t)tm * 128 * D, D, a.in(I_WO) + tn * 64, D, D, lds, [&](int r, int c, float v) {
            const int row = tm * 128 + r, col = tn * 64 + c;
            const float base = row < RL ? a.in(I_X)[(size_t)row * D + col] : a.in(I_CTX)[(size_t)(row - RL) * D + col];
            H[(size_t)row * D + col] = (bf16_t)f2bf(base + mod_ptr(a, 0, mod_row(row))[M_G1 + col] * v); });
    }
}
__device__ __forceinline__ void ph_gu_naive(const Ctx& a, LAS unsigned char* lds, int layer) {
    const int rpe = layer == 0 ? RPE0 : RPE1, tpe = (rpe / 128) * 88;
    const bf16_t* XG = (const bf16_t*)(a.ws() + WS_XG); float* T = (float*)(a.ws() + WS_TMPF);
    for (int t = blockIdx.x; t < NE * tpe; t += gridDim.x) {
        const int e = t / tpe, q = t % tpe, tm = q / 88, tn = q % 88;
        const size_t row0 = (size_t)e * rpe + tm * 128;
        naive_tile(XG + row0 * D, D, a.in(I_WGU) + (size_t)(layer * NE + e) * D * 2 * DE + tn * 64, 2 * DE, D, lds,
                   [&](int r, int c, float v) { T[(row0 + r) * (2 * DE) + tn * 64 + c] = v; });
    }
}
__device__ __forceinline__ void ph_swiglu_naive(const Ctx& a, int layer) {
    const int rpe = layer == 0 ? RPE0 : RPE1;
    const float* T = (const float*)(a.ws() + WS_TMPF); bf16_t* ACT = (bf16_t*)(a.ws() + WS_ACT);
    const size_t total = (size_t)NE * rpe * DE, nth = (size_t)gridDim.x * NTHREADS;
    for (size_t i = (size_t)blockIdx.x * NTHREADS + threadIdx.x; i < total; i += nth) {
        const size_t row = i / DE; const int j = (int)(i % DE);
        const float g = T[row * (2 * DE) + j], u = T[row * (2 * DE) + DE + j];
        ACT[i] = (bf16_t)f2bf(g / (1.f + expf(-g)) * u);
    }
}
__device__ __forceinline__ void ph_dn_naive(const Ctx& a, LAS unsigned char* lds, int layer) {
    const int rpe = layer == 0 ? RPE0 : RPE1, tpe = (rpe / 128) * 16;
    const bf16_t* ACT = (const bf16_t*)(a.ws() + WS_ACT); unsigned char* Y = a.ws() + WS_Y; const float* GATE = (const float*)(a.ws() + WS_GATE);
    for (int t = blockIdx.x; t < NE * tpe; t += gridDim.x) {
        const int e = t / tpe, q = t % tpe, tm = q / 16, tn = q % 16;
        const size_t row0 = (size_t)e * rpe + tm * 128;
        naive_tile(ACT + row0 * DE, DE, a.in(I_WDN) + (size_t)(layer * NE + e) * DE * D + tn * 64, D, DE, lds,
                   [&](int r, int c, float v) { Y[(row0 + r) * D + tn * 64 + c] = (unsigned char)(pk4_fp8(v * GATE[row0 + r] * Y_SCALE, 0.f, 0.f, 0.f) & 0xffu); });
    }
}
__device__ __forceinline__ void ph_win_naive(const Ctx& a, LAS unsigned char* lds) {
    const bf16_t* XN = (const bf16_t*)(a.ws() + WS_XN); bf16_t* YG = (bf16_t*)(a.ws() + WS_YG); bf16_t* XR = (bf16_t*)(a.ws() + WS_XR);
    const int TL = (RL / 128) * 32, TC = (RC / 128) * 16;
    for (int t = blockIdx.x; t < TL + TC; t += gridDim.x) {
        int tm, tn; if (t < TL) { tm = t / 32; tn = t % 32; } else { const int q = t - TL; tm = RL / 128 + q / 16; tn = 16 + q % 16; }
        naive_tile(XN + (size_t)tm * 128 * D, D, a.in(I_WIN) + tn * 64, 2 * D, D, lds, [&](int r, int c, float v) {
            const int row = tm * 128 + r, col = tn * 64 + c; const float x = v + a.in(I_BIN)[col];
            if (col < D) YG[(size_t)row * D + col] = (bf16_t)f2bf(gelu_tanh(x)); else XR[(size_t)row * D + col - D] = (bf16_t)f2bf(x); });
    }
}
__device__ __forceinline__ void ph_conv_naive(const Ctx& a) {
    const bf16_t* XR = (const bf16_t*)(a.ws() + WS_XR); bf16_t* XC = (bf16_t*)(a.ws() + WS_XC);
    const size_t total = (size_t)RT * D, nth = (size_t)gridDim.x * NTHREADS;
    for (size_t i = (size_t)blockIdx.x * NTHREADS + threadIdx.x; i < total; i += nth) {
        const int row = (int)(i >> 10), ch = (int)(i & 1023);
        const int t = row < RL ? (row & 2047) : ((row - RL) & 255), L = row < RL ? SEQ : CTXL;
        float v = a.in(I_CONVB)[ch];
#pragma unroll
        for (int j = 0; j < 4; ++j) { const int tt = t - 2 + j; if (tt >= 0 && tt < L) v += a.in(I_CONVW)[j * D + ch] * bf2f(XR[(size_t)(row - t + tt) * D + ch]); }
        XC[i] = (bf16_t)f2bf(v);
    }
}
__device__ __forceinline__ void ph_gates_naive(const Ctx& a, LAS unsigned char* lds) {
    const bf16_t* XC = (const bf16_t*)(a.ws() + WS_XC); float* T = (float*)(a.ws() + WS_TMPF);
    for (int t = blockIdx.x; t < 16 * (RT / 128) * 4; t += gridDim.x) {
        const int m = t / ((RT / 128) * 4), q = t % ((RT / 128) * 4), tm = q >> 2, tn = q & 3, d = m >> 3, kb = m & 7;
        naive_tile(XC + (size_t)tm * 128 * D + kb * 128, D, a.in(I_WGATES) + (size_t)m * 128 * 256 + tn * 64, 256, 128, lds,
                   [&](int r, int c, float v) { T[((size_t)d * RT + tm * 128 + r) * 2048 + kb * 256 + tn * 64 + c] = v; });
    }
}
__device__ __forceinline__ void ph_gate_elem_naive(const Ctx& a) {
    const float* T = (const float*)(a.ws() + WS_TMPF); const bf16_t* XC = (const bf16_t*)(a.ws() + WS_XC);
    bf16_t* LOGA = (bf16_t*)(a.ws() + WS_LOGA); unsigned char* BT = a.ws() + WS_BT;
    const size_t total = (size_t)2 * RT * D, nth = (size_t)gridDim.x * NTHREADS;
    for (size_t i = (size_t)blockIdx.x * NTHREADS + threadIdx.x; i < total; i += nth) {
        const int d = (int)(i / ((size_t)RT * D)); const size_t rc = i % ((size_t)RT * D); const int row = (int)(rc >> 10), ch = (int)(rc & 1023), kb = ch >> 7, cc = ch & 127;
        const float gr = T[((size_t)d * RT + row) * 2048 + kb * 256 + cc] + a.in(I_BGATES)[(d * 8 + kb) * 256 + cc];
        const float gi = T[((size_t)d * RT + row) * 2048 + kb * 256 + 128 + cc] + a.in(I_BGATES)[(d * 8 + kb) * 256 + 128 + cc];
        const float r = sigmoidf_(gr), ig = sigmoidf_(gi);
        const float lam = a.in(I_LAM)[d * D + ch];
        const float la = -8.0f * r * log1pf(expf(-lam));
        const float x = bf2f(XC[rc]);
        const float bt = sqrtf(-expm1f(2.0f * la)) * (ig * x);
        LOGA[i] = (bf16_t)f2bf(la * 1.4426950408889634f); BT[i] = (unsigned char)(pk4_fp8(bt * BT_SCALE, 0.f, 0.f, 0.f) & 0xffu);
    }
}
__device__ __forceinline__ void ph_wout_naive(const Ctx& a, LAS unsigned char* lds) {
    const bf16_t* HS = (const bf16_t*)(a.ws() + WS_HS); bf16_t* H = (bf16_t*)(a.ws() + WS_H);
    for (int t = blockIdx.x; t < (RL / 128) * 16; t += gridDim.x) {
        const int tm = t / 16, tn = t % 16;
        naive_tile(HS + (size_t)tm * 128 * D, D, a.in(I_WOUT) + tn * 64, D, D, lds, [&](int r, int c, float v) {
            const int row = tm * 128 + r, col = tn * 64 + c;
            H[(size_t)row * D + col] = (bf16_t)f2bf(bf2f(H[(size_t)row * D + col]) + mod_ptr(a, 1, row >> 11)[M_G1 + col] * v); });
    }
}

__device__ __forceinline__ int scan_row(int b, int dir, int c, int s) {
    const int p = c * SCH + s;
    if (dir == 0) return p < CTXL ? RL + b * CTXL + p : b * SEQ + (p - CTXL);
    return p < CTXL ? RL + b * CTXL + (CTXL - 1 - p) : b * SEQ + (SEQ - 1 - (p - CTXL));
}
__device__ __forceinline__ void ph_scan1(const Ctx& a) {
    const int lane = threadIdx.x & 63, gw = blockIdx.x * NWAVES + (threadIdx.x >> 6), NGW = gridDim.x * NWAVES;
    const bf16_t* LOGA = (const bf16_t*)(a.ws() + WS_LOGA); const unsigned char* BT = a.ws() + WS_BT;
    float* CP = (float*)(a.ws() + WS_CP); float* CB = (float*)(a.ws() + WS_CB);
    for (int item = gw; item < NB * 2 * NCH * 8; item += NGW) {
        const int cg = item & 7, c = (item >> 3) % NCH, bd = (item >> 3) / NCH, dir = bd & 1, b = bd >> 1;
        const int ch = cg * 128 + 2 * lane;
        float h0 = 0.f, h1 = 0.f, p0 = 0.f, p1 = 0.f;
#pragma unroll 1
        for (int sg = 0; sg < SCH; sg += 32) {
            unsigned la[32], bt[32];
#pragma unroll
            for (int i = 0; i < 32; ++i) { const size_t o = ((size_t)dir * RT + scan_row(b, dir, c, sg + i)) * D + ch; la[i] = *(const unsigned*)(LOGA + o); bt[i] = *(const unsigned short*)(BT + o); }
            asm volatile("" ::: "memory");
#pragma unroll
            for (int i = 0; i < 32; ++i) { const float l0 = bf_lo(la[i]), l1 = bf_hi(la[i]);
                const f32x2 bb = __builtin_amdgcn_cvt_pk_f32_fp8((int)bt[i], false);
                h0 = __builtin_amdgcn_exp2f(l0) * h0 + bb.x; h1 = __builtin_amdgcn_exp2f(l1) * h1 + bb.y; p0 += l0; p1 += l1; }
        }
        const size_t so = ((size_t)(b * 2 + dir) * NCH + c) * D + ch;
        *(f32x2*)(CP + so) = (f32x2){p0, p1}; *(f32x2*)(CB + so) = (f32x2){h0, h1};
    }
}
__device__ __forceinline__ void ph_scan2(const Ctx& a) {
    const int lane = threadIdx.x & 63, gw = blockIdx.x * NWAVES + (threadIdx.x >> 6), NGW = gridDim.x * NWAVES;
    const bf16_t* LOGA = (const bf16_t*)(a.ws() + WS_LOGA); const unsigned char* BT = a.ws() + WS_BT;
    const float* CP = (const float*)(a.ws() + WS_CP); const float* CB = (const float*)(a.ws() + WS_CB);
    const bf16_t* YG = (const bf16_t*)(a.ws() + WS_YG); bf16_t* HS = (bf16_t*)(a.ws() + WS_HS);
    constexpr int NLC = SEQ / SCH;
    for (int item = gw; item < NB * NLC * 8; item += NGW) {
        const int cg = item & 7, j = (item >> 3) % NLC, b = (item >> 3) / NLC;
        const int ch = cg * 128 + 2 * lane;
        const int cb = NCH_CTX + (NLC - 1 - j), cf = NCH_CTX + j;
        float hb0 = 0.f, hb1 = 0.f, hf0 = 0.f, hf1 = 0.f;
#pragma unroll 1
        for (int c0 = 0; c0 < NCH - 1; c0 += 12) {
            f32x2 pb[12], qb[12], pf[12], qf[12];
#pragma unroll
            for (int i = 0; i < 12; ++i) {
                const int c = c0 + i; const size_t sb_ = ((size_t)(b * 2 + 1) * NCH + c) * D + ch, sf_ = ((size_t)(b * 2 + 0) * NCH + c) * D + ch;
                const f32x2 z = (f32x2){0.f, 0.f};
                pb[i] = c < cb ? *(const f32x2*)(CP + sb_) : z; qb[i] = c < cb ? *(const f32x2*)(CB + sb_) : z;
                pf[i] = c < cf ? *(const f32x2*)(CP + sf_) : z; qf[i] = c < cf ? *(const f32x2*)(CB + sf_) : z;
            }
            asm volatile("" ::: "memory");
#pragma unroll
            for (int i = 0; i < 12; ++i) {
                hb0 = __builtin_amdgcn_exp2f(pb[i].x) * hb0 + qb[i].x; hb1 = __builtin_amdgcn_exp2f(pb[i].y) * hb1 + qb[i].y;
                hf0 = __builtin_amdgcn_exp2f(pf[i].x) * hf0 + qf[i].x; hf1 = __builtin_amdgcn_exp2f(pf[i].y) * hf1 + qf[i].y;
            }
        }
        float sb0[SCH], sb1[SCH];
#pragma unroll
        for (int sg = 0; sg < SCH; sg += 32) {
            unsigned la[32], bt[32];
#pragma unroll
            for (int i = 0; i < 32; ++i) { const size_t o = ((size_t)1 * RT + b * SEQ + j * SCH + (SCH - 1 - (sg + i))) * D + ch; la[i] = *(const unsigned*)(LOGA + o); bt[i] = *(const unsigned short*)(BT + o); }
            asm volatile("" ::: "memory");
#pragma unroll
            for (int i = 0; i < 32; ++i) {
                const f32x2 bb = __builtin_amdgcn_cvt_pk_f32_fp8((int)bt[i], false);
                hb0 = __builtin_amdgcn_exp2f(bf_lo(la[i])) * hb0 + bb.x; hb1 = __builtin_amdgcn_exp2f(bf_hi(la[i])) * hb1 + bb.y;
                sb0[SCH - 1 - (sg + i)] = hb0; sb1[SCH - 1 - (sg + i)] = hb1;
            }
        }
#pragma unroll
        for (int sg = 0; sg < SCH; sg += 16) {
            unsigned la[16], bt[16], yg[16];
#pragma unroll
            for (int i = 0; i < 16; ++i) { const size_t o = ((size_t)b * SEQ + j * SCH + sg + i) * D + ch; la[i] = __builtin_nontemporal_load((const unsigned*)(LOGA + o)); bt[i] = __builtin_nontemporal_load((const unsigned short*)(BT + o)); yg[i] = __builtin_nontemporal_load((const unsigned*)(YG + o)); }
            asm volatile("" ::: "memory");
#pragma unroll
            for (int i = 0; i < 16; ++i) {
                const size_t o = ((size_t)b * SEQ + j * SCH + sg + i) * D + ch;
                const f32x2 bb = __builtin_amdgcn_cvt_pk_f32_fp8((int)bt[i], false);
                hf0 = __builtin_amdgcn_exp2f(bf_lo(la[i])) * hf0 + bb.x; hf1 = __builtin_amdgcn_exp2f(bf_hi(la[i])) * hf1 + bb.y;
                *(unsigned*)(HS + o) = pk2(bf_lo(yg[i]) * ((hf0 + sb0[sg + i]) * (1.0f / BT_SCALE)), bf_hi(yg[i]) * ((hf1 + sb1[sg + i]) * (1.0f / BT_SCALE)));
            }
            asm volatile("" ::: "memory");
        }
    }
}
#define XB_TMO      128
#define XB_XCNT(j)  (256  + 64 * (j))
#define XB_XSUB(j)  (1280 + 64 * (j))
#define XB_XGEN(j)  (2304 + 64 * (j))
#define XB_TOP      3328
#define XB_TOPGEN   3392
#define XCD_BAR_WORDS 3456
#define XB_SPIN_CAP (1u << 18)

__device__ __forceinline__ unsigned xb_ld(unsigned* p)              { return __hip_atomic_load(p, __ATOMIC_RELAXED, __HIP_MEMORY_SCOPE_AGENT); }
__device__ __forceinline__ unsigned xb_add(unsigned* p, unsigned v) { return __hip_atomic_fetch_add(p, v, __ATOMIC_RELAXED, __HIP_MEMORY_SCOPE_AGENT); }
__device__ __forceinline__ unsigned xb_xcc_id() { return (unsigned)__builtin_amdgcn_s_getreg((3 << 11) | 20) & 0xFu; }
#define XB_SPIN(cond, bar) do { unsigned _sp = 0; while (cond) { __builtin_amdgcn_s_sleep(1); \
    if ((++_sp & 255u) == 0u) { if (xb_ld(&(bar)[XB_TMO])) break; if (_sp > XB_SPIN_CAP) { atomicAdd(&(bar)[XB_TMO], 1u); break; } } } } while (0)

struct XcdBarrier {
    unsigned* bar; unsigned x;
    volatile LAS unsigned* st;
};

__device__ __forceinline__ XcdBarrier xcd_barrier_post(unsigned* bar, volatile LAS unsigned* st) {
    XcdBarrier b; b.bar = bar; b.x = xb_xcc_id(); b.st = st;
    if (threadIdx.x == 0) (void)xb_add(&bar[XB_XCNT(b.x)], 1u);
    return b;
}
__device__ __forceinline__ void xcd_barrier_complete(unsigned* bar, unsigned x, unsigned& nloc, unsigned& nx) {
    const unsigned G = gridDim.x * gridDim.y * gridDim.z;
    unsigned sum, cnt, mine, sp = 0u;
    for (;;) {
        sum = 0u; cnt = 0u; mine = 0u;
#pragma unroll
        for (unsigned j = 0; j < 16; ++j) { const unsigned c = xb_ld(&bar[XB_XCNT(j)]); sum += c; cnt += (c > 0u) ? 1u : 0u; mine = (j == x) ? c : mine; }
        if (sum == G) break;
        __builtin_amdgcn_s_sleep(1);
        if ((++sp & 255u) == 0u) { if (xb_ld(&bar[XB_TMO])) break; if (sp > XB_SPIN_CAP) { atomicAdd(&bar[XB_TMO], 1u); break; } }
    }
    nloc = mine > 0u ? mine : 1u; nx = cnt > 0u ? cnt : 1u;
}

__device__ __forceinline__ void xcd_barrier(const XcdBarrier& b) {
    asm volatile("s_waitcnt vmcnt(0)" ::: "memory");
    __syncthreads();
    if (threadIdx.x == 0) {
        unsigned* bar = b.bar;
        __builtin_amdgcn_s_waitcnt(0);
        unsigned nloc = b.st[0], nx = b.st[1];
        if (nloc == 0u) { xcd_barrier_complete(bar, b.x, nloc, nx); b.st[0] = nloc; b.st[1] = nx; }
        const unsigned old = xb_add(&bar[XB_XSUB(b.x)], 1u);
        const unsigned gen = old / nloc;
        if (old + 1u == (gen + 1u) * nloc) {
            __builtin_amdgcn_fence(__ATOMIC_RELEASE, "agent");
            asm volatile("s_waitcnt vmcnt(0)" ::: "memory");
            const unsigned og = xb_add(&bar[XB_TOP], 1u);
            const unsigned tg = og / nx;
            if (og + 1u == (tg + 1u) * nx) xb_add(&bar[XB_TOPGEN], 1u);
            else XB_SPIN(xb_ld(&bar[XB_TOPGEN]) == tg, bar);
            __builtin_amdgcn_fence(__ATOMIC_ACQUIRE, "agent");
            xb_add(&bar[XB_XGEN(b.x)], 1u);
            asm volatile("s_waitcnt vmcnt(0)" ::: "memory");
        } else {
            XB_SPIN(xb_ld(&bar[XB_XGEN(b.x)]) == gen, bar);
            __builtin_amdgcn_fence(__ATOMIC_ACQUIRE, "agent");
            asm volatile("s_waitcnt vmcnt(0)" ::: "memory");
        }
    }
    __syncthreads();
}

__device__ __forceinline__ int xcd_remap(long L, int n) { const int q = n / 8, r = n % 8, xcd = (int)(L % 8), off = (int)(L / 8); return (xcd < r ? xcd * (q + 1) : r * (q + 1) + (xcd - r) * q) + off; }
template <class Map> struct ListOrder {
    int nunits, G, c; Map map;
    __device__ __forceinline__ bool next(int i, pg8::Unit& u) const { const long L = (long)i * G + c; if (L >= nunits) return false; map(xcd_remap(L, nunits), u); return true; }
    __device__ __forceinline__ void a_ready(const pg8::Unit&) const {}
    __device__ __forceinline__ void done(const pg8::Unit&) const {}
};
#ifndef WGMG
#define WGMG 8
#endif
struct MapGrid { int nN; __device__ __forceinline__ void operator()(int w, pg8::Unit& u) const { const int nig = WGMG * nN; u.pm = (w / nig) * WGMG + (w % nig) % WGMG; u.pn = (w % nig) / WGMG; } };
struct MapMoe { int PM, NT; __device__ __forceinline__ void operator()(int w, pg8::Unit& u) const { const int per = PM * NT, e = w / per, rem = w % per; u.pm = e * PM + rem % PM; u.pn = e * NT + rem / PM; } };
struct MapWin { __device__ __forceinline__ void operator()(int w, pg8::Unit& u) const { if (w < 512) { u.pm = (w / 64) * 8 + (w % 64) % 8; u.pn = (w % 64) / 8; } else { const int q = w - 512; u.pm = 64 + q % 8; u.pn = 4 + q / 8; } } };

typedef pg8::f32x4 pf4;
__device__ __forceinline__ float fast_exp(float x) { return __builtin_amdgcn_exp2f(x * 1.4426950408889634f); }

struct EpiQKV {
    static constexpr bool PERM = true, AFTER_DRAIN = false;
    bf16_t* Q; const LAS float* rope;
    __device__ __forceinline__ void operator()(const pf4 (&acc)[2][2][4][2], const pg8::Unit& u, int wr, int wc, int fr, int fq) const {
        const int sec = u.pn >> 2; bf16_t* base = Q + (size_t)sec * ((WS_K - WS_Q) / 2);
        const bool lat = u.pm < 64, dorope = sec < 2 && lat; const int axis = wc & 1;
        const bool upper = fq >= 2;
        const int row0 = u.pm * 256 + wr * 64 + fr, col0 = (u.pn & 3) * 256 + wc * 32 + 8 * fq;
        const float sc = sec == 0 ? QSCALE : 1.0f;
#pragma unroll
        for (int ai = 0; ai < 2; ++ai)
#pragma unroll
            for (int m = 0; m < 4; ++m) {
                const int row = row0 + ai * 128 + m * 16;
                pf4 cs[2], sn[2];
#pragma unroll
                for (int n = 0; n < 2; ++n) { cs[n] = (pf4){1.f, 1.f, 1.f, 1.f}; sn[n] = (pf4){0.f, 0.f, 0.f, 0.f}; }
                if (dorope) { const int t = row & 2047, pos = axis ? (t & 63) : (t >> 6); const LAS float* rp = rope + pos * 16 + 8 * (fq & 1);
#pragma unroll
                    for (int n = 0; n < 2; ++n) { cs[n] = *(const LAS pf4*)(rp + 4 * n); sn[n] = *(const LAS pf4*)(rp + 1024 + 4 * n); } }
#pragma unroll
                for (int bj = 0; bj < 2; ++bj) {
                    pf4 o[2];
#pragma unroll
                    for (int n = 0; n < 2; ++n)
#pragma unroll
                        for (int j = 0; j < 4; ++j) {
                            const float own = acc[ai][bj][m][n][j];
                            float v = own;
                            if (dorope) {
                                const auto rr = __builtin_amdgcn_permlane32_swap(__float_as_uint(own), __float_as_uint(own), false, false);
                                const float other = __uint_as_float(upper ? rr[0] : rr[1]);
                                v = upper ? (own * cs[n][j] + other * sn[n][j]) : (own * cs[n][j] - other * sn[n][j]);
                            }
                            o[n][j] = v * sc;
                        }
                    u32x4 w; w.x = pk2(o[0][0], o[0][1]); w.y = pk2(o[0][2], o[0][3]); w.z = pk2(o[1][0], o[1][1]); w.w = pk2(o[1][2], o[1][3]);
                    st16_wt(base + (size_t)row * D + col0 + bj * 128, w);
                }
            }
    }
};
struct EpiResid {
    static constexpr bool PERM = true, AFTER_DRAIN = false;
    bf16_t* H; const float* x; const float* ctx; const float* mod; int layer;
    __device__ __forceinline__ void operator()(const pf4 (&acc)[2][2][4][2], const pg8::Unit& u, int wr, int wc, int fr, int fq) const {
        const bool lat = u.pm < 64;
        const float* xb = lat ? x + (size_t)u.pm * 256 * D : ctx + (size_t)(u.pm - 64) * 256 * D;
        const float* g = mod + (size_t)(layer * 9 + (lat ? (u.pm >> 3) : 8)) * 6144 + M_G1;
        bf16_t* out = H + (size_t)u.pm * 256 * D;
        const int r0 = wr * 64 + fr, col0 = u.pn * 256 + wc * 32 + 8 * fq;
        pf4 gv[2][2];
#pragma unroll
        for (int bj = 0; bj < 2; ++bj)
#pragma unroll
            for (int n = 0; n < 2; ++n) gv[bj][n] = *(const pf4*)(g + col0 + bj * 128 + 4 * n);
#pragma unroll
        for (int it = 0; it < 8; ++it) {
            const int ai = it >> 2, m = it & 3;
            const size_t ro = (size_t)(r0 + ai * 128 + m * 16) * D + col0;
#pragma unroll
            for (int bj = 0; bj < 2; ++bj) {
                pf4 b0, b1;
                if (layer == 0) { b0 = *(const pf4*)(xb + ro + bj * 128); b1 = *(const pf4*)(xb + ro + bj * 128 + 4); }
                else { const u32x4 hb = *(const u32x4*)(out + ro + bj * 128); b0 = (pf4){bf_lo(hb.x), bf_hi(hb.x), bf_lo(hb.y), bf_hi(hb.y)}; b1 = (pf4){bf_lo(hb.z), bf_hi(hb.z), bf_lo(hb.w), bf_hi(hb.w)}; }
                const pf4 o0 = b0 + gv[bj][0] * acc[ai][bj][m][0], o1 = b1 + gv[bj][1] * acc[ai][bj][m][1];
                u32x4 w; w.x = pk2(o0[0], o0[1]); w.y = pk2(o0[2], o0[3]); w.z = pk2(o1[0], o1[1]); w.w = pk2(o1[2], o1[3]);
                st16_wt(out + ro + bj * 128, w);
            }
        }
    }
};
struct EpiSwiGLU {
    static constexpr bool PERM = true, AFTER_DRAIN = false;
    bf16_t* ACT;
    __device__ __forceinline__ void operator()(const pf4 (&acc)[2][2][4][2], const pg8::Unit& u, int wr, int wc, int fr, int fq) const {
        const int ct = u.pn % 22;
        bf16_t* p0 = ACT + (size_t)(u.pm * 256 + wr * 64 + fr) * DE + ct * 128 + wc * 32 + 8 * fq;
#pragma unroll
        for (int ai = 0; ai < 2; ++ai)
#pragma unroll
            for (int m = 0; m < 4; ++m) {
                float o[8];
#pragma unroll
                for (int n = 0; n < 2; ++n)
#pragma unroll
                    for (int j = 0; j < 4; ++j) { const float g = acc[ai][0][m][n][j], uu = acc[ai][1][m][n][j]; o[n * 4 + j] = g * __builtin_amdgcn_rcpf(1.0f + fast_exp(-g)) * uu; }
                u32x4 w; w.x = pk2(o[0], o[1]); w.y = pk2(o[2], o[3]); w.z = pk2(o[4], o[5]); w.w = pk2(o[6], o[7]);
                *(u32x4*)(p0 + (size_t)(ai * 128 + m * 16) * DE) = w;
            }
    }
};
struct EpiDown {
    static constexpr bool PERM = true, AFTER_DRAIN = false;
    unsigned char* Y; const float* GATE;
    __device__ __forceinline__ void operator()(const pf4 (&acc)[2][2][4][2], const pg8::Unit& u, int wr, int wc, int fr, int fq) const {
        const int row0 = u.pm * 256 + wr * 64 + fr, col0 = (u.pn & 3) * 256 + wc * 32 + 8 * fq;
        float gts[8];
#pragma unroll
        for (int i = 0; i < 8; ++i) gts[i] = GATE[row0 + (i >> 2) * 128 + (i & 3) * 16] * Y_SCALE;
#pragma unroll
        for (int ai = 0; ai < 2; ++ai)
#pragma unroll
            for (int m = 0; m < 4; ++m) {
                const int row = row0 + ai * 128 + m * 16; const float gt = gts[ai * 4 + m];
#pragma unroll
                for (int bj = 0; bj < 2; ++bj) {
                    const pf4 v0 = acc[ai][bj][m][0] * gt, v1 = acc[ai][bj][m][1] * gt;
                    u32x2 w; w.x = pk4_fp8(v0[0], v0[1], v0[2], v0[3]); w.y = pk4_fp8(v1[0], v1[1], v1[2], v1[3]);
                    st8_wt(Y + (size_t)row * D + col0 + bj * 128, w);
                }
            }
    }
};
struct EpiWin {
    static constexpr bool PERM = true, AFTER_DRAIN = false;
    bf16_t *YG, *XR; const float* bin;
    __device__ __forceinline__ void operator()(const pf4 (&acc)[2][2][4][2], const pg8::Unit& u, int wr, int wc, int fr, int fq) const {
        const bool yb = u.pn < 4; bf16_t* base = yb ? YG : XR;
        const int row0 = u.pm * 256 + wr * 64 + fr, colg = u.pn * 256 + wc * 32 + 8 * fq, col0 = (u.pn & 3) * 256 + wc * 32 + 8 * fq;
        pf4 bv[2][2];
#pragma unroll
        for (int bj = 0; bj < 2; ++bj)
#pragma unroll
            for (int n = 0; n < 2; ++n) bv[bj][n] = *(const pf4*)(bin + colg + bj * 128 + 4 * n);
#pragma unroll
        for (int ai = 0; ai < 2; ++ai)
#pragma unroll
            for (int m = 0; m < 4; ++m) {
                const int row = row0 + ai * 128 + m * 16;
#pragma unroll
                for (int bj = 0; bj < 2; ++bj) {
                    pf4 v0 = acc[ai][bj][m][0] + bv[bj][0], v1 = acc[ai][bj][m][1] + bv[bj][1];
                    if (yb) {
#pragma unroll
                        for (int j = 0; j < 4; ++j) {
                            { const float x = v0[j], uu = 0.7978845608028654f * (x + 0.044715f * x * x * x); v0[j] = x * __builtin_amdgcn_rcpf(1.0f + fast_exp(-2.0f * uu)); }
                            { const float x = v1[j], uu = 0.7978845608028654f * (x + 0.044715f * x * x * x); v1[j] = x * __builtin_amdgcn_rcpf(1.0f + fast_exp(-2.0f * uu)); }
                        }
                    }
                    u32x4 w; w.x = pk2(v0[0], v0[1]); w.y = pk2(v0[2], v0[3]); w.z = pk2(v1[0], v1[1]); w.w = pk2(v1[2], v1[3]);
                    st16_wt(base + (size_t)row * D + col0 + bj * 128, w);
                }
            }
    }
};

#ifndef DENSE_ALIGN
#define DENSE_ALIGN true
#endif
#ifndef DENSE_SP2
#define DENSE_SP2 true
#endif
__device__ __forceinline__ void stagger_start(int ticks) {
    if (ticks > 0 && ((blockIdx.x >> 3) & 1)) { const unsigned long long t0 = __builtin_amdgcn_s_memrealtime(); while (__builtin_amdgcn_s_memrealtime() - t0 < (unsigned long long)ticks) __builtin_amdgcn_s_sleep(8); }
}
#ifndef STG_QKV
#define STG_QKV 0
#endif
#ifndef STG_GU
#define STG_GU 0
#endif
#ifndef STG_DN
#define STG_DN 0
#endif
#ifndef STG_WIN
#define STG_WIN 0
#endif
#ifndef STG_WO
#define STG_WO 0
#endif
#define PG8_RUN(EPI, SCHED, g, S, E) pg8::gemm_phase<EPI, SCHED, DENSE_ALIGN, DENSE_SP2>((PG8_LAS unsigned char*)lds, g, S, E)

__device__ __forceinline__ void ph_qkv_fast(const Ctx& a, LAS unsigned char* lds) {
    unsigned char* ws = a.ws();
    pg8::Gemm g{(const bf16_t*)(ws + WS_XN), (const bf16_t*)(ws + WS_WQKV), RT, 3 * D, D};
    const int Gq = gemm_groups(72 * 12, (int)gridDim.x);
    if ((int)blockIdx.x >= Gq) { cvt8_run(a, 0, CV0_QKV + ((int)blockIdx.x - Gq), (int)gridDim.x - Gq, CV0_QKV + CVQ_QKV, lds); return; }
    ListOrder<MapGrid> S{72 * 12, Gq, (int)blockIdx.x, MapGrid{12}};
    static_assert(WS_V - WS_K == WS_K - WS_Q, "Q|K|V spacing");
    LAS float* rl = (LAS float*)(lds + ROPE_LDS);
    { const float* rg = (const float*)(ws + WS_ROPE); for (int i = threadIdx.x; i < 2048; i += NTHREADS) rl[i] = rg[i]; }
    __syncthreads();
    EpiQKV E{(bf16_t*)(ws + WS_Q), rl};
    stagger_start(STG_QKV);
    PG8_RUN(EpiQKV, ListOrder<MapGrid>, g, S, E);
    if (Gq == (int)gridDim.x) cvt8_tail(a, lds, 72 * 12, Gq, (int)blockIdx.x, 0, CV0_QKV, CVQ_QKV);
}
__device__ __forceinline__ void ph_wo_fast(const Ctx& a, LAS unsigned char* lds) {
    unsigned char* ws = a.ws();
    pg8::Gemm g{(const bf16_t*)(ws + WS_ATT), (const bf16_t*)(ws + WS_WO), RT, D, D};
    const int Gq = gemm_groups(72 * 4, (int)gridDim.x);
    if ((int)blockIdx.x >= Gq) { cvt8_run(a, 0, CV0_WO + ((int)blockIdx.x - Gq), (int)gridDim.x - Gq, CV0_WO + CVQ_WO, lds); return; }
    ListOrder<MapGrid> S{72 * 4, Gq, (int)blockIdx.x, MapGrid{4}};
    EpiResid E{(bf16_t*)(ws + WS_H), a.in(I_X), a.in(I_CTX), (const float*)(ws + WS_MOD), 0};
    stagger_start(STG_WO);
    PG8_RUN(EpiResid, ListOrder<MapGrid>, g, S, E);
    if (Gq == (int)gridDim.x) cvt8_tail(a, lds, 72 * 4, Gq, (int)blockIdx.x, 0, CV0_WO, CVQ_WO);
}
__device__ __forceinline__ void ph_wout_fast(const Ctx& a, LAS unsigned char* lds) {
    unsigned char* ws = a.ws();
    pg8::Gemm g{(const bf16_t*)(ws + WS_HS), (const bf16_t*)(ws + WS_WOUT), RL, D, D};
    ListOrder<MapGrid> S{64 * 4, (int)gridDim.x, (int)blockIdx.x, MapGrid{4}};
    EpiResid E{(bf16_t*)(ws + WS_H), nullptr, nullptr, (const float*)(ws + WS_MOD), 1};
    PG8_RUN(EpiResid, ListOrder<MapGrid>, g, S, E);
}
#if FP8_MOE
struct EpiSwiGLU8 {
    static constexpr bool PERM = true, AFTER_DRAIN = false;
    unsigned char* ACT;
    __device__ __forceinline__ void operator()(const pf4 (&acc)[2][2][4][2], const pg8::Unit& u, int wr, int wc, int fr, int fq) const {
        const int ct = u.pn % 22;
        unsigned char* p0 = ACT + (size_t)(u.pm * 256 + wr * 64 + fr) * DE + ct * 128 + wc * 32 + 8 * fq;
#pragma unroll
        for (int ai = 0; ai < 2; ++ai)
#pragma unroll
            for (int m = 0; m < 4; ++m) {
                float o[8];
#pragma unroll
                for (int n = 0; n < 2; ++n)
#pragma unroll
                    for (int j = 0; j < 4; ++j) { const float g = acc[ai][0][m][n][j], uu = acc[ai][1][m][n][j]; o[n * 4 + j] = g * __builtin_amdgcn_rcpf(1.0f + fast_exp(-g)) * uu; }
                u32x2 w; w.x = pk4_fp8(o[0], o[1], o[2], o[3]); w.y = pk4_fp8(o[4], o[5], o[6], o[7]);
                st8_wt(p0 + (size_t)(ai * 128 + m * 16) * DE, w);
            }
    }
};
__device__ __forceinline__ void ph_gu_fast(const Ctx& a, LAS unsigned char* lds, int layer) {
    unsigned char* ws = a.ws(); const int PM = (layer == 0 ? RPE0 : RPE1) / 256;
    pg8::Gemm g{(const bf16_t*)(ws + WS_XG), (const bf16_t*)(ws + WS_WGU + (size_t)layer * (WGU_LAYER / 2)), NE * PM * 256, NE * 2 * DE, D / 2};
    ListOrder<MapMoe> S{NE * PM * 22, (int)gridDim.x, (int)blockIdx.x, MapMoe{PM, 22}};
    EpiSwiGLU8 E{ws + WS_ACT};
    stagger_start(STG_GU);
    pg8::gemm_phase<EpiSwiGLU8, ListOrder<MapMoe>, GU_ALIGN, true, 122>((PG8_LAS unsigned char*)lds, g, S, E);
    if (layer == 0) cvt8_tail(a, lds, NE * PM * 22, (int)gridDim.x, (int)blockIdx.x, 1, CV1_GU0, CVQ_GU0);
}
__device__ __forceinline__ void ph_dn_fast(const Ctx& a, LAS unsigned char* lds, int layer) {
    unsigned char* ws = a.ws(); const int PM = (layer == 0 ? RPE0 : RPE1) / 256;
    pg8::Gemm g{(const bf16_t*)(ws + WS_ACT), (const bf16_t*)(ws + WS_WDN + (size_t)layer * (WDN_LAYER / 2)), NE * PM * 256, NE * D, DE / 2};
    const int Gq = layer == 0 ? gemm_groups(NE * PM * 4, (int)gridDim.x) : (int)gridDim.x;
    if ((int)blockIdx.x >= Gq) { cvt8_run(a, 1, CV1_DN0 + ((int)blockIdx.x - Gq), (int)gridDim.x - Gq, CV1_DN0 + CVQ_DN0, lds); return; }
    ListOrder<MapMoe> S{NE * PM * 4, Gq, (int)blockIdx.x, MapMoe{PM, 4}};
    EpiDown E{ws + WS_Y, (const float*)(ws + WS_GATE)};
    stagger_start(STG_DN);
    pg8::gemm_phase<EpiDown, ListOrder<MapMoe>, DN_ALIGN, true, 121>((PG8_LAS unsigned char*)lds, g, S, E);
    if (layer == 0 && Gq == (int)gridDim.x) cvt8_tail(a, lds, NE * PM * 4, Gq, (int)blockIdx.x, 1, CV1_DN0, CVQ_DN0);
}
#else
__device__ __forceinline__ void ph_gu_fast(const Ctx& a, LAS unsigned char* lds, int layer) {
    unsigned char* ws = a.ws(); const int PM = (layer == 0 ? RPE0 : RPE1) / 256;
    pg8::Gemm g{(const bf16_t*)(ws + WS_XG), (const bf16_t*)(ws + WS_WGU + (size_t)layer * WGU_LAYER), NE * PM * 256, NE * 2 * DE, D};
    ListOrder<MapMoe> S{NE * PM * 22, (int)gridDim.x, (int)blockIdx.x, MapMoe{PM, 22}};
    EpiSwiGLU E{(bf16_t*)(ws + WS_ACT)};
    PG8_RUN(EpiSwiGLU, ListOrder<MapMoe>, g, S, E);
}
__device__ __forceinline__ void ph_dn_fast(const Ctx& a, LAS unsigned char* lds, int layer) {
    unsigned char* ws = a.ws(); const int PM = (layer == 0 ? RPE0 : RPE1) / 256;
    pg8::Gemm g{(const bf16_t*)(ws + WS_ACT), (const bf16_t*)(ws + WS_WDN + (size_t)layer * WDN_LAYER), NE * PM * 256, NE * D, DE};
    const int Gq = layer == 0 ? gemm_groups(NE * PM * 4, (int)gridDim.x) : (int)gridDim.x;
    if ((int)blockIdx.x >= Gq) { cvt8_run(a, 1, CV1_DN0 + ((int)blockIdx.x - Gq), (int)gridDim.x - Gq, CV1_DN0 + CVQ_DN0, lds); return; }
    ListOrder<MapMoe> S{NE * PM * 4, Gq, (int)blockIdx.x, MapMoe{PM, 4}};
    EpiDown E{ws + WS_Y, (const float*)(ws + WS_GATE)};
    PG8_RUN(EpiDown, ListOrder<MapMoe>, g, S, E);
}
#endif
__device__ __forceinline__ void ph_win_fast(const Ctx& a, LAS unsigned char* lds) {
    unsigned char* ws = a.ws();
    pg8::Gemm g{(const bf16_t*)(ws + WS_XN), (const bf16_t*)(ws + WS_WIN), RT, 2 * D, D};
    const int Gq = gemm_groups(512 + 32, (int)gridDim.x);
    if ((int)blockIdx.x >= Gq) { cvt8_run(a, 1, CV1_WIN + ((int)blockIdx.x - Gq), (int)gridDim.x - Gq, CV1_WIN + CVQ_WIN, lds); return; }
    ListOrder<MapWin> S{512 + 32, Gq, (int)blockIdx.x, MapWin{}};
    EpiWin E{(bf16_t*)(ws + WS_YG), (bf16_t*)(ws + WS_XR), a.in(I_BIN)};
    stagger_start(STG_WIN);
    PG8_RUN(EpiWin, ListOrder<MapWin>, g, S, E);
    if (Gq == (int)gridDim.x) cvt8_tail(a, lds, 512 + 32, Gq, (int)blockIdx.x, 1, CV1_WIN, CVQ_WIN);
}

namespace fa {
using bf16x8 = __attribute__((ext_vector_type(8))) short;
using s16x4  = __attribute__((ext_vector_type(4))) short;
using f32x16 = __attribute__((ext_vector_type(16))) float;
using u32x4v = __attribute__((ext_vector_type(4))) unsigned;
constexpr int SHM_V = 64 * 128 * 2, SHM_K = 64 * 128 * 2;
#ifndef ATT_THR
#define ATT_THR 11.5f
#endif
constexpr float THR_L2 = ATT_THR;
#define KSWZ(row, colB) ((row) * 256 + ((colB) ^ (((row) & 7) << 4)))
#define SBAR() __builtin_amdgcn_sched_barrier(0)
__device__ __forceinline__ int crow(int r, int hi) { return (r & 3) + 8 * (r >> 2) + 4 * hi; }
__device__ __forceinline__ unsigned cvtpk(float lo, float hi) { unsigned r; asm volatile("v_cvt_pk_bf16_f32 %0, %1, %2" : "=v"(r) : "v"(lo), "v"(hi)); return r; }
__device__ __forceinline__ void partialSM(f32x16& p0, f32x16& p1, float& m_reg, float& mn, float& alpha) {
  float pmax = p0[0];
#pragma unroll
  for (int r = 1; r < 16; ++r) pmax = fmaxf(pmax, p0[r]);
#pragma unroll
  for (int r = 0; r < 16; ++r) pmax = fmaxf(pmax, p1[r]);
  { auto rr = __builtin_amdgcn_permlane32_swap(__float_as_uint(pmax), __float_as_uint(pmax), false, false);
    pmax = fmaxf(__uint_as_float(rr[0]), __uint_as_float(rr[1])); }
  if (__builtin_expect(__all(pmax - m_reg <= THR_L2), 1)) { mn = m_reg; alpha = 1.f; }
  else { mn = fmaxf(m_reg, pmax); alpha = __builtin_amdgcn_exp2f(m_reg - mn); m_reg = mn; }
  { typedef float f2_t __attribute__((ext_vector_type(2))); const f2_t mn2 = {mn, mn};
#pragma unroll
    for (int r = 0; r < 16; r += 2) { const f2_t a_ = (f2_t){p0[r], p0[r + 1]} - mn2; p0[r] = a_.x; p0[r + 1] = a_.y; const f2_t b_ = (f2_t){p1[r], p1[r + 1]} - mn2; p1[r] = b_.x; p1[r + 1] = b_.y; } }
#pragma unroll
  for (int r = 0; r < 16; ++r) p0[r] = __builtin_amdgcn_exp2f(p0[r]);
}
__device__ __forceinline__ void finishSM(f32x16& p0, f32x16& p1, float alpha, float& l_reg, bf16x8& pa0, bf16x8& pa1, bf16x8& pa2, bf16x8& pa3) {
#pragma unroll
  for (int r = 0; r < 16; ++r) p1[r] = __builtin_amdgcn_exp2f(p1[r]);
  float ps = 0;
#pragma unroll
  for (int r = 0; r < 16; ++r) ps += p0[r];
#pragma unroll
  for (int r = 0; r < 16; ++r) ps += p1[r];
  { auto rr = __builtin_amdgcn_permlane32_swap(__float_as_uint(ps), __float_as_uint(ps), false, false);
    ps = __uint_as_float(rr[0]) + __uint_as_float(rr[1]); }
  l_reg = l_reg * alpha + ps;
#define PK4(P, BASE, OUT) do { unsigned a0 = cvtpk(P[BASE + 0], P[BASE + 1]), a1 = cvtpk(P[BASE + 2], P[BASE + 3]);   \
    unsigned b0 = cvtpk(P[BASE + 4], P[BASE + 5]), b1 = cvtpk(P[BASE + 6], P[BASE + 7]);                              \
    auto r0 = __builtin_amdgcn_permlane32_swap(a0, b0, false, false); auto r1 = __builtin_amdgcn_permlane32_swap(a1, b1, false, false); \
    u32x4v w = {r0[0], r1[0], r0[1], r1[1]}; OUT = *reinterpret_cast<bf16x8*>(&w); } while (0)
  PK4(p0, 0, pa0); PK4(p0, 8, pa1); PK4(p1, 0, pa2); PK4(p1, 8, pa3);
#undef PK4
}
__device__ __forceinline__ void qkt(f32x16& p0, f32x16& p1, const LAS char* Ks, const bf16x8* qr, int r32, int hi, int s) {
  p0 = f32x16{}; p1 = f32x16{};
#pragma unroll
  for (int d0 = 0; d0 < 4; ++d0) { const int cb = (s * 64 + d0 * 16 + hi * 8) * 2;
    const bf16x8 b0 = *reinterpret_cast<const LAS bf16x8*>(Ks + KSWZ(r32, cb));
    const bf16x8 b1 = *reinterpret_cast<const LAS bf16x8*>(Ks + KSWZ(32 + r32, cb));
    p0 = __builtin_amdgcn_mfma_f32_32x32x16_bf16(b0, qr[d0], p0, 0, 0, 0);
    p1 = __builtin_amdgcn_mfma_f32_32x32x16_bf16(b1, qr[d0], p1, 0, 0, 0); }
}
__device__ __forceinline__ int v_st(int k, int c) { const int kk = (k & ~0xC) | ((k & 4) << 1) | ((k & 8) >> 1); return ((kk >> 3) * 4 + (c >> 5)) * 512 + ((kk & 7) * 32 + (c & 31)) * 2; }
__device__ __forceinline__ int v_rd_base(int lane) { return ((lane & 3) << 3) | (((lane >> 2) & 3) << 6) | (((lane >> 4) & 1) << 5) | (((lane >> 5) & 1) << 8); }
constexpr int v_rd_off(int d0, int ks, int half) { return d0 * 512 + ks * 4096 + half * 2048; }
template <int OFF> __device__ __forceinline__ s16x4 tr_read(int vb) {
  s16x4 r; asm volatile("ds_read_b64_tr_b16 %0, %1 offset:%2" : "=&v"(r) : "v"(vb), "i"(OFF) : "memory"); return r;
}
template <int D0> __device__ __forceinline__ void pv_one(f32x16& od, int vb, bf16x8 pa0, bf16x8 pa1, bf16x8 pa2, bf16x8 pa3) {
  const s16x4 l0 = tr_read<v_rd_off(D0, 0, 0)>(vb), h0 = tr_read<v_rd_off(D0, 0, 1)>(vb), l1 = tr_read<v_rd_off(D0, 1, 0)>(vb), h1 = tr_read<v_rd_off(D0, 1, 1)>(vb);
  const s16x4 l2 = tr_read<v_rd_off(D0, 2, 0)>(vb), h2 = tr_read<v_rd_off(D0, 2, 1)>(vb), l3 = tr_read<v_rd_off(D0, 3, 0)>(vb), h3 = tr_read<v_rd_off(D0, 3, 1)>(vb);
  asm volatile("s_waitcnt lgkmcnt(0)" ::: "memory"); SBAR();
#define PK(L, H) (bf16x8){L[0], L[1], L[2], L[3], H[0], H[1], H[2], H[3]}
  od = __builtin_amdgcn_mfma_f32_32x32x16_bf16(pa0, PK(l0, h0), od, 0, 0, 0);
  od = __builtin_amdgcn_mfma_f32_32x32x16_bf16(pa1, PK(l1, h1), od, 0, 0, 0);
  od = __builtin_amdgcn_mfma_f32_32x32x16_bf16(pa2, PK(l2, h2), od, 0, 0, 0);
  od = __builtin_amdgcn_mfma_f32_32x32x16_bf16(pa3, PK(l3, h3), od, 0, 0, 0);
#undef PK
}
__device__ __forceinline__ void pv_d0(f32x16* o, int vb, bf16x8 pa0, bf16x8 pa1, bf16x8 pa2, bf16x8 pa3) {
  pv_one<0>(o[0], vb, pa0, pa1, pa2, pa3); pv_one<1>(o[1], vb, pa0, pa1, pa2, pa3); pv_one<2>(o[2], vb, pa0, pa1, pa2, pa3); pv_one<3>(o[3], vb, pa0, pa1, pa2, pa3);
}

__device__ __forceinline__ int tile_row(bool latq, int b, int j) { return latq ? (j < 32 ? b * SEQ + 64 * j : RL + b * CTXL + 64 * (j - 32)) : RL + b * CTXL + 64 * j; }

__device__ __forceinline__ void attn_unit(const bf16_t* __restrict__ Qg, const bf16_t* __restrict__ Kg, const bf16_t* __restrict__ Vg, bf16_t* __restrict__ ATT,
                                          const float* subg, float lam, bool latq, int b, int h, int qrow0, LAS unsigned char* lds) {
  const int tid = threadIdx.x, wid = __builtin_amdgcn_readfirstlane(tid >> 6), lane = tid & 63, r32 = lane & 31, hi = lane >> 5, rg = wid >> 1, s = wid & 1;
  LAS char* V_lds = (LAS char*)lds; LAS char* K_lds = (LAS char*)lds + 2 * SHM_V;
  LAS float* ws = (LAS float*)(lds + 65536) + wid * 64; LAS float* li_l = ws; LAS float* al_l = ws + 32;
  const int NT = latq ? 36 : 4;
  float m_reg = -1e30f, l_reg = 0; f32x16 o[4] = {}; bf16x8 qr[4];
  const bf16_t* Qw = Qg + (size_t)(qrow0 + rg * 32 + r32) * D + h * 128 + s * 64 + hi * 8;
#pragma unroll
  for (int d0 = 0; d0 < 4; ++d0) qr[d0] = *reinterpret_cast<const bf16x8*>(Qw + d0 * 16);
  const int sr = tid >> 4, sc = (tid & 15) * 8, vst0 = v_st(sr, sc), vst1 = v_st(32 + sr, sc);
  const int vb0 = (int)(unsigned)(size_t)V_lds + v_rd_base(lane);
  const size_t hoff = (size_t)h * 128 + sc;
  struct { bf16x8 vs0, vs1, ks0, ks1; } sr_[2];
#define SLOAD(i, j) do { const size_t ro_ = (size_t)(tile_row(latq, b, (j)) + sr) * D + hoff; \
    sr_[i].vs0 = *reinterpret_cast<const bf16x8*>(Vg + ro_); sr_[i].vs1 = *reinterpret_cast<const bf16x8*>(Vg + ro_ + 32 * D); \
    sr_[i].ks0 = *reinterpret_cast<const bf16x8*>(Kg + ro_); sr_[i].ks1 = *reinterpret_cast<const bf16x8*>(Kg + ro_ + 32 * D); } while (0)
#define SWRITE(bb, i) do { *(LAS bf16x8*)(V_lds + (bb) * SHM_V + vst0) = sr_[i].vs0; *(LAS bf16x8*)(V_lds + (bb) * SHM_V + vst1) = sr_[i].vs1; const int kc = sc * 2; \
    *(LAS bf16x8*)(K_lds + (bb) * SHM_K + KSWZ(sr, kc)) = sr_[i].ks0; *(LAS bf16x8*)(K_lds + (bb) * SHM_K + KSWZ(32 + sr, kc)) = sr_[i].ks1; } while (0)
#define SWAIT() asm volatile("s_waitcnt vmcnt(4)" ::: "memory")
#define RESC(a_) do { if (__any((a_) < 1.f)) { if (hi == 0) al_l[r32] = (a_); asm volatile("s_waitcnt lgkmcnt(0)" ::: "memory"); \
    _Pragma("unroll") for (int d = 0; d < 4; ++d) _Pragma("unroll") for (int r = 0; r < 16; ++r) o[d][r] *= al_l[crow(r, hi)]; } } while (0)
  f32x16 pA0, pA1, pB0, pB1; float mnA, mnB, alA, alB; bf16x8 pa0, pa1, pa2, pa3;
  constexpr int SE = 0, SO = 1;
  SLOAD(SE, 0); asm volatile("s_waitcnt vmcnt(0)" ::: "memory"); SWRITE(0, SE); __syncthreads();
  qkt(pA0, pA1, K_lds, qr, r32, hi, s); partialSM(pA0, pA1, m_reg, mnA, alA);
  SLOAD(SO, 1); if (2 < NT) SLOAD(SE, 2);
  SWAIT(); SWRITE(1, SO); __syncthreads();
  for (int j = 1; j + 1 < NT; j += 2) {
    SBAR(); qkt(pB0, pB1, K_lds + SHM_K, qr, r32, hi, s);
    finishSM(pA0, pA1, alA, l_reg, pa0, pa1, pa2, pa3); SBAR();
    SLOAD(SO, j + 2); SBAR();
    pv_d0(o, vb0, pa0, pa1, pa2, pa3); partialSM(pB0, pB1, m_reg, mnB, alB);
    __syncthreads(); SWAIT(); SWRITE(0, SE);
    RESC(alB); __syncthreads();
    SBAR(); qkt(pA0, pA1, K_lds, qr, r32, hi, s);
    finishSM(pB0, pB1, alB, l_reg, pa0, pa1, pa2, pa3); SBAR();
    if (j + 3 < NT) SLOAD(SE, j + 3); SBAR();
    pv_d0(o, vb0 + SHM_V, pa0, pa1, pa2, pa3); partialSM(pA0, pA1, m_reg, mnA, alA);
    __syncthreads(); SWAIT(); SWRITE(1, SO);
    RESC(alA); __syncthreads();
  }
  SBAR(); qkt(pB0, pB1, K_lds + SHM_K, qr, r32, hi, s);
  finishSM(pA0, pA1, alA, l_reg, pa0, pa1, pa2, pa3); SBAR();
  pv_d0(o, vb0, pa0, pa1, pa2, pa3); partialSM(pB0, pB1, m_reg, mnB, alB);
  __syncthreads(); RESC(alB);
  finishSM(pB0, pB1, alB, l_reg, pa0, pa1, pa2, pa3); SBAR();
  pv_d0(o, vb0 + SHM_V, pa0, pa1, pa2, pa3);
#undef SLOAD
#undef SWRITE
#undef SWAIT
#undef RESC
  if (hi == 0) li_l[r32] = l_reg;
  asm volatile("s_waitcnt lgkmcnt(0)" ::: "memory");
  float rli[16];
#pragma unroll
  for (int r = 0; r < 16; ++r) rli[r] = __builtin_amdgcn_rcpf(li_l[crow(r, hi)]);
  __syncthreads();
  LAS float* X = (LAS float*)lds + rg * 4096;
  if (s == 1) {
#pragma unroll
    for (int r = 0; r < 16; ++r)
#pragma unroll
      for (int d0 = 0; d0 < 4; ++d0) X[crow(r, hi) * 128 + d0 * 32 + r32] = o[d0][r] * (rli[r] * lam);
  }
  __syncthreads();
  if (s == 0) {
    float rstd[16];
#pragma unroll
    for (int r = 0; r < 16; ++r) {
      float acc = 0.f;
#pragma unroll
      for (int d0 = 0; d0 < 4; ++d0) { const float v = o[d0][r] * rli[r] - X[crow(r, hi) * 128 + d0 * 32 + r32]; o[d0][r] = v; acc += v * v; }
#pragma unroll
      for (int off = 1; off < 32; off <<= 1) acc += __shfl_xor(acc, off);
      rstd[r] = 1.0f / sqrtf(acc * (1.0f / 128.0f) + EPS);
    }
    LAS bf16_t* stg = (LAS bf16_t*)(lds + 65536 + 2048) + rg * 4096;
    float gsc[4];
#pragma unroll
    for (int d0 = 0; d0 < 4; ++d0) gsc[d0] = subg[d0 * 32 + r32] * (1.0f - LAMBDA_INIT0);
#pragma unroll
    for (int r = 0; r < 16; ++r)
#pragma unroll
      for (int d0 = 0; d0 < 4; ++d0) stg[crow(r, hi) * 128 + d0 * 32 + r32] = (bf16_t)f2bf(o[d0][r] * rstd[r] * gsc[d0]);
    asm volatile("s_waitcnt lgkmcnt(0)" ::: "memory");
    bf16_t* Ow = ATT + (size_t)(qrow0 + rg * 32) * D + h * 128;
#pragma unroll
    for (int i = 0; i < 8; ++i) { const int row = i * 4 + (lane >> 4), ch = lane & 15; const u32x4v v = *(const LAS u32x4v*)(stg + row * 128 + ch * 8); *(u32x4v*)(Ow + (size_t)row * D + ch * 8) = v; }
  }
  __syncthreads();
}
#undef KSWZ
#undef SBAR
}

__device__ __forceinline__ void ph_attn_fast(const Ctx& a, LAS unsigned char* lds) {
    unsigned char* ws = a.ws();
    const bf16_t* Q = (const bf16_t*)(ws + WS_Q); const bf16_t* Kb = (const bf16_t*)(ws + WS_K); const bf16_t* V = (const bf16_t*)(ws + WS_V);
    bf16_t* ATT = (bf16_t*)(ws + WS_ATT); const float* subg = a.in(I_SUBG);
    const float lam = diff_lambda(a, threadIdx.x & 63);
    const int G = gridDim.x, c = blockIdx.x;
    for (int i = 0;; ++i) {
        const long L = (long)i * G + c; if (L >= 1024) break;
        const int w = xcd_remap(L, 1024), bh = w >> 4, qb = w & 15, b = bh >> 3, h = bh & 7;
        fa::attn_unit(Q, Kb, V, ATT, subg, lam, true, b, h, b * SEQ + qb * 128, lds);
    }
    for (int L = c; L < 128; L += G) {
        const int bh = L >> 1, qb = L & 1, b = bh >> 3, h = bh & 7;
        fa::attn_unit(Q, Kb, V, ATT, subg, lam, false, b, h, RL + b * CTXL + qb * 128, lds);
    }
#if DENSE_LATE && ANY_FAST_GEMM
    if (c >= 128 && G > 128) { for (int r = c - 128; r < IT_DENSE_REST; r += G - 128) cvt_dense_rest_item(a, r); }
#endif
}


__device__ __forceinline__ void ph_gates_fast(const Ctx& a, LAS unsigned char* lds) {
    unsigned char* ws = a.ws();
    const bf16_t* XR = (const bf16_t*)(ws + WS_XR); const bf16_t* WG = (const bf16_t*)(ws + WS_WG);
    bf16_t* LOGA = (bf16_t*)(ws + WS_LOGA); unsigned char* BT = ws + WS_BT;
    const float* convw = a.in(I_CONVW); const float* convb = a.in(I_CONVB); const float* gtab = (const float*)(ws + WS_GTAB);
    const int tid = threadIdx.x, wid = __builtin_amdgcn_readfirstlane(tid >> 6), lane = tid & 63, wr = wid >> 2, wc = wid & 3, fr = lane & 15, fq = lane >> 4;
    constexpr int HTB = pg8::HTB;
    const int aoff = pg8::lds_byte(wr * 64 + fr, fq * 8), boff = pg8::lds_byte(wc * 32 + fr, fq * 8);
    const int sc = tid & 15, rg8 = tid >> 4;
    unsigned bsrc[2];
#pragma unroll
    for (int i = 0; i < 2; ++i) { int R, C; pg8::stage_rc(tid * 16 + i * 8192, R, C); bsrc[i] = (unsigned)(((R & ~31) + pg8::perm32(R & 31)) * 128 + C) * 2u; }
    const unsigned ldsw = (unsigned)wid * 1024u;
#define GT_DMA_B(d_) do { const char* wb_ = (const char*)(WG + (size_t)((d_) * 8 + kb) * 256 * 128); \
        _Pragma("unroll") for (int kt_ = 0; kt_ < 2; ++kt_) _Pragma("unroll") for (int h_ = 0; h_ < 2; ++h_) _Pragma("unroll") for (int i_ = 0; i_ < 2; ++i_) \
            __builtin_amdgcn_global_load_lds((const unsigned*)(wb_ + (size_t)h_ * 128 * 256 + kt_ * 128 + bsrc[i_]), (LAS unsigned*)(lds + (4 + kt_ * 2 + h_) * HTB + ldsw + i_ * 8192), 16, 0, 0); } while (0)
    const int Gq = gemm_groups(72 * 8, (int)gridDim.x);
    if ((int)blockIdx.x >= Gq) { cvt8_run(a, 1, CV1_GATES + ((int)blockIdx.x - Gq), (int)gridDim.x - Gq, CV1_GATES + CVQ_GATES, lds); return; }
    for (int u = blockIdx.x; u < 72 * 8; u += Gq) {
        const int kb = u & 7, rt = u >> 3;
        const bool lat = rt < 64; const int bsm = lat ? (rt >> 3) : (rt - 64), t0 = lat ? (rt & 7) * 256 : 0, L = lat ? SEQ : CTXL;
        const int seqbase = lat ? bsm * SEQ : RL + bsm * CTXL;
        GT_DMA_B(0);
        {
            const int ch0 = kb * 128 + sc * 8, r0 = rg8 * 8;
            u32x4 xin[11];
#pragma unroll
            for (int i = 0; i < 11; ++i) { const int tt = t0 + r0 - 2 + i; xin[i] = (tt >= 0 && tt < L) ? *(const u32x4*)(XR + (size_t)(seqbase + tt) * D + ch0) : (u32x4){0u, 0u, 0u, 0u}; }
            f32x4 cw[4][2], cb[2];
#pragma unroll
            for (int j = 0; j < 4; ++j) { cw[j][0] = *(const f32x4*)(convw + j * D + ch0); cw[j][1] = *(const f32x4*)(convw + j * D + ch0 + 4); }
            cb[0] = *(const f32x4*)(convb + ch0); cb[1] = *(const f32x4*)(convb + ch0 + 4);
#pragma unroll
            for (int k = 0; k < 8; ++k) {
                f32x4 o0 = cb[0], o1 = cb[1];
#pragma unroll
                for (int j = 0; j < 4; ++j) { const u32x4 x = xin[k + j];
                    o0 += cw[j][0] * (f32x4){bf_lo(x.x), bf_hi(x.x), bf_lo(x.y), bf_hi(x.y)}; o1 += cw[j][1] * (f32x4){bf_lo(x.z), bf_hi(x.z), bf_lo(x.w), bf_hi(x.w)}; }
                const int r = r0 + k;
                u32x4 w; w.x = pk2(o0[0], o0[1]); w.y = pk2(o0[2], o0[3]); w.z = pk2(o1[0], o1[1]); w.w = pk2(o1[2], o1[3]);
                *(LAS u32x4*)(lds + ((sc >> 3) * 2 + (r >> 7)) * HTB + pg8::lds_byte(r & 127, (sc & 7) * 8)) = w;
            }
        }
#pragma unroll 1
        for (int d = 0; d < 2; ++d) {
            asm volatile("s_waitcnt vmcnt(0)" ::: "memory");
            __syncthreads();
            pf4 acc[2][2][4][2];
#pragma unroll
            for (int ai = 0; ai < 2; ++ai)
#pragma unroll
                for (int bj = 0; bj < 2; ++bj)
#pragma unroll
                    for (int m = 0; m < 4; ++m)
#pragma unroll
                        for (int n = 0; n < 2; ++n) acc[ai][bj][m][n] = (pf4){0.f, 0.f, 0.f, 0.f};
#pragma unroll 1
            for (int kt = 0; kt < 2; ++kt)
#pragma unroll
                for (int ai = 0; ai < 2; ++ai) {
                    __builtin_amdgcn_sched_barrier(0);
                    pg8::bf16x8 At[4][2];
#pragma unroll
                    for (int m = 0; m < 4; ++m)
#pragma unroll
                        for (int k = 0; k < 2; ++k) At[m][k] = *(const LAS pg8::bf16x8*)(lds + (kt * 2 + ai) * HTB + aoff + m * 2048 + k * 1024);
#pragma unroll
                    for (int bj = 0; bj < 2; ++bj) {
                        pg8::bf16x8 Bf[2][2];
#pragma unroll
                        for (int n = 0; n < 2; ++n)
#pragma unroll
                            for (int k = 0; k < 2; ++k) Bf[n][k] = *(const LAS pg8::bf16x8*)(lds + (4 + kt * 2 + bj) * HTB + boff + n * 2048 + k * 1024);
#pragma unroll
                        for (int m = 0; m < 4; ++m)
#pragma unroll
                            for (int n = 0; n < 2; ++n)
#pragma unroll
                                for (int k = 0; k < 2; ++k) acc[ai][bj][m][n] = __builtin_amdgcn_mfma_f32_16x16x32_bf16(Bf[n][k], At[m][k], acc[ai][bj][m][n], 0, 0, 0);
                        __builtin_amdgcn_sched_barrier(0);
                    }
                }
            if (d == 0) { __syncthreads(); GT_DMA_B(1); }
            const int cc0 = wc * 32 + fq * 8;
            pf4 cl[2], c2[2], brn[2], bin[2];
#pragma unroll
            for (int n = 0; n < 2; ++n) { const float* g = gtab + (size_t)(d * 4) * D + kb * 128 + cc0 + 4 * n;
                cl[n] = *(const pf4*)g; c2[n] = *(const pf4*)(g + D); brn[n] = *(const pf4*)(g + 2 * D); bin[n] = *(const pf4*)(g + 3 * D); }
#pragma unroll
            for (int ai = 0; ai < 2; ++ai)
#pragma unroll
                for (int m = 0; m < 4; ++m) {
                    const int rl = wr * 64 + m * 16 + fr;
                    const int grow = seqbase + t0 + ai * 128 + rl;
                    float la[8], bt[8];
#pragma unroll
                    for (int n = 0; n < 2; ++n) {
                        const int cc = cc0 + 4 * n;
                        const u32x2 xw = *(const LAS u32x2*)(lds + ((cc >> 6) * 2 + ai) * HTB + pg8::lds_byte(rl, cc & 63));
                        const float xv[4] = {bf_lo(xw.x), bf_hi(xw.x), bf_lo(xw.y), bf_hi(xw.y)};
#pragma unroll
                        for (int j = 0; j < 4; ++j) {
                            const float r = __builtin_amdgcn_rcpf(1.0f + __builtin_amdgcn_exp2f(fmaf(acc[ai][0][m][n][j], -1.4426950408889634f, brn[n][j])));
                            const float ig = __builtin_amdgcn_rcpf(1.0f + __builtin_amdgcn_exp2f(fmaf(acc[ai][1][m][n][j], -1.4426950408889634f, bin[n][j])));
                            const float om = 1.0f - __builtin_amdgcn_exp2f(r * c2[n][j]);
                            la[n * 4 + j] = r * cl[n][j]; bt[n * 4 + j] = __builtin_amdgcn_sqrtf(om) * (ig * xv[j]) * BT_SCALE;
                        }
                    }
                    const size_t o = ((size_t)d * RT + grow) * D + kb * 128 + cc0;
                    u32x4 w; w.x = pk2(la[0], la[1]); w.y = pk2(la[2], la[3]); w.z = pk2(la[4], la[5]); w.w = pk2(la[6], la[7]);
                    *(u32x4*)(LOGA + o) = w;
                    u32x2 wb; wb.x = pk4_fp8(bt[0], bt[1], bt[2], bt[3]); wb.y = pk4_fp8(bt[4], bt[5], bt[6], bt[7]);
                    *(u32x2*)(BT + o) = wb;
                }
        }
#if FUSE_SCAN1
        asm volatile("s_waitcnt vmcnt(0)" ::: "memory");
        __syncthreads();
        {
            const int dir = wid >> 2, lc = wid & 3, kc = (t0 >> 6) + lc;
            const int c = dir == 0 ? (lat ? NCH_CTX + kc : kc) : (lat ? NCH - 1 - kc : NCH_CTX - 1 - kc);
            const int ch = kb * 128 + 2 * lane;
            float* CP = (float*)(ws + WS_CP); float* CB = (float*)(ws + WS_CB);
            float h0 = 0.f, h1 = 0.f, p0 = 0.f, p1 = 0.f;
#pragma unroll 1
            for (int sg = 0; sg < SCH; sg += 32) {
                unsigned la[32], bt[32];
#pragma unroll
                for (int i = 0; i < 32; ++i) { const size_t o = ((size_t)dir * RT + scan_row(bsm, dir, c, sg + i)) * D + ch; la[i] = *(const unsigned*)(LOGA + o); bt[i] = *(const unsigned short*)(BT + o); }
                asm volatile("" ::: "memory");
#pragma unroll
                for (int i = 0; i < 32; ++i) { const float l0 = bf_lo(la[i]), l1 = bf_hi(la[i]); const f32x2 bb = __builtin_amdgcn_cvt_pk_f32_fp8((int)bt[i], false);
                    h0 = __builtin_amdgcn_exp2f(l0) * h0 + bb.x; h1 = __builtin_amdgcn_exp2f(l1) * h1 + bb.y; p0 += l0; p1 += l1; }
            }
            const size_t so = ((size_t)(bsm * 2 + dir) * NCH + c) * D + ch;
            *(f32x2*)(CP + so) = (f32x2){p0, p1}; *(f32x2*)(CB + so) = (f32x2){h0, h1};
        }
#endif
        __syncthreads();
    }
#undef GT_DMA_B
    if (Gq == (int)gridDim.x) cvt8_tail(a, lds, 72 * 8, Gq, (int)blockIdx.x, 1, CV1_GATES, CVQ_GATES);
}

constexpr int NPHASES = 25;
__host__ __device__ constexpr bool phase_enabled(int p) {
    return !((p == 3 && FAST_QKV) || (p == 9 && FAST_GU) || (p == 22 && FAST_GU) || (p == 13 && FAST_GATES) || (p == 15 && FAST_GATES) || (p == 16 && FAST_GATES && FUSE_SCAN1));
}

__global__ void __launch_bounds__(NTHREADS, 2) hybrid_fwd(Args args) {
    extern __shared__ __attribute__((aligned(16))) unsigned char lds_raw[];
    LAS unsigned char* lds = (LAS unsigned char*)lds_raw;
    volatile LAS unsigned* MISC = (volatile LAS unsigned*)(lds + MISC_OFF);
    const int lo = args.ph_lo, hi = args.ph_hi;
    if (threadIdx.x == 0) {
        LAS unsigned long long* la64 = (LAS unsigned long long*)(lds + ARGS_OFF);
#pragma unroll
        for (int i = 0; i < 27; ++i) la64[i] = (unsigned long long)args.in[i];
        la64[27] = (unsigned long long)args.out; la64[28] = (unsigned long long)args.ws;
    }
    Ctx ctx; ctx.la = (const LAS unsigned*)(lds + ARGS_OFF);
    if (threadIdx.x < 16) MISC[threadIdx.x] = 0u;
    __syncthreads();
#if MK_ONE_LAUNCH
    XcdBarrier bar = xcd_barrier_post((unsigned*)(ctx.ws() + WS_CTL) + CW_BAR, MISC + 8);
#define GRID_BAR() xcd_barrier(bar)
#else
#define GRID_BAR() do { } while (0)
#endif
#ifndef REP_MASK
#define REP_MASK 0u
#endif
#define RUN(k, call) do { call; if constexpr (((REP_MASK) >> (k)) & 1u) { __syncthreads(); call; } } while (0)
#define IN(k) (lo <= (k) && (k) < hi)
#define SEAM(k) do { if ((k) + 1 < hi) GRID_BAR(); } while (0)

    if (IN(0)) { RUN(0, ph_prologue(ctx, lds)); SEAM(0); }
    if (IN(1)) { RUN(1, ph_norm1_l0(ctx)); SEAM(1); }
    if (IN(2)) {
#if FAST_QKV
        RUN(2, ph_qkv_fast(ctx, lds));
#else
        RUN(2, ph_qkv_naive(ctx, lds));
#endif
        SEAM(2); }
#if !FAST_QKV
    if (IN(3)) { RUN(3, ph_rope_naive(ctx)); SEAM(3); }
#endif
    if (IN(4)) {
#if FAST_ATTN
        RUN(4, ph_attn_fast(ctx, lds));
#else
        RUN(4, ph_attn_naive(ctx, lds));
#endif
        SEAM(4); }
    if (IN(5)) {
#if FAST_WO
        RUN(5, ph_wo_fast(ctx, lds));
#else
        RUN(5, ph_wo_naive(ctx, lds));
#endif
        SEAM(5); }
    if (IN(6)) { RUN(6, ph_norm2_router(ctx, lds, 0, RT)); SEAM(6); }
    if (IN(7)) { RUN(7, ph_topk_gather(ctx, lds, 0)); SEAM(7); }
    if (IN(8)) {
#if FAST_GU
        RUN(8, ph_gu_fast(ctx, lds, 0));
#else
        RUN(8, ph_gu_naive(ctx, lds, 0));
#endif
        SEAM(8); }
#if !FAST_GU
    if (IN(9)) { RUN(9, ph_swiglu_naive(ctx, 0)); SEAM(9); }
#endif
    if (IN(10)) {
#if FAST_DN
        RUN(10, ph_dn_fast(ctx, lds, 0));
#else
        RUN(10, ph_dn_naive(ctx, lds, 0));
#endif
        SEAM(10); }
    if (IN(11)) { RUN(11, ph_combine<0>(ctx, 0, RT)); SEAM(11); }
    if (IN(12)) {
#if FAST_WIN
        RUN(12, ph_win_fast(ctx, lds));
#else
        RUN(12, ph_win_naive(ctx, lds));
#endif
        SEAM(12); }
#if !FAST_GATES
    if (IN(13)) { RUN(13, ph_conv_naive(ctx)); SEAM(13); }
#endif
    if (IN(14)) {
#if FAST_GATES
        RUN(14, ph_gates_fast(ctx, lds));
#else
        RUN(14, ph_gates_naive(ctx, lds));
#endif
        SEAM(14); }
#if !FAST_GATES
    if (IN(15)) { RUN(15, ph_gate_elem_naive(ctx)); SEAM(15); }
#endif
#if !(FUSE_SCAN1 && FAST_GATES)
    if (IN(16)) { RUN(16, ph_scan1(ctx)); SEAM(16); }
#endif
    if (IN(17)) { RUN(17, ph_scan2(ctx)); SEAM(17); }
    if (IN(18)) {
#if FAST_WOUT
        RUN(18, ph_wout_fast(ctx, lds));
#else
        RUN(18, ph_wout_naive(ctx, lds));
#endif
        SEAM(18); }
    if (IN(19)) { RUN(19, ph_norm2_router(ctx, lds, 1, RL)); SEAM(19); }
    if (IN(20)) { RUN(20, ph_topk_gather(ctx, lds, 1)); SEAM(20); }
    if (IN(21)) {
#if FAST_GU
        RUN(21, ph_gu_fast(ctx, lds, 1));
#else
        RUN(21, ph_gu_naive(ctx, lds, 1));
#endif
        SEAM(21); }
#if !FAST_GU
    if (IN(22)) { RUN(22, ph_swiglu_naive(ctx, 1)); SEAM(22); }
#endif
    if (IN(23)) {
#if FAST_DN
        RUN(23, ph_dn_fast(ctx, lds, 1));
#else
        RUN(23, ph_dn_naive(ctx, lds, 1));
#endif
        SEAM(23); }
    if (IN(24)) { RUN(24, ph_combine<1>(ctx, 1, RL)); }
#undef IN
#undef SEAM
#undef GRID_BAR
}

extern "C" void kernel_launch(void* const* d_in, const int* in_sizes, int n_in, void* d_out, int out_size, void* d_ws, size_t ws_size, hipStream_t stream) {
    static int grid = 0;
    if (grid == 0) {
        if (n_in != 27 || out_size != RL * D || ws_size < WS_END) { fprintf(stderr, "kernel_launch: unexpected shapes (n_in %d out %d ws %zu)\n", n_in, out_size, ws_size); grid = -1; return; }
        int dev = 0, cus = 0, per_cu = 0;
        if (hipGetDevice(&dev) != hipSuccess || hipDeviceGetAttribute(&cus, hipDeviceAttributeMultiprocessorCount, dev) != hipSuccess) { grid = -1; return; }
        if (hipFuncSetAttribute((const void*)hybrid_fwd, hipFuncAttributeMaxDynamicSharedMemorySize, LDS_BYTES) != hipSuccess) { fprintf(stderr, "kernel_launch: hipFuncSetAttribute failed\n"); grid = -1; return; }
        if (hipOccupancyMaxActiveBlocksPerMultiprocessor(&per_cu, (const void*)hybrid_fwd, NTHREADS, LDS_BYTES) != hipSuccess || per_cu < 1) { fprintf(stderr, "kernel_launch: occupancy query says %d\n", per_cu); }
        (void)hipGetLastError();
        grid = cus > 0 ? cus : 256;
    }
    if (grid < 0) return;
    if (hipMemsetAsync((char*)d_ws + WS_CTL, 0, CTL_ZERO_BYTES, stream) != hipSuccess) return;
    Args a{};
    for (int i = 0; i < 27; ++i) a.in[i] = (const float*)d_in[i];
    a.out = (float*)d_out; a.ws = (unsigned char*)d_ws;
#if MK_ONE_LAUNCH
    a.ph_lo = 0; a.ph_hi = NPHASES;
    hipLaunchKernelGGL(hybrid_fwd, dim3(grid), dim3(NTHREADS), LDS_BYTES, stream, a);
#else
    for (int p = 0; p < NPHASES; ++p) {
        if (!phase_enabled(p)) continue;
        a.ph_lo = p; a.ph_hi = p + 1;
        hipLaunchKernelGGL(hybrid_fwd, dim3(grid), dim3(NTHREADS), LDS_BYTES, stream, a);
    }
#endif
    const hipError_t le = hipPeekAtLastError();
    if (le != hipSuccess) fprintf(stderr, "kernel_launch: launch failed: %s\n", hipGetErrorName(le));
}
```

```cpp
#define MK_ONE_LAUNCH 1
#define FAST_QKV 1
#define FAST_WO 1
#define FAST_GU 1
#define FAST_DN 1
#define FAST_WIN 1
#define FAST_WOUT 1
#define FAST_ATTN 1
#define FAST_GATES 1
#define FP8_MOE 1
#include <hip/hip_runtime.h>
#include <cstdio>
#include <cstdint>
#include <cmath>

#ifndef MK_ONE_LAUNCH
#define MK_ONE_LAUNCH 0
#endif
#ifndef FAST_QKV
#define FAST_QKV 0
#endif
#ifndef FAST_ATTN
#define FAST_ATTN 0
#endif
#ifndef FAST_WO
#define FAST_WO 0
#endif
#ifndef FAST_GU
#define FAST_GU 0
#endif
#ifndef FAST_DN
#define FAST_DN 0
#endif
#ifndef FAST_WIN
#define FAST_WIN 0
#endif
#ifndef FAST_GATES
#define FAST_GATES 0
#endif
#ifndef FAST_WOUT
#define FAST_WOUT 0
#endif
#ifndef FP8_MOE
#define FP8_MOE 0
#endif
#ifndef GU_ALIGN
#define GU_ALIGN true
#endif
#ifndef DN_ALIGN
#define DN_ALIGN true
#endif
#ifndef FUSE_SCAN1
#define FUSE_SCAN1 1
#endif
#define ANY_FAST_GEMM (FAST_QKV || FAST_WO || FAST_GU || FAST_DN || FAST_WIN || FAST_GATES || FAST_WOUT)

namespace pg8 {
#define PG8_LAS __attribute__((address_space(3)))
typedef unsigned short bf16_t;
typedef short bf16x8 __attribute__((ext_vector_type(8)));
typedef float f32x4 __attribute__((ext_vector_type(4)));
typedef unsigned u32x4 __attribute__((ext_vector_type(4)));
constexpr int BM = 256, BK = 64, HALF = 128, HTB = HALF * BK * 2  , STAGE_BYTES = 8 * HTB, NXCD = 8, WGM = 8;

__host__ __device__ __forceinline__ int lds_byte(int r, int c) { const int st = (r >> 4) * 2 + (c >> 5), rr = r & 15, cc = c & 31, ob = rr * 64 + cc * 2; return st * 1024 + (ob ^ (((ob >> 9) & 1) << 5)); }
__host__ __device__ __forceinline__ void stage_rc(int b, int& R, int& C) { const int st = b / 1024, sb = b % 1024, swz = sb ^ (((sb >> 9) & 1) << 5); R = (st >> 1) * 16 + swz / 64; C = (st & 1) * 32 + (swz % 64) / 2; }
__host__ __device__ __forceinline__ int perm32(int rho) { const int n = rho >> 4, i = rho & 15; return 8 * (i >> 2) + 4 * n + (i & 3); }

struct Unit { int pm, pn; };
struct Gemm { const bf16_t* A; const bf16_t* Bt; int M, N, K; };
__device__ __forceinline__ unsigned cvt_pk_bf16(float lo, float hi) { unsigned r; asm volatile("v_cvt_pk_bf16_f32 %0, %1, %2" : "=v"(r) : "v"(lo), "v"(hi)); return r; }
typedef int v4i_t __attribute__((ext_vector_type(4)));
typedef int v8i_t __attribute__((ext_vector_type(8)));
__device__ __forceinline__ v8i_t cat8(bf16x8 lo, bf16x8 hi) { const v4i_t a = __builtin_bit_cast(v4i_t, lo), b = __builtin_bit_cast(v4i_t, hi); return __builtin_shufflevector(a, b, 0, 1, 2, 3, 4, 5, 6, 7); }
template <class Epi, class Sched, bool ALIGN_EPI = false, bool SP2 = false, int FP8SCALE = 0  >
__device__ __forceinline__ void gemm_phase(PG8_LAS unsigned char* lds, const Gemm g, const Sched& S, const Epi& E) {
    const int tid = threadIdx.x, wid = __builtin_amdgcn_readfirstlane(tid >> 6), lane = tid & 63, wr = wid >> 2, wc = wid & 3, fr = lane & 15, fq = lane >> 4;
    const int K = g.K, nt = K / BK;
    unsigned voffA[2], voffB[2];
#pragma unroll
    for (int i = 0; i < 2; ++i) { int R, C; stage_rc(tid * 16 + i * 8192, R, C); const int Rb = Epi::PERM ? ((R & ~31) + perm32(R & 31)) : R;
        voffA[i] = (unsigned)(R * K + C) * 2u; voffB[i] = (unsigned)(Rb * K + C) * 2u; }
    const size_t kstep = (size_t)(BK * 2);
    const size_t hstep = (size_t)HALF * K * 2;
    const size_t tstep = 2 * hstep;
    const unsigned ldsw = (unsigned)wid * 1024u;
    const int aoff = lds_byte(wr * 64 + fr, fq * 8), boff = lds_byte(wc * 32 + fr, fq * 8);
#define PG8_SA(b, h) (((b) * 2 + (h)) * HTB)
#define PG8_SB(b, h) ((4 + (b) * 2 + (h)) * HTB)
#ifndef PG8_B_AUX
#define PG8_B_AUX 0
#endif
#define PG8_STAGE(bufoff, gbase, voff) do { _Pragma("unroll") for (int _i = 0; _i < 2; ++_i) { \
        if constexpr (FP8SCALE != 0 && PG8_B_AUX != 0) { if ((bufoff) >= 4 * HTB) __builtin_amdgcn_global_load_lds((const unsigned*)((const char*)(gbase) + (voff)[_i]), (PG8_LAS unsigned*)(lds + (bufoff) + ldsw + _i * 8192), 16, 0, PG8_B_AUX); \
            else __builtin_amdgcn_global_load_lds((const unsigned*)((const char*)(gbase) + (voff)[_i]), (PG8_LAS unsigned*)(lds + (bufoff) + ldsw + _i * 8192), 16, 0, 0); } \
        else __builtin_amdgcn_global_load_lds((const unsigned*)((const char*)(gbase) + (voff)[_i]), (PG8_LAS unsigned*)(lds + (bufoff) + ldsw + _i * 8192), 16, 0, 0); } } while (0)
#define PG8_LDA(dst, b, h) do { if constexpr (FP8SCALE == 0) { _Pragma("unroll") for (int m = 0; m < 4; ++m) _Pragma("unroll") for (int k = 0; k < 2; ++k) dst[m][k] = *(const PG8_LAS bf16x8*)(lds + PG8_SA(b, h) + aoff + m * 2048 + k * 1024); } \
        else { _Pragma("unroll") for (int m = 0; m < 4; ++m) { const v4i_t lo_ = *(const PG8_LAS v4i_t*)(lds + PG8_SA(b, h) + aoff + m * 2048), hi_ = *(const PG8_LAS v4i_t*)(lds + PG8_SA(b, h) + aoff + m * 2048 + 1024); dst##8[m] = __builtin_shufflevector(lo_, hi_, 0, 1, 2, 3, 4, 5, 6, 7); } } } while (0)
#define PG8_LDB(dst, b, h) do { if constexpr (FP8SCALE == 0) { _Pragma("unroll") for (int n = 0; n < 2; ++n) _Pragma("unroll") for (int k = 0; k < 2; ++k) dst[n][k] = *(const PG8_LAS bf16x8*)(lds + PG8_SB(b, h) + boff + n * 2048 + k * 1024); } \
        else { _Pragma("unroll") for (int n = 0; n < 2; ++n) { const v4i_t lo_ = *(const PG8_LAS v4i_t*)(lds + PG8_SB(b, h) + boff + n * 2048), hi_ = *(const PG8_LAS v4i_t*)(lds + PG8_SB(b, h) + boff + n * 2048 + 1024); dst##8[n] = __builtin_shufflevector(lo_, hi_, 0, 1, 2, 3, 4, 5, 6, 7); } } } while (0)
#define PG8_MMA(ai, bj, At, Bt) do { __builtin_amdgcn_s_setprio(1); \
        if constexpr (FP8SCALE == 0) { _Pragma("unroll") for (int m = 0; m < 4; ++m) _Pragma("unroll") for (int n = 0; n < 2; ++n) _Pragma("unroll") for (int k = 0; k < 2; ++k) \
            acc[ai][bj][m][n] = __builtin_amdgcn_mfma_f32_16x16x32_bf16(Bt[n][k], At[m][k], acc[ai][bj][m][n], 0, 0, 0); } \
        else { _Pragma("unroll") for (int m = 0; m < 4; ++m) _Pragma("unroll") for (int n = 0; n < 2; ++n) \
            asm volatile("v_mfma_scale_f32_16x16x128_f8f6f4 %0, %1, %2, %0, %3, %4 op_sel_hi:[0,0,0]" : "+v"(acc[ai][bj][m][n]) : "v"(Bt##8[n]), "v"(At##8[m]), "v"(sclW), "v"(sclA)); } \
        __builtin_amdgcn_s_setprio(0); } while (0)
#define PG8_WAIT_V(n) asm volatile("s_waitcnt vmcnt(" #n ")" ::: "memory")
#define PG8_WAIT_L(n) asm volatile("s_waitcnt lgkmcnt(" #n ")" ::: "memory")
#define PG8_BAR __builtin_amdgcn_s_barrier()
#define PG8_SCHED __builtin_amdgcn_sched_barrier(0)
    Unit cur, nxt; int ui = 0;
    if (!S.next(0, cur)) return;
    f32x4 acc[2][2][4][2];
#pragma unroll
    for (int a = 0; a < 2; ++a)
#pragma unroll
        for (int b = 0; b < 2; ++b)
#pragma unroll
            for (int m = 0; m < 4; ++m)
#pragma unroll
                for (int n = 0; n < 2; ++n) acc[a][b][m][n] = (f32x4){0.f, 0.f, 0.f, 0.f};
    bf16x8 At[4][2], B0[2][2], B1[2][2]; v8i_t At8[4], B08[2], B18[2]; const int sclW = FP8SCALE * 0x01010101, sclA = 0x7f7f7f7f;
    const char* cA = (const char*)g.A + (size_t)cur.pm * tstep; const char* cB = (const char*)g.Bt + (size_t)cur.pn * tstep;
    S.a_ready(cur);
    if constexpr (SP2) {
        PG8_STAGE(PG8_SB(0, 0), cB, voffB); PG8_STAGE(PG8_SB(0, 1), cB + hstep, voffB); PG8_STAGE(PG8_SA(0, 0), cA, voffA); PG8_STAGE(PG8_SA(0, 1), cA + hstep, voffA);
        if (wr == 1) PG8_BAR;
        PG8_WAIT_V(2); PG8_BAR;
        PG8_STAGE(PG8_SB(1, 0), cB + kstep, voffB); PG8_STAGE(PG8_SA(1, 0), cA + kstep, voffA); PG8_STAGE(PG8_SB(1, 1), cB + hstep + kstep, voffB);
        PG8_WAIT_V(6); PG8_BAR;
    } else {
        PG8_STAGE(PG8_SB(0, 0), cB, voffB); PG8_STAGE(PG8_SA(0, 0), cA, voffA); PG8_STAGE(PG8_SB(0, 1), cB + hstep, voffB); PG8_STAGE(PG8_SA(0, 1), cA + hstep, voffA);
        if (wr == 1) PG8_BAR;
        PG8_WAIT_V(4); PG8_BAR;
        PG8_STAGE(PG8_SB(1, 0), cB + kstep, voffB); PG8_STAGE(PG8_SA(1, 0), cA + kstep, voffA); PG8_STAGE(PG8_SB(1, 1), cB + hstep + kstep, voffB);
        PG8_WAIT_V(6); PG8_BAR;
    }
    for (;;) {
        const bool has_next = S.next(ui + 1, nxt);
        const char* nA = has_next ? (const char*)g.A + (size_t)nxt.pm * tstep : cA; const char* nB = has_next ? (const char*)g.Bt + (size_t)nxt.pn * tstep : cB;
        for (int t = 0; t < nt; t += 2) {
            const bool last = (t == nt - 2);
            const char* a1 = cA + (size_t)(t + 1) * kstep;
            const char* a2 = last ? nA : cA + (size_t)(t + 2) * kstep; const char* b2 = last ? nB : cB + (size_t)(t + 2) * kstep;
            const char* a3 = a2 + kstep; const char* b3 = b2 + kstep;
            if (last && has_next) S.a_ready(nxt);
            if constexpr (SP2) {
            PG8_LDB(B0, 0, 0); PG8_LDB(B1, 0, 1); PG8_SCHED; PG8_LDA(At, 0, 0); PG8_STAGE(PG8_SA(1, 1), a1 + hstep, voffA);
            PG8_WAIT_V(8); PG8_WAIT_L(0); PG8_BAR; PG8_MMA(0, 0, At, B0); PG8_MMA(0, 1, At, B1); PG8_BAR; PG8_SCHED;
            PG8_LDA(At, 0, 1); PG8_STAGE(PG8_SB(0, 0), b2, voffB); PG8_STAGE(PG8_SB(0, 1), b2 + hstep, voffB); PG8_STAGE(PG8_SA(0, 0), a2, voffA);
            PG8_WAIT_V(8); PG8_WAIT_L(0); PG8_BAR; PG8_MMA(1, 0, At, B0); PG8_MMA(1, 1, At, B1); PG8_BAR; PG8_SCHED;
            PG8_LDB(B0, 1, 0); PG8_LDB(B1, 1, 1); PG8_SCHED; PG8_LDA(At, 1, 0); PG8_STAGE(PG8_SA(0, 1), a2 + hstep, voffA);
            PG8_WAIT_V(8); PG8_WAIT_L(0); PG8_BAR; PG8_MMA(0, 0, At, B0); PG8_MMA(0, 1, At, B1); PG8_BAR; PG8_SCHED;
            PG8_LDA(At, 1, 1); PG8_STAGE(PG8_SB(1, 0), b3, voffB); PG8_STAGE(PG8_SB(1, 1), b3 + hstep, voffB); PG8_STAGE(PG8_SA(1, 0), a3, voffA);
            PG8_WAIT_V(8); PG8_WAIT_L(0); PG8_BAR; PG8_MMA(1, 0, At, B0); PG8_MMA(1, 1, At, B1); PG8_BAR; PG8_SCHED;
            } else {
            PG8_LDB(B0, 0, 0); PG8_SCHED; PG8_LDA(At, 0, 0); PG8_STAGE(PG8_SA(1, 1), a1 + hstep, voffA);
            PG8_WAIT_L(8); PG8_BAR; PG8_WAIT_L(0); PG8_MMA(0, 0, At, B0); PG8_BAR; PG8_SCHED;
            PG8_LDB(B1, 0, 1); PG8_STAGE(PG8_SB(0, 0), b2, voffB);
            PG8_BAR; PG8_WAIT_L(0); PG8_MMA(0, 1, At, B1); PG8_BAR;
            PG8_LDA(At, 0, 1); PG8_STAGE(PG8_SA(0, 0), a2, voffA);
            PG8_BAR; PG8_WAIT_L(0); PG8_MMA(1, 0, At, B0); PG8_BAR; PG8_SCHED;
            PG8_STAGE(PG8_SB(0, 1), b2 + hstep, voffB);
            PG8_WAIT_V(6); PG8_BAR; PG8_MMA(1, 1, At, B1); PG8_BAR;
            PG8_LDB(B0, 1, 0); PG8_SCHED; PG8_LDA(At, 1, 0); PG8_STAGE(PG8_SA(0, 1), a2 + hstep, voffA);
            PG8_WAIT_L(8); PG8_BAR; PG8_WAIT_L(0); PG8_MMA(0, 0, At, B0); PG8_BAR; PG8_SCHED;
            PG8_LDB(B1, 1, 1); PG8_STAGE(PG8_SB(1, 0), b3, voffB);
            PG8_BAR; PG8_WAIT_L(0); PG8_MMA(0, 1, At, B1); PG8_BAR;
            PG8_LDA(At, 1, 1); PG8_STAGE(PG8_SA(1, 0), a3, voffA);
            PG8_BAR; PG8_WAIT_L(0); PG8_MMA(1, 0, At, B0); PG8_BAR; PG8_SCHED;
            PG8_STAGE(PG8_SB(1, 1), b3 + hstep, voffB);
            PG8_WAIT_V(6); PG8_BAR; PG8_MMA(1, 1, At, B1); PG8_BAR;
            }
        }
        if constexpr (ALIGN_EPI) { if (wr == 0) PG8_BAR; }
        if constexpr (FP8SCALE != 0) asm volatile("s_nop 15\n\ts_nop 15" ::: "memory");
        if constexpr (!Epi::AFTER_DRAIN) { E(acc, cur, wr, wc, fr, fq); S.done(cur); }
        if (!has_next) break;
#pragma unroll
        for (int a = 0; a < 2; ++a)
#pragma unroll
            for (int b = 0; b < 2; ++b)
#pragma unroll
                for (int m = 0; m < 4; ++m)
#pragma unroll
                    for (int n = 0; n < 2; ++n) acc[a][b][m][n] = (f32x4){0.f, 0.f, 0.f, 0.f};
        cur = nxt; cA = nA; cB = nB; ++ui;
        if constexpr (ALIGN_EPI) { if (wr == 1) PG8_BAR; }
    }
    PG8_WAIT_V(0);
    if constexpr (!ALIGN_EPI) { if (wr == 0) PG8_BAR; }
    PG8_BAR;
    if constexpr (Epi::AFTER_DRAIN) { E.fused(acc, cur, wr, wc, fr, fq, lds, wid, lane); S.done(cur); }
#undef PG8_SA
#undef PG8_SB
#undef PG8_STAGE
#undef PG8_LDA
#undef PG8_LDB
#undef PG8_MMA
#undef PG8_WAIT_V
#undef PG8_WAIT_L
#undef PG8_BAR
#undef PG8_SCHED
}
}

#define LAS __attribute__((address_space(3)))
typedef unsigned short bf16_t;
typedef float f32x4 __attribute__((ext_vector_type(4)));
typedef float f32x2 __attribute__((ext_vector_type(2)));
typedef unsigned u32x4 __attribute__((ext_vector_type(4)));
typedef unsigned u32x2 __attribute__((ext_vector_type(2)));
typedef short bf16x8 __attribute__((ext_vector_type(8)));

constexpr int NB = 8, SEQ = 2048, CTXL = 256, D = 1024;
constexpr int RL = NB * SEQ, RC = NB * CTXL, RT = RL + RC;
constexpr int NE = 16, DE = 2816, CAPL = 256, CAPC = 32;
constexpr int RPE0 = NB * CAPL + NB * CAPC, RPE1 = NB * CAPL;
constexpr int NWAVES = 8, NTHREADS = 512;
constexpr float EPS = 1e-6f;
constexpr float QSCALE = 0.125f * 1.4426950408889634f;
constexpr float LAMBDA_INIT0 = 0.2f;
constexpr int M_SH1 = 0, M_SC1 = 1024, M_G1 = 2048, M_SH2 = 3072, M_SC2 = 4096, M_G2 = 5120;
constexpr int SCH = 64, NCH = (CTXL + SEQ) / SCH, NCH_CTX = CTXL / SCH;

constexpr size_t MiB = 1u << 20;
constexpr size_t WS_CTL = 0, CTL_ZERO_BYTES = 32768;
constexpr size_t WS_GTAB = 2 * MiB + 65536;
constexpr size_t WS_MOD = 1 * MiB, WS_ROPE = 2 * MiB, WS_PROBS = 3 * MiB, WS_GATE = 5 * MiB, WS_SEL = 6 * MiB, WS_CP = 8 * MiB, WS_CB = 11 * MiB;
constexpr size_t WS_WQKV = 16 * MiB, WS_WO = 22 * MiB, WS_WIN = 24 * MiB, WS_WOUT = 28 * MiB, WS_WG = 30 * MiB;
constexpr size_t WS_XN = 32 * MiB, WS_Q = 68 * MiB, WS_K = 104 * MiB, WS_V = 140 * MiB, WS_ATT = 176 * MiB, WS_H = 212 * MiB;
constexpr size_t WS_XG = 284 * MiB, WS_Y = 356 * MiB, WS_ACT = 428 * MiB, WS_WGU = 626 * MiB, WS_WDN = 978 * MiB;
constexpr size_t WS_YG = 68 * MiB, WS_XR = 104 * MiB, WS_HS = 140 * MiB;
constexpr size_t WS_LOGA = 1154 * MiB, WS_BT = 1226 * MiB;
constexpr size_t WS_TMPF = 1298 * MiB, WS_XC = 2090 * MiB, WS_END = 2126 * MiB;
constexpr size_t WGU_LAYER = (size_t)NE * 2 * DE * D * 2, WDN_LAYER = (size_t)NE * D * DE * 2;
constexpr int CW_BAR = 4096;

constexpr int LDS_BYTES = 147456;
constexpr int MISC_OFF = 131072 + 320;

struct Args { const float* in[27]; float* out; unsigned char* ws; int ph_lo, ph_hi; };
constexpr int ROPE_LDS = 131072 + 1024;
constexpr int ARGS_OFF = 131072 + 512;
struct Ctx {
    const LAS unsigned* la;
    __device__ __forceinline__ unsigned long long ld(int i) const { const unsigned lo = __builtin_amdgcn_readfirstlane(la[2 * i]), hi = __builtin_amdgcn_readfirstlane(la[2 * i + 1]); return ((unsigned long long)hi << 32) | lo; }
    __device__ __forceinline__ const float* in(int i) const { return (const float*)(const __attribute__((address_space(1))) float*)ld(i); }
    __device__ __forceinline__ float* out() const { return (float*)(__attribute__((address_space(1))) float*)ld(27); }
    __device__ __forceinline__ unsigned char* ws() const { return (unsigned char*)(__attribute__((address_space(1))) unsigned char*)ld(28); }
};

enum { I_X = 0, I_C, I_CTX, I_CCTX, I_ADAW, I_ADAB, I_N1G, I_N2G, I_FG, I_WQKV, I_LQ1, I_LK1, I_LQ2, I_LK2, I_SUBG, I_WO, I_WIN, I_BIN, I_CONVW, I_CONVB, I_WGATES, I_BGATES, I_LAM, I_WOUT, I_WR, I_WGU, I_WDN };

__device__ __forceinline__ float bf_lo(unsigned w) { return __uint_as_float(w << 16); }
__device__ __forceinline__ float bf_hi(unsigned w) { return __uint_as_float(w & 0xffff0000u); }
__device__ __forceinline__ float bf2f(bf16_t b) { return __uint_as_float(((unsigned)b) << 16); }
__device__ __forceinline__ unsigned f2bf(float f) { unsigned u = __float_as_uint(f); return (u + 0x7fffu + ((u >> 16) & 1u)) >> 16; }
__device__ __forceinline__ unsigned pk2(float lo, float hi) { unsigned r; asm("v_cvt_pk_bf16_f32 %0, %1, %2" : "=v"(r) : "v"(lo), "v"(hi)); return r; }
#ifndef EPI_WT
#define EPI_WT 0
#endif
__device__ __forceinline__ void st16_wt(void* p, u32x4 v) {
#if EPI_WT
    asm volatile("global_store_dwordx4 %0, %1, off sc1" :: "v"(p), "v"(v) : "memory");
#else
    *(u32x4*)p = v;
#endif
}
__device__ __forceinline__ void st8_wt(void* p, u32x2 v) {
#if EPI_WT
    asm volatile("global_store_dwordx2 %0, %1, off sc1" :: "v"(p), "v"(v) : "memory");
#else
    *(u32x2*)p = v;
#endif
}
__device__ __forceinline__ float wave_sum(float v) {
#pragma unroll
    for (int o = 1; o < 64; o <<= 1) v += __shfl_xor(v, o);
    return v;
}
__device__ __forceinline__ float wave_max(float v) {
#pragma unroll
    for (int o = 1; o < 64; o <<= 1) v = fmaxf(v, __shfl_xor(v, o));
    return v;
}
__device__ __forceinline__ float sigmoidf_(float x) { return 1.f / (1.f + expf(-x)); }
__device__ __forceinline__ float gelu_tanh(float x) { const float u = 0.7978845608028654f * (x + 0.044715f * x * x * x); return x / (1.f + expf(-2.f * u)); }
__device__ __forceinline__ const float* mod_ptr(const Ctx& a, int layer, int r) { return (const float*)(a.ws() + WS_MOD) + (size_t)(layer * 9 + r) * 6144; }
__device__ __forceinline__ int mod_row(int row) { return row < RL ? (row >> 11) : 8; }

__device__ __forceinline__ void load_row(const float* p, int lane, f32x4 (&v)[4]) {
#pragma unroll
    for (int j = 0; j < 4; ++j) v[j] = *(const f32x4*)(p + 4 * lane + 256 * j);
}
__device__ __forceinline__ void load_row_bf16(const bf16_t* p, int lane, f32x4 (&v)[4]) {
#pragma unroll
    for (int j = 0; j < 4; ++j) { const u32x2 w = *(const u32x2*)(p + 4 * lane + 256 * j); v[j] = (f32x4){bf_lo(w.x), bf_hi(w.x), bf_lo(w.y), bf_hi(w.y)}; }
}
__device__ __forceinline__ void store_row_f32(float* p, int lane, const f32x4 (&v)[4]) {
#pragma unroll
    for (int j = 0; j < 4; ++j) *(f32x4*)(p + 4 * lane + 256 * j) = v[j];
}
__device__ __forceinline__ void store_row_bf16(bf16_t* p, int lane, const f32x4 (&v)[4]) {
#pragma unroll
    for (int j = 0; j < 4; ++j) { u32x2 w; w.x = pk2(v[j].x, v[j].y); w.y = pk2(v[j].z, v[j].w); *(u32x2*)(p + 4 * lane + 256 * j) = w; }
}
__device__ __forceinline__ void store_row_fp8(unsigned char* p, int lane, const f32x4 (&v)[4]) {
#pragma unroll
    for (int j = 0; j < 4; ++j) *(unsigned*)(p + 4 * lane + 256 * j) = __builtin_amdgcn_cvt_pk_fp8_f32(v[j].z, v[j].w, __builtin_amdgcn_cvt_pk_fp8_f32(v[j].x, v[j].y, 0u, false), true);
}
__device__ __forceinline__ void rms_mod(f32x4 (&v)[4], const float* g, const float* sh, const float* sc, int lane) {
    float ss = 0.f;
#pragma unroll
    for (int j = 0; j < 4; ++j) ss += (v[j].x * v[j].x + v[j].y * v[j].y) + (v[j].z * v[j].z + v[j].w * v[j].w);
    ss = wave_sum(ss);
    const float rstd = 1.0f / sqrtf(ss * (1.0f / D) + EPS);
#pragma unroll
    for (int j = 0; j < 4; ++j) {
        const int k = 4 * lane + 256 * j;
        const f32x4 gg = *(const f32x4*)(g + k);
        f32x4 y = v[j] * rstd * gg;
        if (sh) { const f32x4 s1 = *(const f32x4*)(sc + k), s0 = *(const f32x4*)(sh + k); y = y * (1.0f + s1) + s0; }
        v[j] = y;
    }
}

template <class F>
__device__ __forceinline__ void naive_tile(const bf16_t* A, int lda, const float* W, int ldw, int K, LAS unsigned char* lds, F f) {
    LAS float* As = (LAS float*)lds;
    LAS float* Bs = (LAS float*)(lds + 16 * 132 * 4);
    const int tid = threadIdx.x, ty = tid >> 4, tx = tid & 15;
    const int ar = tid >> 2, akq = tid & 3, bk = tid >> 5, bc = (tid & 31) * 2;
    float acc[4][4];
#pragma unroll
    for (int i = 0; i < 4; ++i)
#pragma unroll
        for (int j = 0; j < 4; ++j) acc[i][j] = 0.f;
    for (int k0 = 0; k0 < K; k0 += 16) {
        const u32x2 av = *(const u32x2*)(A + (size_t)ar * lda + k0 + akq * 4);
        const f32x2 bv = *(const f32x2*)(W + (size_t)(k0 + bk) * ldw + bc);
        __syncthreads();
        As[(akq * 4 + 0) * 132 + ar] = bf_lo(av.x); As[(akq * 4 + 1) * 132 + ar] = bf_hi(av.x);
        As[(akq * 4 + 2) * 132 + ar] = bf_lo(av.y); As[(akq * 4 + 3) * 132 + ar] = bf_hi(av.y);
        Bs[bk * 64 + bc] = bv.x; Bs[bk * 64 + bc + 1] = bv.y;
        __syncthreads();
#pragma unroll
        for (int kk = 0; kk < 16; ++kk) {
            const f32x4 a4 = *(const LAS f32x4*)(As + kk * 132 + ty * 4);
            const f32x4 b4 = *(const LAS f32x4*)(Bs + kk * 64 + tx * 4);
#pragma unroll
            for (int i = 0; i < 4; ++i)
#pragma unroll
                for (int j = 0; j < 4; ++j) acc[i][j] += a4[i] * b4[j];
        }
    }
#pragma unroll
    for (int i = 0; i < 4; ++i)
#pragma unroll
        for (int j = 0; j < 4; ++j) f(ty * 4 + i, tx * 4 + j, acc[i][j]);
    __syncthreads();
}

__device__ __forceinline__ void cvt_item(const float* W, int N, int k0, int n0, bf16_t* dst, int Kd, int gu_perm) {
    const int tid = threadIdx.x, lane = tid & 63, wave = tid >> 6;
    const float* p = W + (size_t)(k0 + 8 * wave) * N + n0 + 4 * lane;
    f32x4 v[8];
#pragma unroll
    for (int i = 0; i < 8; ++i) v[i] = *(const f32x4*)(p + (size_t)i * N);
#pragma unroll
    for (int j = 0; j < 4; ++j) {
        const int n = n0 + 4 * lane + j;
        const int row = gu_perm ? (((n % DE) >> 7) * 256 + (n / DE) * 128 + (n & 127)) : n;
        u32x4 o; o.x = pk2(v[0][j], v[1][j]); o.y = pk2(v[2][j], v[3][j]); o.z = pk2(v[4][j], v[5][j]); o.w = pk2(v[6][j], v[7][j]);
        *(u32x4*)(dst + (size_t)row * Kd + k0 + 8 * wave) = o;
    }
}
__device__ __forceinline__ unsigned pk4_fp8(float a, float b, float c, float d) { unsigned w = __builtin_amdgcn_cvt_pk_fp8_f32(a, b, 0u, false); return __builtin_amdgcn_cvt_pk_fp8_f32(c, d, w, true); }
constexpr float BT_SCALE = 64.0f, Y_SCALE = 16.0f;
constexpr float WGU_SCALE = 32.0f, WDN_SCALE = 64.0f;
__device__ __forceinline__ void cvt8_load(const float* W, int N, int k0, int n0, f32x4 (&v)[16]) {
    const int tid = threadIdx.x, lane = tid & 63, wave = tid >> 6;
    const float* p = W + (size_t)(k0 + 16 * wave) * N + n0 + 4 * lane;
#pragma unroll
    for (int i = 0; i < 16; ++i) v[i] = __builtin_nontemporal_load((const f32x4*)(p + (size_t)i * N));
}
__device__ __forceinline__ void cvt8_store(const f32x4 (&v)[16], int k0, int n0, unsigned char* dst, int Kd, int gu_perm, float scale, LAS unsigned char* T) {
    const int tid = threadIdx.x, lane = tid & 63, wave = tid >> 6;
#pragma unroll
    for (int j = 0; j < 4; ++j) {
        const int n = 4 * lane + j;
        u32x4 o;
        o.x = pk4_fp8(v[0][j] * scale, v[1][j] * scale, v[2][j] * scale, v[3][j] * scale); o.y = pk4_fp8(v[4][j] * scale, v[5][j] * scale, v[6][j] * scale, v[7][j] * scale);
        o.z = pk4_fp8(v[8][j] * scale, v[9][j] * scale, v[10][j] * scale, v[11][j] * scale); o.w = pk4_fp8(v[12][j] * scale, v[13][j] * scale, v[14][j] * scale, v[15][j] * scale);
        *(LAS u32x4*)(T + n * 128 + ((wave ^ (lane & 7)) << 4)) = o;
    }
    asm volatile("s_waitcnt lgkmcnt(0)" ::: "memory"); __builtin_amdgcn_s_barrier(); asm volatile("" ::: "memory");
#pragma unroll
    for (int i = 0; i < 4; ++i) {
        const int p = tid + NTHREADS * i, n = p >> 3, c = p & 7;
        const u32x4 x = *(const LAS u32x4*)(T + n * 128 + ((c ^ ((n >> 2) & 7)) << 4));
        const int ng = n0 + n;
        const int row = gu_perm ? (((ng % DE) >> 7) * 256 + (ng / DE) * 128 + (ng & 127)) : ng;
        __builtin_nontemporal_store(x, (u32x4*)(dst + (size_t)row * Kd + k0 + 16 * c));
    }
}
constexpr int CV_GU = NE * 8 * 22, CV_DN = NE * 22 * 4, CV_ITEMS = CV_GU + CV_DN;
struct CvItem { const float* W; unsigned char* dst; int N, Kd, k0, n0, perm; float scale; };
__device__ __forceinline__ CvItem cv_decode(const float* wgu, const float* wdn, unsigned char* ws, int layer, int it) {
    CvItem c;
    if (it < CV_GU) { const int e = it / 176, q = it % 176, le = layer * NE + e; c.W = wgu + (size_t)le * D * 2 * DE; c.dst = ws + WS_WGU + (size_t)le * 2 * DE * D; c.N = 2 * DE; c.Kd = D; c.k0 = (q / 22) * 128; c.n0 = (q % 22) * 256; c.perm = 1; c.scale = WGU_SCALE; }
    else { const int r = it - CV_GU, e = r / 88, q = r % 88, le = layer * NE + e; c.W = wdn + (size_t)le * DE * D; c.dst = ws + WS_WDN + (size_t)le * D * DE; c.N = D; c.Kd = DE; c.k0 = (q / 4) * 128; c.n0 = (q % 4) * 256; c.perm = 0; c.scale = WDN_SCALE; }
    return c;
}
__device__ __forceinline__ void cvt8_run(const Ctx& a, int layer, int first, int stride, int end, LAS unsigned char* lds) {
    const float* wgu = a.in(I_WGU); const float* wdn = a.in(I_WDN); unsigned char* ws = a.ws();
    f32x4 va[16], vb[16];
    int it = first;
    if (it < end) { const CvItem c = cv_decode(wgu, wdn, ws, layer, it); cvt8_load(c.W, c.N, c.k0, c.n0, va); }
    while (it < end) {
        int nx = it + stride;
        if (nx < end) { const CvItem c = cv_decode(wgu, wdn, ws, layer, nx); cvt8_load(c.W, c.N, c.k0, c.n0, vb); }
        { const CvItem c = cv_decode(wgu, wdn, ws, layer, it); cvt8_store(va, c.k0, c.n0, c.dst, c.Kd, c.perm, c.scale, lds); }
        it = nx; if (it >= end) break;
        nx = it + stride;
        if (nx < end) { const CvItem c = cv_decode(wgu, wdn, ws, layer, nx); cvt8_load(c.W, c.N, c.k0, c.n0, va); }
        { const CvItem c = cv_decode(wgu, wdn, ws, layer, it); cvt8_store(vb, c.k0, c.n0, c.dst, c.Kd, c.perm, c.scale, lds + 32768); }
        it = nx;
    }
    __syncthreads();
}
#ifndef CVT_HIDE
#define CVT_HIDE 1
#endif
#ifndef CVT_DEDICATED
#define CVT_DEDICATED 0
#endif
#ifndef CVQ_QKV
#define CVQ_QKV 1280
#endif
#ifndef CVQ_WO
#define CVQ_WO 896
#endif
#ifndef CVQ_GU0
#define CVQ_GU0 480
#endif
#ifndef CVQ_DN0
#define CVQ_DN0 960
#endif
#ifndef CVQ_WIN
#define CVQ_WIN 896
#endif
#ifndef CVQ_GATES
#define CVQ_GATES 1120
#endif
constexpr int CV0_QKV = 0, CV0_WO = CV0_QKV + CVQ_QKV, CV0_PRO = CVT_HIDE ? CV0_WO + CVQ_WO : 0;
constexpr int CV1_GU0 = 0, CV1_DN0 = CV1_GU0 + CVQ_GU0, CV1_WIN = CV1_DN0 + CVQ_DN0, CV1_GATES = CV1_WIN + CVQ_WIN, CV1_PRO = CVT_HIDE ? CV1_GATES + CVQ_GATES : 0;
static_assert(CV0_PRO <= CV_ITEMS && CV1_PRO <= CV_ITEMS, "conversion schedule");
__device__ __forceinline__ void cvt8_tail(const Ctx& a, LAS unsigned char* lds, int units, int G, int c, int layer, int base, int count) {
#if CVT_HIDE && FP8_MOE
    const int R = (units + G - 1) / G, first_idle = units - (R - 1) * G;
    if (first_idle >= G || count <= 0 || c < first_idle) return;
    cvt8_run(a, layer, base + (c - first_idle), G - first_idle, base + count, lds);
#endif
}
__device__ __forceinline__ int gemm_groups(int units, int G) {
#if CVT_HIDE && FP8_MOE && CVT_DEDICATED
    const int R = (units + G - 1) / G; int gp = ((units + R - 1) / R + 7) & ~7;
    return gp < G ? gp : G;
#else
    return G;
#endif
}
#ifndef DENSE_LATE
#define DENSE_LATE 1
#endif
constexpr int IT_DENSE_REST = 16 * 4 + 16 * 8 + 16 * 4 + 32;
__device__ __forceinline__ void cvt_dense_rest_item(const Ctx& a, int r) {
    constexpr int IT_WO = 16 * 4, IT_WIN = 16 * 8, IT_WOUT = 16 * 4;
    if (r < IT_WO) { cvt_item(a.in(I_WO), D, (r / 4) * 64, (r % 4) * 256, (bf16_t*)(a.ws() + WS_WO), D, 0); return; }
    r -= IT_WO;
    if (r < IT_WIN) { cvt_item(a.in(I_WIN), 2 * D, (r / 8) * 64, (r % 8) * 256, (bf16_t*)(a.ws() + WS_WIN), D, 0); return; }
    r -= IT_WIN;
    if (r < IT_WOUT) { cvt_item(a.in(I_WOUT), D, (r / 4) * 64, (r % 4) * 256, (bf16_t*)(a.ws() + WS_WOUT), D, 0); return; }
    r -= IT_WOUT;
    { const int m = r >> 1, kk = r & 1;
        cvt_item(a.in(I_WGATES) + (size_t)m * 128 * 256, 256, kk * 64, 0, (bf16_t*)(a.ws() + WS_WG) + (size_t)m * 256 * 128, 128, 0); }
}
__device__ __forceinline__ void ph_prologue(const Ctx& a, LAS unsigned char* lds) {
    const int tid = threadIdx.x, lane = tid & 63, wave = tid >> 6;
    if (blockIdx.x == gridDim.x - 1) {
        float* rope = (float*)(a.ws() + WS_ROPE);
        for (int i = tid; i < 1024; i += NTHREADS) { const int pos = i >> 4, f = i & 15; const float inv = powf(10000.0f, -(float)f / 16.0f); const float ang = (float)pos * inv; rope[i] = cosf(ang); rope[1024 + i] = sinf(ang); }
    }
    if (blockIdx.x == gridDim.x - 2 || gridDim.x == 1) {
        float* gt = (float*)(a.ws() + WS_GTAB); const float* lamp = a.in(I_LAM); const float* bgp = a.in(I_BGATES);
        for (int i = tid; i < 2 * D; i += NTHREADS) {
            const int d = i >> 10, ch = i & 1023, kb = ch >> 7, cc = ch & 127;
            const float cl = -8.0f * log1pf(expf(-lamp[i]));
            gt[(d * 4 + 0) * D + ch] = cl * 1.4426950408889634f; gt[(d * 4 + 1) * D + ch] = 2.0f * cl * 1.4426950408889634f;
            gt[(d * 4 + 2) * D + ch] = -1.4426950408889634f * bgp[(d * 8 + kb) * 256 + cc]; gt[(d * 4 + 3) * D + ch] = -1.4426950408889634f * bgp[(d * 8 + kb) * 256 + 128 + cc];
        }
    }
    for (int u = blockIdx.x; u < 192; u += gridDim.x) {
        LAS float* sl = (LAS float*)lds;
        LAS float* red = (LAS float*)(lds + 49152);
        const int layer = u / 96, n0 = (u % 96) * 64;
        for (int i = tid; i < 9 * 1024; i += NTHREADS) { const int r = i >> 10, k = i & 1023; const float v = r < 8 ? a.in(I_C)[r * 1024 + k] : a.in(I_CCTX)[k]; sl[k * 12 + r] = v / (1.f + expf(-v)); }
        __syncthreads();
        const float* W = a.in(I_ADAW) + (size_t)layer * 1024 * 6144 + n0 + lane;
        float acc[9];
#pragma unroll
        for (int r = 0; r < 9; ++r) acc[r] = 0.f;
#pragma unroll 32
        for (int k = wave * 128; k < wave * 128 + 128; ++k) {
            const float w = __builtin_nontemporal_load(W + (size_t)k * 6144);
            const f32x4 s0 = *(const LAS f32x4*)(sl + k * 12), s1 = *(const LAS f32x4*)(sl + k * 12 + 4); const float s8 = sl[k * 12 + 8];
            acc[0] += s0.x * w; acc[1] += s0.y * w; acc[2] += s0.z * w; acc[3] += s0.w * w;
            acc[4] += s1.x * w; acc[5] += s1.y * w; acc[6] += s1.z * w; acc[7] += s1.w * w; acc[8] += s8 * w;
        }
#pragma unroll
        for (int r = 0; r < 9; ++r) red[(wave * 9 + r) * 64 + lane] = acc[r];
        __syncthreads();
        float* MOD = (float*)(a.ws() + WS_MOD);
        for (int i = tid; i < 576; i += NTHREADS) {
            const int r = i >> 6, l = i & 63; float s = 0.f;
#pragma unroll
            for (int w = 0; w < 8; ++w) s += red[(w * 9 + r) * 64 + l];
            MOD[(size_t)(layer * 9 + r) * 6144 + n0 + l] = s + a.in(I_ADAB)[layer * 6144 + n0 + l];
        }
        __syncthreads();
    }
#if ANY_FAST_GEMM
    constexpr int IT_QKV = 16 * 12, IT_WO = 16 * 4, IT_WIN = 16 * 8, IT_WOUT = 16 * 4, IT_G = 32;
#if FP8_MOE
    cvt8_run(a, 0, CV0_PRO + (int)blockIdx.x, (int)gridDim.x, CV_ITEMS, lds);
    cvt8_run(a, 1, CV1_PRO + (int)blockIdx.x, (int)gridDim.x, CV_ITEMS, lds);
    constexpr int IT_GU = 0, IT_DN = 0;
#else
    constexpr int IT_GU1 = 16 * 22, IT_DN1 = 44 * 4;
    constexpr int IT_GU = 32 * IT_GU1, IT_DN = 32 * IT_DN1;
#endif
    constexpr int NITEMS = IT_GU + IT_DN + IT_QKV + ((DENSE_LATE && FAST_ATTN) ? 0 : IT_DENSE_REST);
    for (int it = blockIdx.x; it < NITEMS; it += gridDim.x) {
        int r = it;
#if !FP8_MOE
        if (r < IT_GU) { const int le = r / IT_GU1, q = r % IT_GU1;
            cvt_item(a.in(I_WGU) + (size_t)le * D * 2 * DE, 2 * DE, (q / 22) * 64, (q % 22) * 256, (bf16_t*)(a.ws() + WS_WGU) + (size_t)le * 2 * DE * D, D, 1); continue; }
        r -= IT_GU;
        if (r < IT_DN) { const int le = r / IT_DN1, q = r % IT_DN1;
            cvt_item(a.in(I_WDN) + (size_t)le * DE * D, D, (q / 4) * 64, (q % 4) * 256, (bf16_t*)(a.ws() + WS_WDN) + (size_t)le * D * DE, DE, 0); continue; }
#endif
        r -= IT_DN;
        if (r < IT_QKV) { cvt_item(a.in(I_WQKV), 3 * D, (r / 12) * 64, (r % 12) * 256, (bf16_t*)(a.ws() + WS_WQKV), D, 0); continue; }
        r -= IT_QKV;
#if !(DENSE_LATE && FAST_ATTN)
        cvt_dense_rest_item(a, r);
#endif
    }
#endif
}

__device__ __forceinline__ void ph_norm1_l0(const Ctx& a) {
    const int lane = threadIdx.x & 63, gw = blockIdx.x * NWAVES + (threadIdx.x >> 6), NGW = gridDim.x * NWAVES;
    unsigned char* ws = a.ws();
    bf16_t* XN = (bf16_t*)(ws + WS_XN); const float* X = a.in(I_X); const float* CX = a.in(I_CTX); const float* n1g = a.in(I_N1G);
    f32x4 v[4], nx[4];
    int row = gw;
    if (row < RT) load_row(row < RL ? X + (size_t)row * D : CX + (size_t)(row - RL) * D, lane, v);
    for (; row < RT; row += NGW) {
        const int rn = row + NGW;
        if (rn < RT) load_row(rn < RL ? X + (size_t)rn * D : CX + (size_t)(rn - RL) * D, lane, nx);
        const float* mp = (const float*)(ws + WS_MOD) + (size_t)mod_row(row) * 6144;
        rms_mod(v, n1g, mp + M_SH1, mp + M_SC1, lane);
        store_row_bf16(XN + (size_t)row * D, lane, v);
#pragma unroll
        for (int j = 0; j < 4; ++j) v[j] = nx[j];
    }
}
__device__ __forceinline__ float rs16(float (&s)[16], int lane) {
    float r8[8], r4[4], r2[2];
    const bool b5 = lane & 32, b4 = lane & 16, b3 = lane & 8, b2 = lane & 4;
#pragma unroll
    for (int i = 0; i < 8; ++i) { const float send = b5 ? s[i] : s[i + 8], keep = b5 ? s[i + 8] : s[i]; r8[i] = keep + __shfl_xor(send, 32); }
#pragma unroll
    for (int i = 0; i < 4; ++i) { const float send = b4 ? r8[i] : r8[i + 4], keep = b4 ? r8[i + 4] : r8[i]; r4[i] = keep + __shfl_xor(send, 16); }
#pragma unroll
    for (int i = 0; i < 2; ++i) { const float send = b3 ? r4[i] : r4[i + 2], keep = b3 ? r4[i + 2] : r4[i]; r2[i] = keep + __shfl_xor(send, 8); }
    float r = (b2 ? r2[1] : r2[0]) + __shfl_xor(b2 ? r2[0] : r2[1], 4);
    r += __shfl_xor(r, 2); r += __shfl_xor(r, 1);
    return r;
}
__device__ __forceinline__ void ph_norm2_router(const Ctx& a, LAS unsigned char* lds, int layer, int nrows) {
    const int tid = threadIdx.x, lane = tid & 63, gw = blockIdx.x * NWAVES + (tid >> 6), NGW = gridDim.x * NWAVES;
    LAS float* wrT = (LAS float*)lds;
    const float* wr = a.in(I_WR) + (size_t)layer * D * NE;
    for (int i = tid; i < D * NE; i += NTHREADS) wrT[(i & 15) * 1024 + (i >> 4)] = wr[i];
    __syncthreads();
    unsigned char* ws = a.ws();
    bf16_t* XN = (bf16_t*)(ws + WS_XN); const bf16_t* H = (const bf16_t*)(ws + WS_H);
    float* PL = (float*)(ws + WS_PROBS); float* PC = PL + NB * NE * SEQ;
    const float* n2g = a.in(I_N2G) + layer * D;
    const int elane = ((lane >> 5) & 1) * 8 + ((lane >> 4) & 1) * 4 + ((lane >> 3) & 1) * 2 + ((lane >> 2) & 1);
    f32x4 v0[4], v1[4], n0[4], n1[4];
    int p = gw;
    if (p < nrows / 2) { load_row_bf16(H + (size_t)(2 * p) * D, lane, v0); load_row_bf16(H + (size_t)(2 * p + 1) * D, lane, v1); }
    for (; p < nrows / 2; p += NGW) {
        const int pn = p + NGW;
        if (pn < nrows / 2) { load_row_bf16(H + (size_t)(2 * pn) * D, lane, n0); load_row_bf16(H + (size_t)(2 * pn + 1) * D, lane, n1); }
        const int row = 2 * p;
        const float* mp = (const float*)(ws + WS_MOD) + (size_t)(layer * 9 + mod_row(row)) * 6144;
        rms_mod(v0, n2g, mp + M_SH2, mp + M_SC2, lane); rms_mod(v1, n2g, mp + M_SH2, mp + M_SC2, lane);
#if FP8_MOE
        store_row_fp8((unsigned char*)XN + (size_t)row * D, lane, v0); store_row_fp8((unsigned char*)XN + (size_t)(row + 1) * D, lane, v1);
#else
        store_row_bf16(XN + (size_t)row * D, lane, v0); store_row_bf16(XN + (size_t)(row + 1) * D, lane, v1);
#endif
        float s0[16], s1[16];
#pragma unroll
        for (int e = 0; e < 16; ++e) {
            float a0 = 0.f, a1 = 0.f;
#pragma unroll
            for (int j = 0; j < 4; ++j) { const f32x4 w = *(const LAS f32x4*)(wrT + e * 1024 + 4 * lane + 256 * j);
                a0 += (v0[j].x * w.x + v0[j].y * w.y) + (v0[j].z * w.z + v0[j].w * w.w); a1 += (v1[j].x * w.x + v1[j].y * w.y) + (v1[j].z * w.z + v1[j].w * w.w); }
            s0[e] = a0; s1[e] = a1;
            if ((e & 3) == 3) asm volatile("" ::: "memory");
        }
        const float l0 = rs16(s0, lane), l1 = rs16(s1, lane);
        const float m0 = wave_max(l0), m1 = wave_max(l1);
        const float e0 = expf(l0 - m0), e1 = expf(l1 - m1);
        const float q0 = e0 / (wave_sum(e0) * 0.25f), q1 = e1 / (wave_sum(e1) * 0.25f);
        if ((lane & 3) == 0) {
            if (row < RL) { float* d = PL + ((size_t)(row >> 11) * NE + elane) * SEQ + (row & 2047); *(f32x2*)d = (f32x2){q0, q1}; }
            else { const int rc = row - RL; float* d = PC + ((size_t)(rc >> 8) * NE + elane) * CTXL + (rc & 255); *(f32x2*)d = (f32x2){q0, q1}; }
        }
#pragma unroll
        for (int j = 0; j < 4; ++j) { v0[j] = n0[j]; v1[j] = n1[j]; }
    }
    __syncthreads();
}
__device__ __forceinline__ void ph_topk_gather(const Ctx& a, LAS unsigned char* lds, int layer) {
    const int tid = threadIdx.x, lane = tid & 63, wave = tid >> 6;
    LAS int* idxl = (LAS int*)lds;
    LAS int* cnt = (LAS int*)(lds + 1024);
    unsigned char* ws = a.ws();
    const float* PL = (const float*)(ws + WS_PROBS); const float* PC = PL + NB * NE * SEQ;
    float* GATE = (float*)(ws + WS_GATE); int* SEL = (int*)(ws + WS_SEL);
    const bf16_t* XN = (const bf16_t*)(ws + WS_XN); bf16_t* XG = (bf16_t*)(ws + WS_XG);
    const int nunits = layer == 0 ? 256 : 128, rpe = layer == 0 ? RPE0 : RPE1;
    const unsigned long long lt = (1ull << lane) - 1ull;
    for (int u0 = blockIdx.x; u0 < nunits; u0 += gridDim.x) {
        const int u = layer == 0 ? ((u0 & 1) * 128 + (u0 >> 1)) : u0;
        const bool lat = u < 128; const int b = (u & 127) >> 4, e = u & 15;
        const int n = lat ? SEQ : CTXL, cap = lat ? CAPL : CAPC;
        const float* src = lat ? PL + ((size_t)b * NE + e) * SEQ : PC + ((size_t)b * NE + e) * CTXL;
        const int rowbase = lat ? b * SEQ : RL + b * CTXL;
        const int xgbase = e * rpe + (lat ? b * CAPL : NB * CAPL + b * CAPC);
        unsigned v[4];
#pragma unroll
        for (int i = 0; i < 4; ++i) { const int t = wave * 256 + i * 64 + lane; v[i] = t < n ? __float_as_uint(src[t]) : 0u; }
        unsigned prefix = 0u;
#pragma unroll 1
        for (int bit = 30; bit >= 0; --bit) {
            const unsigned cand = prefix | (1u << bit); int c = 0;
#pragma unroll
            for (int i = 0; i < 4; ++i) c += __popcll(__ballot(v[i] >= cand));
            LAS int* slot = cnt + (bit & 1) * 8;
            if (lane == 0) slot[wave] = c;
            __syncthreads();
            int tot = 0;
#pragma unroll
            for (int w = 0; w < 8; ++w) tot += slot[w];
            if (tot >= cap) prefix = cand;
        }
        int mg = 0, me = 0;
#pragma unroll
        for (int i = 0; i < 4; ++i) { mg += __popcll(__ballot(v[i] > prefix)); me += __popcll(__ballot(v[i] == prefix)); }
        if (lane == 0) { cnt[16 + wave] = mg; cnt[24 + wave] = me; }
        __syncthreads();
        int tg = 0, eqb = 0;
#pragma unroll
        for (int w = 0; w < 8; ++w) { tg += cnt[16 + w]; eqb += (w < wave) ? cnt[24 + w] : 0; }
        const int need = cap - tg;
        bool sel[4]; int ms = 0, eqseen = eqb;
#pragma unroll
        for (int i = 0; i < 4; ++i) {
            const bool gt = v[i] > prefix, eq = v[i] == prefix;
            const unsigned long long meq = __ballot(eq);
            sel[i] = gt || (eq && (eqseen + __popcll(meq & lt)) < need);
            ms += __popcll(__ballot(sel[i])); eqseen += __popcll(meq);
        }
        if (lane == 0) cnt[32 + wave] = ms;
        __syncthreads();
        int slotbase = 0;
#pragma unroll
        for (int w = 0; w < 8; ++w) slotbase += (w < wave) ? cnt[32 + w] : 0;
#pragma unroll
        for (int i = 0; i < 4; ++i) {
            const unsigned long long msel = __ballot(sel[i]);
            const int slot = slotbase + __popcll(msel & lt), t = wave * 256 + i * 64 + lane;
            if (t < n) SEL[(size_t)(rowbase + t) * NE + e] = sel[i] ? slot : -1;
            if (sel[i]) { idxl[slot] = t; GATE[xgbase + slot] = __uint_as_float(v[i]); }
            slotbase += __popcll(msel);
        }
        __syncthreads();
        for (int slot = wave; slot < cap; slot += NWAVES) {
            const int t = idxl[slot];
#if FP8_MOE
            ((u32x4*)((unsigned char*)XG + (size_t)(xgbase + slot) * D))[lane] = ((const u32x4*)((const unsigned char*)XN + (size_t)(rowbase + t) * D))[lane];
#else
            const u32x4* s = (const u32x4*)(XN + (size_t)(rowbase + t) * D);
            u32x4* d = (u32x4*)(XG + (size_t)(xgbase + slot) * D);
            d[lane] = s[lane]; d[lane + 64] = s[lane + 64];
#endif
        }
        __syncthreads();
    }
}
template <int MODE>
__device__ __forceinline__ void ph_combine(const Ctx& a, int layer, int nrows) {
    const int lane = threadIdx.x & 63, gw = blockIdx.x * NWAVES + (threadIdx.x >> 6), NGW = gridDim.x * NWAVES;
    bf16_t* H = (bf16_t*)(a.ws() + WS_H); const int* SEL = (const int*)(a.ws() + WS_SEL); const unsigned char* Y = a.ws() + WS_Y;
    const float* GATE = (const float*)(a.ws() + WS_GATE);
    bf16_t* XN = (bf16_t*)(a.ws() + WS_XN);
    const int rpe = layer == 0 ? RPE0 : RPE1;
    f32x4 v[4], vn[4]; int sel = -1, seln = -1;
    if (gw < nrows) { load_row_bf16(H + (size_t)gw * D, lane, v); sel = SEL[(size_t)gw * NE + (lane & 15)]; }
    for (int row = gw; row < nrows; row += NGW) {
        const int rnx = row + NGW;
        if (rnx < nrows) { load_row_bf16(H + (size_t)rnx * D, lane, vn); seln = SEL[(size_t)rnx * NE + (lane & 15)]; }
        const int mr = mod_row(row);
        const float* mp = mod_ptr(a, layer, mr);
        const int off = row < RL ? (row >> 11) * CAPL : NB * CAPL + ((row - RL) >> 8) * CAPC;
        f32x4 acc[4];
#pragma unroll
        for (int j = 0; j < 4; ++j) acc[j] = (f32x4){0.f, 0.f, 0.f, 0.f};
        unsigned mask = (unsigned)(__ballot(sel >= 0) & 0xffffull);
        int yw[4][4]; float gk[4];
#pragma unroll
        for (int k = 0; k < 4; ++k) {
            const bool on = mask != 0u; const int e = on ? __builtin_ctz(mask) : 0; mask = on ? (mask & (mask - 1u)) : 0u;
            const int sidx = __builtin_amdgcn_readlane(sel, e);
            const int yrow = on ? (e * rpe + off + sidx) : 0;
            const unsigned char* yr = Y + (size_t)yrow * D;
            gk[k] = on ? GATE[yrow] : 0.f;
#pragma unroll
            for (int j = 0; j < 4; ++j) { const int w = __builtin_nontemporal_load((const int*)(yr + 4 * lane + 256 * j)); yw[k][j] = on ? w : 0; }
        }
#pragma unroll
        for (int k = 0; k < 4; ++k)
#pragma unroll
            for (int j = 0; j < 4; ++j) { const f32x2 lo = __builtin_amdgcn_cvt_pk_f32_fp8(yw[k][j], false), hi2 = __builtin_amdgcn_cvt_pk_f32_fp8(yw[k][j], true);
                acc[j].x += gk[k] * lo.x; acc[j].y += gk[k] * lo.y; acc[j].z += gk[k] * hi2.x; acc[j].w += gk[k] * hi2.y; }
        while (mask != 0u) {
            const int e = __builtin_ctz(mask); mask &= mask - 1u;
            const int sidx = __builtin_amdgcn_readlane(sel, e);
            const int yrow = e * rpe + off + sidx; const float g1 = GATE[yrow];
            const unsigned char* yr = Y + (size_t)yrow * D;
#pragma unroll
            for (int j = 0; j < 4; ++j) { const int w = *(const int*)(yr + 4 * lane + 256 * j); const f32x2 lo = __builtin_amdgcn_cvt_pk_f32_fp8(w, false), hi2 = __builtin_amdgcn_cvt_pk_f32_fp8(w, true);
                acc[j].x += g1 * lo.x; acc[j].y += g1 * lo.y; acc[j].z += g1 * hi2.x; acc[j].w += g1 * hi2.y; }
        }
#pragma unroll
        for (int j = 0; j < 4; ++j) { const f32x4 g2 = *(const f32x4*)(mp + M_G2 + 4 * lane + 256 * j); v[j] = v[j] + g2 * (acc[j] * (1.0f / Y_SCALE)); }
        if (MODE == 0) {
            store_row_bf16(H + (size_t)row * D, lane, v);
            const float* mp1 = mod_ptr(a, 1, mr);
            rms_mod(v, a.in(I_N1G) + D, mp1 + M_SH1, mp1 + M_SC1, lane);
            store_row_bf16(XN + (size_t)row * D, lane, v);
        } else {
            rms_mod(v, a.in(I_FG), nullptr, nullptr, lane);
            { float* po = a.out() + (size_t)row * D;
#pragma unroll
              for (int j = 0; j < 4; ++j) __builtin_nontemporal_store(v[j], (f32x4*)(po + 4 * lane + 256 * j)); }
        }
#pragma unroll
        for (int j = 0; j < 4; ++j) v[j] = vn[j];
        sel = seln;
    }
}

__device__ __forceinline__ void ph_qkv_naive(const Ctx& a, LAS unsigned char* lds) {
    const bf16_t* XN = (const bf16_t*)(a.ws() + WS_XN); float* T = (float*)(a.ws() + WS_TMPF);
    for (int t = blockIdx.x; t < (RT / 128) * 48; t += gridDim.x) {
        const int tm = t / 48, tn = t % 48;
        naive_tile(XN + (size_t)tm * 128 * D, D, a.in(I_WQKV) + tn * 64, 3 * D, D, lds,
                   [&](int r, int c, float v) { T[(size_t)(tm * 128 + r) * 3072 + tn * 64 + c] = v; });
    }
}
__device__ __forceinline__ void ph_rope_naive(const Ctx& a) {
    const float* T = (const float*)(a.ws() + WS_TMPF); const float* rope = (const float*)(a.ws() + WS_ROPE);
    bf16_t* Q = (bf16_t*)(a.ws() + WS_Q); bf16_t* Kb = (bf16_t*)(a.ws() + WS_K); bf16_t* V = (bf16_t*)(a.ws() + WS_V);
    const size_t total = (size_t)RT * 3072, nth = (size_t)gridDim.x * NTHREADS;
    for (size_t i = (size_t)blockIdx.x * NTHREADS + threadIdx.x; i < total; i += nth) {
        const int row = (int)(i / 3072), c = (int)(i % 3072);
        if (c >= 2048) { V[(size_t)row * D + (c - 2048)] = (bf16_t)f2bf(T[i]); continue; }
        const int d = c & 63; if ((d & 31) >= 16) continue;
        float x1 = T[i], x2 = T[i + 16];
        if (row < RL) {
            const int t = row & 2047, axis = d >> 5, f = d & 15, pos = axis == 0 ? (t >> 6) : (t & 63);
            const float cs = rope[pos * 16 + f], sn = rope[1024 + pos * 16 + f];
            const float o1 = x1 * cs - x2 * sn, o2 = x2 * cs + x1 * sn; x1 = o1; x2 = o2;
        }
        if (c < 1024) { Q[(size_t)row * D + c] = (bf16_t)f2bf(x1 * QSCALE); Q[(size_t)row * D + c + 16] = (bf16_t)f2bf(x2 * QSCALE); }
        else { Kb[(size_t)row * D + c - 1024] = (bf16_t)f2bf(x1); Kb[(size_t)row * D + c - 1024 + 16] = (bf16_t)f2bf(x2); }
    }
}
template <int NIT>
__device__ __forceinline__ void naive_attn_item(const Ctx& a, int row, int h, float lam, LAS float* qs, int lane) {
    const bf16_t* Q = (const bf16_t*)(a.ws() + WS_Q); const bf16_t* Kb = (const bf16_t*)(a.ws() + WS_K); const bf16_t* V = (const bf16_t*)(a.ws() + WS_V);
    bf16_t* ATT = (bf16_t*)(a.ws() + WS_ATT);
    const int b = row < RL ? (row >> 11) : ((row - RL) >> 8);
    const int lat0 = b * SEQ, ctx0 = RL + b * CTXL;
    { const unsigned qq = *(const unsigned*)(Q + (size_t)row * D + h * 128 + 2 * lane); qs[2 * lane] = bf_lo(qq); qs[2 * lane + 1] = bf_hi(qq); }
    __builtin_amdgcn_fence(__ATOMIC_RELEASE, "wavefront"); __builtin_amdgcn_wave_barrier(); __builtin_amdgcn_fence(__ATOMIC_ACQUIRE, "wavefront");
#define NA_SCORE(it, d0, d1) do { const int kk_ = (it) * 64 + lane; \
        const int krow_ = (NIT == 36) ? (kk_ < SEQ ? lat0 + kk_ : ctx0 + kk_ - SEQ) : ctx0 + kk_; \
        const u32x4* kp_ = (const u32x4*)(Kb + (size_t)krow_ * D + h * 128); d0 = 0.f; d1 = 0.f; \
        _Pragma("unroll 4") for (int c = 0; c < 16; ++c) { const u32x4 kv = kp_[c]; \
            const f32x4 qa = *(const LAS f32x4*)(qs + 8 * c), qb = *(const LAS f32x4*)(qs + 8 * c + 4); \
            const float dd = (qa.x * bf_lo(kv.x) + qa.y * bf_hi(kv.x)) + (qa.z * bf_lo(kv.y) + qa.w * bf_hi(kv.y)) \
                           + (qb.x * bf_lo(kv.z) + qb.y * bf_hi(kv.z)) + (qb.z * bf_lo(kv.w) + qb.w * bf_hi(kv.w)); \
            if (c < 8) d0 += dd; else d1 += dd; } } while (0)
    float m0 = -3.0e38f, m1 = -3.0e38f, l0 = 0.f, l1 = 0.f;
#pragma unroll 1
    for (int it = 0; it < NIT; ++it) {
        float d0, d1; NA_SCORE(it, d0, d1);
        const float n0 = fmaxf(m0, d0), n1 = fmaxf(m1, d1);
        l0 = l0 * exp2f(m0 - n0) + exp2f(d0 - n0); l1 = l1 * exp2f(m1 - n1) + exp2f(d1 - n1); m0 = n0; m1 = n1;
    }
    { const float g0 = wave_max(m0), g1 = wave_max(m1); l0 = wave_sum(l0 * exp2f(m0 - g0)); l1 = wave_sum(l1 * exp2f(m1 - g1)); m0 = g0; m1 = g1; }
    const float i0 = 1.f / l0, i1 = lam / l1;
    float o0 = 0.f, o1 = 0.f;
#pragma unroll 1
    for (int it = 0; it < NIT; ++it) {
        float d0, d1; NA_SCORE(it, d0, d1);
        const int wbits = __float_as_int(exp2f(d0 - m0) * i0 - exp2f(d1 - m1) * i1);
#pragma unroll 4
        for (int src = 0; src < 64; ++src) {
            const float wv = __int_as_float(__builtin_amdgcn_readlane(wbits, src));
            const int kk = it * 64 + src;
            const int krow = (NIT == 36) ? (kk < SEQ ? lat0 + kk : ctx0 + kk - SEQ) : ctx0 + kk;
            const unsigned vv = *(const unsigned*)(V + (size_t)krow * D + h * 128 + 2 * lane);
            o0 += wv * bf_lo(vv); o1 += wv * bf_hi(vv);
        }
    }
#undef NA_SCORE
    const float ss = wave_sum(o0 * o0 + o1 * o1);
    const float rstd = 1.0f / sqrtf(ss * (1.0f / 128.0f) + EPS);
    const float g0 = a.in(I_SUBG)[2 * lane], g1 = a.in(I_SUBG)[2 * lane + 1];
    *(unsigned*)(ATT + (size_t)row * D + h * 128 + 2 * lane) = pk2(o0 * rstd * g0 * (1.0f - LAMBDA_INIT0), o1 * rstd * g1 * (1.0f - LAMBDA_INIT0));
}
__device__ __forceinline__ float diff_lambda(const Ctx& a, int lane) {
    const float s1 = wave_sum(a.in(I_LQ1)[lane] * a.in(I_LK1)[lane]), s2 = wave_sum(a.in(I_LQ2)[lane] * a.in(I_LK2)[lane]);
    return expf(s1) - expf(s2) + LAMBDA_INIT0;
}
__device__ __forceinline__ void ph_attn_naive(const Ctx& a, LAS unsigned char* lds) {
    const int lane = threadIdx.x & 63, wave = threadIdx.x >> 6, gw = blockIdx.x * NWAVES + wave, NGW = gridDim.x * NWAVES;
    LAS float* qs = (LAS float*)lds + wave * 128;
    const float lam = diff_lambda(a, lane);
    for (int item = gw; item < RT * 8; item += NGW) {
        const int h = item / RT, row = item % RT;
        if (row < RL) naive_attn_item<36>(a, row, h, lam, qs, lane); else naive_attn_item<4>(a, row, h, lam, qs, lane);
    }
}
__device__ __forceinline__ void ph_wo_naive(const Ctx& a, LAS unsigned char* lds) {
    const bf16_t* ATT = (const bf16_t*)(a.ws() + WS_ATT); bf16_t* H = (bf16_t*)(a.ws() + WS_H);
    for (int t = blockIdx.x; t < (RT / 128) * 16; t += gridDim.x) {
        const int tm = t / 16, tn = t % 16;
        naive_tile(ATT + (size_t)tm * 128 * D, D, a.in(I_WO) + tn * 64, D, D, lds, [&](int r, int c, float v) {
            const int row = tm * 128 + r, col = tn * 64 + c;
            const float base = row < RL ? a.in(I_X)[(size_t)row * D + col] : a.in(I_CTX)[(size_t)(row - RL) * D + col];
            H[(size_t)row * D + col] = (bf16_t)f2bf(base + mod_ptr(a, 0, mod_row(row))[M_G1 + col] * v); });
    }
}
__device__ __forceinline__ void ph_gu_naive(const Ctx& a, LAS unsigned char* lds, int layer) {
    const int rpe = layer == 0 ? RPE0 : RPE1, tpe = (rpe / 128) * 88;
    const bf16_t* XG = (const bf16_t*)(a.ws() + WS_XG); float* T = (float*)(a.ws() + WS_TMPF);
    for (int t = blockIdx.x; t < NE * tpe; t += gridDim.x) {
        const int e = t / tpe, q = t % tpe, tm = q / 88, tn = q % 88;
        const size_t row0 = (size_t)e * rpe + tm * 128;
        naive_tile(XG + row0 * D, D, a.in(I_WGU) + (size_t)(layer * NE + e) * D * 2 * DE + tn * 64, 2 * DE, D, lds,
                   [&](int r, int c, float v) { T[(row0 + r) * (2 * DE) + tn * 64 + c] = v; });
    }
}
__device__ __forceinline__ void ph_swiglu_naive(const Ctx& a, int layer) {
    const int rpe = layer == 0 ? RPE0 : RPE1;
    const float* T = (const float*)(a.ws() + WS_TMPF); bf16_t* ACT = (bf16_t*)(a.ws() + WS_ACT);
    const size_t total = (size_t)NE * rpe * DE, nth = (size_t)gridDim.x * NTHREADS;
    for (size_t i = (size_t)blockIdx.x * NTHREADS + threadIdx.x; i < total; i += nth) {
        const size_t row = i / DE; const int j = (int)(i % DE);
        const float g = T[row * (2 * DE) + j], u = T[row * (2 * DE) + DE + j];
        ACT[i] = (bf16_t)f2bf(g / (1.f + expf(-g)) * u);
    }
}
__device__ __forceinline__ void ph_dn_naive(const Ctx& a, LAS unsigned char* lds, int layer) {
    const int rpe = layer == 0 ? RPE0 : RPE1, tpe = (rpe / 128) * 16;
    const bf16_t* ACT = (const bf16_t*)(a.ws() + WS_ACT); unsigned char* Y = a.ws() + WS_Y; const float* GATE = (const float*)(a.ws() + WS_GATE);
    for (int t = blockIdx.x; t < NE * tpe; t += gridDim.x) {
        const int e = t / tpe, q = t % tpe, tm = q / 16, tn = q % 16;
        const size_t row0 = (size_t)e * rpe + tm * 128;
        naive_tile(ACT + row0 * DE, DE, a.in(I_WDN) + (size_t)(layer * NE + e) * DE * D + tn * 64, D, DE, lds,
                   [&](int r, int c, float v) { Y[(row0 + r) * D + tn * 64 + c] = (unsigned char)(pk4_fp8(v * Y_SCALE, 0.f, 0.f, 0.f) & 0xffu); });
    }
}
__device__ __forceinline__ void ph_win_naive(const Ctx& a, LAS unsigned char* lds) {
    const bf16_t* XN = (const bf16_t*)(a.ws() + WS_XN); bf16_t* YG = (bf16_t*)(a.ws() + WS_YG); bf16_t* XR = (bf16_t*)(a.ws() + WS_XR);
    const int TL = (RL / 128) * 32, TC = (RC / 128) * 16;
    for (int t = blockIdx.x; t < TL + TC; t += gridDim.x) {
        int tm, tn; if (t < TL) { tm = t / 32; tn = t % 32; } else { const int q = t - TL; tm = RL / 128 + q / 16; tn = 16 + q % 16; }
        naive_tile(XN + (size_t)tm * 128 * D, D, a.in(I_WIN) + tn * 64, 2 * D, D, lds, [&](int r, int c, float v) {
            const int row = tm * 128 + r, col = tn * 64 + c; const float x = v + a.in(I_BIN)[col];
            if (col < D) YG[(size_t)row * D + col] = (bf16_t)f2bf(gelu_tanh(x)); else XR[(size_t)row * D + col - D] = (bf16_t)f2bf(x); });
    }
}
__device__ __forceinline__ void ph_conv_naive(const Ctx& a) {
    const bf16_t* XR = (const bf16_t*)(a.ws() + WS_XR); bf16_t* XC = (bf16_t*)(a.ws() + WS_XC);
    const size_t total = (size_t)RT * D, nth = (size_t)gridDim.x * NTHREADS;
    for (size_t i = (size_t)blockIdx.x * NTHREADS + threadIdx.x; i < total; i += nth) {
        const int row = (int)(i >> 10), ch = (int)(i & 1023);
        const int t = row < RL ? (row & 2047) : ((row - RL) & 255), L = row < RL ? SEQ : CTXL;
        float v = a.in(I_CONVB)[ch];
#pragma unroll
        for (int j = 0; j < 4; ++j) { const int tt = t - 2 + j; if (tt >= 0 && tt < L) v += a.in(I_CONVW)[j * D + ch] * bf2f(XR[(size_t)(row - t + tt) * D + ch]); }
        XC[i] = (bf16_t)f2bf(v);
    }
}
__device__ __forceinline__ void ph_gates_naive(const Ctx& a, LAS unsigned char* lds) {
    const bf16_t* XC = (const bf16_t*)(a.ws() + WS_XC); float* T = (float*)(a.ws() + WS_TMPF);
    for (int t = blockIdx.x; t < 16 * (RT / 128) * 4; t += gridDim.x) {
        const int m = t / ((RT / 128) * 4), q = t % ((RT / 128) * 4), tm = q >> 2, tn = q & 3, d = m >> 3, kb = m & 7;
        naive_tile(XC + (size_t)tm * 128 * D + kb * 128, D, a.in(I_WGATES) + (size_t)m * 128 * 256 + tn * 64, 256, 128, lds,
                   [&](int r, int c, float v) { T[((size_t)d * RT + tm * 128 + r) * 2048 + kb * 256 + tn * 64 + c] = v; });
    }
}
__device__ __forceinline__ void ph_gate_elem_naive(const Ctx& a) {
    const float* T = (const float*)(a.ws() + WS_TMPF); const bf16_t* XC = (const bf16_t*)(a.ws() + WS_XC);
    bf16_t* LOGA = (bf16_t*)(a.ws() + WS_LOGA); unsigned char* BT = a.ws() + WS_BT;
    const size_t total = (size_t)2 * RT * D, nth = (size_t)gridDim.x * NTHREADS;
    for (size_t i = (size_t)blockIdx.x * NTHREADS + threadIdx.x; i < total; i += nth) {
        const int d = (int)(i / ((size_t)RT * D)); const size_t rc = i % ((size_t)RT * D); const int row = (int)(rc >> 10), ch = (int)(rc & 1023), kb = ch >> 7, cc = ch & 127;
        const float gr = T[((size_t)d * RT + row) * 2048 + kb * 256 + cc] + a.in(I_BGATES)[(d * 8 + kb) * 256 + cc];
        const float gi = T[((size_t)d * RT + row) * 2048 + kb * 256 + 128 + cc] + a.in(I_BGATES)[(d * 8 + kb) * 256 + 128 + cc];
        const float r = sigmoidf_(gr), ig = sigmoidf_(gi);
        const float lam = a.in(I_LAM)[d * D + ch];
        const float la = -8.0f * r * log1pf(expf(-lam));
        const float x = bf2f(XC[rc]);
        const float bt = sqrtf(-expm1f(2.0f * la)) * (ig * x);
        LOGA[i] = (bf16_t)f2bf(la * 1.4426950408889634f); BT[i] = (unsigned char)(pk4_fp8(bt * BT_SCALE, 0.f, 0.f, 0.f) & 0xffu);
    }
}
__device__ __forceinline__ void ph_wout_naive(const Ctx& a, LAS unsigned char* lds) {
    const bf16_t* HS = (const bf16_t*)(a.ws() + WS_HS); bf16_t* H = (bf16_t*)(a.ws() + WS_H);
    for (int t = blockIdx.x; t < (RL / 128) * 16; t += gridDim.x) {
        const int tm = t / 16, tn = t % 16;
        naive_tile(HS + (size_t)tm * 128 * D, D, a.in(I_WOUT) + tn * 64, D, D, lds, [&](int r, int c, float v) {
            const int row = tm * 128 + r, col = tn * 64 + c;
            H[(size_t)row * D + col] = (bf16_t)f2bf(bf2f(H[(size_t)row * D + col]) + mod_ptr(a, 1, row >> 11)[M_G1 + col] * v); });
    }
}

__device__ __forceinline__ int scan_row(int b, int dir, int c, int s) {
    const int p = c * SCH + s;
    if (dir == 0) return p < CTXL ? RL + b * CTXL + p : b * SEQ + (p - CTXL);
    return p < CTXL ? RL + b * CTXL + (CTXL - 1 - p) : b * SEQ + (SEQ - 1 - (p - CTXL));
}
__device__ __forceinline__ void ph_scan1(const Ctx& a) {
    const int lane = threadIdx.x & 63, gw = blockIdx.x * NWAVES + (threadIdx.x >> 6), NGW = gridDim.x * NWAVES;
    const bf16_t* LOGA = (const bf16_t*)(a.ws() + WS_LOGA); const unsigned char* BT = a.ws() + WS_BT;
    float* CP = (float*)(a.ws() + WS_CP); float* CB = (float*)(a.ws() + WS_CB);
    for (int item = gw; item < NB * 2 * NCH * 8; item += NGW) {
        const int cg = item & 7, c = (item >> 3) % NCH, bd = (item >> 3) / NCH, dir = bd & 1, b = bd >> 1;
        const int ch = cg * 128 + 2 * lane;
        float h0 = 0.f, h1 = 0.f, p0 = 0.f, p1 = 0.f;
#pragma unroll 1
        for (int sg = 0; sg < SCH; sg += 32) {
            unsigned la[32], bt[32];
#pragma unroll
            for (int i = 0; i < 32; ++i) { const size_t o = ((size_t)dir * RT + scan_row(b, dir, c, sg + i)) * D + ch; la[i] = *(const unsigned*)(LOGA + o); bt[i] = *(const unsigned short*)(BT + o); }
            asm volatile("" ::: "memory");
#pragma unroll
            for (int i = 0; i < 32; ++i) { const float l0 = bf_lo(la[i]), l1 = bf_hi(la[i]);
                const f32x2 bb = __builtin_amdgcn_cvt_pk_f32_fp8((int)bt[i], false);
                h0 = __builtin_amdgcn_exp2f(l0) * h0 + bb.x; h1 = __builtin_amdgcn_exp2f(l1) * h1 + bb.y; p0 += l0; p1 += l1; }
        }
        const size_t so = ((size_t)(b * 2 + dir) * NCH + c) * D + ch;
        *(f32x2*)(CP + so) = (f32x2){p0, p1}; *(f32x2*)(CB + so) = (f32x2){h0, h1};
    }
}
__device__ __forceinline__ void ph_scan2(const Ctx& a) {
    const int lane = threadIdx.x & 63, gw = blockIdx.x * NWAVES + (threadIdx.x >> 6), NGW = gridDim.x * NWAVES;
    const bf16_t* LOGA = (const bf16_t*)(a.ws() + WS_LOGA); const unsigned char* BT = a.ws() + WS_BT;
    const float* CP = (const float*)(a.ws() + WS_CP); const float* CB = (const float*)(a.ws() + WS_CB);
    const bf16_t* YG = (const bf16_t*)(a.ws() + WS_YG); bf16_t* HS = (bf16_t*)(a.ws() + WS_HS);
    constexpr int NLC = SEQ / SCH;
    for (int item = gw; item < NB * NLC * 8; item += NGW) {
        const int cg = item & 7, j = (item >> 3) % NLC, b = (item >> 3) / NLC;
        const int ch = cg * 128 + 2 * lane;
        const int cb = NCH_CTX + (NLC - 1 - j), cf = NCH_CTX + j;
        float hb0 = 0.f, hb1 = 0.f, hf0 = 0.f, hf1 = 0.f;
#pragma unroll 1
        for (int c0 = 0; c0 < NCH - 1; c0 += 12) {
            f32x2 pb[12], qb[12], pf[12], qf[12];
#pragma unroll
            for (int i = 0; i < 12; ++i) {
                const int c = c0 + i; const size_t sb_ = ((size_t)(b * 2 + 1) * NCH + c) * D + ch, sf_ = ((size_t)(b * 2 + 0) * NCH + c) * D + ch;
                const f32x2 z = (f32x2){0.f, 0.f};
                pb[i] = c < cb ? *(const f32x2*)(CP + sb_) : z; qb[i] = c < cb ? *(const f32x2*)(CB + sb_) : z;
                pf[i] = c < cf ? *(const f32x2*)(CP + sf_) : z; qf[i] = c < cf ? *(const f32x2*)(CB + sf_) : z;
            }
            asm volatile("" ::: "memory");
#pragma unroll
            for (int i = 0; i < 12; ++i) {
                hb0 = __builtin_amdgcn_exp2f(pb[i].x) * hb0 + qb[i].x; hb1 = __builtin_amdgcn_exp2f(pb[i].y) * hb1 + qb[i].y;
                hf0 = __builtin_amdgcn_exp2f(pf[i].x) * hf0 + qf[i].x; hf1 = __builtin_amdgcn_exp2f(pf[i].y) * hf1 + qf[i].y;
            }
        }
        float sb0[SCH], sb1[SCH];
#pragma unroll
        for (int sg = 0; sg < SCH; sg += 32) {
            unsigned la[32], bt[32];
#pragma unroll
            for (int i = 0; i < 32; ++i) { const size_t o = ((size_t)1 * RT + b * SEQ + j * SCH + (SCH - 1 - (sg + i))) * D + ch; la[i] = *(const unsigned*)(LOGA + o); bt[i] = *(const unsigned short*)(BT + o); }
            asm volatile("" ::: "memory");
#pragma unroll
            for (int i = 0; i < 32; ++i) {
                const f32x2 bb = __builtin_amdgcn_cvt_pk_f32_fp8((int)bt[i], false);
                hb0 = __builtin_amdgcn_exp2f(bf_lo(la[i])) * hb0 + bb.x; hb1 = __builtin_amdgcn_exp2f(bf_hi(la[i])) * hb1 + bb.y;
                sb0[SCH - 1 - (sg + i)] = hb0; sb1[SCH - 1 - (sg + i)] = hb1;
            }
        }
#pragma unroll
        for (int sg = 0; sg < SCH; sg += 16) {
            unsigned la[16], bt[16], yg[16];
#pragma unroll
            for (int i = 0; i < 16; ++i) { const size_t o = ((size_t)b * SEQ + j * SCH + sg + i) * D + ch; la[i] = __builtin_nontemporal_load((const unsigned*)(LOGA + o)); bt[i] = __builtin_nontemporal_load((const unsigned short*)(BT + o)); yg[i] = __builtin_nontemporal_load((const unsigned*)(YG + o)); }
            asm volatile("" ::: "memory");
#pragma unroll
            for (int i = 0; i < 16; ++i) {
                const size_t o = ((size_t)b * SEQ + j * SCH + sg + i) * D + ch;
                const f32x2 bb = __builtin_amdgcn_cvt_pk_f32_fp8((int)bt[i], false);
                hf0 = __builtin_amdgcn_exp2f(bf_lo(la[i])) * hf0 + bb.x; hf1 = __builtin_amdgcn_exp2f(bf_hi(la[i])) * hf1 + bb.y;
                *(unsigned*)(HS + o) = pk2(bf_lo(yg[i]) * ((hf0 + sb0[sg + i]) * (1.0f / BT_SCALE)), bf_hi(yg[i]) * ((hf1 + sb1[sg + i]) * (1.0f / BT_SCALE)));
            }
            asm volatile("" ::: "memory");
        }
    }
}
#define XB_TMO      128
#define XB_XCNT(j)  (256  + 64 * (j))
#define XB_XSUB(j)  (1280 + 64 * (j))
#define XB_XGEN(j)  (2304 + 64 * (j))
#define XB_TOP      3328
#define XB_TOPGEN   3392
#define XCD_BAR_WORDS 3456
#define XB_SPIN_CAP (1u << 18)

__device__ __forceinline__ unsigned xb_ld(unsigned* p)              { return __hip_atomic_load(p, __ATOMIC_RELAXED, __HIP_MEMORY_SCOPE_AGENT); }
__device__ __forceinline__ unsigned xb_add(unsigned* p, unsigned v) { return __hip_atomic_fetch_add(p, v, __ATOMIC_RELAXED, __HIP_MEMORY_SCOPE_AGENT); }
__device__ __forceinline__ unsigned xb_xcc_id() { return (unsigned)__builtin_amdgcn_s_getreg((3 << 11) | 20) & 0xFu; }
#define XB_SPIN(cond, bar) do { unsigned _sp = 0; while (cond) { __builtin_amdgcn_s_sleep(1); \
    if ((++_sp & 255u) == 0u) { if (xb_ld(&(bar)[XB_TMO])) break; if (_sp > XB_SPIN_CAP) { atomicAdd(&(bar)[XB_TMO], 1u); break; } } } } while (0)

struct XcdBarrier {
    unsigned* bar; unsigned x;
    volatile LAS unsigned* st;
};

__device__ __forceinline__ XcdBarrier xcd_barrier_post(unsigned* bar, volatile LAS unsigned* st) {
    XcdBarrier b; b.bar = bar; b.x = xb_xcc_id(); b.st = st;
    if (threadIdx.x == 0) (void)xb_add(&bar[XB_XCNT(b.x)], 1u);
    return b;
}
__device__ __forceinline__ void xcd_barrier_complete(unsigned* bar, unsigned x, unsigned& nloc, unsigned& nx) {
    const unsigned G = gridDim.x * gridDim.y * gridDim.z;
    unsigned sum, cnt, mine, sp = 0u;
    for (;;) {
        sum = 0u; cnt = 0u; mine = 0u;
#pragma unroll
        for (unsigned j = 0; j < 16; ++j) { const unsigned c = xb_ld(&bar[XB_XCNT(j)]); sum += c; cnt += (c > 0u) ? 1u : 0u; mine = (j == x) ? c : mine; }
        if (sum == G) break;
        __builtin_amdgcn_s_sleep(1);
        if ((++sp & 255u) == 0u) { if (xb_ld(&bar[XB_TMO])) break; if (sp > XB_SPIN_CAP) { atomicAdd(&bar[XB_TMO], 1u); break; } }
    }
    nloc = mine > 0u ? mine : 1u; nx = cnt > 0u ? cnt : 1u;
}

__device__ __forceinline__ void xcd_barrier(const XcdBarrier& b) {
    asm volatile("s_waitcnt vmcnt(0)" ::: "memory");
    __syncthreads();
    if (threadIdx.x == 0) {
        unsigned* bar = b.bar;
        __builtin_amdgcn_s_waitcnt(0);
        unsigned nloc = b.st[0], nx = b.st[1];
        if (nloc == 0u) { xcd_barrier_complete(bar, b.x, nloc, nx); b.st[0] = nloc; b.st[1] = nx; }
        const unsigned old = xb_add(&bar[XB_XSUB(b.x)], 1u);
        const unsigned gen = old / nloc;
        if (old + 1u == (gen + 1u) * nloc) {
            __builtin_amdgcn_fence(__ATOMIC_RELEASE, "agent");
            asm volatile("s_waitcnt vmcnt(0)" ::: "memory");
            const unsigned og = xb_add(&bar[XB_TOP], 1u);
            const unsigned tg = og / nx;
            if (og + 1u == (tg + 1u) * nx) xb_add(&bar[XB_TOPGEN], 1u);
            else XB_SPIN(xb_ld(&bar[XB_TOPGEN]) == tg, bar);
            __builtin_amdgcn_fence(__ATOMIC_ACQUIRE, "agent");
            xb_add(&bar[XB_XGEN(b.x)], 1u);
            asm volatile("s_waitcnt vmcnt(0)" ::: "memory");
        } else {
            XB_SPIN(xb_ld(&bar[XB_XGEN(b.x)]) == gen, bar);
            __builtin_amdgcn_fence(__ATOMIC_ACQUIRE, "agent");
            asm volatile("s_waitcnt vmcnt(0)" ::: "memory");
        }
    }
    __syncthreads();
}

__device__ __forceinline__ int xcd_remap(long L, int n) { const int q = n / 8, r = n % 8, xcd = (int)(L % 8), off = (int)(L / 8); return (xcd < r ? xcd * (q + 1) : r * (q + 1) + (xcd - r) * q) + off; }
template <class Map> struct ListOrder {
    int nunits, G, c; Map map;
    __device__ __forceinline__ bool next(int i, pg8::Unit& u) const { const long L = (long)i * G + c; if (L >= nunits) return false; map(xcd_remap(L, nunits), u); return true; }
    __device__ __forceinline__ void a_ready(const pg8::Unit&) const {}
    __device__ __forceinline__ void done(const pg8::Unit&) const {}
};
#ifndef WGMG
#define WGMG 8
#endif
struct MapGrid { int nN; __device__ __forceinline__ void operator()(int w, pg8::Unit& u) const { const int nig = WGMG * nN; u.pm = (w / nig) * WGMG + (w % nig) % WGMG; u.pn = (w % nig) / WGMG; } };
struct MapMoe { int PM, NT; __device__ __forceinline__ void operator()(int w, pg8::Unit& u) const { const int per = PM * NT, e = w / per, rem = w % per; u.pm = e * PM + rem % PM; u.pn = e * NT + rem / PM; } };
struct MapWin { __device__ __forceinline__ void operator()(int w, pg8::Unit& u) const { if (w < 512) { u.pm = (w / 64) * 8 + (w % 64) % 8; u.pn = (w % 64) / 8; } else { const int q = w - 512; u.pm = 64 + q % 8; u.pn = 4 + q / 8; } } };

typedef pg8::f32x4 pf4;
__device__ __forceinline__ float fast_exp(float x) { return __builtin_amdgcn_exp2f(x * 1.4426950408889634f); }

struct EpiQKV {
    static constexpr bool PERM = true, AFTER_DRAIN = false;
    bf16_t* Q; const LAS float* rope;
    __device__ __forceinline__ void operator()(const pf4 (&acc)[2][2][4][2], const pg8::Unit& u, int wr, int wc, int fr, int fq) const {
        const int sec = u.pn >> 2; bf16_t* base = Q + (size_t)sec * ((WS_K - WS_Q) / 2);
        const bool lat = u.pm < 64, dorope = sec < 2 && lat; const int axis = wc & 1;
        const bool upper = fq >= 2;
        const int row0 = u.pm * 256 + wr * 64 + fr, col0 = (u.pn & 3) * 256 + wc * 32 + 8 * fq;
        const float sc = sec == 0 ? QSCALE : 1.0f;
#pragma unroll
        for (int ai = 0; ai < 2; ++ai)
#pragma unroll
            for (int m = 0; m < 4; ++m) {
                const int row = row0 + ai * 128 + m * 16;
                pf4 cs[2], sn[2];
#pragma unroll
                for (int n = 0; n < 2; ++n) { cs[n] = (pf4){1.f, 1.f, 1.f, 1.f}; sn[n] = (pf4){0.f, 0.f, 0.f, 0.f}; }
                if (dorope) { const int t = row & 2047, pos = axis ? (t & 63) : (t >> 6); const LAS float* rp = rope + pos * 16 + 8 * (fq & 1);
#pragma unroll
                    for (int n = 0; n < 2; ++n) { cs[n] = *(const LAS pf4*)(rp + 4 * n); sn[n] = *(const LAS pf4*)(rp + 1024 + 4 * n); } }
#pragma unroll
                for (int bj = 0; bj < 2; ++bj) {
                    pf4 o[2];
#pragma unroll
                    for (int n = 0; n < 2; ++n)
#pragma unroll
                        for (int j = 0; j < 4; ++j) {
                            const float own = acc[ai][bj][m][n][j];
                            float v = own;
                            if (dorope) {
                                const auto rr = __builtin_amdgcn_permlane32_swap(__float_as_uint(own), __float_as_uint(own), false, false);
                                const float other = __uint_as_float(upper ? rr[0] : rr[1]);
                                v = upper ? (own * cs[n][j] + other * sn[n][j]) : (own * cs[n][j] - other * sn[n][j]);
                            }
                            o[n][j] = v * sc;
                        }
                    u32x4 w; w.x = pk2(o[0][0], o[0][1]); w.y = pk2(o[0][2], o[0][3]); w.z = pk2(o[1][0], o[1][1]); w.w = pk2(o[1][2], o[1][3]);
                    st16_wt(base + (size_t)row * D + col0 + bj * 128, w);
                }
            }
    }
};
struct EpiResid {
    static constexpr bool PERM = true, AFTER_DRAIN = false;
    bf16_t* H; const float* x; const float* ctx; const float* mod; int layer;
    __device__ __forceinline__ void operator()(const pf4 (&acc)[2][2][4][2], const pg8::Unit& u, int wr, int wc, int fr, int fq) const {
        const bool lat = u.pm < 64;
        const float* xb = lat ? x + (size_t)u.pm * 256 * D : ctx + (size_t)(u.pm - 64) * 256 * D;
        const float* g = mod + (size_t)(layer * 9 + (lat ? (u.pm >> 3) : 8)) * 6144 + M_G1;
        bf16_t* out = H + (size_t)u.pm * 256 * D;
        const int r0 = wr * 64 + fr, col0 = u.pn * 256 + wc * 32 + 8 * fq;
        pf4 gv[2][2];
#pragma unroll
        for (int bj = 0; bj < 2; ++bj)
#pragma unroll
            for (int n = 0; n < 2; ++n) gv[bj][n] = *(const pf4*)(g + col0 + bj * 128 + 4 * n);
#pragma unroll
        for (int it = 0; it < 8; ++it) {
            const int ai = it >> 2, m = it & 3;
            const size_t ro = (size_t)(r0 + ai * 128 + m * 16) * D + col0;
#pragma unroll
            for (int bj = 0; bj < 2; ++bj) {
                pf4 b0, b1;
                if (layer == 0) { b0 = *(const pf4*)(xb + ro + bj * 128); b1 = *(const pf4*)(xb + ro + bj * 128 + 4); }
                else { const u32x4 hb = *(const u32x4*)(out + ro + bj * 128); b0 = (pf4){bf_lo(hb.x), bf_hi(hb.x), bf_lo(hb.y), bf_hi(hb.y)}; b1 = (pf4){bf_lo(hb.z), bf_hi(hb.z), bf_lo(hb.w), bf_hi(hb.w)}; }
                const pf4 o0 = b0 + gv[bj][0] * acc[ai][bj][m][0], o1 = b1 + gv[bj][1] * acc[ai][bj][m][1];
                u32x4 w; w.x = pk2(o0[0], o0[1]); w.y = pk2(o0[2], o0[3]); w.z = pk2(o1[0], o1[1]); w.w = pk2(o1[2], o1[3]);
                st16_wt(out + ro + bj * 128, w);
            }
        }
    }
};
struct EpiSwiGLU {
    static constexpr bool PERM = true, AFTER_DRAIN = false;
    bf16_t* ACT;
    __device__ __forceinline__ void operator()(const pf4 (&acc)[2][2][4][2], const pg8::Unit& u, int wr, int wc, int fr, int fq) const {
        const int ct = u.pn % 22;
        bf16_t* p0 = ACT + (size_t)(u.pm * 256 + wr * 64 + fr) * DE + ct * 128 + wc * 32 + 8 * fq;
#pragma unroll
        for (int ai = 0; ai < 2; ++ai)
#pragma unroll
            for (int m = 0; m < 4; ++m) {
                float o[8];
#pragma unroll
                for (int n = 0; n < 2; ++n)
#pragma unroll
                    for (int j = 0; j < 4; ++j) { const float g = acc[ai][0][m][n][j], uu = acc[ai][1][m][n][j]; o[n * 4 + j] = g * __builtin_amdgcn_rcpf(1.0f + fast_exp(-g)) * uu; }
                u32x4 w; w.x = pk2(o[0], o[1]); w.y = pk2(o[2], o[3]); w.z = pk2(o[4], o[5]); w.w = pk2(o[6], o[7]);
                *(u32x4*)(p0 + (size_t)(ai * 128 + m * 16) * DE) = w;
            }
    }
};
struct EpiDown {
    static constexpr bool PERM = true, AFTER_DRAIN = false;
    unsigned char* Y;
    __device__ __forceinline__ void operator()(const pf4 (&acc)[2][2][4][2], const pg8::Unit& u, int wr, int wc, int fr, int fq) const {
        const int row0 = u.pm * 256 + wr * 64 + fr, col0 = (u.pn & 3) * 256 + wc * 32 + 8 * fq;
#pragma unroll
        for (int ai = 0; ai < 2; ++ai)
#pragma unroll
            for (int m = 0; m < 4; ++m) {
                const int row = row0 + ai * 128 + m * 16;
#pragma unroll
                for (int bj = 0; bj < 2; ++bj) {
                    const pf4 v0 = acc[ai][bj][m][0] * Y_SCALE, v1 = acc[ai][bj][m][1] * Y_SCALE;
                    u32x2 w; w.x = pk4_fp8(v0[0], v0[1], v0[2], v0[3]); w.y = pk4_fp8(v1[0], v1[1], v1[2], v1[3]);
                    st8_wt(Y + (size_t)row * D + col0 + bj * 128, w);
                }
            }
    }
};
struct EpiWin {
    static constexpr bool PERM = true, AFTER_DRAIN = false;
    bf16_t *YG, *XR; const LAS float* bin;
    __device__ __forceinline__ void operator()(const pf4 (&acc)[2][2][4][2], const pg8::Unit& u, int wr, int wc, int fr, int fq) const {
        const bool yb = u.pn < 4; bf16_t* base = yb ? YG : XR;
        const int row0 = u.pm * 256 + wr * 64 + fr, colg = u.pn * 256 + wc * 32 + 8 * fq, col0 = (u.pn & 3) * 256 + wc * 32 + 8 * fq;
        pf4 bv[2][2];
#pragma unroll
        for (int bj = 0; bj < 2; ++bj)
#pragma unroll
            for (int n = 0; n < 2; ++n) bv[bj][n] = *(const LAS pf4*)(bin + colg + bj * 128 + 4 * n);
#pragma unroll
        for (int ai = 0; ai < 2; ++ai)
#pragma unroll
            for (int m = 0; m < 4; ++m) {
                const int row = row0 + ai * 128 + m * 16;
#pragma unroll
                for (int bj = 0; bj < 2; ++bj) {
                    pf4 v0 = acc[ai][bj][m][0] + bv[bj][0], v1 = acc[ai][bj][m][1] + bv[bj][1];
                    if (yb) {
#pragma unroll
                        for (int j = 0; j < 4; ++j) {
                            { const float x = v0[j], uu = 0.7978845608028654f * (x + 0.044715f * x * x * x); v0[j] = x * __builtin_amdgcn_rcpf(1.0f + fast_exp(-2.0f * uu)); }
                            { const float x = v1[j], uu = 0.7978845608028654f * (x + 0.044715f * x * x * x); v1[j] = x * __builtin_amdgcn_rcpf(1.0f + fast_exp(-2.0f * uu)); }
                        }
                    }
                    u32x4 w; w.x = pk2(v0[0], v0[1]); w.y = pk2(v0[2], v0[3]); w.z = pk2(v1[0], v1[1]); w.w = pk2(v1[2], v1[3]);
                    st16_wt(base + (size_t)row * D + col0 + bj * 128, w);
                }
            }
    }
};

#ifndef DENSE_ALIGN
#define DENSE_ALIGN true
#endif
#ifndef DENSE_SP2
#define DENSE_SP2 true
#endif
__device__ __forceinline__ void stagger_start(int ticks) {
    if (ticks > 0 && ((blockIdx.x >> 3) & 1)) { const unsigned long long t0 = __builtin_amdgcn_s_memrealtime(); while (__builtin_amdgcn_s_memrealtime() - t0 < (unsigned long long)ticks) __builtin_amdgcn_s_sleep(8); }
}
#ifndef STG_QKV
#define STG_QKV 0
#endif
#ifndef STG_GU
#define STG_GU 0
#endif
#ifndef STG_DN
#define STG_DN 0
#endif
#ifndef STG_WIN
#define STG_WIN 0
#endif
#ifndef STG_WO
#define STG_WO 0
#endif
#define PG8_RUN(EPI, SCHED, g, S, E) pg8::gemm_phase<EPI, SCHED, DENSE_ALIGN, DENSE_SP2>((PG8_LAS unsigned char*)lds, g, S, E)

__device__ __forceinline__ void ph_qkv_fast(const Ctx& a, LAS unsigned char* lds) {
    unsigned char* ws = a.ws();
    pg8::Gemm g{(const bf16_t*)(ws + WS_XN), (const bf16_t*)(ws + WS_WQKV), RT, 3 * D, D};
    const int Gq = gemm_groups(72 * 12, (int)gridDim.x);
    if ((int)blockIdx.x >= Gq) { cvt8_run(a, 0, CV0_QKV + ((int)blockIdx.x - Gq), (int)gridDim.x - Gq, CV0_QKV + CVQ_QKV, lds); return; }
    ListOrder<MapGrid> S{72 * 12, Gq, (int)blockIdx.x, MapGrid{12}};
    static_assert(WS_V - WS_K == WS_K - WS_Q, "Q|K|V spacing");
    LAS float* rl = (LAS float*)(lds + ROPE_LDS);
    { const float* rg = (const float*)(ws + WS_ROPE); for (int i = threadIdx.x; i < 2048; i += NTHREADS) rl[i] = rg[i]; }
    __syncthreads();
    EpiQKV E{(bf16_t*)(ws + WS_Q), rl};
    stagger_start(STG_QKV);
    PG8_RUN(EpiQKV, ListOrder<MapGrid>, g, S, E);
    if (Gq == (int)gridDim.x) cvt8_tail(a, lds, 72 * 12, Gq, (int)blockIdx.x, 0, CV0_QKV, CVQ_QKV);
}
__device__ __forceinline__ void ph_wo_fast(const Ctx& a, LAS unsigned char* lds) {
    unsigned char* ws = a.ws();
    pg8::Gemm g{(const bf16_t*)(ws + WS_ATT), (const bf16_t*)(ws + WS_WO), RT, D, D};
    const int Gq = gemm_groups(72 * 4, (int)gridDim.x);
    if ((int)blockIdx.x >= Gq) { cvt8_run(a, 0, CV0_WO + ((int)blockIdx.x - Gq), (int)gridDim.x - Gq, CV0_WO + CVQ_WO, lds); return; }
    ListOrder<MapGrid> S{72 * 4, Gq, (int)blockIdx.x, MapGrid{4}};
    EpiResid E{(bf16_t*)(ws + WS_H), a.in(I_X), a.in(I_CTX), (const float*)(ws + WS_MOD), 0};
    stagger_start(STG_WO);
    PG8_RUN(EpiResid, ListOrder<MapGrid>, g, S, E);
    if (Gq == (int)gridDim.x) cvt8_tail(a, lds, 72 * 4, Gq, (int)blockIdx.x, 0, CV0_WO, CVQ_WO);
}
__device__ __forceinline__ void ph_wout_fast(const Ctx& a, LAS unsigned char* lds) {
    unsigned char* ws = a.ws();
    pg8::Gemm g{(const bf16_t*)(ws + WS_HS), (const bf16_t*)(ws + WS_WOUT), RL, D, D};
    ListOrder<MapGrid> S{64 * 4, (int)gridDim.x, (int)blockIdx.x, MapGrid{4}};
    EpiResid E{(bf16_t*)(ws + WS_H), nullptr, nullptr, (const float*)(ws + WS_MOD), 1};
    PG8_RUN(EpiResid, ListOrder<MapGrid>, g, S, E);
}
#if FP8_MOE
struct EpiSwiGLU8 {
    static constexpr bool PERM = true, AFTER_DRAIN = false;
    unsigned char* ACT;
    __device__ __forceinline__ void operator()(const pf4 (&acc)[2][2][4][2], const pg8::Unit& u, int wr, int wc, int fr, int fq) const {
        const int ct = u.pn % 22;
        unsigned char* p0 = ACT + (size_t)(u.pm * 256 + wr * 64 + fr) * DE + ct * 128 + wc * 32 + 8 * fq;
#pragma unroll
        for (int ai = 0; ai < 2; ++ai)
#pragma unroll
            for (int m = 0; m < 4; ++m) {
                float o[8];
#pragma unroll
                for (int n = 0; n < 2; ++n)
#pragma unroll
                    for (int j = 0; j < 4; ++j) { const float g = acc[ai][0][m][n][j], uu = acc[ai][1][m][n][j]; o[n * 4 + j] = g * __builtin_amdgcn_rcpf(1.0f + fast_exp(-g)) * uu; }
                u32x2 w; w.x = pk4_fp8(o[0], o[1], o[2], o[3]); w.y = pk4_fp8(o[4], o[5], o[6], o[7]);
                st8_wt(p0 + (size_t)(ai * 128 + m * 16) * DE, w);
            }
    }
};
__device__ __forceinline__ void ph_gu_fast(const Ctx& a, LAS unsigned char* lds, int layer) {
    unsigned char* ws = a.ws(); const int PM = (layer == 0 ? RPE0 : RPE1) / 256;
    pg8::Gemm g{(const bf16_t*)(ws + WS_XG), (const bf16_t*)(ws + WS_WGU + (size_t)layer * (WGU_LAYER / 2)), NE * PM * 256, NE * 2 * DE, D / 2};
    ListOrder<MapMoe> S{NE * PM * 22, (int)gridDim.x, (int)blockIdx.x, MapMoe{PM, 22}};
    EpiSwiGLU8 E{ws + WS_ACT};
    stagger_start(STG_GU);
    pg8::gemm_phase<EpiSwiGLU8, ListOrder<MapMoe>, GU_ALIGN, true, 122>((PG8_LAS unsigned char*)lds, g, S, E);
    if (layer == 0) cvt8_tail(a, lds, NE * PM * 22, (int)gridDim.x, (int)blockIdx.x, 1, CV1_GU0, CVQ_GU0);
}
__device__ __forceinline__ void ph_dn_fast(const Ctx& a, LAS unsigned char* lds, int layer) {
    unsigned char* ws = a.ws(); const int PM = (layer == 0 ? RPE0 : RPE1) / 256;
    pg8::Gemm g{(const bf16_t*)(ws + WS_ACT), (const bf16_t*)(ws + WS_WDN + (size_t)layer * (WDN_LAYER / 2)), NE * PM * 256, NE * D, DE / 2};
    const int Gq = layer == 0 ? gemm_groups(NE * PM * 4, (int)gridDim.x) : (int)gridDim.x;
    if ((int)blockIdx.x >= Gq) { cvt8_run(a, 1, CV1_DN0 + ((int)blockIdx.x - Gq), (int)gridDim.x - Gq, CV1_DN0 + CVQ_DN0, lds); return; }
    ListOrder<MapMoe> S{NE * PM * 4, Gq, (int)blockIdx.x, MapMoe{PM, 4}};
    EpiDown E{ws + WS_Y};
    stagger_start(STG_DN);
    pg8::gemm_phase<EpiDown, ListOrder<MapMoe>, DN_ALIGN, true, 121>((PG8_LAS unsigned char*)lds, g, S, E);
    if (layer == 0 && Gq == (int)gridDim.x) cvt8_tail(a, lds, NE * PM * 4, Gq, (int)blockIdx.x, 1, CV1_DN0, CVQ_DN0);
}
#else
__device__ __forceinline__ void ph_gu_fast(const Ctx& a, LAS unsigned char* lds, int layer) {
    unsigned char* ws = a.ws(); const int PM = (layer == 0 ? RPE0 : RPE1) / 256;
    pg8::Gemm g{(const bf16_t*)(ws + WS_XG), (const bf16_t*)(ws + WS_WGU + (size_t)layer * WGU_LAYER), NE * PM * 256, NE * 2 * DE, D};
    ListOrder<MapMoe> S{NE * PM * 22, (int)gridDim.x, (int)blockIdx.x, MapMoe{PM, 22}};
    EpiSwiGLU E{(bf16_t*)(ws + WS_ACT)};
    PG8_RUN(EpiSwiGLU, ListOrder<MapMoe>, g, S, E);
}
__device__ __forceinline__ void ph_dn_fast(const Ctx& a, LAS unsigned char* lds, int layer) {
    unsigned char* ws = a.ws(); const int PM = (layer == 0 ? RPE0 : RPE1) / 256;
    pg8::Gemm g{(const bf16_t*)(ws + WS_ACT), (const bf16_t*)(ws + WS_WDN + (size_t)layer * WDN_LAYER), NE * PM * 256, NE * D, DE};
    const int Gq = layer == 0 ? gemm_groups(NE * PM * 4, (int)gridDim.x) : (int)gridDim.x;
    if ((int)blockIdx.x >= Gq) { cvt8_run(a, 1, CV1_DN0 + ((int)blockIdx.x - Gq), (int)gridDim.x - Gq, CV1_DN0 + CVQ_DN0, lds); return; }
    ListOrder<MapMoe> S{NE * PM * 4, Gq, (int)blockIdx.x, MapMoe{PM, 4}};
    EpiDown E{ws + WS_Y};
    PG8_RUN(EpiDown, ListOrder<MapMoe>, g, S, E);
}
#endif
__device__ __forceinline__ void ph_win_fast(const Ctx& a, LAS unsigned char* lds) {
    unsigned char* ws = a.ws();
    pg8::Gemm g{(const bf16_t*)(ws + WS_XN), (const bf16_t*)(ws + WS_WIN), RT, 2 * D, D};
    const int Gq = gemm_groups(512 + 32, (int)gridDim.x);
    if ((int)blockIdx.x >= Gq) { cvt8_run(a, 1, CV1_WIN + ((int)blockIdx.x - Gq), (int)gridDim.x - Gq, CV1_WIN + CVQ_WIN, lds); return; }
    ListOrder<MapWin> S{512 + 32, Gq, (int)blockIdx.x, MapWin{}};
    LAS float* bl = (LAS float*)(lds + ROPE_LDS);
    { const float* bg = a.in(I_BIN); for (int i = threadIdx.x; i < 2 * D; i += NTHREADS) bl[i] = bg[i]; }
    __syncthreads();
    EpiWin E{(bf16_t*)(ws + WS_YG), (bf16_t*)(ws + WS_XR), bl};
    stagger_start(STG_WIN);
    PG8_RUN(EpiWin, ListOrder<MapWin>, g, S, E);
    if (Gq == (int)gridDim.x) cvt8_tail(a, lds, 512 + 32, Gq, (int)blockIdx.x, 1, CV1_WIN, CVQ_WIN);
}

namespace fa {
using bf16x8 = __attribute__((ext_vector_type(8))) short;
using s16x4  = __attribute__((ext_vector_type(4))) short;
using f32x16 = __attribute__((ext_vector_type(16))) float;
using u32x4v = __attribute__((ext_vector_type(4))) unsigned;
constexpr int SHM_V = 64 * 128 * 2, SHM_K = 64 * 128 * 2;
#ifndef ATT_THR
#define ATT_THR 11.5f
#endif
constexpr float THR_L2 = ATT_THR;
#define KSWZ(row, colB) ((row) * 256 + ((colB) ^ (((row) & 7) << 4)))
#define SBAR() __builtin_amdgcn_sched_barrier(0)
__device__ __forceinline__ int crow(int r, int hi) { return (r & 3) + 8 * (r >> 2) + 4 * hi; }
__device__ __forceinline__ unsigned cvtpk(float lo, float hi) { unsigned r; asm volatile("v_cvt_pk_bf16_f32 %0, %1, %2" : "=v"(r) : "v"(lo), "v"(hi)); return r; }
__device__ __forceinline__ void partialSM(f32x16& p0, f32x16& p1, float& m_reg, float& mn, float& alpha) {
  float pmax = p0[0];
#pragma unroll
  for (int r = 1; r < 16; ++r) pmax = fmaxf(pmax, p0[r]);
#pragma unroll
  for (int r = 0; r < 16; ++r) pmax = fmaxf(pmax, p1[r]);
  { auto rr = __builtin_amdgcn_permlane32_swap(__float_as_uint(pmax), __float_as_uint(pmax), false, false);
    pmax = fmaxf(__uint_as_float(rr[0]), __uint_as_float(rr[1])); }
  if (__builtin_expect(__all(pmax - m_reg <= THR_L2), 1)) { mn = m_reg; alpha = 1.f; }
  else { mn = fmaxf(m_reg, pmax); alpha = __builtin_amdgcn_exp2f(m_reg - mn); m_reg = mn; }
  { typedef float f2_t __attribute__((ext_vector_type(2))); const f2_t mn2 = {mn, mn};
#pragma unroll
    for (int r = 0; r < 16; r += 2) { const f2_t a_ = (f2_t){p0[r], p0[r + 1]} - mn2; p0[r] = a_.x; p0[r + 1] = a_.y; const f2_t b_ = (f2_t){p1[r], p1[r + 1]} - mn2; p1[r] = b_.x; p1[r + 1] = b_.y; } }
#pragma unroll
  for (int r = 0; r < 16; ++r) p0[r] = __builtin_amdgcn_exp2f(p0[r]);
}
__device__ __forceinline__ void finishSM(f32x16& p0, f32x16& p1, float alpha, float& l_reg, bf16x8& pa0, bf16x8& pa1, bf16x8& pa2, bf16x8& pa3) {
#pragma unroll
  for (int r = 0; r < 16; ++r) p1[r] = __builtin_amdgcn_exp2f(p1[r]);
  float ps = 0;
#pragma unroll
  for (int r = 0; r < 16; ++r) ps += p0[r];
#pragma unroll
  for (int r = 0; r < 16; ++r) ps += p1[r];
  { auto rr = __builtin_amdgcn_permlane32_swap(__float_as_uint(ps), __float_as_uint(ps), false, false);
    ps = __uint_as_float(rr[0]) + __uint_as_float(rr[1]); }
  l_reg = l_reg * alpha + ps;
#define PK4(P, BASE, OUT) do { unsigned a0 = cvtpk(P[BASE + 0], P[BASE + 1]), a1 = cvtpk(P[BASE + 2], P[BASE + 3]);   \
    unsigned b0 = cvtpk(P[BASE + 4], P[BASE + 5]), b1 = cvtpk(P[BASE + 6], P[BASE + 7]);                              \
    auto r0 = __builtin_amdgcn_permlane32_swap(a0, b0, false, false); auto r1 = __builtin_amdgcn_permlane32_swap(a1, b1, false, false); \
    u32x4v w = {r0[0], r1[0], r0[1], r1[1]}; OUT = *reinterpret_cast<bf16x8*>(&w); } while (0)
  PK4(p0, 0, pa0); PK4(p0, 8, pa1); PK4(p1, 0, pa2); PK4(p1, 8, pa3);
#undef PK4
}
__device__ __forceinline__ void qkt(f32x16& p0, f32x16& p1, const LAS char* Ks, const bf16x8* qr, int r32, int hi, int s) {
  p0 = f32x16{}; p1 = f32x16{};
#pragma unroll
  for (int d0 = 0; d0 < 4; ++d0) { const int cb = (s * 64 + d0 * 16 + hi * 8) * 2;
    const bf16x8 b0 = *reinterpret_cast<const LAS bf16x8*>(Ks + KSWZ(r32, cb));
    const bf16x8 b1 = *reinterpret_cast<const LAS bf16x8*>(Ks + KSWZ(32 + r32, cb));
    p0 = __builtin_amdgcn_mfma_f32_32x32x16_bf16(b0, qr[d0], p0, 0, 0, 0);
    p1 = __builtin_amdgcn_mfma_f32_32x32x16_bf16(b1, qr[d0], p1, 0, 0, 0); }
}
__device__ __forceinline__ int v_st(int k, int c) { const int kk = (k & ~0xC) | ((k & 4) << 1) | ((k & 8) >> 1); return ((kk >> 3) * 4 + (c >> 5)) * 512 + ((kk & 7) * 32 + (c & 31)) * 2; }
__device__ __forceinline__ int v_rd_base(int lane) { return ((lane & 3) << 3) | (((lane >> 2) & 3) << 6) | (((lane >> 4) & 1) << 5) | (((lane >> 5) & 1) << 8); }
constexpr int v_rd_off(int d0, int ks, int half) { return d0 * 512 + ks * 4096 + half * 2048; }
template <int OFF> __device__ __forceinline__ s16x4 tr_read(int vb) {
  s16x4 r; asm volatile("ds_read_b64_tr_b16 %0, %1 offset:%2" : "=&v"(r) : "v"(vb), "i"(OFF) : "memory"); return r;
}
template <int D0> __device__ __forceinline__ void pv_one(f32x16& od, int vb, bf16x8 pa0, bf16x8 pa1, bf16x8 pa2, bf16x8 pa3) {
  const s16x4 l0 = tr_read<v_rd_off(D0, 0, 0)>(vb), h0 = tr_read<v_rd_off(D0, 0, 1)>(vb), l1 = tr_read<v_rd_off(D0, 1, 0)>(vb), h1 = tr_read<v_rd_off(D0, 1, 1)>(vb);
  const s16x4 l2 = tr_read<v_rd_off(D0, 2, 0)>(vb), h2 = tr_read<v_rd_off(D0, 2, 1)>(vb), l3 = tr_read<v_rd_off(D0, 3, 0)>(vb), h3 = tr_read<v_rd_off(D0, 3, 1)>(vb);
  asm volatile("s_waitcnt lgkmcnt(0)" ::: "memory"); SBAR();
#define PK(L, H) (bf16x8){L[0], L[1], L[2], L[3], H[0], H[1], H[2], H[3]}
  od = __builtin_amdgcn_mfma_f32_32x32x16_bf16(pa0, PK(l0, h0), od, 0, 0, 0);
  od = __builtin_amdgcn_mfma_f32_32x32x16_bf16(pa1, PK(l1, h1), od, 0, 0, 0);
  od = __builtin_amdgcn_mfma_f32_32x32x16_bf16(pa2, PK(l2, h2), od, 0, 0, 0);
  od = __builtin_amdgcn_mfma_f32_32x32x16_bf16(pa3, PK(l3, h3), od, 0, 0, 0);
#undef PK
}
__device__ __forceinline__ void pv_d0(f32x16* o, int vb, bf16x8 pa0, bf16x8 pa1, bf16x8 pa2, bf16x8 pa3) {
  pv_one<0>(o[0], vb, pa0, pa1, pa2, pa3); pv_one<1>(o[1], vb, pa0, pa1, pa2, pa3); pv_one<2>(o[2], vb, pa0, pa1, pa2, pa3); pv_one<3>(o[3], vb, pa0, pa1, pa2, pa3);
}

__device__ __forceinline__ int tile_row(bool latq, int b, int j) { return latq ? (j < 32 ? b * SEQ + 64 * j : RL + b * CTXL + 64 * (j - 32)) : RL + b * CTXL + 64 * j; }

__device__ __forceinline__ void attn_unit(const bf16_t* __restrict__ Qg, const bf16_t* __restrict__ Kg, const bf16_t* __restrict__ Vg, bf16_t* __restrict__ ATT,
                                          const float* subg, float lam, bool latq, int b, int h, int qrow0, LAS unsigned char* lds) {
  const int tid = threadIdx.x, wid = __builtin_amdgcn_readfirstlane(tid >> 6), lane = tid & 63, r32 = lane & 31, hi = lane >> 5, rg = wid >> 1, s = wid & 1;
  LAS char* V_lds = (LAS char*)lds; LAS char* K_lds = (LAS char*)lds + 2 * SHM_V;
  LAS float* ws = (LAS float*)(lds + 65536) + wid * 64; LAS float* li_l = ws; LAS float* al_l = ws + 32;
  const int NT = latq ? 36 : 4;
  float m_reg = -1e30f, l_reg = 0; f32x16 o[4] = {}; bf16x8 qr[4];
  const bf16_t* Qw = Qg + (size_t)(qrow0 + rg * 32 + r32) * D + h * 128 + s * 64 + hi * 8;
#pragma unroll
  for (int d0 = 0; d0 < 4; ++d0) qr[d0] = *reinterpret_cast<const bf16x8*>(Qw + d0 * 16);
  const int sr = tid >> 4, sc = (tid & 15) * 8, vst0 = v_st(sr, sc), vst1 = v_st(32 + sr, sc);
  const int vb0 = (int)(unsigned)(size_t)V_lds + v_rd_base(lane);
  const size_t hoff = (size_t)h * 128 + sc;
  struct { bf16x8 vs0, vs1, ks0, ks1; } sr_[2];
#define SLOAD(i, j) do { const size_t ro_ = (size_t)(tile_row(latq, b, (j)) + sr) * D + hoff; \
    sr_[i].vs0 = *reinterpret_cast<const bf16x8*>(Vg + ro_); sr_[i].vs1 = *reinterpret_cast<const bf16x8*>(Vg + ro_ + 32 * D); \
    sr_[i].ks0 = *reinterpret_cast<const bf16x8*>(Kg + ro_); sr_[i].ks1 = *reinterpret_cast<const bf16x8*>(Kg + ro_ + 32 * D); } while (0)
#define SWRITE(bb, i) do { *(LAS bf16x8*)(V_lds + (bb) * SHM_V + vst0) = sr_[i].vs0; *(LAS bf16x8*)(V_lds + (bb) * SHM_V + vst1) = sr_[i].vs1; const int kc = sc * 2; \
    *(LAS bf16x8*)(K_lds + (bb) * SHM_K + KSWZ(sr, kc)) = sr_[i].ks0; *(LAS bf16x8*)(K_lds + (bb) * SHM_K + KSWZ(32 + sr, kc)) = sr_[i].ks1; } while (0)
#define SWAIT() asm volatile("s_waitcnt vmcnt(4)" ::: "memory")
#define RESC(a_) do { if (__any((a_) < 1.f)) { if (hi == 0) al_l[r32] = (a_); asm volatile("s_waitcnt lgkmcnt(0)" ::: "memory"); \
    _Pragma("unroll") for (int d = 0; d < 4; ++d) _Pragma("unroll") for (int r = 0; r < 16; ++r) o[d][r] *= al_l[crow(r, hi)]; } } while (0)
  f32x16 pA0, pA1, pB0, pB1; float mnA, mnB, alA, alB; bf16x8 pa0, pa1, pa2, pa3;
  constexpr int SE = 0, SO = 1;
  SLOAD(SE, 0); asm volatile("s_waitcnt vmcnt(0)" ::: "memory"); SWRITE(0, SE); __syncthreads();
  qkt(pA0, pA1, K_lds, qr, r32, hi, s); partialSM(pA0, pA1, m_reg, mnA, alA);
  SLOAD(SO, 1); if (2 < NT) SLOAD(SE, 2);
  SWAIT(); SWRITE(1, SO); __syncthreads();
  for (int j = 1; j + 1 < NT; j += 2) {
    SBAR(); qkt(pB0, pB1, K_lds + SHM_K, qr, r32, hi, s);
    finishSM(pA0, pA1, alA, l_reg, pa0, pa1, pa2, pa3); SBAR();
    SLOAD(SO, j + 2); SBAR();
    pv_d0(o, vb0, pa0, pa1, pa2, pa3); partialSM(pB0, pB1, m_reg, mnB, alB);
    __syncthreads(); SWAIT(); SWRITE(0, SE);
    RESC(alB); __syncthreads();
    SBAR(); qkt(pA0, pA1, K_lds, qr, r32, hi, s);
    finishSM(pB0, pB1, alB, l_reg, pa0, pa1, pa2, pa3); SBAR();
    if (j + 3 < NT) SLOAD(SE, j + 3); SBAR();
    pv_d0(o, vb0 + SHM_V, pa0, pa1, pa2, pa3); partialSM(pA0, pA1, m_reg, mnA, alA);
    __syncthreads(); SWAIT(); SWRITE(1, SO);
    RESC(alA); __syncthreads();
  }
  SBAR(); qkt(pB0, pB1, K_lds + SHM_K, qr, r32, hi, s);
  finishSM(pA0, pA1, alA, l_reg, pa0, pa1, pa2, pa3); SBAR();
  pv_d0(o, vb0, pa0, pa1, pa2, pa3); partialSM(pB0, pB1, m_reg, mnB, alB);
  __syncthreads(); RESC(alB);
  finishSM(pB0, pB1, alB, l_reg, pa0, pa1, pa2, pa3); SBAR();
  pv_d0(o, vb0 + SHM_V, pa0, pa1, pa2, pa3);
#undef SLOAD
#undef SWRITE
#undef SWAIT
#undef RESC
  if (hi == 0) li_l[r32] = l_reg;
  asm volatile("s_waitcnt lgkmcnt(0)" ::: "memory");
  float rli[16];
#pragma unroll
  for (int r = 0; r < 16; ++r) rli[r] = __builtin_amdgcn_rcpf(li_l[crow(r, hi)]);
  __syncthreads();
  LAS float* X = (LAS float*)lds + rg * 4096;
  if (s == 1) {
#pragma unroll
    for (int r = 0; r < 16; ++r)
#pragma unroll
      for (int d0 = 0; d0 < 4; ++d0) X[crow(r, hi) * 128 + d0 * 32 + r32] = o[d0][r] * (rli[r] * lam);
  }
  __syncthreads();
  if (s == 0) {
    float rstd[16];
#pragma unroll
    for (int r = 0; r < 16; ++r) {
      float acc = 0.f;
#pragma unroll
      for (int d0 = 0; d0 < 4; ++d0) { const float v = o[d0][r] * rli[r] - X[crow(r, hi) * 128 + d0 * 32 + r32]; o[d0][r] = v; acc += v * v; }
#pragma unroll
      for (int off = 1; off < 32; off <<= 1) acc += __shfl_xor(acc, off);
      rstd[r] = 1.0f / sqrtf(acc * (1.0f / 128.0f) + EPS);
    }
    LAS bf16_t* stg = (LAS bf16_t*)(lds + 65536 + 2048) + rg * 4096;
    float gsc[4];
#pragma unroll
    for (int d0 = 0; d0 < 4; ++d0) gsc[d0] = subg[d0 * 32 + r32] * (1.0f - LAMBDA_INIT0);
#pragma unroll
    for (int r = 0; r < 16; ++r)
#pragma unroll
      for (int d0 = 0; d0 < 4; ++d0) stg[crow(r, hi) * 128 + d0 * 32 + r32] = (bf16_t)f2bf(o[d0][r] * rstd[r] * gsc[d0]);
    asm volatile("s_waitcnt lgkmcnt(0)" ::: "memory");
    bf16_t* Ow = ATT + (size_t)(qrow0 + rg * 32) * D + h * 128;
#pragma unroll
    for (int i = 0; i < 8; ++i) { const int row = i * 4 + (lane >> 4), ch = lane & 15; const u32x4v v = *(const LAS u32x4v*)(stg + row * 128 + ch * 8); *(u32x4v*)(Ow + (size_t)row * D + ch * 8) = v; }
  }
  __syncthreads();
}
#undef KSWZ
#undef SBAR
}

__device__ __forceinline__ void ph_attn_fast(const Ctx& a, LAS unsigned char* lds) {
    unsigned char* ws = a.ws();
    const bf16_t* Q = (const bf16_t*)(ws + WS_Q); const bf16_t* Kb = (const bf16_t*)(ws + WS_K); const bf16_t* V = (const bf16_t*)(ws + WS_V);
    bf16_t* ATT = (bf16_t*)(ws + WS_ATT); const float* subg = a.in(I_SUBG);
    const float lam = diff_lambda(a, threadIdx.x & 63);
    const int G = gridDim.x, c = blockIdx.x;
    for (int i = 0;; ++i) {
        const long L = (long)i * G + c; if (L >= 1024) break;
        const int w = xcd_remap(L, 1024), bh = w >> 4, qb = w & 15, b = bh >> 3, h = bh & 7;
        fa::attn_unit(Q, Kb, V, ATT, subg, lam, true, b, h, b * SEQ + qb * 128, lds);
    }
    for (int L = c; L < 128; L += G) {
        const int bh = L >> 1, qb = L & 1, b = bh >> 3, h = bh & 7;
        fa::attn_unit(Q, Kb, V, ATT, subg, lam, false, b, h, RL + b * CTXL + qb * 128, lds);
    }
#if DENSE_LATE && ANY_FAST_GEMM
    if (c >= 128 && G > 128) { for (int r = c - 128; r < IT_DENSE_REST; r += G - 128) cvt_dense_rest_item(a, r); }
#endif
}


__device__ __forceinline__ void ph_gates_fast(const Ctx& a, LAS unsigned char* lds) {
    unsigned char* ws = a.ws();
    const bf16_t* XR = (const bf16_t*)(ws + WS_XR); const bf16_t* WG = (const bf16_t*)(ws + WS_WG);
    bf16_t* LOGA = (bf16_t*)(ws + WS_LOGA); unsigned char* BT = ws + WS_BT;
    const float* convw = a.in(I_CONVW); const float* convb = a.in(I_CONVB); const float* gtab = (const float*)(ws + WS_GTAB);
    const int tid = threadIdx.x, wid = __builtin_amdgcn_readfirstlane(tid >> 6), lane = tid & 63, wr = wid >> 2, wc = wid & 3, fr = lane & 15, fq = lane >> 4;
    constexpr int HTB = pg8::HTB;
    const int aoff = pg8::lds_byte(wr * 64 + fr, fq * 8), boff = pg8::lds_byte(wc * 32 + fr, fq * 8);
    const int sc = tid & 15, rg8 = tid >> 4;
    unsigned bsrc[2];
#pragma unroll
    for (int i = 0; i < 2; ++i) { int R, C; pg8::stage_rc(tid * 16 + i * 8192, R, C); bsrc[i] = (unsigned)(((R & ~31) + pg8::perm32(R & 31)) * 128 + C) * 2u; }
    const unsigned ldsw = (unsigned)wid * 1024u;
#define GT_DMA_B(d_) do { const char* wb_ = (const char*)(WG + (size_t)((d_) * 8 + kb) * 256 * 128); \
        _Pragma("unroll") for (int kt_ = 0; kt_ < 2; ++kt_) _Pragma("unroll") for (int h_ = 0; h_ < 2; ++h_) _Pragma("unroll") for (int i_ = 0; i_ < 2; ++i_) \
            __builtin_amdgcn_global_load_lds((const unsigned*)(wb_ + (size_t)h_ * 128 * 256 + kt_ * 128 + bsrc[i_]), (LAS unsigned*)(lds + (4 + kt_ * 2 + h_) * HTB + ldsw + i_ * 8192), 16, 0, 0); } while (0)
    const int Gq = gemm_groups(72 * 8, (int)gridDim.x);
    if ((int)blockIdx.x >= Gq) { cvt8_run(a, 1, CV1_GATES + ((int)blockIdx.x - Gq), (int)gridDim.x - Gq, CV1_GATES + CVQ_GATES, lds); return; }
    for (int u = blockIdx.x; u < 72 * 8; u += Gq) {
        const int kb = u & 7, rt = u >> 3;
        const bool lat = rt < 64; const int bsm = lat ? (rt >> 3) : (rt - 64), t0 = lat ? (rt & 7) * 256 : 0, L = lat ? SEQ : CTXL;
        const int seqbase = lat ? bsm * SEQ : RL + bsm * CTXL;
        GT_DMA_B(0);
        {
            const int ch0 = kb * 128 + sc * 8, r0 = rg8 * 8;
            u32x4 xin[11];
#pragma unroll
            for (int i = 0; i < 11; ++i) { const int tt = t0 + r0 - 2 + i; xin[i] = (tt >= 0 && tt < L) ? *(const u32x4*)(XR + (size_t)(seqbase + tt) * D + ch0) : (u32x4){0u, 0u, 0u, 0u}; }
            f32x4 cw[4][2], cb[2];
#pragma unroll
            for (int j = 0; j < 4; ++j) { cw[j][0] = *(const f32x4*)(convw + j * D + ch0); cw[j][1] = *(const f32x4*)(convw + j * D + ch0 + 4); }
            cb[0] = *(const f32x4*)(convb + ch0); cb[1] = *(const f32x4*)(convb + ch0 + 4);
#pragma unroll
            for (int k = 0; k < 8; ++k) {
                f32x4 o0 = cb[0], o1 = cb[1];
#pragma unroll
                for (int j = 0; j < 4; ++j) { const u32x4 x = xin[k + j];
                    o0 += cw[j][0] * (f32x4){bf_lo(x.x), bf_hi(x.x), bf_lo(x.y), bf_hi(x.y)}; o1 += cw[j][1] * (f32x4){bf_lo(x.z), bf_hi(x.z), bf_lo(x.w), bf_hi(x.w)}; }
                const int r = r0 + k;
                u32x4 w; w.x = pk2(o0[0], o0[1]); w.y = pk2(o0[2], o0[3]); w.z = pk2(o1[0], o1[1]); w.w = pk2(o1[2], o1[3]);
                *(LAS u32x4*)(lds + ((sc >> 3) * 2 + (r >> 7)) * HTB + pg8::lds_byte(r & 127, (sc & 7) * 8)) = w;
            }
        }
#pragma unroll 1
        for (int d = 0; d < 2; ++d) {
            asm volatile("s_waitcnt vmcnt(0)" ::: "memory");
            __syncthreads();
            pf4 acc[2][2][4][2];
#pragma unroll
            for (int ai = 0; ai < 2; ++ai)
#pragma unroll
                for (int bj = 0; bj < 2; ++bj)
#pragma unroll
                    for (int m = 0; m < 4; ++m)
#pragma unroll
                        for (int n = 0; n < 2; ++n) acc[ai][bj][m][n] = (pf4){0.f, 0.f, 0.f, 0.f};
#pragma unroll 1
            for (int kt = 0; kt < 2; ++kt)
#pragma unroll
                for (int ai = 0; ai < 2; ++ai) {
                    __builtin_amdgcn_sched_barrier(0);
                    pg8::bf16x8 At[4][2];
#pragma unroll
                    for (int m = 0; m < 4; ++m)
#pragma unroll
                        for (int k = 0; k < 2; ++k) At[m][k] = *(const LAS pg8::bf16x8*)(lds + (kt * 2 + ai) * HTB + aoff + m * 2048 + k * 1024);
#pragma unroll
                    for (int bj = 0; bj < 2; ++bj) {
                        pg8::bf16x8 Bf[2][2];
#pragma unroll
                        for (int n = 0; n < 2; ++n)
#pragma unroll
                            for (int k = 0; k < 2; ++k) Bf[n][k] = *(const LAS pg8::bf16x8*)(lds + (4 + kt * 2 + bj) * HTB + boff + n * 2048 + k * 1024);
#pragma unroll
                        for (int m = 0; m < 4; ++m)
#pragma unroll
                            for (int n = 0; n < 2; ++n)
#pragma unroll
                                for (int k = 0; k < 2; ++k) acc[ai][bj][m][n] = __builtin_amdgcn_mfma_f32_16x16x32_bf16(Bf[n][k], At[m][k], acc[ai][bj][m][n], 0, 0, 0);
                        __builtin_amdgcn_sched_barrier(0);
                    }
                }
            if (d == 0) { __syncthreads(); GT_DMA_B(1); }
            const int cc0 = wc * 32 + fq * 8;
            pf4 cl[2], c2[2], brn[2], bin[2];
#pragma unroll
            for (int n = 0; n < 2; ++n) { const float* g = gtab + (size_t)(d * 4) * D + kb * 128 + cc0 + 4 * n;
                cl[n] = *(const pf4*)g; c2[n] = *(const pf4*)(g + D); brn[n] = *(const pf4*)(g + 2 * D); bin[n] = *(const pf4*)(g + 3 * D); }
#pragma unroll
            for (int ai = 0; ai < 2; ++ai)
#pragma unroll
                for (int m = 0; m < 4; ++m) {
                    const int rl = wr * 64 + m * 16 + fr;
                    const int grow = seqbase + t0 + ai * 128 + rl;
                    float la[8], bt[8];
#pragma unroll
                    for (int n = 0; n < 2; ++n) {
                        const int cc = cc0 + 4 * n;
                        const u32x2 xw = *(const LAS u32x2*)(lds + ((cc >> 6) * 2 + ai) * HTB + pg8::lds_byte(rl, cc & 63));
                        const float xv[4] = {bf_lo(xw.x), bf_hi(xw.x), bf_lo(xw.y), bf_hi(xw.y)};
#pragma unroll
                        for (int j = 0; j < 4; ++j) {
                            const float r = __builtin_amdgcn_rcpf(1.0f + __builtin_amdgcn_exp2f(fmaf(acc[ai][0][m][n][j], -1.4426950408889634f, brn[n][j])));
                            const float ig = __builtin_amdgcn_rcpf(1.0f + __builtin_amdgcn_exp2f(fmaf(acc[ai][1][m][n][j], -1.4426950408889634f, bin[n][j])));
                            const float om = 1.0f - __builtin_amdgcn_exp2f(r * c2[n][j]);
                            la[n * 4 + j] = r * cl[n][j]; bt[n * 4 + j] = __builtin_amdgcn_sqrtf(om) * (ig * xv[j]) * BT_SCALE;
                        }
                    }
                    const size_t o = ((size_t)d * RT + grow) * D + kb * 128 + cc0;
                    u32x4 w; w.x = pk2(la[0], la[1]); w.y = pk2(la[2], la[3]); w.z = pk2(la[4], la[5]); w.w = pk2(la[6], la[7]);
                    *(u32x4*)(LOGA + o) = w;
                    u32x2 wb; wb.x = pk4_fp8(bt[0], bt[1], bt[2], bt[3]); wb.y = pk4_fp8(bt[4], bt[5], bt[6], bt[7]);
                    *(u32x2*)(BT + o) = wb;
                }
        }
#if FUSE_SCAN1
        asm volatile("s_waitcnt vmcnt(0)" ::: "memory");
        __syncthreads();
        {
            const int dir = wid >> 2, lc = wid & 3, kc = (t0 >> 6) + lc;
            const int c = dir == 0 ? (lat ? NCH_CTX + kc : kc) : (lat ? NCH - 1 - kc : NCH_CTX - 1 - kc);
            const int ch = kb * 128 + 2 * lane;
            float* CP = (float*)(ws + WS_CP); float* CB = (float*)(ws + WS_CB);
            float h0 = 0.f, h1 = 0.f, p0 = 0.f, p1 = 0.f;
#pragma unroll 1
            for (int sg = 0; sg < SCH; sg += 32) {
                unsigned la[32], bt[32];
#pragma unroll
                for (int i = 0; i < 32; ++i) { const size_t o = ((size_t)dir * RT + scan_row(bsm, dir, c, sg + i)) * D + ch; la[i] = *(const unsigned*)(LOGA + o); bt[i] = *(const unsigned short*)(BT + o); }
                asm volatile("" ::: "memory");
#pragma unroll
                for (int i = 0; i < 32; ++i) { const float l0 = bf_lo(la[i]), l1 = bf_hi(la[i]); const f32x2 bb = __builtin_amdgcn_cvt_pk_f32_fp8((int)bt[i], false);
                    h0 = __builtin_amdgcn_exp2f(l0) * h0 + bb.x; h1 = __builtin_amdgcn_exp2f(l1) * h1 + bb.y; p0 += l0; p1 += l1; }
            }
            const size_t so = ((size_t)(bsm * 2 + dir) * NCH + c) * D + ch;
            *(f32x2*)(CP + so) = (f32x2){p0, p1}; *(f32x2*)(CB + so) = (f32x2){h0, h1};
        }
#endif
        __syncthreads();
    }
#undef GT_DMA_B
    if (Gq == (int)gridDim.x) cvt8_tail(a, lds, 72 * 8, Gq, (int)blockIdx.x, 1, CV1_GATES, CVQ_GATES);
}

constexpr int NPHASES = 25;
__host__ __device__ constexpr bool phase_enabled(int p) {
    return !((p == 3 && FAST_QKV) || (p == 9 && FAST_GU) || (p == 22 && FAST_GU) || (p == 13 && FAST_GATES) || (p == 15 && FAST_GATES) || (p == 16 && FAST_GATES && FUSE_SCAN1));
}

__global__ void __launch_bounds__(NTHREADS, 2) hybrid_fwd(Args args) {
    extern __shared__ __attribute__((aligned(16))) unsigned char lds_raw[];
    LAS unsigned char* lds = (LAS unsigned char*)lds_raw;
    volatile LAS unsigned* MISC = (volatile LAS unsigned*)(lds + MISC_OFF);
    const int lo = args.ph_lo, hi = args.ph_hi;
    if (threadIdx.x == 0) {
        LAS unsigned long long* la64 = (LAS unsigned long long*)(lds + ARGS_OFF);
#pragma unroll
        for (int i = 0; i < 27; ++i) la64[i] = (unsigned long long)args.in[i];
        la64[27] = (unsigned long long)args.out; la64[28] = (unsigned long long)args.ws;
    }
    Ctx ctx; ctx.la = (const LAS unsigned*)(lds + ARGS_OFF);
    if (threadIdx.x < 16) MISC[threadIdx.x] = 0u;
    __syncthreads();
#if MK_ONE_LAUNCH
    XcdBarrier bar = xcd_barrier_post((unsigned*)(ctx.ws() + WS_CTL) + CW_BAR, MISC + 8);
#define GRID_BAR() xcd_barrier(bar)
#else
#define GRID_BAR() do { } while (0)
#endif
#ifndef REP_MASK
#define REP_MASK 0u
#endif
#define RUN(k, call) do { call; if constexpr (((REP_MASK) >> (k)) & 1u) { __syncthreads(); call; } } while (0)
#define IN(k) (lo <= (k) && (k) < hi)
#define SEAM(k) do { if ((k) + 1 < hi) GRID_BAR(); } while (0)

    if (IN(0)) { RUN(0, ph_prologue(ctx, lds)); SEAM(0); }
    if (IN(1)) { RUN(1, ph_norm1_l0(ctx)); SEAM(1); }
    if (IN(2)) {
#if FAST_QKV
        RUN(2, ph_qkv_fast(ctx, lds));
#else
        RUN(2, ph_qkv_naive(ctx, lds));
#endif
        SEAM(2); }
#if !FAST_QKV
    if (IN(3)) { RUN(3, ph_rope_naive(ctx)); SEAM(3); }
#endif
    if (IN(4)) {
#if FAST_ATTN
        RUN(4, ph_attn_fast(ctx, lds));
#else
        RUN(4, ph_attn_naive(ctx, lds));
#endif
        SEAM(4); }
    if (IN(5)) {
#if FAST_WO
        RUN(5, ph_wo_fast(ctx, lds));
#else
        RUN(5, ph_wo_naive(ctx, lds));
#endif
        SEAM(5); }
    if (IN(6)) { RUN(6, ph_norm2_router(ctx, lds, 0, RT)); SEAM(6); }
    if (IN(7)) { RUN(7, ph_topk_gather(ctx, lds, 0)); SEAM(7); }
    if (IN(8)) {
#if FAST_GU
        RUN(8, ph_gu_fast(ctx, lds, 0));
#else
        RUN(8, ph_gu_naive(ctx, lds, 0));
#endif
        SEAM(8); }
#if !FAST_GU
    if (IN(9)) { RUN(9, ph_swiglu_naive(ctx, 0)); SEAM(9); }
#endif
    if (IN(10)) {
#if FAST_DN
        RUN(10, ph_dn_fast(ctx, lds, 0));
#else
        RUN(10, ph_dn_naive(ctx, lds, 0));
#endif
        SEAM(10); }
    if (IN(11)) { RUN(11, ph_combine<0>(ctx, 0, RT)); SEAM(11); }
    if (IN(12)) {
#if FAST_WIN
        RUN(12, ph_win_fast(ctx, lds));
#else
        RUN(12, ph_win_naive(ctx, lds));
#endif
        SEAM(12); }
#if !FAST_GATES
    if (IN(13)) { RUN(13, ph_conv_naive(ctx)); SEAM(13); }
#endif
    if (IN(14)) {
#if FAST_GATES
        RUN(14, ph_gates_fast(ctx, lds));
#else
        RUN(14, ph_gates_naive(ctx, lds));
#endif
        SEAM(14); }
#if !FAST_GATES
    if (IN(15)) { RUN(15, ph_gate_elem_naive(ctx)); SEAM(15); }
#endif
#if !(FUSE_SCAN1 && FAST_GATES)
    if (IN(16)) { RUN(16, ph_scan1(ctx)); SEAM(16); }
#endif
    if (IN(17)) { RUN(17, ph_scan2(ctx)); SEAM(17); }
    if (IN(18)) {
#if FAST_WOUT
        RUN(18, ph_wout_fast(ctx, lds));
#else
        RUN(18, ph_wout_naive(ctx, lds));
#endif
        SEAM(18); }
    if (IN(19)) { RUN(19, ph_norm2_router(ctx, lds, 1, RL)); SEAM(19); }
    if (IN(20)) { RUN(20, ph_topk_gather(ctx, lds, 1)); SEAM(20); }
    if (IN(21)) {
#if FAST_GU
        RUN(21, ph_gu_fast(ctx, lds, 1));
#else
        RUN(21, ph_gu_naive(ctx, lds, 1));
#endif
        SEAM(21); }
#if !FAST_GU
    if (IN(22)) { RUN(22, ph_swiglu_naive(ctx, 1)); SEAM(22); }
#endif
    if (IN(23)) {
#if FAST_DN
        RUN(23, ph_dn_fast(ctx, lds, 1));
#else
        RUN(23, ph_dn_naive(ctx, lds, 1));
#endif
        SEAM(23); }
    if (IN(24)) { RUN(24, ph_combine<1>(ctx, 1, RL)); }
#undef IN
#undef SEAM
#undef GRID_BAR
}

extern "C" void kernel_launch(void* const* d_in, const int* in_sizes, int n_in, void* d_out, int out_size, void* d_ws, size_t ws_size, hipStream_t stream) {
    static int grid = 0;
    if (grid == 0) {
        if (n_in != 27 || out_size != RL * D || ws_size < WS_END) { fprintf(stderr, "kernel_launch: unexpected shapes (n_in %d out %d ws %zu)\n", n_in, out_size, ws_size); grid = -1; return; }
        int dev = 0, cus = 0, per_cu = 0;
        if (hipGetDevice(&dev) != hipSuccess || hipDeviceGetAttribute(&cus, hipDeviceAttributeMultiprocessorCount, dev) != hipSuccess) { grid = -1; return; }
        if (hipFuncSetAttribute((const void*)hybrid_fwd, hipFuncAttributeMaxDynamicSharedMemorySize, LDS_BYTES) != hipSuccess) { fprintf(stderr, "kernel_launch: hipFuncSetAttribute failed\n"); grid = -1; return; }
        if (hipOccupancyMaxActiveBlocksPerMultiprocessor(&per_cu, (const void*)hybrid_fwd, NTHREADS, LDS_BYTES) != hipSuccess || per_cu < 1) { fprintf(stderr, "kernel_launch: occupancy query says %d\n", per_cu); }
        (void)hipGetLastError();
        grid = cus > 0 ? cus : 256;
    }
    if (grid < 0) return;
    if (hipMemsetAsync((char*)d_ws + WS_CTL, 0, CTL_ZERO_BYTES, stream) != hipSuccess) return;
    Args a{};
    for (int i = 0; i < 27; ++i) a.in[i] = (const float*)d_in[i];
    a.out = (float*)d_out; a.ws = (unsigned char*)d_ws;
#if MK_ONE_LAUNCH
    a.ph_lo = 0; a.ph_hi = NPHASES;
    hipLaunchKernelGGL(hybrid_fwd, dim3(grid), dim3(NTHREADS), LDS_BYTES, stream, a);
#else
    for (int p = 0; p < NPHASES; ++p) {
        if (!phase_enabled(p)) continue;
        a.ph_lo = p; a.ph_hi = p + 1;
        hipLaunchKernelGGL(hybrid_fwd, dim3(grid), dim3(NTHREADS), LDS_BYTES, stream, a);
    }
#endif
    const hipError_t le = hipPeekAtLastError();
    if (le != hipSuccess) fprintf(stderr, "kernel_launch: launch failed: %s\n", hipGetErrorName(le));
}
```

```cpp
#define MK_ONE_LAUNCH 1
#define FAST_QKV 1
#define FAST_WO 1
#define FAST_GU 1
#define FAST_DN 1
#define FAST_WIN 1
#define FAST_WOUT 1
#define FAST_ATTN 1
#define FAST_GATES 1
#define FP8_MOE 1
#include <hip/hip_runtime.h>
#include <cstdio>
#include <cstdint>
#include <cmath>

#ifndef MK_ONE_LAUNCH
#define MK_ONE_LAUNCH 0
#endif
#ifndef FAST_QKV
#define FAST_QKV 0
#endif
#ifndef FAST_ATTN
#define FAST_ATTN 0
#endif
#ifndef FAST_WO
#define FAST_WO 0
#endif
#ifndef FAST_GU
#define FAST_GU 0
#endif
#ifndef FAST_DN
#define FAST_DN 0
#endif
#ifndef FAST_WIN
#define FAST_WIN 0
#endif
#ifndef FAST_GATES
#define FAST_GATES 0
#endif
#ifndef FAST_WOUT
#define FAST_WOUT 0
#endif
#ifndef FP8_MOE
#define FP8_MOE 0
#endif
#ifndef GU_ALIGN
#define GU_ALIGN true
#endif
#ifndef DN_ALIGN
#define DN_ALIGN true
#endif
#ifndef FUSE_SCAN1
#define FUSE_SCAN1 1
#endif
#define ANY_FAST_GEMM (FAST_QKV || FAST_WO || FAST_GU || FAST_DN || FAST_WIN || FAST_GATES || FAST_WOUT)

namespace pg8 {
#define PG8_LAS __attribute__((address_space(3)))
typedef unsigned short bf16_t;
typedef short bf16x8 __attribute__((ext_vector_type(8)));
typedef float f32x4 __attribute__((ext_vector_type(4)));
typedef unsigned u32x4 __attribute__((ext_vector_type(4)));
constexpr int BM = 256, BK = 64, HALF = 128, HTB = HALF * BK * 2  , STAGE_BYTES = 8 * HTB, NXCD = 8, WGM = 8;

__host__ __device__ __forceinline__ int lds_byte(int r, int c) { const int st = (r >> 4) * 2 + (c >> 5), rr = r & 15, cc = c & 31, ob = rr * 64 + cc * 2; return st * 1024 + (ob ^ (((ob >> 9) & 1) << 5)); }
__host__ __device__ __forceinline__ void stage_rc(int b, int& R, int& C) { const int st = b / 1024, sb = b % 1024, swz = sb ^ (((sb >> 9) & 1) << 5); R = (st >> 1) * 16 + swz / 64; C = (st & 1) * 32 + (swz % 64) / 2; }
__host__ __device__ __forceinline__ int perm32(int rho) { const int n = rho >> 4, i = rho & 15; return 8 * (i >> 2) + 4 * n + (i & 3); }

struct Unit { int pm, pn; };
struct Gemm { const bf16_t* A; const bf16_t* Bt; int M, N, K; };
__device__ __forceinline__ unsigned cvt_pk_bf16(float lo, float hi) { unsigned r; asm volatile("v_cvt_pk_bf16_f32 %0, %1, %2" : "=v"(r) : "v"(lo), "v"(hi)); return r; }
typedef int v4i_t __attribute__((ext_vector_type(4)));
typedef int v8i_t __attribute__((ext_vector_type(8)));
__device__ __forceinline__ v8i_t cat8(bf16x8 lo, bf16x8 hi) { const v4i_t a = __builtin_bit_cast(v4i_t, lo), b = __builtin_bit_cast(v4i_t, hi); return __builtin_shufflevector(a, b, 0, 1, 2, 3, 4, 5, 6, 7); }
template <class Epi, class Sched, bool ALIGN_EPI = false, bool SP2 = false, int FP8SCALE = 0  >
__device__ __forceinline__ void gemm_phase(PG8_LAS unsigned char* lds, const Gemm g, const Sched& S, const Epi& E) {
    const int tid = threadIdx.x, wid = __builtin_amdgcn_readfirstlane(tid >> 6), lane = tid & 63, wr = wid >> 2, wc = wid & 3, fr = lane & 15, fq = lane >> 4;
    const int K = g.K, nt = K / BK;
    unsigned voffA[2], voffB[2];
#pragma unroll
    for (int i = 0; i < 2; ++i) { int R, C; stage_rc(tid * 16 + i * 8192, R, C); const int Rb = Epi::PERM ? ((R & ~31) + perm32(R & 31)) : R;
        voffA[i] = (unsigned)(R * K + C) * 2u; voffB[i] = (unsigned)(Rb * K + C) * 2u; }
    const size_t kstep = (size_t)(BK * 2);
    const size_t hstep = (size_t)HALF * K * 2;
    const size_t tstep = 2 * hstep;
    const unsigned ldsw = (unsigned)wid * 1024u;
    const int aoff = lds_byte(wr * 64 + fr, fq * 8), boff = lds_byte(wc * 32 + fr, fq * 8);
#define PG8_SA(b, h) (((b) * 2 + (h)) * HTB)
#define PG8_SB(b, h) ((4 + (b) * 2 + (h)) * HTB)
#ifndef PG8_B_AUX
#define PG8_B_AUX 0
#endif
#define PG8_STAGE(bufoff, gbase, voff) do { _Pragma("unroll") for (int _i = 0; _i < 2; ++_i) { \
        if constexpr (FP8SCALE != 0 && PG8_B_AUX != 0) { if ((bufoff) >= 4 * HTB) __builtin_amdgcn_global_load_lds((const unsigned*)((const char*)(gbase) + (voff)[_i]), (PG8_LAS unsigned*)(lds + (bufoff) + ldsw + _i * 8192), 16, 0, PG8_B_AUX); \
            else __builtin_amdgcn_global_load_lds((const unsigned*)((const char*)(gbase) + (voff)[_i]), (PG8_LAS unsigned*)(lds + (bufoff) + ldsw + _i * 8192), 16, 0, 0); } \
        else __builtin_amdgcn_global_load_lds((const unsigned*)((const char*)(gbase) + (voff)[_i]), (PG8_LAS unsigned*)(lds + (bufoff) + ldsw + _i * 8192), 16, 0, 0); } } while (0)
#define PG8_LDA(dst, b, h) do { if constexpr (FP8SCALE == 0) { _Pragma("unroll") for (int m = 0; m < 4; ++m) _Pragma("unroll") for (int k = 0; k < 2; ++k) dst[m][k] = *(const PG8_LAS bf16x8*)(lds + PG8_SA(b, h) + aoff + m * 2048 + k * 1024); } \
        else { _Pragma("unroll") for (int m = 0; m < 4; ++m) { const v4i_t lo_ = *(const PG8_LAS v4i_t*)(lds + PG8_SA(b, h) + aoff + m * 2048), hi_ = *(const PG8_LAS v4i_t*)(lds + PG8_SA(b, h) + aoff + m * 2048 + 1024); dst##8[m] = __builtin_shufflevector(lo_, hi_, 0, 1, 2, 3, 4, 5, 6, 7); } } } while (0)
#define PG8_LDB(dst, b, h) do { if constexpr (FP8SCALE == 0) { _Pragma("unroll") for (int n = 0; n < 2; ++n) _Pragma("unroll") for (int k = 0; k < 2; ++k) dst[n][k] = *(const PG8_LAS bf16x8*)(lds + PG8_SB(b, h) + boff + n * 2048 + k * 1024); } \
        else { _Pragma("unroll") for (int n = 0; n < 2; ++n) { const v4i_t lo_ = *(const PG8_LAS v4i_t*)(lds + PG8_SB(b, h) + boff + n * 2048), hi_ = *(const PG8_LAS v4i_t*)(lds + PG8_SB(b, h) + boff + n * 2048 + 1024); dst##8[n] = __builtin_shufflevector(lo_, hi_, 0, 1, 2, 3, 4, 5, 6, 7); } } } while (0)
#define PG8_MMA(ai, bj, At, Bt) do { __builtin_amdgcn_s_setprio(1); \
        if constexpr (FP8SCALE == 0) { _Pragma("unroll") for (int m = 0; m < 4; ++m) _Pragma("unroll") for (int n = 0; n < 2; ++n) _Pragma("unroll") for (int k = 0; k < 2; ++k) \
            acc[ai][bj][m][n] = __builtin_amdgcn_mfma_f32_16x16x32_bf16(Bt[n][k], At[m][k], acc[ai][bj][m][n], 0, 0, 0); } \
        else { _Pragma("unroll") for (int m = 0; m < 4; ++m) _Pragma("unroll") for (int n = 0; n < 2; ++n) \
            asm volatile("v_mfma_scale_f32_16x16x128_f8f6f4 %0, %1, %2, %0, %3, %4 op_sel_hi:[0,0,0]" : "+v"(acc[ai][bj][m][n]) : "v"(Bt##8[n]), "v"(At##8[m]), "v"(sclW), "v"(sclA)); } \
        __builtin_amdgcn_s_setprio(0); } while (0)
#define PG8_WAIT_V(n) asm volatile("s_waitcnt vmcnt(" #n ")" ::: "memory")
#define PG8_WAIT_L(n) asm volatile("s_waitcnt lgkmcnt(" #n ")" ::: "memory")
#define PG8_BAR __builtin_amdgcn_s_barrier()
#define PG8_SCHED __builtin_amdgcn_sched_barrier(0)
    Unit cur, nxt; int ui = 0;
    if (!S.next(0, cur)) return;
    f32x4 acc[2][2][4][2];
#pragma unroll
    for (int a = 0; a < 2; ++a)
#pragma unroll
        for (int b = 0; b < 2; ++b)
#pragma unroll
            for (int m = 0; m < 4; ++m)
#pragma unroll
                for (int n = 0; n < 2; ++n) acc[a][b][m][n] = (f32x4){0.f, 0.f, 0.f, 0.f};
    bf16x8 At[4][2], B0[2][2], B1[2][2]; v8i_t At8[4], B08[2], B18[2]; const int sclW = FP8SCALE * 0x01010101, sclA = 0x7f7f7f7f;
    const char* cA = (const char*)g.A + (size_t)cur.pm * tstep; const char* cB = (const char*)g.Bt + (size_t)cur.pn * tstep;
    S.a_ready(cur);
    if constexpr (SP2) {
        PG8_STAGE(PG8_SB(0, 0), cB, voffB); PG8_STAGE(PG8_SB(0, 1), cB + hstep, voffB); PG8_STAGE(PG8_SA(0, 0), cA, voffA); PG8_STAGE(PG8_SA(0, 1), cA + hstep, voffA);
        if (wr == 1) PG8_BAR;
        PG8_WAIT_V(2); PG8_BAR;
        PG8_STAGE(PG8_SB(1, 0), cB + kstep, voffB); PG8_STAGE(PG8_SA(1, 0), cA + kstep, voffA); PG8_STAGE(PG8_SB(1, 1), cB + hstep + kstep, voffB);
        PG8_WAIT_V(6); PG8_BAR;
    } else {
        PG8_STAGE(PG8_SB(0, 0), cB, voffB); PG8_STAGE(PG8_SA(0, 0), cA, voffA); PG8_STAGE(PG8_SB(0, 1), cB + hstep, voffB); PG8_STAGE(PG8_SA(0, 1), cA + hstep, voffA);
        if (wr == 1) PG8_BAR;
        PG8_WAIT_V(4); PG8_BAR;
        PG8_STAGE(PG8_SB(1, 0), cB + kstep, voffB); PG8_STAGE(PG8_SA(1, 0), cA + kstep, voffA); PG8_STAGE(PG8_SB(1, 1), cB + hstep + kstep, voffB);
        PG8_WAIT_V(6); PG8_BAR;
    }
    for (;;) {
        const bool has_next = S.next(ui + 1, nxt);
        const char* nA = has_next ? (const char*)g.A + (size_t)nxt.pm * tstep : cA; const char* nB = has_next ? (const char*)g.Bt + (size_t)nxt.pn * tstep : cB;
        for (int t = 0; t < nt; t += 2) {
            const bool last = (t == nt - 2);
            const char* a1 = cA + (size_t)(t + 1) * kstep;
            const char* a2 = last ? nA : cA + (size_t)(t + 2) * kstep; const char* b2 = last ? nB : cB + (size_t)(t + 2) * kstep;
            const char* a3 = a2 + kstep; const char* b3 = b2 + kstep;
            if (last && has_next) S.a_ready(nxt);
            if constexpr (SP2) {
            PG8_LDB(B0, 0, 0); PG8_LDB(B1, 0, 1); PG8_SCHED; PG8_LDA(At, 0, 0); PG8_STAGE(PG8_SA(1, 1), a1 + hstep, voffA);
            PG8_WAIT_V(8); PG8_WAIT_L(0); PG8_BAR; PG8_MMA(0, 0, At, B0); PG8_MMA(0, 1, At, B1); PG8_BAR; PG8_SCHED;
            PG8_LDA(At, 0, 1); PG8_STAGE(PG8_SB(0, 0), b2, voffB); PG8_STAGE(PG8_SB(0, 1), b2 + hstep, voffB); PG8_STAGE(PG8_SA(0, 0), a2, voffA);
            PG8_WAIT_V(8); PG8_WAIT_L(0); PG8_BAR; PG8_MMA(1, 0, At, B0); PG8_MMA(1, 1, At, B1); PG8_BAR; PG8_SCHED;
            PG8_LDB(B0, 1, 0); PG8_LDB(B1, 1, 1); PG8_SCHED; PG8_LDA(At, 1, 0); PG8_STAGE(PG8_SA(0, 1), a2 + hstep, voffA);
            PG8_WAIT_V(8); PG8_WAIT_L(0); PG8_BAR; PG8_MMA(0, 0, At, B0); PG8_MMA(0, 1, At, B1); PG8_BAR; PG8_SCHED;
            PG8_LDA(At, 1, 1); PG8_STAGE(PG8_SB(1, 0), b3, voffB); PG8_STAGE(PG8_SB(1, 1), b3 + hstep, voffB); PG8_STAGE(PG8_SA(1, 0), a3, voffA);
            PG8_WAIT_V(8); PG8_WAIT_L(0); PG8_BAR; PG8_MMA(1, 0, At, B0); PG8_MMA(1, 1, At, B1); PG8_BAR; PG8_SCHED;
            } else {
            PG8_LDB(B0, 0, 0); PG8_SCHED; PG8_LDA(At, 0, 0); PG8_STAGE(PG8_SA(1, 1), a1 + hstep, voffA);
            PG8_WAIT_L(8); PG8_BAR; PG8_WAIT_L(0); PG8_MMA(0, 0, At, B0); PG8_BAR; PG8_SCHED;
            PG8_LDB(B1, 0, 1); PG8_STAGE(PG8_SB(0, 0), b2, voffB);
            PG8_BAR; PG8_WAIT_L(0); PG8_MMA(0, 1, At, B1); PG8_BAR;
            PG8_LDA(At, 0, 1); PG8_STAGE(PG8_SA(0, 0), a2, voffA);
            PG8_BAR; PG8_WAIT_L(0); PG8_MMA(1, 0, At, B0); PG8_BAR; PG8_SCHED;
            PG8_STAGE(PG8_SB(0, 1), b2 + hstep, voffB);
            PG8_WAIT_V(6); PG8_BAR; PG8_MMA(1, 1, At, B1); PG8_BAR;
            PG8_LDB(B0, 1, 0); PG8_SCHED; PG8_LDA(At, 1, 0); PG8_STAGE(PG8_SA(0, 1), a2 + hstep, voffA);
            PG8_WAIT_L(8); PG8_BAR; PG8_WAIT_L(0); PG8_MMA(0, 0, At, B0); PG8_BAR; PG8_SCHED;
            PG8_LDB(B1, 1, 1); PG8_STAGE(PG8_SB(1, 0), b3, voffB);
            PG8_BAR; PG8_WAIT_L(0); PG8_MMA(0, 1, At, B1); PG8_BAR;
            PG8_LDA(At, 1, 1); PG8_STAGE(PG8_SA(1, 0), a3, voffA);
            PG8_BAR; PG8_WAIT_L(0); PG8_MMA(1, 0, At, B0); PG8_BAR; PG8_SCHED;
            PG8_STAGE(PG8_SB(1, 1), b3 + hstep, voffB);
            PG8_WAIT_V(6); PG8_BAR; PG8_MMA(1, 1, At, B1); PG8_BAR;
            }
        }
        if constexpr (ALIGN_EPI) { if (wr == 0) PG8_BAR; }
        if constexpr (FP8SCALE != 0) asm volatile("s_nop 15\n\ts_nop 15" ::: "memory");
        if constexpr (!Epi::AFTER_DRAIN) { E(acc, cur, wr, wc, fr, fq); S.done(cur); }
        if (!has_next) break;
#pragma unroll
        for (int a = 0; a < 2; ++a)
#pragma unroll
            for (int b = 0; b < 2; ++b)
#pragma unroll
                for (int m = 0; m < 4; ++m)
#pragma unroll
                    for (int n = 0; n < 2; ++n) acc[a][b][m][n] = (f32x4){0.f, 0.f, 0.f, 0.f};
        cur = nxt; cA = nA; cB = nB; ++ui;
        if constexpr (ALIGN_EPI) { if (wr == 1) PG8_BAR; }
    }
    PG8_WAIT_V(0);
    if constexpr (!ALIGN_EPI) { if (wr == 0) PG8_BAR; }
    PG8_BAR;
    if constexpr (Epi::AFTER_DRAIN) { E.fused(acc, cur, wr, wc, fr, fq, lds, wid, lane); S.done(cur); }
#undef PG8_SA
#undef PG8_SB
#undef PG8_STAGE
#undef PG8_LDA
#undef PG8_LDB
#undef PG8_MMA
#undef PG8_WAIT_V
#undef PG8_WAIT_L
#undef PG8_BAR
#undef PG8_SCHED
}
}

#define LAS __attribute__((address_space(3)))
typedef unsigned short bf16_t;
typedef float f32x4 __attribute__((ext_vector_type(4)));
typedef float f32x2 __attribute__((ext_vector_type(2)));
typedef unsigned u32x4 __attribute__((ext_vector_type(4)));
typedef unsigned u32x2 __attribute__((ext_vector_type(2)));
typedef short bf16x8 __attribute__((ext_vector_type(8)));

constexpr int NB = 8, SEQ = 2048, CTXL = 256, D = 1024;
constexpr int RL = NB * SEQ, RC = NB * CTXL, RT = RL + RC;
constexpr int NE = 16, DE = 2816, CAPL = 256, CAPC = 32;
constexpr int RPE0 = NB * CAPL + NB * CAPC, RPE1 = NB * CAPL;
constexpr int NWAVES = 8, NTHREADS = 512;
constexpr float EPS = 1e-6f;
constexpr float QSCALE = 0.125f * 1.4426950408889634f;
constexpr float LAMBDA_INIT0 = 0.2f;
constexpr int M_SH1 = 0, M_SC1 = 1024, M_G1 = 2048, M_SH2 = 3072, M_SC2 = 4096, M_G2 = 5120;
constexpr int SCH = 64, NCH = (CTXL + SEQ) / SCH, NCH_CTX = CTXL / SCH;

constexpr size_t MiB = 1u << 20;
constexpr size_t WS_CTL = 0, CTL_ZERO_BYTES = 32768;
constexpr size_t WS_GTAB = 2 * MiB + 65536;
constexpr size_t WS_MOD = 1 * MiB, WS_ROPE = 2 * MiB, WS_PROBS = 3 * MiB, WS_GATE = 5 * MiB, WS_SEL = 6 * MiB, WS_CP = 8 * MiB, WS_CB = 11 * MiB;
constexpr size_t WS_WQKV = 16 * MiB, WS_WO = 22 * MiB, WS_WIN = 24 * MiB, WS_WOUT = 28 * MiB, WS_WG = 30 * MiB;
constexpr size_t WS_XN = 32 * MiB, WS_Q = 68 * MiB, WS_K = 104 * MiB, WS_V = 140 * MiB, WS_ATT = 176 * MiB, WS_H = 212 * MiB;
constexpr size_t WS_XG = 284 * MiB, WS_Y = 356 * MiB, WS_ACT = 428 * MiB, WS_WGU = 626 * MiB, WS_WDN = 978 * MiB;
constexpr size_t WS_YG = 68 * MiB, WS_XR = 104 * MiB, WS_HS = 140 * MiB;
constexpr size_t WS_LOGA = 1154 * MiB, WS_BT = 1226 * MiB;
constexpr size_t WS_TMPF = 1298 * MiB, WS_XC = 2090 * MiB, WS_END = 2126 * MiB;
constexpr size_t WGU_LAYER = (size_t)NE * 2 * DE * D * 2, WDN_LAYER = (size_t)NE * D * DE * 2;
constexpr int CW_BAR = 4096;

constexpr int LDS_BYTES = 147456;
constexpr int MISC_OFF = 131072 + 320;

struct Args { const float* in[27]; float* out; unsigned char* ws; int ph_lo, ph_hi; };
constexpr int ROPE_LDS = 131072 + 1024;
constexpr int ARGS_OFF = 131072 + 512;
struct Ctx {
    const LAS unsigned* la;
    __device__ __forceinline__ unsigned long long ld(int i) const { const unsigned lo = __builtin_amdgcn_readfirstlane(la[2 * i]), hi = __builtin_amdgcn_readfirstlane(la[2 * i + 1]); return ((unsigned long long)hi << 32) | lo; }
    __device__ __forceinline__ const float* in(int i) const { return (const float*)(const __attribute__((address_space(1))) float*)ld(i); }
    __device__ __forceinline__ float* out() const { return (float*)(__attribute__((address_space(1))) float*)ld(27); }
    __device__ __forceinline__ unsigned char* ws() const { return (unsigned char*)(__attribute__((address_space(1))) unsigned char*)ld(28); }
};

enum { I_X = 0, I_C, I_CTX, I_CCTX, I_ADAW, I_ADAB, I_N1G, I_N2G, I_FG, I_WQKV, I_LQ1, I_LK1, I_LQ2, I_LK2, I_SUBG, I_WO, I_WIN, I_BIN, I_CONVW, I_CONVB, I_WGATES, I_BGATES, I_LAM, I_WOUT, I_WR, I_WGU, I_WDN };

__device__ __forceinline__ float bf_lo(unsigned w) { return __uint_as_float(w << 16); }
__device__ __forceinline__ float bf_hi(unsigned w) { return __uint_as_float(w & 0xffff0000u); }
__device__ __forceinline__ float bf2f(bf16_t b) { return __uint_as_float(((unsigned)b) << 16); }
__device__ __forceinline__ unsigned f2bf(float f) { unsigned u = __float_as_uint(f); return (u + 0x7fffu + ((u >> 16) & 1u)) >> 16; }
__device__ __forceinline__ unsigned pk2(float lo, float hi) { unsigned r; asm("v_cvt_pk_bf16_f32 %0, %1, %2" : "=v"(r) : "v"(lo), "v"(hi)); return r; }
#ifndef EPI_WT
#define EPI_WT 0
#endif
__device__ __forceinline__ void st16_wt(void* p, u32x4 v) {
#if EPI_WT
    asm volatile("global_store_dwordx4 %0, %1, off sc1" :: "v"(p), "v"(v) : "memory");
#else
    *(u32x4*)p = v;
#endif
}
__device__ __forceinline__ void st8_wt(void* p, u32x2 v) {
#if EPI_WT
    asm volatile("global_store_dwordx2 %0, %1, off sc1" :: "v"(p), "v"(v) : "memory");
#else
    *(u32x2*)p = v;
#endif
}
__device__ __forceinline__ float wave_sum(float v) {
#pragma unroll
    for (int o = 1; o < 64; o <<= 1) v += __shfl_xor(v, o);
    return v;
}
__device__ __forceinline__ float wave_max(float v) {
#pragma unroll
    for (int o = 1; o < 64; o <<= 1) v = fmaxf(v, __shfl_xor(v, o));
    return v;
}
__device__ __forceinline__ float sigmoidf_(float x) { return 1.f / (1.f + expf(-x)); }
__device__ __forceinline__ float gelu_tanh(float x) { const float u = 0.7978845608028654f * (x + 0.044715f * x * x * x); return x / (1.f + expf(-2.f * u)); }
__device__ __forceinline__ const float* mod_ptr(const Ctx& a, int layer, int r) { return (const float*)(a.ws() + WS_MOD) + (size_t)(layer * 9 + r) * 6144; }
__device__ __forceinline__ int mod_row(int row) { return row < RL ? (row >> 11) : 8; }

__device__ __forceinline__ void load_row(const float* p, int lane, f32x4 (&v)[4]) {
#pragma unroll
    for (int j = 0; j < 4; ++j) v[j] = *(const f32x4*)(p + 4 * lane + 256 * j);
}
__device__ __forceinline__ void load_row_bf16(const bf16_t* p, int lane, f32x4 (&v)[4]) {
#pragma unroll
    for (int j = 0; j < 4; ++j) { const u32x2 w = *(const u32x2*)(p + 4 * lane + 256 * j); v[j] = (f32x4){bf_lo(w.x), bf_hi(w.x), bf_lo(w.y), bf_hi(w.y)}; }
}
__device__ __forceinline__ void store_row_f32(float* p, int lane, const f32x4 (&v)[4]) {
#pragma unroll
    for (int j = 0; j < 4; ++j) *(f32x4*)(p + 4 * lane + 256 * j) = v[j];
}
__device__ __forceinline__ void store_row_bf16(bf16_t* p, int lane, const f32x4 (&v)[4]) {
#pragma unroll
    for (int j = 0; j < 4; ++j) { u32x2 w; w.x = pk2(v[j].x, v[j].y); w.y = pk2(v[j].z, v[j].w); *(u32x2*)(p + 4 * lane + 256 * j) = w; }
}
__device__ __forceinline__ void store_row_fp8(unsigned char* p, int lane, const f32x4 (&v)[4]) {
#pragma unroll
    for (int j = 0; j < 4; ++j) *(unsigned*)(p + 4 * lane + 256 * j) = __builtin_amdgcn_cvt_pk_fp8_f32(v[j].z, v[j].w, __builtin_amdgcn_cvt_pk_fp8_f32(v[j].x, v[j].y, 0u, false), true);
}
__device__ __forceinline__ void rms_mod(f32x4 (&v)[4], const float* g, const float* sh, const float* sc, int lane) {
    float ss = 0.f;
#pragma unroll
    for (int j = 0; j < 4; ++j) ss += (v[j].x * v[j].x + v[j].y * v[j].y) + (v[j].z * v[j].z + v[j].w * v[j].w);
    ss = wave_sum(ss);
    const float rstd = 1.0f / sqrtf(ss * (1.0f / D) + EPS);
#pragma unroll
    for (int j = 0; j < 4; ++j) {
        const int k = 4 * lane + 256 * j;
        const f32x4 gg = *(const f32x4*)(g + k);
        f32x4 y = v[j] * rstd * gg;
        if (sh) { const f32x4 s1 = *(const f32x4*)(sc + k), s0 = *(const f32x4*)(sh + k); y = y * (1.0f + s1) + s0; }
        v[j] = y;
    }
}

template <class F>
__device__ __forceinline__ void naive_tile(const bf16_t* A, int lda, const float* W, int ldw, int K, LAS unsigned char* lds, F f) {
    LAS float* As = (LAS float*)lds;
    LAS float* Bs = (LAS float*)(lds + 16 * 132 * 4);
    const int tid = threadIdx.x, ty = tid >> 4, tx = tid & 15;
    const int ar = tid >> 2, akq = tid & 3, bk = tid >> 5, bc = (tid & 31) * 2;
    float acc[4][4];
#pragma unroll
    for (int i = 0; i < 4; ++i)
#pragma unroll
        for (int j = 0; j < 4; ++j) acc[i][j] = 0.f;
    for (int k0 = 0; k0 < K; k0 += 16) {
        const u32x2 av = *(const u32x2*)(A + (size_t)ar * lda + k0 + akq * 4);
        const f32x2 bv = *(const f32x2*)(W + (size_t)(k0 + bk) * ldw + bc);
        __syncthreads();
        As[(akq * 4 + 0) * 132 + ar] = bf_lo(av.x); As[(akq * 4 + 1) * 132 + ar] = bf_hi(av.x);
        As[(akq * 4 + 2) * 132 + ar] = bf_lo(av.y); As[(akq * 4 + 3) * 132 + ar] = bf_hi(av.y);
        Bs[bk * 64 + bc] = bv.x; Bs[bk * 64 + bc + 1] = bv.y;
        __syncthreads();
#pragma unroll
        for (int kk = 0; kk < 16; ++kk) {
            const f32x4 a4 = *(const LAS f32x4*)(As + kk * 132 + ty * 4);
            const f32x4 b4 = *(const LAS f32x4*)(Bs + kk * 64 + tx * 4);
#pragma unroll
            for (int i = 0; i < 4; ++i)
#pragma unroll
                for (int j = 0; j < 4; ++j) acc[i][j] += a4[i] * b4[j];
        }
    }
#pragma unroll
    for (int i = 0; i < 4; ++i)
#pragma unroll
        for (int j = 0; j < 4; ++j) f(ty * 4 + i, tx * 4 + j, acc[i][j]);
    __syncthreads();
}

__device__ __forceinline__ void cvt_item(const float* W, int N, int k0, int n0, bf16_t* dst, int Kd, int gu_perm) {
    const int tid = threadIdx.x, lane = tid & 63, wave = tid >> 6;
    const float* p = W + (size_t)(k0 + 8 * wave) * N + n0 + 4 * lane;
    f32x4 v[8];
#pragma unroll
    for (int i = 0; i < 8; ++i) v[i] = *(const f32x4*)(p + (size_t)i * N);
#pragma unroll
    for (int j = 0; j < 4; ++j) {
        const int n = n0 + 4 * lane + j;
        const int row = gu_perm ? (((n % DE) >> 7) * 256 + (n / DE) * 128 + (n & 127)) : n;
        u32x4 o; o.x = pk2(v[0][j], v[1][j]); o.y = pk2(v[2][j], v[3][j]); o.z = pk2(v[4][j], v[5][j]); o.w = pk2(v[6][j], v[7][j]);
        *(u32x4*)(dst + (size_t)row * Kd + k0 + 8 * wave) = o;
    }
}
__device__ __forceinline__ unsigned pk4_fp8(float a, float b, float c, float d) { unsigned w = __builtin_amdgcn_cvt_pk_fp8_f32(a, b, 0u, false); return __builtin_amdgcn_cvt_pk_fp8_f32(c, d, w, true); }
constexpr float BT_SCALE = 64.0f, Y_SCALE = 16.0f;
constexpr float WGU_SCALE = 32.0f, WDN_SCALE = 64.0f;
__device__ __forceinline__ void cvt8_load(const float* W, int N, int k0, int n0, f32x4 (&v)[16]) {
    const int tid = threadIdx.x, lane = tid & 63, wave = tid >> 6;
    const float* p = W + (size_t)(k0 + 16 * wave) * N + n0 + 4 * lane;
#pragma unroll
    for (int i = 0; i < 16; ++i) v[i] = __builtin_nontemporal_load((const f32x4*)(p + (size_t)i * N));
}
__device__ __forceinline__ void cvt8_store(const f32x4 (&v)[16], int k0, int n0, unsigned char* dst, int Kd, int gu_perm, float scale, LAS unsigned char* T) {
    const int tid = threadIdx.x, lane = tid & 63, wave = tid >> 6;
#pragma unroll
    for (int j = 0; j < 4; ++j) {
        const int n = 4 * lane + j;
        u32x4 o;
        o.x = pk4_fp8(v[0][j] * scale, v[1][j] * scale, v[2][j] * scale, v[3][j] * scale); o.y = pk4_fp8(v[4][j] * scale, v[5][j] * scale, v[6][j] * scale, v[7][j] * scale);
        o.z = pk4_fp8(v[8][j] * scale, v[9][j] * scale, v[10][j] * scale, v[11][j] * scale); o.w = pk4_fp8(v[12][j] * scale, v[13][j] * scale, v[14][j] * scale, v[15][j] * scale);
        *(LAS u32x4*)(T + n * 128 + ((wave ^ (lane & 7)) << 4)) = o;
    }
    asm volatile("s_waitcnt lgkmcnt(0)" ::: "memory"); __builtin_amdgcn_s_barrier(); asm volatile("" ::: "memory");
#pragma unroll
    for (int i = 0; i < 4; ++i) {
        const int p = tid + NTHREADS * i, n = p >> 3, c = p & 7;
        const u32x4 x = *(const LAS u32x4*)(T + n * 128 + ((c ^ ((n >> 2) & 7)) << 4));
        const int ng = n0 + n;
        const int row = gu_perm ? (((ng % DE) >> 7) * 256 + (ng / DE) * 128 + (ng & 127)) : ng;
        __builtin_nontemporal_store(x, (u32x4*)(dst + (size_t)row * Kd + k0 + 16 * c));
    }
}
constexpr int CV_GU = NE * 8 * 22, CV_DN = NE * 22 * 4, CV_ITEMS = CV_GU + CV_DN;
struct CvItem { const float* W; unsigned char* dst; int N, Kd, k0, n0, perm; float scale; };
__device__ __forceinline__ CvItem cv_decode(const float* wgu, const float* wdn, unsigned char* ws, int layer, int it) {
    CvItem c;
    if (it < CV_GU) { const int e = it / 176, q = it % 176, le = layer * NE + e; c.W = wgu + (size_t)le * D * 2 * DE; c.dst = ws + WS_WGU + (size_t)le * 2 * DE * D; c.N = 2 * DE; c.Kd = D; c.k0 = (q / 22) * 128; c.n0 = (q % 22) * 256; c.perm = 1; c.scale = WGU_SCALE; }
    else { const int r = it - CV_GU, e = r / 88, q = r % 88, le = layer * NE + e; c.W = wdn + (size_t)le * DE * D; c.dst = ws + WS_WDN + (size_t)le * D * DE; c.N = D; c.Kd = DE; c.k0 = (q / 4) * 128; c.n0 = (q % 4) * 256; c.perm = 0; c.scale = WDN_SCALE; }
    return c;
}
__device__ __forceinline__ void cvt8_run(const Ctx& a, int layer, int first, int stride, int end, LAS unsigned char* lds) {
    const float* wgu = a.in(I_WGU); const float* wdn = a.in(I_WDN); unsigned char* ws = a.ws();
    f32x4 va[16], vb[16];
    int it = first;
    if (it < end) { const CvItem c = cv_decode(wgu, wdn, ws, layer, it); cvt8_load(c.W, c.N, c.k0, c.n0, va); }
    while (it < end) {
        int nx = it + stride;
        if (nx < end) { const CvItem c = cv_decode(wgu, wdn, ws, layer, nx); cvt8_load(c.W, c.N, c.k0, c.n0, vb); }
        { const CvItem c = cv_decode(wgu, wdn, ws, layer, it); cvt8_store(va, c.k0, c.n0, c.dst, c.Kd, c.perm, c.scale, lds); }
        it = nx; if (it >= end) break;
        nx = it + stride;
        if (nx < end) { const CvItem c = cv_decode(wgu, wdn, ws, layer, nx); cvt8_load(c.W, c.N, c.k0, c.n0, va); }
        { const CvItem c = cv_decode(wgu, wdn, ws, layer, it); cvt8_store(vb, c.k0, c.n0, c.dst, c.Kd, c.perm, c.scale, lds + 32768); }
        it = nx;
    }
    __syncthreads();
}
#ifndef CVT_HIDE
#define CVT_HIDE 1
#endif
#ifndef CVT_DEDICATED
#define CVT_DEDICATED 0
#endif
#ifndef CVQ_QKV
#define CVQ_QKV 1280
#endif
#ifndef CVQ_WO
#define CVQ_WO 896
#endif
#ifndef CVQ_GU0
#define CVQ_GU0 480
#endif
#ifndef CVQ_DN0
#define CVQ_DN0 960
#endif
#ifndef CVQ_WIN
#define CVQ_WIN 896
#endif
#ifndef CVQ_GATES
#define CVQ_GATES 1120
#endif
#ifndef CVQ_ATT
#define CVQ_ATT 256
#endif
#ifndef CVQ_TK1
#define CVQ_TK1 512
#endif
constexpr int CV0_QKV = 0, CV0_WO = CV0_QKV + CVQ_QKV, CV0_ATT = CV0_WO + CVQ_WO, CV0_PRO = CVT_HIDE ? CV0_ATT + CVQ_ATT : 0;
constexpr int CV1_GU0 = 0, CV1_DN0 = CV1_GU0 + CVQ_GU0, CV1_WIN = CV1_DN0 + CVQ_DN0, CV1_GATES = CV1_WIN + CVQ_WIN, CV1_TK = CV1_GATES + CVQ_GATES, CV1_PRO = CVT_HIDE ? CV1_TK + CVQ_TK1 : 0;
static_assert(CV0_PRO <= CV_ITEMS && CV1_PRO <= CV_ITEMS, "conversion schedule");
__device__ __forceinline__ void cvt8_tail(const Ctx& a, LAS unsigned char* lds, int units, int G, int c, int layer, int base, int count) {
#if CVT_HIDE && FP8_MOE
    const int R = (units + G - 1) / G, first_idle = units - (R - 1) * G;
    if (first_idle >= G || count <= 0 || c < first_idle) return;
    cvt8_run(a, layer, base + (c - first_idle), G - first_idle, base + count, lds);
#endif
}
__device__ __forceinline__ int gemm_groups(int units, int G) {
#if CVT_HIDE && FP8_MOE && CVT_DEDICATED
    const int R = (units + G - 1) / G; int gp = ((units + R - 1) / R + 7) & ~7;
    return gp < G ? gp : G;
#else
    return G;
#endif
}
#ifndef DENSE_LATE
#define DENSE_LATE 1
#endif
constexpr int IT_DENSE_REST = 16 * 4 + 16 * 8 + 16 * 4 + 32;
__device__ __forceinline__ void cvt_dense_rest_item(const Ctx& a, int r) {
    constexpr int IT_WO = 16 * 4, IT_WIN = 16 * 8, IT_WOUT = 16 * 4;
    if (r < IT_WO) { cvt_item(a.in(I_WO), D, (r / 4) * 64, (r % 4) * 256, (bf16_t*)(a.ws() + WS_WO), D, 0); return; }
    r -= IT_WO;
    if (r < IT_WIN) { cvt_item(a.in(I_WIN), 2 * D, (r / 8) * 64, (r % 8) * 256, (bf16_t*)(a.ws() + WS_WIN), D, 0); return; }
    r -= IT_WIN;
    if (r < IT_WOUT) { cvt_item(a.in(I_WOUT), D, (r / 4) * 64, (r % 4) * 256, (bf16_t*)(a.ws() + WS_WOUT), D, 0); return; }
    r -= IT_WOUT;
    { const int m = r >> 1, kk = r & 1;
        cvt_item(a.in(I_WGATES) + (size_t)m * 128 * 256, 256, kk * 64, 0, (bf16_t*)(a.ws() + WS_WG) + (size_t)m * 256 * 128, 128, 0); }
}
__device__ __forceinline__ void ph_prologue(const Ctx& a, LAS unsigned char* lds) {
    const int tid = threadIdx.x, lane = tid & 63, wave = tid >> 6;
    if (blockIdx.x == gridDim.x - 1) {
        float* rope = (float*)(a.ws() + WS_ROPE);
        for (int i = tid; i < 1024; i += NTHREADS) { const int pos = i >> 4, f = i & 15; const float inv = powf(10000.0f, -(float)f / 16.0f); const float ang = (float)pos * inv; rope[i] = cosf(ang); rope[1024 + i] = sinf(ang); }
    }
    if (blockIdx.x == gridDim.x - 2 || gridDim.x == 1) {
        float* gt = (float*)(a.ws() + WS_GTAB); const float* lamp = a.in(I_LAM); const float* bgp = a.in(I_BGATES);
        for (int i = tid; i < 2 * D; i += NTHREADS) {
            const int d = i >> 10, ch = i & 1023, kb = ch >> 7, cc = ch & 127;
            const float cl = -8.0f * log1pf(expf(-lamp[i]));
            gt[(d * 4 + 0) * D + ch] = cl * 1.4426950408889634f; gt[(d * 4 + 1) * D + ch] = 2.0f * cl * 1.4426950408889634f;
            gt[(d * 4 + 2) * D + ch] = -1.4426950408889634f * bgp[(d * 8 + kb) * 256 + cc]; gt[(d * 4 + 3) * D + ch] = -1.4426950408889634f * bgp[(d * 8 + kb) * 256 + 128 + cc];
        }
    }
    for (int u = blockIdx.x; u < 192; u += gridDim.x) {
        LAS float* sl = (LAS float*)lds;
        LAS float* red = (LAS float*)(lds + 49152);
        const int layer = u / 96, n0 = (u % 96) * 64;
        for (int i = tid; i < 9 * 1024; i += NTHREADS) { const int r = i >> 10, k = i & 1023; const float v = r < 8 ? a.in(I_C)[r * 1024 + k] : a.in(I_CCTX)[k]; sl[k * 12 + r] = v / (1.f + expf(-v)); }
        __syncthreads();
        const float* W = a.in(I_ADAW) + (size_t)layer * 1024 * 6144 + n0 + lane;
        float acc[9];
#pragma unroll
        for (int r = 0; r < 9; ++r) acc[r] = 0.f;
#pragma unroll 32
        for (int k = wave * 128; k < wave * 128 + 128; ++k) {
            const float w = __builtin_nontemporal_load(W + (size_t)k * 6144);
            const f32x4 s0 = *(const LAS f32x4*)(sl + k * 12), s1 = *(const LAS f32x4*)(sl + k * 12 + 4); const float s8 = sl[k * 12 + 8];
            acc[0] += s0.x * w; acc[1] += s0.y * w; acc[2] += s0.z * w; acc[3] += s0.w * w;
            acc[4] += s1.x * w; acc[5] += s1.y * w; acc[6] += s1.z * w; acc[7] += s1.w * w; acc[8] += s8 * w;
        }
#pragma unroll
        for (int r = 0; r < 9; ++r) red[(wave * 9 + r) * 64 + lane] = acc[r];
        __syncthreads();
        float* MOD = (float*)(a.ws() + WS_MOD);
        for (int i = tid; i < 576; i += NTHREADS) {
            const int r = i >> 6, l = i & 63; float s = 0.f;
#pragma unroll
            for (int w = 0; w < 8; ++w) s += red[(w * 9 + r) * 64 + l];
            MOD[(size_t)(layer * 9 + r) * 6144 + n0 + l] = s + a.in(I_ADAB)[layer * 6144 + n0 + l];
        }
        __syncthreads();
    }
#if ANY_FAST_GEMM
    constexpr int IT_QKV = 16 * 12, IT_WO = 16 * 4, IT_WIN = 16 * 8, IT_WOUT = 16 * 4, IT_G = 32;
#if FP8_MOE
    cvt8_run(a, 0, CV0_PRO + (int)blockIdx.x, (int)gridDim.x, CV_ITEMS, lds);
    cvt8_run(a, 1, CV1_PRO + (int)blockIdx.x, (int)gridDim.x, CV_ITEMS, lds);
    constexpr int IT_GU = 0, IT_DN = 0;
#else
    constexpr int IT_GU1 = 16 * 22, IT_DN1 = 44 * 4;
    constexpr int IT_GU = 32 * IT_GU1, IT_DN = 32 * IT_DN1;
#endif
    constexpr int NITEMS = IT_GU + IT_DN + IT_QKV + ((DENSE_LATE && FAST_ATTN) ? 0 : IT_DENSE_REST);
    for (int it = blockIdx.x; it < NITEMS; it += gridDim.x) {
        int r = it;
#if !FP8_MOE
        if (r < IT_GU) { const int le = r / IT_GU1, q = r % IT_GU1;
            cvt_item(a.in(I_WGU) + (size_t)le * D * 2 * DE, 2 * DE, (q / 22) * 64, (q % 22) * 256, (bf16_t*)(a.ws() + WS_WGU) + (size_t)le * 2 * DE * D, D, 1); continue; }
        r -= IT_GU;
        if (r < IT_DN) { const int le = r / IT_DN1, q = r % IT_DN1;
            cvt_item(a.in(I_WDN) + (size_t)le * DE * D, D, (q / 4) * 64, (q % 4) * 256, (bf16_t*)(a.ws() + WS_WDN) + (size_t)le * D * DE, DE, 0); continue; }
#endif
        r -= IT_DN;
        if (r < IT_QKV) { cvt_item(a.in(I_WQKV), 3 * D, (r / 12) * 64, (r % 12) * 256, (bf16_t*)(a.ws() + WS_WQKV), D, 0); continue; }
        r -= IT_QKV;
#if !(DENSE_LATE && FAST_ATTN)
        cvt_dense_rest_item(a, r);
#endif
    }
#endif
}

__device__ __forceinline__ void ph_norm1_l0(const Ctx& a) {
    const int lane = threadIdx.x & 63, gw = blockIdx.x * NWAVES + (threadIdx.x >> 6), NGW = gridDim.x * NWAVES;
    unsigned char* ws = a.ws();
    bf16_t* XN = (bf16_t*)(ws + WS_XN); const float* X = a.in(I_X); const float* CX = a.in(I_CTX); const float* n1g = a.in(I_N1G);
    f32x4 v[4], nx[4];
    int row = gw;
    if (row < RT) load_row(row < RL ? X + (size_t)row * D : CX + (size_t)(row - RL) * D, lane, v);
    for (; row < RT; row += NGW) {
        const int rn = row + NGW;
        if (rn < RT) load_row(rn < RL ? X + (size_t)rn * D : CX + (size_t)(rn - RL) * D, lane, nx);
        const float* mp = (const float*)(ws + WS_MOD) + (size_t)mod_row(row) * 6144;
        rms_mod(v, n1g, mp + M_SH1, mp + M_SC1, lane);
        store_row_bf16(XN + (size_t)row * D, lane, v);
#pragma unroll
        for (int j = 0; j < 4; ++j) v[j] = nx[j];
    }
}
__device__ __forceinline__ float rs16(float (&s)[16], int lane) {
    float r8[8], r4[4], r2[2];
    const bool b5 = lane & 32, b4 = lane & 16, b3 = lane & 8, b2 = lane & 4;
#pragma unroll
    for (int i = 0; i < 8; ++i) { const float send = b5 ? s[i] : s[i + 8], keep = b5 ? s[i + 8] : s[i]; r8[i] = keep + __shfl_xor(send, 32); }
#pragma unroll
    for (int i = 0; i < 4; ++i) { const float send = b4 ? r8[i] : r8[i + 4], keep = b4 ? r8[i + 4] : r8[i]; r4[i] = keep + __shfl_xor(send, 16); }
#pragma unroll
    for (int i = 0; i < 2; ++i) { const float send = b3 ? r4[i] : r4[i + 2], keep = b3 ? r4[i + 2] : r4[i]; r2[i] = keep + __shfl_xor(send, 8); }
    float r = (b2 ? r2[1] : r2[0]) + __shfl_xor(b2 ? r2[0] : r2[1], 4);
    r += __shfl_xor(r, 2); r += __shfl_xor(r, 1);
    return r;
}
__device__ __forceinline__ void ph_norm2_router(const Ctx& a, LAS unsigned char* lds, int layer, int nrows) {
    const int tid = threadIdx.x, lane = tid & 63, gw = blockIdx.x * NWAVES + (tid >> 6), NGW = gridDim.x * NWAVES;
    LAS float* wrT = (LAS float*)lds;
    const float* wr = a.in(I_WR) + (size_t)layer * D * NE;
    for (int i = tid; i < D * NE; i += NTHREADS) wrT[(i & 15) * 1024 + (i >> 4)] = wr[i];
    __syncthreads();
    unsigned char* ws = a.ws();
    bf16_t* XN = (bf16_t*)(ws + WS_XN); const bf16_t* H = (const bf16_t*)(ws + WS_H);
    float* PL = (float*)(ws + WS_PROBS); float* PC = PL + NB * NE * SEQ;
    const float* n2g = a.in(I_N2G) + layer * D;
    const int elane = ((lane >> 5) & 1) * 8 + ((lane >> 4) & 1) * 4 + ((lane >> 3) & 1) * 2 + ((lane >> 2) & 1);
    f32x4 v0[4], v1[4], n0[4], n1[4];
    int p = gw;
    if (p < nrows / 2) { load_row_bf16(H + (size_t)(2 * p) * D, lane, v0); load_row_bf16(H + (size_t)(2 * p + 1) * D, lane, v1); }
    for (; p < nrows / 2; p += NGW) {
        const int pn = p + NGW;
        if (pn < nrows / 2) { load_row_bf16(H + (size_t)(2 * pn) * D, lane, n0); load_row_bf16(H + (size_t)(2 * pn + 1) * D, lane, n1); }
        const int row = 2 * p;
        const float* mp = (const float*)(ws + WS_MOD) + (size_t)(layer * 9 + mod_row(row)) * 6144;
        rms_mod(v0, n2g, mp + M_SH2, mp + M_SC2, lane); rms_mod(v1, n2g, mp + M_SH2, mp + M_SC2, lane);
#if FP8_MOE
        store_row_fp8((unsigned char*)XN + (size_t)row * D, lane, v0); store_row_fp8((unsigned char*)XN + (size_t)(row + 1) * D, lane, v1);
#else
        store_row_bf16(XN + (size_t)row * D, lane, v0); store_row_bf16(XN + (size_t)(row + 1) * D, lane, v1);
#endif
        float s0[16], s1[16];
#pragma unroll
        for (int e = 0; e < 16; ++e) {
            float a0 = 0.f, a1 = 0.f;
#pragma unroll
            for (int j = 0; j < 4; ++j) { const f32x4 w = *(const LAS f32x4*)(wrT + e * 1024 + 4 * lane + 256 * j);
                a0 += (v0[j].x * w.x + v0[j].y * w.y) + (v0[j].z * w.z + v0[j].w * w.w); a1 += (v1[j].x * w.x + v1[j].y * w.y) + (v1[j].z * w.z + v1[j].w * w.w); }
            s0[e] = a0; s1[e] = a1;
            if ((e & 3) == 3) asm volatile("" ::: "memory");
        }
        const float l0 = rs16(s0, lane), l1 = rs16(s1, lane);
        const float m0 = wave_max(l0), m1 = wave_max(l1);
        const float e0 = expf(l0 - m0), e1 = expf(l1 - m1);
        const float q0 = e0 / (wave_sum(e0) * 0.25f), q1 = e1 / (wave_sum(e1) * 0.25f);
        if ((lane & 3) == 0) {
            if (row < RL) { float* d = PL + ((size_t)(row >> 11) * NE + elane) * SEQ + (row & 2047); *(f32x2*)d = (f32x2){q0, q1}; }
            else { const int rc = row - RL; float* d = PC + ((size_t)(rc >> 8) * NE + elane) * CTXL + (rc & 255); *(f32x2*)d = (f32x2){q0, q1}; }
        }
#pragma unroll
        for (int j = 0; j < 4; ++j) { v0[j] = n0[j]; v1[j] = n1[j]; }
    }
    __syncthreads();
}
__device__ __forceinline__ void ph_topk_gather(const Ctx& a, LAS unsigned char* lds, int layer) {
    const int tid = threadIdx.x, lane = tid & 63, wave = tid >> 6;
    LAS int* idxl = (LAS int*)lds;
    LAS int* cnt = (LAS int*)(lds + 1024);
    unsigned char* ws = a.ws();
    const float* PL = (const float*)(ws + WS_PROBS); const float* PC = PL + NB * NE * SEQ;
    float* GATE = (float*)(ws + WS_GATE); int* SEL = (int*)(ws + WS_SEL);
    const bf16_t* XN = (const bf16_t*)(ws + WS_XN); bf16_t* XG = (bf16_t*)(ws + WS_XG);
    const int nunits = layer == 0 ? 256 : 128, rpe = layer == 0 ? RPE0 : RPE1;
    const unsigned long long lt = (1ull << lane) - 1ull;
    for (int u0 = blockIdx.x; u0 < nunits; u0 += gridDim.x) {
        const int u = layer == 0 ? ((u0 & 1) * 128 + (u0 >> 1)) : u0;
        const bool lat = u < 128; const int b = (u & 127) >> 4, e = u & 15;
        const int n = lat ? SEQ : CTXL, cap = lat ? CAPL : CAPC;
        const float* src = lat ? PL + ((size_t)b * NE + e) * SEQ : PC + ((size_t)b * NE + e) * CTXL;
        const int rowbase = lat ? b * SEQ : RL + b * CTXL;
        const int xgbase = e * rpe + (lat ? b * CAPL : NB * CAPL + b * CAPC);
        unsigned v[4];
#pragma unroll
        for (int i = 0; i < 4; ++i) { const int t = wave * 256 + i * 64 + lane; v[i] = t < n ? __float_as_uint(src[t]) : 0u; }
        unsigned prefix = 0u;
#pragma unroll 1
        for (int bit = 30; bit >= 0; --bit) {
            const unsigned cand = prefix | (1u << bit); int c = 0;
#pragma unroll
            for (int i = 0; i < 4; ++i) c += __popcll(__ballot(v[i] >= cand));
            LAS int* slot = cnt + (bit & 1) * 8;
            if (lane == 0) slot[wave] = c;
            __syncthreads();
            int tot = 0;
#pragma unroll
            for (int w = 0; w < 8; ++w) tot += slot[w];
            if (tot >= cap) prefix = cand;
        }
        int mg = 0, me = 0;
#pragma unroll
        for (int i = 0; i < 4; ++i) { mg += __popcll(__ballot(v[i] > prefix)); me += __popcll(__ballot(v[i] == prefix)); }
        if (lane == 0) { cnt[16 + wave] = mg; cnt[24 + wave] = me; }
        __syncthreads();
        int tg = 0, eqb = 0;
#pragma unroll
        for (int w = 0; w < 8; ++w) { tg += cnt[16 + w]; eqb += (w < wave) ? cnt[24 + w] : 0; }
        const int need = cap - tg;
        bool sel[4]; int ms = 0, eqseen = eqb;
#pragma unroll
        for (int i = 0; i < 4; ++i) {
            const bool gt = v[i] > prefix, eq = v[i] == prefix;
            const unsigned long long meq = __ballot(eq);
            sel[i] = gt || (eq && (eqseen + __popcll(meq & lt)) < need);
            ms += __popcll(__ballot(sel[i])); eqseen += __popcll(meq);
        }
        if (lane == 0) cnt[32 + wave] = ms;
        __syncthreads();
        int slotbase = 0;
#pragma unroll
        for (int w = 0; w < 8; ++w) slotbase += (w < wave) ? cnt[32 + w] : 0;
#pragma unroll
        for (int i = 0; i < 4; ++i) {
            const unsigned long long msel = __ballot(sel[i]);
            const int slot = slotbase + __popcll(msel & lt), t = wave * 256 + i * 64 + lane;
            if (t < n) SEL[(size_t)(rowbase + t) * NE + e] = sel[i] ? slot : -1;
            if (sel[i]) { idxl[slot] = t; GATE[xgbase + slot] = __uint_as_float(v[i]); }
            slotbase += __popcll(msel);
        }
        __syncthreads();
        for (int slot = wave; slot < cap; slot += NWAVES) {
            const int t = idxl[slot];
#if FP8_MOE
            ((u32x4*)((unsigned char*)XG + (size_t)(xgbase + slot) * D))[lane] = ((const u32x4*)((const unsigned char*)XN + (size_t)(rowbase + t) * D))[lane];
#else
            const u32x4* s = (const u32x4*)(XN + (size_t)(rowbase + t) * D);
            u32x4* d = (u32x4*)(XG + (size_t)(xgbase + slot) * D);
            d[lane] = s[lane]; d[lane + 64] = s[lane + 64];
#endif
        }
        __syncthreads();
    }
#if CVT_HIDE && FP8_MOE
    if (layer == 1 && (int)blockIdx.x >= 128 && (int)gridDim.x > 128)
        cvt8_run(a, 1, CV1_TK + ((int)blockIdx.x - 128), (int)gridDim.x - 128, CV1_TK + CVQ_TK1, lds);
#endif
}
template <int MODE>
__device__ __forceinline__ void ph_combine(const Ctx& a, int layer, int nrows) {
    const int lane = threadIdx.x & 63, gw = blockIdx.x * NWAVES + (threadIdx.x >> 6), NGW = gridDim.x * NWAVES;
    bf16_t* H = (bf16_t*)(a.ws() + WS_H); const int* SEL = (const int*)(a.ws() + WS_SEL); const unsigned char* Y = a.ws() + WS_Y;
    const float* GATE = (const float*)(a.ws() + WS_GATE);
    bf16_t* XN = (bf16_t*)(a.ws() + WS_XN);
    const int rpe = layer == 0 ? RPE0 : RPE1;
    f32x4 v[4], vn[4]; int sel = -1, seln = -1;
    if (gw < nrows) { load_row_bf16(H + (size_t)gw * D, lane, v); sel = SEL[(size_t)gw * NE + (lane & 15)]; }
    for (int row = gw; row < nrows; row += NGW) {
        const int rnx = row + NGW;
        if (rnx < nrows) { load_row_bf16(H + (size_t)rnx * D, lane, vn); seln = SEL[(size_t)rnx * NE + (lane & 15)]; }
        const int mr = mod_row(row);
        const float* mp = mod_ptr(a, layer, mr);
        const int off = row < RL ? (row >> 11) * CAPL : NB * CAPL + ((row - RL) >> 8) * CAPC;
        f32x4 acc[4];
#pragma unroll
        for (int j = 0; j < 4; ++j) acc[j] = (f32x4){0.f, 0.f, 0.f, 0.f};
        unsigned mask = (unsigned)(__ballot(sel >= 0) & 0xffffull);
        int yw[4][4]; float gk[4];
#pragma unroll
        for (int k = 0; k < 4; ++k) {
            const bool on = mask != 0u; const int e = on ? __builtin_ctz(mask) : 0; mask = on ? (mask & (mask - 1u)) : 0u;
            const int sidx = __builtin_amdgcn_readlane(sel, e);
            const int yrow = on ? (e * rpe + off + sidx) : 0;
            const unsigned char* yr = Y + (size_t)yrow * D;
            gk[k] = on ? GATE[yrow] : 0.f;
#pragma unroll
            for (int j = 0; j < 4; ++j) { const int w = __builtin_nontemporal_load((const int*)(yr + 4 * lane + 256 * j)); yw[k][j] = on ? w : 0; }
        }
#pragma unroll
        for (int k = 0; k < 4; ++k)
#pragma unroll
            for (int j = 0; j < 4; ++j) { const f32x2 lo = __builtin_amdgcn_cvt_pk_f32_fp8(yw[k][j], false), hi2 = __builtin_amdgcn_cvt_pk_f32_fp8(yw[k][j], true);
                acc[j].x += gk[k] * lo.x; acc[j].y += gk[k] * lo.y; acc[j].z += gk[k] * hi2.x; acc[j].w += gk[k] * hi2.y; }
        while (mask != 0u) {
            const int e = __builtin_ctz(mask); mask &= mask - 1u;
            const int sidx = __builtin_amdgcn_readlane(sel, e);
            const int yrow = e * rpe + off + sidx; const float g1 = GATE[yrow];
            const unsigned char* yr = Y + (size_t)yrow * D;
#pragma unroll
            for (int j = 0; j < 4; ++j) { const int w = *(const int*)(yr + 4 * lane + 256 * j); const f32x2 lo = __builtin_amdgcn_cvt_pk_f32_fp8(w, false), hi2 = __builtin_amdgcn_cvt_pk_f32_fp8(w, true);
                acc[j].x += g1 * lo.x; acc[j].y += g1 * lo.y; acc[j].z += g1 * hi2.x; acc[j].w += g1 * hi2.y; }
        }
#pragma unroll
        for (int j = 0; j < 4; ++j) { const f32x4 g2 = *(const f32x4*)(mp + M_G2 + 4 * lane + 256 * j); v[j] = v[j] + g2 * (acc[j] * (1.0f / Y_SCALE)); }
        if (MODE == 0) {
            store_row_bf16(H + (size_t)row * D, lane, v);
            const float* mp1 = mod_ptr(a, 1, mr);
            rms_mod(v, a.in(I_N1G) + D, mp1 + M_SH1, mp1 + M_SC1, lane);
            store_row_bf16(XN + (size_t)row * D, lane, v);
        } else {
            rms_mod(v, a.in(I_FG), nullptr, nullptr, lane);
            { float* po = a.out() + (size_t)row * D;
#pragma unroll
              for (int j = 0; j < 4; ++j) __builtin_nontemporal_store(v[j], (f32x4*)(po + 4 * lane + 256 * j)); }
        }
#pragma unroll
        for (int j = 0; j < 4; ++j) v[j] = vn[j];
        sel = seln;
    }
}

__device__ __forceinline__ void ph_qkv_naive(const Ctx& a, LAS unsigned char* lds) {
    const bf16_t* XN = (const bf16_t*)(a.ws() + WS_XN); float* T = (float*)(a.ws() + WS_TMPF);
    for (int t = blockIdx.x; t < (RT / 128) * 48; t += gridDim.x) {
        const int tm = t / 48, tn = t % 48;
        naive_tile(XN + (size_t)tm * 128 * D, D, a.in(I_WQKV) + tn * 64, 3 * D, D, lds,
                   [&](int r, int c, float v) { T[(size_t)(tm * 128 + r) * 3072 + tn * 64 + c] = v; });
    }
}
__device__ __forceinline__ void ph_rope_naive(const Ctx& a) {
    const float* T = (const float*)(a.ws() + WS_TMPF); const float* rope = (const float*)(a.ws() + WS_ROPE);
    bf16_t* Q = (bf16_t*)(a.ws() + WS_Q); bf16_t* Kb = (bf16_t*)(a.ws() + WS_K); bf16_t* V = (bf16_t*)(a.ws() + WS_V);
    const size_t total = (size_t)RT * 3072, nth = (size_t)gridDim.x * NTHREADS;
    for (size_t i = (size_t)blockIdx.x * NTHREADS + threadIdx.x; i < total; i += nth) {
        const int row = (int)(i / 3072), c = (int)(i % 3072);
        if (c >= 2048) { V[(size_t)row * D + (c - 2048)] = (bf16_t)f2bf(T[i]); continue; }
        const int d = c & 63; if ((d & 31) >= 16) continue;
        float x1 = T[i], x2 = T[i + 16];
        if (row < RL) {
            const int t = row & 2047, axis = d >> 5, f = d & 15, pos = axis == 0 ? (t >> 6) : (t & 63);
            const float cs = rope[pos * 16 + f], sn = rope[1024 + pos * 16 + f];
            const float o1 = x1 * cs - x2 * sn, o2 = x2 * cs + x1 * sn; x1 = o1; x2 = o2;
        }
        if (c < 1024) { Q[(size_t)row * D + c] = (bf16_t)f2bf(x1 * QSCALE); Q[(size_t)row * D + c + 16] = (bf16_t)f2bf(x2 * QSCALE); }
        else { Kb[(size_t)row * D + c - 1024] = (bf16_t)f2bf(x1); Kb[(size_t)row * D + c - 1024 + 16] = (bf16_t)f2bf(x2); }
    }
}
template <int NIT>
__device__ __forceinline__ void naive_attn_item(const Ctx& a, int row, int h, float lam, LAS float* qs, int lane) {
    const bf16_t* Q = (const bf16_t*)(a.ws() + WS_Q); const bf16_t* Kb = (const bf16_t*)(a.ws() + WS_K); const bf16_t* V = (const bf16_t*)(a.ws() + WS_V);
    bf16_t* ATT = (bf16_t*)(a.ws() + WS_ATT);
    const int b = row < RL ? (row >> 11) : ((row - RL) >> 8);
    const int lat0 = b * SEQ, ctx0 = RL + b * CTXL;
    { const unsigned qq = *(const unsigned*)(Q + (size_t)row * D + h * 128 + 2 * lane); qs[2 * lane] = bf_lo(qq); qs[2 * lane + 1] = bf_hi(qq); }
    __builtin_amdgcn_fence(__ATOMIC_RELEASE, "wavefront"); __builtin_amdgcn_wave_barrier(); __builtin_amdgcn_fence(__ATOMIC_ACQUIRE, "wavefront");
#define NA_SCORE(it, d0, d1) do { const int kk_ = (it) * 64 + lane; \
        const int krow_ = (NIT == 36) ? (kk_ < SEQ ? lat0 + kk_ : ctx0 + kk_ - SEQ) : ctx0 + kk_; \
        const u32x4* kp_ = (const u32x4*)(Kb + (size_t)krow_ * D + h * 128); d0 = 0.f; d1 = 0.f; \
        _Pragma("unroll 4") for (int c = 0; c < 16; ++c) { const u32x4 kv = kp_[c]; \
            const f32x4 qa = *(const LAS f32x4*)(qs + 8 * c), qb = *(const LAS f32x4*)(qs + 8 * c + 4); \
            const float dd = (qa.x * bf_lo(kv.x) + qa.y * bf_hi(kv.x)) + (qa.z * bf_lo(kv.y) + qa.w * bf_hi(kv.y)) \
                           + (qb.x * bf_lo(kv.z) + qb.y * bf_hi(kv.z)) + (qb.z * bf_lo(kv.w) + qb.w * bf_hi(kv.w)); \
            if (c < 8) d0 += dd; else d1 += dd; } } while (0)
    float m0 = -3.0e38f, m1 = -3.0e38f, l0 = 0.f, l1 = 0.f;
#pragma unroll 1
    for (int it = 0; it < NIT; ++it) {
        float d0, d1; NA_SCORE(it, d0, d1);
        const float n0 = fmaxf(m0, d0), n1 = fmaxf(m1, d1);
        l0 = l0 * exp2f(m0 - n0) + exp2f(d0 - n0); l1 = l1 * exp2f(m1 - n1) + exp2f(d1 - n1); m0 = n0; m1 = n1;
    }
    { const float g0 = wave_max(m0), g1 = wave_max(m1); l0 = wave_sum(l0 * exp2f(m0 - g0)); l1 = wave_sum(l1 * exp2f(m1 - g1)); m0 = g0; m1 = g1; }
    const float i0 = 1.f / l0, i1 = lam / l1;
    float o0 = 0.f, o1 = 0.f;
#pragma unroll 1
    for (int it = 0; it < NIT; ++it) {
        float d0, d1; NA_SCORE(it, d0, d1);
        const int wbits = __float_as_int(exp2f(d0 - m0) * i0 - exp2f(d1 - m1) * i1);
#pragma unroll 4
        for (int src = 0; src < 64; ++src) {
            const float wv = __int_as_float(__builtin_amdgcn_readlane(wbits, src));
            const int kk = it * 64 + src;
            const int krow = (NIT == 36) ? (kk < SEQ ? lat0 + kk : ctx0 + kk - SEQ) : ctx0 + kk;
            const unsigned vv = *(const unsigned*)(V + (size_t)krow * D + h * 128 + 2 * lane);
            o0 += wv * bf_lo(vv); o1 += wv * bf_hi(vv);
        }
    }
#undef NA_SCORE
    const float ss = wave_sum(o0 * o0 + o1 * o1);
    const float rstd = 1.0f / sqrtf(ss * (1.0f / 128.0f) + EPS);
    const float g0 = a.in(I_SUBG)[2 * lane], g1 = a.in(I_SUBG)[2 * lane + 1];
    *(unsigned*)(ATT + (size_t)row * D + h * 128 + 2 * lane) = pk2(o0 * rstd * g0 * (1.0f - LAMBDA_INIT0), o1 * rstd * g1 * (1.0f - LAMBDA_INIT0));
}
__device__ __forceinline__ float diff_lambda(const Ctx& a, int lane) {
    const float s1 = wave_sum(a.in(I_LQ1)[lane] * a.in(I_LK1)[lane]), s2 = wave_sum(a.in(I_LQ2)[lane] * a.in(I_LK2)[lane]);
    return expf(s1) - expf(s2) + LAMBDA_INIT0;
}
__device__ __forceinline__ void ph_attn_naive(const Ctx& a, LAS unsigned char* lds) {
    const int lane = threadIdx.x & 63, wave = threadIdx.x >> 6, gw = blockIdx.x * NWAVES + wave, NGW = gridDim.x * NWAVES;
    LAS float* qs = (LAS float*)lds + wave * 128;
    const float lam = diff_lambda(a, lane);
    for (int item = gw; item < RT * 8; item += NGW) {
        const int h = item / RT, row = item % RT;
        if (row < RL) naive_attn_item<36>(a, row, h, lam, qs, lane); else naive_attn_item<4>(a, row, h, lam, qs, lane);
    }
}
__device__ __forceinline__ void ph_wo_naive(const Ctx& a, LAS unsigned char* lds) {
    const bf16_t* ATT = (const bf16_t*)(a.ws() + WS_ATT); bf16_t* H = (bf16_t*)(a.ws() + WS_H);
    for (int t = blockIdx.x; t < (RT / 128) * 16; t += gridDim.x) {
        const int tm = t / 16, tn = t % 16;
        naive_tile(ATT + (size_t)tm * 128 * D, D, a.in(I_WO) + tn * 64, D, D, lds, [&](int r, int c, float v) {
            const int row = tm * 128 + r, col = tn * 64 + c;
            const float base = row < RL ? a.in(I_X)[(size_t)row * D + col] : a.in(I_CTX)[(size_t)(row - RL) * D + col];
            H[(size_t)row * D + col] = (bf16_t)f2bf(base + mod_ptr(a, 0, mod_row(row))[M_G1 + col] * v); });
    }
}
__device__ __forceinline__ void ph_gu_naive(const Ctx& a, LAS unsigned char* lds, int layer) {
    const int rpe = layer == 0 ? RPE0 : RPE1, tpe = (rpe / 128) * 88;
    const bf16_t* XG = (const bf16_t*)(a.ws() + WS_XG); float* T = (float*)(a.ws() + WS_TMPF);
    for (int t = blockIdx.x; t < NE * tpe; t += gridDim.x) {
        const int e = t / tpe, q = t % tpe, tm = q / 88, tn = q % 88;
        const size_t row0 = (size_t)e * rpe + tm * 128;
        naive_tile(XG + row0 * D, D, a.in(I_WGU) + (size_t)(layer * NE + e) * D * 2 * DE + tn * 64, 2 * DE, D, lds,
                   [&](int r, int c, float v) { T[(row0 + r) * (2 * DE) + tn * 64 + c] = v; });
    }
}
__device__ __forceinline__ void ph_swiglu_naive(const Ctx& a, int layer) {
    const int rpe = layer == 0 ? RPE0 : RPE1;
    const float* T = (const float*)(a.ws() + WS_TMPF); bf16_t* ACT = (bf16_t*)(a.ws() + WS_ACT);
    const size_t total = (size_t)NE * rpe * DE, nth = (size_t)gridDim.x * NTHREADS;
    for (size_t i = (size_t)blockIdx.x * NTHREADS + threadIdx.x; i < total; i += nth) {
        const size_t row = i / DE; const int j = (int)(i % DE);
        const float g = T[row * (2 * DE) + j], u = T[row * (2 * DE) + DE + j];
        ACT[i] = (bf16_t)f2bf(g / (1.f + expf(-g)) * u);
    }
}
__device__ __forceinline__ void ph_dn_naive(const Ctx& a, LAS unsigned char* lds, int layer) {
    const int rpe = layer == 0 ? RPE0 : RPE1, tpe = (rpe / 128) * 16;
    const bf16_t* ACT = (const bf16_t*)(a.ws() + WS_ACT); unsigned char* Y = a.ws() + WS_Y; const float* GATE = (const float*)(a.ws() + WS_GATE);
    for (int t = blockIdx.x; t < NE * tpe; t += gridDim.x) {
        const int e = t / tpe, q = t % tpe, tm = q / 16, tn = q % 16;
        const size_t row0 = (size_t)e * rpe + tm * 128;
        naive_tile(ACT + row0 * DE, DE, a.in(I_WDN) + (size_t)(layer * NE + e) * DE * D + tn * 64, D, DE, lds,
                   [&](int r, int c, float v) { Y[(row0 + r) * D + tn * 64 + c] = (unsigned char)(pk4_fp8(v * Y_SCALE, 0.f, 0.f, 0.f) & 0xffu); });
    }
}
__device__ __forceinline__ void ph_win_naive(const Ctx& a, LAS unsigned char* lds) {
    const bf16_t* XN = (const bf16_t*)(a.ws() + WS_XN); bf16_t* YG = (bf16_t*)(a.ws() + WS_YG); bf16_t* XR = (bf16_t*)(a.ws() + WS_XR);
    const int TL = (RL / 128) * 32, TC = (RC / 128) * 16;
    for (int t = blockIdx.x; t < TL + TC; t += gridDim.x) {
        int tm, tn; if (t < TL) { tm = t / 32; tn = t % 32; } else { const int q = t - TL; tm = RL / 128 + q / 16; tn = 16 + q % 16; }
        naive_tile(XN + (size_t)tm * 128 * D, D, a.in(I_WIN) + tn * 64, 2 * D, D, lds, [&](int r, int c, float v) {
            const int row = tm * 128 + r, col = tn * 64 + c; const float x = v + a.in(I_BIN)[col];
            if (col < D) YG[(size_t)row * D + col] = (bf16_t)f2bf(gelu_tanh(x)); else XR[(size_t)row * D + col - D] = (bf16_t)f2bf(x); });
    }
}
__device__ __forceinline__ void ph_conv_naive(const Ctx& a) {
    const bf16_t* XR = (const bf16_t*)(a.ws() + WS_XR); bf16_t* XC = (bf16_t*)(a.ws() + WS_XC);
    const size_t total = (size_t)RT * D, nth = (size_t)gridDim.x * NTHREADS;
    for (size_t i = (size_t)blockIdx.x * NTHREADS + threadIdx.x; i < total; i += nth) {
        const int row = (int)(i >> 10), ch = (int)(i & 1023);
        const int t = row < RL ? (row & 2047) : ((row - RL) & 255), L = row < RL ? SEQ : CTXL;
        float v = a.in(I_CONVB)[ch];
#pragma unroll
        for (int j = 0; j < 4; ++j) { const int tt = t - 2 + j; if (tt >= 0 && tt < L) v += a.in(I_CONVW)[j * D + ch] * bf2f(XR[(size_t)(row - t + tt) * D + ch]); }
        XC[i] = (bf16_t)f2bf(v);
    }
}
__device__ __forceinline__ void ph_gates_naive(const Ctx& a, LAS unsigned char* lds) {
    const bf16_t* XC = (const bf16_t*)(a.ws() + WS_XC); float* T = (float*)(a.ws() + WS_TMPF);
    for (int t = blockIdx.x; t < 16 * (RT / 128) * 4; t += gridDim.x) {
        const int m = t / ((RT / 128) * 4), q = t % ((RT / 128) * 4), tm = q >> 2, tn = q & 3, d = m >> 3, kb = m & 7;
        naive_tile(XC + (size_t)tm * 128 * D + kb * 128, D, a.in(I_WGATES) + (size_t)m * 128 * 256 + tn * 64, 256, 128, lds,
                   [&](int r, int c, float v) { T[((size_t)d * RT + tm * 128 + r) * 2048 + kb * 256 + tn * 64 + c] = v; });
    }
}
__device__ __forceinline__ void ph_gate_elem_naive(const Ctx& a) {
    const float* T = (const float*)(a.ws() + WS_TMPF); const bf16_t* XC = (const bf16_t*)(a.ws() + WS_XC);
    bf16_t* LOGA = (bf16_t*)(a.ws() + WS_LOGA); unsigned char* BT = a.ws() + WS_BT;
    const size_t total = (size_t)2 * RT * D, nth = (size_t)gridDim.x * NTHREADS;
    for (size_t i = (size_t)blockIdx.x * NTHREADS + threadIdx.x; i < total; i += nth) {
        const int d = (int)(i / ((size_t)RT * D)); const size_t rc = i % ((size_t)RT * D); const int row = (int)(rc >> 10), ch = (int)(rc & 1023), kb = ch >> 7, cc = ch & 127;
        const float gr = T[((size_t)d * RT + row) * 2048 + kb * 256 + cc] + a.in(I_BGATES)[(d * 8 + kb) * 256 + cc];
        const float gi = T[((size_t)d * RT + row) * 2048 + kb * 256 + 128 + cc] + a.in(I_BGATES)[(d * 8 + kb) * 256 + 128 + cc];
        const float r = sigmoidf_(gr), ig = sigmoidf_(gi);
        const float lam = a.in(I_LAM)[d * D + ch];
        const float la = -8.0f * r * log1pf(expf(-lam));
        const float x = bf2f(XC[rc]);
        const float bt = sqrtf(-expm1f(2.0f * la)) * (ig * x);
        LOGA[i] = (bf16_t)f2bf(la * 1.4426950408889634f); BT[i] = (unsigned char)(pk4_fp8(bt * BT_SCALE, 0.f, 0.f, 0.f) & 0xffu);
    }
}
__device__ __forceinline__ void ph_wout_naive(const Ctx& a, LAS unsigned char* lds) {
    const bf16_t* HS = (const bf16_t*)(a.ws() + WS_HS); bf16_t* H = (bf16_t*)(a.ws() + WS_H);
    for (int t = blockIdx.x; t < (RL / 128) * 16; t += gridDim.x) {
        const int tm = t / 16, tn = t % 16;
        naive_tile(HS + (size_t)tm * 128 * D, D, a.in(I_WOUT) + tn * 64, D, D, lds, [&](int r, int c, float v) {
            const int row = tm * 128 + r, col = tn * 64 + c;
            H[(size_t)row * D + col] = (bf16_t)f2bf(bf2f(H[(size_t)row * D + col]) + mod_ptr(a, 1, row >> 11)[M_G1 + col] * v); });
    }
}

__device__ __forceinline__ int scan_row(int b, int dir, int c, int s) {
    const int p = c * SCH + s;
    if (dir == 0) return p < CTXL ? RL + b * CTXL + p : b * SEQ + (p - CTXL);
    return p < CTXL ? RL + b * CTXL + (CTXL - 1 - p) : b * SEQ + (SEQ - 1 - (p - CTXL));
}
__device__ __forceinline__ void ph_scan1(const Ctx& a) {
    const int lane = threadIdx.x & 63, gw = blockIdx.x * NWAVES + (threadIdx.x >> 6), NGW = gridDim.x * NWAVES;
    const bf16_t* LOGA = (const bf16_t*)(a.ws() + WS_LOGA); const unsigned char* BT = a.ws() + WS_BT;
    float* CP = (float*)(a.ws() + WS_CP); float* CB = (float*)(a.ws() + WS_CB);
    for (int item = gw; item < NB * 2 * NCH * 8; item += NGW) {
        const int cg = item & 7, c = (item >> 3) % NCH, bd = (item >> 3) / NCH, dir = bd & 1, b = bd >> 1;
        const int ch = cg * 128 + 2 * lane;
        float h0 = 0.f, h1 = 0.f, p0 = 0.f, p1 = 0.f;
#pragma unroll 1
        for (int sg = 0; sg < SCH; sg += 32) {
            unsigned la[32], bt[32];
#pragma unroll
            for (int i = 0; i < 32; ++i) { const size_t o = ((size_t)dir * RT + scan_row(b, dir, c, sg + i)) * D + ch; la[i] = *(const unsigned*)(LOGA + o); bt[i] = *(const unsigned short*)(BT + o); }
            asm volatile("" ::: "memory");
#pragma unroll
            for (int i = 0; i < 32; ++i) { const float l0 = bf_lo(la[i]), l1 = bf_hi(la[i]);
                const f32x2 bb = __builtin_amdgcn_cvt_pk_f32_fp8((int)bt[i], false);
                h0 = __builtin_amdgcn_exp2f(l0) * h0 + bb.x; h1 = __builtin_amdgcn_exp2f(l1) * h1 + bb.y; p0 += l0; p1 += l1; }
        }
        const size_t so = ((size_t)(b * 2 + dir) * NCH + c) * D + ch;
        *(f32x2*)(CP + so) = (f32x2){p0, p1}; *(f32x2*)(CB + so) = (f32x2){h0, h1};
    }
}
__device__ __forceinline__ void ph_scan2(const Ctx& a) {
    const int lane = threadIdx.x & 63, gw = blockIdx.x * NWAVES + (threadIdx.x >> 6), NGW = gridDim.x * NWAVES;
    const bf16_t* LOGA = (const bf16_t*)(a.ws() + WS_LOGA); const unsigned char* BT = a.ws() + WS_BT;
    const float* CP = (const float*)(a.ws() + WS_CP); const float* CB = (const float*)(a.ws() + WS_CB);
    const bf16_t* YG = (const bf16_t*)(a.ws() + WS_YG); bf16_t* HS = (bf16_t*)(a.ws() + WS_HS);
    constexpr int NLC = SEQ / SCH;
    for (int item = gw; item < NB * NLC * 8; item += NGW) {
        const int cg = item & 7, j = (item >> 3) % NLC, b = (item >> 3) / NLC;
        const int ch = cg * 128 + 2 * lane;
        const int cb = NCH_CTX + (NLC - 1 - j), cf = NCH_CTX + j;
        float hb0 = 0.f, hb1 = 0.f, hf0 = 0.f, hf1 = 0.f;
#pragma unroll 1
        for (int c0 = 0; c0 < NCH - 1; c0 += 12) {
            f32x2 pb[12], qb[12], pf[12], qf[12];
#pragma unroll
            for (int i = 0; i < 12; ++i) {
                const int c = c0 + i; const size_t sb_ = ((size_t)(b * 2 + 1) * NCH + c) * D + ch, sf_ = ((size_t)(b * 2 + 0) * NCH + c) * D + ch;
                const f32x2 z = (f32x2){0.f, 0.f};
                pb[i] = c < cb ? *(const f32x2*)(CP + sb_) : z; qb[i] = c < cb ? *(const f32x2*)(CB + sb_) : z;
                pf[i] = c < cf ? *(const f32x2*)(CP + sf_) : z; qf[i] = c < cf ? *(const f32x2*)(CB + sf_) : z;
            }
            asm volatile("" ::: "memory");
#pragma unroll
            for (int i = 0; i < 12; ++i) {
                hb0 = __builtin_amdgcn_exp2f(pb[i].x) * hb0 + qb[i].x; hb1 = __builtin_amdgcn_exp2f(pb[i].y) * hb1 + qb[i].y;
                hf0 = __builtin_amdgcn_exp2f(pf[i].x) * hf0 + qf[i].x; hf1 = __builtin_amdgcn_exp2f(pf[i].y) * hf1 + qf[i].y;
            }
        }
        float sb0[SCH], sb1[SCH];
#pragma unroll
        for (int sg = 0; sg < SCH; sg += 32) {
            unsigned la[32], bt[32];
#pragma unroll
            for (int i = 0; i < 32; ++i) { const size_t o = ((size_t)1 * RT + b * SEQ + j * SCH + (SCH - 1 - (sg + i))) * D + ch; la[i] = *(const unsigned*)(LOGA + o); bt[i] = *(const unsigned short*)(BT + o); }
            asm volatile("" ::: "memory");
#pragma unroll
            for (int i = 0; i < 32; ++i) {
                const f32x2 bb = __builtin_amdgcn_cvt_pk_f32_fp8((int)bt[i], false);
                hb0 = __builtin_amdgcn_exp2f(bf_lo(la[i])) * hb0 + bb.x; hb1 = __builtin_amdgcn_exp2f(bf_hi(la[i])) * hb1 + bb.y;
                sb0[SCH - 1 - (sg + i)] = hb0; sb1[SCH - 1 - (sg + i)] = hb1;
            }
        }
#pragma unroll
        for (int sg = 0; sg < SCH; sg += 16) {
            unsigned la[16], bt[16], yg[16];
#pragma unroll
            for (int i = 0; i < 16; ++i) { const size_t o = ((size_t)b * SEQ + j * SCH + sg + i) * D + ch; la[i] = __builtin_nontemporal_load((const unsigned*)(LOGA + o)); bt[i] = __builtin_nontemporal_load((const unsigned short*)(BT + o)); yg[i] = __builtin_nontemporal_load((const unsigned*)(YG + o)); }
            asm volatile("" ::: "memory");
#pragma unroll
            for (int i = 0; i < 16; ++i) {
                const size_t o = ((size_t)b * SEQ + j * SCH + sg + i) * D + ch;
                const f32x2 bb = __builtin_amdgcn_cvt_pk_f32_fp8((int)bt[i], false);
                hf0 = __builtin_amdgcn_exp2f(bf_lo(la[i])) * hf0 + bb.x; hf1 = __builtin_amdgcn_exp2f(bf_hi(la[i])) * hf1 + bb.y;
                *(unsigned*)(HS + o) = pk2(bf_lo(yg[i]) * ((hf0 + sb0[sg + i]) * (1.0f / BT_SCALE)), bf_hi(yg[i]) * ((hf1 + sb1[sg + i]) * (1.0f / BT_SCALE)));
            }
            asm volatile("" ::: "memory");
        }
    }
}
#define XB_TMO      128
#define XB_XCNT(j)  (256  + 64 * (j))
#define XB_XSUB(j)  (1280 + 64 * (j))
#define XB_XGEN(j)  (2304 + 64 * (j))
#define XB_TOP      3328
#define XB_TOPGEN   3392
#define XCD_BAR_WORDS 3456
#define XB_SPIN_CAP (1u << 18)

__device__ __forceinline__ unsigned xb_ld(unsigned* p)              { return __hip_atomic_load(p, __ATOMIC_RELAXED, __HIP_MEMORY_SCOPE_AGENT); }
__device__ __forceinline__ unsigned xb_add(unsigned* p, unsigned v) { return __hip_atomic_fetch_add(p, v, __ATOMIC_RELAXED, __HIP_MEMORY_SCOPE_AGENT); }
__device__ __forceinline__ unsigned xb_xcc_id() { return (unsigned)__builtin_amdgcn_s_getreg((3 << 11) | 20) & 0xFu; }
#define XB_SPIN(cond, bar) do { unsigned _sp = 0; while (cond) { __builtin_amdgcn_s_sleep(1); \
    if ((++_sp & 255u) == 0u) { if (xb_ld(&(bar)[XB_TMO])) break; if (_sp > XB_SPIN_CAP) { atomicAdd(&(bar)[XB_TMO], 1u); break; } } } } while (0)

struct XcdBarrier {
    unsigned* bar; unsigned x;
    volatile LAS unsigned* st;
};

__device__ __forceinline__ XcdBarrier xcd_barrier_post(unsigned* bar, volatile LAS unsigned* st) {
    XcdBarrier b; b.bar = bar; b.x = xb_xcc_id(); b.st = st;
    if (threadIdx.x == 0) (void)xb_add(&bar[XB_XCNT(b.x)], 1u);
    return b;
}
__device__ __forceinline__ void xcd_barrier_complete(unsigned* bar, unsigned x, unsigned& nloc, unsigned& nx) {
    const unsigned G = gridDim.x * gridDim.y * gridDim.z;
    unsigned sum, cnt, mine, sp = 0u;
    for (;;) {
        sum = 0u; cnt = 0u; mine = 0u;
#pragma unroll
        for (unsigned j = 0; j < 16; ++j) { const unsigned c = xb_ld(&bar[XB_XCNT(j)]); sum += c; cnt += (c > 0u) ? 1u : 0u; mine = (j == x) ? c : mine; }
        if (sum == G) break;
        __builtin_amdgcn_s_sleep(1);
        if ((++sp & 255u) == 0u) { if (xb_ld(&bar[XB_TMO])) break; if (sp > XB_SPIN_CAP) { atomicAdd(&bar[XB_TMO], 1u); break; } }
    }
    nloc = mine > 0u ? mine : 1u; nx = cnt > 0u ? cnt : 1u;
}

__device__ __forceinline__ void xcd_barrier(const XcdBarrier& b) {
    asm volatile("s_waitcnt vmcnt(0)" ::: "memory");
    __syncthreads();
    if (threadIdx.x == 0) {
        unsigned* bar = b.bar;
        __builtin_amdgcn_s_waitcnt(0);
        unsigned nloc = b.st[0], nx = b.st[1];
        if (nloc == 0u) { xcd_barrier_complete(bar, b.x, nloc, nx); b.st[0] = nloc; b.st[1] = nx; }
        const unsigned old = xb_add(&bar[XB_XSUB(b.x)], 1u);
        const unsigned gen = old / nloc;
        if (old + 1u == (gen + 1u) * nloc) {
            __builtin_amdgcn_fence(__ATOMIC_RELEASE, "agent");
            asm volatile("s_waitcnt vmcnt(0)" ::: "memory");
            const unsigned og = xb_add(&bar[XB_TOP], 1u);
            const unsigned tg = og / nx;
            if (og + 1u == (tg + 1u) * nx) xb_add(&bar[XB_TOPGEN], 1u);
            else XB_SPIN(xb_ld(&bar[XB_TOPGEN]) == tg, bar);
            __builtin_amdgcn_fence(__ATOMIC_ACQUIRE, "agent");
            xb_add(&bar[XB_XGEN(b.x)], 1u);
            asm volatile("s_waitcnt vmcnt(0)" ::: "memory");
        } else {
            XB_SPIN(xb_ld(&bar[XB_XGEN(b.x)]) == gen, bar);
            __builtin_amdgcn_fence(__ATOMIC_ACQUIRE, "agent");
            asm volatile("s_waitcnt vmcnt(0)" ::: "memory");
        }
    }
    __syncthreads();
}

__device__ __forceinline__ int xcd_remap(long L, int n) { const int q = n / 8, r = n % 8, xcd = (int)(L % 8), off = (int)(L / 8); return (xcd < r ? xcd * (q + 1) : r * (q + 1) + (xcd - r) * q) + off; }
template <class Map> struct ListOrder {
    int nunits, G, c; Map map;
    __device__ __forceinline__ bool next(int i, pg8::Unit& u) const { const long L = (long)i * G + c; if (L >= nunits) return false; map(xcd_remap(L, nunits), u); return true; }
    __device__ __forceinline__ void a_ready(const pg8::Unit&) const {}
    __device__ __forceinline__ void done(const pg8::Unit&) const {}
};
#ifndef WGMG
#define WGMG 8
#endif
struct MapGrid { int nN; __device__ __forceinline__ void operator()(int w, pg8::Unit& u) const { const int nig = WGMG * nN; u.pm = (w / nig) * WGMG + (w % nig) % WGMG; u.pn = (w % nig) / WGMG; } };
struct MapMoe { int PM, NT; __device__ __forceinline__ void operator()(int w, pg8::Unit& u) const { const int per = PM * NT, e = w / per, rem = w % per; u.pm = e * PM + rem % PM; u.pn = e * NT + rem / PM; } };
struct MapWin { __device__ __forceinline__ void operator()(int w, pg8::Unit& u) const { if (w < 512) { u.pm = (w / 64) * 8 + (w % 64) % 8; u.pn = (w % 64) / 8; } else { const int q = w - 512; u.pm = 64 + q % 8; u.pn = 4 + q / 8; } } };

typedef pg8::f32x4 pf4;
__device__ __forceinline__ float fast_exp(float x) { return __builtin_amdgcn_exp2f(x * 1.4426950408889634f); }

struct EpiQKV {
    static constexpr bool PERM = true, AFTER_DRAIN = false;
    bf16_t* Q; const LAS float* rope;
    __device__ __forceinline__ void operator()(const pf4 (&acc)[2][2][4][2], const pg8::Unit& u, int wr, int wc, int fr, int fq) const {
        const int sec = u.pn >> 2; bf16_t* base = Q + (size_t)sec * ((WS_K - WS_Q) / 2);
        const bool lat = u.pm < 64, dorope = sec < 2 && lat; const int axis = wc & 1;
        const bool upper = fq >= 2;
        const int row0 = u.pm * 256 + wr * 64 + fr, col0 = (u.pn & 3) * 256 + wc * 32 + 8 * fq;
        const float sc = sec == 0 ? QSCALE : 1.0f;
#pragma unroll
        for (int ai = 0; ai < 2; ++ai)
#pragma unroll
            for (int m = 0; m < 4; ++m) {
                const int row = row0 + ai * 128 + m * 16;
                pf4 cs[2], sn[2];
#pragma unroll
                for (int n = 0; n < 2; ++n) { cs[n] = (pf4){1.f, 1.f, 1.f, 1.f}; sn[n] = (pf4){0.f, 0.f, 0.f, 0.f}; }
                if (dorope) { const int t = row & 2047, pos = axis ? (t & 63) : (t >> 6); const LAS float* rp = rope + pos * 16 + 8 * (fq & 1);
#pragma unroll
                    for (int n = 0; n < 2; ++n) { cs[n] = *(const LAS pf4*)(rp + 4 * n); sn[n] = *(const LAS pf4*)(rp + 1024 + 4 * n); } }
#pragma unroll
                for (int bj = 0; bj < 2; ++bj) {
                    pf4 o[2];
#pragma unroll
                    for (int n = 0; n < 2; ++n)
#pragma unroll
                        for (int j = 0; j < 4; ++j) {
                            const float own = acc[ai][bj][m][n][j];
                            float v = own;
                            if (dorope) {
                                const auto rr = __builtin_amdgcn_permlane32_swap(__float_as_uint(own), __float_as_uint(own), false, false);
                                const float other = __uint_as_float(upper ? rr[0] : rr[1]);
                                v = upper ? (own * cs[n][j] + other * sn[n][j]) : (own * cs[n][j] - other * sn[n][j]);
                            }
                            o[n][j] = v * sc;
                        }
                    u32x4 w; w.x = pk2(o[0][0], o[0][1]); w.y = pk2(o[0][2], o[0][3]); w.z = pk2(o[1][0], o[1][1]); w.w = pk2(o[1][2], o[1][3]);
                    st16_wt(base + (size_t)row * D + col0 + bj * 128, w);
                }
            }
    }
};
struct EpiResid {
    static constexpr bool PERM = true, AFTER_DRAIN = false;
    bf16_t* H; const float* x; const float* ctx; const float* mod; int layer;
    __device__ __forceinline__ void operator()(const pf4 (&acc)[2][2][4][2], const pg8::Unit& u, int wr, int wc, int fr, int fq) const {
        const bool lat = u.pm < 64;
        const float* xb = lat ? x + (size_t)u.pm * 256 * D : ctx + (size_t)(u.pm - 64) * 256 * D;
        const float* g = mod + (size_t)(layer * 9 + (lat ? (u.pm >> 3) : 8)) * 6144 + M_G1;
        bf16_t* out = H + (size_t)u.pm * 256 * D;
        const int r0 = wr * 64 + fr, col0 = u.pn * 256 + wc * 32 + 8 * fq;
        pf4 gv[2][2];
#pragma unroll
        for (int bj = 0; bj < 2; ++bj)
#pragma unroll
            for (int n = 0; n < 2; ++n) gv[bj][n] = *(const pf4*)(g + col0 + bj * 128 + 4 * n);
#pragma unroll
        for (int it = 0; it < 8; ++it) {
            const int ai = it >> 2, m = it & 3;
            const size_t ro = (size_t)(r0 + ai * 128 + m * 16) * D + col0;
#pragma unroll
            for (int bj = 0; bj < 2; ++bj) {
                pf4 b0, b1;
                if (layer == 0) { b0 = *(const pf4*)(xb + ro + bj * 128); b1 = *(const pf4*)(xb + ro + bj * 128 + 4); }
                else { const u32x4 hb = *(const u32x4*)(out + ro + bj * 128); b0 = (pf4){bf_lo(hb.x), bf_hi(hb.x), bf_lo(hb.y), bf_hi(hb.y)}; b1 = (pf4){bf_lo(hb.z), bf_hi(hb.z), bf_lo(hb.w), bf_hi(hb.w)}; }
                const pf4 o0 = b0 + gv[bj][0] * acc[ai][bj][m][0], o1 = b1 + gv[bj][1] * acc[ai][bj][m][1];
                u32x4 w; w.x = pk2(o0[0], o0[1]); w.y = pk2(o0[2], o0[3]); w.z = pk2(o1[0], o1[1]); w.w = pk2(o1[2], o1[3]);
                st16_wt(out + ro + bj * 128, w);
            }
        }
    }
};
struct EpiSwiGLU {
    static constexpr bool PERM = true, AFTER_DRAIN = false;
    bf16_t* ACT;
    __device__ __forceinline__ void operator()(const pf4 (&acc)[2][2][4][2], const pg8::Unit& u, int wr, int wc, int fr, int fq) const {
        const int ct = u.pn % 22;
        bf16_t* p0 = ACT + (size_t)(u.pm * 256 + wr * 64 + fr) * DE + ct * 128 + wc * 32 + 8 * fq;
#pragma unroll
        for (int ai = 0; ai < 2; ++ai)
#pragma unroll
            for (int m = 0; m < 4; ++m) {
                float o[8];
#pragma unroll
                for (int n = 0; n < 2; ++n)
#pragma unroll
                    for (int j = 0; j < 4; ++j) { const float g = acc[ai][0][m][n][j], uu = acc[ai][1][m][n][j]; o[n * 4 + j] = g * __builtin_amdgcn_rcpf(1.0f + fast_exp(-g)) * uu; }
                u32x4 w; w.x = pk2(o[0], o[1]); w.y = pk2(o[2], o[3]); w.z = pk2(o[4], o[5]); w.w = pk2(o[6], o[7]);
                *(u32x4*)(p0 + (size_t)(ai * 128 + m * 16) * DE) = w;
            }
    }
};
struct EpiDown {
    static constexpr bool PERM = true, AFTER_DRAIN = false;
    unsigned char* Y;
    __device__ __forceinline__ void operator()(const pf4 (&acc)[2][2][4][2], const pg8::Unit& u, int wr, int wc, int fr, int fq) const {
        const int row0 = u.pm * 256 + wr * 64 + fr, col0 = (u.pn & 3) * 256 + wc * 32 + 8 * fq;
#pragma unroll
        for (int ai = 0; ai < 2; ++ai)
#pragma unroll
            for (int m = 0; m < 4; ++m) {
                const int row = row0 + ai * 128 + m * 16;
#pragma unroll
                for (int bj = 0; bj < 2; ++bj) {
                    const pf4 v0 = acc[ai][bj][m][0] * Y_SCALE, v1 = acc[ai][bj][m][1] * Y_SCALE;
                    u32x2 w; w.x = pk4_fp8(v0[0], v0[1], v0[2], v0[3]); w.y = pk4_fp8(v1[0], v1[1], v1[2], v1[3]);
                    st8_wt(Y + (size_t)row * D + col0 + bj * 128, w);
                }
            }
    }
};
struct EpiWin {
    static constexpr bool PERM = true, AFTER_DRAIN = false;
    bf16_t *YG, *XR; const LAS float* bin;
    __device__ __forceinline__ void operator()(const pf4 (&acc)[2][2][4][2], const pg8::Unit& u, int wr, int wc, int fr, int fq) const {
        const bool yb = u.pn < 4; bf16_t* base = yb ? YG : XR;
        const int row0 = u.pm * 256 + wr * 64 + fr, colg = u.pn * 256 + wc * 32 + 8 * fq, col0 = (u.pn & 3) * 256 + wc * 32 + 8 * fq;
        pf4 bv[2][2];
#pragma unroll
        for (int bj = 0; bj < 2; ++bj)
#pragma unroll
            for (int n = 0; n < 2; ++n) bv[bj][n] = *(const LAS pf4*)(bin + colg + bj * 128 + 4 * n);
#pragma unroll
        for (int ai = 0; ai < 2; ++ai)
#pragma unroll
            for (int m = 0; m < 4; ++m) {
                const int row = row0 + ai * 128 + m * 16;
#pragma unroll
                for (int bj = 0; bj < 2; ++bj) {
                    pf4 v0 = acc[ai][bj][m][0] + bv[bj][0], v1 = acc[ai][bj][m][1] + bv[bj][1];
                    if (yb) {
#pragma unroll
                        for (int j = 0; j < 4; ++j) {
                            { const float x = v0[j], uu = 0.7978845608028654f * (x + 0.044715f * x * x * x); v0[j] = x * __builtin_amdgcn_rcpf(1.0f + fast_exp(-2.0f * uu)); }
                            { const float x = v1[j], uu = 0.7978845608028654f * (x + 0.044715f * x * x * x); v1[j] = x * __builtin_amdgcn_rcpf(1.0f + fast_exp(-2.0f * uu)); }
                        }
                    }
                    u32x4 w; w.x = pk2(v0[0], v0[1]); w.y = pk2(v0[2], v0[3]); w.z = pk2(v1[0], v1[1]); w.w = pk2(v1[2], v1[3]);
                    st16_wt(base + (size_t)row * D + col0 + bj * 128, w);
                }
            }
    }
};

#ifndef DENSE_ALIGN
#define DENSE_ALIGN true
#endif
#ifndef DENSE_SP2
#define DENSE_SP2 true
#endif
__device__ __forceinline__ void stagger_start(int ticks) {
    if (ticks > 0 && ((blockIdx.x >> 3) & 1)) { const unsigned long long t0 = __builtin_amdgcn_s_memrealtime(); while (__builtin_amdgcn_s_memrealtime() - t0 < (unsigned long long)ticks) __builtin_amdgcn_s_sleep(8); }
}
#ifndef STG_QKV
#define STG_QKV 0
#endif
#ifndef STG_GU
#define STG_GU 0
#endif
#ifndef STG_DN
#define STG_DN 0
#endif
#ifndef STG_WIN
#define STG_WIN 0
#endif
#ifndef STG_WO
#define STG_WO 0
#endif
#define PG8_RUN(EPI, SCHED, g, S, E) pg8::gemm_phase<EPI, SCHED, DENSE_ALIGN, DENSE_SP2>((PG8_LAS unsigned char*)lds, g, S, E)

__device__ __forceinline__ void ph_qkv_fast(const Ctx& a, LAS unsigned char* lds) {
    unsigned char* ws = a.ws();
    pg8::Gemm g{(const bf16_t*)(ws + WS_XN), (const bf16_t*)(ws + WS_WQKV), RT, 3 * D, D};
    const int Gq = gemm_groups(72 * 12, (int)gridDim.x);
    if ((int)blockIdx.x >= Gq) { cvt8_run(a, 0, CV0_QKV + ((int)blockIdx.x - Gq), (int)gridDim.x - Gq, CV0_QKV + CVQ_QKV, lds); return; }
    ListOrder<MapGrid> S{72 * 12, Gq, (int)blockIdx.x, MapGrid{12}};
    static_assert(WS_V - WS_K == WS_K - WS_Q, "Q|K|V spacing");
    LAS float* rl = (LAS float*)(lds + ROPE_LDS);
    { const float* rg = (const float*)(ws + WS_ROPE); for (int i = threadIdx.x; i < 2048; i += NTHREADS) rl[i] = rg[i]; }
    __syncthreads();
    EpiQKV E{(bf16_t*)(ws + WS_Q), rl};
    stagger_start(STG_QKV);
    PG8_RUN(EpiQKV, ListOrder<MapGrid>, g, S, E);
    if (Gq == (int)gridDim.x) cvt8_tail(a, lds, 72 * 12, Gq, (int)blockIdx.x, 0, CV0_QKV, CVQ_QKV);
}
__device__ __forceinline__ void ph_wo_fast(const Ctx& a, LAS unsigned char* lds) {
    unsigned char* ws = a.ws();
    pg8::Gemm g{(const bf16_t*)(ws + WS_ATT), (const bf16_t*)(ws + WS_WO), RT, D, D};
    const int Gq = gemm_groups(72 * 4, (int)gridDim.x);
    if ((int)blockIdx.x >= Gq) { cvt8_run(a, 0, CV0_WO + ((int)blockIdx.x - Gq), (int)gridDim.x - Gq, CV0_WO + CVQ_WO, lds); return; }
    ListOrder<MapGrid> S{72 * 4, Gq, (int)blockIdx.x, MapGrid{4}};
    EpiResid E{(bf16_t*)(ws + WS_H), a.in(I_X), a.in(I_CTX), (const float*)(ws + WS_MOD), 0};
    stagger_start(STG_WO);
    PG8_RUN(EpiResid, ListOrder<MapGrid>, g, S, E);
    if (Gq == (int)gridDim.x) cvt8_tail(a, lds, 72 * 4, Gq, (int)blockIdx.x, 0, CV0_WO, CVQ_WO);
}
__device__ __forceinline__ void ph_wout_fast(const Ctx& a, LAS unsigned char* lds) {
    unsigned char* ws = a.ws();
    pg8::Gemm g{(const bf16_t*)(ws + WS_HS), (const bf16_t*)(ws + WS_WOUT), RL, D, D};
    ListOrder<MapGrid> S{64 * 4, (int)gridDim.x, (int)blockIdx.x, MapGrid{4}};
    EpiResid E{(bf16_t*)(ws + WS_H), nullptr, nullptr, (const float*)(ws + WS_MOD), 1};
    PG8_RUN(EpiResid, ListOrder<MapGrid>, g, S, E);
}
#if FP8_MOE
struct EpiSwiGLU8 {
    static constexpr bool PERM = true, AFTER_DRAIN = false;
    unsigned char* ACT;
    __device__ __forceinline__ void operator()(const pf4 (&acc)[2][2][4][2], const pg8::Unit& u, int wr, int wc, int fr, int fq) const {
        const int ct = u.pn % 22;
        unsigned char* p0 = ACT + (size_t)(u.pm * 256 + wr * 64 + fr) * DE + ct * 128 + wc * 32 + 8 * fq;
#pragma unroll
        for (int ai = 0; ai < 2; ++ai)
#pragma unroll
            for (int m = 0; m < 4; ++m) {
                float o[8];
#pragma unroll
                for (int n = 0; n < 2; ++n)
#pragma unroll
                    for (int j = 0; j < 4; ++j) { const float g = acc[ai][0][m][n][j], uu = acc[ai][1][m][n][j]; o[n * 4 + j] = g * __builtin_amdgcn_rcpf(1.0f + fast_exp(-g)) * uu; }
                u32x2 w; w.x = pk4_fp8(o[0], o[1], o[2], o[3]); w.y = pk4_fp8(o[4], o[5], o[6], o[7]);
                st8_wt(p0 + (size_t)(ai * 128 + m * 16) * DE, w);
            }
    }
};
__device__ __forceinline__ void ph_gu_fast(const Ctx& a, LAS unsigned char* lds, int layer) {
    unsigned char* ws = a.ws(); const int PM = (layer == 0 ? RPE0 : RPE1) / 256;
    pg8::Gemm g{(const bf16_t*)(ws + WS_XG), (const bf16_t*)(ws + WS_WGU + (size_t)layer * (WGU_LAYER / 2)), NE * PM * 256, NE * 2 * DE, D / 2};
    ListOrder<MapMoe> S{NE * PM * 22, (int)gridDim.x, (int)blockIdx.x, MapMoe{PM, 22}};
    EpiSwiGLU8 E{ws + WS_ACT};
    stagger_start(STG_GU);
    pg8::gemm_phase<EpiSwiGLU8, ListOrder<MapMoe>, GU_ALIGN, true, 122>((PG8_LAS unsigned char*)lds, g, S, E);
    if (layer == 0) cvt8_tail(a, lds, NE * PM * 22, (int)gridDim.x, (int)blockIdx.x, 1, CV1_GU0, CVQ_GU0);
}
__device__ __forceinline__ void ph_dn_fast(const Ctx& a, LAS unsigned char* lds, int layer) {
    unsigned char* ws = a.ws(); const int PM = (layer == 0 ? RPE0 : RPE1) / 256;
    pg8::Gemm g{(const bf16_t*)(ws + WS_ACT), (const bf16_t*)(ws + WS_WDN + (size_t)layer * (WDN_LAYER / 2)), NE * PM * 256, NE * D, DE / 2};
    const int Gq = layer == 0 ? gemm_groups(NE * PM * 4, (int)gridDim.x) : (int)gridDim.x;
    if ((int)blockIdx.x >= Gq) { cvt8_run(a, 1, CV1_DN0 + ((int)blockIdx.x - Gq), (int)gridDim.x - Gq, CV1_DN0 + CVQ_DN0, lds); return; }
    ListOrder<MapMoe> S{NE * PM * 4, Gq, (int)blockIdx.x, MapMoe{PM, 4}};
    EpiDown E{ws + WS_Y};
    stagger_start(STG_DN);
    pg8::gemm_phase<EpiDown, ListOrder<MapMoe>, DN_ALIGN, true, 121>((PG8_LAS unsigned char*)lds, g, S, E);
    if (layer == 0 && Gq == (int)gridDim.x) cvt8_tail(a, lds, NE * PM * 4, Gq, (int)blockIdx.x, 1, CV1_DN0, CVQ_DN0);
}
#else
__device__ __forceinline__ void ph_gu_fast(const Ctx& a, LAS unsigned char* lds, int layer) {
    unsigned char* ws = a.ws(); const int PM = (layer == 0 ? RPE0 : RPE1) / 256;
    pg8::Gemm g{(const bf16_t*)(ws + WS_XG), (const bf16_t*)(ws + WS_WGU + (size_t)layer * WGU_LAYER), NE * PM * 256, NE * 2 * DE, D};
    ListOrder<MapMoe> S{NE * PM * 22, (int)gridDim.x, (int)blockIdx.x, MapMoe{PM, 22}};
    EpiSwiGLU E{(bf16_t*)(ws + WS_ACT)};
    PG8_RUN(EpiSwiGLU, ListOrder<MapMoe>, g, S, E);
}
__device__ __forceinline__ void ph_dn_fast(const Ctx& a, LAS unsigned char* lds, int layer) {
    unsigned char* ws = a.ws(); const int PM = (layer == 0 ? RPE0 : RPE1) / 256;
    pg8::Gemm g{(const bf16_t*)(ws + WS_ACT), (const bf16_t*)(ws + WS_WDN + (size_t)layer * WDN_LAYER), NE * PM * 256, NE * D, DE};
    const int Gq = layer == 0 ? gemm_groups(NE * PM * 4, (int)gridDim.x) : (int)gridDim.x;
    if ((int)blockIdx.x >= Gq) { cvt8_run(a, 1, CV1_DN0 + ((int)blockIdx.x - Gq), (int)gridDim.x - Gq, CV1_DN0 + CVQ_DN0, lds); return; }
    ListOrder<MapMoe> S{NE * PM * 4, Gq, (int)blockIdx.x, MapMoe{PM, 4}};
    EpiDown E{ws + WS_Y};
    PG8_RUN(EpiDown, ListOrder<MapMoe>, g, S, E);
}
#endif
__device__ __forceinline__ void ph_win_fast(const Ctx& a, LAS unsigned char* lds) {
    unsigned char* ws = a.ws();
    pg8::Gemm g{(const bf16_t*)(ws + WS_XN), (const bf16_t*)(ws + WS_WIN), RT, 2 * D, D};
    const int Gq = gemm_groups(512 + 32, (int)gridDim.x);
    if ((int)blockIdx.x >= Gq) { cvt8_run(a, 1, CV1_WIN + ((int)blockIdx.x - Gq), (int)gridDim.x - Gq, CV1_WIN + CVQ_WIN, lds); return; }
    ListOrder<MapWin> S{512 + 32, Gq, (int)blockIdx.x, MapWin{}};
    LAS float* bl = (LAS float*)(lds + ROPE_LDS);
    { const float* bg = a.in(I_BIN); for (int i = threadIdx.x; i < 2 * D; i += NTHREADS) bl[i] = bg[i]; }
    __syncthreads();
    EpiWin E{(bf16_t*)(ws + WS_YG), (bf16_t*)(ws + WS_XR), bl};
    stagger_start(STG_WIN);
    PG8_RUN(EpiWin, ListOrder<MapWin>, g, S, E);
    if (Gq == (int)gridDim.x) cvt8_tail(a, lds, 512 + 32, Gq, (int)blockIdx.x, 1, CV1_WIN, CVQ_WIN);
}

namespace fa {
using bf16x8 = __attribute__((ext_vector_type(8))) short;
using s16x4  = __attribute__((ext_vector_type(4))) short;
using f32x16 = __attribute__((ext_vector_type(16))) float;
using u32x4v = __attribute__((ext_vector_type(4))) unsigned;
constexpr int SHM_V = 64 * 128 * 2, SHM_K = 64 * 128 * 2;
#ifndef ATT_THR
#define ATT_THR 11.5f
#endif
constexpr float THR_L2 = ATT_THR;
#define KSWZ(row, colB) ((row) * 256 + ((colB) ^ (((row) & 7) << 4)))
#define SBAR() __builtin_amdgcn_sched_barrier(0)
__device__ __forceinline__ int crow(int r, int hi) { return (r & 3) + 8 * (r >> 2) + 4 * hi; }
__device__ __forceinline__ unsigned cvtpk(float lo, float hi) { unsigned r; asm volatile("v_cvt_pk_bf16_f32 %0, %1, %2" : "=v"(r) : "v"(lo), "v"(hi)); return r; }
__device__ __forceinline__ void partialSM(f32x16& p0, f32x16& p1, float& m_reg, float& mn, float& alpha) {
  float pmax = p0[0];
#pragma unroll
  for (int r = 1; r < 16; ++r) pmax = fmaxf(pmax, p0[r]);
#pragma unroll
  for (int r = 0; r < 16; ++r) pmax = fmaxf(pmax, p1[r]);
  { auto rr = __builtin_amdgcn_permlane32_swap(__float_as_uint(pmax), __float_as_uint(pmax), false, false);
    pmax = fmaxf(__uint_as_float(rr[0]), __uint_as_float(rr[1])); }
  if (__builtin_expect(__all(pmax - m_reg <= THR_L2), 1)) { mn = m_reg; alpha = 1.f; }
  else { mn = fmaxf(m_reg, pmax); alpha = __builtin_amdgcn_exp2f(m_reg - mn); m_reg = mn; }
  { typedef float f2_t __attribute__((ext_vector_type(2))); const f2_t mn2 = {mn, mn};
#pragma unroll
    for (int r = 0; r < 16; r += 2) { const f2_t a_ = (f2_t){p0[r], p0[r + 1]} - mn2; p0[r] = a_.x; p0[r + 1] = a_.y; const f2_t b_ = (f2_t){p1[r], p1[r + 1]} - mn2; p1[r] = b_.x; p1[r + 1] = b_.y; } }
#pragma unroll
  for (int r = 0; r < 16; ++r) p0[r] = __builtin_amdgcn_exp2f(p0[r]);
}
__device__ __forceinline__ void finishSM(f32x16& p0, f32x16& p1, float alpha, float& l_reg, bf16x8& pa0, bf16x8& pa1, bf16x8& pa2, bf16x8& pa3) {
#pragma unroll
  for (int r = 0; r < 16; ++r) p1[r] = __builtin_amdgcn_exp2f(p1[r]);
  float ps = 0;
#pragma unroll
  for (int r = 0; r < 16; ++r) ps += p0[r];
#pragma unroll
  for (int r = 0; r < 16; ++r) ps += p1[r];
  { auto rr = __builtin_amdgcn_permlane32_swap(__float_as_uint(ps), __float_as_uint(ps), false, false);
    ps = __uint_as_float(rr[0]) + __uint_as_float(rr[1]); }
  l_reg = l_reg * alpha + ps;
#define PK4(P, BASE, OUT) do { unsigned a0 = cvtpk(P[BASE + 0], P[BASE + 1]), a1 = cvtpk(P[BASE + 2], P[BASE + 3]);   \
    unsigned b0 = cvtpk(P[BASE + 4], P[BASE + 5]), b1 = cvtpk(P[BASE + 6], P[BASE + 7]);                              \
    auto r0 = __builtin_amdgcn_permlane32_swap(a0, b0, false, false); auto r1 = __builtin_amdgcn_permlane32_swap(a1, b1, false, false); \
    u32x4v w = {r0[0], r1[0], r0[1], r1[1]}; OUT = *reinterpret_cast<bf16x8*>(&w); } while (0)
  PK4(p0, 0, pa0); PK4(p0, 8, pa1); PK4(p1, 0, pa2); PK4(p1, 8, pa3);
#undef PK4
}
__device__ __forceinline__ void qkt(f32x16& p0, f32x16& p1, const LAS char* Ks, const bf16x8* qr, int r32, int hi, int s) {
  p0 = f32x16{}; p1 = f32x16{};
#pragma unroll
  for (int d0 = 0; d0 < 4; ++d0) { const int cb = (s * 64 + d0 * 16 + hi * 8) * 2;
    const bf16x8 b0 = *reinterpret_cast<const LAS bf16x8*>(Ks + KSWZ(r32, cb));
    const bf16x8 b1 = *reinterpret_cast<const LAS bf16x8*>(Ks + KSWZ(32 + r32, cb));
    p0 = __builtin_amdgcn_mfma_f32_32x32x16_bf16(b0, qr[d0], p0, 0, 0, 0);
    p1 = __builtin_amdgcn_mfma_f32_32x32x16_bf16(b1, qr[d0], p1, 0, 0, 0); }
}
__device__ __forceinline__ int v_st(int k, int c) { const int kk = (k & ~0xC) | ((k & 4) << 1) | ((k & 8) >> 1); return ((kk >> 3) * 4 + (c >> 5)) * 512 + ((kk & 7) * 32 + (c & 31)) * 2; }
__device__ __forceinline__ int v_rd_base(int lane) { return ((lane & 3) << 3) | (((lane >> 2) & 3) << 6) | (((lane >> 4) & 1) << 5) | (((lane >> 5) & 1) << 8); }
constexpr int v_rd_off(int d0, int ks, int half) { return d0 * 512 + ks * 4096 + half * 2048; }
template <int OFF> __device__ __forceinline__ s16x4 tr_read(int vb) {
  s16x4 r; asm volatile("ds_read_b64_tr_b16 %0, %1 offset:%2" : "=&v"(r) : "v"(vb), "i"(OFF) : "memory"); return r;
}
template <int D0> __device__ __forceinline__ void pv_one(f32x16& od, int vb, bf16x8 pa0, bf16x8 pa1, bf16x8 pa2, bf16x8 pa3) {
  const s16x4 l0 = tr_read<v_rd_off(D0, 0, 0)>(vb), h0 = tr_read<v_rd_off(D0, 0, 1)>(vb), l1 = tr_read<v_rd_off(D0, 1, 0)>(vb), h1 = tr_read<v_rd_off(D0, 1, 1)>(vb);
  const s16x4 l2 = tr_read<v_rd_off(D0, 2, 0)>(vb), h2 = tr_read<v_rd_off(D0, 2, 1)>(vb), l3 = tr_read<v_rd_off(D0, 3, 0)>(vb), h3 = tr_read<v_rd_off(D0, 3, 1)>(vb);
  asm volatile("s_waitcnt lgkmcnt(0)" ::: "memory"); SBAR();
#define PK(L, H) (bf16x8){L[0], L[1], L[2], L[3], H[0], H[1], H[2], H[3]}
  od = __builtin_amdgcn_mfma_f32_32x32x16_bf16(pa0, PK(l0, h0), od, 0, 0, 0);
  od = __builtin_amdgcn_mfma_f32_32x32x16_bf16(pa1, PK(l1, h1), od, 0, 0, 0);
  od = __builtin_amdgcn_mfma_f32_32x32x16_bf16(pa2, PK(l2, h2), od, 0, 0, 0);
  od = __builtin_amdgcn_mfma_f32_32x32x16_bf16(pa3, PK(l3, h3), od, 0, 0, 0);
#undef PK
}
__device__ __forceinline__ void pv_d0(f32x16* o, int vb, bf16x8 pa0, bf16x8 pa1, bf16x8 pa2, bf16x8 pa3) {
  pv_one<0>(o[0], vb, pa0, pa1, pa2, pa3); pv_one<1>(o[1], vb, pa0, pa1, pa2, pa3); pv_one<2>(o[2], vb, pa0, pa1, pa2, pa3); pv_one<3>(o[3], vb, pa0, pa1, pa2, pa3);
}

__device__ __forceinline__ int tile_row(bool latq, int b, int j) { return latq ? (j < 32 ? b * SEQ + 64 * j : RL + b * CTXL + 64 * (j - 32)) : RL + b * CTXL + 64 * j; }

__device__ __forceinline__ void attn_unit(const bf16_t* __restrict__ Qg, const bf16_t* __restrict__ Kg, const bf16_t* __restrict__ Vg, bf16_t* __restrict__ ATT,
                                          const float* subg, float lam, bool latq, int b, int h, int qrow0, LAS unsigned char* lds) {
  const int tid = threadIdx.x, wid = __builtin_amdgcn_readfirstlane(tid >> 6), lane = tid & 63, r32 = lane & 31, hi = lane >> 5, rg = wid >> 1, s = wid & 1;
  LAS char* V_lds = (LAS char*)lds; LAS char* K_lds = (LAS char*)lds + 2 * SHM_V;
  LAS float* ws = (LAS float*)(lds + 65536) + wid * 64; LAS float* li_l = ws; LAS float* al_l = ws + 32;
  const int NT = latq ? 36 : 4;
  float m_reg = -1e30f, l_reg = 0; f32x16 o[4] = {}; bf16x8 qr[4];
  const bf16_t* Qw = Qg + (size_t)(qrow0 + rg * 32 + r32) * D + h * 128 + s * 64 + hi * 8;
#pragma unroll
  for (int d0 = 0; d0 < 4; ++d0) qr[d0] = *reinterpret_cast<const bf16x8*>(Qw + d0 * 16);
  const int sr = tid >> 4, sc = (tid & 15) * 8, vst0 = v_st(sr, sc), vst1 = v_st(32 + sr, sc);
  const int vb0 = (int)(unsigned)(size_t)V_lds + v_rd_base(lane);
  const size_t hoff = (size_t)h * 128 + sc;
  struct { bf16x8 vs0, vs1, ks0, ks1; } sr_[2];
#define SLOAD(i, j) do { const size_t ro_ = (size_t)(tile_row(latq, b, (j)) + sr) * D + hoff; \
    sr_[i].vs0 = *reinterpret_cast<const bf16x8*>(Vg + ro_); sr_[i].vs1 = *reinterpret_cast<const bf16x8*>(Vg + ro_ + 32 * D); \
    sr_[i].ks0 = *reinterpret_cast<const bf16x8*>(Kg + ro_); sr_[i].ks1 = *reinterpret_cast<const bf16x8*>(Kg + ro_ + 32 * D); } while (0)
#define SWRITE(bb, i) do { *(LAS bf16x8*)(V_lds + (bb) * SHM_V + vst0) = sr_[i].vs0; *(LAS bf16x8*)(V_lds + (bb) * SHM_V + vst1) = sr_[i].vs1; const int kc = sc * 2; \
    *(LAS bf16x8*)(K_lds + (bb) * SHM_K + KSWZ(sr, kc)) = sr_[i].ks0; *(LAS bf16x8*)(K_lds + (bb) * SHM_K + KSWZ(32 + sr, kc)) = sr_[i].ks1; } while (0)
#define SWAIT() asm volatile("s_waitcnt vmcnt(4)" ::: "memory")
#define RESC(a_) do { if (__any((a_) < 1.f)) { if (hi == 0) al_l[r32] = (a_); asm volatile("s_waitcnt lgkmcnt(0)" ::: "memory"); \
    _Pragma("unroll") for (int d = 0; d < 4; ++d) _Pragma("unroll") for (int r = 0; r < 16; ++r) o[d][r] *= al_l[crow(r, hi)]; } } while (0)
  f32x16 pA0, pA1, pB0, pB1; float mnA, mnB, alA, alB; bf16x8 pa0, pa1, pa2, pa3;
  constexpr int SE = 0, SO = 1;
  SLOAD(SE, 0); asm volatile("s_waitcnt vmcnt(0)" ::: "memory"); SWRITE(0, SE); __syncthreads();
  qkt(pA0, pA1, K_lds, qr, r32, hi, s); partialSM(pA0, pA1, m_reg, mnA, alA);
  SLOAD(SO, 1); if (2 < NT) SLOAD(SE, 2);
  SWAIT(); SWRITE(1, SO); __syncthreads();
  for (int j = 1; j + 1 < NT; j += 2) {
    SBAR(); qkt(pB0, pB1, K_lds + SHM_K, qr, r32, hi, s);
    finishSM(pA0, pA1, alA, l_reg, pa0, pa1, pa2, pa3); SBAR();
    SLOAD(SO, j + 2); SBAR();
    pv_d0(o, vb0, pa0, pa1, pa2, pa3); partialSM(pB0, pB1, m_reg, mnB, alB);
    __syncthreads(); SWAIT(); SWRITE(0, SE);
    RESC(alB); __syncthreads();
    SBAR(); qkt(pA0, pA1, K_lds, qr, r32, hi, s);
    finishSM(pB0, pB1, alB, l_reg, pa0, pa1, pa2, pa3); SBAR();
    if (j + 3 < NT) SLOAD(SE, j + 3); SBAR();
    pv_d0(o, vb0 + SHM_V, pa0, pa1, pa2, pa3); partialSM(pA0, pA1, m_reg, mnA, alA);
    __syncthreads(); SWAIT(); SWRITE(1, SO);
    RESC(alA); __syncthreads();
  }
  SBAR(); qkt(pB0, pB1, K_lds + SHM_K, qr, r32, hi, s);
  finishSM(pA0, pA1, alA, l_reg, pa0, pa1, pa2, pa3); SBAR();
  pv_d0(o, vb0, pa0, pa1, pa2, pa3); partialSM(pB0, pB1, m_reg, mnB, alB);
  __syncthreads(); RESC(alB);
  finishSM(pB0, pB1, alB, l_reg, pa0, pa1, pa2, pa3); SBAR();
  pv_d0(o, vb0 + SHM_V, pa0, pa1, pa2, pa3);
#undef SLOAD
#undef SWRITE
#undef SWAIT
#undef RESC
  if (hi == 0) li_l[r32] = l_reg;
  asm volatile("s_waitcnt lgkmcnt(0)" ::: "memory");
  float rli[16];
#pragma unroll
  for (int r = 0; r < 16; ++r) rli[r] = __builtin_amdgcn_rcpf(li_l[crow(r, hi)]);
  __syncthreads();
  LAS float* X = (LAS float*)lds + rg * 4096;
  if (s == 1) {
#pragma unroll
    for (int r = 0; r < 16; ++r)
#pragma unroll
      for (int d0 = 0; d0 < 4; ++d0) X[crow(r, hi) * 128 + d0 * 32 + r32] = o[d0][r] * (rli[r] * lam);
  }
  __syncthreads();
  if (s == 0) {
    float rstd[16];
#pragma unroll
    for (int r = 0; r < 16; ++r) {
      float acc = 0.f;
#pragma unroll
      for (int d0 = 0; d0 < 4; ++d0) { const float v = o[d0][r] * rli[r] - X[crow(r, hi) * 128 + d0 * 32 + r32]; o[d0][r] = v; acc += v * v; }
#pragma unroll
      for (int off = 1; off < 32; off <<= 1) acc += __shfl_xor(acc, off);
      rstd[r] = 1.0f / sqrtf(acc * (1.0f / 128.0f) + EPS);
    }
    LAS bf16_t* stg = (LAS bf16_t*)(lds + 65536 + 2048) + rg * 4096;
    float gsc[4];
#pragma unroll
    for (int d0 = 0; d0 < 4; ++d0) gsc[d0] = subg[d0 * 32 + r32] * (1.0f - LAMBDA_INIT0);
#pragma unroll
    for (int r = 0; r < 16; ++r)
#pragma unroll
      for (int d0 = 0; d0 < 4; ++d0) stg[crow(r, hi) * 128 + d0 * 32 + r32] = (bf16_t)f2bf(o[d0][r] * rstd[r] * gsc[d0]);
    asm volatile("s_waitcnt lgkmcnt(0)" ::: "memory");
    bf16_t* Ow = ATT + (size_t)(qrow0 + rg * 32) * D + h * 128;
#pragma unroll
    for (int i = 0; i < 8; ++i) { const int row = i * 4 + (lane >> 4), ch = lane & 15; const u32x4v v = *(const LAS u32x4v*)(stg + row * 128 + ch * 8); *(u32x4v*)(Ow + (size_t)row * D + ch * 8) = v; }
  }
  __syncthreads();
}
#undef KSWZ
#undef SBAR
}

__device__ __forceinline__ void ph_attn_fast(const Ctx& a, LAS unsigned char* lds) {
    unsigned char* ws = a.ws();
    const bf16_t* Q = (const bf16_t*)(ws + WS_Q); const bf16_t* Kb = (const bf16_t*)(ws + WS_K); const bf16_t* V = (const bf16_t*)(ws + WS_V);
    bf16_t* ATT = (bf16_t*)(ws + WS_ATT); const float* subg = a.in(I_SUBG);
    const float lam = diff_lambda(a, threadIdx.x & 63);
    const int G = gridDim.x, c = blockIdx.x;
    for (int i = 0;; ++i) {
        const long L = (long)i * G + c; if (L >= 1024) break;
        const int w = xcd_remap(L, 1024), bh = w >> 4, qb = w & 15, b = bh >> 3, h = bh & 7;
        fa::attn_unit(Q, Kb, V, ATT, subg, lam, true, b, h, b * SEQ + qb * 128, lds);
    }
    for (int L = c; L < 128; L += G) {
        const int bh = L >> 1, qb = L & 1, b = bh >> 3, h = bh & 7;
        fa::attn_unit(Q, Kb, V, ATT, subg, lam, false, b, h, RL + b * CTXL + qb * 128, lds);
    }
#if DENSE_LATE && ANY_FAST_GEMM
    if (c >= 128 && G > 128) { for (int r = c - 128; r < IT_DENSE_REST; r += G - 128) cvt_dense_rest_item(a, r); }
#endif
#if CVT_HIDE && FP8_MOE
    if (c >= 128 && G > 128) { __syncthreads(); cvt8_run(a, 0, CV0_ATT + (c - 128), G - 128, CV0_ATT + CVQ_ATT, lds); }
#endif
}


__device__ __forceinline__ void ph_gates_fast(const Ctx& a, LAS unsigned char* lds) {
    unsigned char* ws = a.ws();
    const bf16_t* XR = (const bf16_t*)(ws + WS_XR); const bf16_t* WG = (const bf16_t*)(ws + WS_WG);
    bf16_t* LOGA = (bf16_t*)(ws + WS_LOGA); unsigned char* BT = ws + WS_BT;
    const float* convw = a.in(I_CONVW); const float* convb = a.in(I_CONVB); const float* gtab = (const float*)(ws + WS_GTAB);
    const int tid = threadIdx.x, wid = __builtin_amdgcn_readfirstlane(tid >> 6), lane = tid & 63, wr = wid >> 2, wc = wid & 3, fr = lane & 15, fq = lane >> 4;
    constexpr int HTB = pg8::HTB;
    const int aoff = pg8::lds_byte(wr * 64 + fr, fq * 8), boff = pg8::lds_byte(wc * 32 + fr, fq * 8);
    const int sc = tid & 15, rg8 = tid >> 4;
    unsigned bsrc[2];
#pragma unroll
    for (int i = 0; i < 2; ++i) { int R, C; pg8::stage_rc(tid * 16 + i * 8192, R, C); bsrc[i] = (unsigned)(((R & ~31) + pg8::perm32(R & 31)) * 128 + C) * 2u; }
    const unsigned ldsw = (unsigned)wid * 1024u;
#define GT_DMA_B(d_) do { const char* wb_ = (const char*)(WG + (size_t)((d_) * 8 + kb) * 256 * 128); \
        _Pragma("unroll") for (int kt_ = 0; kt_ < 2; ++kt_) _Pragma("unroll") for (int h_ = 0; h_ < 2; ++h_) _Pragma("unroll") for (int i_ = 0; i_ < 2; ++i_) \
            __builtin_amdgcn_global_load_lds((const unsigned*)(wb_ + (size_t)h_ * 128 * 256 + kt_ * 128 + bsrc[i_]), (LAS unsigned*)(lds + (4 + kt_ * 2 + h_) * HTB + ldsw + i_ * 8192), 16, 0, 0); } while (0)
    const int Gq = gemm_groups(72 * 8, (int)gridDim.x);
    if ((int)blockIdx.x >= Gq) { cvt8_run(a, 1, CV1_GATES + ((int)blockIdx.x - Gq), (int)gridDim.x - Gq, CV1_GATES + CVQ_GATES, lds); return; }
    for (int u = blockIdx.x; u < 72 * 8; u += Gq) {
        const int kb = u & 7, rt = u >> 3;
        const bool lat = rt < 64; const int bsm = lat ? (rt >> 3) : (rt - 64), t0 = lat ? (rt & 7) * 256 : 0, L = lat ? SEQ : CTXL;
        const int seqbase = lat ? bsm * SEQ : RL + bsm * CTXL;
        GT_DMA_B(0);
        {
            const int ch0 = kb * 128 + sc * 8, r0 = rg8 * 8;
            u32x4 xin[11];
#pragma unroll
            for (int i = 0; i < 11; ++i) { const int tt = t0 + r0 - 2 + i; xin[i] = (tt >= 0 && tt < L) ? *(const u32x4*)(XR + (size_t)(seqbase + tt) * D + ch0) : (u32x4){0u, 0u, 0u, 0u}; }
            f32x4 cw[4][2], cb[2];
#pragma unroll
            for (int j = 0; j < 4; ++j) { cw[j][0] = *(const f32x4*)(convw + j * D + ch0); cw[j][1] = *(const f32x4*)(convw + j * D + ch0 + 4); }
            cb[0] = *(const f32x4*)(convb + ch0); cb[1] = *(const f32x4*)(convb + ch0 + 4);
#pragma unroll
            for (int k = 0; k < 8; ++k) {
                f32x4 o0 = cb[0], o1 = cb[1];
#pragma unroll
                for (int j = 0; j < 4; ++j) { const u32x4 x = xin[k + j];
                    o0 += cw[j][0] * (f32x4){bf_lo(x.x), bf_hi(x.x), bf_lo(x.y), bf_hi(x.y)}; o1 += cw[j][1] * (f32x4){bf_lo(x.z), bf_hi(x.z), bf_lo(x.w), bf_hi(x.w)}; }
                const int r = r0 + k;
                u32x4 w; w.x = pk2(o0[0], o0[1]); w.y = pk2(o0[2], o0[3]); w.z = pk2(o1[0], o1[1]); w.w = pk2(o1[2], o1[3]);
                *(LAS u32x4*)(lds + ((sc >> 3) * 2 + (r >> 7)) * HTB + pg8::lds_byte(r & 127, (sc & 7) * 8)) = w;
            }
        }
#pragma unroll 1
        for (int d = 0; d < 2; ++d) {
            asm volatile("s_waitcnt vmcnt(0)" ::: "memory");
            __syncthreads();
            pf4 acc[2][2][4][2];
#pragma unroll
            for (int ai = 0; ai < 2; ++ai)
#pragma unroll
                for (int bj = 0; bj < 2; ++bj)
#pragma unroll
                    for (int m = 0; m < 4; ++m)
#pragma unroll
                        for (int n = 0; n < 2; ++n) acc[ai][bj][m][n] = (pf4){0.f, 0.f, 0.f, 0.f};
#pragma unroll 1
            for (int kt = 0; kt < 2; ++kt)
#pragma unroll
                for (int ai = 0; ai < 2; ++ai) {
                    __builtin_amdgcn_sched_barrier(0);
                    pg8::bf16x8 At[4][2];
#pragma unroll
                    for (int m = 0; m < 4; ++m)
#pragma unroll
                        for (int k = 0; k < 2; ++k) At[m][k] = *(const LAS pg8::bf16x8*)(lds + (kt * 2 + ai) * HTB + aoff + m * 2048 + k * 1024);
#pragma unroll
                    for (int bj = 0; bj < 2; ++bj) {
                        pg8::bf16x8 Bf[2][2];
#pragma unroll
                        for (int n = 0; n < 2; ++n)
#pragma unroll
                            for (int k = 0; k < 2; ++k) Bf[n][k] = *(const LAS pg8::bf16x8*)(lds + (4 + kt * 2 + bj) * HTB + boff + n * 2048 + k * 1024);
#pragma unroll
                        for (int m = 0; m < 4; ++m)
#pragma unroll
                            for (int n = 0; n < 2; ++n)
#pragma unroll
                                for (int k = 0; k < 2; ++k) acc[ai][bj][m][n] = __builtin_amdgcn_mfma_f32_16x16x32_bf16(Bf[n][k], At[m][k], acc[ai][bj][m][n], 0, 0, 0);
                        __builtin_amdgcn_sched_barrier(0);
                    }
                }
            if (d == 0) { __syncthreads(); GT_DMA_B(1); }
            const int cc0 = wc * 32 + fq * 8;
            pf4 cl[2], c2[2], brn[2], bin[2];
#pragma unroll
            for (int n = 0; n < 2; ++n) { const float* g = gtab + (size_t)(d * 4) * D + kb * 128 + cc0 + 4 * n;
                cl[n] = *(const pf4*)g; c2[n] = *(const pf4*)(g + D); brn[n] = *(const pf4*)(g + 2 * D); bin[n] = *(const pf4*)(g + 3 * D); }
#pragma unroll
            for (int ai = 0; ai < 2; ++ai)
#pragma unroll
                for (int m = 0; m < 4; ++m) {
                    const int rl = wr * 64 + m * 16 + fr;
                    const int grow = seqbase + t0 + ai * 128 + rl;
                    float la[8], bt[8];
#pragma unroll
                    for (int n = 0; n < 2; ++n) {
                        const int cc = cc0 + 4 * n;
                        const u32x2 xw = *(const LAS u32x2*)(lds + ((cc >> 6) * 2 + ai) * HTB + pg8::lds_byte(rl, cc & 63));
                        const float xv[4] = {bf_lo(xw.x), bf_hi(xw.x), bf_lo(xw.y), bf_hi(xw.y)};
#pragma unroll
                        for (int j = 0; j < 4; ++j) {
                            const float r = __builtin_amdgcn_rcpf(1.0f + __builtin_amdgcn_exp2f(fmaf(acc[ai][0][m][n][j], -1.4426950408889634f, brn[n][j])));
                            const float ig = __builtin_amdgcn_rcpf(1.0f + __builtin_amdgcn_exp2f(fmaf(acc[ai][1][m][n][j], -1.4426950408889634f, bin[n][j])));
                            const float om = 1.0f - __builtin_amdgcn_exp2f(r * c2[n][j]);
                            la[n * 4 + j] = r * cl[n][j]; bt[n * 4 + j] = __builtin_amdgcn_sqrtf(om) * (ig * xv[j]) * BT_SCALE;
                        }
                    }
                    const size_t o = ((size_t)d * RT + grow) * D + kb * 128 + cc0;
                    u32x4 w; w.x = pk2(la[0], la[1]); w.y = pk2(la[2], la[3]); w.z = pk2(la[4], la[5]); w.w = pk2(la[6], la[7]);
                    *(u32x4*)(LOGA + o) = w;
                    u32x2 wb; wb.x = pk4_fp8(bt[0], bt[1], bt[2], bt[3]); wb.y = pk4_fp8(bt[4], bt[5], bt[6], bt[7]);
                    *(u32x2*)(BT + o) = wb;
                }
        }
#if FUSE_SCAN1
        asm volatile("s_waitcnt vmcnt(0)" ::: "memory");
        __syncthreads();
        {
            const int dir = wid >> 2, lc = wid & 3, kc = (t0 >> 6) + lc;
            const int c = dir == 0 ? (lat ? NCH_CTX + kc : kc) : (lat ? NCH - 1 - kc : NCH_CTX - 1 - kc);
            const int ch = kb * 128 + 2 * lane;
            float* CP = (float*)(ws + WS_CP); float* CB = (float*)(ws + WS_CB);
            float h0 = 0.f, h1 = 0.f, p0 = 0.f, p1 = 0.f;
#pragma unroll 1
            for (int sg = 0; sg < SCH; sg += 32) {
                unsigned la[32], bt[32];
#pragma unroll
                for (int i = 0; i < 32; ++i) { const size_t o = ((size_t)dir * RT + scan_row(bsm, dir, c, sg + i)) * D + ch; la[i] = *(const unsigned*)(LOGA + o); bt[i] = *(const unsigned short*)(BT + o); }
                asm volatile("" ::: "memory");
#pragma unroll
                for (int i = 0; i < 32; ++i) { const float l0 = bf_lo(la[i]), l1 = bf_hi(la[i]); const f32x2 bb = __builtin_amdgcn_cvt_pk_f32_fp8((int)bt[i], false);
                    h0 = __builtin_amdgcn_exp2f(l0) * h0 + bb.x; h1 = __builtin_amdgcn_exp2f(l1) * h1 + bb.y; p0 += l0; p1 += l1; }
            }
            const size_t so = ((size_t)(bsm * 2 + dir) * NCH + c) * D + ch;
            *(f32x2*)(CP + so) = (f32x2){p0, p1}; *(f32x2*)(CB + so) = (f32x2){h0, h1};
        }
#endif
        __syncthreads();
    }
#undef GT_DMA_B
    if (Gq == (int)gridDim.x) cvt8_tail(a, lds, 72 * 8, Gq, (int)blockIdx.x, 1, CV1_GATES, CVQ_GATES);
}

constexpr int NPHASES = 25;
__host__ __device__ constexpr bool phase_enabled(int p) {
    return !((p == 3 && FAST_QKV) || (p == 9 && FAST_GU) || (p == 22 && FAST_GU) || (p == 13 && FAST_GATES) || (p == 15 && FAST_GATES) || (p == 16 && FAST_GATES && FUSE_SCAN1));
}

__global__ void __launch_bounds__(NTHREADS, 2) hybrid_fwd(Args args) {
    extern __shared__ __attribute__((aligned(16))) unsigned char lds_raw[];
    LAS unsigned char* lds = (LAS unsigned char*)lds_raw;
    volatile LAS unsigned* MISC = (volatile LAS unsigned*)(lds + MISC_OFF);
    const int lo = args.ph_lo, hi = args.ph_hi;
    if (threadIdx.x == 0) {
        LAS unsigned long long* la64 = (LAS unsigned long long*)(lds + ARGS_OFF);
#pragma unroll
        for (int i = 0; i < 27; ++i) la64[i] = (unsigned long long)args.in[i];
        la64[27] = (unsigned long long)args.out; la64[28] = (unsigned long long)args.ws;
    }
    Ctx ctx; ctx.la = (const LAS unsigned*)(lds + ARGS_OFF);
    if (threadIdx.x < 16) MISC[threadIdx.x] = 0u;
    __syncthreads();
#if MK_ONE_LAUNCH
    XcdBarrier bar = xcd_barrier_post((unsigned*)(ctx.ws() + WS_CTL) + CW_BAR, MISC + 8);
#define GRID_BAR() xcd_barrier(bar)
#else
#define GRID_BAR() do { } while (0)
#endif
#ifndef REP_MASK
#define REP_MASK 0u
#endif
#define RUN(k, call) do { call; if constexpr (((REP_MASK) >> (k)) & 1u) { __syncthreads(); call; } } while (0)
#define IN(k) (lo <= (k) && (k) < hi)
#define SEAM(k) do { if ((k) + 1 < hi) GRID_BAR(); } while (0)

    if (IN(0)) { RUN(0, ph_prologue(ctx, lds)); SEAM(0); }
    if (IN(1)) { RUN(1, ph_norm1_l0(ctx)); SEAM(1); }
    if (IN(2)) {
#if FAST_QKV
        RUN(2, ph_qkv_fast(ctx, lds));
#else
        RUN(2, ph_qkv_naive(ctx, lds));
#endif
        SEAM(2); }
#if !FAST_QKV
    if (IN(3)) { RUN(3, ph_rope_naive(ctx)); SEAM(3); }
#endif
    if (IN(4)) {
#if FAST_ATTN
        RUN(4, ph_attn_fast(ctx, lds));
#else
        RUN(4, ph_attn_naive(ctx, lds));
#endif
        SEAM(4); }
    if (IN(5)) {
#if FAST_WO
        RUN(5, ph_wo_fast(ctx, lds));
#else
        RUN(5, ph_wo_naive(ctx, lds));
#endif
        SEAM(5); }
    if (IN(6)) { RUN(6, ph_norm2_router(ctx, lds, 0, RT)); SEAM(6); }
    if (IN(7)) { RUN(7, ph_topk_gather(ctx, lds, 0)); SEAM(7); }
    if (IN(8)) {
#if FAST_GU
        RUN(8, ph_gu_fast(ctx, lds, 0));
#else
        RUN(8, ph_gu_naive(ctx, lds, 0));
#endif
        SEAM(8); }
#if !FAST_GU
    if (IN(9)) { RUN(9, ph_swiglu_naive(ctx, 0)); SEAM(9); }
#endif
    if (IN(10)) {
#if FAST_DN
        RUN(10, ph_dn_fast(ctx, lds, 0));
#else
        RUN(10, ph_dn_naive(ctx, lds, 0));
#endif
        SEAM(10); }
    if (IN(11)) { RUN(11, ph_combine<0>(ctx, 0, RT)); SEAM(11); }
    if (IN(12)) {
#if FAST_WIN
        RUN(12, ph_win_fast(ctx, lds));
#else
        RUN(12, ph_win_naive(ctx, lds));
#endif
        SEAM(12); }
#if !FAST_GATES
    if (IN(13)) { RUN(13, ph_conv_naive(ctx)); SEAM(13); }
#endif
    if (IN(14)) {
#if FAST_GATES
        RUN(14, ph_gates_fast(ctx, lds));
#else
        RUN(14, ph_gates_naive(ctx, lds));
#endif
        SEAM(14); }
#if !FAST_GATES
    if (IN(15)) { RUN(15, ph_gate_elem_naive(ctx)); SEAM(15); }
#endif
#if !(FUSE_SCAN1 && FAST_GATES)
    if (IN(16)) { RUN(16, ph_scan1(ctx)); SEAM(16); }
#endif
    if (IN(17)) { RUN(17, ph_scan2(ctx)); SEAM(17); }
    if (IN(18)) {
#if FAST_WOUT
        RUN(18, ph_wout_fast(ctx, lds));
#else
        RUN(18, ph_wout_naive(ctx, lds));
#endif
        SEAM(18); }
    if (IN(19)) { RUN(19, ph_norm2_router(ctx, lds, 1, RL)); SEAM(19); }
    if (IN(20)) { RUN(20, ph_topk_gather(ctx, lds, 1)); SEAM(20); }
    if (IN(21)) {
#if FAST_GU
        RUN(21, ph_gu_fast(ctx, lds, 1));
#else
        RUN(21, ph_gu_naive(ctx, lds, 1));
#endif
        SEAM(21); }
#if !FAST_GU
    if (IN(22)) { RUN(22, ph_swiglu_naive(ctx, 1)); SEAM(22); }
#endif
    if (IN(23)) {
#if FAST_DN
        RUN(23, ph_dn_fast(ctx, lds, 1));
#else
        RUN(23, ph_dn_naive(ctx, lds, 1));
#endif
        SEAM(23); }
    if (IN(24)) { RUN(24, ph_combine<1>(ctx, 1, RL)); }
#undef IN
#undef SEAM
#undef GRID_BAR
}

extern "C" void kernel_launch(void* const* d_in, const int* in_sizes, int n_in, void* d_out, int out_size, void* d_ws, size_t ws_size, hipStream_t stream) {
    static int grid = 0;
    if (grid == 0) {
        if (n_in != 27 || out_size != RL * D || ws_size < WS_END) { fprintf(stderr, "kernel_launch: unexpected shapes (n_in %d out %d ws %zu)\n", n_in, out_size, ws_size); grid = -1; return; }
        int dev = 0, cus = 0, per_cu = 0;
        if (hipGetDevice(&dev) != hipSuccess || hipDeviceGetAttribute(&cus, hipDeviceAttributeMultiprocessorCount, dev) != hipSuccess) { grid = -1; return; }
        if (hipFuncSetAttribute((const void*)hybrid_fwd, hipFuncAttributeMaxDynamicSharedMemorySize, LDS_BYTES) != hipSuccess) { fprintf(stderr, "kernel_launch: hipFuncSetAttribute failed\n"); grid = -1; return; }
        if (hipOccupancyMaxActiveBlocksPerMultiprocessor(&per_cu, (const void*)hybrid_fwd, NTHREADS, LDS_BYTES) != hipSuccess || per_cu < 1) { fprintf(stderr, "kernel_launch: occupancy query says %d\n", per_cu); }
        (void)hipGetLastError();
        grid = cus > 0 ? cus : 256;
    }
    if (grid < 0) return;
    if (hipMemsetAsync((char*)d_ws + WS_CTL, 0, CTL_ZERO_BYTES, stream) != hipSuccess) return;
    Args a{};
    for (int i = 0; i < 27; ++i) a.in[i] = (const float*)d_in[i];
    a.out = (float*)d_out; a.ws = (unsigned char*)d_ws;
#if MK_ONE_LAUNCH
    a.ph_lo = 0; a.ph_hi = NPHASES;
    hipLaunchKernelGGL(hybrid_fwd, dim3(grid), dim3(NTHREADS), LDS_BYTES, stream, a);
#else
    for (int p = 0; p < NPHASES; ++p) {
        if (!phase_enabled(p)) continue;
        a.ph_lo = p; a.ph_hi = p + 1;
        hipLaunchKernelGGL(hybrid_fwd, dim3(grid), dim3(NTHREADS), LDS_BYTES, stream, a);
    }
#endif
    const hipError_t le = hipPeekAtLastError();
    if (le != hipSuccess) fprintf(stderr, "kernel_launch: launch failed: %s\n", hipGetErrorName(le));
}
```

```cpp
#define MK_ONE_LAUNCH 1
#define FAST_QKV 1
#define FAST_WO 1
#define FAST_GU 1
#define FAST_DN 1
#define FAST_WIN 1
#define FAST_WOUT 1
#define FAST_ATTN 1
#define FAST_GATES 1
#define FP8_MOE 1
#include <hip/hip_runtime.h>
#include <cstdio>
#include <cstdint>
#include <cmath>

#ifndef MK_ONE_LAUNCH
#define MK_ONE_LAUNCH 0
#endif
#ifndef FAST_QKV
#define FAST_QKV 0
#endif
#ifndef FAST_ATTN
#define FAST_ATTN 0
#endif
#ifndef FAST_WO
#define FAST_WO 0
#endif
#ifndef FAST_GU
#define FAST_GU 0
#endif
#ifndef FAST_DN
#define FAST_DN 0
#endif
#ifndef FAST_WIN
#define FAST_WIN 0
#endif
#ifndef FAST_GATES
#define FAST_GATES 0
#endif
#ifndef FAST_WOUT
#define FAST_WOUT 0
#endif
#ifndef FP8_MOE
#define FP8_MOE 0
#endif
#ifndef GU_ALIGN
#define GU_ALIGN true
#endif
#ifndef DN_ALIGN
#define DN_ALIGN true
#endif
#ifndef FUSE_SCAN1
#define FUSE_SCAN1 1
#endif
#define ANY_FAST_GEMM (FAST_QKV || FAST_WO || FAST_GU || FAST_DN || FAST_WIN || FAST_GATES || FAST_WOUT)

namespace pg8 {
#define PG8_LAS __attribute__((address_space(3)))
typedef unsigned short bf16_t;
typedef short bf16x8 __attribute__((ext_vector_type(8)));
typedef float f32x4 __attribute__((ext_vector_type(4)));
typedef unsigned u32x4 __attribute__((ext_vector_type(4)));
constexpr int BM = 256, BK = 64, HALF = 128, HTB = HALF * BK * 2  , STAGE_BYTES = 8 * HTB, NXCD = 8, WGM = 8;

__host__ __device__ __forceinline__ int lds_byte(int r, int c) { const int st = (r >> 4) * 2 + (c >> 5), rr = r & 15, cc = c & 31, ob = rr * 64 + cc * 2; return st * 1024 + (ob ^ (((ob >> 9) & 1) << 5)); }
__host__ __device__ __forceinline__ void stage_rc(int b, int& R, int& C) { const int st = b / 1024, sb = b % 1024, swz = sb ^ (((sb >> 9) & 1) << 5); R = (st >> 1) * 16 + swz / 64; C = (st & 1) * 32 + (swz % 64) / 2; }
__host__ __device__ __forceinline__ int perm32(int rho) { const int n = rho >> 4, i = rho & 15; return 8 * (i >> 2) + 4 * n + (i & 3); }

struct Unit { int pm, pn; };
struct Gemm { const bf16_t* A; const bf16_t* Bt; int M, N, K; };
__device__ __forceinline__ unsigned cvt_pk_bf16(float lo, float hi) { unsigned r; asm volatile("v_cvt_pk_bf16_f32 %0, %1, %2" : "=v"(r) : "v"(lo), "v"(hi)); return r; }
typedef int v4i_t __attribute__((ext_vector_type(4)));
typedef int v8i_t __attribute__((ext_vector_type(8)));
__device__ __forceinline__ v8i_t cat8(bf16x8 lo, bf16x8 hi) { const v4i_t a = __builtin_bit_cast(v4i_t, lo), b = __builtin_bit_cast(v4i_t, hi); return __builtin_shufflevector(a, b, 0, 1, 2, 3, 4, 5, 6, 7); }
template <class Epi, class Sched, bool ALIGN_EPI = false, bool SP2 = false, int FP8SCALE = 0  >
__device__ __forceinline__ void gemm_phase(PG8_LAS unsigned char* lds, const Gemm g, const Sched& S, const Epi& E) {
    const int tid = threadIdx.x, wid = __builtin_amdgcn_readfirstlane(tid >> 6), lane = tid & 63, wr = wid >> 2, wc = wid & 3, fr = lane & 15, fq = lane >> 4;
    const int K = g.K, nt = K / BK;
    unsigned voffA[2], voffB[2];
#pragma unroll
    for (int i = 0; i < 2; ++i) { int R, C; stage_rc(tid * 16 + i * 8192, R, C); const int Rb = Epi::PERM ? ((R & ~31) + perm32(R & 31)) : R;
        voffA[i] = (unsigned)(R * K + C) * 2u; voffB[i] = (unsigned)(Rb * K + C) * 2u; }
    const size_t kstep = (size_t)(BK * 2);
    const size_t hstep = (size_t)HALF * K * 2;
    const size_t tstep = 2 * hstep;
    const unsigned ldsw = (unsigned)wid * 1024u;
    const int aoff = lds_byte(wr * 64 + fr, fq * 8), boff = lds_byte(wc * 32 + fr, fq * 8);
#define PG8_SA(b, h) (((b) * 2 + (h)) * HTB)
#define PG8_SB(b, h) ((4 + (b) * 2 + (h)) * HTB)
#ifndef PG8_B_AUX
#define PG8_B_AUX 0
#endif
#define PG8_STAGE(bufoff, gbase, voff) do { _Pragma("unroll") for (int _i = 0; _i < 2; ++_i) { \
        if constexpr (FP8SCALE != 0 && PG8_B_AUX != 0) { if ((bufoff) >= 4 * HTB) __builtin_amdgcn_global_load_lds((const unsigned*)((const char*)(gbase) + (voff)[_i]), (PG8_LAS unsigned*)(lds + (bufoff) + ldsw + _i * 8192), 16, 0, PG8_B_AUX); \
            else __builtin_amdgcn_global_load_lds((const unsigned*)((const char*)(gbase) + (voff)[_i]), (PG8_LAS unsigned*)(lds + (bufoff) + ldsw + _i * 8192), 16, 0, 0); } \
        else __builtin_amdgcn_global_load_lds((const unsigned*)((const char*)(gbase) + (voff)[_i]), (PG8_LAS unsigned*)(lds + (bufoff) + ldsw + _i * 8192), 16, 0, 0); } } while (0)
#define PG8_LDA(dst, b, h) do { if constexpr (FP8SCALE == 0) { _Pragma("unroll") for (int m = 0; m < 4; ++m) _Pragma("unroll") for (int k = 0; k < 2; ++k) dst[m][k] = *(const PG8_LAS bf16x8*)(lds + PG8_SA(b, h) + aoff + m * 2048 + k * 1024); } \
        else { _Pragma("unroll") for (int m = 0; m < 4; ++m) { const v4i_t lo_ = *(const PG8_LAS v4i_t*)(lds + PG8_SA(b, h) + aoff + m * 2048), hi_ = *(const PG8_LAS v4i_t*)(lds + PG8_SA(b, h) + aoff + m * 2048 + 1024); dst##8[m] = __builtin_shufflevector(lo_, hi_, 0, 1, 2, 3, 4, 5, 6, 7); } } } while (0)
#define PG8_LDB(dst, b, h) do { if constexpr (FP8SCALE == 0) { _Pragma("unroll") for (int n = 0; n < 2; ++n) _Pragma("unroll") for (int k = 0; k < 2; ++k) dst[n][k] = *(const PG8_LAS bf16x8*)(lds + PG8_SB(b, h) + boff + n * 2048 + k * 1024); } \
        else { _Pragma("unroll") for (int n = 0; n < 2; ++n) { const v4i_t lo_ = *(const PG8_LAS v4i_t*)(lds + PG8_SB(b, h) + boff + n * 2048), hi_ = *(const PG8_LAS v4i_t*)(lds + PG8_SB(b, h) + boff + n * 2048 + 1024); dst##8[n] = __builtin_shufflevector(lo_, hi_, 0, 1, 2, 3, 4, 5, 6, 7); } } } while (0)
#define PG8_MMA(ai, bj, At, Bt) do { __builtin_amdgcn_s_setprio(1); \
        if constexpr (FP8SCALE == 0) { _Pragma("unroll") for (int m = 0; m < 4; ++m) _Pragma("unroll") for (int n = 0; n < 2; ++n) _Pragma("unroll") for (int k = 0; k < 2; ++k) \
            acc[ai][bj][m][n] = __builtin_amdgcn_mfma_f32_16x16x32_bf16(Bt[n][k], At[m][k], acc[ai][bj][m][n], 0, 0, 0); } \
        else { _Pragma("unroll") for (int m = 0; m < 4; ++m) _Pragma("unroll") for (int n = 0; n < 2; ++n) \
            asm volatile("v_mfma_scale_f32_16x16x128_f8f6f4 %0, %1, %2, %0, %3, %4 op_sel_hi:[0,0,0]" : "+v"(acc[ai][bj][m][n]) : "v"(Bt##8[n]), "v"(At##8[m]), "v"(sclW), "v"(sclA)); } \
        __builtin_amdgcn_s_setprio(0); } while (0)
#define PG8_WAIT_V(n) asm volatile("s_waitcnt vmcnt(" #n ")" ::: "memory")
#define PG8_WAIT_L(n) asm volatile("s_waitcnt lgkmcnt(" #n ")" ::: "memory")
#define PG8_BAR __builtin_amdgcn_s_barrier()
#define PG8_SCHED __builtin_amdgcn_sched_barrier(0)
    Unit cur, nxt; int ui = 0;
    if (!S.next(0, cur)) return;
    f32x4 acc[2][2][4][2];
#pragma unroll
    for (int a = 0; a < 2; ++a)
#pragma unroll
        for (int b = 0; b < 2; ++b)
#pragma unroll
            for (int m = 0; m < 4; ++m)
#pragma unroll
                for (int n = 0; n < 2; ++n) acc[a][b][m][n] = (f32x4){0.f, 0.f, 0.f, 0.f};
    bf16x8 At[4][2], B0[2][2], B1[2][2]; v8i_t At8[4], B08[2], B18[2]; const int sclW = FP8SCALE * 0x01010101, sclA = 0x7f7f7f7f;
    const char* cA = (const char*)g.A + (size_t)cur.pm * tstep; const char* cB = (const char*)g.Bt + (size_t)cur.pn * tstep;
    S.a_ready(cur);
    if constexpr (SP2) {
        PG8_STAGE(PG8_SB(0, 0), cB, voffB); PG8_STAGE(PG8_SB(0, 1), cB + hstep, voffB); PG8_STAGE(PG8_SA(0, 0), cA, voffA); PG8_STAGE(PG8_SA(0, 1), cA + hstep, voffA);
        if (wr == 1) PG8_BAR;
        PG8_WAIT_V(2); PG8_BAR;
        PG8_STAGE(PG8_SB(1, 0), cB + kstep, voffB); PG8_STAGE(PG8_SA(1, 0), cA + kstep, voffA); PG8_STAGE(PG8_SB(1, 1), cB + hstep + kstep, voffB);
        PG8_WAIT_V(6); PG8_BAR;
    } else {
        PG8_STAGE(PG8_SB(0, 0), cB, voffB); PG8_STAGE(PG8_SA(0, 0), cA, voffA); PG8_STAGE(PG8_SB(0, 1), cB + hstep, voffB); PG8_STAGE(PG8_SA(0, 1), cA + hstep, voffA);
        if (wr == 1) PG8_BAR;
        PG8_WAIT_V(4); PG8_BAR;
        PG8_STAGE(PG8_SB(1, 0), cB + kstep, voffB); PG8_STAGE(PG8_SA(1, 0), cA + kstep, voffA); PG8_STAGE(PG8_SB(1, 1), cB + hstep + kstep, voffB);
        PG8_WAIT_V(6); PG8_BAR;
    }
    for (;;) {
        const bool has_next = S.next(ui + 1, nxt);
        const char* nA = has_next ? (const char*)g.A + (size_t)nxt.pm * tstep : cA; const char* nB = has_next ? (const char*)g.Bt + (size_t)nxt.pn * tstep : cB;
        for (int t = 0; t < nt; t += 2) {
            const bool last = (t == nt - 2);
            const char* a1 = cA + (size_t)(t + 1) * kstep;
            const char* a2 = last ? nA : cA + (size_t)(t + 2) * kstep; const char* b2 = last ? nB : cB + (size_t)(t + 2) * kstep;
            const char* a3 = a2 + kstep; const char* b3 = b2 + kstep;
            if (last && has_next) S.a_ready(nxt);
            if constexpr (SP2) {
            PG8_LDB(B0, 0, 0); PG8_LDB(B1, 0, 1); PG8_SCHED; PG8_LDA(At, 0, 0); PG8_STAGE(PG8_SA(1, 1), a1 + hstep, voffA);
            PG8_WAIT_V(8); PG8_WAIT_L(0); PG8_BAR; PG8_MMA(0, 0, At, B0); PG8_MMA(0, 1, At, B1); PG8_BAR; PG8_SCHED;
            PG8_LDA(At, 0, 1); PG8_STAGE(PG8_SB(0, 0), b2, voffB); PG8_STAGE(PG8_SB(0, 1), b2 + hstep, voffB); PG8_STAGE(PG8_SA(0, 0), a2, voffA);
            PG8_WAIT_V(8); PG8_WAIT_L(0); PG8_BAR; PG8_MMA(1, 0, At, B0); PG8_MMA(1, 1, At, B1); PG8_BAR; PG8_SCHED;
            PG8_LDB(B0, 1, 0); PG8_LDB(B1, 1, 1); PG8_SCHED; PG8_LDA(At, 1, 0); PG8_STAGE(PG8_SA(0, 1), a2 + hstep, voffA);
            PG8_WAIT_V(8); PG8_WAIT_L(0); PG8_BAR; PG8_MMA(0, 0, At, B0); PG8_MMA(0, 1, At, B1); PG8_BAR; PG8_SCHED;
            PG8_LDA(At, 1, 1); PG8_STAGE(PG8_SB(1, 0), b3, voffB); PG8_STAGE(PG8_SB(1, 1), b3 + hstep, voffB); PG8_STAGE(PG8_SA(1, 0), a3, voffA);
            PG8_WAIT_V(8); PG8_WAIT_L(0); PG8_BAR; PG8_MMA(1, 0, At, B0); PG8_MMA(1, 1, At, B1); PG8_BAR; PG8_SCHED;
            } else {
            PG8_LDB(B0, 0, 0); PG8_SCHED; PG8_LDA(At, 0, 0); PG8_STAGE(PG8_SA(1, 1), a1 + hstep, voffA);
            PG8_WAIT_L(8); PG8_BAR; PG8_WAIT_L(0); PG8_MMA(0, 0, At, B0); PG8_BAR; PG8_SCHED;
            PG8_LDB(B1, 0, 1); PG8_STAGE(PG8_SB(0, 0), b2, voffB);
            PG8_BAR; PG8_WAIT_L(0); PG8_MMA(0, 1, At, B1); PG8_BAR;
            PG8_LDA(At, 0, 1); PG8_STAGE(PG8_SA(0, 0), a2, voffA);
            PG8_BAR; PG8_WAIT_L(0); PG8_MMA(1, 0, At, B0); PG8_BAR; PG8_SCHED;
            PG8_STAGE(PG8_SB(0, 1), b2 + hstep, voffB);
            PG8_WAIT_V(6); PG8_BAR; PG8_MMA(1, 1, At, B1); PG8_BAR;
            PG8_LDB(B0, 1, 0); PG8_SCHED; PG8_LDA(At, 1, 0); PG8_STAGE(PG8_SA(0, 1), a2 + hstep, voffA);
            PG8_WAIT_L(8); PG8_BAR; PG8_WAIT_L(0); PG8_MMA(0, 0, At, B0); PG8_BAR; PG8_SCHED;
            PG8_LDB(B1, 1, 1); PG8_STAGE(PG8_SB(1, 0), b3, voffB);
            PG8_BAR; PG8_WAIT_L(0); PG8_MMA(0, 1, At, B1); PG8_BAR;
            PG8_LDA(At, 1, 1); PG8_STAGE(PG8_SA(1, 0), a3, voffA);
            PG8_BAR; PG8_WAIT_L(0); PG8_MMA(1, 0, At, B0); PG8_BAR; PG8_SCHED;
            PG8_STAGE(PG8_SB(1, 1), b3 + hstep, voffB);
            PG8_WAIT_V(6); PG8_BAR; PG8_MMA(1, 1, At, B1); PG8_BAR;
            }
        }
        if constexpr (ALIGN_EPI) { if (wr == 0) PG8_BAR; }
        if constexpr (FP8SCALE != 0) asm volatile("s_nop 15\n\ts_nop 15" ::: "memory");
        if constexpr (!Epi::AFTER_DRAIN) { E(acc, cur, wr, wc, fr, fq); S.done(cur); }
        if (!has_next) break;
#pragma unroll
        for (int a = 0; a < 2; ++a)
#pragma unroll
            for (int b = 0; b < 2; ++b)
#pragma unroll
                for (int m = 0; m < 4; ++m)
#pragma unroll
                    for (int n = 0; n < 2; ++n) acc[a][b][m][n] = (f32x4){0.f, 0.f, 0.f, 0.f};
        cur = nxt; cA = nA; cB = nB; ++ui;
        if constexpr (ALIGN_EPI) { if (wr == 1) PG8_BAR; }
    }
    PG8_WAIT_V(0);
    if constexpr (!ALIGN_EPI) { if (wr == 0) PG8_BAR; }
    PG8_BAR;
    if constexpr (Epi::AFTER_DRAIN) { E.fused(acc, cur, wr, wc, fr, fq, lds, wid, lane); S.done(cur); }
#undef PG8_SA
#undef PG8_SB
#undef PG8_STAGE
#undef PG8_LDA
#undef PG8_LDB
#undef PG8_MMA
#undef PG8_WAIT_V
#undef PG8_WAIT_L
#undef PG8_BAR
#undef PG8_SCHED
}
}

#define LAS __attribute__((address_space(3)))
typedef unsigned short bf16_t;
typedef float f32x4 __attribute__((ext_vector_type(4)));
typedef float f32x2 __attribute__((ext_vector_type(2)));
typedef unsigned u32x4 __attribute__((ext_vector_type(4)));
typedef unsigned u32x2 __attribute__((ext_vector_type(2)));
typedef short bf16x8 __attribute__((ext_vector_type(8)));

constexpr int NB = 8, SEQ = 2048, CTXL = 256, D = 1024;
constexpr int RL = NB * SEQ, RC = NB * CTXL, RT = RL + RC;
constexpr int NE = 16, DE = 2816, CAPL = 256, CAPC = 32;
constexpr int RPE0 = NB * CAPL + NB * CAPC, RPE1 = NB * CAPL;
constexpr int NWAVES = 8, NTHREADS = 512;
constexpr float EPS = 1e-6f;
constexpr float QSCALE = 0.125f * 1.4426950408889634f;
constexpr float LAMBDA_INIT0 = 0.2f;
constexpr int M_SH1 = 0, M_SC1 = 1024, M_G1 = 2048, M_SH2 = 3072, M_SC2 = 4096, M_G2 = 5120;
constexpr int SCH = 64, NCH = (CTXL + SEQ) / SCH, NCH_CTX = CTXL / SCH;

constexpr size_t MiB = 1u << 20;
constexpr size_t WS_CTL = 0, CTL_ZERO_BYTES = 32768;
constexpr size_t WS_GTAB = 2 * MiB + 65536;
constexpr size_t WS_MOD = 1 * MiB, WS_ROPE = 2 * MiB, WS_PROBS = 3 * MiB, WS_GATE = 5 * MiB, WS_SEL = 6 * MiB, WS_CP = 8 * MiB, WS_CB = 11 * MiB;
constexpr size_t WS_WQKV = 16 * MiB, WS_WO = 22 * MiB, WS_WIN = 24 * MiB, WS_WOUT = 28 * MiB, WS_WG = 30 * MiB;
constexpr size_t WS_XN = 32 * MiB, WS_Q = 68 * MiB, WS_K = 104 * MiB, WS_V = 140 * MiB, WS_ATT = 176 * MiB, WS_H = 212 * MiB;
constexpr size_t WS_XG = 284 * MiB, WS_Y = 356 * MiB, WS_ACT = 428 * MiB, WS_WGU = 626 * MiB, WS_WDN = 978 * MiB;
constexpr size_t WS_YG = 68 * MiB, WS_XR = 104 * MiB, WS_HS = 140 * MiB;
constexpr size_t WS_LOGA = 1154 * MiB, WS_BT = 1226 * MiB;
constexpr size_t WS_TMPF = 1298 * MiB, WS_XC = 2090 * MiB, WS_END = 2126 * MiB;
constexpr size_t WGU_LAYER = (size_t)NE * 2 * DE * D * 2, WDN_LAYER = (size_t)NE * D * DE * 2;
constexpr int CW_BAR = 4096;

constexpr int LDS_BYTES = 147456;
constexpr int MISC_OFF = 131072 + 320;

struct Args { const float* in[27]; float* out; unsigned char* ws; int ph_lo, ph_hi; };
constexpr int ROPE_LDS = 131072 + 1024;
constexpr int ARGS_OFF = 131072 + 512;
struct Ctx {
    const LAS unsigned* la;
    __device__ __forceinline__ unsigned long long ld(int i) const { const unsigned lo = __builtin_amdgcn_readfirstlane(la[2 * i]), hi = __builtin_amdgcn_readfirstlane(la[2 * i + 1]); return ((unsigned long long)hi << 32) | lo; }
    __device__ __forceinline__ const float* in(int i) const { return (const float*)(const __attribute__((address_space(1))) float*)ld(i); }
    __device__ __forceinline__ float* out() const { return (float*)(__attribute__((address_space(1))) float*)ld(27); }
    __device__ __forceinline__ unsigned char* ws() const { return (unsigned char*)(__attribute__((address_space(1))) unsigned char*)ld(28); }
};

enum { I_X = 0, I_C, I_CTX, I_CCTX, I_ADAW, I_ADAB, I_N1G, I_N2G, I_FG, I_WQKV, I_LQ1, I_LK1, I_LQ2, I_LK2, I_SUBG, I_WO, I_WIN, I_BIN, I_CONVW, I_CONVB, I_WGATES, I_BGATES, I_LAM, I_WOUT, I_WR, I_WGU, I_WDN };

__device__ __forceinline__ float bf_lo(unsigned w) { return __uint_as_float(w << 16); }
__device__ __forceinline__ float bf_hi(unsigned w) { return __uint_as_float(w & 0xffff0000u); }
__device__ __forceinline__ float bf2f(bf16_t b) { return __uint_as_float(((unsigned)b) << 16); }
__device__ __forceinline__ unsigned f2bf(float f) { unsigned u = __float_as_uint(f); return (u + 0x7fffu + ((u >> 16) & 1u)) >> 16; }
__device__ __forceinline__ unsigned pk2(float lo, float hi) { unsigned r; asm("v_cvt_pk_bf16_f32 %0, %1, %2" : "=v"(r) : "v"(lo), "v"(hi)); return r; }
#ifndef EPI_WT
#define EPI_WT 0
#endif
__device__ __forceinline__ void st16_wt(void* p, u32x4 v) {
#if EPI_WT
    asm volatile("global_store_dwordx4 %0, %1, off sc1" :: "v"(p), "v"(v) : "memory");
#else
    *(u32x4*)p = v;
#endif
}
__device__ __forceinline__ void st8_wt(void* p, u32x2 v) {
#if EPI_WT
    asm volatile("global_store_dwordx2 %0, %1, off sc1" :: "v"(p), "v"(v) : "memory");
#else
    *(u32x2*)p = v;
#endif
}
#define DPPF(v, ctrl) __int_as_float(__builtin_amdgcn_update_dpp(0, __float_as_int(v), ctrl, 0xF, 0xF, true))
__device__ __forceinline__ float wave_sum(float v) {
    v += DPPF(v, 0xB1); v += DPPF(v, 0x4E); v += DPPF(v, 0x141); v += DPPF(v, 0x140);
    const float s0 = __int_as_float(__builtin_amdgcn_readlane(__float_as_int(v), 0)), s1 = __int_as_float(__builtin_amdgcn_readlane(__float_as_int(v), 16));
    const float s2 = __int_as_float(__builtin_amdgcn_readlane(__float_as_int(v), 32)), s3 = __int_as_float(__builtin_amdgcn_readlane(__float_as_int(v), 48));
    return (s0 + s1) + (s2 + s3);
}
__device__ __forceinline__ float wave_max(float v) {
    v = fmaxf(v, DPPF(v, 0xB1)); v = fmaxf(v, DPPF(v, 0x4E)); v = fmaxf(v, DPPF(v, 0x141)); v = fmaxf(v, DPPF(v, 0x140));
    const float s0 = __int_as_float(__builtin_amdgcn_readlane(__float_as_int(v), 0)), s1 = __int_as_float(__builtin_amdgcn_readlane(__float_as_int(v), 16));
    const float s2 = __int_as_float(__builtin_amdgcn_readlane(__float_as_int(v), 32)), s3 = __int_as_float(__builtin_amdgcn_readlane(__float_as_int(v), 48));
    return fmaxf(fmaxf(s0, s1), fmaxf(s2, s3));
}
__device__ __forceinline__ float sigmoidf_(float x) { return 1.f / (1.f + expf(-x)); }
__device__ __forceinline__ float gelu_tanh(float x) { const float u = 0.7978845608028654f * (x + 0.044715f * x * x * x); return x / (1.f + expf(-2.f * u)); }
__device__ __forceinline__ const float* mod_ptr(const Ctx& a, int layer, int r) { return (const float*)(a.ws() + WS_MOD) + (size_t)(layer * 9 + r) * 6144; }
__device__ __forceinline__ int mod_row(int row) { return row < RL ? (row >> 11) : 8; }

__device__ __forceinline__ void load_row(const float* p, int lane, f32x4 (&v)[4]) {
#pragma unroll
    for (int j = 0; j < 4; ++j) v[j] = *(const f32x4*)(p + 4 * lane + 256 * j);
}
__device__ __forceinline__ void load_row_bf16(const bf16_t* p, int lane, f32x4 (&v)[4]) {
#pragma unroll
    for (int j = 0; j < 4; ++j) { const u32x2 w = *(const u32x2*)(p + 4 * lane + 256 * j); v[j] = (f32x4){bf_lo(w.x), bf_hi(w.x), bf_lo(w.y), bf_hi(w.y)}; }
}
__device__ __forceinline__ void store_row_f32(float* p, int lane, const f32x4 (&v)[4]) {
#pragma unroll
    for (int j = 0; j < 4; ++j) *(f32x4*)(p + 4 * lane + 256 * j) = v[j];
}
__device__ __forceinline__ void store_row_bf16(bf16_t* p, int lane, const f32x4 (&v)[4]) {
#pragma unroll
    for (int j = 0; j < 4; ++j) { u32x2 w; w.x = pk2(v[j].x, v[j].y); w.y = pk2(v[j].z, v[j].w); *(u32x2*)(p + 4 * lane + 256 * j) = w; }
}
__device__ __forceinline__ void store_row_fp8(unsigned char* p, int lane, const f32x4 (&v)[4]) {
#pragma unroll
    for (int j = 0; j < 4; ++j) *(unsigned*)(p + 4 * lane + 256 * j) = __builtin_amdgcn_cvt_pk_fp8_f32(v[j].z, v[j].w, __builtin_amdgcn_cvt_pk_fp8_f32(v[j].x, v[j].y, 0u, false), true);
}
__device__ __forceinline__ void rms_mod(f32x4 (&v)[4], const float* g, const float* sh, const float* sc, int lane) {
    float ss = 0.f;
#pragma unroll
    for (int j = 0; j < 4; ++j) ss += (v[j].x * v[j].x + v[j].y * v[j].y) + (v[j].z * v[j].z + v[j].w * v[j].w);
    ss = wave_sum(ss);
    const float rstd = 1.0f / sqrtf(ss * (1.0f / D) + EPS);
#pragma unroll
    for (int j = 0; j < 4; ++j) {
        const int k = 4 * lane + 256 * j;
        const f32x4 gg = *(const f32x4*)(g + k);
        f32x4 y = v[j] * rstd * gg;
        if (sh) { const f32x4 s1 = *(const f32x4*)(sc + k), s0 = *(const f32x4*)(sh + k); y = y * (1.0f + s1) + s0; }
        v[j] = y;
    }
}

template <class F>
__device__ __forceinline__ void naive_tile(const bf16_t* A, int lda, const float* W, int ldw, int K, LAS unsigned char* lds, F f) {
    LAS float* As = (LAS float*)lds;
    LAS float* Bs = (LAS float*)(lds + 16 * 132 * 4);
    const int tid = threadIdx.x, ty = tid >> 4, tx = tid & 15;
    const int ar = tid >> 2, akq = tid & 3, bk = tid >> 5, bc = (tid & 31) * 2;
    float acc[4][4];
#pragma unroll
    for (int i = 0; i < 4; ++i)
#pragma unroll
        for (int j = 0; j < 4; ++j) acc[i][j] = 0.f;
    for (int k0 = 0; k0 < K; k0 += 16) {
        const u32x2 av = *(const u32x2*)(A + (size_t)ar * lda + k0 + akq * 4);
        const f32x2 bv = *(const f32x2*)(W + (size_t)(k0 + bk) * ldw + bc);
        __syncthreads();
        As[(akq * 4 + 0) * 132 + ar] = bf_lo(av.x); As[(akq * 4 + 1) * 132 + ar] = bf_hi(av.x);
        As[(akq * 4 + 2) * 132 + ar] = bf_lo(av.y); As[(akq * 4 + 3) * 132 + ar] = bf_hi(av.y);
        Bs[bk * 64 + bc] = bv.x; Bs[bk * 64 + bc + 1] = bv.y;
        __syncthreads();
#pragma unroll
        for (int kk = 0; kk < 16; ++kk) {
            const f32x4 a4 = *(const LAS f32x4*)(As + kk * 132 + ty * 4);
            const f32x4 b4 = *(const LAS f32x4*)(Bs + kk * 64 + tx * 4);
#pragma unroll
            for (int i = 0; i < 4; ++i)
#pragma unroll
                for (int j = 0; j < 4; ++j) acc[i][j] += a4[i] * b4[j];
        }
    }
#pragma unroll
    for (int i = 0; i < 4; ++i)
#pragma unroll
        for (int j = 0; j < 4; ++j) f(ty * 4 + i, tx * 4 + j, acc[i][j]);
    __syncthreads();
}

__device__ __forceinline__ void cvt_item(const float* W, int N, int k0, int n0, bf16_t* dst, int Kd, int gu_perm) {
    const int tid = threadIdx.x, lane = tid & 63, wave = tid >> 6;
    const float* p = W + (size_t)(k0 + 8 * wave) * N + n0 + 4 * lane;
    f32x4 v[8];
#pragma unroll
    for (int i = 0; i < 8; ++i) v[i] = *(const f32x4*)(p + (size_t)i * N);
#pragma unroll
    for (int j = 0; j < 4; ++j) {
        const int n = n0 + 4 * lane + j;
        const int row = gu_perm ? (((n % DE) >> 7) * 256 + (n / DE) * 128 + (n & 127)) : n;
        u32x4 o; o.x = pk2(v[0][j], v[1][j]); o.y = pk2(v[2][j], v[3][j]); o.z = pk2(v[4][j], v[5][j]); o.w = pk2(v[6][j], v[7][j]);
        *(u32x4*)(dst + (size_t)row * Kd + k0 + 8 * wave) = o;
    }
}
__device__ __forceinline__ unsigned pk4_fp8(float a, float b, float c, float d) { unsigned w = __builtin_amdgcn_cvt_pk_fp8_f32(a, b, 0u, false); return __builtin_amdgcn_cvt_pk_fp8_f32(c, d, w, true); }
constexpr float BT_SCALE = 64.0f, Y_SCALE = 16.0f;
constexpr float WGU_SCALE = 32.0f, WDN_SCALE = 64.0f;
__device__ __forceinline__ void cvt8_load(const float* W, int N, int k0, int n0, f32x4 (&v)[16]) {
    const int tid = threadIdx.x, lane = tid & 63, wave = tid >> 6;
    const float* p = W + (size_t)(k0 + 16 * wave) * N + n0 + 4 * lane;
#pragma unroll
    for (int i = 0; i < 16; ++i) v[i] = __builtin_nontemporal_load((const f32x4*)(p + (size_t)i * N));
}
__device__ __forceinline__ void cvt8_store(const f32x4 (&v)[16], int k0, int n0, unsigned char* dst, int Kd, int gu_perm, float scale, LAS unsigned char* T) {
    const int tid = threadIdx.x, lane = tid & 63, wave = tid >> 6;
#pragma unroll
    for (int j = 0; j < 4; ++j) {
        const int n = 4 * lane + j;
        u32x4 o;
        o.x = pk4_fp8(v[0][j] * scale, v[1][j] * scale, v[2][j] * scale, v[3][j] * scale); o.y = pk4_fp8(v[4][j] * scale, v[5][j] * scale, v[6][j] * scale, v[7][j] * scale);
        o.z = pk4_fp8(v[8][j] * scale, v[9][j] * scale, v[10][j] * scale, v[11][j] * scale); o.w = pk4_fp8(v[12][j] * scale, v[13][j] * scale, v[14][j] * scale, v[15][j] * scale);
        *(LAS u32x4*)(T + n * 128 + ((wave ^ (lane & 7)) << 4)) = o;
    }
    asm volatile("s_waitcnt lgkmcnt(0)" ::: "memory"); __builtin_amdgcn_s_barrier(); asm volatile("" ::: "memory");
#pragma unroll
    for (int i = 0; i < 4; ++i) {
        const int p = tid + NTHREADS * i, n = p >> 3, c = p & 7;
        const u32x4 x = *(const LAS u32x4*)(T + n * 128 + ((c ^ ((n >> 2) & 7)) << 4));
        const int ng = n0 + n;
        const int row = gu_perm ? (((ng % DE) >> 7) * 256 + (ng / DE) * 128 + (ng & 127)) : ng;
        __builtin_nontemporal_store(x, (u32x4*)(dst + (size_t)row * Kd + k0 + 16 * c));
    }
}
constexpr int CV_GU = NE * 8 * 22, CV_DN = NE * 22 * 4, CV_ITEMS = CV_GU + CV_DN;
struct CvItem { const float* W; unsigned char* dst; int N, Kd, k0, n0, perm; float scale; };
__device__ __forceinline__ CvItem cv_decode(const float* wgu, const float* wdn, unsigned char* ws, int layer, int it) {
    CvItem c;
    if (it < CV_GU) { const int e = it / 176, q = it % 176, le = layer * NE + e; c.W = wgu + (size_t)le * D * 2 * DE; c.dst = ws + WS_WGU + (size_t)le * 2 * DE * D; c.N = 2 * DE; c.Kd = D; c.k0 = (q / 22) * 128; c.n0 = (q % 22) * 256; c.perm = 1; c.scale = WGU_SCALE; }
    else { const int r = it - CV_GU, e = r / 88, q = r % 88, le = layer * NE + e; c.W = wdn + (size_t)le * DE * D; c.dst = ws + WS_WDN + (size_t)le * D * DE; c.N = D; c.Kd = DE; c.k0 = (q / 4) * 128; c.n0 = (q % 4) * 256; c.perm = 0; c.scale = WDN_SCALE; }
    return c;
}
__device__ __forceinline__ void cvt8_run(const Ctx& a, int layer, int first, int stride, int end, LAS unsigned char* lds) {
    const float* wgu = a.in(I_WGU); const float* wdn = a.in(I_WDN); unsigned char* ws = a.ws();
    f32x4 va[16], vb[16];
    int it = first;
    if (it < end) { const CvItem c = cv_decode(wgu, wdn, ws, layer, it); cvt8_load(c.W, c.N, c.k0, c.n0, va); }
    while (it < end) {
        int nx = it + stride;
        if (nx < end) { const CvItem c = cv_decode(wgu, wdn, ws, layer, nx); cvt8_load(c.W, c.N, c.k0, c.n0, vb); }
        { const CvItem c = cv_decode(wgu, wdn, ws, layer, it); cvt8_store(va, c.k0, c.n0, c.dst, c.Kd, c.perm, c.scale, lds); }
        it = nx; if (it >= end) break;
        nx = it + stride;
        if (nx < end) { const CvItem c = cv_decode(wgu, wdn, ws, layer, nx); cvt8_load(c.W, c.N, c.k0, c.n0, va); }
        { const CvItem c = cv_decode(wgu, wdn, ws, layer, it); cvt8_store(vb, c.k0, c.n0, c.dst, c.Kd, c.perm, c.scale, lds + 32768); }
        it = nx;
    }
    __syncthreads();
}
#ifndef CVT_HIDE
#define CVT_HIDE 1
#endif
#ifndef CVT_DEDICATED
#define CVT_DEDICATED 0
#endif
#ifndef CVQ_QKV
#define CVQ_QKV 1280
#endif
#ifndef CVQ_WO
#define CVQ_WO 896
#endif
#ifndef CVQ_GU0
#define CVQ_GU0 480
#endif
#ifndef CVQ_DN0
#define CVQ_DN0 960
#endif
#ifndef CVQ_WIN
#define CVQ_WIN 896
#endif
#ifndef CVQ_GATES
#define CVQ_GATES 1120
#endif
#ifndef CVQ_ATT
#define CVQ_ATT 256
#endif
#ifndef CVQ_TK1
#define CVQ_TK1 512
#endif
#ifndef CVQ_TK0
#define CVQ_TK0 0
#endif
constexpr int CV0_QKV = 0, CV0_WO = CV0_QKV + CVQ_QKV, CV0_ATT = CV0_WO + CVQ_WO, CV0_TK = CV0_ATT + CVQ_ATT, CV0_PRO = CVT_HIDE ? CV0_TK + CVQ_TK0 : 0;
constexpr int CV1_GU0 = 0, CV1_DN0 = CV1_GU0 + CVQ_GU0, CV1_WIN = CV1_DN0 + CVQ_DN0, CV1_GATES = CV1_WIN + CVQ_WIN, CV1_TK = CV1_GATES + CVQ_GATES, CV1_PRO = CVT_HIDE ? CV1_TK + CVQ_TK1 : 0;
static_assert(CV0_PRO <= CV_ITEMS && CV1_PRO <= CV_ITEMS, "conversion schedule");
__device__ __forceinline__ void cvt8_tail(const Ctx& a, LAS unsigned char* lds, int units, int G, int c, int layer, int base, int count) {
#if CVT_HIDE && FP8_MOE
    const int R = (units + G - 1) / G, first_idle = units - (R - 1) * G;
    if (first_idle >= G || count <= 0 || c < first_idle) return;
    cvt8_run(a, layer, base + (c - first_idle), G - first_idle, base + count, lds);
#endif
}
__device__ __forceinline__ int gemm_groups(int units, int G) {
#if CVT_HIDE && FP8_MOE && CVT_DEDICATED
    const int R = (units + G - 1) / G; int gp = ((units + R - 1) / R + 7) & ~7;
    return gp < G ? gp : G;
#else
    return G;
#endif
}
#ifndef DENSE_LATE
#define DENSE_LATE 1
#endif
constexpr int IT_DENSE_REST = 16 * 4 + 16 * 8 + 16 * 4 + 32;
__device__ __forceinline__ void cvt_dense_rest_item(const Ctx& a, int r) {
    constexpr int IT_WO = 16 * 4, IT_WIN = 16 * 8, IT_WOUT = 16 * 4;
    if (r < IT_WO) { cvt_item(a.in(I_WO), D, (r / 4) * 64, (r % 4) * 256, (bf16_t*)(a.ws() + WS_WO), D, 0); return; }
    r -= IT_WO;
    if (r < IT_WIN) { cvt_item(a.in(I_WIN), 2 * D, (r / 8) * 64, (r % 8) * 256, (bf16_t*)(a.ws() + WS_WIN), D, 0); return; }
    r -= IT_WIN;
    if (r < IT_WOUT) { cvt_item(a.in(I_WOUT), D, (r / 4) * 64, (r % 4) * 256, (bf16_t*)(a.ws() + WS_WOUT), D, 0); return; }
    r -= IT_WOUT;
    { const int m = r >> 1, kk = r & 1;
        cvt_item(a.in(I_WGATES) + (size_t)m * 128 * 256, 256, kk * 64, 0, (bf16_t*)(a.ws() + WS_WG) + (size_t)m * 256 * 128, 128, 0); }
}
__device__ __forceinline__ void ph_prologue(const Ctx& a, LAS unsigned char* lds) {
    const int tid = threadIdx.x, lane = tid & 63, wave = tid >> 6;
    if (blockIdx.x == gridDim.x - 1) {
        float* rope = (float*)(a.ws() + WS_ROPE);
        for (int i = tid; i < 1024; i += NTHREADS) { const int pos = i >> 4, f = i & 15; const float inv = powf(10000.0f, -(float)f / 16.0f); const float ang = (float)pos * inv; rope[i] = cosf(ang); rope[1024 + i] = sinf(ang); }
    }
    if (blockIdx.x == gridDim.x - 2 || gridDim.x == 1) {
        float* gt = (float*)(a.ws() + WS_GTAB); const float* lamp = a.in(I_LAM); const float* bgp = a.in(I_BGATES);
        for (int i = tid; i < 2 * D; i += NTHREADS) {
            const int d = i >> 10, ch = i & 1023, kb = ch >> 7, cc = ch & 127;
            const float cl = -8.0f * log1pf(expf(-lamp[i]));
            gt[(d * 4 + 0) * D + ch] = cl * 1.4426950408889634f; gt[(d * 4 + 1) * D + ch] = 2.0f * cl * 1.4426950408889634f;
            gt[(d * 4 + 2) * D + ch] = -1.4426950408889634f * bgp[(d * 8 + kb) * 256 + cc]; gt[(d * 4 + 3) * D + ch] = -1.4426950408889634f * bgp[(d * 8 + kb) * 256 + 128 + cc];
        }
    }
    for (int u = blockIdx.x; u < 192; u += gridDim.x) {
        LAS float* sl = (LAS float*)lds;
        LAS float* red = (LAS float*)(lds + 49152);
        const int layer = u / 96, n0 = (u % 96) * 64;
        for (int i = tid; i < 9 * 1024; i += NTHREADS) { const int r = i >> 10, k = i & 1023; const float v = r < 8 ? a.in(I_C)[r * 1024 + k] : a.in(I_CCTX)[k]; sl[k * 12 + r] = v / (1.f + expf(-v)); }
        __syncthreads();
        const float* W = a.in(I_ADAW) + (size_t)layer * 1024 * 6144 + n0 + lane;
        float acc[9];
#pragma unroll
        for (int r = 0; r < 9; ++r) acc[r] = 0.f;
#pragma unroll 32
        for (int k = wave * 128; k < wave * 128 + 128; ++k) {
            const float w = __builtin_nontemporal_load(W + (size_t)k * 6144);
            const f32x4 s0 = *(const LAS f32x4*)(sl + k * 12), s1 = *(const LAS f32x4*)(sl + k * 12 + 4); const float s8 = sl[k * 12 + 8];
            acc[0] += s0.x * w; acc[1] += s0.y * w; acc[2] += s0.z * w; acc[3] += s0.w * w;
            acc[4] += s1.x * w; acc[5] += s1.y * w; acc[6] += s1.z * w; acc[7] += s1.w * w; acc[8] += s8 * w;
        }
#pragma unroll
        for (int r = 0; r < 9; ++r) red[(wave * 9 + r) * 64 + lane] = acc[r];
        __syncthreads();
        float* MOD = (float*)(a.ws() + WS_MOD);
        for (int i = tid; i < 576; i += NTHREADS) {
            const int r = i >> 6, l = i & 63; float s = 0.f;
#pragma unroll
            for (int w = 0; w < 8; ++w) s += red[(w * 9 + r) * 64 + l];
            MOD[(size_t)(layer * 9 + r) * 6144 + n0 + l] = s + a.in(I_ADAB)[layer * 6144 + n0 + l];
        }
        __syncthreads();
    }
#if ANY_FAST_GEMM
    constexpr int IT_QKV = 16 * 12, IT_WO = 16 * 4, IT_WIN = 16 * 8, IT_WOUT = 16 * 4, IT_G = 32;
#if FP8_MOE
    cvt8_run(a, 0, CV0_PRO + (int)blockIdx.x, (int)gridDim.x, CV_ITEMS, lds);
    cvt8_run(a, 1, CV1_PRO + (int)blockIdx.x, (int)gridDim.x, CV_ITEMS, lds);
    constexpr int IT_GU = 0, IT_DN = 0;
#else
    constexpr int IT_GU1 = 16 * 22, IT_DN1 = 44 * 4;
    constexpr int IT_GU = 32 * IT_GU1, IT_DN = 32 * IT_DN1;
#endif
    constexpr int NITEMS = IT_GU + IT_DN + IT_QKV + ((DENSE_LATE && FAST_ATTN) ? 0 : IT_DENSE_REST);
    for (int it = blockIdx.x; it < NITEMS; it += gridDim.x) {
        int r = it;
#if !FP8_MOE
        if (r < IT_GU) { const int le = r / IT_GU1, q = r % IT_GU1;
            cvt_item(a.in(I_WGU) + (size_t)le * D * 2 * DE, 2 * DE, (q / 22) * 64, (q % 22) * 256, (bf16_t*)(a.ws() + WS_WGU) + (size_t)le * 2 * DE * D, D, 1); continue; }
        r -= IT_GU;
        if (r < IT_DN) { const int le = r / IT_DN1, q = r % IT_DN1;
            cvt_item(a.in(I_WDN) + (size_t)le * DE * D, D, (q / 4) * 64, (q % 4) * 256, (bf16_t*)(a.ws() + WS_WDN) + (size_t)le * D * DE, DE, 0); continue; }
#endif
        r -= IT_DN;
        if (r < IT_QKV) { cvt_item(a.in(I_WQKV), 3 * D, (r / 12) * 64, (r % 12) * 256, (bf16_t*)(a.ws() + WS_WQKV), D, 0); continue; }
        r -= IT_QKV;
#if !(DENSE_LATE && FAST_ATTN)
        cvt_dense_rest_item(a, r);
#endif
    }
#endif
}

__device__ __forceinline__ void ph_norm1_l0(const Ctx& a) {
    const int lane = threadIdx.x & 63, gw = blockIdx.x * NWAVES + (threadIdx.x >> 6), NGW = gridDim.x * NWAVES;
    unsigned char* ws = a.ws();
    bf16_t* XN = (bf16_t*)(ws + WS_XN); const float* X = a.in(I_X); const float* CX = a.in(I_CTX); const float* n1g = a.in(I_N1G);
    f32x4 v[4], nx[4];
    int row = gw;
    if (row < RT) load_row(row < RL ? X + (size_t)row * D : CX + (size_t)(row - RL) * D, lane, v);
    for (; row < RT; row += NGW) {
        const int rn = row + NGW;
        if (rn < RT) load_row(rn < RL ? X + (size_t)rn * D : CX + (size_t)(rn - RL) * D, lane, nx);
        const float* mp = (const float*)(ws + WS_MOD) + (size_t)mod_row(row) * 6144;
        rms_mod(v, n1g, mp + M_SH1, mp + M_SC1, lane);
        store_row_bf16(XN + (size_t)row * D, lane, v);
#pragma unroll
        for (int j = 0; j < 4; ++j) v[j] = nx[j];
    }
}
__device__ __forceinline__ float rs16(float (&s)[16], int lane) {
    float r8[8], r4[4], r2[2];
    const bool b3 = lane & 8, b2 = lane & 4;
#pragma unroll
    for (int i = 0; i < 8; ++i) { const auto rr = __builtin_amdgcn_permlane32_swap(__float_as_uint(s[i]), __float_as_uint(s[i + 8]), false, false); r8[i] = __uint_as_float(rr[0]) + __uint_as_float(rr[1]); }
#pragma unroll
    for (int i = 0; i < 4; ++i) { const auto rr = __builtin_amdgcn_permlane16_swap(__float_as_uint(r8[i]), __float_as_uint(r8[i + 4]), false, false); r4[i] = __uint_as_float(rr[0]) + __uint_as_float(rr[1]); }
#pragma unroll
    for (int i = 0; i < 2; ++i) { const float send = b3 ? r4[i] : r4[i + 2], keep = b3 ? r4[i + 2] : r4[i]; r2[i] = keep + DPPF(send, 0x128); }
    float r = (b2 ? r2[1] : r2[0]) + DPPF(b2 ? r2[0] : r2[1], 0x141);
    r += DPPF(r, 0xB1); r += DPPF(r, 0x4E);
    return r;
}
__device__ __forceinline__ void ph_norm2_router(const Ctx& a, LAS unsigned char* lds, int layer, int nrows) {
    const int tid = threadIdx.x, lane = tid & 63, gw = blockIdx.x * NWAVES + (tid >> 6), NGW = gridDim.x * NWAVES;
    LAS float* wrT = (LAS float*)lds;
    const float* wr = a.in(I_WR) + (size_t)layer * D * NE;
    for (int i = tid; i < D * NE; i += NTHREADS) wrT[(i & 15) * 1024 + (i >> 4)] = wr[i];
    __syncthreads();
    unsigned char* ws = a.ws();
    bf16_t* XN = (bf16_t*)(ws + WS_XN); const bf16_t* H = (const bf16_t*)(ws + WS_H);
    float* PL = (float*)(ws + WS_PROBS); float* PC = PL + NB * NE * SEQ;
    const float* n2g = a.in(I_N2G) + layer * D;
    const int elane = ((lane >> 5) & 1) * 8 + ((lane >> 4) & 1) * 4 + ((lane >> 3) & 1) * 2 + ((lane >> 2) & 1);
    f32x4 v0[4], v1[4], n0[4], n1[4];
    int p = gw;
    if (p < nrows / 2) { load_row_bf16(H + (size_t)(2 * p) * D, lane, v0); load_row_bf16(H + (size_t)(2 * p + 1) * D, lane, v1); }
    for (; p < nrows / 2; p += NGW) {
        const int pn = p + NGW;
        if (pn < nrows / 2) { load_row_bf16(H + (size_t)(2 * pn) * D, lane, n0); load_row_bf16(H + (size_t)(2 * pn + 1) * D, lane, n1); }
        const int row = 2 * p;
        const float* mp = (const float*)(ws + WS_MOD) + (size_t)(layer * 9 + mod_row(row)) * 6144;
        rms_mod(v0, n2g, mp + M_SH2, mp + M_SC2, lane); rms_mod(v1, n2g, mp + M_SH2, mp + M_SC2, lane);
#if FP8_MOE
        store_row_fp8((unsigned char*)XN + (size_t)row * D, lane, v0); store_row_fp8((unsigned char*)XN + (size_t)(row + 1) * D, lane, v1);
#else
        store_row_bf16(XN + (size_t)row * D, lane, v0); store_row_bf16(XN + (size_t)(row + 1) * D, lane, v1);
#endif
        float s0[16], s1[16];
#pragma unroll
        for (int e = 0; e < 16; ++e) {
            float a0 = 0.f, a1 = 0.f;
#pragma unroll
            for (int j = 0; j < 4; ++j) { const f32x4 w = *(const LAS f32x4*)(wrT + e * 1024 + 4 * lane + 256 * j);
                a0 += (v0[j].x * w.x + v0[j].y * w.y) + (v0[j].z * w.z + v0[j].w * w.w); a1 += (v1[j].x * w.x + v1[j].y * w.y) + (v1[j].z * w.z + v1[j].w * w.w); }
            s0[e] = a0; s1[e] = a1;
            if ((e & 3) == 3) asm volatile("" ::: "memory");
        }
        const float l0 = rs16(s0, lane), l1 = rs16(s1, lane);
        const float m0 = wave_max(l0), m1 = wave_max(l1);
        const float e0 = expf(l0 - m0), e1 = expf(l1 - m1);
        const float q0 = e0 / (wave_sum(e0) * 0.25f), q1 = e1 / (wave_sum(e1) * 0.25f);
        if ((lane & 3) == 0) {
            if (row < RL) { float* d = PL + ((size_t)(row >> 11) * NE + elane) * SEQ + (row & 2047); *(f32x2*)d = (f32x2){q0, q1}; }
            else { const int rc = row - RL; float* d = PC + ((size_t)(rc >> 8) * NE + elane) * CTXL + (rc & 255); *(f32x2*)d = (f32x2){q0, q1}; }
        }
#pragma unroll
        for (int j = 0; j < 4; ++j) { v0[j] = n0[j]; v1[j] = n1[j]; }
    }
    __syncthreads();
}
__device__ __forceinline__ void ph_topk_gather(const Ctx& a, LAS unsigned char* lds, int layer) {
    const int tid = threadIdx.x, lane = tid & 63, wave = tid >> 6;
    LAS int* idxl = (LAS int*)lds;
    LAS int* cnt = (LAS int*)(lds + 1024);
    unsigned char* ws = a.ws();
    const float* PL = (const float*)(ws + WS_PROBS); const float* PC = PL + NB * NE * SEQ;
    float* GATE = (float*)(ws + WS_GATE); int* SEL = (int*)(ws + WS_SEL);
    const bf16_t* XN = (const bf16_t*)(ws + WS_XN); bf16_t* XG = (bf16_t*)(ws + WS_XG);
    const int nunits = layer == 0 ? 256 : 128, rpe = layer == 0 ? RPE0 : RPE1;
    const unsigned long long lt = (1ull << lane) - 1ull;
    for (int u0 = blockIdx.x; u0 < nunits; u0 += gridDim.x) {
        const int u = layer == 0 ? ((u0 & 1) * 128 + (u0 >> 1)) : u0;
        const bool lat = u < 128; const int b = (u & 127) >> 4, e = u & 15;
        const int n = lat ? SEQ : CTXL, cap = lat ? CAPL : CAPC;
        const float* src = lat ? PL + ((size_t)b * NE + e) * SEQ : PC + ((size_t)b * NE + e) * CTXL;
        const int rowbase = lat ? b * SEQ : RL + b * CTXL;
        const int xgbase = e * rpe + (lat ? b * CAPL : NB * CAPL + b * CAPC);
        unsigned v[4];
#pragma unroll
        for (int i = 0; i < 4; ++i) { const int t = wave * 256 + i * 64 + lane; v[i] = t < n ? __float_as_uint(src[t]) : 0u; }
        unsigned prefix = 0u;
#pragma unroll 1
        for (int bit = 30; bit >= 0; --bit) {
            const unsigned cand = prefix | (1u << bit); int c = 0;
#pragma unroll
            for (int i = 0; i < 4; ++i) c += __popcll(__ballot(v[i] >= cand));
            LAS int* slot = cnt + (bit & 1) * 8;
            if (lane == 0) slot[wave] = c;
            __syncthreads();
            int tot = 0;
#pragma unroll
            for (int w = 0; w < 8; ++w) tot += slot[w];
            if (tot >= cap) prefix = cand;
        }
        int mg = 0, me = 0;
#pragma unroll
        for (int i = 0; i < 4; ++i) { mg += __popcll(__ballot(v[i] > prefix)); me += __popcll(__ballot(v[i] == prefix)); }
        if (lane == 0) { cnt[16 + wave] = mg; cnt[24 + wave] = me; }
        __syncthreads();
        int tg = 0, eqb = 0;
#pragma unroll
        for (int w = 0; w < 8; ++w) { tg += cnt[16 + w]; eqb += (w < wave) ? cnt[24 + w] : 0; }
        const int need = cap - tg;
        bool sel[4]; int ms = 0, eqseen = eqb;
#pragma unroll
        for (int i = 0; i < 4; ++i) {
            const bool gt = v[i] > prefix, eq = v[i] == prefix;
            const unsigned long long meq = __ballot(eq);
            sel[i] = gt || (eq && (eqseen + __popcll(meq & lt)) < need);
            ms += __popcll(__ballot(sel[i])); eqseen += __popcll(meq);
        }
        if (lane == 0) cnt[32 + wave] = ms;
        __syncthreads();
        int slotbase = 0;
#pragma unroll
        for (int w = 0; w < 8; ++w) slotbase += (w < wave) ? cnt[32 + w] : 0;
#pragma unroll
        for (int i = 0; i < 4; ++i) {
            const unsigned long long msel = __ballot(sel[i]);
            const int slot = slotbase + __popcll(msel & lt), t = wave * 256 + i * 64 + lane;
            if (t < n) SEL[(size_t)(rowbase + t) * NE + e] = sel[i] ? slot : -1;
            if (sel[i]) { idxl[slot] = t; GATE[xgbase + slot] = __uint_as_float(v[i]); }
            slotbase += __popcll(msel);
        }
        __syncthreads();
        for (int slot = wave; slot < cap; slot += NWAVES) {
            const int t = idxl[slot];
#if FP8_MOE
            ((u32x4*)((unsigned char*)XG + (size_t)(xgbase + slot) * D))[lane] = ((const u32x4*)((const unsigned char*)XN + (size_t)(rowbase + t) * D))[lane];
#else
            const u32x4* s = (const u32x4*)(XN + (size_t)(rowbase + t) * D);
            u32x4* d = (u32x4*)(XG + (size_t)(xgbase + slot) * D);
            d[lane] = s[lane]; d[lane + 64] = s[lane + 64];
#endif
        }
        __syncthreads();
    }
#if CVT_HIDE && FP8_MOE
    if (layer == 1 && (int)blockIdx.x >= 128 && (int)gridDim.x > 128)
        cvt8_run(a, 1, CV1_TK + ((int)blockIdx.x - 128), (int)gridDim.x - 128, CV1_TK + CVQ_TK1, lds);
    if (layer == 0 && ((int)blockIdx.x & 1) && (int)gridDim.x == 256)
        cvt8_run(a, 0, CV0_TK + ((int)blockIdx.x >> 1), 128, CV0_TK + CVQ_TK0, lds);
#endif
}
template <int MODE>
__device__ __forceinline__ void ph_combine(const Ctx& a, int layer, int nrows) {
    const int lane = threadIdx.x & 63, gw = blockIdx.x * NWAVES + (threadIdx.x >> 6), NGW = gridDim.x * NWAVES;
    bf16_t* H = (bf16_t*)(a.ws() + WS_H); const int* SEL = (const int*)(a.ws() + WS_SEL); const unsigned char* Y = a.ws() + WS_Y;
    const float* GATE = (const float*)(a.ws() + WS_GATE);
    bf16_t* XN = (bf16_t*)(a.ws() + WS_XN);
    const int rpe = layer == 0 ? RPE0 : RPE1;
    f32x4 v[4], vn[4]; int sel = -1, seln = -1;
    if (gw < nrows) { load_row_bf16(H + (size_t)gw * D, lane, v); sel = SEL[(size_t)gw * NE + (lane & 15)]; }
    for (int row = gw; row < nrows; row += NGW) {
        const int rnx = row + NGW;
        if (rnx < nrows) { load_row_bf16(H + (size_t)rnx * D, lane, vn); seln = SEL[(size_t)rnx * NE + (lane & 15)]; }
        const int mr = mod_row(row);
        const float* mp = mod_ptr(a, layer, mr);
        const int off = row < RL ? (row >> 11) * CAPL : NB * CAPL + ((row - RL) >> 8) * CAPC;
        f32x4 acc[4];
#pragma unroll
        for (int j = 0; j < 4; ++j) acc[j] = (f32x4){0.f, 0.f, 0.f, 0.f};
        unsigned mask = (unsigned)(__ballot(sel >= 0) & 0xffffull);
        int yw[4][4]; float gk[4];
#pragma unroll
        for (int k = 0; k < 4; ++k) {
            const bool on = mask != 0u; const int e = on ? __builtin_ctz(mask) : 0; mask = on ? (mask & (mask - 1u)) : 0u;
            const int sidx = __builtin_amdgcn_readlane(sel, e);
            const int yrow = on ? (e * rpe + off + sidx) : 0;
            const unsigned char* yr = Y + (size_t)yrow * D;
            gk[k] = on ? GATE[yrow] : 0.f;
#pragma unroll
            for (int j = 0; j < 4; ++j) { const int w = __builtin_nontemporal_load((const int*)(yr + 4 * lane + 256 * j)); yw[k][j] = on ? w : 0; }
        }
#pragma unroll
        for (int k = 0; k < 4; ++k)
#pragma unroll
            for (int j = 0; j < 4; ++j) { const f32x2 lo = __builtin_amdgcn_cvt_pk_f32_fp8(yw[k][j], false), hi2 = __builtin_amdgcn_cvt_pk_f32_fp8(yw[k][j], true);
                acc[j].x += gk[k] * lo.x; acc[j].y += gk[k] * lo.y; acc[j].z += gk[k] * hi2.x; acc[j].w += gk[k] * hi2.y; }
        while (mask != 0u) {
            const int e = __builtin_ctz(mask); mask &= mask - 1u;
            const int sidx = __builtin_amdgcn_readlane(sel, e);
            const int yrow = e * rpe + off + sidx; const float g1 = GATE[yrow];
            const unsigned char* yr = Y + (size_t)yrow * D;
#pragma unroll
            for (int j = 0; j < 4; ++j) { const int w = *(const int*)(yr + 4 * lane + 256 * j); const f32x2 lo = __builtin_amdgcn_cvt_pk_f32_fp8(w, false), hi2 = __builtin_amdgcn_cvt_pk_f32_fp8(w, true);
                acc[j].x += g1 * lo.x; acc[j].y += g1 * lo.y; acc[j].z += g1 * hi2.x; acc[j].w += g1 * hi2.y; }
        }
#pragma unroll
        for (int j = 0; j < 4; ++j) { const f32x4 g2 = *(const f32x4*)(mp + M_G2 + 4 * lane + 256 * j); v[j] = v[j] + g2 * (acc[j] * (1.0f / Y_SCALE)); }
        if (MODE == 0) {
            store_row_bf16(H + (size_t)row * D, lane, v);
            const float* mp1 = mod_ptr(a, 1, mr);
            rms_mod(v, a.in(I_N1G) + D, mp1 + M_SH1, mp1 + M_SC1, lane);
            store_row_bf16(XN + (size_t)row * D, lane, v);
        } else {
            rms_mod(v, a.in(I_FG), nullptr, nullptr, lane);
            { float* po = a.out() + (size_t)row * D;
#pragma unroll
              for (int j = 0; j < 4; ++j) __builtin_nontemporal_store(v[j], (f32x4*)(po + 4 * lane + 256 * j)); }
        }
#pragma unroll
        for (int j = 0; j < 4; ++j) v[j] = vn[j];
        sel = seln;
    }
}

__device__ __forceinline__ void ph_qkv_naive(const Ctx& a, LAS unsigned char* lds) {
    const bf16_t* XN = (const bf16_t*)(a.ws() + WS_XN); float* T = (float*)(a.ws() + WS_TMPF);
    for (int t = blockIdx.x; t < (RT / 128) * 48; t += gridDim.x) {
        const int tm = t / 48, tn = t % 48;
        naive_tile(XN + (size_t)tm * 128 * D, D, a.in(I_WQKV) + tn * 64, 3 * D, D, lds,
                   [&](int r, int c, float v) { T[(size_t)(tm * 128 + r) * 3072 + tn * 64 + c] = v; });
    }
}
__device__ __forceinline__ void ph_rope_naive(const Ctx& a) {
    const float* T = (const float*)(a.ws() + WS_TMPF); const float* rope = (const float*)(a.ws() + WS_ROPE);
    bf16_t* Q = (bf16_t*)(a.ws() + WS_Q); bf16_t* Kb = (bf16_t*)(a.ws() + WS_K); bf16_t* V = (bf16_t*)(a.ws() + WS_V);
    const size_t total = (size_t)RT * 3072, nth = (size_t)gridDim.x * NTHREADS;
    for (size_t i = (size_t)blockIdx.x * NTHREADS + threadIdx.x; i < total; i += nth) {
        const int row = (int)(i / 3072), c = (int)(i % 3072);
        if (c >= 2048) { V[(size_t)row * D + (c - 2048)] = (bf16_t)f2bf(T[i]); continue; }
        const int d = c & 63; if ((d & 31) >= 16) continue;
        float x1 = T[i], x2 = T[i + 16];
        if (row < RL) {
            const int t = row & 2047, axis = d >> 5, f = d & 15, pos = axis == 0 ? (t >> 6) : (t & 63);
            const float cs = rope[pos * 16 + f], sn = rope[1024 + pos * 16 + f];
            const float o1 = x1 * cs - x2 * sn, o2 = x2 * cs + x1 * sn; x1 = o1; x2 = o2;
        }
        if (c < 1024) { Q[(size_t)row * D + c] = (bf16_t)f2bf(x1 * QSCALE); Q[(size_t)row * D + c + 16] = (bf16_t)f2bf(x2 * QSCALE); }
        else { Kb[(size_t)row * D + c - 1024] = (bf16_t)f2bf(x1); Kb[(size_t)row * D + c - 1024 + 16] = (bf16_t)f2bf(x2); }
    }
}
template <int NIT>
__device__ __forceinline__ void naive_attn_item(const Ctx& a, int row, int h, float lam, LAS float* qs, int lane) {
    const bf16_t* Q = (const bf16_t*)(a.ws() + WS_Q); const bf16_t* Kb = (const bf16_t*)(a.ws() + WS_K); const bf16_t* V = (const bf16_t*)(a.ws() + WS_V);
    bf16_t* ATT = (bf16_t*)(a.ws() + WS_ATT);
    const int b = row < RL ? (row >> 11) : ((row - RL) >> 8);
    const int lat0 = b * SEQ, ctx0 = RL + b * CTXL;
    { const unsigned qq = *(const unsigned*)(Q + (size_t)row * D + h * 128 + 2 * lane); qs[2 * lane] = bf_lo(qq); qs[2 * lane + 1] = bf_hi(qq); }
    __builtin_amdgcn_fence(__ATOMIC_RELEASE, "wavefront"); __builtin_amdgcn_wave_barrier(); __builtin_amdgcn_fence(__ATOMIC_ACQUIRE, "wavefront");
#define NA_SCORE(it, d0, d1) do { const int kk_ = (it) * 64 + lane; \
        const int krow_ = (NIT == 36) ? (kk_ < SEQ ? lat0 + kk_ : ctx0 + kk_ - SEQ) : ctx0 + kk_; \
        const u32x4* kp_ = (const u32x4*)(Kb + (size_t)krow_ * D + h * 128); d0 = 0.f; d1 = 0.f; \
        _Pragma("unroll 4") for (int c = 0; c < 16; ++c) { const u32x4 kv = kp_[c]; \
            const f32x4 qa = *(const LAS f32x4*)(qs + 8 * c), qb = *(const LAS f32x4*)(qs + 8 * c + 4); \
            const float dd = (qa.x * bf_lo(kv.x) + qa.y * bf_hi(kv.x)) + (qa.z * bf_lo(kv.y) + qa.w * bf_hi(kv.y)) \
                           + (qb.x * bf_lo(kv.z) + qb.y * bf_hi(kv.z)) + (qb.z * bf_lo(kv.w) + qb.w * bf_hi(kv.w)); \
            if (c < 8) d0 += dd; else d1 += dd; } } while (0)
    float m0 = -3.0e38f, m1 = -3.0e38f, l0 = 0.f, l1 = 0.f;
#pragma unroll 1
    for (int it = 0; it < NIT; ++it) {
        float d0, d1; NA_SCORE(it, d0, d1);
        const float n0 = fmaxf(m0, d0), n1 = fmaxf(m1, d1);
        l0 = l0 * exp2f(m0 - n0) + exp2f(d0 - n0); l1 = l1 * exp2f(m1 - n1) + exp2f(d1 - n1); m0 = n0; m1 = n1;
    }
    { const float g0 = wave_max(m0), g1 = wave_max(m1); l0 = wave_sum(l0 * exp2f(m0 - g0)); l1 = wave_sum(l1 * exp2f(m1 - g1)); m0 = g0; m1 = g1; }
    const float i0 = 1.f / l0, i1 = lam / l1;
    float o0 = 0.f, o1 = 0.f;
#pragma unroll 1
    for (int it = 0; it < NIT; ++it) {
        float d0, d1; NA_SCORE(it, d0, d1);
        const int wbits = __float_as_int(exp2f(d0 - m0) * i0 - exp2f(d1 - m1) * i1);
#pragma unroll 4
        for (int src = 0; src < 64; ++src) {
            const float wv = __int_as_float(__builtin_amdgcn_readlane(wbits, src));
            const int kk = it * 64 + src;
            const int krow = (NIT == 36) ? (kk < SEQ ? lat0 + kk : ctx0 + kk - SEQ) : ctx0 + kk;
            const unsigned vv = *(const unsigned*)(V + (size_t)krow * D + h * 128 + 2 * lane);
            o0 += wv * bf_lo(vv); o1 += wv * bf_hi(vv);
        }
    }
#undef NA_SCORE
    const float ss = wave_sum(o0 * o0 + o1 * o1);
    const float rstd = 1.0f / sqrtf(ss * (1.0f / 128.0f) + EPS);
    const float g0 = a.in(I_SUBG)[2 * lane], g1 = a.in(I_SUBG)[2 * lane + 1];
    *(unsigned*)(ATT + (size_t)row * D + h * 128 + 2 * lane) = pk2(o0 * rstd * g0 * (1.0f - LAMBDA_INIT0), o1 * rstd * g1 * (1.0f - LAMBDA_INIT0));
}
__device__ __forceinline__ float diff_lambda(const Ctx& a, int lane) {
    const float s1 = wave_sum(a.in(I_LQ1)[lane] * a.in(I_LK1)[lane]), s2 = wave_sum(a.in(I_LQ2)[lane] * a.in(I_LK2)[lane]);
    return expf(s1) - expf(s2) + LAMBDA_INIT0;
}
__device__ __forceinline__ void ph_attn_naive(const Ctx& a, LAS unsigned char* lds) {
    const int lane = threadIdx.x & 63, wave = threadIdx.x >> 6, gw = blockIdx.x * NWAVES + wave, NGW = gridDim.x * NWAVES;
    LAS float* qs = (LAS float*)lds + wave * 128;
    const float lam = diff_lambda(a, lane);
    for (int item = gw; item < RT * 8; item += NGW) {
        const int h = item / RT, row = item % RT;
        if (row < RL) naive_attn_item<36>(a, row, h, lam, qs, lane); else naive_attn_item<4>(a, row, h, lam, qs, lane);
    }
}
__device__ __forceinline__ void ph_wo_naive(const Ctx& a, LAS unsigned char* lds) {
    const bf16_t* ATT = (const bf16_t*)(a.ws() + WS_ATT); bf16_t* H = (bf16_t*)(a.ws() + WS_H);
    for (int t = blockIdx.x; t < (RT / 128) * 16; t += gridDim.x) {
        const int tm = t / 16, tn = t % 16;
        naive_tile(ATT + (size_t)tm * 128 * D, D, a.in(I_WO) + tn * 64, D, D, lds, [&](int r, int c, float v) {
            const int row = tm * 128 + r, col = tn * 64 + c;
            const float base = row < RL ? a.in(I_X)[(size_t)row * D + col] : a.in(I_CTX)[(size_t)(row - RL) * D + col];
            H[(size_t)row * D + col] = (bf16_t)f2bf(base + mod_ptr(a, 0, mod_row(row))[M_G1 + col] * v); });
    }
}
__device__ __forceinline__ void ph_gu_naive(const Ctx& a, LAS unsigned char* lds, int layer) {
    const int rpe = layer == 0 ? RPE0 : RPE1, tpe = (rpe / 128) * 88;
    const bf16_t* XG = (const bf16_t*)(a.ws() + WS_XG); float* T = (float*)(a.ws() + WS_TMPF);
    for (int t = blockIdx.x; t < NE * tpe; t += gridDim.x) {
        const int e = t / tpe, q = t % tpe, tm = q / 88, tn = q % 88;
        const size_t row0 = (size_t)e * rpe + tm * 128;
        naive_tile(XG + row0 * D, D, a.in(I_WGU) + (size_t)(layer * NE + e) * D * 2 * DE + tn * 64, 2 * DE, D, lds,
                   [&](int r, int c, float v) { T[(row0 + r) * (2 * DE) + tn * 64 + c] = v; });
    }
}
__device__ __forceinline__ void ph_swiglu_naive(const Ctx& a, int layer) {
    const int rpe = layer == 0 ? RPE0 : RPE1;
    const float* T = (const float*)(a.ws() + WS_TMPF); bf16_t* ACT = (bf16_t*)(a.ws() + WS_ACT);
    const size_t total = (size_t)NE * rpe * DE, nth = (size_t)gridDim.x * NTHREADS;
    for (size_t i = (size_t)blockIdx.x * NTHREADS + threadIdx.x; i < total; i += nth) {
        const size_t row = i / DE; const int j = (int)(i % DE);
        const float g = T[row * (2 * DE) + j], u = T[row * (2 * DE) + DE + j];
        ACT[i] = (bf16_t)f2bf(g / (1.f + expf(-g)) * u);
    }
}
__device__ __forceinline__ void ph_dn_naive(const Ctx& a, LAS unsigned char* lds, int layer) {
    const int rpe = layer == 0 ? RPE0 : RPE1, tpe = (rpe / 128) * 16;
    const bf16_t* ACT = (const bf16_t*)(a.ws() + WS_ACT); unsigned char* Y = a.ws() + WS_Y; const float* GATE = (const float*)(a.ws() + WS_GATE);
    for (int t = blockIdx.x; t < NE * tpe; t += gridDim.x) {
        const int e = t / tpe, q = t % tpe, tm = q / 16, tn = q % 16;
        const size_t row0 = (size_t)e * rpe + tm * 128;
        naive_tile(ACT + row0 * DE, DE, a.in(I_WDN) + (size_t)(layer * NE + e) * DE * D + tn * 64, D, DE, lds,
                   [&](int r, int c, float v) { Y[(row0 + r) * D + tn * 64 + c] = (unsigned char)(pk4_fp8(v * Y_SCALE, 0.f, 0.f, 0.f) & 0xffu); });
    }
}
__device__ __forceinline__ void ph_win_naive(const Ctx& a, LAS unsigned char* lds) {
    const bf16_t* XN = (const bf16_t*)(a.ws() + WS_XN); bf16_t* YG = (bf16_t*)(a.ws() + WS_YG); bf16_t* XR = (bf16_t*)(a.ws() + WS_XR);
    const int TL = (RL / 128) * 32, TC = (RC / 128) * 16;
    for (int t = blockIdx.x; t < TL + TC; t += gridDim.x) {
        int tm, tn; if (t < TL) { tm = t / 32; tn = t % 32; } else { const int q = t - TL; tm = RL / 128 + q / 16; tn = 16 + q % 16; }
        naive_tile(XN + (size_t)tm * 128 * D, D, a.in(I_WIN) + tn * 64, 2 * D, D, lds, [&](int r, int c, float v) {
            const int row = tm * 128 + r, col = tn * 64 + c; const float x = v + a.in(I_BIN)[col];
            if (col < D) YG[(size_t)row * D + col] = (bf16_t)f2bf(gelu_tanh(x)); else XR[(size_t)row * D + col - D] = (bf16_t)f2bf(x); });
    }
}
__device__ __forceinline__ void ph_conv_naive(const Ctx& a) {
    const bf16_t* XR = (const bf16_t*)(a.ws() + WS_XR); bf16_t* XC = (bf16_t*)(a.ws() + WS_XC);
    const size_t total = (size_t)RT * D, nth = (size_t)gridDim.x * NTHREADS;
    for (size_t i = (size_t)blockIdx.x * NTHREADS + threadIdx.x; i < total; i += nth) {
        const int row = (int)(i >> 10), ch = (int)(i & 1023);
        const int t = row < RL ? (row & 2047) : ((row - RL) & 255), L = row < RL ? SEQ : CTXL;
        float v = a.in(I_CONVB)[ch];
#pragma unroll
        for (int j = 0; j < 4; ++j) { const int tt = t - 2 + j; if (tt >= 0 && tt < L) v += a.in(I_CONVW)[j * D + ch] * bf2f(XR[(size_t)(row - t + tt) * D + ch]); }
        XC[i] = (bf16_t)f2bf(v);
    }
}
__device__ __forceinline__ void ph_gates_naive(const Ctx& a, LAS unsigned char* lds) {
    const bf16_t* XC = (const bf16_t*)(a.ws() + WS_XC); float* T = (float*)(a.ws() + WS_TMPF);
    for (int t = blockIdx.x; t < 16 * (RT / 128) * 4; t += gridDim.x) {
        const int m = t / ((RT / 128) * 4), q = t % ((RT / 128) * 4), tm = q >> 2, tn = q & 3, d = m >> 3, kb = m & 7;
        naive_tile(XC + (size_t)tm * 128 * D + kb * 128, D, a.in(I_WGATES) + (size_t)m * 128 * 256 + tn * 64, 256, 128, lds,
                   [&](int r, int c, float v) { T[((size_t)d * RT + tm * 128 + r) * 2048 + kb * 256 + tn * 64 + c] = v; });
    }
}
__device__ __forceinline__ void ph_gate_elem_naive(const Ctx& a) {
    const float* T = (const float*)(a.ws() + WS_TMPF); const bf16_t* XC = (const bf16_t*)(a.ws() + WS_XC);
    bf16_t* LOGA = (bf16_t*)(a.ws() + WS_LOGA); unsigned char* BT = a.ws() + WS_BT;
    const size_t total = (size_t)2 * RT * D, nth = (size_t)gridDim.x * NTHREADS;
    for (size_t i = (size_t)blockIdx.x * NTHREADS + threadIdx.x; i < total; i += nth) {
        const int d = (int)(i / ((size_t)RT * D)); const size_t rc = i % ((size_t)RT * D); const int row = (int)(rc >> 10), ch = (int)(rc & 1023), kb = ch >> 7, cc = ch & 127;
        const float gr = T[((size_t)d * RT + row) * 2048 + kb * 256 + cc] + a.in(I_BGATES)[(d * 8 + kb) * 256 + cc];
        const float gi = T[((size_t)d * RT + row) * 2048 + kb * 256 + 128 + cc] + a.in(I_BGATES)[(d * 8 + kb) * 256 + 128 + cc];
        const float r = sigmoidf_(gr), ig = sigmoidf_(gi);
        const float lam = a.in(I_LAM)[d * D + ch];
        const float la = -8.0f * r * log1pf(expf(-lam));
        const float x = bf2f(XC[rc]);
        const float bt = sqrtf(-expm1f(2.0f * la)) * (ig * x);
        LOGA[i] = (bf16_t)f2bf(la * 1.4426950408889634f); BT[i] = (unsigned char)(pk4_fp8(bt * BT_SCALE, 0.f, 0.f, 0.f) & 0xffu);
    }
}
__device__ __forceinline__ void ph_wout_naive(const Ctx& a, LAS unsigned char* lds) {
    const bf16_t* HS = (const bf16_t*)(a.ws() + WS_HS); bf16_t* H = (bf16_t*)(a.ws() + WS_H);
    for (int t = blockIdx.x; t < (RL / 128) * 16; t += gridDim.x) {
        const int tm = t / 16, tn = t % 16;
        naive_tile(HS + (size_t)tm * 128 * D, D, a.in(I_WOUT) + tn * 64, D, D, lds, [&](int r, int c, float v) {
            const int row = tm * 128 + r, col = tn * 64 + c;
            H[(size_t)row * D + col] = (bf16_t)f2bf(bf2f(H[(size_t)row * D + col]) + mod_ptr(a, 1, row >> 11)[M_G1 + col] * v); });
    }
}

__device__ __forceinline__ int scan_row(int b, int dir, int c, int s) {
    const int p = c * SCH + s;
    if (dir == 0) return p < CTXL ? RL + b * CTXL + p : b * SEQ + (p - CTXL);
    return p < CTXL ? RL + b * CTXL + (CTXL - 1 - p) : b * SEQ + (SEQ - 1 - (p - CTXL));
}
__device__ __forceinline__ void ph_scan1(const Ctx& a) {
    const int lane = threadIdx.x & 63, gw = blockIdx.x * NWAVES + (threadIdx.x >> 6), NGW = gridDim.x * NWAVES;
    const bf16_t* LOGA = (const bf16_t*)(a.ws() + WS_LOGA); const unsigned char* BT = a.ws() + WS_BT;
    float* CP = (float*)(a.ws() + WS_CP); float* CB = (float*)(a.ws() + WS_CB);
    for (int item = gw; item < NB * 2 * NCH * 8; item += NGW) {
        const int cg = item & 7, c = (item >> 3) % NCH, bd = (item >> 3) / NCH, dir = bd & 1, b = bd >> 1;
        const int ch = cg * 128 + 2 * lane;
        float h0 = 0.f, h1 = 0.f, p0 = 0.f, p1 = 0.f;
#pragma unroll 1
        for (int sg = 0; sg < SCH; sg += 32) {
            unsigned la[32], bt[32];
#pragma unroll
            for (int i = 0; i < 32; ++i) { const size_t o = ((size_t)dir * RT + scan_row(b, dir, c, sg + i)) * D + ch; la[i] = *(const unsigned*)(LOGA + o); bt[i] = *(const unsigned short*)(BT + o); }
            asm volatile("" ::: "memory");
#pragma unroll
            for (int i = 0; i < 32; ++i) { const float l0 = bf_lo(la[i]), l1 = bf_hi(la[i]);
                const f32x2 bb = __builtin_amdgcn_cvt_pk_f32_fp8((int)bt[i], false);
                h0 = __builtin_amdgcn_exp2f(l0) * h0 + bb.x; h1 = __builtin_amdgcn_exp2f(l1) * h1 + bb.y; p0 += l0; p1 += l1; }
        }
        const size_t so = ((size_t)(b * 2 + dir) * NCH + c) * D + ch;
        *(f32x2*)(CP + so) = (f32x2){p0, p1}; *(f32x2*)(CB + so) = (f32x2){h0, h1};
    }
}
__device__ __forceinline__ void ph_scan2(const Ctx& a) {
    const int lane = threadIdx.x & 63, gw = blockIdx.x * NWAVES + (threadIdx.x >> 6), NGW = gridDim.x * NWAVES;
    const bf16_t* LOGA = (const bf16_t*)(a.ws() + WS_LOGA); const unsigned char* BT = a.ws() + WS_BT;
    const float* CP = (const float*)(a.ws() + WS_CP); const float* CB = (const float*)(a.ws() + WS_CB);
    const bf16_t* YG = (const bf16_t*)(a.ws() + WS_YG); bf16_t* HS = (bf16_t*)(a.ws() + WS_HS);
    constexpr int NLC = SEQ / SCH;
    for (int item = gw; item < NB * NLC * 8; item += NGW) {
        const int cg = item & 7, j = (item >> 3) % NLC, b = (item >> 3) / NLC;
        const int ch = cg * 128 + 2 * lane;
        const int cb = NCH_CTX + (NLC - 1 - j), cf = NCH_CTX + j;
        float hb0 = 0.f, hb1 = 0.f, hf0 = 0.f, hf1 = 0.f;
#pragma unroll 1
        for (int c0 = 0; c0 < NCH - 1; c0 += 12) {
            f32x2 pb[12], qb[12], pf[12], qf[12];
#pragma unroll
            for (int i = 0; i < 12; ++i) {
                const int c = c0 + i; const size_t sb_ = ((size_t)(b * 2 + 1) * NCH + c) * D + ch, sf_ = ((size_t)(b * 2 + 0) * NCH + c) * D + ch;
                const f32x2 z = (f32x2){0.f, 0.f};
                pb[i] = c < cb ? *(const f32x2*)(CP + sb_) : z; qb[i] = c < cb ? *(const f32x2*)(CB + sb_) : z;
                pf[i] = c < cf ? *(const f32x2*)(CP + sf_) : z; qf[i] = c < cf ? *(const f32x2*)(CB + sf_) : z;
            }
            asm volatile("" ::: "memory");
#pragma unroll
            for (int i = 0; i < 12; ++i) {
                hb0 = __builtin_amdgcn_exp2f(pb[i].x) * hb0 + qb[i].x; hb1 = __builtin_amdgcn_exp2f(pb[i].y) * hb1 + qb[i].y;
                hf0 = __builtin_amdgcn_exp2f(pf[i].x) * hf0 + qf[i].x; hf1 = __builtin_amdgcn_exp2f(pf[i].y) * hf1 + qf[i].y;
            }
        }
        float sb0[SCH], sb1[SCH];
#pragma unroll
        for (int sg = 0; sg < SCH; sg += 32) {
            unsigned la[32], bt[32];
#pragma unroll
            for (int i = 0; i < 32; ++i) { const size_t o = ((size_t)1 * RT + b * SEQ + j * SCH + (SCH - 1 - (sg + i))) * D + ch; la[i] = *(const unsigned*)(LOGA + o); bt[i] = *(const unsigned short*)(BT + o); }
            asm volatile("" ::: "memory");
#pragma unroll
            for (int i = 0; i < 32; ++i) {
                const f32x2 bb = __builtin_amdgcn_cvt_pk_f32_fp8((int)bt[i], false);
                hb0 = __builtin_amdgcn_exp2f(bf_lo(la[i])) * hb0 + bb.x; hb1 = __builtin_amdgcn_exp2f(bf_hi(la[i])) * hb1 + bb.y;
                sb0[SCH - 1 - (sg + i)] = hb0; sb1[SCH - 1 - (sg + i)] = hb1;
            }
        }
#pragma unroll
        for (int sg = 0; sg < SCH; sg += 16) {
            unsigned la[16], bt[16], yg[16];
#pragma unroll
            for (int i = 0; i < 16; ++i) { const size_t o = ((size_t)b * SEQ + j * SCH + sg + i) * D + ch; la[i] = __builtin_nontemporal_load((const unsigned*)(LOGA + o)); bt[i] = __builtin_nontemporal_load((const unsigned short*)(BT + o)); yg[i] = __builtin_nontemporal_load((const unsigned*)(YG + o)); }
            asm volatile("" ::: "memory");
#pragma unroll
            for (int i = 0; i < 16; ++i) {
                const size_t o = ((size_t)b * SEQ + j * SCH + sg + i) * D + ch;
                const f32x2 bb = __builtin_amdgcn_cvt_pk_f32_fp8((int)bt[i], false);
                hf0 = __builtin_amdgcn_exp2f(bf_lo(la[i])) * hf0 + bb.x; hf1 = __builtin_amdgcn_exp2f(bf_hi(la[i])) * hf1 + bb.y;
                *(unsigned*)(HS + o) = pk2(bf_lo(yg[i]) * ((hf0 + sb0[sg + i]) * (1.0f / BT_SCALE)), bf_hi(yg[i]) * ((hf1 + sb1[sg + i]) * (1.0f / BT_SCALE)));
            }
            asm volatile("" ::: "memory");
        }
    }
}
#define XB_TMO      128
#define XB_XCNT(j)  (256  + 64 * (j))
#define XB_XSUB(j)  (1280 + 64 * (j))
#define XB_XGEN(j)  (2304 + 64 * (j))
#define XB_TOP      3328
#define XB_TOPGEN   3392
#define XCD_BAR_WORDS 3456
#define XB_SPIN_CAP (1u << 18)

__device__ __forceinline__ unsigned xb_ld(unsigned* p)              { return __hip_atomic_load(p, __ATOMIC_RELAXED, __HIP_MEMORY_SCOPE_AGENT); }
__device__ __forceinline__ unsigned xb_add(unsigned* p, unsigned v) { return __hip_atomic_fetch_add(p, v, __ATOMIC_RELAXED, __HIP_MEMORY_SCOPE_AGENT); }
__device__ __forceinline__ unsigned xb_xcc_id() { return (unsigned)__builtin_amdgcn_s_getreg((3 << 11) | 20) & 0xFu; }
#define XB_SPIN(cond, bar) do { unsigned _sp = 0; while (cond) { __builtin_amdgcn_s_sleep(1); \
    if ((++_sp & 255u) == 0u) { if (xb_ld(&(bar)[XB_TMO])) break; if (_sp > XB_SPIN_CAP) { atomicAdd(&(bar)[XB_TMO], 1u); break; } } } } while (0)

struct XcdBarrier {
    unsigned* bar; unsigned x;
    volatile LAS unsigned* st;
};

__device__ __forceinline__ XcdBarrier xcd_barrier_post(unsigned* bar, volatile LAS unsigned* st) {
    XcdBarrier b; b.bar = bar; b.x = xb_xcc_id(); b.st = st;
    if (threadIdx.x == 0) (void)xb_add(&bar[XB_XCNT(b.x)], 1u);
    return b;
}
__device__ __forceinline__ void xcd_barrier_complete(unsigned* bar, unsigned x, unsigned& nloc, unsigned& nx) {
    const unsigned G = gridDim.x * gridDim.y * gridDim.z;
    unsigned sum, cnt, mine, sp = 0u;
    for (;;) {
        sum = 0u; cnt = 0u; mine = 0u;
#pragma unroll
        for (unsigned j = 0; j < 16; ++j) { const unsigned c = xb_ld(&bar[XB_XCNT(j)]); sum += c; cnt += (c > 0u) ? 1u : 0u; mine = (j == x) ? c : mine; }
        if (sum == G) break;
        __builtin_amdgcn_s_sleep(1);
        if ((++sp & 255u) == 0u) { if (xb_ld(&bar[XB_TMO])) break; if (sp > XB_SPIN_CAP) { atomicAdd(&bar[XB_TMO], 1u); break; } }
    }
    nloc = mine > 0u ? mine : 1u; nx = cnt > 0u ? cnt : 1u;
}

__device__ __forceinline__ void xcd_barrier(const XcdBarrier& b) {
    asm volatile("s_waitcnt vmcnt(0)" ::: "memory");
    __syncthreads();
    if (threadIdx.x == 0) {
        unsigned* bar = b.bar;
        __builtin_amdgcn_s_waitcnt(0);
        unsigned nloc = b.st[0], nx = b.st[1];
        if (nloc == 0u) { xcd_barrier_complete(bar, b.x, nloc, nx); b.st[0] = nloc; b.st[1] = nx; }
        const unsigned old = xb_add(&bar[XB_XSUB(b.x)], 1u);
        const unsigned gen = old / nloc;
        if (old + 1u == (gen + 1u) * nloc) {
            __builtin_amdgcn_fence(__ATOMIC_RELEASE, "agent");
            asm volatile("s_waitcnt vmcnt(0)" ::: "memory");
            const unsigned og = xb_add(&bar[XB_TOP], 1u);
            const unsigned tg = og / nx;
            if (og + 1u == (tg + 1u) * nx) xb_add(&bar[XB_TOPGEN], 1u);
            else XB_SPIN(xb_ld(&bar[XB_TOPGEN]) == tg, bar);
            __builtin_amdgcn_fence(__ATOMIC_ACQUIRE, "agent");
            xb_add(&bar[XB_XGEN(b.x)], 1u);
            asm volatile("s_waitcnt vmcnt(0)" ::: "memory");
        } else {
            XB_SPIN(xb_ld(&bar[XB_XGEN(b.x)]) == gen, bar);
            __builtin_amdgcn_fence(__ATOMIC_ACQUIRE, "agent");
            asm volatile("s_waitcnt vmcnt(0)" ::: "memory");
        }
    }
    __syncthreads();
}

__device__ __forceinline__ int xcd_remap(long L, int n) { const int q = n / 8, r = n % 8, xcd = (int)(L % 8), off = (int)(L / 8); return (xcd < r ? xcd * (q + 1) : r * (q + 1) + (xcd - r) * q) + off; }
template <class Map> struct ListOrder {
    int nunits, G, c; Map map;
    __device__ __forceinline__ bool next(int i, pg8::Unit& u) const { const long L = (long)i * G + c; if (L >= nunits) return false; map(xcd_remap(L, nunits), u); return true; }
    __device__ __forceinline__ void a_ready(const pg8::Unit&) const {}
    __device__ __forceinline__ void done(const pg8::Unit&) const {}
};
#ifndef WGMG
#define WGMG 8
#endif
struct MapGrid { int nN; __device__ __forceinline__ void operator()(int w, pg8::Unit& u) const { const int nig = WGMG * nN; u.pm = (w / nig) * WGMG + (w % nig) % WGMG; u.pn = (w % nig) / WGMG; } };
struct MapMoe { int PM, NT; __device__ __forceinline__ void operator()(int w, pg8::Unit& u) const { const int per = PM * NT, e = w / per, rem = w % per; u.pm = e * PM + rem % PM; u.pn = e * NT + rem / PM; } };
struct MapWin { __device__ __forceinline__ void operator()(int w, pg8::Unit& u) const { if (w < 512) { u.pm = (w / 64) * 8 + (w % 64) % 8; u.pn = (w % 64) / 8; } else { const int q = w - 512; u.pm = 64 + q % 8; u.pn = 4 + q / 8; } } };

typedef pg8::f32x4 pf4;
__device__ __forceinline__ float fast_exp(float x) { return __builtin_amdgcn_exp2f(x * 1.4426950408889634f); }

struct EpiQKV {
    static constexpr bool PERM = true, AFTER_DRAIN = false;
    bf16_t* Q; const LAS float* rope;
    __device__ __forceinline__ void operator()(const pf4 (&acc)[2][2][4][2], const pg8::Unit& u, int wr, int wc, int fr, int fq) const {
        const int sec = u.pn >> 2; bf16_t* base = Q + (size_t)sec * ((WS_K - WS_Q) / 2);
        const bool lat = u.pm < 64, dorope = sec < 2 && lat; const int axis = wc & 1;
        const bool upper = fq >= 2;
        const int row0 = u.pm * 256 + wr * 64 + fr, col0 = (u.pn & 3) * 256 + wc * 32 + 8 * fq;
        const float sc = sec == 0 ? QSCALE : 1.0f;
#pragma unroll
        for (int ai = 0; ai < 2; ++ai)
#pragma unroll
            for (int m = 0; m < 4; ++m) {
                const int row = row0 + ai * 128 + m * 16;
                pf4 cs[2], sn[2];
#pragma unroll
                for (int n = 0; n < 2; ++n) { cs[n] = (pf4){1.f, 1.f, 1.f, 1.f}; sn[n] = (pf4){0.f, 0.f, 0.f, 0.f}; }
                if (dorope) { const int t = row & 2047, pos = axis ? (t & 63) : (t >> 6); const LAS float* rp = rope + pos * 16 + 8 * (fq & 1);
#pragma unroll
                    for (int n = 0; n < 2; ++n) { cs[n] = *(const LAS pf4*)(rp + 4 * n); sn[n] = *(const LAS pf4*)(rp + 1024 + 4 * n); } }
#pragma unroll
                for (int bj = 0; bj < 2; ++bj) {
                    pf4 o[2];
#pragma unroll
                    for (int n = 0; n < 2; ++n)
#pragma unroll
                        for (int j = 0; j < 4; ++j) {
                            const float own = acc[ai][bj][m][n][j];
                            float v = own;
                            if (dorope) {
                                const auto rr = __builtin_amdgcn_permlane32_swap(__float_as_uint(own), __float_as_uint(own), false, false);
                                const float other = __uint_as_float(upper ? rr[0] : rr[1]);
                                v = upper ? (own * cs[n][j] + other * sn[n][j]) : (own * cs[n][j] - other * sn[n][j]);
                            }
                            o[n][j] = v * sc;
                        }
                    u32x4 w; w.x = pk2(o[0][0], o[0][1]); w.y = pk2(o[0][2], o[0][3]); w.z = pk2(o[1][0], o[1][1]); w.w = pk2(o[1][2], o[1][3]);
                    st16_wt(base + (size_t)row * D + col0 + bj * 128, w);
                }
            }
    }
};
struct EpiResid {
    static constexpr bool PERM = true, AFTER_DRAIN = false;
    bf16_t* H; const float* x; const float* ctx; const float* mod; int layer;
    __device__ __forceinline__ void operator()(const pf4 (&acc)[2][2][4][2], const pg8::Unit& u, int wr, int wc, int fr, int fq) const {
        const bool lat = u.pm < 64;
        const float* xb = lat ? x + (size_t)u.pm * 256 * D : ctx + (size_t)(u.pm - 64) * 256 * D;
        const float* g = mod + (size_t)(layer * 9 + (lat ? (u.pm >> 3) : 8)) * 6144 + M_G1;
        bf16_t* out = H + (size_t)u.pm * 256 * D;
        const int r0 = wr * 64 + fr, col0 = u.pn * 256 + wc * 32 + 8 * fq;
        pf4 gv[2][2];
#pragma unroll
        for (int bj = 0; bj < 2; ++bj)
#pragma unroll
            for (int n = 0; n < 2; ++n) gv[bj][n] = *(const pf4*)(g + col0 + bj * 128 + 4 * n);
#pragma unroll
        for (int it = 0; it < 8; ++it) {
            const int ai = it >> 2, m = it & 3;
            const size_t ro = (size_t)(r0 + ai * 128 + m * 16) * D + col0;
#pragma unroll
            for (int bj = 0; bj < 2; ++bj) {
                pf4 b0, b1;
                if (layer == 0) { b0 = *(const pf4*)(xb + ro + bj * 128); b1 = *(const pf4*)(xb + ro + bj * 128 + 4); }
                else { const u32x4 hb = *(const u32x4*)(out + ro + bj * 128); b0 = (pf4){bf_lo(hb.x), bf_hi(hb.x), bf_lo(hb.y), bf_hi(hb.y)}; b1 = (pf4){bf_lo(hb.z), bf_hi(hb.z), bf_lo(hb.w), bf_hi(hb.w)}; }
                const pf4 o0 = b0 + gv[bj][0] * acc[ai][bj][m][0], o1 = b1 + gv[bj][1] * acc[ai][bj][m][1];
                u32x4 w; w.x = pk2(o0[0], o0[1]); w.y = pk2(o0[2], o0[3]); w.z = pk2(o1[0], o1[1]); w.w = pk2(o1[2], o1[3]);
                st16_wt(out + ro + bj * 128, w);
            }
        }
    }
};
struct EpiSwiGLU {
    static constexpr bool PERM = true, AFTER_DRAIN = false;
    bf16_t* ACT;
    __device__ __forceinline__ void operator()(const pf4 (&acc)[2][2][4][2], const pg8::Unit& u, int wr, int wc, int fr, int fq) const {
        const int ct = u.pn % 22;
        bf16_t* p0 = ACT + (size_t)(u.pm * 256 + wr * 64 + fr) * DE + ct * 128 + wc * 32 + 8 * fq;
#pragma unroll
        for (int ai = 0; ai < 2; ++ai)
#pragma unroll
            for (int m = 0; m < 4; ++m) {
                float o[8];
#pragma unroll
                for (int n = 0; n < 2; ++n)
#pragma unroll
                    for (int j = 0; j < 4; ++j) { const float g = acc[ai][0][m][n][j], uu = acc[ai][1][m][n][j]; o[n * 4 + j] = g * __builtin_amdgcn_rcpf(1.0f + fast_exp(-g)) * uu; }
                u32x4 w; w.x = pk2(o[0], o[1]); w.y = pk2(o[2], o[3]); w.z = pk2(o[4], o[5]); w.w = pk2(o[6], o[7]);
                *(u32x4*)(p0 + (size_t)(ai * 128 + m * 16) * DE) = w;
            }
    }
};
struct EpiDown {
    static constexpr bool PERM = true, AFTER_DRAIN = false;
    unsigned char* Y;
    __device__ __forceinline__ void operator()(const pf4 (&acc)[2][2][4][2], const pg8::Unit& u, int wr, int wc, int fr, int fq) const {
        const int row0 = u.pm * 256 + wr * 64 + fr, col0 = (u.pn & 3) * 256 + wc * 32 + 8 * fq;
#pragma unroll
        for (int ai = 0; ai < 2; ++ai)
#pragma unroll
            for (int m = 0; m < 4; ++m) {
                const int row = row0 + ai * 128 + m * 16;
#pragma unroll
                for (int bj = 0; bj < 2; ++bj) {
                    const pf4 v0 = acc[ai][bj][m][0] * Y_SCALE, v1 = acc[ai][bj][m][1] * Y_SCALE;
                    u32x2 w; w.x = pk4_fp8(v0[0], v0[1], v0[2], v0[3]); w.y = pk4_fp8(v1[0], v1[1], v1[2], v1[3]);
                    st8_wt(Y + (size_t)row * D + col0 + bj * 128, w);
                }
            }
    }
};
struct EpiWin {
    static constexpr bool PERM = true, AFTER_DRAIN = false;
    bf16_t *YG, *XR; const LAS float* bin;
    __device__ __forceinline__ void operator()(const pf4 (&acc)[2][2][4][2], const pg8::Unit& u, int wr, int wc, int fr, int fq) const {
        const bool yb = u.pn < 4; bf16_t* base = yb ? YG : XR;
        const int row0 = u.pm * 256 + wr * 64 + fr, colg = u.pn * 256 + wc * 32 + 8 * fq, col0 = (u.pn & 3) * 256 + wc * 32 + 8 * fq;
        pf4 bv[2][2];
#pragma unroll
        for (int bj = 0; bj < 2; ++bj)
#pragma unroll
            for (int n = 0; n < 2; ++n) bv[bj][n] = *(const LAS pf4*)(bin + colg + bj * 128 + 4 * n);
#pragma unroll
        for (int ai = 0; ai < 2; ++ai)
#pragma unroll
            for (int m = 0; m < 4; ++m) {
                const int row = row0 + ai * 128 + m * 16;
#pragma unroll
                for (int bj = 0; bj < 2; ++bj) {
                    pf4 v0 = acc[ai][bj][m][0] + bv[bj][0], v1 = acc[ai][bj][m][1] + bv[bj][1];
                    if (yb) {
#pragma unroll
                        for (int j = 0; j < 4; ++j) {
                            { const float x = v0[j], uu = 0.7978845608028654f * (x + 0.044715f * x * x * x); v0[j] = x * __builtin_amdgcn_rcpf(1.0f + fast_exp(-2.0f * uu)); }
                            { const float x = v1[j], uu = 0.7978845608028654f * (x + 0.044715f * x * x * x); v1[j] = x * __builtin_amdgcn_rcpf(1.0f + fast_exp(-2.0f * uu)); }
                        }
                    }
                    u32x4 w; w.x = pk2(v0[0], v0[1]); w.y = pk2(v0[2], v0[3]); w.z = pk2(v1[0], v1[1]); w.w = pk2(v1[2], v1[3]);
                    st16_wt(base + (size_t)row * D + col0 + bj * 128, w);
                }
            }
    }
};

#ifndef DENSE_ALIGN
#define DENSE_ALIGN true
#endif
#ifndef DENSE_SP2
#define DENSE_SP2 true
#endif
__device__ __forceinline__ void stagger_start(int ticks) {
    if (ticks > 0 && ((blockIdx.x >> 3) & 1)) { const unsigned long long t0 = __builtin_amdgcn_s_memrealtime(); while (__builtin_amdgcn_s_memrealtime() - t0 < (unsigned long long)ticks) __builtin_amdgcn_s_sleep(8); }
}
#ifndef STG_QKV
#define STG_QKV 0
#endif
#ifndef STG_GU
#define STG_GU 0
#endif
#ifndef STG_DN
#define STG_DN 0
#endif
#ifndef STG_WIN
#define STG_WIN 0
#endif
#ifndef STG_WO
#define STG_WO 0
#endif
#define PG8_RUN(EPI, SCHED, g, S, E) pg8::gemm_phase<EPI, SCHED, DENSE_ALIGN, DENSE_SP2>((PG8_LAS unsigned char*)lds, g, S, E)

__device__ __forceinline__ void ph_qkv_fast(const Ctx& a, LAS unsigned char* lds) {
    unsigned char* ws = a.ws();
    pg8::Gemm g{(const bf16_t*)(ws + WS_XN), (const bf16_t*)(ws + WS_WQKV), RT, 3 * D, D};
    const int Gq = gemm_groups(72 * 12, (int)gridDim.x);
    if ((int)blockIdx.x >= Gq) { cvt8_run(a, 0, CV0_QKV + ((int)blockIdx.x - Gq), (int)gridDim.x - Gq, CV0_QKV + CVQ_QKV, lds); return; }
    ListOrder<MapGrid> S{72 * 12, Gq, (int)blockIdx.x, MapGrid{12}};
    static_assert(WS_V - WS_K == WS_K - WS_Q, "Q|K|V spacing");
    LAS float* rl = (LAS float*)(lds + ROPE_LDS);
    { const float* rg = (const float*)(ws + WS_ROPE); for (int i = threadIdx.x; i < 2048; i += NTHREADS) rl[i] = rg[i]; }
    __syncthreads();
    EpiQKV E{(bf16_t*)(ws + WS_Q), rl};
    stagger_start(STG_QKV);
    PG8_RUN(EpiQKV, ListOrder<MapGrid>, g, S, E);
    if (Gq == (int)gridDim.x) cvt8_tail(a, lds, 72 * 12, Gq, (int)blockIdx.x, 0, CV0_QKV, CVQ_QKV);
}
__device__ __forceinline__ void ph_wo_fast(const Ctx& a, LAS unsigned char* lds) {
    unsigned char* ws = a.ws();
    pg8::Gemm g{(const bf16_t*)(ws + WS_ATT), (const bf16_t*)(ws + WS_WO), RT, D, D};
    const int Gq = gemm_groups(72 * 4, (int)gridDim.x);
    if ((int)blockIdx.x >= Gq) { cvt8_run(a, 0, CV0_WO + ((int)blockIdx.x - Gq), (int)gridDim.x - Gq, CV0_WO + CVQ_WO, lds); return; }
    ListOrder<MapGrid> S{72 * 4, Gq, (int)blockIdx.x, MapGrid{4}};
    EpiResid E{(bf16_t*)(ws + WS_H), a.in(I_X), a.in(I_CTX), (const float*)(ws + WS_MOD), 0};
    stagger_start(STG_WO);
    PG8_RUN(EpiResid, ListOrder<MapGrid>, g, S, E);
    if (Gq == (int)gridDim.x) cvt8_tail(a, lds, 72 * 4, Gq, (int)blockIdx.x, 0, CV0_WO, CVQ_WO);
}
__device__ __forceinline__ void ph_wout_fast(const Ctx& a, LAS unsigned char* lds) {
    unsigned char* ws = a.ws();
    pg8::Gemm g{(const bf16_t*)(ws + WS_HS), (const bf16_t*)(ws + WS_WOUT), RL, D, D};
    ListOrder<MapGrid> S{64 * 4, (int)gridDim.x, (int)blockIdx.x, MapGrid{4}};
    EpiResid E{(bf16_t*)(ws + WS_H), nullptr, nullptr, (const float*)(ws + WS_MOD), 1};
    PG8_RUN(EpiResid, ListOrder<MapGrid>, g, S, E);
}
#if FP8_MOE
struct EpiSwiGLU8 {
    static constexpr bool PERM = true, AFTER_DRAIN = false;
    unsigned char* ACT;
    __device__ __forceinline__ void operator()(const pf4 (&acc)[2][2][4][2], const pg8::Unit& u, int wr, int wc, int fr, int fq) const {
        const int ct = u.pn % 22;
        unsigned char* p0 = ACT + (size_t)(u.pm * 256 + wr * 64 + fr) * DE + ct * 128 + wc * 32 + 8 * fq;
#pragma unroll
        for (int ai = 0; ai < 2; ++ai)
#pragma unroll
            for (int m = 0; m < 4; ++m) {
                float o[8];
#pragma unroll
                for (int n = 0; n < 2; ++n)
#pragma unroll
                    for (int j = 0; j < 4; ++j) { const float g = acc[ai][0][m][n][j], uu = acc[ai][1][m][n][j]; o[n * 4 + j] = g * __builtin_amdgcn_rcpf(1.0f + fast_exp(-g)) * uu; }
                u32x2 w; w.x = pk4_fp8(o[0], o[1], o[2], o[3]); w.y = pk4_fp8(o[4], o[5], o[6], o[7]);
                st8_wt(p0 + (size_t)(ai * 128 + m * 16) * DE, w);
            }
    }
};
__device__ __forceinline__ void ph_gu_fast(const Ctx& a, LAS unsigned char* lds, int layer) {
    unsigned char* ws = a.ws(); const int PM = (layer == 0 ? RPE0 : RPE1) / 256;
    pg8::Gemm g{(const bf16_t*)(ws + WS_XG), (const bf16_t*)(ws + WS_WGU + (size_t)layer * (WGU_LAYER / 2)), NE * PM * 256, NE * 2 * DE, D / 2};
    ListOrder<MapMoe> S{NE * PM * 22, (int)gridDim.x, (int)blockIdx.x, MapMoe{PM, 22}};
    EpiSwiGLU8 E{ws + WS_ACT};
    stagger_start(STG_GU);
    pg8::gemm_phase<EpiSwiGLU8, ListOrder<MapMoe>, GU_ALIGN, true, 122>((PG8_LAS unsigned char*)lds, g, S, E);
    if (layer == 0) cvt8_tail(a, lds, NE * PM * 22, (int)gridDim.x, (int)blockIdx.x, 1, CV1_GU0, CVQ_GU0);
}
__device__ __forceinline__ void ph_dn_fast(const Ctx& a, LAS unsigned char* lds, int layer) {
    unsigned char* ws = a.ws(); const int PM = (layer == 0 ? RPE0 : RPE1) / 256;
    pg8::Gemm g{(const bf16_t*)(ws + WS_ACT), (const bf16_t*)(ws + WS_WDN + (size_t)layer * (WDN_LAYER / 2)), NE * PM * 256, NE * D, DE / 2};
    const int Gq = layer == 0 ? gemm_groups(NE * PM * 4, (int)gridDim.x) : (int)gridDim.x;
    if ((int)blockIdx.x >= Gq) { cvt8_run(a, 1, CV1_DN0 + ((int)blockIdx.x - Gq), (int)gridDim.x - Gq, CV1_DN0 + CVQ_DN0, lds); return; }
    ListOrder<MapMoe> S{NE * PM * 4, Gq, (int)blockIdx.x, MapMoe{PM, 4}};
    EpiDown E{ws + WS_Y};
    stagger_start(STG_DN);
    pg8::gemm_phase<EpiDown, ListOrder<MapMoe>, DN_ALIGN, true, 121>((PG8_LAS unsigned char*)lds, g, S, E);
    if (layer == 0 && Gq == (int)gridDim.x) cvt8_tail(a, lds, NE * PM * 4, Gq, (int)blockIdx.x, 1, CV1_DN0, CVQ_DN0);
}
#else
__device__ __forceinline__ void ph_gu_fast(const Ctx& a, LAS unsigned char* lds, int layer) {
    unsigned char* ws = a.ws(); const int PM = (layer == 0 ? RPE0 : RPE1) / 256;
    pg8::Gemm g{(const bf16_t*)(ws + WS_XG), (const bf16_t*)(ws + WS_WGU + (size_t)layer * WGU_LAYER), NE * PM * 256, NE * 2 * DE, D};
    ListOrder<MapMoe> S{NE * PM * 22, (int)gridDim.x, (int)blockIdx.x, MapMoe{PM, 22}};
    EpiSwiGLU E{(bf16_t*)(ws + WS_ACT)};
    PG8_RUN(EpiSwiGLU, ListOrder<MapMoe>, g, S, E);
}
__device__ __forceinline__ void ph_dn_fast(const Ctx& a, LAS unsigned char* lds, int layer) {
    unsigned char* ws = a.ws(); const int PM = (layer == 0 ? RPE0 : RPE1) / 256;
    pg8::Gemm g{(const bf16_t*)(ws + WS_ACT), (const bf16_t*)(ws + WS_WDN + (size_t)layer * WDN_LAYER), NE * PM * 256, NE * D, DE};
    const int Gq = layer == 0 ? gemm_groups(NE * PM * 4, (int)gridDim.x) : (int)gridDim.x;
    if ((int)blockIdx.x >= Gq) { cvt8_run(a, 1, CV1_DN0 + ((int)blockIdx.x - Gq), (int)gridDim.x - Gq, CV1_DN0 + CVQ_DN0, lds); return; }
    ListOrder<MapMoe> S{NE * PM * 4, Gq, (int)blockIdx.x, MapMoe{PM, 4}};
    EpiDown E{ws + WS_Y};
    PG8_RUN(EpiDown, ListOrder<MapMoe>, g, S, E);
}
#endif
__device__ __forceinline__ void ph_win_fast(const Ctx& a, LAS unsigned char* lds) {
    unsigned char* ws = a.ws();
    pg8::Gemm g{(const bf16_t*)(ws + WS_XN), (const bf16_t*)(ws + WS_WIN), RT, 2 * D, D};
    const int Gq = gemm_groups(512 + 32, (int)gridDim.x);
    if ((int)blockIdx.x >= Gq) { cvt8_run(a, 1, CV1_WIN + ((int)blockIdx.x - Gq), (int)gridDim.x - Gq, CV1_WIN + CVQ_WIN, lds); return; }
    ListOrder<MapWin> S{512 + 32, Gq, (int)blockIdx.x, MapWin{}};
    LAS float* bl = (LAS float*)(lds + ROPE_LDS);
    { const float* bg = a.in(I_BIN); for (int i = threadIdx.x; i < 2 * D; i += NTHREADS) bl[i] = bg[i]; }
    __syncthreads();
    EpiWin E{(bf16_t*)(ws + WS_YG), (bf16_t*)(ws + WS_XR), bl};
    stagger_start(STG_WIN);
    PG8_RUN(EpiWin, ListOrder<MapWin>, g, S, E);
    if (Gq == (int)gridDim.x) cvt8_tail(a, lds, 512 + 32, Gq, (int)blockIdx.x, 1, CV1_WIN, CVQ_WIN);
}

namespace fa {
using bf16x8 = __attribute__((ext_vector_type(8))) short;
using s16x4  = __attribute__((ext_vector_type(4))) short;
using f32x16 = __attribute__((ext_vector_type(16))) float;
using u32x4v = __attribute__((ext_vector_type(4))) unsigned;
constexpr int SHM_V = 64 * 128 * 2, SHM_K = 64 * 128 * 2;
#ifndef ATT_THR
#define ATT_THR 11.5f
#endif
constexpr float THR_L2 = ATT_THR;
#define KSWZ(row, colB) ((row) * 256 + ((colB) ^ (((row) & 7) << 4)))
#define SBAR() __builtin_amdgcn_sched_barrier(0)
__device__ __forceinline__ int crow(int r, int hi) { return (r & 3) + 8 * (r >> 2) + 4 * hi; }
__device__ __forceinline__ unsigned cvtpk(float lo, float hi) { unsigned r; asm volatile("v_cvt_pk_bf16_f32 %0, %1, %2" : "=v"(r) : "v"(lo), "v"(hi)); return r; }
__device__ __forceinline__ void partialSM(f32x16& p0, f32x16& p1, float& m_reg, float& mn, float& alpha) {
  float pmax = p0[0];
#pragma unroll
  for (int r = 1; r < 16; ++r) pmax = fmaxf(pmax, p0[r]);
#pragma unroll
  for (int r = 0; r < 16; ++r) pmax = fmaxf(pmax, p1[r]);
  { auto rr = __builtin_amdgcn_permlane32_swap(__float_as_uint(pmax), __float_as_uint(pmax), false, false);
    pmax = fmaxf(__uint_as_float(rr[0]), __uint_as_float(rr[1])); }
  if (__builtin_expect(__all(pmax - m_reg <= THR_L2), 1)) { mn = m_reg; alpha = 1.f; }
  else { mn = fmaxf(m_reg, pmax); alpha = __builtin_amdgcn_exp2f(m_reg - mn); m_reg = mn; }
  { typedef float f2_t __attribute__((ext_vector_type(2))); const f2_t mn2 = {mn, mn};
#pragma unroll
    for (int r = 0; r < 16; r += 2) { const f2_t a_ = (f2_t){p0[r], p0[r + 1]} - mn2; p0[r] = a_.x; p0[r + 1] = a_.y; const f2_t b_ = (f2_t){p1[r], p1[r + 1]} - mn2; p1[r] = b_.x; p1[r + 1] = b_.y; } }
#pragma unroll
  for (int r = 0; r < 16; ++r) p0[r] = __builtin_amdgcn_exp2f(p0[r]);
}
__device__ __forceinline__ void finishSM(f32x16& p0, f32x16& p1, float alpha, float& l_reg, bf16x8& pa0, bf16x8& pa1, bf16x8& pa2, bf16x8& pa3) {
#pragma unroll
  for (int r = 0; r < 16; ++r) p1[r] = __builtin_amdgcn_exp2f(p1[r]);
  float ps = 0;
#pragma unroll
  for (int r = 0; r < 16; ++r) ps += p0[r];
#pragma unroll
  for (int r = 0; r < 16; ++r) ps += p1[r];
  { auto rr = __builtin_amdgcn_permlane32_swap(__float_as_uint(ps), __float_as_uint(ps), false, false);
    ps = __uint_as_float(rr[0]) + __uint_as_float(rr[1]); }
  l_reg = l_reg * alpha + ps;
#define PK4(P, BASE, OUT) do { unsigned a0 = cvtpk(P[BASE + 0], P[BASE + 1]), a1 = cvtpk(P[BASE + 2], P[BASE + 3]);   \
    unsigned b0 = cvtpk(P[BASE + 4], P[BASE + 5]), b1 = cvtpk(P[BASE + 6], P[BASE + 7]);                              \
    auto r0 = __builtin_amdgcn_permlane32_swap(a0, b0, false, false); auto r1 = __builtin_amdgcn_permlane32_swap(a1, b1, false, false); \
    u32x4v w = {r0[0], r1[0], r0[1], r1[1]}; OUT = *reinterpret_cast<bf16x8*>(&w); } while (0)
  PK4(p0, 0, pa0); PK4(p0, 8, pa1); PK4(p1, 0, pa2); PK4(p1, 8, pa3);
#undef PK4
}
__device__ __forceinline__ void qkt(f32x16& p0, f32x16& p1, const LAS char* Ks, const bf16x8* qr, int r32, int hi, int s) {
  p0 = f32x16{}; p1 = f32x16{};
#pragma unroll
  for (int d0 = 0; d0 < 4; ++d0) { const int cb = (s * 64 + d0 * 16 + hi * 8) * 2;
    const bf16x8 b0 = *reinterpret_cast<const LAS bf16x8*>(Ks + KSWZ(r32, cb));
    const bf16x8 b1 = *reinterpret_cast<const LAS bf16x8*>(Ks + KSWZ(32 + r32, cb));
    p0 = __builtin_amdgcn_mfma_f32_32x32x16_bf16(b0, qr[d0], p0, 0, 0, 0);
    p1 = __builtin_amdgcn_mfma_f32_32x32x16_bf16(b1, qr[d0], p1, 0, 0, 0); }
}
__device__ __forceinline__ int v_st(int k, int c) { const int kk = (k & ~0xC) | ((k & 4) << 1) | ((k & 8) >> 1); return ((kk >> 3) * 4 + (c >> 5)) * 512 + ((kk & 7) * 32 + (c & 31)) * 2; }
__device__ __forceinline__ int v_rd_base(int lane) { return ((lane & 3) << 3) | (((lane >> 2) & 3) << 6) | (((lane >> 4) & 1) << 5) | (((lane >> 5) & 1) << 8); }
constexpr int v_rd_off(int d0, int ks, int half) { return d0 * 512 + ks * 4096 + half * 2048; }
template <int OFF> __device__ __forceinline__ s16x4 tr_read(int vb) {
  s16x4 r; asm volatile("ds_read_b64_tr_b16 %0, %1 offset:%2" : "=&v"(r) : "v"(vb), "i"(OFF) : "memory"); return r;
}
template <int D0> __device__ __forceinline__ void pv_one(f32x16& od, int vb, bf16x8 pa0, bf16x8 pa1, bf16x8 pa2, bf16x8 pa3) {
  const s16x4 l0 = tr_read<v_rd_off(D0, 0, 0)>(vb), h0 = tr_read<v_rd_off(D0, 0, 1)>(vb), l1 = tr_read<v_rd_off(D0, 1, 0)>(vb), h1 = tr_read<v_rd_off(D0, 1, 1)>(vb);
  const s16x4 l2 = tr_read<v_rd_off(D0, 2, 0)>(vb), h2 = tr_read<v_rd_off(D0, 2, 1)>(vb), l3 = tr_read<v_rd_off(D0, 3, 0)>(vb), h3 = tr_read<v_rd_off(D0, 3, 1)>(vb);
  asm volatile("s_waitcnt lgkmcnt(0)" ::: "memory"); SBAR();
#define PK(L, H) (bf16x8){L[0], L[1], L[2], L[3], H[0], H[1], H[2], H[3]}
  od = __builtin_amdgcn_mfma_f32_32x32x16_bf16(pa0, PK(l0, h0), od, 0, 0, 0);
  od = __builtin_amdgcn_mfma_f32_32x32x16_bf16(pa1, PK(l1, h1), od, 0, 0, 0);
  od = __builtin_amdgcn_mfma_f32_32x32x16_bf16(pa2, PK(l2, h2), od, 0, 0, 0);
  od = __builtin_amdgcn_mfma_f32_32x32x16_bf16(pa3, PK(l3, h3), od, 0, 0, 0);
#undef PK
}
__device__ __forceinline__ void pv_d0(f32x16* o, int vb, bf16x8 pa0, bf16x8 pa1, bf16x8 pa2, bf16x8 pa3) {
  pv_one<0>(o[0], vb, pa0, pa1, pa2, pa3); pv_one<1>(o[1], vb, pa0, pa1, pa2, pa3); pv_one<2>(o[2], vb, pa0, pa1, pa2, pa3); pv_one<3>(o[3], vb, pa0, pa1, pa2, pa3);
}

__device__ __forceinline__ int tile_row(bool latq, int b, int j) { return latq ? (j < 32 ? b * SEQ + 64 * j : RL + b * CTXL + 64 * (j - 32)) : RL + b * CTXL + 64 * j; }

__device__ __forceinline__ void attn_unit(const bf16_t* __restrict__ Qg, const bf16_t* __restrict__ Kg, const bf16_t* __restrict__ Vg, bf16_t* __restrict__ ATT,
                                          const float* subg, float lam, bool latq, int b, int h, int qrow0, LAS unsigned char* lds) {
  const int tid = threadIdx.x, wid = __builtin_amdgcn_readfirstlane(tid >> 6), lane = tid & 63, r32 = lane & 31, hi = lane >> 5, rg = wid >> 1, s = wid & 1;
  LAS char* V_lds = (LAS char*)lds; LAS char* K_lds = (LAS char*)lds + 2 * SHM_V;
  LAS float* ws = (LAS float*)(lds + 65536) + wid * 64; LAS float* li_l = ws; LAS float* al_l = ws + 32;
  const int NT = latq ? 36 : 4;
  float m_reg = -1e30f, l_reg = 0; f32x16 o[4] = {}; bf16x8 qr[4];
  const bf16_t* Qw = Qg + (size_t)(qrow0 + rg * 32 + r32) * D + h * 128 + s * 64 + hi * 8;
#pragma unroll
  for (int d0 = 0; d0 < 4; ++d0) qr[d0] = *reinterpret_cast<const bf16x8*>(Qw + d0 * 16);
  const int sr = tid >> 4, sc = (tid & 15) * 8, vst0 = v_st(sr, sc), vst1 = v_st(32 + sr, sc);
  const int vb0 = (int)(unsigned)(size_t)V_lds + v_rd_base(lane);
  const size_t hoff = (size_t)h * 128 + sc;
  struct { bf16x8 vs0, vs1, ks0, ks1; } sr_[2];
#define SLOAD(i, j) do { const size_t ro_ = (size_t)(tile_row(latq, b, (j)) + sr) * D + hoff; \
    sr_[i].vs0 = *reinterpret_cast<const bf16x8*>(Vg + ro_); sr_[i].vs1 = *reinterpret_cast<const bf16x8*>(Vg + ro_ + 32 * D); \
    sr_[i].ks0 = *reinterpret_cast<const bf16x8*>(Kg + ro_); sr_[i].ks1 = *reinterpret_cast<const bf16x8*>(Kg + ro_ + 32 * D); } while (0)
#define SWRITE(bb, i) do { *(LAS bf16x8*)(V_lds + (bb) * SHM_V + vst0) = sr_[i].vs0; *(LAS bf16x8*)(V_lds + (bb) * SHM_V + vst1) = sr_[i].vs1; const int kc = sc * 2; \
    *(LAS bf16x8*)(K_lds + (bb) * SHM_K + KSWZ(sr, kc)) = sr_[i].ks0; *(LAS bf16x8*)(K_lds + (bb) * SHM_K + KSWZ(32 + sr, kc)) = sr_[i].ks1; } while (0)
#define SWAIT() asm volatile("s_waitcnt vmcnt(4)" ::: "memory")
#define RESC(a_) do { if (__any((a_) < 1.f)) { if (hi == 0) al_l[r32] = (a_); asm volatile("s_waitcnt lgkmcnt(0)" ::: "memory"); \
    _Pragma("unroll") for (int d = 0; d < 4; ++d) _Pragma("unroll") for (int r = 0; r < 16; ++r) o[d][r] *= al_l[crow(r, hi)]; } } while (0)
  f32x16 pA0, pA1, pB0, pB1; float mnA, mnB, alA, alB; bf16x8 pa0, pa1, pa2, pa3;
  constexpr int SE = 0, SO = 1;
  SLOAD(SE, 0); asm volatile("s_waitcnt vmcnt(0)" ::: "memory"); SWRITE(0, SE); __syncthreads();
  qkt(pA0, pA1, K_lds, qr, r32, hi, s); partialSM(pA0, pA1, m_reg, mnA, alA);
  SLOAD(SO, 1); if (2 < NT) SLOAD(SE, 2);
  SWAIT(); SWRITE(1, SO); __syncthreads();
  for (int j = 1; j + 1 < NT; j += 2) {
    SBAR(); qkt(pB0, pB1, K_lds + SHM_K, qr, r32, hi, s);
    finishSM(pA0, pA1, alA, l_reg, pa0, pa1, pa2, pa3); SBAR();
    SLOAD(SO, j + 2); SBAR();
    pv_d0(o, vb0, pa0, pa1, pa2, pa3); partialSM(pB0, pB1, m_reg, mnB, alB);
    __syncthreads(); SWAIT(); SWRITE(0, SE);
    RESC(alB); __syncthreads();
    SBAR(); qkt(pA0, pA1, K_lds, qr, r32, hi, s);
    finishSM(pB0, pB1, alB, l_reg, pa0, pa1, pa2, pa3); SBAR();
    if (j + 3 < NT) SLOAD(SE, j + 3); SBAR();
    pv_d0(o, vb0 + SHM_V, pa0, pa1, pa2, pa3); partialSM(pA0, pA1, m_reg, mnA, alA);
    __syncthreads(); SWAIT(); SWRITE(1, SO);
    RESC(alA); __syncthreads();
  }
  SBAR(); qkt(pB0, pB1, K_lds + SHM_K, qr, r32, hi, s);
  finishSM(pA0, pA1, alA, l_reg, pa0, pa1, pa2, pa3); SBAR();
  pv_d0(o, vb0, pa0, pa1, pa2, pa3); partialSM(pB0, pB1, m_reg, mnB, alB);
  __syncthreads(); RESC(alB);
  finishSM(pB0, pB1, alB, l_reg, pa0, pa1, pa2, pa3); SBAR();
  pv_d0(o, vb0 + SHM_V, pa0, pa1, pa2, pa3);
#undef SLOAD
#undef SWRITE
#undef SWAIT
#undef RESC
  if (hi == 0) li_l[r32] = l_reg;
  asm volatile("s_waitcnt lgkmcnt(0)" ::: "memory");
  float rli[16];
#pragma unroll
  for (int r = 0; r < 16; ++r) rli[r] = __builtin_amdgcn_rcpf(li_l[crow(r, hi)]);
  __syncthreads();
  LAS float* X = (LAS float*)lds + rg * 4096;
  if (s == 1) {
#pragma unroll
    for (int r = 0; r < 16; ++r)
#pragma unroll
      for (int d0 = 0; d0 < 4; ++d0) X[crow(r, hi) * 128 + d0 * 32 + r32] = o[d0][r] * (rli[r] * lam);
  }
  __syncthreads();
  if (s == 0) {
    float rstd[16];
#pragma unroll
    for (int r = 0; r < 16; ++r) {
      float acc = 0.f;
#pragma unroll
      for (int d0 = 0; d0 < 4; ++d0) { const float v = o[d0][r] * rli[r] - X[crow(r, hi) * 128 + d0 * 32 + r32]; o[d0][r] = v; acc += v * v; }
#pragma unroll
      for (int off = 1; off < 32; off <<= 1) acc += __shfl_xor(acc, off);
      rstd[r] = 1.0f / sqrtf(acc * (1.0f / 128.0f) + EPS);
    }
    LAS bf16_t* stg = (LAS bf16_t*)(lds + 65536 + 2048) + rg * 4096;
    float gsc[4];
#pragma unroll
    for (int d0 = 0; d0 < 4; ++d0) gsc[d0] = subg[d0 * 32 + r32] * (1.0f - LAMBDA_INIT0);
#pragma unroll
    for (int r = 0; r < 16; ++r)
#pragma unroll
      for (int d0 = 0; d0 < 4; ++d0) stg[crow(r, hi) * 128 + d0 * 32 + r32] = (bf16_t)f2bf(o[d0][r] * rstd[r] * gsc[d0]);
    asm volatile("s_waitcnt lgkmcnt(0)" ::: "memory");
    bf16_t* Ow = ATT + (size_t)(qrow0 + rg * 32) * D + h * 128;
#pragma unroll
    for (int i = 0; i < 8; ++i) { const int row = i * 4 + (lane >> 4), ch = lane & 15; const u32x4v v = *(const LAS u32x4v*)(stg + row * 128 + ch * 8); *(u32x4v*)(Ow + (size_t)row * D + ch * 8) = v; }
  }
  __syncthreads();
}
#undef KSWZ
#undef SBAR
}

__device__ __forceinline__ void ph_attn_fast(const Ctx& a, LAS unsigned char* lds) {
    unsigned char* ws = a.ws();
    const bf16_t* Q = (const bf16_t*)(ws + WS_Q); const bf16_t* Kb = (const bf16_t*)(ws + WS_K); const bf16_t* V = (const bf16_t*)(ws + WS_V);
    bf16_t* ATT = (bf16_t*)(ws + WS_ATT); const float* subg = a.in(I_SUBG);
    const float lam = diff_lambda(a, threadIdx.x & 63);
    const int G = gridDim.x, c = blockIdx.x;
    for (int i = 0;; ++i) {
        const long L = (long)i * G + c; if (L >= 1024) break;
        const int w = xcd_remap(L, 1024), bh = w >> 4, qb = w & 15, b = bh >> 3, h = bh & 7;
        fa::attn_unit(Q, Kb, V, ATT, subg, lam, true, b, h, b * SEQ + qb * 128, lds);
    }
    for (int L = c; L < 128; L += G) {
        const int bh = L >> 1, qb = L & 1, b = bh >> 3, h = bh & 7;
        fa::attn_unit(Q, Kb, V, ATT, subg, lam, false, b, h, RL + b * CTXL + qb * 128, lds);
    }
#if DENSE_LATE && ANY_FAST_GEMM
    if (c >= 128 && G > 128) { for (int r = c - 128; r < IT_DENSE_REST; r += G - 128) cvt_dense_rest_item(a, r); }
#endif
#if CVT_HIDE && FP8_MOE
    if (c >= 128 && G > 128) { __syncthreads(); cvt8_run(a, 0, CV0_ATT + (c - 128), G - 128, CV0_ATT + CVQ_ATT, lds); }
#endif
}


__device__ __forceinline__ void ph_gates_fast(const Ctx& a, LAS unsigned char* lds) {
    unsigned char* ws = a.ws();
    const bf16_t* XR = (const bf16_t*)(ws + WS_XR); const bf16_t* WG = (const bf16_t*)(ws + WS_WG);
    bf16_t* LOGA = (bf16_t*)(ws + WS_LOGA); unsigned char* BT = ws + WS_BT;
    const float* convw = a.in(I_CONVW); const float* convb = a.in(I_CONVB); const float* gtab = (const float*)(ws + WS_GTAB);
    const int tid = threadIdx.x, wid = __builtin_amdgcn_readfirstlane(tid >> 6), lane = tid & 63, wr = wid >> 2, wc = wid & 3, fr = lane & 15, fq = lane >> 4;
    constexpr int HTB = pg8::HTB;
    const int aoff = pg8::lds_byte(wr * 64 + fr, fq * 8), boff = pg8::lds_byte(wc * 32 + fr, fq * 8);
    const int sc = tid & 15, rg8 = tid >> 4;
    unsigned bsrc[2];
#pragma unroll
    for (int i = 0; i < 2; ++i) { int R, C; pg8::stage_rc(tid * 16 + i * 8192, R, C); bsrc[i] = (unsigned)(((R & ~31) + pg8::perm32(R & 31)) * 128 + C) * 2u; }
    const unsigned ldsw = (unsigned)wid * 1024u;
#define GT_DMA_B(d_) do { const char* wb_ = (const char*)(WG + (size_t)((d_) * 8 + kb) * 256 * 128); \
        _Pragma("unroll") for (int kt_ = 0; kt_ < 2; ++kt_) _Pragma("unroll") for (int h_ = 0; h_ < 2; ++h_) _Pragma("unroll") for (int i_ = 0; i_ < 2; ++i_) \
            __builtin_amdgcn_global_load_lds((const unsigned*)(wb_ + (size_t)h_ * 128 * 256 + kt_ * 128 + bsrc[i_]), (LAS unsigned*)(lds + (4 + kt_ * 2 + h_) * HTB + ldsw + i_ * 8192), 16, 0, 0); } while (0)
    const int Gq = gemm_groups(72 * 8, (int)gridDim.x);
    if ((int)blockIdx.x >= Gq) { cvt8_run(a, 1, CV1_GATES + ((int)blockIdx.x - Gq), (int)gridDim.x - Gq, CV1_GATES + CVQ_GATES, lds); return; }
    for (int u = blockIdx.x; u < 72 * 8; u += Gq) {
        const int kb = u & 7, rt = u >> 3;
        const bool lat = rt < 64; const int bsm = lat ? (rt >> 3) : (rt - 64), t0 = lat ? (rt & 7) * 256 : 0, L = lat ? SEQ : CTXL;
        const int seqbase = lat ? bsm * SEQ : RL + bsm * CTXL;
        GT_DMA_B(0);
        {
            const int ch0 = kb * 128 + sc * 8, r0 = rg8 * 8;
            u32x4 xin[11];
#pragma unroll
            for (int i = 0; i < 11; ++i) { const int tt = t0 + r0 - 2 + i; xin[i] = (tt >= 0 && tt < L) ? *(const u32x4*)(XR + (size_t)(seqbase + tt) * D + ch0) : (u32x4){0u, 0u, 0u, 0u}; }
            f32x4 cw[4][2], cb[2];
#pragma unroll
            for (int j = 0; j < 4; ++j) { cw[j][0] = *(const f32x4*)(convw + j * D + ch0); cw[j][1] = *(const f32x4*)(convw + j * D + ch0 + 4); }
            cb[0] = *(const f32x4*)(convb + ch0); cb[1] = *(const f32x4*)(convb + ch0 + 4);
#pragma unroll
            for (int k = 0; k < 8; ++k) {
                f32x4 o0 = cb[0], o1 = cb[1];
#pragma unroll
                for (int j = 0; j < 4; ++j) { const u32x4 x = xin[k + j];
                    o0 += cw[j][0] * (f32x4){bf_lo(x.x), bf_hi(x.x), bf_lo(x.y), bf_hi(x.y)}; o1 += cw[j][1] * (f32x4){bf_lo(x.z), bf_hi(x.z), bf_lo(x.w), bf_hi(x.w)}; }
                const int r = r0 + k;
                u32x4 w; w.x = pk2(o0[0], o0[1]); w.y = pk2(o0[2], o0[3]); w.z = pk2(o1[0], o1[1]); w.w = pk2(o1[2], o1[3]);
                *(LAS u32x4*)(lds + ((sc >> 3) * 2 + (r >> 7)) * HTB + pg8::lds_byte(r & 127, (sc & 7) * 8)) = w;
            }
        }
#pragma unroll 1
        for (int d = 0; d < 2; ++d) {
            asm volatile("s_waitcnt vmcnt(0)" ::: "memory");
            __syncthreads();
            pf4 acc[2][2][4][2];
#pragma unroll
            for (int ai = 0; ai < 2; ++ai)
#pragma unroll
                for (int bj = 0; bj < 2; ++bj)
#pragma unroll
                    for (int m = 0; m < 4; ++m)
#pragma unroll
                        for (int n = 0; n < 2; ++n) acc[ai][bj][m][n] = (pf4){0.f, 0.f, 0.f, 0.f};
#pragma unroll 1
            for (int kt = 0; kt < 2; ++kt)
#pragma unroll
                for (int ai = 0; ai < 2; ++ai) {
                    __builtin_amdgcn_sched_barrier(0);
                    pg8::bf16x8 At[4][2];
#pragma unroll
                    for (int m = 0; m < 4; ++m)
#pragma unroll
                        for (int k = 0; k < 2; ++k) At[m][k] = *(const LAS pg8::bf16x8*)(lds + (kt * 2 + ai) * HTB + aoff + m * 2048 + k * 1024);
#pragma unroll
                    for (int bj = 0; bj < 2; ++bj) {
                        pg8::bf16x8 Bf[2][2];
#pragma unroll
                        for (int n = 0; n < 2; ++n)
#pragma unroll
                            for (int k = 0; k < 2; ++k) Bf[n][k] = *(const LAS pg8::bf16x8*)(lds + (4 + kt * 2 + bj) * HTB + boff + n * 2048 + k * 1024);
#pragma unroll
                        for (int m = 0; m < 4; ++m)
#pragma unroll
                            for (int n = 0; n < 2; ++n)
#pragma unroll
                                for (int k = 0; k < 2; ++k) acc[ai][bj][m][n] = __builtin_amdgcn_mfma_f32_16x16x32_bf16(Bf[n][k], At[m][k], acc[ai][bj][m][n], 0, 0, 0);
                        __builtin_amdgcn_sched_barrier(0);
                    }
                }
            if (d == 0) { __syncthreads(); GT_DMA_B(1); }
            const int cc0 = wc * 32 + fq * 8;
            pf4 cl[2], c2[2], brn[2], bin[2];
#pragma unroll
            for (int n = 0; n < 2; ++n) { const float* g = gtab + (size_t)(d * 4) * D + kb * 128 + cc0 + 4 * n;
                cl[n] = *(const pf4*)g; c2[n] = *(const pf4*)(g + D); brn[n] = *(const pf4*)(g + 2 * D); bin[n] = *(const pf4*)(g + 3 * D); }
#pragma unroll
            for (int ai = 0; ai < 2; ++ai)
#pragma unroll
                for (int m = 0; m < 4; ++m) {
                    const int rl = wr * 64 + m * 16 + fr;
                    const int grow = seqbase + t0 + ai * 128 + rl;
                    float la[8], bt[8];
#pragma unroll
                    for (int n = 0; n < 2; ++n) {
                        const int cc = cc0 + 4 * n;
                        const u32x2 xw = *(const LAS u32x2*)(lds + ((cc >> 6) * 2 + ai) * HTB + pg8::lds_byte(rl, cc & 63));
                        const float xv[4] = {bf_lo(xw.x), bf_hi(xw.x), bf_lo(xw.y), bf_hi(xw.y)};
#pragma unroll
                        for (int j = 0; j < 4; ++j) {
                            const float r = __builtin_amdgcn_rcpf(1.0f + __builtin_amdgcn_exp2f(fmaf(acc[ai][0][m][n][j], -1.4426950408889634f, brn[n][j])));
                            const float ig = __builtin_amdgcn_rcpf(1.0f + __builtin_amdgcn_exp2f(fmaf(acc[ai][1][m][n][j], -1.4426950408889634f, bin[n][j])));
                            const float om = 1.0f - __builtin_amdgcn_exp2f(r * c2[n][j]);
                            la[n * 4 + j] = r * cl[n][j]; bt[n * 4 + j] = __builtin_amdgcn_sqrtf(om) * (ig * xv[j]) * BT_SCALE;
                        }
                    }
                    const size_t o = ((size_t)d * RT + grow) * D + kb * 128 + cc0;
                    u32x4 w; w.x = pk2(la[0], la[1]); w.y = pk2(la[2], la[3]); w.z = pk2(la[4], la[5]); w.w = pk2(la[6], la[7]);
                    *(u32x4*)(LOGA + o) = w;
                    u32x2 wb; wb.x = pk4_fp8(bt[0], bt[1], bt[2], bt[3]); wb.y = pk4_fp8(bt[4], bt[5], bt[6], bt[7]);
                    *(u32x2*)(BT + o) = wb;
                }
        }
#if FUSE_SCAN1
        asm volatile("s_waitcnt vmcnt(0)" ::: "memory");
        __syncthreads();
        {
            const int dir = wid >> 2, lc = wid & 3, kc = (t0 >> 6) + lc;
            const int c = dir == 0 ? (lat ? NCH_CTX + kc : kc) : (lat ? NCH - 1 - kc : NCH_CTX - 1 - kc);
            const int ch = kb * 128 + 2 * lane;
            float* CP = (float*)(ws + WS_CP); float* CB = (float*)(ws + WS_CB);
            float h0 = 0.f, h1 = 0.f, p0 = 0.f, p1 = 0.f;
#pragma unroll 1
            for (int sg = 0; sg < SCH; sg += 32) {
                unsigned la[32], bt[32];
#pragma unroll
                for (int i = 0; i < 32; ++i) { const size_t o = ((size_t)dir * RT + scan_row(bsm, dir, c, sg + i)) * D + ch; la[i] = *(const unsigned*)(LOGA + o); bt[i] = *(const unsigned short*)(BT + o); }
                asm volatile("" ::: "memory");
#pragma unroll
                for (int i = 0; i < 32; ++i) { const float l0 = bf_lo(la[i]), l1 = bf_hi(la[i]); const f32x2 bb = __builtin_amdgcn_cvt_pk_f32_fp8((int)bt[i], false);
                    h0 = __builtin_amdgcn_exp2f(l0) * h0 + bb.x; h1 = __builtin_amdgcn_exp2f(l1) * h1 + bb.y; p0 += l0; p1 += l1; }
            }
            const size_t so = ((size_t)(bsm * 2 + dir) * NCH + c) * D + ch;
            *(f32x2*)(CP + so) = (f32x2){p0, p1}; *(f32x2*)(CB + so) = (f32x2){h0, h1};
        }
#endif
        __syncthreads();
    }
#undef GT_DMA_B
    if (Gq == (int)gridDim.x) cvt8_tail(a, lds, 72 * 8, Gq, (int)blockIdx.x, 1, CV1_GATES, CVQ_GATES);
}

constexpr int NPHASES = 25;
__host__ __device__ constexpr bool phase_enabled(int p) {
    return !((p == 3 && FAST_QKV) || (p == 9 && FAST_GU) || (p == 22 && FAST_GU) || (p == 13 && FAST_GATES) || (p == 15 && FAST_GATES) || (p == 16 && FAST_GATES && FUSE_SCAN1));
}

__global__ void __launch_bounds__(NTHREADS, 2) hybrid_fwd(Args args) {
    extern __shared__ __attribute__((aligned(16))) unsigned char lds_raw[];
    LAS unsigned char* lds = (LAS unsigned char*)lds_raw;
    volatile LAS unsigned* MISC = (volatile LAS unsigned*)(lds + MISC_OFF);
    const int lo = args.ph_lo, hi = args.ph_hi;
    if (threadIdx.x == 0) {
        LAS unsigned long long* la64 = (LAS unsigned long long*)(lds + ARGS_OFF);
#pragma unroll
        for (int i = 0; i < 27; ++i) la64[i] = (unsigned long long)args.in[i];
        la64[27] = (unsigned long long)args.out; la64[28] = (unsigned long long)args.ws;
    }
    Ctx ctx; ctx.la = (const LAS unsigned*)(lds + ARGS_OFF);
    if (threadIdx.x < 16) MISC[threadIdx.x] = 0u;
    __syncthreads();
#if MK_ONE_LAUNCH
    XcdBarrier bar = xcd_barrier_post((unsigned*)(ctx.ws() + WS_CTL) + CW_BAR, MISC + 8);
#define GRID_BAR() xcd_barrier(bar)
#else
#define GRID_BAR() do { } while (0)
#endif
#ifndef REP_MASK
#define REP_MASK 0u
#endif
#define RUN(k, call) do { call; if constexpr (((REP_MASK) >> (k)) & 1u) { __syncthreads(); call; } } while (0)
#define IN(k) (lo <= (k) && (k) < hi)
#define SEAM(k) do { if ((k) + 1 < hi) GRID_BAR(); } while (0)

    if (IN(0)) { RUN(0, ph_prologue(ctx, lds)); SEAM(0); }
    if (IN(1)) { RUN(1, ph_norm1_l0(ctx)); SEAM(1); }
    if (IN(2)) {
#if FAST_QKV
        RUN(2, ph_qkv_fast(ctx, lds));
#else
        RUN(2, ph_qkv_naive(ctx, lds));
#endif
        SEAM(2); }
#if !FAST_QKV
    if (IN(3)) { RUN(3, ph_rope_naive(ctx)); SEAM(3); }
#endif
    if (IN(4)) {
#if FAST_ATTN
        RUN(4, ph_attn_fast(ctx, lds));
#else
        RUN(4, ph_attn_naive(ctx, lds));
#endif
        SEAM(4); }
    if (IN(5)) {
#if FAST_WO
        RUN(5, ph_wo_fast(ctx, lds));
#else
        RUN(5, ph_wo_naive(ctx, lds));
#endif
        SEAM(5); }
    if (IN(6)) { RUN(6, ph_norm2_router(ctx, lds, 0, RT)); SEAM(6); }
    if (IN(7)) { RUN(7, ph_topk_gather(ctx, lds, 0)); SEAM(7); }
    if (IN(8)) {
#if FAST_GU
        RUN(8, ph_gu_fast(ctx, lds, 0));
#else
        RUN(8, ph_gu_naive(ctx, lds, 0));
#endif
        SEAM(8); }
#if !FAST_GU
    if (IN(9)) { RUN(9, ph_swiglu_naive(ctx, 0)); SEAM(9); }
#endif
    if (IN(10)) {
#if FAST_DN
        RUN(10, ph_dn_fast(ctx, lds, 0));
#else
        RUN(10, ph_dn_naive(ctx, lds, 0));
#endif
        SEAM(10); }
    if (IN(11)) { RUN(11, ph_combine<0>(ctx, 0, RT)); SEAM(11); }
    if (IN(12)) {
#if FAST_WIN
        RUN(12, ph_win_fast(ctx, lds));
#else
        RUN(12, ph_win_naive(ctx, lds));
#endif
        SEAM(12); }
#if !FAST_GATES
    if (IN(13)) { RUN(13, ph_conv_naive(ctx)); SEAM(13); }
#endif
    if (IN(14)) {
#if FAST_GATES
        RUN(14, ph_gates_fast(ctx, lds));
#else
        RUN(14, ph_gates_naive(ctx, lds));
#endif
        SEAM(14); }
#if !FAST_GATES
    if (IN(15)) { RUN(15, ph_gate_elem_naive(ctx)); SEAM(15); }
#endif
#if !(FUSE_SCAN1 && FAST_GATES)
    if (IN(16)) { RUN(16, ph_scan1(ctx)); SEAM(16); }
#endif
    if (IN(17)) { RUN(17, ph_scan2(ctx)); SEAM(17); }
    if (IN(18)) {
#if FAST_WOUT
        RUN(18, ph_wout_fast(ctx, lds));
#else
        RUN(18, ph_wout_naive(ctx, lds));
#endif
        SEAM(18); }
    if (IN(19)) { RUN(19, ph_norm2_router(ctx, lds, 1, RL)); SEAM(19); }
    if (IN(20)) { RUN(20, ph_topk_gather(ctx, lds, 1)); SEAM(20); }
    if (IN(21)) {
#if FAST_GU
        RUN(21, ph_gu_fast(ctx, lds, 1));
#else
        RUN(21, ph_gu_naive(ctx, lds, 1));
#endif
        SEAM(21); }
#if !FAST_GU
    if (IN(22)) { RUN(22, ph_swiglu_naive(ctx, 1)); SEAM(22); }
#endif
    if (IN(23)) {
#if FAST_DN
        RUN(23, ph_dn_fast(ctx, lds, 1));
#else
        RUN(23, ph_dn_naive(ctx, lds, 1));
#endif
        SEAM(23); }
    if (IN(24)) { RUN(24, ph_combine<1>(ctx, 1, RL)); }
#undef IN
#undef SEAM
#undef GRID_BAR
}

extern "C" void kernel_launch(void* const* d_in, const int* in_sizes, int n_in, void* d_out, int out_size, void* d_ws, size_t ws_size, hipStream_t stream) {
    static int grid = 0;
    if (grid == 0) {
        if (n_in != 27 || out_size != RL * D || ws_size < WS_END) { fprintf(stderr, "kernel_launch: unexpected shapes (n_in %d out %d ws %zu)\n", n_in, out_size, ws_size); grid = -1; return; }
        int dev = 0, cus = 0, per_cu = 0;
        if (hipGetDevice(&dev) != hipSuccess || hipDeviceGetAttribute(&cus, hipDeviceAttributeMultiprocessorCount, dev) != hipSuccess) { grid = -1; return; }
        if (hipFuncSetAttribute((const void*)hybrid_fwd, hipFuncAttributeMaxDynamicSharedMemorySize, LDS_BYTES) != hipSuccess) { fprintf(stderr, "kernel_launch: hipFuncSetAttribute failed\n"); grid = -1; return; }
        if (hipOccupancyMaxActiveBlocksPerMultiprocessor(&per_cu, (const void*)hybrid_fwd, NTHREADS, LDS_BYTES) != hipSuccess || per_cu < 1) { fprintf(stderr, "kernel_launch: occupancy query says %d\n", per_cu); }
        (void)hipGetLastError();
        grid = cus > 0 ? cus : 256;
    }
    if (grid < 0) return;
    if (hipMemsetAsync((char*)d_ws + WS_CTL, 0, CTL_ZERO_BYTES, stream) != hipSuccess) return;
    Args a{};
    for (int i = 0; i < 27; ++i) a.in[i] = (const float*)d_in[i];
    a.out = (float*)d_out; a.ws = (unsigned char*)d_ws;
#if MK_ONE_LAUNCH
    a.ph_lo = 0; a.ph_hi = NPHASES;
    hipLaunchKernelGGL(hybrid_fwd, dim3(grid), dim3(NTHREADS), LDS_BYTES, stream, a);
#else
    for (int p = 0; p < NPHASES; ++p) {
        if (!phase_enabled(p)) continue;
        a.ph_lo = p; a.ph_hi = p + 1;
        hipLaunchKernelGGL(hybrid_fwd, dim3(grid), dim3(NTHREADS), LDS_BYTES, stream, a);
    }
#endif
    const hipError_t le = hipPeekAtLastError();
    if (le != hipSuccess) fprintf(stderr, "kernel_launch: launch failed: %s\n", hipGetErrorName(le));
}
```

```cpp
#define MK_ONE_LAUNCH 1
#define FAST_QKV 1
#define FAST_WO 1
#define FAST_GU 1
#define FAST_DN 1
#define FAST_WIN 1
#define FAST_WOUT 1
#define FAST_ATTN 1
#define FAST_GATES 1
#define FP8_MOE 1
#include <hip/hip_runtime.h>
#include <cstdio>
#include <cstdint>
#include <cmath>

#ifndef MK_ONE_LAUNCH
#define MK_ONE_LAUNCH 0
#endif
#ifndef FAST_QKV
#define FAST_QKV 0
#endif
#ifndef FAST_ATTN
#define FAST_ATTN 0
#endif
#ifndef FAST_WO
#define FAST_WO 0
#endif
#ifndef FAST_GU
#define FAST_GU 0
#endif
#ifndef FAST_DN
#define FAST_DN 0
#endif
#ifndef FAST_WIN
#define FAST_WIN 0
#endif
#ifndef FAST_GATES
#define FAST_GATES 0
#endif
#ifndef FAST_WOUT
#define FAST_WOUT 0
#endif
#ifndef FP8_MOE
#define FP8_MOE 0
#endif
#ifndef GU_ALIGN
#define GU_ALIGN true
#endif
#ifndef DN_ALIGN
#define DN_ALIGN true
#endif
#ifndef FUSE_SCAN1
#define FUSE_SCAN1 1
#endif
#define ANY_FAST_GEMM (FAST_QKV || FAST_WO || FAST_GU || FAST_DN || FAST_WIN || FAST_GATES || FAST_WOUT)

namespace pg8 {
#define PG8_LAS __attribute__((address_space(3)))
typedef unsigned short bf16_t;
typedef short bf16x8 __attribute__((ext_vector_type(8)));
typedef float f32x4 __attribute__((ext_vector_type(4)));
typedef unsigned u32x4 __attribute__((ext_vector_type(4)));
constexpr int BM = 256, BK = 64, HALF = 128, HTB = HALF * BK * 2  , STAGE_BYTES = 8 * HTB, NXCD = 8, WGM = 8;

__host__ __device__ __forceinline__ int lds_byte(int r, int c) { const int st = (r >> 4) * 2 + (c >> 5), rr = r & 15, cc = c & 31, ob = rr * 64 + cc * 2; return st * 1024 + (ob ^ (((ob >> 9) & 1) << 5)); }
__host__ __device__ __forceinline__ void stage_rc(int b, int& R, int& C) { const int st = b / 1024, sb = b % 1024, swz = sb ^ (((sb >> 9) & 1) << 5); R = (st >> 1) * 16 + swz / 64; C = (st & 1) * 32 + (swz % 64) / 2; }
__host__ __device__ __forceinline__ int perm32(int rho) { const int n = rho >> 4, i = rho & 15; return 8 * (i >> 2) + 4 * n + (i & 3); }

struct Unit { int pm, pn; };
struct Gemm { const bf16_t* A; const bf16_t* Bt; int M, N, K; };
__device__ __forceinline__ unsigned cvt_pk_bf16(float lo, float hi) { unsigned r; asm volatile("v_cvt_pk_bf16_f32 %0, %1, %2" : "=v"(r) : "v"(lo), "v"(hi)); return r; }
typedef int v4i_t __attribute__((ext_vector_type(4)));
typedef int v8i_t __attribute__((ext_vector_type(8)));
__device__ __forceinline__ v8i_t cat8(bf16x8 lo, bf16x8 hi) { const v4i_t a = __builtin_bit_cast(v4i_t, lo), b = __builtin_bit_cast(v4i_t, hi); return __builtin_shufflevector(a, b, 0, 1, 2, 3, 4, 5, 6, 7); }
template <class Epi, class Sched, bool ALIGN_EPI = false, bool SP2 = false, int FP8SCALE = 0  >
__device__ __forceinline__ void gemm_phase(PG8_LAS unsigned char* lds, const Gemm g, const Sched& S, const Epi& E) {
    const int tid = threadIdx.x, wid = __builtin_amdgcn_readfirstlane(tid >> 6), lane = tid & 63, wr = wid >> 2, wc = wid & 3, fr = lane & 15, fq = lane >> 4;
    const int K = g.K, nt = K / BK;
    unsigned voffA[2], voffB[2];
#pragma unroll
    for (int i = 0; i < 2; ++i) { int R, C; stage_rc(tid * 16 + i * 8192, R, C); const int Rb = Epi::PERM ? ((R & ~31) + perm32(R & 31)) : R;
        voffA[i] = (unsigned)(R * K + C) * 2u; voffB[i] = (unsigned)(Rb * K + C) * 2u; }
    const size_t kstep = (size_t)(BK * 2);
    const size_t hstep = (size_t)HALF * K * 2;
    const size_t tstep = 2 * hstep;
    const unsigned ldsw = (unsigned)wid * 1024u;
    const int aoff = lds_byte(wr * 64 + fr, fq * 8), boff = lds_byte(wc * 32 + fr, fq * 8);
#define PG8_SA(b, h) (((b) * 2 + (h)) * HTB)
#define PG8_SB(b, h) ((4 + (b) * 2 + (h)) * HTB)
#ifndef PG8_B_AUX
#define PG8_B_AUX 0
#endif
#define PG8_STAGE(bufoff, gbase, voff) do { _Pragma("unroll") for (int _i = 0; _i < 2; ++_i) { \
        if constexpr (FP8SCALE != 0 && PG8_B_AUX != 0) { if ((bufoff) >= 4 * HTB) __builtin_amdgcn_global_load_lds((const unsigned*)((const char*)(gbase) + (voff)[_i]), (PG8_LAS unsigned*)(lds + (bufoff) + ldsw + _i * 8192), 16, 0, PG8_B_AUX); \
            else __builtin_amdgcn_global_load_lds((const unsigned*)((const char*)(gbase) + (voff)[_i]), (PG8_LAS unsigned*)(lds + (bufoff) + ldsw + _i * 8192), 16, 0, 0); } \
        else __builtin_amdgcn_global_load_lds((const unsigned*)((const char*)(gbase) + (voff)[_i]), (PG8_LAS unsigned*)(lds + (bufoff) + ldsw + _i * 8192), 16, 0, 0); } } while (0)
#define PG8_LDA(dst, b, h) do { if constexpr (FP8SCALE == 0) { _Pragma("unroll") for (int m = 0; m < 4; ++m) _Pragma("unroll") for (int k = 0; k < 2; ++k) dst[m][k] = *(const PG8_LAS bf16x8*)(lds + PG8_SA(b, h) + aoff + m * 2048 + k * 1024); } \
        else { _Pragma("unroll") for (int m = 0; m < 4; ++m) { const v4i_t lo_ = *(const PG8_LAS v4i_t*)(lds + PG8_SA(b, h) + aoff + m * 2048), hi_ = *(const PG8_LAS v4i_t*)(lds + PG8_SA(b, h) + aoff + m * 2048 + 1024); dst##8[m] = __builtin_shufflevector(lo_, hi_, 0, 1, 2, 3, 4, 5, 6, 7); } } } while (0)
#define PG8_LDB(dst, b, h) do { if constexpr (FP8SCALE == 0) { _Pragma("unroll") for (int n = 0; n < 2; ++n) _Pragma("unroll") for (int k = 0; k < 2; ++k) dst[n][k] = *(const PG8_LAS bf16x8*)(lds + PG8_SB(b, h) + boff + n * 2048 + k * 1024); } \
        else { _Pragma("unroll") for (int n = 0; n < 2; ++n) { const v4i_t lo_ = *(const PG8_LAS v4i_t*)(lds + PG8_SB(b, h) + boff + n * 2048), hi_ = *(const PG8_LAS v4i_t*)(lds + PG8_SB(b, h) + boff + n * 2048 + 1024); dst##8[n] = __builtin_shufflevector(lo_, hi_, 0, 1, 2, 3, 4, 5, 6, 7); } } } while (0)
#define PG8_MMA(ai, bj, At, Bt) do { __builtin_amdgcn_s_setprio(1); \
        if constexpr (FP8SCALE == 0) { _Pragma("unroll") for (int m = 0; m < 4; ++m) _Pragma("unroll") for (int n = 0; n < 2; ++n) _Pragma("unroll") for (int k = 0; k < 2; ++k) \
            acc[ai][bj][m][n] = __builtin_amdgcn_mfma_f32_16x16x32_bf16(Bt[n][k], At[m][k], acc[ai][bj][m][n], 0, 0, 0); } \
        else { _Pragma("unroll") for (int m = 0; m < 4; ++m) _Pragma("unroll") for (int n = 0; n < 2; ++n) \
            asm volatile("v_mfma_scale_f32_16x16x128_f8f6f4 %0, %1, %2, %0, %3, %4 op_sel_hi:[0,0,0]" : "+v"(acc[ai][bj][m][n]) : "v"(Bt##8[n]), "v"(At##8[m]), "v"(sclW), "v"(sclA)); } \
        __builtin_amdgcn_s_setprio(0); } while (0)
#define PG8_WAIT_V(n) asm volatile("s_waitcnt vmcnt(" #n ")" ::: "memory")
#define PG8_WAIT_L(n) asm volatile("s_waitcnt lgkmcnt(" #n ")" ::: "memory")
#define PG8_BAR __builtin_amdgcn_s_barrier()
#define PG8_SCHED __builtin_amdgcn_sched_barrier(0)
    Unit cur, nxt; int ui = 0;
    if (!S.next(0, cur)) return;
    f32x4 acc[2][2][4][2];
#pragma unroll
    for (int a = 0; a < 2; ++a)
#pragma unroll
        for (int b = 0; b < 2; ++b)
#pragma unroll
            for (int m = 0; m < 4; ++m)
#pragma unroll
                for (int n = 0; n < 2; ++n) acc[a][b][m][n] = (f32x4){0.f, 0.f, 0.f, 0.f};
    bf16x8 At[4][2], B0[2][2], B1[2][2]; v8i_t At8[4], B08[2], B18[2]; const int sclW = FP8SCALE * 0x01010101, sclA = 0x7f7f7f7f;
    const char* cA = (const char*)g.A + (size_t)cur.pm * tstep; const char* cB = (const char*)g.Bt + (size_t)cur.pn * tstep;
    S.a_ready(cur);
    if constexpr (SP2) {
        PG8_STAGE(PG8_SB(0, 0), cB, voffB); PG8_STAGE(PG8_SB(0, 1), cB + hstep, voffB); PG8_STAGE(PG8_SA(0, 0), cA, voffA); PG8_STAGE(PG8_SA(0, 1), cA + hstep, voffA);
        if (wr == 1) PG8_BAR;
        PG8_WAIT_V(2); PG8_BAR;
        PG8_STAGE(PG8_SB(1, 0), cB + kstep, voffB); PG8_STAGE(PG8_SA(1, 0), cA + kstep, voffA); PG8_STAGE(PG8_SB(1, 1), cB + hstep + kstep, voffB);
        PG8_WAIT_V(6); PG8_BAR;
    } else {
        PG8_STAGE(PG8_SB(0, 0), cB, voffB); PG8_STAGE(PG8_SA(0, 0), cA, voffA); PG8_STAGE(PG8_SB(0, 1), cB + hstep, voffB); PG8_STAGE(PG8_SA(0, 1), cA + hstep, voffA);
        if (wr == 1) PG8_BAR;
        PG8_WAIT_V(4); PG8_BAR;
        PG8_STAGE(PG8_SB(1, 0), cB + kstep, voffB); PG8_STAGE(PG8_SA(1, 0), cA + kstep, voffA); PG8_STAGE(PG8_SB(1, 1), cB + hstep + kstep, voffB);
        PG8_WAIT_V(6); PG8_BAR;
    }
    for (;;) {
        const bool has_next = S.next(ui + 1, nxt);
        const char* nA = has_next ? (const char*)g.A + (size_t)nxt.pm * tstep : cA; const char* nB = has_next ? (const char*)g.Bt + (size_t)nxt.pn * tstep : cB;
        for (int t = 0; t < nt; t += 2) {
            const bool last = (t == nt - 2);
            const char* a1 = cA + (size_t)(t + 1) * kstep;
            const char* a2 = last ? nA : cA + (size_t)(t + 2) * kstep; const char* b2 = last ? nB : cB + (size_t)(t + 2) * kstep;
            const char* a3 = a2 + kstep; const char* b3 = b2 + kstep;
            if (last && has_next) S.a_ready(nxt);
            if constexpr (SP2) {
            PG8_LDB(B0, 0, 0); PG8_LDB(B1, 0, 1); PG8_SCHED; PG8_LDA(At, 0, 0); PG8_STAGE(PG8_SA(1, 1), a1 + hstep, voffA);
            PG8_WAIT_V(8); PG8_WAIT_L(0); PG8_BAR; PG8_MMA(0, 0, At, B0); PG8_MMA(0, 1, At, B1); PG8_BAR; PG8_SCHED;
            PG8_LDA(At, 0, 1); PG8_STAGE(PG8_SB(0, 0), b2, voffB); PG8_STAGE(PG8_SB(0, 1), b2 + hstep, voffB); PG8_STAGE(PG8_SA(0, 0), a2, voffA);
            PG8_WAIT_V(8); PG8_WAIT_L(0); PG8_BAR; PG8_MMA(1, 0, At, B0); PG8_MMA(1, 1, At, B1); PG8_BAR; PG8_SCHED;
            PG8_LDB(B0, 1, 0); PG8_LDB(B1, 1, 1); PG8_SCHED; PG8_LDA(At, 1, 0); PG8_STAGE(PG8_SA(0, 1), a2 + hstep, voffA);
            PG8_WAIT_V(8); PG8_WAIT_L(0); PG8_BAR; PG8_MMA(0, 0, At, B0); PG8_MMA(0, 1, At, B1); PG8_BAR; PG8_SCHED;
            PG8_LDA(At, 1, 1); PG8_STAGE(PG8_SB(1, 0), b3, voffB); PG8_STAGE(PG8_SB(1, 1), b3 + hstep, voffB); PG8_STAGE(PG8_SA(1, 0), a3, voffA);
            PG8_WAIT_V(8); PG8_WAIT_L(0); PG8_BAR; PG8_MMA(1, 0, At, B0); PG8_MMA(1, 1, At, B1); PG8_BAR; PG8_SCHED;
            } else {
            PG8_LDB(B0, 0, 0); PG8_SCHED; PG8_LDA(At, 0, 0); PG8_STAGE(PG8_SA(1, 1), a1 + hstep, voffA);
            PG8_WAIT_L(8); PG8_BAR; PG8_WAIT_L(0); PG8_MMA(0, 0, At, B0); PG8_BAR; PG8_SCHED;
            PG8_LDB(B1, 0, 1); PG8_STAGE(PG8_SB(0, 0), b2, voffB);
            PG8_BAR; PG8_WAIT_L(0); PG8_MMA(0, 1, At, B1); PG8_BAR;
            PG8_LDA(At, 0, 1); PG8_STAGE(PG8_SA(0, 0), a2, voffA);
            PG8_BAR; PG8_WAIT_L(0); PG8_MMA(1, 0, At, B0); PG8_BAR; PG8_SCHED;
            PG8_STAGE(PG8_SB(0, 1), b2 + hstep, voffB);
            PG8_WAIT_V(6); PG8_BAR; PG8_MMA(1, 1, At, B1); PG8_BAR;
            PG8_LDB(B0, 1, 0); PG8_SCHED; PG8_LDA(At, 1, 0); PG8_STAGE(PG8_SA(0, 1), a2 + hstep, voffA);
            PG8_WAIT_L(8); PG8_BAR; PG8_WAIT_L(0); PG8_MMA(0, 0, At, B0); PG8_BAR; PG8_SCHED;
            PG8_LDB(B1, 1, 1); PG8_STAGE(PG8_SB(1, 0), b3, voffB);
            PG8_BAR; PG8_WAIT_L(0); PG8_MMA(0, 1, At, B1); PG8_BAR;
            PG8_LDA(At, 1, 1); PG8_STAGE(PG8_SA(1, 0), a3, voffA);
            PG8_BAR; PG8_WAIT_L(0); PG8_MMA(1, 0, At, B0); PG8_BAR; PG8_SCHED;
            PG8_STAGE(PG8_SB(1, 1), b3 + hstep, voffB);
            PG8_WAIT_V(6); PG8_BAR; PG8_MMA(1, 1, At, B1); PG8_BAR;
            }
        }
        if constexpr (ALIGN_EPI) { if (wr == 0) PG8_BAR; }
        if constexpr (FP8SCALE != 0) asm volatile("s_nop 15\n\ts_nop 15" ::: "memory");
        if constexpr (!Epi::AFTER_DRAIN) { E(acc, cur, wr, wc, fr, fq); S.done(cur); }
        if (!has_next) break;
#pragma unroll
        for (int a = 0; a < 2; ++a)
#pragma unroll
            for (int b = 0; b < 2; ++b)
#pragma unroll
                for (int m = 0; m < 4; ++m)
#pragma unroll
                    for (int n = 0; n < 2; ++n) acc[a][b][m][n] = (f32x4){0.f, 0.f, 0.f, 0.f};
        cur = nxt; cA = nA; cB = nB; ++ui;
        if constexpr (ALIGN_EPI) { if (wr == 1) PG8_BAR; }
    }
    PG8_WAIT_V(0);
    if constexpr (!ALIGN_EPI) { if (wr == 0) PG8_BAR; }
    PG8_BAR;
    if constexpr (Epi::AFTER_DRAIN) { E.fused(acc, cur, wr, wc, fr, fq, lds, wid, lane); S.done(cur); }
#undef PG8_SA
#undef PG8_SB
#undef PG8_STAGE
#undef PG8_LDA
#undef PG8_LDB
#undef PG8_MMA
#undef PG8_WAIT_V
#undef PG8_WAIT_L
#undef PG8_BAR
#undef PG8_SCHED
}
}

#define LAS __attribute__((address_space(3)))
typedef unsigned short bf16_t;
typedef float f32x4 __attribute__((ext_vector_type(4)));
typedef float f32x2 __attribute__((ext_vector_type(2)));
typedef unsigned u32x4 __attribute__((ext_vector_type(4)));
typedef unsigned u32x2 __attribute__((ext_vector_type(2)));
typedef short bf16x8 __attribute__((ext_vector_type(8)));

constexpr int NB = 8, SEQ = 2048, CTXL = 256, D = 1024;
constexpr int RL = NB * SEQ, RC = NB * CTXL, RT = RL + RC;
constexpr int NE = 16, DE = 2816, CAPL = 256, CAPC = 32;
constexpr int RPE0 = NB * CAPL + NB * CAPC, RPE1 = NB * CAPL;
constexpr int NWAVES = 8, NTHREADS = 512;
constexpr float EPS = 1e-6f;
constexpr float QSCALE = 0.125f * 1.4426950408889634f;
constexpr float LAMBDA_INIT0 = 0.2f;
constexpr int M_SH1 = 0, M_SC1 = 1024, M_G1 = 2048, M_SH2 = 3072, M_SC2 = 4096, M_G2 = 5120;
constexpr int SCH = 64, NCH = (CTXL + SEQ) / SCH, NCH_CTX = CTXL / SCH;

constexpr size_t MiB = 1u << 20;
constexpr size_t WS_CTL = 0, CTL_ZERO_BYTES = 32768;
constexpr size_t WS_GTAB = 2 * MiB + 65536;
constexpr size_t WS_MOD = 1 * MiB, WS_ROPE = 2 * MiB, WS_PROBS = 3 * MiB, WS_GATE = 5 * MiB, WS_SEL = 6 * MiB, WS_CP = 8 * MiB, WS_CB = 11 * MiB;
constexpr size_t WS_WQKV = 16 * MiB, WS_WO = 22 * MiB, WS_WIN = 24 * MiB, WS_WOUT = 28 * MiB, WS_WG = 30 * MiB;
constexpr size_t WS_XN = 32 * MiB, WS_Q = 68 * MiB, WS_K = 104 * MiB, WS_V = 140 * MiB, WS_ATT = 176 * MiB, WS_H = 212 * MiB;
constexpr size_t WS_XG = 284 * MiB, WS_Y = 356 * MiB, WS_ACT = 428 * MiB, WS_WGU = 626 * MiB, WS_WDN = 978 * MiB;
constexpr size_t WS_YG = 68 * MiB, WS_XR = 104 * MiB, WS_HS = 140 * MiB;
constexpr size_t WS_LOGA = 1154 * MiB, WS_BT = 1226 * MiB;
constexpr size_t WS_TMPF = 1298 * MiB, WS_XC = 2090 * MiB, WS_END = 2126 * MiB;
constexpr size_t WGU_LAYER = (size_t)NE * 2 * DE * D * 2, WDN_LAYER = (size_t)NE * D * DE * 2;
constexpr int CW_BAR = 4096;

constexpr int LDS_BYTES = 147456;
constexpr int MISC_OFF = 131072 + 320;

struct Args { const float* in[27]; float* out; unsigned char* ws; int ph_lo, ph_hi; };
constexpr int ROPE_LDS = 131072 + 1024;
constexpr int ARGS_OFF = 131072 + 512;
struct Ctx {
    const LAS unsigned* la;
    __device__ __forceinline__ unsigned long long ld(int i) const { const unsigned lo = __builtin_amdgcn_readfirstlane(la[2 * i]), hi = __builtin_amdgcn_readfirstlane(la[2 * i + 1]); return ((unsigned long long)hi << 32) | lo; }
    __device__ __forceinline__ const float* in(int i) const { return (const float*)(const __attribute__((address_space(1))) float*)ld(i); }
    __device__ __forceinline__ float* out() const { return (float*)(__attribute__((address_space(1))) float*)ld(27); }
    __device__ __forceinline__ unsigned char* ws() const { return (unsigned char*)(__attribute__((address_space(1))) unsigned char*)ld(28); }
};

enum { I_X = 0, I_C, I_CTX, I_CCTX, I_ADAW, I_ADAB, I_N1G, I_N2G, I_FG, I_WQKV, I_LQ1, I_LK1, I_LQ2, I_LK2, I_SUBG, I_WO, I_WIN, I_BIN, I_CONVW, I_CONVB, I_WGATES, I_BGATES, I_LAM, I_WOUT, I_WR, I_WGU, I_WDN };

__device__ __forceinline__ float bf_lo(unsigned w) { return __uint_as_float(w << 16); }
__device__ __forceinline__ float bf_hi(unsigned w) { return __uint_as_float(w & 0xffff0000u); }
__device__ __forceinline__ float bf2f(bf16_t b) { return __uint_as_float(((unsigned)b) << 16); }
__device__ __forceinline__ unsigned f2bf(float f) { unsigned u = __float_as_uint(f); return (u + 0x7fffu + ((u >> 16) & 1u)) >> 16; }
__device__ __forceinline__ unsigned pk2(float lo, float hi) { unsigned r; asm("v_cvt_pk_bf16_f32 %0, %1, %2" : "=v"(r) : "v"(lo), "v"(hi)); return r; }
#ifndef EPI_WT
#define EPI_WT 0
#endif
__device__ __forceinline__ void st16_wt(void* p, u32x4 v) {
#if EPI_WT
    asm volatile("global_store_dwordx4 %0, %1, off sc1" :: "v"(p), "v"(v) : "memory");
#else
    *(u32x4*)p = v;
#endif
}
__device__ __forceinline__ void st8_wt(void* p, u32x2 v) {
#if EPI_WT
    asm volatile("global_store_dwordx2 %0, %1, off sc1" :: "v"(p), "v"(v) : "memory");
#else
    *(u32x2*)p = v;
#endif
}
#define DPPF(v, ctrl) __int_as_float(__builtin_amdgcn_update_dpp(0, __float_as_int(v), ctrl, 0xF, 0xF, true))
__device__ __forceinline__ float wave_sum(float v) {
    v += DPPF(v, 0xB1); v += DPPF(v, 0x4E); v += DPPF(v, 0x141); v += DPPF(v, 0x140);
    const float s0 = __int_as_float(__builtin_amdgcn_readlane(__float_as_int(v), 0)), s1 = __int_as_float(__builtin_amdgcn_readlane(__float_as_int(v), 16));
    const float s2 = __int_as_float(__builtin_amdgcn_readlane(__float_as_int(v), 32)), s3 = __int_as_float(__builtin_amdgcn_readlane(__float_as_int(v), 48));
    return (s0 + s1) + (s2 + s3);
}
__device__ __forceinline__ float wave_max(float v) {
    v = fmaxf(v, DPPF(v, 0xB1)); v = fmaxf(v, DPPF(v, 0x4E)); v = fmaxf(v, DPPF(v, 0x141)); v = fmaxf(v, DPPF(v, 0x140));
    const float s0 = __int_as_float(__builtin_amdgcn_readlane(__float_as_int(v), 0)), s1 = __int_as_float(__builtin_amdgcn_readlane(__float_as_int(v), 16));
    const float s2 = __int_as_float(__builtin_amdgcn_readlane(__float_as_int(v), 32)), s3 = __int_as_float(__builtin_amdgcn_readlane(__float_as_int(v), 48));
    return fmaxf(fmaxf(s0, s1), fmaxf(s2, s3));
}
__device__ __forceinline__ float sigmoidf_(float x) { return 1.f / (1.f + expf(-x)); }
__device__ __forceinline__ float gelu_tanh(float x) { const float u = 0.7978845608028654f * (x + 0.044715f * x * x * x); return x / (1.f + expf(-2.f * u)); }
__device__ __forceinline__ const float* mod_ptr(const Ctx& a, int layer, int r) { return (const float*)(a.ws() + WS_MOD) + (size_t)(layer * 9 + r) * 6144; }
__device__ __forceinline__ int mod_row(int row) { return row < RL ? (row >> 11) : 8; }

__device__ __forceinline__ void load_row(const float* p, int lane, f32x4 (&v)[4]) {
#pragma unroll
    for (int j = 0; j < 4; ++j) v[j] = *(const f32x4*)(p + 4 * lane + 256 * j);
}
__device__ __forceinline__ void load_row_bf16(const bf16_t* p, int lane, f32x4 (&v)[4]) {
#pragma unroll
    for (int j = 0; j < 4; ++j) { const u32x2 w = *(const u32x2*)(p + 4 * lane + 256 * j); v[j] = (f32x4){bf_lo(w.x), bf_hi(w.x), bf_lo(w.y), bf_hi(w.y)}; }
}
__device__ __forceinline__ void store_row_f32(float* p, int lane, const f32x4 (&v)[4]) {
#pragma unroll
    for (int j = 0; j < 4; ++j) *(f32x4*)(p + 4 * lane + 256 * j) = v[j];
}
__device__ __forceinline__ void store_row_bf16(bf16_t* p, int lane, const f32x4 (&v)[4]) {
#pragma unroll
    for (int j = 0; j < 4; ++j) { u32x2 w; w.x = pk2(v[j].x, v[j].y); w.y = pk2(v[j].z, v[j].w); *(u32x2*)(p + 4 * lane + 256 * j) = w; }
}
__device__ __forceinline__ void store_row_fp8(unsigned char* p, int lane, const f32x4 (&v)[4]) {
#pragma unroll
    for (int j = 0; j < 4; ++j) *(unsigned*)(p + 4 * lane + 256 * j) = __builtin_amdgcn_cvt_pk_fp8_f32(v[j].z, v[j].w, __builtin_amdgcn_cvt_pk_fp8_f32(v[j].x, v[j].y, 0u, false), true);
}
__device__ __forceinline__ void rms_mod(f32x4 (&v)[4], const float* g, const float* sh, const float* sc, int lane) {
    float ss = 0.f;
#pragma unroll
    for (int j = 0; j < 4; ++j) ss += (v[j].x * v[j].x + v[j].y * v[j].y) + (v[j].z * v[j].z + v[j].w * v[j].w);
    ss = wave_sum(ss);
    const float rstd = 1.0f / sqrtf(ss * (1.0f / D) + EPS);
#pragma unroll
    for (int j = 0; j < 4; ++j) {
        const int k = 4 * lane + 256 * j;
        const f32x4 gg = *(const f32x4*)(g + k);
        f32x4 y = v[j] * rstd * gg;
        if (sh) { const f32x4 s1 = *(const f32x4*)(sc + k), s0 = *(const f32x4*)(sh + k); y = y * (1.0f + s1) + s0; }
        v[j] = y;
    }
}

template <class F>
__device__ __forceinline__ void naive_tile(const bf16_t* A, int lda, const float* W, int ldw, int K, LAS unsigned char* lds, F f) {
    LAS float* As = (LAS float*)lds;
    LAS float* Bs = (LAS float*)(lds + 16 * 132 * 4);
    const int tid = threadIdx.x, ty = tid >> 4, tx = tid & 15;
    const int ar = tid >> 2, akq = tid & 3, bk = tid >> 5, bc = (tid & 31) * 2;
    float acc[4][4];
#pragma unroll
    for (int i = 0; i < 4; ++i)
#pragma unroll
        for (int j = 0; j < 4; ++j) acc[i][j] = 0.f;
    for (int k0 = 0; k0 < K; k0 += 16) {
        const u32x2 av = *(const u32x2*)(A + (size_t)ar * lda + k0 + akq * 4);
        const f32x2 bv = *(const f32x2*)(W + (size_t)(k0 + bk) * ldw + bc);
        __syncthreads();
        As[(akq * 4 + 0) * 132 + ar] = bf_lo(av.x); As[(akq * 4 + 1) * 132 + ar] = bf_hi(av.x);
        As[(akq * 4 + 2) * 132 + ar] = bf_lo(av.y); As[(akq * 4 + 3) * 132 + ar] = bf_hi(av.y);
        Bs[bk * 64 + bc] = bv.x; Bs[bk * 64 + bc + 1] = bv.y;
        __syncthreads();
#pragma unroll
        for (int kk = 0; kk < 16; ++kk) {
            const f32x4 a4 = *(const LAS f32x4*)(As + kk * 132 + ty * 4);
            const f32x4 b4 = *(const LAS f32x4*)(Bs + kk * 64 + tx * 4);
#pragma unroll
            for (int i = 0; i < 4; ++i)
#pragma unroll
                for (int j = 0; j < 4; ++j) acc[i][j] += a4[i] * b4[j];
        }
    }
#pragma unroll
    for (int i = 0; i < 4; ++i)
#pragma unroll
        for (int j = 0; j < 4; ++j) f(ty * 4 + i, tx * 4 + j, acc[i][j]);
    __syncthreads();
}

__device__ __forceinline__ void cvt_item(const float* W, int N, int k0, int n0, bf16_t* dst, int Kd, int gu_perm) {
    const int tid = threadIdx.x, lane = tid & 63, wave = tid >> 6;
    const float* p = W + (size_t)(k0 + 8 * wave) * N + n0 + 4 * lane;
    f32x4 v[8];
#pragma unroll
    for (int i = 0; i < 8; ++i) v[i] = *(const f32x4*)(p + (size_t)i * N);
#pragma unroll
    for (int j = 0; j < 4; ++j) {
        const int n = n0 + 4 * lane + j;
        const int row = gu_perm ? (((n % DE) >> 7) * 256 + (n / DE) * 128 + (n & 127)) : n;
        u32x4 o; o.x = pk2(v[0][j], v[1][j]); o.y = pk2(v[2][j], v[3][j]); o.z = pk2(v[4][j], v[5][j]); o.w = pk2(v[6][j], v[7][j]);
        *(u32x4*)(dst + (size_t)row * Kd + k0 + 8 * wave) = o;
    }
}
__device__ __forceinline__ unsigned pk4_fp8(float a, float b, float c, float d) { unsigned w = __builtin_amdgcn_cvt_pk_fp8_f32(a, b, 0u, false); return __builtin_amdgcn_cvt_pk_fp8_f32(c, d, w, true); }
constexpr float BT_SCALE = 64.0f, Y_SCALE = 16.0f;
constexpr float WGU_SCALE = 32.0f, WDN_SCALE = 64.0f;
__device__ __forceinline__ void cvt8_load(const float* W, int N, int k0, int n0, f32x4 (&v)[16]) {
    const int tid = threadIdx.x, lane = tid & 63, wave = tid >> 6;
    const float* p = W + (size_t)(k0 + 16 * wave) * N + n0 + 4 * lane;
#pragma unroll
    for (int i = 0; i < 16; ++i) v[i] = __builtin_nontemporal_load((const f32x4*)(p + (size_t)i * N));
}
__device__ __forceinline__ void cvt8_store(const f32x4 (&v)[16], int k0, int n0, unsigned char* dst, int Kd, int gu_perm, float scale, LAS unsigned char* T) {
    const int tid = threadIdx.x, lane = tid & 63, wave = tid >> 6;
#pragma unroll
    for (int j = 0; j < 4; ++j) {
        const int n = 4 * lane + j;
        u32x4 o;
        o.x = pk4_fp8(v[0][j] * scale, v[1][j] * scale, v[2][j] * scale, v[3][j] * scale); o.y = pk4_fp8(v[4][j] * scale, v[5][j] * scale, v[6][j] * scale, v[7][j] * scale);
        o.z = pk4_fp8(v[8][j] * scale, v[9][j] * scale, v[10][j] * scale, v[11][j] * scale); o.w = pk4_fp8(v[12][j] * scale, v[13][j] * scale, v[14][j] * scale, v[15][j] * scale);
        *(LAS u32x4*)(T + n * 128 + ((wave ^ (lane & 7)) << 4)) = o;
    }
    asm volatile("s_waitcnt lgkmcnt(0)" ::: "memory"); __builtin_amdgcn_s_barrier(); asm volatile("" ::: "memory");
#pragma unroll
    for (int i = 0; i < 4; ++i) {
        const int p = tid + NTHREADS * i, n = p >> 3, c = p & 7;
        const u32x4 x = *(const LAS u32x4*)(T + n * 128 + ((c ^ ((n >> 2) & 7)) << 4));
        const int ng = n0 + n;
        const int row = gu_perm ? (((ng % DE) >> 7) * 256 + (ng / DE) * 128 + (ng & 127)) : ng;
        __builtin_nontemporal_store(x, (u32x4*)(dst + (size_t)row * Kd + k0 + 16 * c));
    }
}
constexpr int CV_GU = NE * 8 * 22, CV_DN = NE * 22 * 4, CV_ITEMS = CV_GU + CV_DN;
struct CvItem { const float* W; unsigned char* dst; int N, Kd, k0, n0, perm; float scale; };
__device__ __forceinline__ CvItem cv_decode(const float* wgu, const float* wdn, unsigned char* ws, int layer, int it) {
    CvItem c;
    if (it < CV_GU) { const int e = it / 176, q = it % 176, le = layer * NE + e; c.W = wgu + (size_t)le * D * 2 * DE; c.dst = ws + WS_WGU + (size_t)le * 2 * DE * D; c.N = 2 * DE; c.Kd = D; c.k0 = (q / 22) * 128; c.n0 = (q % 22) * 256; c.perm = 1; c.scale = WGU_SCALE; }
    else { const int r = it - CV_GU, e = r / 88, q = r % 88, le = layer * NE + e; c.W = wdn + (size_t)le * DE * D; c.dst = ws + WS_WDN + (size_t)le * D * DE; c.N = D; c.Kd = DE; c.k0 = (q / 4) * 128; c.n0 = (q % 4) * 256; c.perm = 0; c.scale = WDN_SCALE; }
    return c;
}
__device__ __forceinline__ void cvt8_run(const Ctx& a, int layer, int first, int stride, int end, LAS unsigned char* lds) {
    const float* wgu = a.in(I_WGU); const float* wdn = a.in(I_WDN); unsigned char* ws = a.ws();
    f32x4 va[16], vb[16];
    int it = first;
    if (it < end) { const CvItem c = cv_decode(wgu, wdn, ws, layer, it); cvt8_load(c.W, c.N, c.k0, c.n0, va); }
    while (it < end) {
        int nx = it + stride;
        if (nx < end) { const CvItem c = cv_decode(wgu, wdn, ws, layer, nx); cvt8_load(c.W, c.N, c.k0, c.n0, vb); }
        { const CvItem c = cv_decode(wgu, wdn, ws, layer, it); cvt8_store(va, c.k0, c.n0, c.dst, c.Kd, c.perm, c.scale, lds); }
        it = nx; if (it >= end) break;
        nx = it + stride;
        if (nx < end) { const CvItem c = cv_decode(wgu, wdn, ws, layer, nx); cvt8_load(c.W, c.N, c.k0, c.n0, va); }
        { const CvItem c = cv_decode(wgu, wdn, ws, layer, it); cvt8_store(vb, c.k0, c.n0, c.dst, c.Kd, c.perm, c.scale, lds + 32768); }
        it = nx;
    }
    __syncthreads();
}
#ifndef CVT_HIDE
#define CVT_HIDE 1
#endif
#ifndef CVT_DEDICATED
#define CVT_DEDICATED 0
#endif
#ifndef CVQ_QKV
#define CVQ_QKV 1280
#endif
#ifndef CVQ_WO
#define CVQ_WO 896
#endif
#ifndef CVQ_GU0
#define CVQ_GU0 480
#endif
#ifndef CVQ_DN0
#define CVQ_DN0 960
#endif
#ifndef CVQ_WIN
#define CVQ_WIN 896
#endif
#ifndef CVQ_GATES
#define CVQ_GATES 1120
#endif
#ifndef CVQ_ATT
#define CVQ_ATT 256
#endif
#ifndef CVQ_TK1
#define CVQ_TK1 512
#endif
#ifndef CVQ_TK0
#define CVQ_TK0 0
#endif
constexpr int CV0_QKV = 0, CV0_WO = CV0_QKV + CVQ_QKV, CV0_ATT = CV0_WO + CVQ_WO, CV0_TK = CV0_ATT + CVQ_ATT, CV0_PRO = CVT_HIDE ? CV0_TK + CVQ_TK0 : 0;
constexpr int CV1_GU0 = 0, CV1_DN0 = CV1_GU0 + CVQ_GU0, CV1_WIN = CV1_DN0 + CVQ_DN0, CV1_GATES = CV1_WIN + CVQ_WIN, CV1_TK = CV1_GATES + CVQ_GATES, CV1_PRO = CVT_HIDE ? CV1_TK + CVQ_TK1 : 0;
static_assert(CV0_PRO <= CV_ITEMS && CV1_PRO <= CV_ITEMS, "conversion schedule");
__device__ __forceinline__ void cvt8_tail(const Ctx& a, LAS unsigned char* lds, int units, int G, int c, int layer, int base, int count) {
#if CVT_HIDE && FP8_MOE
    const int R = (units + G - 1) / G, first_idle = units - (R - 1) * G;
    if (first_idle >= G || count <= 0 || c < first_idle) return;
    cvt8_run(a, layer, base + (c - first_idle), G - first_idle, base + count, lds);
#endif
}
__device__ __forceinline__ int gemm_groups(int units, int G) {
#if CVT_HIDE && FP8_MOE && CVT_DEDICATED
    const int R = (units + G - 1) / G; int gp = ((units + R - 1) / R + 7) & ~7;
    return gp < G ? gp : G;
#else
    return G;
#endif
}
#ifndef DENSE_LATE
#define DENSE_LATE 1
#endif
constexpr int IT_DENSE_REST = 16 * 4 + 16 * 8 + 16 * 4 + 32;
__device__ __forceinline__ void cvt_dense_rest_item(const Ctx& a, int r) {
    constexpr int IT_WO = 16 * 4, IT_WIN = 16 * 8, IT_WOUT = 16 * 4;
    if (r < IT_WO) { cvt_item(a.in(I_WO), D, (r / 4) * 64, (r % 4) * 256, (bf16_t*)(a.ws() + WS_WO), D, 0); return; }
    r -= IT_WO;
    if (r < IT_WIN) { cvt_item(a.in(I_WIN), 2 * D, (r / 8) * 64, (r % 8) * 256, (bf16_t*)(a.ws() + WS_WIN), D, 0); return; }
    r -= IT_WIN;
    if (r < IT_WOUT) { cvt_item(a.in(I_WOUT), D, (r / 4) * 64, (r % 4) * 256, (bf16_t*)(a.ws() + WS_WOUT), D, 0); return; }
    r -= IT_WOUT;
    { const int m = r >> 1, kk = r & 1;
        cvt_item(a.in(I_WGATES) + (size_t)m * 128 * 256, 256, kk * 64, 0, (bf16_t*)(a.ws() + WS_WG) + (size_t)m * 256 * 128, 128, 0); }
}
__device__ __forceinline__ void ph_prologue(const Ctx& a, LAS unsigned char* lds) {
    const int tid = threadIdx.x, lane = tid & 63, wave = tid >> 6;
    if (blockIdx.x == gridDim.x - 1) {
        float* rope = (float*)(a.ws() + WS_ROPE);
        for (int i = tid; i < 1024; i += NTHREADS) { const int pos = i >> 4, f = i & 15; const float inv = powf(10000.0f, -(float)f / 16.0f); const float ang = (float)pos * inv; rope[i] = cosf(ang); rope[1024 + i] = sinf(ang); }
    }
    if (blockIdx.x == gridDim.x - 2 || gridDim.x == 1) {
        float* gt = (float*)(a.ws() + WS_GTAB); const float* lamp = a.in(I_LAM); const float* bgp = a.in(I_BGATES);
        for (int i = tid; i < 2 * D; i += NTHREADS) {
            const int d = i >> 10, ch = i & 1023, kb = ch >> 7, cc = ch & 127;
            const float cl = -8.0f * log1pf(expf(-lamp[i]));
            gt[(d * 4 + 0) * D + ch] = cl * 1.4426950408889634f; gt[(d * 4 + 1) * D + ch] = 2.0f * cl * 1.4426950408889634f;
            gt[(d * 4 + 2) * D + ch] = -1.4426950408889634f * bgp[(d * 8 + kb) * 256 + cc]; gt[(d * 4 + 3) * D + ch] = -1.4426950408889634f * bgp[(d * 8 + kb) * 256 + 128 + cc];
        }
    }
    for (int u = blockIdx.x; u < 256; u += gridDim.x) {
        LAS float* sl = (LAS float*)lds;
        LAS float* red = (LAS float*)(lds + 49152);
        const int layer = u >> 7, n0 = (u & 127) * 48;
        { const float* cin = a.in(I_C); const float* cctx = a.in(I_CCTX);
          for (int i = tid; i < 9 * 1024; i += NTHREADS) { const int r = i >> 10, k = i & 1023; const float v = r < 8 ? cin[r * 1024 + k] : cctx[k]; sl[k * 12 + r] = v / (1.f + expf(-v)); } }
        __syncthreads();
        const int kk = lane / 12, c4 = lane % 12; const bool act = lane < 60;
        const float* W = a.in(I_ADAW) + (size_t)layer * 1024 * 6144 + n0 + 4 * c4;
        f32x4 acc[9];
#pragma unroll
        for (int r = 0; r < 9; ++r) acc[r] = (f32x4){0.f, 0.f, 0.f, 0.f};
#pragma unroll 1
        for (int half = 0; half < 2; ++half) {
            f32x4 wv[13];
#pragma unroll
            for (int i = 0; i < 13; ++i) { const int ko = 5 * (half * 13 + i) + kk; wv[i] = (act && ko < 128) ? __builtin_nontemporal_load((const f32x4*)(W + (size_t)(wave * 128 + ko) * 6144)) : (f32x4){0.f, 0.f, 0.f, 0.f}; }
#pragma unroll
            for (int i = 0; i < 13; ++i) { const int ko = 5 * (half * 13 + i) + kk; const int k = wave * 128 + (ko < 128 ? ko : 0);
                const f32x4 s0 = *(const LAS f32x4*)(sl + k * 12), s1 = *(const LAS f32x4*)(sl + k * 12 + 4); const float s8 = sl[k * 12 + 8];
                acc[0] += wv[i] * s0.x; acc[1] += wv[i] * s0.y; acc[2] += wv[i] * s0.z; acc[3] += wv[i] * s0.w;
                acc[4] += wv[i] * s1.x; acc[5] += wv[i] * s1.y; acc[6] += wv[i] * s1.z; acc[7] += wv[i] * s1.w; acc[8] += wv[i] * s8; }
        }
        { LAS f32x4* rp = (LAS f32x4*)(red + (size_t)(wave * 64 + lane) * 36);
#pragma unroll
          for (int r = 0; r < 9; ++r) rp[r] = acc[r]; }
        __syncthreads();
        float* MOD = (float*)(a.ws() + WS_MOD); const float* adab = a.in(I_ADAB);
        for (int i = tid; i < 9 * 48; i += NTHREADS) {
            const int r = i / 48, col = i % 48, q = col >> 2, j = col & 3; float sacc = 0.f;
#pragma unroll
            for (int w = 0; w < 8; ++w)
#pragma unroll
                for (int g = 0; g < 5; ++g) sacc += red[(size_t)(w * 64 + g * 12 + q) * 36 + r * 4 + j];
            MOD[(size_t)(layer * 9 + r) * 6144 + n0 + col] = sacc + adab[layer * 6144 + n0 + col];
        }
        __syncthreads();
    }
#if ANY_FAST_GEMM
    constexpr int IT_QKV = 16 * 12, IT_WO = 16 * 4, IT_WIN = 16 * 8, IT_WOUT = 16 * 4, IT_G = 32;
#if FP8_MOE
    cvt8_run(a, 0, CV0_PRO + (int)blockIdx.x, (int)gridDim.x, CV_ITEMS, lds);
    cvt8_run(a, 1, CV1_PRO + (int)blockIdx.x, (int)gridDim.x, CV_ITEMS, lds);
    constexpr int IT_GU = 0, IT_DN = 0;
#else
    constexpr int IT_GU1 = 16 * 22, IT_DN1 = 44 * 4;
    constexpr int IT_GU = 32 * IT_GU1, IT_DN = 32 * IT_DN1;
#endif
    constexpr int NITEMS = IT_GU + IT_DN + IT_QKV + ((DENSE_LATE && FAST_ATTN) ? 0 : IT_DENSE_REST);
    for (int it = blockIdx.x; it < NITEMS; it += gridDim.x) {
        int r = it;
#if !FP8_MOE
        if (r < IT_GU) { const int le = r / IT_GU1, q = r % IT_GU1;
            cvt_item(a.in(I_WGU) + (size_t)le * D * 2 * DE, 2 * DE, (q / 22) * 64, (q % 22) * 256, (bf16_t*)(a.ws() + WS_WGU) + (size_t)le * 2 * DE * D, D, 1); continue; }
        r -= IT_GU;
        if (r < IT_DN) { const int le = r / IT_DN1, q = r % IT_DN1;
            cvt_item(a.in(I_WDN) + (size_t)le * DE * D, D, (q / 4) * 64, (q % 4) * 256, (bf16_t*)(a.ws() + WS_WDN) + (size_t)le * D * DE, DE, 0); continue; }
#endif
        r -= IT_DN;
        if (r < IT_QKV) { cvt_item(a.in(I_WQKV), 3 * D, (r / 12) * 64, (r % 12) * 256, (bf16_t*)(a.ws() + WS_WQKV), D, 0); continue; }
        r -= IT_QKV;
#if !(DENSE_LATE && FAST_ATTN)
        cvt_dense_rest_item(a, r);
#endif
    }
#endif
}

__device__ __forceinline__ void ph_norm1_l0(const Ctx& a) {
    const int lane = threadIdx.x & 63, gw = blockIdx.x * NWAVES + (threadIdx.x >> 6), NGW = gridDim.x * NWAVES;
    unsigned char* ws = a.ws();
    bf16_t* XN = (bf16_t*)(ws + WS_XN); const float* X = a.in(I_X); const float* CX = a.in(I_CTX); const float* n1g = a.in(I_N1G);
    f32x4 v[4], nx[4];
    int row = gw;
    if (row < RT) load_row(row < RL ? X + (size_t)row * D : CX + (size_t)(row - RL) * D, lane, v);
    for (; row < RT; row += NGW) {
        const int rn = row + NGW;
        if (rn < RT) load_row(rn < RL ? X + (size_t)rn * D : CX + (size_t)(rn - RL) * D, lane, nx);
        const float* mp = (const float*)(ws + WS_MOD) + (size_t)mod_row(row) * 6144;
        rms_mod(v, n1g, mp + M_SH1, mp + M_SC1, lane);
        store_row_bf16(XN + (size_t)row * D, lane, v);
#pragma unroll
        for (int j = 0; j < 4; ++j) v[j] = nx[j];
    }
}
__device__ __forceinline__ float rs16(float (&s)[16], int lane) {
    float r8[8], r4[4], r2[2];
    const bool b3 = lane & 8, b2 = lane & 4;
#pragma unroll
    for (int i = 0; i < 8; ++i) { const auto rr = __builtin_amdgcn_permlane32_swap(__float_as_uint(s[i]), __float_as_uint(s[i + 8]), false, false); r8[i] = __uint_as_float(rr[0]) + __uint_as_float(rr[1]); }
#pragma unroll
    for (int i = 0; i < 4; ++i) { const auto rr = __builtin_amdgcn_permlane16_swap(__float_as_uint(r8[i]), __float_as_uint(r8[i + 4]), false, false); r4[i] = __uint_as_float(rr[0]) + __uint_as_float(rr[1]); }
#pragma unroll
    for (int i = 0; i < 2; ++i) { const float send = b3 ? r4[i] : r4[i + 2], keep = b3 ? r4[i + 2] : r4[i]; r2[i] = keep + DPPF(send, 0x128); }
    float r = (b2 ? r2[1] : r2[0]) + DPPF(b2 ? r2[0] : r2[1], 0x141);
    r += DPPF(r, 0xB1); r += DPPF(r, 0x4E);
    return r;
}
__device__ __forceinline__ void ph_norm2_router(const Ctx& a, LAS unsigned char* lds, int layer, int nrows) {
    const int tid = threadIdx.x, lane = tid & 63, gw = blockIdx.x * NWAVES + (tid >> 6), NGW = gridDim.x * NWAVES;
    LAS float* wrT = (LAS float*)lds;
    const float* wr = a.in(I_WR) + (size_t)layer * D * NE;
    for (int i = tid; i < D * NE; i += NTHREADS) wrT[(i & 15) * 1024 + (i >> 4)] = wr[i];
    __syncthreads();
    unsigned char* ws = a.ws();
    bf16_t* XN = (bf16_t*)(ws + WS_XN); const bf16_t* H = (const bf16_t*)(ws + WS_H);
    float* PL = (float*)(ws + WS_PROBS); float* PC = PL + NB * NE * SEQ;
    const float* n2g = a.in(I_N2G) + layer * D;
    const int elane = ((lane >> 5) & 1) * 8 + ((lane >> 4) & 1) * 4 + ((lane >> 3) & 1) * 2 + ((lane >> 2) & 1);
    f32x4 v0[4], v1[4], n0[4], n1[4];
    int p = gw;
    if (p < nrows / 2) { load_row_bf16(H + (size_t)(2 * p) * D, lane, v0); load_row_bf16(H + (size_t)(2 * p + 1) * D, lane, v1); }
    for (; p < nrows / 2; p += NGW) {
        const int pn = p + NGW;
        if (pn < nrows / 2) { load_row_bf16(H + (size_t)(2 * pn) * D, lane, n0); load_row_bf16(H + (size_t)(2 * pn + 1) * D, lane, n1); }
        const int row = 2 * p;
        const float* mp = (const float*)(ws + WS_MOD) + (size_t)(layer * 9 + mod_row(row)) * 6144;
        rms_mod(v0, n2g, mp + M_SH2, mp + M_SC2, lane); rms_mod(v1, n2g, mp + M_SH2, mp + M_SC2, lane);
#if FP8_MOE
        store_row_fp8((unsigned char*)XN + (size_t)row * D, lane, v0); store_row_fp8((unsigned char*)XN + (size_t)(row + 1) * D, lane, v1);
#else
        store_row_bf16(XN + (size_t)row * D, lane, v0); store_row_bf16(XN + (size_t)(row + 1) * D, lane, v1);
#endif
        float s0[16], s1[16];
#pragma unroll
        for (int e = 0; e < 16; ++e) {
            float a0 = 0.f, a1 = 0.f;
#pragma unroll
            for (int j = 0; j < 4; ++j) { const f32x4 w = *(const LAS f32x4*)(wrT + e * 1024 + 4 * lane + 256 * j);
                a0 += (v0[j].x * w.x + v0[j].y * w.y) + (v0[j].z * w.z + v0[j].w * w.w); a1 += (v1[j].x * w.x + v1[j].y * w.y) + (v1[j].z * w.z + v1[j].w * w.w); }
            s0[e] = a0; s1[e] = a1;
            if ((e & 3) == 3) asm volatile("" ::: "memory");
        }
        const float l0 = rs16(s0, lane), l1 = rs16(s1, lane);
        const float m0 = wave_max(l0), m1 = wave_max(l1);
        const float e0 = expf(l0 - m0), e1 = expf(l1 - m1);
        const float q0 = e0 / (wave_sum(e0) * 0.25f), q1 = e1 / (wave_sum(e1) * 0.25f);
        if ((lane & 3) == 0) {
            if (row < RL) { float* d = PL + ((size_t)(row >> 11) * NE + elane) * SEQ + (row & 2047); *(f32x2*)d = (f32x2){q0, q1}; }
            else { const int rc = row - RL; float* d = PC + ((size_t)(rc >> 8) * NE + elane) * CTXL + (rc & 255); *(f32x2*)d = (f32x2){q0, q1}; }
        }
#pragma unroll
        for (int j = 0; j < 4; ++j) { v0[j] = n0[j]; v1[j] = n1[j]; }
    }
    __syncthreads();
}
__device__ __forceinline__ void ph_topk_gather(const Ctx& a, LAS unsigned char* lds, int layer) {
    const int tid = threadIdx.x, lane = tid & 63, wave = tid >> 6;
    LAS int* idxl = (LAS int*)lds;
    LAS int* cnt = (LAS int*)(lds + 1024);
    unsigned char* ws = a.ws();
    const float* PL = (const float*)(ws + WS_PROBS); const float* PC = PL + NB * NE * SEQ;
    float* GATE = (float*)(ws + WS_GATE); int* SEL = (int*)(ws + WS_SEL);
    const bf16_t* XN = (const bf16_t*)(ws + WS_XN); bf16_t* XG = (bf16_t*)(ws + WS_XG);
    const int nunits = layer == 0 ? 256 : 128, rpe = layer == 0 ? RPE0 : RPE1;
    const unsigned long long lt = (1ull << lane) - 1ull;
    for (int u0 = blockIdx.x; u0 < nunits; u0 += gridDim.x) {
        const int u = layer == 0 ? ((u0 & 1) * 128 + (u0 >> 1)) : u0;
        const bool lat = u < 128; const int b = (u & 127) >> 4, e = u & 15;
        const int n = lat ? SEQ : CTXL, cap = lat ? CAPL : CAPC;
        const float* src = lat ? PL + ((size_t)b * NE + e) * SEQ : PC + ((size_t)b * NE + e) * CTXL;
        const int rowbase = lat ? b * SEQ : RL + b * CTXL;
        const int xgbase = e * rpe + (lat ? b * CAPL : NB * CAPL + b * CAPC);
        unsigned v[4];
#pragma unroll
        for (int i = 0; i < 4; ++i) { const int t = wave * 256 + i * 64 + lane; v[i] = t < n ? __float_as_uint(src[t]) : 0u; }
        unsigned prefix = 0u;
#pragma unroll 1
        for (int bit = 30; bit >= 0; --bit) {
            const unsigned cand = prefix | (1u << bit); int c = 0;
#pragma unroll
            for (int i = 0; i < 4; ++i) c += __popcll(__ballot(v[i] >= cand));
            LAS int* slot = cnt + (bit & 1) * 8;
            if (lane == 0) slot[wave] = c;
            __syncthreads();
            int tot = 0;
#pragma unroll
            for (int w = 0; w < 8; ++w) tot += slot[w];
            if (tot >= cap) prefix = cand;
        }
        int mg = 0, me = 0;
#pragma unroll
        for (int i = 0; i < 4; ++i) { mg += __popcll(__ballot(v[i] > prefix)); me += __popcll(__ballot(v[i] == prefix)); }
        if (lane == 0) { cnt[16 + wave] = mg; cnt[24 + wave] = me; }
        __syncthreads();
        int tg = 0, eqb = 0;
#pragma unroll
        for (int w = 0; w < 8; ++w) { tg += cnt[16 + w]; eqb += (w < wave) ? cnt[24 + w] : 0; }
        const int need = cap - tg;
        bool sel[4]; int ms = 0, eqseen = eqb;
#pragma unroll
        for (int i = 0; i < 4; ++i) {
            const bool gt = v[i] > prefix, eq = v[i] == prefix;
            const unsigned long long meq = __ballot(eq);
            sel[i] = gt || (eq && (eqseen + __popcll(meq & lt)) < need);
            ms += __popcll(__ballot(sel[i])); eqseen += __popcll(meq);
        }
        if (lane == 0) cnt[32 + wave] = ms;
        __syncthreads();
        int slotbase = 0;
#pragma unroll
        for (int w = 0; w < 8; ++w) slotbase += (w < wave) ? cnt[32 + w] : 0;
#pragma unroll
        for (int i = 0; i < 4; ++i) {
            const unsigned long long msel = __ballot(sel[i]);
            const int slot = slotbase + __popcll(msel & lt), t = wave * 256 + i * 64 + lane;
            if (t < n) SEL[(size_t)(rowbase + t) * NE + e] = sel[i] ? slot : -1;
            if (sel[i]) { idxl[slot] = t; GATE[xgbase + slot] = __uint_as_float(v[i]); }
            slotbase += __popcll(msel);
        }
        __syncthreads();
        for (int slot = wave; slot < cap; slot += NWAVES) {
            const int t = idxl[slot];
#if FP8_MOE
            ((u32x4*)((unsigned char*)XG + (size_t)(xgbase + slot) * D))[lane] = ((const u32x4*)((const unsigned char*)XN + (size_t)(rowbase + t) * D))[lane];
#else
            const u32x4* s = (const u32x4*)(XN + (size_t)(rowbase + t) * D);
            u32x4* d = (u32x4*)(XG + (size_t)(xgbase + slot) * D);
            d[lane] = s[lane]; d[lane + 64] = s[lane + 64];
#endif
        }
        __syncthreads();
    }
#if CVT_HIDE && FP8_MOE
    if (layer == 1 && (int)blockIdx.x >= 128 && (int)gridDim.x > 128)
        cvt8_run(a, 1, CV1_TK + ((int)blockIdx.x - 128), (int)gridDim.x - 128, CV1_TK + CVQ_TK1, lds);
    if (layer == 0 && ((int)blockIdx.x & 1) && (int)gridDim.x == 256)
        cvt8_run(a, 0, CV0_TK + ((int)blockIdx.x >> 1), 128, CV0_TK + CVQ_TK0, lds);
#endif
}
template <int MODE>
__device__ __forceinline__ void ph_combine(const Ctx& a, int layer, int nrows) {
    const int lane = threadIdx.x & 63, gw = blockIdx.x * NWAVES + (threadIdx.x >> 6), NGW = gridDim.x * NWAVES;
    bf16_t* H = (bf16_t*)(a.ws() + WS_H); const int* SEL = (const int*)(a.ws() + WS_SEL); const unsigned char* Y = a.ws() + WS_Y;
    const float* GATE = (const float*)(a.ws() + WS_GATE);
    bf16_t* XN = (bf16_t*)(a.ws() + WS_XN);
    const int rpe = layer == 0 ? RPE0 : RPE1;
    f32x4 v[4], vn[4]; int sel = -1, seln = -1;
    if (gw < nrows) { load_row_bf16(H + (size_t)gw * D, lane, v); sel = SEL[(size_t)gw * NE + (lane & 15)]; }
    for (int row = gw; row < nrows; row += NGW) {
        const int rnx = row + NGW;
        if (rnx < nrows) { load_row_bf16(H + (size_t)rnx * D, lane, vn); seln = SEL[(size_t)rnx * NE + (lane & 15)]; }
        const int mr = mod_row(row);
        const float* mp = mod_ptr(a, layer, mr);
        const int off = row < RL ? (row >> 11) * CAPL : NB * CAPL + ((row - RL) >> 8) * CAPC;
        f32x4 acc[4];
#pragma unroll
        for (int j = 0; j < 4; ++j) acc[j] = (f32x4){0.f, 0.f, 0.f, 0.f};
        unsigned mask = (unsigned)(__ballot(sel >= 0) & 0xffffull);
        int yw[4][4]; float gk[4];
#pragma unroll
        for (int k = 0; k < 4; ++k) {
            const bool on = mask != 0u; const int e = on ? __builtin_ctz(mask) : 0; mask = on ? (mask & (mask - 1u)) : 0u;
            const int sidx = __builtin_amdgcn_readlane(sel, e);
            const int yrow = on ? (e * rpe + off + sidx) : 0;
            const unsigned char* yr = Y + (size_t)yrow * D;
            gk[k] = on ? GATE[yrow] : 0.f;
#pragma unroll
            for (int j = 0; j < 4; ++j) { const int w = __builtin_nontemporal_load((const int*)(yr + 4 * lane + 256 * j)); yw[k][j] = on ? w : 0; }
        }
#pragma unroll
        for (int k = 0; k < 4; ++k)
#pragma unroll
            for (int j = 0; j < 4; ++j) { const f32x2 lo = __builtin_amdgcn_cvt_pk_f32_fp8(yw[k][j], false), hi2 = __builtin_amdgcn_cvt_pk_f32_fp8(yw[k][j], true);
                acc[j].x += gk[k] * lo.x; acc[j].y += gk[k] * lo.y; acc[j].z += gk[k] * hi2.x; acc[j].w += gk[k] * hi2.y; }
        while (mask != 0u) {
            const int e = __builtin_ctz(mask); mask &= mask - 1u;
            const int sidx = __builtin_amdgcn_readlane(sel, e);
            const int yrow = e * rpe + off + sidx; const float g1 = GATE[yrow];
            const unsigned char* yr = Y + (size_t)yrow * D;
#pragma unroll
            for (int j = 0; j < 4; ++j) { const int w = *(const int*)(yr + 4 * lane + 256 * j); const f32x2 lo = __builtin_amdgcn_cvt_pk_f32_fp8(w, false), hi2 = __builtin_amdgcn_cvt_pk_f32_fp8(w, true);
                acc[j].x += g1 * lo.x; acc[j].y += g1 * lo.y; acc[j].z += g1 * hi2.x; acc[j].w += g1 * hi2.y; }
        }
#pragma unroll
        for (int j = 0; j < 4; ++j) { const f32x4 g2 = *(const f32x4*)(mp + M_G2 + 4 * lane + 256 * j); v[j] = v[j] + g2 * (acc[j] * (1.0f / Y_SCALE)); }
        if (MODE == 0) {
            store_row_bf16(H + (size_t)row * D, lane, v);
            const float* mp1 = mod_ptr(a, 1, mr);
            rms_mod(v, a.in(I_N1G) + D, mp1 + M_SH1, mp1 + M_SC1, lane);
            store_row_bf16(XN + (size_t)row * D, lane, v);
        } else {
            rms_mod(v, a.in(I_FG), nullptr, nullptr, lane);
            { float* po = a.out() + (size_t)row * D;
#pragma unroll
              for (int j = 0; j < 4; ++j) __builtin_nontemporal_store(v[j], (f32x4*)(po + 4 * lane + 256 * j)); }
        }
#pragma unroll
        for (int j = 0; j < 4; ++j) v[j] = vn[j];
        sel = seln;
    }
}

__device__ __forceinline__ void ph_qkv_naive(const Ctx& a, LAS unsigned char* lds) {
    const bf16_t* XN = (const bf16_t*)(a.ws() + WS_XN); float* T = (float*)(a.ws() + WS_TMPF);
    for (int t = blockIdx.x; t < (RT / 128) * 48; t += gridDim.x) {
        const int tm = t / 48, tn = t % 48;
        naive_tile(XN + (size_t)tm * 128 * D, D, a.in(I_WQKV) + tn * 64, 3 * D, D, lds,
                   [&](int r, int c, float v) { T[(size_t)(tm * 128 + r) * 3072 + tn * 64 + c] = v; });
    }
}
__device__ __forceinline__ void ph_rope_naive(const Ctx& a) {
    const float* T = (const float*)(a.ws() + WS_TMPF); const float* rope = (const float*)(a.ws() + WS_ROPE);
    bf16_t* Q = (bf16_t*)(a.ws() + WS_Q); bf16_t* Kb = (bf16_t*)(a.ws() + WS_K); bf16_t* V = (bf16_t*)(a.ws() + WS_V);
    const size_t total = (size_t)RT * 3072, nth = (size_t)gridDim.x * NTHREADS;
    for (size_t i = (size_t)blockIdx.x * NTHREADS + threadIdx.x; i < total; i += nth) {
        const int row = (int)(i / 3072), c = (int)(i % 3072);
        if (c >= 2048) { V[(size_t)row * D + (c - 2048)] = (bf16_t)f2bf(T[i]); continue; }
        const int d = c & 63; if ((d & 31) >= 16) continue;
        float x1 = T[i], x2 = T[i + 16];
        if (row < RL) {
            const int t = row & 2047, axis = d >> 5, f = d & 15, pos = axis == 0 ? (t >> 6) : (t & 63);
            const float cs = rope[pos * 16 + f], sn = rope[1024 + pos * 16 + f];
            const float o1 = x1 * cs - x2 * sn, o2 = x2 * cs + x1 * sn; x1 = o1; x2 = o2;
        }
        if (c < 1024) { Q[(size_t)row * D + c] = (bf16_t)f2bf(x1 * QSCALE); Q[(size_t)row * D + c + 16] = (bf16_t)f2bf(x2 * QSCALE); }
        else { Kb[(size_t)row * D + c - 1024] = (bf16_t)f2bf(x1); Kb[(size_t)row * D + c - 1024 + 16] = (bf16_t)f2bf(x2); }
    }
}
template <int NIT>
__device__ __forceinline__ void naive_attn_item(const Ctx& a, int row, int h, float lam, LAS float* qs, int lane) {
    const bf16_t* Q = (const bf16_t*)(a.ws() + WS_Q); const bf16_t* Kb = (const bf16_t*)(a.ws() + WS_K); const bf16_t* V = (const bf16_t*)(a.ws() + WS_V);
    bf16_t* ATT = (bf16_t*)(a.ws() + WS_ATT);
    const int b = row < RL ? (row >> 11) : ((row - RL) >> 8);
    const int lat0 = b * SEQ, ctx0 = RL + b * CTXL;
    { const unsigned qq = *(const unsigned*)(Q + (size_t)row * D + h * 128 + 2 * lane); qs[2 * lane] = bf_lo(qq); qs[2 * lane + 1] = bf_hi(qq); }
    __builtin_amdgcn_fence(__ATOMIC_RELEASE, "wavefront"); __builtin_amdgcn_wave_barrier(); __builtin_amdgcn_fence(__ATOMIC_ACQUIRE, "wavefront");
#define NA_SCORE(it, d0, d1) do { const int kk_ = (it) * 64 + lane; \
        const int krow_ = (NIT == 36) ? (kk_ < SEQ ? lat0 + kk_ : ctx0 + kk_ - SEQ) : ctx0 + kk_; \
        const u32x4* kp_ = (const u32x4*)(Kb + (size_t)krow_ * D + h * 128); d0 = 0.f; d1 = 0.f; \
        _Pragma("unroll 4") for (int c = 0; c < 16; ++c) { const u32x4 kv = kp_[c]; \
            const f32x4 qa = *(const LAS f32x4*)(qs + 8 * c), qb = *(const LAS f32x4*)(qs + 8 * c + 4); \
            const float dd = (qa.x * bf_lo(kv.x) + qa.y * bf_hi(kv.x)) + (qa.z * bf_lo(kv.y) + qa.w * bf_hi(kv.y)) \
                           + (qb.x * bf_lo(kv.z) + qb.y * bf_hi(kv.z)) + (qb.z * bf_lo(kv.w) + qb.w * bf_hi(kv.w)); \
            if (c < 8) d0 += dd; else d1 += dd; } } while (0)
    float m0 = -3.0e38f, m1 = -3.0e38f, l0 = 0.f, l1 = 0.f;
#pragma unroll 1
    for (int it = 0; it < NIT; ++it) {
        float d0, d1; NA_SCORE(it, d0, d1);
        const float n0 = fmaxf(m0, d0), n1 = fmaxf(m1, d1);
        l0 = l0 * exp2f(m0 - n0) + exp2f(d0 - n0); l1 = l1 * exp2f(m1 - n1) + exp2f(d1 - n1); m0 = n0; m1 = n1;
    }
    { const float g0 = wave_max(m0), g1 = wave_max(m1); l0 = wave_sum(l0 * exp2f(m0 - g0)); l1 = wave_sum(l1 * exp2f(m1 - g1)); m0 = g0; m1 = g1; }
    const float i0 = 1.f / l0, i1 = lam / l1;
    float o0 = 0.f, o1 = 0.f;
#pragma unroll 1
    for (int it = 0; it < NIT; ++it) {
        float d0, d1; NA_SCORE(it, d0, d1);
        const int wbits = __float_as_int(exp2f(d0 - m0) * i0 - exp2f(d1 - m1) * i1);
#pragma unroll 4
        for (int src = 0; src < 64; ++src) {
            const float wv = __int_as_float(__builtin_amdgcn_readlane(wbits, src));
            const int kk = it * 64 + src;
            const int krow = (NIT == 36) ? (kk < SEQ ? lat0 + kk : ctx0 + kk - SEQ) : ctx0 + kk;
            const unsigned vv = *(const unsigned*)(V + (size_t)krow * D + h * 128 + 2 * lane);
            o0 += wv * bf_lo(vv); o1 += wv * bf_hi(vv);
        }
    }
#undef NA_SCORE
    const float ss = wave_sum(o0 * o0 + o1 * o1);
    const float rstd = 1.0f / sqrtf(ss * (1.0f / 128.0f) + EPS);
    const float g0 = a.in(I_SUBG)[2 * lane], g1 = a.in(I_SUBG)[2 * lane + 1];
    *(unsigned*)(ATT + (size_t)row * D + h * 128 + 2 * lane) = pk2(o0 * rstd * g0 * (1.0f - LAMBDA_INIT0), o1 * rstd * g1 * (1.0f - LAMBDA_INIT0));
}
__device__ __forceinline__ float diff_lambda(const Ctx& a, int lane) {
    const float s1 = wave_sum(a.in(I_LQ1)[lane] * a.in(I_LK1)[lane]), s2 = wave_sum(a.in(I_LQ2)[lane] * a.in(I_LK2)[lane]);
    return expf(s1) - expf(s2) + LAMBDA_INIT0;
}
__device__ __forceinline__ void ph_attn_naive(const Ctx& a, LAS unsigned char* lds) {
    const int lane = threadIdx.x & 63, wave = threadIdx.x >> 6, gw = blockIdx.x * NWAVES + wave, NGW = gridDim.x * NWAVES;
    LAS float* qs = (LAS float*)lds + wave * 128;
    const float lam = diff_lambda(a, lane);
    for (int item = gw; item < RT * 8; item += NGW) {
        const int h = item / RT, row = item % RT;
        if (row < RL) naive_attn_item<36>(a, row, h, lam, qs, lane); else naive_attn_item<4>(a, row, h, lam, qs, lane);
    }
}
__device__ __forceinline__ void ph_wo_naive(const Ctx& a, LAS unsigned char* lds) {
    const bf16_t* ATT = (const bf16_t*)(a.ws() + WS_ATT); bf16_t* H = (bf16_t*)(a.ws() + WS_H);
    for (int t = blockIdx.x; t < (RT / 128) * 16; t += gridDim.x) {
        const int tm = t / 16, tn = t % 16;
        naive_tile(ATT + (size_t)tm * 128 * D, D, a.in(I_WO) + tn * 64, D, D, lds, [&](int r, int c, float v) {
            const int row = tm * 128 + r, col = tn * 64 + c;
            const float base = row < RL ? a.in(I_X)[(size_t)row * D + col] : a.in(I_CTX)[(size_t)(row - RL) * D + col];
            H[(size_t)row * D + col] = (bf16_t)f2bf(base + mod_ptr(a, 0, mod_row(row))[M_G1 + col] * v); });
    }
}
__device__ __forceinline__ void ph_gu_naive(const Ctx& a, LAS unsigned char* lds, int layer) {
    const int rpe = layer == 0 ? RPE0 : RPE1, tpe = (rpe / 128) * 88;
    const bf16_t* XG = (const bf16_t*)(a.ws() + WS_XG); float* T = (float*)(a.ws() + WS_TMPF);
    for (int t = blockIdx.x; t < NE * tpe; t += gridDim.x) {
        const int e = t / tpe, q = t % tpe, tm = q / 88, tn = q % 88;
        const size_t row0 = (size_t)e * rpe + tm * 128;
        naive_tile(XG + row0 * D, D, a.in(I_WGU) + (size_t)(layer * NE + e) * D * 2 * DE + tn * 64, 2 * DE, D, lds,
                   [&](int r, int c, float v) { T[(row0 + r) * (2 * DE) + tn * 64 + c] = v; });
    }
}
__device__ __forceinline__ void ph_swiglu_naive(const Ctx& a, int layer) {
    const int rpe = layer == 0 ? RPE0 : RPE1;
    const float* T = (const float*)(a.ws() + WS_TMPF); bf16_t* ACT = (bf16_t*)(a.ws() + WS_ACT);
    const size_t total = (size_t)NE * rpe * DE, nth = (size_t)gridDim.x * NTHREADS;
    for (size_t i = (size_t)blockIdx.x * NTHREADS + threadIdx.x; i < total; i += nth) {
        const size_t row = i / DE; const int j = (int)(i % DE);
        const float g = T[row * (2 * DE) + j], u = T[row * (2 * DE) + DE + j];
        ACT[i] = (bf16_t)f2bf(g / (1.f + expf(-g)) * u);
    }
}
__device__ __forceinline__ void ph_dn_naive(const Ctx& a, LAS unsigned char* lds, int layer) {
    const int rpe = layer == 0 ? RPE0 : RPE1, tpe = (rpe / 128) * 16;
    const bf16_t* ACT = (const bf16_t*)(a.ws() + WS_ACT); unsigned char* Y = a.ws() + WS_Y; const float* GATE = (const float*)(a.ws() + WS_GATE);
    for (int t = blockIdx.x; t < NE * tpe; t += gridDim.x) {
        const int e = t / tpe, q = t % tpe, tm = q / 16, tn = q % 16;
        const size_t row0 = (size_t)e * rpe + tm * 128;
        naive_tile(ACT + row0 * DE, DE, a.in(I_WDN) + (size_t)(layer * NE + e) * DE * D + tn * 64, D, DE, lds,
                   [&](int r, int c, float v) { Y[(row0 + r) * D + tn * 64 + c] = (unsigned char)(pk4_fp8(v * Y_SCALE, 0.f, 0.f, 0.f) & 0xffu); });
    }
}
__device__ __forceinline__ void ph_win_naive(const Ctx& a, LAS unsigned char* lds) {
    const bf16_t* XN = (const bf16_t*)(a.ws() + WS_XN); bf16_t* YG = (bf16_t*)(a.ws() + WS_YG); bf16_t* XR = (bf16_t*)(a.ws() + WS_XR);
    const int TL = (RL / 128) * 32, TC = (RC / 128) * 16;
    for (int t = blockIdx.x; t < TL + TC; t += gridDim.x) {
        int tm, tn; if (t < TL) { tm = t / 32; tn = t % 32; } else { const int q = t - TL; tm = RL / 128 + q / 16; tn = 16 + q % 16; }
        naive_tile(XN + (size_t)tm * 128 * D, D, a.in(I_WIN) + tn * 64, 2 * D, D, lds, [&](int r, int c, float v) {
            const int row = tm * 128 + r, col = tn * 64 + c; const float x = v + a.in(I_BIN)[col];
            if (col < D) YG[(size_t)row * D + col] = (bf16_t)f2bf(gelu_tanh(x)); else XR[(size_t)row * D + col - D] = (bf16_t)f2bf(x); });
    }
}
__device__ __forceinline__ void ph_conv_naive(const Ctx& a) {
    const bf16_t* XR = (const bf16_t*)(a.ws() + WS_XR); bf16_t* XC = (bf16_t*)(a.ws() + WS_XC);
    const size_t total = (size_t)RT * D, nth = (size_t)gridDim.x * NTHREADS;
    for (size_t i = (size_t)blockIdx.x * NTHREADS + threadIdx.x; i < total; i += nth) {
        const int row = (int)(i >> 10), ch = (int)(i & 1023);
        const int t = row < RL ? (row & 2047) : ((row - RL) & 255), L = row < RL ? SEQ : CTXL;
        float v = a.in(I_CONVB)[ch];
#pragma unroll
        for (int j = 0; j < 4; ++j) { const int tt = t - 2 + j; if (tt >= 0 && tt < L) v += a.in(I_CONVW)[j * D + ch] * bf2f(XR[(size_t)(row - t + tt) * D + ch]); }
        XC[i] = (bf16_t)f2bf(v);
    }
}
__device__ __forceinline__ void ph_gates_naive(const Ctx& a, LAS unsigned char* lds) {
    const bf16_t* XC = (const bf16_t*)(a.ws() + WS_XC); float* T = (float*)(a.ws() + WS_TMPF);
    for (int t = blockIdx.x; t < 16 * (RT / 128) * 4; t += gridDim.x) {
        const int m = t / ((RT / 128) * 4), q = t % ((RT / 128) * 4), tm = q >> 2, tn = q & 3, d = m >> 3, kb = m & 7;
        naive_tile(XC + (size_t)tm * 128 * D + kb * 128, D, a.in(I_WGATES) + (size_t)m * 128 * 256 + tn * 64, 256, 128, lds,
                   [&](int r, int c, float v) { T[((size_t)d * RT + tm * 128 + r) * 2048 + kb * 256 + tn * 64 + c] = v; });
    }
}
__device__ __forceinline__ void ph_gate_elem_naive(const Ctx& a) {
    const float* T = (const float*)(a.ws() + WS_TMPF); const bf16_t* XC = (const bf16_t*)(a.ws() + WS_XC);
    bf16_t* LOGA = (bf16_t*)(a.ws() + WS_LOGA); unsigned char* BT = a.ws() + WS_BT;
    const size_t total = (size_t)2 * RT * D, nth = (size_t)gridDim.x * NTHREADS;
    for (size_t i = (size_t)blockIdx.x * NTHREADS + threadIdx.x; i < total; i += nth) {
        const int d = (int)(i / ((size_t)RT * D)); const size_t rc = i % ((size_t)RT * D); const int row = (int)(rc >> 10), ch = (int)(rc & 1023), kb = ch >> 7, cc = ch & 127;
        const float gr = T[((size_t)d * RT + row) * 2048 + kb * 256 + cc] + a.in(I_BGATES)[(d * 8 + kb) * 256 + cc];
        const float gi = T[((size_t)d * RT + row) * 2048 + kb * 256 + 128 + cc] + a.in(I_BGATES)[(d * 8 + kb) * 256 + 128 + cc];
        const float r = sigmoidf_(gr), ig = sigmoidf_(gi);
        const float lam = a.in(I_LAM)[d * D + ch];
        const float la = -8.0f * r * log1pf(expf(-lam));
        const float x = bf2f(XC[rc]);
        const float bt = sqrtf(-expm1f(2.0f * la)) * (ig * x);
        LOGA[i] = (bf16_t)f2bf(la * 1.4426950408889634f); BT[i] = (unsigned char)(pk4_fp8(bt * BT_SCALE, 0.f, 0.f, 0.f) & 0xffu);
    }
}
__device__ __forceinline__ void ph_wout_naive(const Ctx& a, LAS unsigned char* lds) {
    const bf16_t* HS = (const bf16_t*)(a.ws() + WS_HS); bf16_t* H = (bf16_t*)(a.ws() + WS_H);
    for (int t = blockIdx.x; t < (RL / 128) * 16; t += gridDim.x) {
        const int tm = t / 16, tn = t % 16;
        naive_tile(HS + (size_t)tm * 128 * D, D, a.in(I_WOUT) + tn * 64, D, D, lds, [&](int r, int c, float v) {
            const int row = tm * 128 + r, col = tn * 64 + c;
            H[(size_t)row * D + col] = (bf16_t)f2bf(bf2f(H[(size_t)row * D + col]) + mod_ptr(a, 1, row >> 11)[M_G1 + col] * v); });
    }
}

__device__ __forceinline__ int scan_row(int b, int dir, int c, int s) {
    const int p = c * SCH + s;
    if (dir == 0) return p < CTXL ? RL + b * CTXL + p : b * SEQ + (p - CTXL);
    return p < CTXL ? RL + b * CTXL + (CTXL - 1 - p) : b * SEQ + (SEQ - 1 - (p - CTXL));
}
__device__ __forceinline__ void ph_scan1(const Ctx& a) {
    const int lane = threadIdx.x & 63, gw = blockIdx.x * NWAVES + (threadIdx.x >> 6), NGW = gridDim.x * NWAVES;
    const bf16_t* LOGA = (const bf16_t*)(a.ws() + WS_LOGA); const unsigned char* BT = a.ws() + WS_BT;
    float* CP = (float*)(a.ws() + WS_CP); float* CB = (float*)(a.ws() + WS_CB);
    for (int item = gw; item < NB * 2 * NCH * 8; item += NGW) {
        const int cg = item & 7, c = (item >> 3) % NCH, bd = (item >> 3) / NCH, dir = bd & 1, b = bd >> 1;
        const int ch = cg * 128 + 2 * lane;
        float h0 = 0.f, h1 = 0.f, p0 = 0.f, p1 = 0.f;
#pragma unroll 1
        for (int sg = 0; sg < SCH; sg += 32) {
            unsigned la[32], bt[32];
#pragma unroll
            for (int i = 0; i < 32; ++i) { const size_t o = ((size_t)dir * RT + scan_row(b, dir, c, sg + i)) * D + ch; la[i] = *(const unsigned*)(LOGA + o); bt[i] = *(const unsigned short*)(BT + o); }
            asm volatile("" ::: "memory");
#pragma unroll
            for (int i = 0; i < 32; ++i) { const float l0 = bf_lo(la[i]), l1 = bf_hi(la[i]);
                const f32x2 bb = __builtin_amdgcn_cvt_pk_f32_fp8((int)bt[i], false);
                h0 = __builtin_amdgcn_exp2f(l0) * h0 + bb.x; h1 = __builtin_amdgcn_exp2f(l1) * h1 + bb.y; p0 += l0; p1 += l1; }
        }
        const size_t so = ((size_t)(b * 2 + dir) * NCH + c) * D + ch;
        *(f32x2*)(CP + so) = (f32x2){p0, p1}; *(f32x2*)(CB + so) = (f32x2){h0, h1};
    }
}
__device__ __forceinline__ void ph_scan2(const Ctx& a) {
    const int lane = threadIdx.x & 63, gw = blockIdx.x * NWAVES + (threadIdx.x >> 6), NGW = gridDim.x * NWAVES;
    const bf16_t* LOGA = (const bf16_t*)(a.ws() + WS_LOGA); const unsigned char* BT = a.ws() + WS_BT;
    const float* CP = (const float*)(a.ws() + WS_CP); const float* CB = (const float*)(a.ws() + WS_CB);
    const bf16_t* YG = (const bf16_t*)(a.ws() + WS_YG); bf16_t* HS = (bf16_t*)(a.ws() + WS_HS);
    constexpr int NLC = SEQ / SCH;
    for (int item = gw; item < NB * NLC * 8; item += NGW) {
        const int cg = item & 7, j = (item >> 3) % NLC, b = (item >> 3) / NLC;
        const int ch = cg * 128 + 2 * lane;
        const int cb = NCH_CTX + (NLC - 1 - j), cf = NCH_CTX + j;
        float hb0 = 0.f, hb1 = 0.f, hf0 = 0.f, hf1 = 0.f;
#pragma unroll 1
        for (int c0 = 0; c0 < NCH - 1; c0 += 12) {
            f32x2 pb[12], qb[12], pf[12], qf[12];
#pragma unroll
            for (int i = 0; i < 12; ++i) {
                const int c = c0 + i; const size_t sb_ = ((size_t)(b * 2 + 1) * NCH + c) * D + ch, sf_ = ((size_t)(b * 2 + 0) * NCH + c) * D + ch;
                const f32x2 z = (f32x2){0.f, 0.f};
                pb[i] = c < cb ? *(const f32x2*)(CP + sb_) : z; qb[i] = c < cb ? *(const f32x2*)(CB + sb_) : z;
                pf[i] = c < cf ? *(const f32x2*)(CP + sf_) : z; qf[i] = c < cf ? *(const f32x2*)(CB + sf_) : z;
            }
            asm volatile("" ::: "memory");
#pragma unroll
            for (int i = 0; i < 12; ++i) {
                hb0 = __builtin_amdgcn_exp2f(pb[i].x) * hb0 + qb[i].x; hb1 = __builtin_amdgcn_exp2f(pb[i].y) * hb1 + qb[i].y;
                hf0 = __builtin_amdgcn_exp2f(pf[i].x) * hf0 + qf[i].x; hf1 = __builtin_amdgcn_exp2f(pf[i].y) * hf1 + qf[i].y;
            }
        }
        float sb0[SCH], sb1[SCH];
#pragma unroll
        for (int sg = 0; sg < SCH; sg += 32) {
            unsigned la[32], bt[32];
#pragma unroll
            for (int i = 0; i < 32; ++i) { const size_t o = ((size_t)1 * RT + b * SEQ + j * SCH + (SCH - 1 - (sg + i))) * D + ch; la[i] = *(const unsigned*)(LOGA + o); bt[i] = *(const unsigned short*)(BT + o); }
            asm volatile("" ::: "memory");
#pragma unroll
            for (int i = 0; i < 32; ++i) {
                const f32x2 bb = __builtin_amdgcn_cvt_pk_f32_fp8((int)bt[i], false);
                hb0 = __builtin_amdgcn_exp2f(bf_lo(la[i])) * hb0 + bb.x; hb1 = __builtin_amdgcn_exp2f(bf_hi(la[i])) * hb1 + bb.y;
                sb0[SCH - 1 - (sg + i)] = hb0; sb1[SCH - 1 - (sg + i)] = hb1;
            }
        }
#pragma unroll
        for (int sg = 0; sg < SCH; sg += 16) {
            unsigned la[16], bt[16], yg[16];
#pragma unroll
            for (int i = 0; i < 16; ++i) { const size_t o = ((size_t)b * SEQ + j * SCH + sg + i) * D + ch; la[i] = __builtin_nontemporal_load((const unsigned*)(LOGA + o)); bt[i] = __builtin_nontemporal_load((const unsigned short*)(BT + o)); yg[i] = __builtin_nontemporal_load((const unsigned*)(YG + o)); }
            asm volatile("" ::: "memory");
#pragma unroll
            for (int i = 0; i < 16; ++i) {
                const size_t o = ((size_t)b * SEQ + j * SCH + sg + i) * D + ch;
                const f32x2 bb = __builtin_amdgcn_cvt_pk_f32_fp8((int)bt[i], false);
                hf0 = __builtin_amdgcn_exp2f(bf_lo(la[i])) * hf0 + bb.x; hf1 = __builtin_amdgcn_exp2f(bf_hi(la[i])) * hf1 + bb.y;
                *(unsigned*)(HS + o) = pk2(bf_lo(yg[i]) * ((hf0 + sb0[sg + i]) * (1.0f / BT_SCALE)), bf_hi(yg[i]) * ((hf1 + sb1[sg + i]) * (1.0f / BT_SCALE)));
            }
            asm volatile("" ::: "memory");
        }
    }
}
#define XB_TMO      128
#define XB_XCNT(j)  (256  + 64 * (j))
#define XB_XSUB(j)  (1280 + 64 * (j))
#define XB_XGEN(j)  (2304 + 64 * (j))
#define XB_TOP      3328
#define XB_TOPGEN   3392
#define XCD_BAR_WORDS 3456
#define XB_SPIN_CAP (1u << 18)

__device__ __forceinline__ unsigned xb_ld(unsigned* p)              { return __hip_atomic_load(p, __ATOMIC_RELAXED, __HIP_MEMORY_SCOPE_AGENT); }
__device__ __forceinline__ unsigned xb_add(unsigned* p, unsigned v) { return __hip_atomic_fetch_add(p, v, __ATOMIC_RELAXED, __HIP_MEMORY_SCOPE_AGENT); }
__device__ __forceinline__ unsigned xb_xcc_id() { return (unsigned)__builtin_amdgcn_s_getreg((3 << 11) | 20) & 0xFu; }
#define XB_SPIN(cond, bar) do { unsigned _sp = 0; while (cond) { __builtin_amdgcn_s_sleep(1); \
    if ((++_sp & 255u) == 0u) { if (xb_ld(&(bar)[XB_TMO])) break; if (_sp > XB_SPIN_CAP) { atomicAdd(&(bar)[XB_TMO], 1u); break; } } } } while (0)

struct XcdBarrier {
    unsigned* bar; unsigned x;
    volatile LAS unsigned* st;
};

__device__ __forceinline__ XcdBarrier xcd_barrier_post(unsigned* bar, volatile LAS unsigned* st) {
    XcdBarrier b; b.bar = bar; b.x = xb_xcc_id(); b.st = st;
    if (threadIdx.x == 0) (void)xb_add(&bar[XB_XCNT(b.x)], 1u);
    return b;
}
__device__ __forceinline__ void xcd_barrier_complete(unsigned* bar, unsigned x, unsigned& nloc, unsigned& nx) {
    const unsigned G = gridDim.x * gridDim.y * gridDim.z;
    unsigned sum, cnt, mine, sp = 0u;
    for (;;) {
        sum = 0u; cnt = 0u; mine = 0u;
#pragma unroll
        for (unsigned j = 0; j < 16; ++j) { const unsigned c = xb_ld(&bar[XB_XCNT(j)]); sum += c; cnt += (c > 0u) ? 1u : 0u; mine = (j == x) ? c : mine; }
        if (sum == G) break;
        __builtin_amdgcn_s_sleep(1);
        if ((++sp & 255u) == 0u) { if (xb_ld(&bar[XB_TMO])) break; if (sp > XB_SPIN_CAP) { atomicAdd(&bar[XB_TMO], 1u); break; } }
    }
    nloc = mine > 0u ? mine : 1u; nx = cnt > 0u ? cnt : 1u;
}

__device__ __forceinline__ void xcd_barrier(const XcdBarrier& b) {
    asm volatile("s_waitcnt vmcnt(0)" ::: "memory");
    __syncthreads();
    if (threadIdx.x == 0) {
        unsigned* bar = b.bar;
        __builtin_amdgcn_s_waitcnt(0);
        unsigned nloc = b.st[0], nx = b.st[1];
        if (nloc == 0u) { xcd_barrier_complete(bar, b.x, nloc, nx); b.st[0] = nloc; b.st[1] = nx; }
        const unsigned old = xb_add(&bar[XB_XSUB(b.x)], 1u);
        const unsigned gen = old / nloc;
        if (old + 1u == (gen + 1u) * nloc) {
            __builtin_amdgcn_fence(__ATOMIC_RELEASE, "agent");
            asm volatile("s_waitcnt vmcnt(0)" ::: "memory");
            const unsigned og = xb_add(&bar[XB_TOP], 1u);
            const unsigned tg = og / nx;
            if (og + 1u == (tg + 1u) * nx) xb_add(&bar[XB_TOPGEN], 1u);
            else XB_SPIN(xb_ld(&bar[XB_TOPGEN]) == tg, bar);
            __builtin_amdgcn_fence(__ATOMIC_ACQUIRE, "agent");
            xb_add(&bar[XB_XGEN(b.x)], 1u);
            asm volatile("s_waitcnt vmcnt(0)" ::: "memory");
        } else {
            XB_SPIN(xb_ld(&bar[XB_XGEN(b.x)]) == gen, bar);
            __builtin_amdgcn_fence(__ATOMIC_ACQUIRE, "agent");
            asm volatile("s_waitcnt vmcnt(0)" ::: "memory");
        }
    }
    __syncthreads();
}

__device__ __forceinline__ int xcd_remap(long L, int n) { const int q = n / 8, r = n % 8, xcd = (int)(L % 8), off = (int)(L / 8); return (xcd < r ? xcd * (q + 1) : r * (q + 1) + (xcd - r) * q) + off; }
template <class Map> struct ListOrder {
    int nunits, G, c; Map map;
    __device__ __forceinline__ bool next(int i, pg8::Unit& u) const { const long L = (long)i * G + c; if (L >= nunits) return false; map(xcd_remap(L, nunits), u); return true; }
    __device__ __forceinline__ void a_ready(const pg8::Unit&) const {}
    __device__ __forceinline__ void done(const pg8::Unit&) const {}
};
#ifndef WGMG
#define WGMG 8
#endif
struct MapGrid { int nN; __device__ __forceinline__ void operator()(int w, pg8::Unit& u) const { const int nig = WGMG * nN; u.pm = (w / nig) * WGMG + (w % nig) % WGMG; u.pn = (w % nig) / WGMG; } };
struct MapMoe { int PM, NT; __device__ __forceinline__ void operator()(int w, pg8::Unit& u) const { const int per = PM * NT, e = w / per, rem = w % per; u.pm = e * PM + rem % PM; u.pn = e * NT + rem / PM; } };
struct MapWin { __device__ __forceinline__ void operator()(int w, pg8::Unit& u) const { if (w < 512) { u.pm = (w / 64) * 8 + (w % 64) % 8; u.pn = (w % 64) / 8; } else { const int q = w - 512; u.pm = 64 + q % 8; u.pn = 4 + q / 8; } } };

typedef pg8::f32x4 pf4;
__device__ __forceinline__ float fast_exp(float x) { return __builtin_amdgcn_exp2f(x * 1.4426950408889634f); }

struct EpiQKV {
    static constexpr bool PERM = true, AFTER_DRAIN = false;
    bf16_t* Q; const LAS float* rope;
    __device__ __forceinline__ void operator()(const pf4 (&acc)[2][2][4][2], const pg8::Unit& u, int wr, int wc, int fr, int fq) const {
        const int sec = u.pn >> 2; bf16_t* base = Q + (size_t)sec * ((WS_K - WS_Q) / 2);
        const bool lat = u.pm < 64, dorope = sec < 2 && lat; const int axis = wc & 1;
        const bool upper = fq >= 2;
        const int row0 = u.pm * 256 + wr * 64 + fr, col0 = (u.pn & 3) * 256 + wc * 32 + 8 * fq;
        const float sc = sec == 0 ? QSCALE : 1.0f;
#pragma unroll
        for (int ai = 0; ai < 2; ++ai)
#pragma unroll
            for (int m = 0; m < 4; ++m) {
                const int row = row0 + ai * 128 + m * 16;
                pf4 cs[2], sn[2];
#pragma unroll
                for (int n = 0; n < 2; ++n) { cs[n] = (pf4){1.f, 1.f, 1.f, 1.f}; sn[n] = (pf4){0.f, 0.f, 0.f, 0.f}; }
                if (dorope) { const int t = row & 2047, pos = axis ? (t & 63) : (t >> 6); const LAS float* rp = rope + pos * 16 + 8 * (fq & 1);
#pragma unroll
                    for (int n = 0; n < 2; ++n) { cs[n] = *(const LAS pf4*)(rp + 4 * n); sn[n] = *(const LAS pf4*)(rp + 1024 + 4 * n); } }
#pragma unroll
                for (int bj = 0; bj < 2; ++bj) {
                    pf4 o[2];
#pragma unroll
                    for (int n = 0; n < 2; ++n)
#pragma unroll
                        for (int j = 0; j < 4; ++j) {
                            const float own = acc[ai][bj][m][n][j];
                            float v = own;
                            if (dorope) {
                                const auto rr = __builtin_amdgcn_permlane32_swap(__float_as_uint(own), __float_as_uint(own), false, false);
                                const float other = __uint_as_float(upper ? rr[0] : rr[1]);
                                v = upper ? (own * cs[n][j] + other * sn[n][j]) : (own * cs[n][j] - other * sn[n][j]);
                            }
                            o[n][j] = v * sc;
                        }
                    u32x4 w; w.x = pk2(o[0][0], o[0][1]); w.y = pk2(o[0][2], o[0][3]); w.z = pk2(o[1][0], o[1][1]); w.w = pk2(o[1][2], o[1][3]);
                    st16_wt(base + (size_t)row * D + col0 + bj * 128, w);
                }
            }
    }
};
struct EpiResid {
    static constexpr bool PERM = true, AFTER_DRAIN = false;
    bf16_t* H; const float* x; const float* ctx; const float* mod; int layer;
    __device__ __forceinline__ void operator()(const pf4 (&acc)[2][2][4][2], const pg8::Unit& u, int wr, int wc, int fr, int fq) const {
        const bool lat = u.pm < 64;
        const float* xb = lat ? x + (size_t)u.pm * 256 * D : ctx + (size_t)(u.pm - 64) * 256 * D;
        const float* g = mod + (size_t)(layer * 9 + (lat ? (u.pm >> 3) : 8)) * 6144 + M_G1;
        bf16_t* out = H + (size_t)u.pm * 256 * D;
        const int r0 = wr * 64 + fr, col0 = u.pn * 256 + wc * 32 + 8 * fq;
        pf4 gv[2][2];
#pragma unroll
        for (int bj = 0; bj < 2; ++bj)
#pragma unroll
            for (int n = 0; n < 2; ++n) gv[bj][n] = *(const pf4*)(g + col0 + bj * 128 + 4 * n);
#pragma unroll
        for (int it = 0; it < 8; ++it) {
            const int ai = it >> 2, m = it & 3;
            const size_t ro = (size_t)(r0 + ai * 128 + m * 16) * D + col0;
#pragma unroll
            for (int bj = 0; bj < 2; ++bj) {
                pf4 b0, b1;
                if (layer == 0) { b0 = *(const pf4*)(xb + ro + bj * 128); b1 = *(const pf4*)(xb + ro + bj * 128 + 4); }
                else { const u32x4 hb = *(const u32x4*)(out + ro + bj * 128); b0 = (pf4){bf_lo(hb.x), bf_hi(hb.x), bf_lo(hb.y), bf_hi(hb.y)}; b1 = (pf4){bf_lo(hb.z), bf_hi(hb.z), bf_lo(hb.w), bf_hi(hb.w)}; }
                const pf4 o0 = b0 + gv[bj][0] * acc[ai][bj][m][0], o1 = b1 + gv[bj][1] * acc[ai][bj][m][1];
                u32x4 w; w.x = pk2(o0[0], o0[1]); w.y = pk2(o0[2], o0[3]); w.z = pk2(o1[0], o1[1]); w.w = pk2(o1[2], o1[3]);
                st16_wt(out + ro + bj * 128, w);
            }
        }
    }
};
struct EpiSwiGLU {
    static constexpr bool PERM = true, AFTER_DRAIN = false;
    bf16_t* ACT;
    __device__ __forceinline__ void operator()(const pf4 (&acc)[2][2][4][2], const pg8::Unit& u, int wr, int wc, int fr, int fq) const {
        const int ct = u.pn % 22;
        bf16_t* p0 = ACT + (size_t)(u.pm * 256 + wr * 64 + fr) * DE + ct * 128 + wc * 32 + 8 * fq;
#pragma unroll
        for (int ai = 0; ai < 2; ++ai)
#pragma unroll
            for (int m = 0; m < 4; ++m) {
                float o[8];
#pragma unroll
                for (int n = 0; n < 2; ++n)
#pragma unroll
                    for (int j = 0; j < 4; ++j) { const float g = acc[ai][0][m][n][j], uu = acc[ai][1][m][n][j]; o[n * 4 + j] = g * __builtin_amdgcn_rcpf(1.0f + fast_exp(-g)) * uu; }
                u32x4 w; w.x = pk2(o[0], o[1]); w.y = pk2(o[2], o[3]); w.z = pk2(o[4], o[5]); w.w = pk2(o[6], o[7]);
                *(u32x4*)(p0 + (size_t)(ai * 128 + m * 16) * DE) = w;
            }
    }
};
struct EpiDown {
    static constexpr bool PERM = true, AFTER_DRAIN = false;
    unsigned char* Y;
    __device__ __forceinline__ void operator()(const pf4 (&acc)[2][2][4][2], const pg8::Unit& u, int wr, int wc, int fr, int fq) const {
        const int row0 = u.pm * 256 + wr * 64 + fr, col0 = (u.pn & 3) * 256 + wc * 32 + 8 * fq;
#pragma unroll
        for (int ai = 0; ai < 2; ++ai)
#pragma unroll
            for (int m = 0; m < 4; ++m) {
                const int row = row0 + ai * 128 + m * 16;
#pragma unroll
                for (int bj = 0; bj < 2; ++bj) {
                    const pf4 v0 = acc[ai][bj][m][0] * Y_SCALE, v1 = acc[ai][bj][m][1] * Y_SCALE;
                    u32x2 w; w.x = pk4_fp8(v0[0], v0[1], v0[2], v0[3]); w.y = pk4_fp8(v1[0], v1[1], v1[2], v1[3]);
                    st8_wt(Y + (size_t)row * D + col0 + bj * 128, w);
                }
            }
    }
};
struct EpiWin {
    static constexpr bool PERM = true, AFTER_DRAIN = false;
    bf16_t *YG, *XR; const LAS float* bin;
    __device__ __forceinline__ void operator()(const pf4 (&acc)[2][2][4][2], const pg8::Unit& u, int wr, int wc, int fr, int fq) const {
        const bool yb = u.pn < 4; bf16_t* base = yb ? YG : XR;
        const int row0 = u.pm * 256 + wr * 64 + fr, colg = u.pn * 256 + wc * 32 + 8 * fq, col0 = (u.pn & 3) * 256 + wc * 32 + 8 * fq;
        pf4 bv[2][2];
#pragma unroll
        for (int bj = 0; bj < 2; ++bj)
#pragma unroll
            for (int n = 0; n < 2; ++n) bv[bj][n] = *(const LAS pf4*)(bin + colg + bj * 128 + 4 * n);
#pragma unroll
        for (int ai = 0; ai < 2; ++ai)
#pragma unroll
            for (int m = 0; m < 4; ++m) {
                const int row = row0 + ai * 128 + m * 16;
#pragma unroll
                for (int bj = 0; bj < 2; ++bj) {
                    pf4 v0 = acc[ai][bj][m][0] + bv[bj][0], v1 = acc[ai][bj][m][1] + bv[bj][1];
                    if (yb) {
#pragma unroll
                        for (int j = 0; j < 4; ++j) {
                            { const float x = v0[j], uu = 0.7978845608028654f * (x + 0.044715f * x * x * x); v0[j] = x * __builtin_amdgcn_rcpf(1.0f + fast_exp(-2.0f * uu)); }
                            { const float x = v1[j], uu = 0.7978845608028654f * (x + 0.044715f * x * x * x); v1[j] = x * __builtin_amdgcn_rcpf(1.0f + fast_exp(-2.0f * uu)); }
                        }
                    }
                    u32x4 w; w.x = pk2(v0[0], v0[1]); w.y = pk2(v0[2], v0[3]); w.z = pk2(v1[0], v1[1]); w.w = pk2(v1[2], v1[3]);
                    st16_wt(base + (size_t)row * D + col0 + bj * 128, w);
                }
            }
    }
};

#ifndef DENSE_ALIGN
#define DENSE_ALIGN true
#endif
#ifndef DENSE_SP2
#define DENSE_SP2 true
#endif
__device__ __forceinline__ void stagger_start(int ticks) {
    if (ticks > 0 && ((blockIdx.x >> 3) & 1)) { const unsigned long long t0 = __builtin_amdgcn_s_memrealtime(); while (__builtin_amdgcn_s_memrealtime() - t0 < (unsigned long long)ticks) __builtin_amdgcn_s_sleep(8); }
}
#ifndef STG_QKV
#define STG_QKV 0
#endif
#ifndef STG_GU
#define STG_GU 0
#endif
#ifndef STG_DN
#define STG_DN 0
#endif
#ifndef STG_WIN
#define STG_WIN 0
#endif
#ifndef STG_WO
#define STG_WO 0
#endif
#define PG8_RUN(EPI, SCHED, g, S, E) pg8::gemm_phase<EPI, SCHED, DENSE_ALIGN, DENSE_SP2>((PG8_LAS unsigned char*)lds, g, S, E)

__device__ __forceinline__ void ph_qkv_fast(const Ctx& a, LAS unsigned char* lds) {
    unsigned char* ws = a.ws();
    pg8::Gemm g{(const bf16_t*)(ws + WS_XN), (const bf16_t*)(ws + WS_WQKV), RT, 3 * D, D};
    const int Gq = gemm_groups(72 * 12, (int)gridDim.x);
    if ((int)blockIdx.x >= Gq) { cvt8_run(a, 0, CV0_QKV + ((int)blockIdx.x - Gq), (int)gridDim.x - Gq, CV0_QKV + CVQ_QKV, lds); return; }
    ListOrder<MapGrid> S{72 * 12, Gq, (int)blockIdx.x, MapGrid{12}};
    static_assert(WS_V - WS_K == WS_K - WS_Q, "Q|K|V spacing");
    LAS float* rl = (LAS float*)(lds + ROPE_LDS);
    { const float* rg = (const float*)(ws + WS_ROPE); for (int i = threadIdx.x; i < 2048; i += NTHREADS) rl[i] = rg[i]; }
    __syncthreads();
    EpiQKV E{(bf16_t*)(ws + WS_Q), rl};
    stagger_start(STG_QKV);
    PG8_RUN(EpiQKV, ListOrder<MapGrid>, g, S, E);
    if (Gq == (int)gridDim.x) cvt8_tail(a, lds, 72 * 12, Gq, (int)blockIdx.x, 0, CV0_QKV, CVQ_QKV);
}
__device__ __forceinline__ void ph_wo_fast(const Ctx& a, LAS unsigned char* lds) {
    unsigned char* ws = a.ws();
    pg8::Gemm g{(const bf16_t*)(ws + WS_ATT), (const bf16_t*)(ws + WS_WO), RT, D, D};
    const int Gq = gemm_groups(72 * 4, (int)gridDim.x);
    if ((int)blockIdx.x >= Gq) { cvt8_run(a, 0, CV0_WO + ((int)blockIdx.x - Gq), (int)gridDim.x - Gq, CV0_WO + CVQ_WO, lds); return; }
    ListOrder<MapGrid> S{72 * 4, Gq, (int)blockIdx.x, MapGrid{4}};
    EpiResid E{(bf16_t*)(ws + WS_H), a.in(I_X), a.in(I_CTX), (const float*)(ws + WS_MOD), 0};
    stagger_start(STG_WO);
    PG8_RUN(EpiResid, ListOrder<MapGrid>, g, S, E);
    if (Gq == (int)gridDim.x) cvt8_tail(a, lds, 72 * 4, Gq, (int)blockIdx.x, 0, CV0_WO, CVQ_WO);
}
__device__ __forceinline__ void ph_wout_fast(const Ctx& a, LAS unsigned char* lds) {
    unsigned char* ws = a.ws();
    pg8::Gemm g{(const bf16_t*)(ws + WS_HS), (const bf16_t*)(ws + WS_WOUT), RL, D, D};
    ListOrder<MapGrid> S{64 * 4, (int)gridDim.x, (int)blockIdx.x, MapGrid{4}};
    EpiResid E{(bf16_t*)(ws + WS_H), nullptr, nullptr, (const float*)(ws + WS_MOD), 1};
    PG8_RUN(EpiResid, ListOrder<MapGrid>, g, S, E);
}
#if FP8_MOE
struct EpiSwiGLU8 {
    static constexpr bool PERM = true, AFTER_DRAIN = false;
    unsigned char* ACT;
    __device__ __forceinline__ void operator()(const pf4 (&acc)[2][2][4][2], const pg8::Unit& u, int wr, int wc, int fr, int fq) const {
        const int ct = u.pn % 22;
        unsigned char* p0 = ACT + (size_t)(u.pm * 256 + wr * 64 + fr) * DE + ct * 128 + wc * 32 + 8 * fq;
#pragma unroll
        for (int ai = 0; ai < 2; ++ai)
#pragma unroll
            for (int m = 0; m < 4; ++m) {
                float o[8];
#pragma unroll
                for (int n = 0; n < 2; ++n)
#pragma unroll
                    for (int j = 0; j < 4; ++j) { const float g = acc[ai][0][m][n][j], uu = acc[ai][1][m][n][j]; o[n * 4 + j] = g * __builtin_amdgcn_rcpf(1.0f + fast_exp(-g)) * uu; }
                u32x2 w; w.x = pk4_fp8(o[0], o[1], o[2], o[3]); w.y = pk4_fp8(o[4], o[5], o[6], o[7]);
                st8_wt(p0 + (size_t)(ai * 128 + m * 16) * DE, w);
            }
    }
};
__device__ __forceinline__ void ph_gu_fast(const Ctx& a, LAS unsigned char* lds, int layer) {
    unsigned char* ws = a.ws(); const int PM = (layer == 0 ? RPE0 : RPE1) / 256;
    pg8::Gemm g{(const bf16_t*)(ws + WS_XG), (const bf16_t*)(ws + WS_WGU + (size_t)layer * (WGU_LAYER / 2)), NE * PM * 256, NE * 2 * DE, D / 2};
    ListOrder<MapMoe> S{NE * PM * 22, (int)gridDim.x, (int)blockIdx.x, MapMoe{PM, 22}};
    EpiSwiGLU8 E{ws + WS_ACT};
    stagger_start(STG_GU);
    pg8::gemm_phase<EpiSwiGLU8, ListOrder<MapMoe>, GU_ALIGN, true, 122>((PG8_LAS unsigned char*)lds, g, S, E);
    if (layer == 0) cvt8_tail(a, lds, NE * PM * 22, (int)gridDim.x, (int)blockIdx.x, 1, CV1_GU0, CVQ_GU0);
}
__device__ __forceinline__ void ph_dn_fast(const Ctx& a, LAS unsigned char* lds, int layer) {
    unsigned char* ws = a.ws(); const int PM = (layer == 0 ? RPE0 : RPE1) / 256;
    pg8::Gemm g{(const bf16_t*)(ws + WS_ACT), (const bf16_t*)(ws + WS_WDN + (size_t)layer * (WDN_LAYER / 2)), NE * PM * 256, NE * D, DE / 2};
    const int Gq = layer == 0 ? gemm_groups(NE * PM * 4, (int)gridDim.x) : (int)gridDim.x;
    if ((int)blockIdx.x >= Gq) { cvt8_run(a, 1, CV1_DN0 + ((int)blockIdx.x - Gq), (int)gridDim.x - Gq, CV1_DN0 + CVQ_DN0, lds); return; }
    ListOrder<MapMoe> S{NE * PM * 4, Gq, (int)blockIdx.x, MapMoe{PM, 4}};
    EpiDown E{ws + WS_Y};
    stagger_start(STG_DN);
    pg8::gemm_phase<EpiDown, ListOrder<MapMoe>, DN_ALIGN, true, 121>((PG8_LAS unsigned char*)lds, g, S, E);
    if (layer == 0 && Gq == (int)gridDim.x) cvt8_tail(a, lds, NE * PM * 4, Gq, (int)blockIdx.x, 1, CV1_DN0, CVQ_DN0);
}
#else
__device__ __forceinline__ void ph_gu_fast(const Ctx& a, LAS unsigned char* lds, int layer) {
    unsigned char* ws = a.ws(); const int PM = (layer == 0 ? RPE0 : RPE1) / 256;
    pg8::Gemm g{(const bf16_t*)(ws + WS_XG), (const bf16_t*)(ws + WS_WGU + (size_t)layer * WGU_LAYER), NE * PM * 256, NE * 2 * DE, D};
    ListOrder<MapMoe> S{NE * PM * 22, (int)gridDim.x, (int)blockIdx.x, MapMoe{PM, 22}};
    EpiSwiGLU E{(bf16_t*)(ws + WS_ACT)};
    PG8_RUN(EpiSwiGLU, ListOrder<MapMoe>, g, S, E);
}
__device__ __forceinline__ void ph_dn_fast(const Ctx& a, LAS unsigned char* lds, int layer) {
    unsigned char* ws = a.ws(); const int PM = (layer == 0 ? RPE0 : RPE1) / 256;
    pg8::Gemm g{(const bf16_t*)(ws + WS_ACT), (const bf16_t*)(ws + WS_WDN + (size_t)layer * WDN_LAYER), NE * PM * 256, NE * D, DE};
    const int Gq = layer == 0 ? gemm_groups(NE * PM * 4, (int)gridDim.x) : (int)gridDim.x;
    if ((int)blockIdx.x >= Gq) { cvt8_run(a, 1, CV1_DN0 + ((int)blockIdx.x - Gq), (int)gridDim.x - Gq, CV1_DN0 + CVQ_DN0, lds); return; }
    ListOrder<MapMoe> S{NE * PM * 4, Gq, (int)blockIdx.x, MapMoe{PM, 4}};
    EpiDown E{ws + WS_Y};
    PG8_RUN(EpiDown, ListOrder<MapMoe>, g, S, E);
}
#endif
__device__ __forceinline__ void ph_win_fast(const Ctx& a, LAS unsigned char* lds) {
    unsigned char* ws = a.ws();
    pg8::Gemm g{(const bf16_t*)(ws + WS_XN), (const bf16_t*)(ws + WS_WIN), RT, 2 * D, D};
    const int Gq = gemm_groups(512 + 32, (int)gridDim.x);
    if ((int)blockIdx.x >= Gq) { cvt8_run(a, 1, CV1_WIN + ((int)blockIdx.x - Gq), (int)gridDim.x - Gq, CV1_WIN + CVQ_WIN, lds); return; }
    ListOrder<MapWin> S{512 + 32, Gq, (int)blockIdx.x, MapWin{}};
    LAS float* bl = (LAS float*)(lds + ROPE_LDS);
    { const float* bg = a.in(I_BIN); for (int i = threadIdx.x; i < 2 * D; i += NTHREADS) bl[i] = bg[i]; }
    __syncthreads();
    EpiWin E{(bf16_t*)(ws + WS_YG), (bf16_t*)(ws + WS_XR), bl};
    stagger_start(STG_WIN);
    PG8_RUN(EpiWin, ListOrder<MapWin>, g, S, E);
    if (Gq == (int)gridDim.x) cvt8_tail(a, lds, 512 + 32, Gq, (int)blockIdx.x, 1, CV1_WIN, CVQ_WIN);
}

namespace fa {
using bf16x8 = __attribute__((ext_vector_type(8))) short;
using s16x4  = __attribute__((ext_vector_type(4))) short;
using f32x16 = __attribute__((ext_vector_type(16))) float;
using u32x4v = __attribute__((ext_vector_type(4))) unsigned;
constexpr int SHM_V = 64 * 128 * 2, SHM_K = 64 * 128 * 2;
#ifndef ATT_THR
#define ATT_THR 11.5f
#endif
constexpr float THR_L2 = ATT_THR;
#define KSWZ(row, colB) ((row) * 256 + ((colB) ^ (((row) & 7) << 4)))
#define SBAR() __builtin_amdgcn_sched_barrier(0)
__device__ __forceinline__ int crow(int r, int hi) { return (r & 3) + 8 * (r >> 2) + 4 * hi; }
__device__ __forceinline__ unsigned cvtpk(float lo, float hi) { unsigned r; asm volatile("v_cvt_pk_bf16_f32 %0, %1, %2" : "=v"(r) : "v"(lo), "v"(hi)); return r; }
__device__ __forceinline__ void partialSM(f32x16& p0, f32x16& p1, float& m_reg, float& mn, float& alpha) {
  float pmax = p0[0];
#pragma unroll
  for (int r = 1; r < 16; ++r) pmax = fmaxf(pmax, p0[r]);
#pragma unroll
  for (int r = 0; r < 16; ++r) pmax = fmaxf(pmax, p1[r]);
  { auto rr = __builtin_amdgcn_permlane32_swap(__float_as_uint(pmax), __float_as_uint(pmax), false, false);
    pmax = fmaxf(__uint_as_float(rr[0]), __uint_as_float(rr[1])); }
  if (__builtin_expect(__all(pmax - m_reg <= THR_L2), 1)) { mn = m_reg; alpha = 1.f; }
  else { mn = fmaxf(m_reg, pmax); alpha = __builtin_amdgcn_exp2f(m_reg - mn); m_reg = mn; }
  { typedef float f2_t __attribute__((ext_vector_type(2))); const f2_t mn2 = {mn, mn};
#pragma unroll
    for (int r = 0; r < 16; r += 2) { const f2_t a_ = (f2_t){p0[r], p0[r + 1]} - mn2; p0[r] = a_.x; p0[r + 1] = a_.y; const f2_t b_ = (f2_t){p1[r], p1[r + 1]} - mn2; p1[r] = b_.x; p1[r + 1] = b_.y; } }
#pragma unroll
  for (int r = 0; r < 16; ++r) p0[r] = __builtin_amdgcn_exp2f(p0[r]);
}
__device__ __forceinline__ void finishSM(f32x16& p0, f32x16& p1, float alpha, float& l_reg, bf16x8& pa0, bf16x8& pa1, bf16x8& pa2, bf16x8& pa3) {
#pragma unroll
  for (int r = 0; r < 16; ++r) p1[r] = __builtin_amdgcn_exp2f(p1[r]);
  float ps = 0;
#pragma unroll
  for (int r = 0; r < 16; ++r) ps += p0[r];
#pragma unroll
  for (int r = 0; r < 16; ++r) ps += p1[r];
  { auto rr = __builtin_amdgcn_permlane32_swap(__float_as_uint(ps), __float_as_uint(ps), false, false);
    ps = __uint_as_float(rr[0]) + __uint_as_float(rr[1]); }
  l_reg = l_reg * alpha + ps;
#define PK4(P, BASE, OUT) do { unsigned a0 = cvtpk(P[BASE + 0], P[BASE + 1]), a1 = cvtpk(P[BASE + 2], P[BASE + 3]);   \
    unsigned b0 = cvtpk(P[BASE + 4], P[BASE + 5]), b1 = cvtpk(P[BASE + 6], P[BASE + 7]);                              \
    auto r0 = __builtin_amdgcn_permlane32_swap(a0, b0, false, false); auto r1 = __builtin_amdgcn_permlane32_swap(a1, b1, false, false); \
    u32x4v w = {r0[0], r1[0], r0[1], r1[1]}; OUT = *reinterpret_cast<bf16x8*>(&w); } while (0)
  PK4(p0, 0, pa0); PK4(p0, 8, pa1); PK4(p1, 0, pa2); PK4(p1, 8, pa3);
#undef PK4
}
__device__ __forceinline__ void qkt(f32x16& p0, f32x16& p1, const LAS char* Ks, const bf16x8* qr, int r32, int hi, int s) {
  p0 = f32x16{}; p1 = f32x16{};
#pragma unroll
  for (int d0 = 0; d0 < 4; ++d0) { const int cb = (s * 64 + d0 * 16 + hi * 8) * 2;
    const bf16x8 b0 = *reinterpret_cast<const LAS bf16x8*>(Ks + KSWZ(r32, cb));
    const bf16x8 b1 = *reinterpret_cast<const LAS bf16x8*>(Ks + KSWZ(32 + r32, cb));
    p0 = __builtin_amdgcn_mfma_f32_32x32x16_bf16(b0, qr[d0], p0, 0, 0, 0);
    p1 = __builtin_amdgcn_mfma_f32_32x32x16_bf16(b1, qr[d0], p1, 0, 0, 0); }
}
__device__ __forceinline__ int v_st(int k, int c) { const int kk = (k & ~0xC) | ((k & 4) << 1) | ((k & 8) >> 1); return ((kk >> 3) * 4 + (c >> 5)) * 512 + ((kk & 7) * 32 + (c & 31)) * 2; }
__device__ __forceinline__ int v_rd_base(int lane) { return ((lane & 3) << 3) | (((lane >> 2) & 3) << 6) | (((lane >> 4) & 1) << 5) | (((lane >> 5) & 1) << 8); }
constexpr int v_rd_off(int d0, int ks, int half) { return d0 * 512 + ks * 4096 + half * 2048; }
template <int OFF> __device__ __forceinline__ s16x4 tr_read(int vb) {
  s16x4 r; asm volatile("ds_read_b64_tr_b16 %0, %1 offset:%2" : "=&v"(r) : "v"(vb), "i"(OFF) : "memory"); return r;
}
template <int D0> __device__ __forceinline__ void pv_one(f32x16& od, int vb, bf16x8 pa0, bf16x8 pa1, bf16x8 pa2, bf16x8 pa3) {
  const s16x4 l0 = tr_read<v_rd_off(D0, 0, 0)>(vb), h0 = tr_read<v_rd_off(D0, 0, 1)>(vb), l1 = tr_read<v_rd_off(D0, 1, 0)>(vb), h1 = tr_read<v_rd_off(D0, 1, 1)>(vb);
  const s16x4 l2 = tr_read<v_rd_off(D0, 2, 0)>(vb), h2 = tr_read<v_rd_off(D0, 2, 1)>(vb), l3 = tr_read<v_rd_off(D0, 3, 0)>(vb), h3 = tr_read<v_rd_off(D0, 3, 1)>(vb);
  asm volatile("s_waitcnt lgkmcnt(0)" ::: "memory"); SBAR();
#define PK(L, H) (bf16x8){L[0], L[1], L[2], L[3], H[0], H[1], H[2], H[3]}
  od = __builtin_amdgcn_mfma_f32_32x32x16_bf16(pa0, PK(l0, h0), od, 0, 0, 0);
  od = __builtin_amdgcn_mfma_f32_32x32x16_bf16(pa1, PK(l1, h1), od, 0, 0, 0);
  od = __builtin_amdgcn_mfma_f32_32x32x16_bf16(pa2, PK(l2, h2), od, 0, 0, 0);
  od = __builtin_amdgcn_mfma_f32_32x32x16_bf16(pa3, PK(l3, h3), od, 0, 0, 0);
#undef PK
}
__device__ __forceinline__ void pv_d0(f32x16* o, int vb, bf16x8 pa0, bf16x8 pa1, bf16x8 pa2, bf16x8 pa3) {
  pv_one<0>(o[0], vb, pa0, pa1, pa2, pa3); pv_one<1>(o[1], vb, pa0, pa1, pa2, pa3); pv_one<2>(o[2], vb, pa0, pa1, pa2, pa3); pv_one<3>(o[3], vb, pa0, pa1, pa2, pa3);
}

__device__ __forceinline__ int tile_row(bool latq, int b, int j) { return latq ? (j < 32 ? b * SEQ + 64 * j : RL + b * CTXL + 64 * (j - 32)) : RL + b * CTXL + 64 * j; }

__device__ __forceinline__ void attn_unit(const bf16_t* __restrict__ Qg, const bf16_t* __restrict__ Kg, const bf16_t* __restrict__ Vg, bf16_t* __restrict__ ATT,
                                          const float* subg, float lam, bool latq, int b, int h, int qrow0, LAS unsigned char* lds) {
  const int tid = threadIdx.x, wid = __builtin_amdgcn_readfirstlane(tid >> 6), lane = tid & 63, r32 = lane & 31, hi = lane >> 5, rg = wid >> 1, s = wid & 1;
  LAS char* V_lds = (LAS char*)lds; LAS char* K_lds = (LAS char*)lds + 2 * SHM_V;
  LAS float* ws = (LAS float*)(lds + 65536) + wid * 64; LAS float* li_l = ws; LAS float* al_l = ws + 32;
  const int NT = latq ? 36 : 4;
  float m_reg = -1e30f, l_reg = 0; f32x16 o[4] = {}; bf16x8 qr[4];
  const bf16_t* Qw = Qg + (size_t)(qrow0 + rg * 32 + r32) * D + h * 128 + s * 64 + hi * 8;
#pragma unroll
  for (int d0 = 0; d0 < 4; ++d0) qr[d0] = *reinterpret_cast<const bf16x8*>(Qw + d0 * 16);
  const int sr = tid >> 4, sc = (tid & 15) * 8, vst0 = v_st(sr, sc), vst1 = v_st(32 + sr, sc);
  const int vb0 = (int)(unsigned)(size_t)V_lds + v_rd_base(lane);
  const size_t hoff = (size_t)h * 128 + sc;
  struct { bf16x8 vs0, vs1, ks0, ks1; } sr_[2];
#define SLOAD(i, j) do { const size_t ro_ = (size_t)(tile_row(latq, b, (j)) + sr) * D + hoff; \
    sr_[i].vs0 = *reinterpret_cast<const bf16x8*>(Vg + ro_); sr_[i].vs1 = *reinterpret_cast<const bf16x8*>(Vg + ro_ + 32 * D); \
    sr_[i].ks0 = *reinterpret_cast<const bf16x8*>(Kg + ro_); sr_[i].ks1 = *reinterpret_cast<const bf16x8*>(Kg + ro_ + 32 * D); } while (0)
#define SWRITE(bb, i) do { *(LAS bf16x8*)(V_lds + (bb) * SHM_V + vst0) = sr_[i].vs0; *(LAS bf16x8*)(V_lds + (bb) * SHM_V + vst1) = sr_[i].vs1; const int kc = sc * 2; \
    *(LAS bf16x8*)(K_lds + (bb) * SHM_K + KSWZ(sr, kc)) = sr_[i].ks0; *(LAS bf16x8*)(K_lds + (bb) * SHM_K + KSWZ(32 + sr, kc)) = sr_[i].ks1; } while (0)
#define SWAIT() asm volatile("s_waitcnt vmcnt(4)" ::: "memory")
#define RESC(a_) do { if (__any((a_) < 1.f)) { if (hi == 0) al_l[r32] = (a_); asm volatile("s_waitcnt lgkmcnt(0)" ::: "memory"); \
    _Pragma("unroll") for (int d = 0; d < 4; ++d) _Pragma("unroll") for (int r = 0; r < 16; ++r) o[d][r] *= al_l[crow(r, hi)]; } } while (0)
  f32x16 pA0, pA1, pB0, pB1; float mnA, mnB, alA, alB; bf16x8 pa0, pa1, pa2, pa3;
  constexpr int SE = 0, SO = 1;
  SLOAD(SE, 0); asm volatile("s_waitcnt vmcnt(0)" ::: "memory"); SWRITE(0, SE); __syncthreads();
  qkt(pA0, pA1, K_lds, qr, r32, hi, s); partialSM(pA0, pA1, m_reg, mnA, alA);
  SLOAD(SO, 1); if (2 < NT) SLOAD(SE, 2);
  SWAIT(); SWRITE(1, SO); __syncthreads();
  for (int j = 1; j + 1 < NT; j += 2) {
    SBAR(); qkt(pB0, pB1, K_lds + SHM_K, qr, r32, hi, s);
    finishSM(pA0, pA1, alA, l_reg, pa0, pa1, pa2, pa3); SBAR();
    SLOAD(SO, j + 2); SBAR();
    pv_d0(o, vb0, pa0, pa1, pa2, pa3); partialSM(pB0, pB1, m_reg, mnB, alB);
    __syncthreads(); SWAIT(); SWRITE(0, SE);
    RESC(alB); __syncthreads();
    SBAR(); qkt(pA0, pA1, K_lds, qr, r32, hi, s);
    finishSM(pB0, pB1, alB, l_reg, pa0, pa1, pa2, pa3); SBAR();
    if (j + 3 < NT) SLOAD(SE, j + 3); SBAR();
    pv_d0(o, vb0 + SHM_V, pa0, pa1, pa2, pa3); partialSM(pA0, pA1, m_reg, mnA, alA);
    __syncthreads(); SWAIT(); SWRITE(1, SO);
    RESC(alA); __syncthreads();
  }
  SBAR(); qkt(pB0, pB1, K_lds + SHM_K, qr, r32, hi, s);
  finishSM(pA0, pA1, alA, l_reg, pa0, pa1, pa2, pa3); SBAR();
  pv_d0(o, vb0, pa0, pa1, pa2, pa3); partialSM(pB0, pB1, m_reg, mnB, alB);
  __syncthreads(); RESC(alB);
  finishSM(pB0, pB1, alB, l_reg, pa0, pa1, pa2, pa3); SBAR();
  pv_d0(o, vb0 + SHM_V, pa0, pa1, pa2, pa3);
#undef SLOAD
#undef SWRITE
#undef SWAIT
#undef RESC
  if (hi == 0) li_l[r32] = l_reg;
  asm volatile("s_waitcnt lgkmcnt(0)" ::: "memory");
  float rli[16];
#pragma unroll
  for (int r = 0; r < 16; ++r) rli[r] = __builtin_amdgcn_rcpf(li_l[crow(r, hi)]);
  __syncthreads();
  LAS float* X = (LAS float*)lds + rg * 4096;
  if (s == 1) {
#pragma unroll
    for (int r = 0; r < 16; ++r)
#pragma unroll
      for (int d0 = 0; d0 < 4; ++d0) X[crow(r, hi) * 128 + d0 * 32 + r32] = o[d0][r] * (rli[r] * lam);
  }
  __syncthreads();
  if (s == 0) {
    float rstd[16];
#pragma unroll
    for (int r = 0; r < 16; ++r) {
      float acc = 0.f;
#pragma unroll
      for (int d0 = 0; d0 < 4; ++d0) { const float v = o[d0][r] * rli[r] - X[crow(r, hi) * 128 + d0 * 32 + r32]; o[d0][r] = v; acc += v * v; }
#pragma unroll
      for (int off = 1; off < 32; off <<= 1) acc += __shfl_xor(acc, off);
      rstd[r] = 1.0f / sqrtf(acc * (1.0f / 128.0f) + EPS);
    }
    LAS bf16_t* stg = (LAS bf16_t*)(lds + 65536 + 2048) + rg * 4096;
    float gsc[4];
#pragma unroll
    for (int d0 = 0; d0 < 4; ++d0) gsc[d0] = subg[d0 * 32 + r32] * (1.0f - LAMBDA_INIT0);
#pragma unroll
    for (int r = 0; r < 16; ++r)
#pragma unroll
      for (int d0 = 0; d0 < 4; ++d0) stg[crow(r, hi) * 128 + d0 * 32 + r32] = (bf16_t)f2bf(o[d0][r] * rstd[r] * gsc[d0]);
    asm volatile("s_waitcnt lgkmcnt(0)" ::: "memory");
    bf16_t* Ow = ATT + (size_t)(qrow0 + rg * 32) * D + h * 128;
#pragma unroll
    for (int i = 0; i < 8; ++i) { const int row = i * 4 + (lane >> 4), ch = lane & 15; const u32x4v v = *(const LAS u32x4v*)(stg + row * 128 + ch * 8); *(u32x4v*)(Ow + (size_t)row * D + ch * 8) = v; }
  }
  __syncthreads();
}
#undef KSWZ
#undef SBAR
}

__device__ __forceinline__ void ph_attn_fast(const Ctx& a, LAS unsigned char* lds) {
    unsigned char* ws = a.ws();
    const bf16_t* Q = (const bf16_t*)(ws + WS_Q); const bf16_t* Kb = (const bf16_t*)(ws + WS_K); const bf16_t* V = (const bf16_t*)(ws + WS_V);
    bf16_t* ATT = (bf16_t*)(ws + WS_ATT); const float* subg = a.in(I_SUBG);
    const float lam = diff_lambda(a, threadIdx.x & 63);
    const int G = gridDim.x, c = blockIdx.x;
    for (int i = 0;; ++i) {
        const long L = (long)i * G + c; if (L >= 1024) break;
        const int w = xcd_remap(L, 1024), bh = w >> 4, qb = w & 15, b = bh >> 3, h = bh & 7;
        fa::attn_unit(Q, Kb, V, ATT, subg, lam, true, b, h, b * SEQ + qb * 128, lds);
    }
    for (int L = c; L < 128; L += G) {
        const int bh = L >> 1, qb = L & 1, b = bh >> 3, h = bh & 7;
        fa::attn_unit(Q, Kb, V, ATT, subg, lam, false, b, h, RL + b * CTXL + qb * 128, lds);
    }
#if DENSE_LATE && ANY_FAST_GEMM
    if (c >= 128 && G > 128) { for (int r = c - 128; r < IT_DENSE_REST; r += G - 128) cvt_dense_rest_item(a, r); }
#endif
#if CVT_HIDE && FP8_MOE
    if (c >= 128 && G > 128) { __syncthreads(); cvt8_run(a, 0, CV0_ATT + (c - 128), G - 128, CV0_ATT + CVQ_ATT, lds); }
#endif
}


__device__ __forceinline__ void ph_gates_fast(const Ctx& a, LAS unsigned char* lds) {
    unsigned char* ws = a.ws();
    const bf16_t* XR = (const bf16_t*)(ws + WS_XR); const bf16_t* WG = (const bf16_t*)(ws + WS_WG);
    bf16_t* LOGA = (bf16_t*)(ws + WS_LOGA); unsigned char* BT = ws + WS_BT;
    const float* convw = a.in(I_CONVW); const float* convb = a.in(I_CONVB); const float* gtab = (const float*)(ws + WS_GTAB);
    const int tid = threadIdx.x, wid = __builtin_amdgcn_readfirstlane(tid >> 6), lane = tid & 63, wr = wid >> 2, wc = wid & 3, fr = lane & 15, fq = lane >> 4;
    constexpr int HTB = pg8::HTB;
    const int aoff = pg8::lds_byte(wr * 64 + fr, fq * 8), boff = pg8::lds_byte(wc * 32 + fr, fq * 8);
    const int sc = tid & 15, rg8 = tid >> 4;
    unsigned bsrc[2];
#pragma unroll
    for (int i = 0; i < 2; ++i) { int R, C; pg8::stage_rc(tid * 16 + i * 8192, R, C); bsrc[i] = (unsigned)(((R & ~31) + pg8::perm32(R & 31)) * 128 + C) * 2u; }
    const unsigned ldsw = (unsigned)wid * 1024u;
#define GT_DMA_B(d_) do { const char* wb_ = (const char*)(WG + (size_t)((d_) * 8 + kb) * 256 * 128); \
        _Pragma("unroll") for (int kt_ = 0; kt_ < 2; ++kt_) _Pragma("unroll") for (int h_ = 0; h_ < 2; ++h_) _Pragma("unroll") for (int i_ = 0; i_ < 2; ++i_) \
            __builtin_amdgcn_global_load_lds((const unsigned*)(wb_ + (size_t)h_ * 128 * 256 + kt_ * 128 + bsrc[i_]), (LAS unsigned*)(lds + (4 + kt_ * 2 + h_) * HTB + ldsw + i_ * 8192), 16, 0, 0); } while (0)
    const int Gq = gemm_groups(72 * 8, (int)gridDim.x);
    if ((int)blockIdx.x >= Gq) { cvt8_run(a, 1, CV1_GATES + ((int)blockIdx.x - Gq), (int)gridDim.x - Gq, CV1_GATES + CVQ_GATES, lds); return; }
    for (int u = blockIdx.x; u < 72 * 8; u += Gq) {
        const int kb = u & 7, rt = u >> 3;
        const bool lat = rt < 64; const int bsm = lat ? (rt >> 3) : (rt - 64), t0 = lat ? (rt & 7) * 256 : 0, L = lat ? SEQ : CTXL;
        const int seqbase = lat ? bsm * SEQ : RL + bsm * CTXL;
        GT_DMA_B(0);
        {
            const int ch0 = kb * 128 + sc * 8, r0 = rg8 * 8;
            u32x4 xin[11];
#pragma unroll
            for (int i = 0; i < 11; ++i) { const int tt = t0 + r0 - 2 + i; xin[i] = (tt >= 0 && tt < L) ? *(const u32x4*)(XR + (size_t)(seqbase + tt) * D + ch0) : (u32x4){0u, 0u, 0u, 0u}; }
            f32x4 cw[4][2], cb[2];
#pragma unroll
            for (int j = 0; j < 4; ++j) { cw[j][0] = *(const f32x4*)(convw + j * D + ch0); cw[j][1] = *(const f32x4*)(convw + j * D + ch0 + 4); }
            cb[0] = *(const f32x4*)(convb + ch0); cb[1] = *(const f32x4*)(convb + ch0 + 4);
#pragma unroll
            for (int k = 0; k < 8; ++k) {
                f32x4 o0 = cb[0], o1 = cb[1];
#pragma unroll
                for (int j = 0; j < 4; ++j) { const u32x4 x = xin[k + j];
                    o0 += cw[j][0] * (f32x4){bf_lo(x.x), bf_hi(x.x), bf_lo(x.y), bf_hi(x.y)}; o1 += cw[j][1] * (f32x4){bf_lo(x.z), bf_hi(x.z), bf_lo(x.w), bf_hi(x.w)}; }
                const int r = r0 + k;
                u32x4 w; w.x = pk2(o0[0], o0[1]); w.y = pk2(o0[2], o0[3]); w.z = pk2(o1[0], o1[1]); w.w = pk2(o1[2], o1[3]);
                *(LAS u32x4*)(lds + ((sc >> 3) * 2 + (r >> 7)) * HTB + pg8::lds_byte(r & 127, (sc & 7) * 8)) = w;
            }
        }
#pragma unroll 1
        for (int d = 0; d < 2; ++d) {
            asm volatile("s_waitcnt vmcnt(0)" ::: "memory");
            __syncthreads();
            pf4 acc[2][2][4][2];
#pragma unroll
            for (int ai = 0; ai < 2; ++ai)
#pragma unroll
                for (int bj = 0; bj < 2; ++bj)
#pragma unroll
                    for (int m = 0; m < 4; ++m)
#pragma unroll
                        for (int n = 0; n < 2; ++n) acc[ai][bj][m][n] = (pf4){0.f, 0.f, 0.f, 0.f};
#pragma unroll 1
            for (int kt = 0; kt < 2; ++kt)
#pragma unroll
                for (int ai = 0; ai < 2; ++ai) {
                    __builtin_amdgcn_sched_barrier(0);
                    pg8::bf16x8 At[4][2];
#pragma unroll
                    for (int m = 0; m < 4; ++m)
#pragma unroll
                        for (int k = 0; k < 2; ++k) At[m][k] = *(const LAS pg8::bf16x8*)(lds + (kt * 2 + ai) * HTB + aoff + m * 2048 + k * 1024);
#pragma unroll
                    for (int bj = 0; bj < 2; ++bj) {
                        pg8::bf16x8 Bf[2][2];
#pragma unroll
                        for (int n = 0; n < 2; ++n)
#pragma unroll
                            for (int k = 0; k < 2; ++k) Bf[n][k] = *(const LAS pg8::bf16x8*)(lds + (4 + kt * 2 + bj) * HTB + boff + n * 2048 + k * 1024);
#pragma unroll
                        for (int m = 0; m < 4; ++m)
#pragma unroll
                            for (int n = 0; n < 2; ++n)
#pragma unroll
                                for (int k = 0; k < 2; ++k) acc[ai][bj][m][n] = __builtin_amdgcn_mfma_f32_16x16x32_bf16(Bf[n][k], At[m][k], acc[ai][bj][m][n], 0, 0, 0);
                        __builtin_amdgcn_sched_barrier(0);
                    }
                }
            if (d == 0) { __syncthreads(); GT_DMA_B(1); }
            const int cc0 = wc * 32 + fq * 8;
            pf4 cl[2], c2[2], brn[2], bin[2];
#pragma unroll
            for (int n = 0; n < 2; ++n) { const float* g = gtab + (size_t)(d * 4) * D + kb * 128 + cc0 + 4 * n;
                cl[n] = *(const pf4*)g; c2[n] = *(const pf4*)(g + D); brn[n] = *(const pf4*)(g + 2 * D); bin[n] = *(const pf4*)(g + 3 * D); }
#pragma unroll
            for (int ai = 0; ai < 2; ++ai)
#pragma unroll
                for (int m = 0; m < 4; ++m) {
                    const int rl = wr * 64 + m * 16 + fr;
                    const int grow = seqbase + t0 + ai * 128 + rl;
                    float la[8], bt[8];
#pragma unroll
                    for (int n = 0; n < 2; ++n) {
                        const int cc = cc0 + 4 * n;
                        const u32x2 xw = *(const LAS u32x2*)(lds + ((cc >> 6) * 2 + ai) * HTB + pg8::lds_byte(rl, cc & 63));
                        const float xv[4] = {bf_lo(xw.x), bf_hi(xw.x), bf_lo(xw.y), bf_hi(xw.y)};
#pragma unroll
                        for (int j = 0; j < 4; ++j) {
                            const float r = __builtin_amdgcn_rcpf(1.0f + __builtin_amdgcn_exp2f(fmaf(acc[ai][0][m][n][j], -1.4426950408889634f, brn[n][j])));
                            const float ig = __builtin_amdgcn_rcpf(1.0f + __builtin_amdgcn_exp2f(fmaf(acc[ai][1][m][n][j], -1.4426950408889634f, bin[n][j])));
                            const float om = 1.0f - __builtin_amdgcn_exp2f(r * c2[n][j]);
                            la[n * 4 + j] = r * cl[n][j]; bt[n * 4 + j] = __builtin_amdgcn_sqrtf(om) * (ig * xv[j]) * BT_SCALE;
                        }
                    }
                    const size_t o = ((size_t)d * RT + grow) * D + kb * 128 + cc0;
                    u32x4 w; w.x = pk2(la[0], la[1]); w.y = pk2(la[2], la[3]); w.z = pk2(la[4], la[5]); w.w = pk2(la[6], la[7]);
                    *(u32x4*)(LOGA + o) = w;
                    u32x2 wb; wb.x = pk4_fp8(bt[0], bt[1], bt[2], bt[3]); wb.y = pk4_fp8(bt[4], bt[5], bt[6], bt[7]);
                    *(u32x2*)(BT + o) = wb;
                }
        }
#if FUSE_SCAN1
        asm volatile("s_waitcnt vmcnt(0)" ::: "memory");
        __syncthreads();
        {
            const int dir = wid >> 2, lc = wid & 3, kc = (t0 >> 6) + lc;
            const int c = dir == 0 ? (lat ? NCH_CTX + kc : kc) : (lat ? NCH - 1 - kc : NCH_CTX - 1 - kc);
            const int ch = kb * 128 + 2 * lane;
            float* CP = (float*)(ws + WS_CP); float* CB = (float*)(ws + WS_CB);
            float h0 = 0.f, h1 = 0.f, p0 = 0.f, p1 = 0.f;
#pragma unroll 1
            for (int sg = 0; sg < SCH; sg += 32) {
                unsigned la[32], bt[32];
#pragma unroll
                for (int i = 0; i < 32; ++i) { const size_t o = ((size_t)dir * RT + scan_row(bsm, dir, c, sg + i)) * D + ch; la[i] = *(const unsigned*)(LOGA + o); bt[i] = *(const unsigned short*)(BT + o); }
                asm volatile("" ::: "memory");
#pragma unroll
                for (int i = 0; i < 32; ++i) { const float l0 = bf_lo(la[i]), l1 = bf_hi(la[i]); const f32x2 bb = __builtin_amdgcn_cvt_pk_f32_fp8((int)bt[i], false);
                    h0 = __builtin_amdgcn_exp2f(l0) * h0 + bb.x; h1 = __builtin_amdgcn_exp2f(l1) * h1 + bb.y; p0 += l0; p1 += l1; }
            }
            const size_t so = ((size_t)(bsm * 2 + dir) * NCH + c) * D + ch;
            *(f32x2*)(CP + so) = (f32x2){p0, p1}; *(f32x2*)(CB + so) = (f32x2){h0, h1};
        }
#endif
        __syncthreads();
    }
#undef GT_DMA_B
    if (Gq == (int)gridDim.x) cvt8_tail(a, lds, 72 * 8, Gq, (int)blockIdx.x, 1, CV1_GATES, CVQ_GATES);
}

constexpr int NPHASES = 25;
__host__ __device__ constexpr bool phase_enabled(int p) {
    return !((p == 3 && FAST_QKV) || (p == 9 && FAST_GU) || (p == 22 && FAST_GU) || (p == 13 && FAST_GATES) || (p == 15 && FAST_GATES) || (p == 16 && FAST_GATES && FUSE_SCAN1));
}

__global__ void __launch_bounds__(NTHREADS, 2) hybrid_fwd(Args args) {
    extern __shared__ __attribute__((aligned(16))) unsigned char lds_raw[];
    LAS unsigned char* lds = (LAS unsigned char*)lds_raw;
    volatile LAS unsigned* MISC = (volatile LAS unsigned*)(lds + MISC_OFF);
    const int lo = args.ph_lo, hi = args.ph_hi;
    if (threadIdx.x == 0) {
        LAS unsigned long long* la64 = (LAS unsigned long long*)(lds + ARGS_OFF);
#pragma unroll
        for (int i = 0; i < 27; ++i) la64[i] = (unsigned long long)args.in[i];
        la64[27] = (unsigned long long)args.out; la64[28] = (unsigned long long)args.ws;
    }
    Ctx ctx; ctx.la = (const LAS unsigned*)(lds + ARGS_OFF);
    if (threadIdx.x < 16) MISC[threadIdx.x] = 0u;
    __syncthreads();
#if MK_ONE_LAUNCH
    XcdBarrier bar = xcd_barrier_post((unsigned*)(ctx.ws() + WS_CTL) + CW_BAR, MISC + 8);
#define GRID_BAR() xcd_barrier(bar)
#else
#define GRID_BAR() do { } while (0)
#endif
#ifndef REP_MASK
#define REP_MASK 0u
#endif
#define RUN(k, call) do { call; if constexpr (((REP_MASK) >> (k)) & 1u) { __syncthreads(); call; } } while (0)
#define IN(k) (lo <= (k) && (k) < hi)
#define SEAM(k) do { if ((k) + 1 < hi) GRID_BAR(); } while (0)

    if (IN(0)) { RUN(0, ph_prologue(ctx, lds)); SEAM(0); }
    if (IN(1)) { RUN(1, ph_norm1_l0(ctx)); SEAM(1); }
    if (IN(2)) {
#if FAST_QKV
        RUN(2, ph_qkv_fast(ctx, lds));
#else
        RUN(2, ph_qkv_naive(ctx, lds));
#endif
        SEAM(2); }
#if !FAST_QKV
    if (IN(3)) { RUN(3, ph_rope_naive(ctx)); SEAM(3); }
#endif
    if (IN(4)) {
#if FAST_ATTN
        RUN(4, ph_attn_fast(ctx, lds));
#else
        RUN(4, ph_attn_naive(ctx, lds));
#endif
        SEAM(4); }
    if (IN(5)) {
#if FAST_WO
        RUN(5, ph_wo_fast(ctx, lds));
#else
        RUN(5, ph_wo_naive(ctx, lds));
#endif
        SEAM(5); }
    if (IN(6)) { RUN(6, ph_norm2_router(ctx, lds, 0, RT)); SEAM(6); }
    if (IN(7)) { RUN(7, ph_topk_gather(ctx, lds, 0)); SEAM(7); }
    if (IN(8)) {
#if FAST_GU
        RUN(8, ph_gu_fast(ctx, lds, 0));
#else
        RUN(8, ph_gu_naive(ctx, lds, 0));
#endif
        SEAM(8); }
#if !FAST_GU
    if (IN(9)) { RUN(9, ph_swiglu_naive(ctx, 0)); SEAM(9); }
#endif
    if (IN(10)) {
#if FAST_DN
        RUN(10, ph_dn_fast(ctx, lds, 0));
#else
        RUN(10, ph_dn_naive(ctx, lds, 0));
#endif
        SEAM(10); }
    if (IN(11)) { RUN(11, ph_combine<0>(ctx, 0, RT)); SEAM(11); }
    if (IN(12)) {
#if FAST_WIN
        RUN(12, ph_win_fast(ctx, lds));
#else
        RUN(12, ph_win_naive(ctx, lds));
#endif
        SEAM(12); }
#if !FAST_GATES
    if (IN(13)) { RUN(13, ph_conv_naive(ctx)); SEAM(13); }
#endif
    if (IN(14)) {
#if FAST_GATES
        RUN(14, ph_gates_fast(ctx, lds));
#else
        RUN(14, ph_gates_naive(ctx, lds));
#endif
        SEAM(14); }
#if !FAST_GATES
    if (IN(15)) { RUN(15, ph_gate_elem_naive(ctx)); SEAM(15); }
#endif
#if !(FUSE_SCAN1 && FAST_GATES)
    if (IN(16)) { RUN(16, ph_scan1(ctx)); SEAM(16); }
#endif
    if (IN(17)) { RUN(17, ph_scan2(ctx)); SEAM(17); }
    if (IN(18)) {
#if FAST_WOUT
        RUN(18, ph_wout_fast(ctx, lds));
#else
        RUN(18, ph_wout_naive(ctx, lds));
#endif
        SEAM(18); }
    if (IN(19)) { RUN(19, ph_norm2_router(ctx, lds, 1, RL)); SEAM(19); }
    if (IN(20)) { RUN(20, ph_topk_gather(ctx, lds, 1)); SEAM(20); }
    if (IN(21)) {
#if FAST_GU
        RUN(21, ph_gu_fast(ctx, lds, 1));
#else
        RUN(21, ph_gu_naive(ctx, lds, 1));
#endif
        SEAM(21); }
#if !FAST_GU
    if (IN(22)) { RUN(22, ph_swiglu_naive(ctx, 1)); SEAM(22); }
#endif
    if (IN(23)) {
#if FAST_DN
        RUN(23, ph_dn_fast(ctx, lds, 1));
#else
        RUN(23, ph_dn_naive(ctx, lds, 1));
#endif
        SEAM(23); }
    if (IN(24)) { RUN(24, ph_combine<1>(ctx, 1, RL)); }
#undef IN
#undef SEAM
#undef GRID_BAR
}

extern "C" void kernel_launch(void* const* d_in, const int* in_sizes, int n_in, void* d_out, int out_size, void* d_ws, size_t ws_size, hipStream_t stream) {
    static int grid = 0;
    if (grid == 0) {
        if (n_in != 27 || out_size != RL * D || ws_size < WS_END) { fprintf(stderr, "kernel_launch: unexpected shapes (n_in %d out %d ws %zu)\n", n_in, out_size, ws_size); grid = -1; return; }
        int dev = 0, cus = 0, per_cu = 0;
        if (hipGetDevice(&dev) != hipSuccess || hipDeviceGetAttribute(&cus, hipDeviceAttributeMultiprocessorCount, dev) != hipSuccess) { grid = -1; return; }
        if (hipFuncSetAttribute((const void*)hybrid_fwd, hipFuncAttributeMaxDynamicSharedMemorySize, LDS_BYTES) != hipSuccess) { fprintf(stderr, "kernel_launch: hipFuncSetAttribute failed\n"); grid = -1; return; }
        if (hipOccupancyMaxActiveBlocksPerMultiprocessor(&per_cu, (const void*)hybrid_fwd, NTHREADS, LDS_BYTES) != hipSuccess || per_cu < 1) { fprintf(stderr, "kernel_launch: occupancy query says %d\n", per_cu); }
        (void)hipGetLastError();
        grid = cus > 0 ? cus : 256;
    }
    if (grid < 0) return;
    if (hipMemsetAsync((char*)d_ws + WS_CTL, 0, CTL_ZERO_BYTES, stream) != hipSuccess) return;
    Args a{};
    for (int i = 0; i < 27; ++i) a.in[i] = (const float*)d_in[i];
    a.out = (float*)d_out; a.ws = (unsigned char*)d_ws;
#if MK_ONE_LAUNCH
    a.ph_lo = 0; a.ph_hi = NPHASES;
    hipLaunchKernelGGL(hybrid_fwd, dim3(grid), dim3(NTHREADS), LDS_BYTES, stream, a);
#else
    for (int p = 0; p < NPHASES; ++p) {
        if (!phase_enabled(p)) continue;
        a.ph_lo = p; a.ph_hi = p + 1;
        hipLaunchKernelGGL(hybrid_fwd, dim3(grid), dim3(NTHREADS), LDS_BYTES, stream, a);
    }
#endif
    const hipError_t le = hipPeekAtLastError();
    if (le != hipSuccess) fprintf(stderr, "kernel_launch: launch failed: %s\n", hipGetErrorName(le));
}
```

```cpp
#define MK_ONE_LAUNCH 1
#define FAST_QKV 1
#define FAST_WO 1
#define FAST_GU 1
#define FAST_DN 1
#define FAST_WIN 1
#define FAST_WOUT 1
#define FAST_ATTN 1
#define FAST_GATES 1
#define FP8_MOE 1
#define CVQ_TK0 512
#define ATT_CVB 0
#define DED_MASK 62
#define CVQ_GU0L0 256
#define CVQ_GU0 160
#define CVQ_GATES 1536
#define CVQ_TK1 256
#define CVQ_WIN 1024
#define CVQ_DN0 1248
#define CVQ_WO 1920
#define TK_HANDOFF 1
#include <hip/hip_runtime.h>
#include <cstdio>
#include <cstdint>
#include <cmath>

#ifndef MK_ONE_LAUNCH
#define MK_ONE_LAUNCH 0
#endif
#ifndef FAST_QKV
#define FAST_QKV 0
#endif
#ifndef FAST_ATTN
#define FAST_ATTN 0
#endif
#ifndef FAST_WO
#define FAST_WO 0
#endif
#ifndef FAST_GU
#define FAST_GU 0
#endif
#ifndef FAST_DN
#define FAST_DN 0
#endif
#ifndef FAST_WIN
#define FAST_WIN 0
#endif
#ifndef FAST_GATES
#define FAST_GATES 0
#endif
#ifndef FAST_WOUT
#define FAST_WOUT 0
#endif
#ifndef FP8_MOE
#define FP8_MOE 0
#endif
#ifndef GU_ALIGN
#define GU_ALIGN true
#endif
#ifndef DN_ALIGN
#define DN_ALIGN true
#endif
#ifndef FUSE_SCAN1
#define FUSE_SCAN1 1
#endif
#ifndef GU_GATHER
#define GU_GATHER 1
#endif
#define ANY_FAST_GEMM (FAST_QKV || FAST_WO || FAST_GU || FAST_DN || FAST_WIN || FAST_GATES || FAST_WOUT)

namespace pg8 {
#define PG8_LAS __attribute__((address_space(3)))
typedef unsigned short bf16_t;
typedef short bf16x8 __attribute__((ext_vector_type(8)));
typedef float f32x4 __attribute__((ext_vector_type(4)));
typedef unsigned u32x4 __attribute__((ext_vector_type(4)));
constexpr int BM = 256, BK = 64, HALF = 128, HTB = HALF * BK * 2  , STAGE_BYTES = 8 * HTB, NXCD = 8, WGM = 8;

__host__ __device__ __forceinline__ int lds_byte(int r, int c) { const int st = (r >> 4) * 2 + (c >> 5), rr = r & 15, cc = c & 31, ob = rr * 64 + cc * 2; return st * 1024 + (ob ^ (((ob >> 9) & 1) << 5)); }
__host__ __device__ __forceinline__ void stage_rc(int b, int& R, int& C) { const int st = b / 1024, sb = b % 1024, swz = sb ^ (((sb >> 9) & 1) << 5); R = (st >> 1) * 16 + swz / 64; C = (st & 1) * 32 + (swz % 64) / 2; }
__host__ __device__ __forceinline__ int perm32(int rho) { const int n = rho >> 4, i = rho & 15; return 8 * (i >> 2) + 4 * n + (i & 3); }

struct Unit { int pm, pn; };
struct Gemm { const bf16_t* A; const bf16_t* Bt; int M, N, K; const int* arow; const unsigned* acnt; int aneed, apm; };
__device__ __forceinline__ unsigned cvt_pk_bf16(float lo, float hi) { unsigned r; asm volatile("v_cvt_pk_bf16_f32 %0, %1, %2" : "=v"(r) : "v"(lo), "v"(hi)); return r; }
typedef int v4i_t __attribute__((ext_vector_type(4)));
typedef int v8i_t __attribute__((ext_vector_type(8)));
__device__ __forceinline__ v8i_t cat8(bf16x8 lo, bf16x8 hi) { const v4i_t a = __builtin_bit_cast(v4i_t, lo), b = __builtin_bit_cast(v4i_t, hi); return __builtin_shufflevector(a, b, 0, 1, 2, 3, 4, 5, 6, 7); }
template <class Epi, class Sched, bool ALIGN_EPI = false, bool SP2 = false, int FP8SCALE = 0  , bool GATHER = false  >
__device__ __forceinline__ void gemm_phase(PG8_LAS unsigned char* lds, const Gemm g, const Sched& S, const Epi& E) {
    const int tid = threadIdx.x, wid = __builtin_amdgcn_readfirstlane(tid >> 6), lane = tid & 63, wr = wid >> 2, wc = wid & 3, fr = lane & 15, fq = lane >> 4;
    const int K = g.K, nt = K / BK;
    unsigned voffA[2], voffB[2];
#pragma unroll
    for (int i = 0; i < 2; ++i) { int R, C; stage_rc(tid * 16 + i * 8192, R, C); const int Rb = Epi::PERM ? ((R & ~31) + perm32(R & 31)) : R;
        voffA[i] = (unsigned)(R * K + C) * 2u; voffB[i] = (unsigned)(Rb * K + C) * 2u; }
    const size_t kstep = (size_t)(BK * 2);
    const size_t hstep = (size_t)HALF * K * 2;
    const size_t tstep = 2 * hstep;
    const unsigned ldsw = (unsigned)wid * 1024u;
    const int aoff = lds_byte(wr * 64 + fr, fq * 8), boff = lds_byte(wc * 32 + fr, fq * 8);
#define PG8_SA(b, h) (((b) * 2 + (h)) * HTB)
#define PG8_SB(b, h) ((4 + (b) * 2 + (h)) * HTB)
#ifndef PG8_B_AUX
#define PG8_B_AUX 0
#endif
#define PG8_STAGE(bufoff, gbase, voff) do { _Pragma("unroll") for (int _i = 0; _i < 2; ++_i) { \
        if constexpr (FP8SCALE != 0 && PG8_B_AUX != 0) { if ((bufoff) >= 4 * HTB) __builtin_amdgcn_global_load_lds((const unsigned*)((const char*)(gbase) + (voff)[_i]), (PG8_LAS unsigned*)(lds + (bufoff) + ldsw + _i * 8192), 16, 0, PG8_B_AUX); \
            else __builtin_amdgcn_global_load_lds((const unsigned*)((const char*)(gbase) + (voff)[_i]), (PG8_LAS unsigned*)(lds + (bufoff) + ldsw + _i * 8192), 16, 0, 0); } \
        else __builtin_amdgcn_global_load_lds((const unsigned*)((const char*)(gbase) + (voff)[_i]), (PG8_LAS unsigned*)(lds + (bufoff) + ldsw + _i * 8192), 16, 0, 0); } } while (0)
#define PG8_STAGE_A(bufoff, base, vo, h) do { if constexpr (GATHER) PG8_STAGE(bufoff, base, vo[h]); else PG8_STAGE(bufoff, (base) + (h) * hstep, voffA); } while (0)
#define PG8_LDA(dst, b, h) do { if constexpr (FP8SCALE == 0) { _Pragma("unroll") for (int m = 0; m < 4; ++m) _Pragma("unroll") for (int k = 0; k < 2; ++k) dst[m][k] = *(const PG8_LAS bf16x8*)(lds + PG8_SA(b, h) + aoff + m * 2048 + k * 1024); } \
        else { _Pragma("unroll") for (int m = 0; m < 4; ++m) { const v4i_t lo_ = *(const PG8_LAS v4i_t*)(lds + PG8_SA(b, h) + aoff + m * 2048), hi_ = *(const PG8_LAS v4i_t*)(lds + PG8_SA(b, h) + aoff + m * 2048 + 1024); dst##8[m] = __builtin_shufflevector(lo_, hi_, 0, 1, 2, 3, 4, 5, 6, 7); } } } while (0)
#define PG8_LDB(dst, b, h) do { if constexpr (FP8SCALE == 0) { _Pragma("unroll") for (int n = 0; n < 2; ++n) _Pragma("unroll") for (int k = 0; k < 2; ++k) dst[n][k] = *(const PG8_LAS bf16x8*)(lds + PG8_SB(b, h) + boff + n * 2048 + k * 1024); } \
        else { _Pragma("unroll") for (int n = 0; n < 2; ++n) { const v4i_t lo_ = *(const PG8_LAS v4i_t*)(lds + PG8_SB(b, h) + boff + n * 2048), hi_ = *(const PG8_LAS v4i_t*)(lds + PG8_SB(b, h) + boff + n * 2048 + 1024); dst##8[n] = __builtin_shufflevector(lo_, hi_, 0, 1, 2, 3, 4, 5, 6, 7); } } } while (0)
#define PG8_MMA(ai, bj, At, Bt) do { __builtin_amdgcn_s_setprio(1); \
        if constexpr (FP8SCALE == 0) { _Pragma("unroll") for (int m = 0; m < 4; ++m) _Pragma("unroll") for (int n = 0; n < 2; ++n) _Pragma("unroll") for (int k = 0; k < 2; ++k) \
            acc[ai][bj][m][n] = __builtin_amdgcn_mfma_f32_16x16x32_bf16(Bt[n][k], At[m][k], acc[ai][bj][m][n], 0, 0, 0); } \
        else { _Pragma("unroll") for (int m = 0; m < 4; ++m) _Pragma("unroll") for (int n = 0; n < 2; ++n) \
            asm volatile("v_mfma_scale_f32_16x16x128_f8f6f4 %0, %1, %2, %0, %3, %4 op_sel_hi:[0,0,0]" : "+v"(acc[ai][bj][m][n]) : "v"(Bt##8[n]), "v"(At##8[m]), "v"(sclW), "v"(sclA)); } \
        __builtin_amdgcn_s_setprio(0); } while (0)
#define PG8_WAIT_V(n) asm volatile("s_waitcnt vmcnt(" #n ")" ::: "memory")
#define PG8_WAIT_L(n) asm volatile("s_waitcnt lgkmcnt(" #n ")" ::: "memory")
#define PG8_BAR __builtin_amdgcn_s_barrier()
#define PG8_SCHED __builtin_amdgcn_sched_barrier(0)
    Unit cur, nxt; int ui = 0;
    if (!S.next(0, cur)) return;
    f32x4 acc[2][2][4][2];
#pragma unroll
    for (int a = 0; a < 2; ++a)
#pragma unroll
        for (int b = 0; b < 2; ++b)
#pragma unroll
            for (int m = 0; m < 4; ++m)
#pragma unroll
                for (int n = 0; n < 2; ++n) acc[a][b][m][n] = (f32x4){0.f, 0.f, 0.f, 0.f};
    bf16x8 At[4][2], B0[2][2], B1[2][2]; v8i_t At8[4], B08[2], B18[2]; const int sclW = FP8SCALE * 0x01010101, sclA = 0x7f7f7f7f;
    const char* cA = (const char*)g.A + (GATHER ? (size_t)0 : (size_t)cur.pm * tstep); const char* cB = (const char*)g.Bt + (size_t)cur.pn * tstep;
    unsigned vAc[2][2], vAn[2][2];
    int acnt_ok = -1;
    auto load_rows = [&](int pm, unsigned (&vo)[2][2]) {
        if (g.acnt) {
            const int ge = pm / g.apm;
            if (ge != acnt_ok) {
                const unsigned* cp = g.acnt + ge * 64;
                if (lane == 0) { unsigned sp = 0; while (__hip_atomic_load(cp, __ATOMIC_RELAXED, __HIP_MEMORY_SCOPE_AGENT) < (unsigned)g.aneed && ++sp < (1u << 20)) __builtin_amdgcn_s_sleep(1); }
                acnt_ok = ge;
            }
        }
#pragma unroll
        for (int h = 0; h < 2; ++h)
#pragma unroll
            for (int i = 0; i < 2; ++i) { int R, C; stage_rc(tid * 16 + i * 8192, R, C);
                const int gr = g.acnt ? __hip_atomic_load(g.arow + pm * 256 + h * 128 + R, __ATOMIC_RELAXED, __HIP_MEMORY_SCOPE_AGENT) : g.arow[pm * 256 + h * 128 + R];
                vo[h][i] = (unsigned)(gr * K + C) * 2u; } };
    if constexpr (GATHER) load_rows(cur.pm, vAc);
    S.a_ready(cur);
    if constexpr (SP2) {
        PG8_STAGE(PG8_SB(0, 0), cB, voffB); PG8_STAGE(PG8_SB(0, 1), cB + hstep, voffB); PG8_STAGE_A(PG8_SA(0, 0), cA, vAc, 0); PG8_STAGE_A(PG8_SA(0, 1), cA, vAc, 1);
        if (wr == 1) PG8_BAR;
        PG8_WAIT_V(2); PG8_BAR;
        PG8_STAGE(PG8_SB(1, 0), cB + kstep, voffB); PG8_STAGE_A(PG8_SA(1, 0), cA + kstep, vAc, 0); PG8_STAGE(PG8_SB(1, 1), cB + hstep + kstep, voffB);
        PG8_WAIT_V(6); PG8_BAR;
    } else {
        PG8_STAGE(PG8_SB(0, 0), cB, voffB); PG8_STAGE_A(PG8_SA(0, 0), cA, vAc, 0); PG8_STAGE(PG8_SB(0, 1), cB + hstep, voffB); PG8_STAGE_A(PG8_SA(0, 1), cA, vAc, 1);
        if (wr == 1) PG8_BAR;
        PG8_WAIT_V(4); PG8_BAR;
        PG8_STAGE(PG8_SB(1, 0), cB + kstep, voffB); PG8_STAGE_A(PG8_SA(1, 0), cA + kstep, vAc, 0); PG8_STAGE(PG8_SB(1, 1), cB + hstep + kstep, voffB);
        PG8_WAIT_V(6); PG8_BAR;
    }
    for (;;) {
        const bool has_next = S.next(ui + 1, nxt);
        if constexpr (GATHER) { if (has_next) load_rows(nxt.pm, vAn); else {
#pragma unroll
            for (int h = 0; h < 2; ++h) { vAn[h][0] = vAc[h][0]; vAn[h][1] = vAc[h][1]; } } }
        const char* nA = (has_next && !GATHER) ? (const char*)g.A + (size_t)nxt.pm * tstep : cA; const char* nB = has_next ? (const char*)g.Bt + (size_t)nxt.pn * tstep : cB;
        for (int t = 0; t < nt; t += 2) {
            const bool last = (t == nt - 2);
            const char* a1 = cA + (size_t)(t + 1) * kstep;
            const char* a2 = last ? nA : cA + (size_t)(t + 2) * kstep; const char* b2 = last ? nB : cB + (size_t)(t + 2) * kstep;
            const char* a3 = a2 + kstep; const char* b3 = b2 + kstep;
            unsigned vo2[2][2];
#pragma unroll
            for (int h = 0; h < 2; ++h) { vo2[h][0] = last ? vAn[h][0] : vAc[h][0]; vo2[h][1] = last ? vAn[h][1] : vAc[h][1]; }
            if (last && has_next) S.a_ready(nxt);
            if constexpr (SP2) {
            PG8_LDB(B0, 0, 0); PG8_LDB(B1, 0, 1); PG8_SCHED; PG8_LDA(At, 0, 0); PG8_STAGE_A(PG8_SA(1, 1), a1, vAc, 1);
            PG8_WAIT_V(8); PG8_WAIT_L(0); PG8_BAR; PG8_MMA(0, 0, At, B0); PG8_MMA(0, 1, At, B1); PG8_BAR; PG8_SCHED;
            PG8_LDA(At, 0, 1); PG8_STAGE(PG8_SB(0, 0), b2, voffB); PG8_STAGE(PG8_SB(0, 1), b2 + hstep, voffB); PG8_STAGE_A(PG8_SA(0, 0), a2, vo2, 0);
            PG8_WAIT_V(8); PG8_WAIT_L(0); PG8_BAR; PG8_MMA(1, 0, At, B0); PG8_MMA(1, 1, At, B1); PG8_BAR; PG8_SCHED;
            PG8_LDB(B0, 1, 0); PG8_LDB(B1, 1, 1); PG8_SCHED; PG8_LDA(At, 1, 0); PG8_STAGE_A(PG8_SA(0, 1), a2, vo2, 1);
            PG8_WAIT_V(8); PG8_WAIT_L(0); PG8_BAR; PG8_MMA(0, 0, At, B0); PG8_MMA(0, 1, At, B1); PG8_BAR; PG8_SCHED;
            PG8_LDA(At, 1, 1); PG8_STAGE(PG8_SB(1, 0), b3, voffB); PG8_STAGE(PG8_SB(1, 1), b3 + hstep, voffB); PG8_STAGE_A(PG8_SA(1, 0), a3, vo2, 0);
            PG8_WAIT_V(8); PG8_WAIT_L(0); PG8_BAR; PG8_MMA(1, 0, At, B0); PG8_MMA(1, 1, At, B1); PG8_BAR; PG8_SCHED;
            } else {
            PG8_LDB(B0, 0, 0); PG8_SCHED; PG8_LDA(At, 0, 0); PG8_STAGE_A(PG8_SA(1, 1), a1, vAc, 1);
            PG8_WAIT_L(8); PG8_BAR; PG8_WAIT_L(0); PG8_MMA(0, 0, At, B0); PG8_BAR; PG8_SCHED;
            PG8_LDB(B1, 0, 1); PG8_STAGE(PG8_SB(0, 0), b2, voffB);
            PG8_BAR; PG8_WAIT_L(0); PG8_MMA(0, 1, At, B1); PG8_BAR;
            PG8_LDA(At, 0, 1); PG8_STAGE_A(PG8_SA(0, 0), a2, vo2, 0);
            PG8_BAR; PG8_WAIT_L(0); PG8_MMA(1, 0, At, B0); PG8_BAR; PG8_SCHED;
            PG8_STAGE(PG8_SB(0, 1), b2 + hstep, voffB);
            PG8_WAIT_V(6); PG8_BAR; PG8_MMA(1, 1, At, B1); PG8_BAR;
            PG8_LDB(B0, 1, 0); PG8_SCHED; PG8_LDA(At, 1, 0); PG8_STAGE_A(PG8_SA(0, 1), a2, vo2, 1);
            PG8_WAIT_L(8); PG8_BAR; PG8_WAIT_L(0); PG8_MMA(0, 0, At, B0); PG8_BAR; PG8_SCHED;
            PG8_LDB(B1, 1, 1); PG8_STAGE(PG8_SB(1, 0), b3, voffB);
            PG8_BAR; PG8_WAIT_L(0); PG8_MMA(0, 1, At, B1); PG8_BAR;
            PG8_LDA(At, 1, 1); PG8_STAGE_A(PG8_SA(1, 0), a3, vo2, 0);
            PG8_BAR; PG8_WAIT_L(0); PG8_MMA(1, 0, At, B0); PG8_BAR; PG8_SCHED;
            PG8_STAGE(PG8_SB(1, 1), b3 + hstep, voffB);
            PG8_WAIT_V(6); PG8_BAR; PG8_MMA(1, 1, At, B1); PG8_BAR;
            }
        }
        if constexpr (ALIGN_EPI) { if (wr == 0) PG8_BAR; }
        if constexpr (FP8SCALE != 0) asm volatile("s_nop 15\n\ts_nop 15" ::: "memory");
        if constexpr (!Epi::AFTER_DRAIN) { E(acc, cur, wr, wc, fr, fq); S.done(cur); }
        if (!has_next) break;
#pragma unroll
        for (int a = 0; a < 2; ++a)
#pragma unroll
            for (int b = 0; b < 2; ++b)
#pragma unroll
                for (int m = 0; m < 4; ++m)
#pragma unroll
                    for (int n = 0; n < 2; ++n) acc[a][b][m][n] = (f32x4){0.f, 0.f, 0.f, 0.f};
        cur = nxt; cA = nA; cB = nB; ++ui;
        if constexpr (GATHER) {
#pragma unroll
            for (int h = 0; h < 2; ++h) { vAc[h][0] = vAn[h][0]; vAc[h][1] = vAn[h][1]; } }
        if constexpr (ALIGN_EPI) { if (wr == 1) PG8_BAR; }
    }
    PG8_WAIT_V(0);
    if constexpr (!ALIGN_EPI) { if (wr == 0) PG8_BAR; }
    PG8_BAR;
    if constexpr (Epi::AFTER_DRAIN) { E.fused(acc, cur, wr, wc, fr, fq, lds, wid, lane); S.done(cur); }
#undef PG8_SA
#undef PG8_SB
#undef PG8_STAGE
#undef PG8_STAGE_A
#undef PG8_LDA
#undef PG8_LDB
#undef PG8_MMA
#undef PG8_WAIT_V
#undef PG8_WAIT_L
#undef PG8_BAR
#undef PG8_SCHED
}
}

#define LAS __attribute__((address_space(3)))
typedef unsigned short bf16_t;
typedef float f32x4 __attribute__((ext_vector_type(4)));
typedef float f32x2 __attribute__((ext_vector_type(2)));
typedef unsigned u32x4 __attribute__((ext_vector_type(4)));
typedef unsigned u32x2 __attribute__((ext_vector_type(2)));
typedef short bf16x8 __attribute__((ext_vector_type(8)));

constexpr int NB = 8, SEQ = 2048, CTXL = 256, D = 1024;
constexpr int RL = NB * SEQ, RC = NB * CTXL, RT = RL + RC;
constexpr int NE = 16, DE = 2816, CAPL = 256, CAPC = 32;
constexpr int RPE0 = NB * CAPL + NB * CAPC, RPE1 = NB * CAPL;
constexpr int NWAVES = 8, NTHREADS = 512;
constexpr float EPS = 1e-6f;
constexpr float QSCALE = 0.125f * 1.4426950408889634f;
constexpr float LAMBDA_INIT0 = 0.2f;
constexpr int M_SH1 = 0, M_SC1 = 1024, M_G1 = 2048, M_SH2 = 3072, M_SC2 = 4096, M_G2 = 5120;
constexpr int SCH = 64, NCH = (CTXL + SEQ) / SCH, NCH_CTX = CTXL / SCH;

constexpr size_t MiB = 1u << 20;
constexpr size_t WS_CTL = 0, CTL_ZERO_BYTES = 32768;
constexpr size_t WS_GTAB = 2 * MiB + 65536;
constexpr size_t WS_MOD = 1 * MiB, WS_ROPE = 2 * MiB, WS_PROBS = 3 * MiB, WS_GATE = 5 * MiB, WS_XROW = 5 * MiB + 512 * 1024  , WS_SEL = 6 * MiB, WS_CP = 8 * MiB, WS_CB = 11 * MiB;
constexpr size_t WS_WQKV = 16 * MiB, WS_WO = 22 * MiB, WS_WIN = 24 * MiB, WS_WOUT = 28 * MiB, WS_WG = 30 * MiB;
constexpr size_t WS_XN = 32 * MiB, WS_Q = 68 * MiB, WS_K = 104 * MiB, WS_V = 140 * MiB, WS_ATT = 176 * MiB, WS_H = 212 * MiB;
constexpr size_t WS_XG = 284 * MiB, WS_Y = 356 * MiB, WS_ACT = 428 * MiB, WS_WGU = 626 * MiB, WS_WDN = 978 * MiB;
constexpr size_t WS_YG = 68 * MiB, WS_XR = 104 * MiB, WS_HS = 140 * MiB;
constexpr size_t WS_LOGA = 1154 * MiB, WS_BT = 1226 * MiB;
constexpr size_t WS_TMPF = 1298 * MiB, WS_XC = 2090 * MiB, WS_END = 2126 * MiB;
constexpr size_t WGU_LAYER = (size_t)NE * 2 * DE * D * 2, WDN_LAYER = (size_t)NE * D * DE * 2;
constexpr int CW_BAR = 4096, CW_TKC = 128;
constexpr int CW_NRC = CW_TKC + 64 * 32;
#ifndef NR_HANDOFF
#define NR_HANDOFF 0
#endif
#ifndef TK_HANDOFF
#define TK_HANDOFF 1
#endif

constexpr int LDS_BYTES = 147456;
constexpr int MISC_OFF = 131072 + 320;

struct Args { const float* in[27]; float* out; unsigned char* ws; int ph_lo, ph_hi; };
constexpr int ROPE_LDS = 131072 + 1024;
constexpr int ARGS_OFF = 131072 + 512;
struct Ctx {
    const LAS unsigned* la;
    __device__ __forceinline__ unsigned long long ld(int i) const { const unsigned lo = __builtin_amdgcn_readfirstlane(la[2 * i]), hi = __builtin_amdgcn_readfirstlane(la[2 * i + 1]); return ((unsigned long long)hi << 32) | lo; }
    __device__ __forceinline__ const float* in(int i) const { return (const float*)(const __attribute__((address_space(1))) float*)ld(i); }
    __device__ __forceinline__ float* out() const { return (float*)(__attribute__((address_space(1))) float*)ld(27); }
    __device__ __forceinline__ unsigned char* ws() const { return (unsigned char*)(__attribute__((address_space(1))) unsigned char*)ld(28); }
};

enum { I_X = 0, I_C, I_CTX, I_CCTX, I_ADAW, I_ADAB, I_N1G, I_N2G, I_FG, I_WQKV, I_LQ1, I_LK1, I_LQ2, I_LK2, I_SUBG, I_WO, I_WIN, I_BIN, I_CONVW, I_CONVB, I_WGATES, I_BGATES, I_LAM, I_WOUT, I_WR, I_WGU, I_WDN };

__device__ __forceinline__ float bf_lo(unsigned w) { return __uint_as_float(w << 16); }
__device__ __forceinline__ float bf_hi(unsigned w) { return __uint_as_float(w & 0xffff0000u); }
__device__ __forceinline__ float bf2f(bf16_t b) { return __uint_as_float(((unsigned)b) << 16); }
__device__ __forceinline__ unsigned f2bf(float f) { unsigned u = __float_as_uint(f); return (u + 0x7fffu + ((u >> 16) & 1u)) >> 16; }
__device__ __forceinline__ unsigned pk2(float lo, float hi) { unsigned r; asm("v_cvt_pk_bf16_f32 %0, %1, %2" : "=v"(r) : "v"(lo), "v"(hi)); return r; }
#ifndef EPI_WT
#define EPI_WT 0
#endif
__device__ __forceinline__ void st16_wt(void* p, u32x4 v) {
#if EPI_WT
    asm volatile("global_store_dwordx4 %0, %1, off sc1" :: "v"(p), "v"(v) : "memory");
#else
    *(u32x4*)p = v;
#endif
}
__device__ __forceinline__ void st8_wt(void* p, u32x2 v) {
#if EPI_WT
    asm volatile("global_store_dwordx2 %0, %1, off sc1" :: "v"(p), "v"(v) : "memory");
#else
    *(u32x2*)p = v;
#endif
}
#define DPPF(v, ctrl) __int_as_float(__builtin_amdgcn_update_dpp(0, __float_as_int(v), ctrl, 0xF, 0xF, true))
__device__ __forceinline__ float wave_sum(float v) {
    v += DPPF(v, 0xB1); v += DPPF(v, 0x4E); v += DPPF(v, 0x141); v += DPPF(v, 0x140);
    const float s0 = __int_as_float(__builtin_amdgcn_readlane(__float_as_int(v), 0)), s1 = __int_as_float(__builtin_amdgcn_readlane(__float_as_int(v), 16));
    const float s2 = __int_as_float(__builtin_amdgcn_readlane(__float_as_int(v), 32)), s3 = __int_as_float(__builtin_amdgcn_readlane(__float_as_int(v), 48));
    return (s0 + s1) + (s2 + s3);
}
__device__ __forceinline__ float wave_max(float v) {
    v = fmaxf(v, DPPF(v, 0xB1)); v = fmaxf(v, DPPF(v, 0x4E)); v = fmaxf(v, DPPF(v, 0x141)); v = fmaxf(v, DPPF(v, 0x140));
    const float s0 = __int_as_float(__builtin_amdgcn_readlane(__float_as_int(v), 0)), s1 = __int_as_float(__builtin_amdgcn_readlane(__float_as_int(v), 16));
    const float s2 = __int_as_float(__builtin_amdgcn_readlane(__float_as_int(v), 32)), s3 = __int_as_float(__builtin_amdgcn_readlane(__float_as_int(v), 48));
    return fmaxf(fmaxf(s0, s1), fmaxf(s2, s3));
}
__device__ __forceinline__ float sigmoidf_(float x) { return 1.f / (1.f + expf(-x)); }
__device__ __forceinline__ float gelu_tanh(float x) { const float u = 0.7978845608028654f * (x + 0.044715f * x * x * x); return x / (1.f + expf(-2.f * u)); }
__device__ __forceinline__ const float* mod_ptr(const Ctx& a, int layer, int r) { return (const float*)(a.ws() + WS_MOD) + (size_t)(layer * 9 + r) * 6144; }
__device__ __forceinline__ int mod_row(int row) { return row < RL ? (row >> 11) : 8; }

__device__ __forceinline__ void load_row(const float* p, int lane, f32x4 (&v)[4]) {
#pragma unroll
    for (int j = 0; j < 4; ++j) v[j] = *(const f32x4*)(p + 4 * lane + 256 * j);
}
__device__ __forceinline__ void load_row_bf16(const bf16_t* p, int lane, f32x4 (&v)[4]) {
#pragma unroll
    for (int j = 0; j < 4; ++j) { const u32x2 w = *(const u32x2*)(p + 4 * lane + 256 * j); v[j] = (f32x4){bf_lo(w.x), bf_hi(w.x), bf_lo(w.y), bf_hi(w.y)}; }
}
__device__ __forceinline__ void store_row_f32(float* p, int lane, const f32x4 (&v)[4]) {
#pragma unroll
    for (int j = 0; j < 4; ++j) *(f32x4*)(p + 4 * lane + 256 * j) = v[j];
}
__device__ __forceinline__ void store_row_bf16(bf16_t* p, int lane, const f32x4 (&v)[4]) {
#pragma unroll
    for (int j = 0; j < 4; ++j) { u32x2 w; w.x = pk2(v[j].x, v[j].y); w.y = pk2(v[j].z, v[j].w); *(u32x2*)(p + 4 * lane + 256 * j) = w; }
}
__device__ __forceinline__ void store_row_fp8(unsigned char* p, int lane, const f32x4 (&v)[4]) {
#pragma unroll
    for (int j = 0; j < 4; ++j) *(unsigned*)(p + 4 * lane + 256 * j) = __builtin_amdgcn_cvt_pk_fp8_f32(v[j].z, v[j].w, __builtin_amdgcn_cvt_pk_fp8_f32(v[j].x, v[j].y, 0u, false), true);
}
__device__ __forceinline__ float rms_mod(f32x4 (&v)[4], const float* g, const float* sh, const float* sc, int lane) {
    float ss = 0.f;
#pragma unroll
    for (int j = 0; j < 4; ++j) ss += (v[j].x * v[j].x + v[j].y * v[j].y) + (v[j].z * v[j].z + v[j].w * v[j].w);
    ss = wave_sum(ss);
    const float rstd = 1.0f / sqrtf(ss * (1.0f / D) + EPS);
#pragma unroll
    for (int j = 0; j < 4; ++j) {
        const int k = 4 * lane + 256 * j;
        const f32x4 gg = *(const f32x4*)(g + k);
        f32x4 y = v[j] * rstd * gg;
        if (sh) { const f32x4 s1 = *(const f32x4*)(sc + k), s0 = *(const f32x4*)(sh + k); y = y * (1.0f + s1) + s0; }
        v[j] = y;
    }
    return rstd;
}

template <class F>
__device__ __forceinline__ void naive_tile(const bf16_t* A, int lda, const float* W, int ldw, int K, LAS unsigned char* lds, F f) {
    LAS float* As = (LAS float*)lds;
    LAS float* Bs = (LAS float*)(lds + 16 * 132 * 4);
    const int tid = threadIdx.x, ty = tid >> 4, tx = tid & 15;
    const int ar = tid >> 2, akq = tid & 3, bk = tid >> 5, bc = (tid & 31) * 2;
    float acc[4][4];
#pragma unroll
    for (int i = 0; i < 4; ++i)
#pragma unroll
        for (int j = 0; j < 4; ++j) acc[i][j] = 0.f;
    for (int k0 = 0; k0 < K; k0 += 16) {
        const u32x2 av = *(const u32x2*)(A + (size_t)ar * lda + k0 + akq * 4);
        const f32x2 bv = *(const f32x2*)(W + (size_t)(k0 + bk) * ldw + bc);
        __syncthreads();
        As[(akq * 4 + 0) * 132 + ar] = bf_lo(av.x); As[(akq * 4 + 1) * 132 + ar] = bf_hi(av.x);
        As[(akq * 4 + 2) * 132 + ar] = bf_lo(av.y); As[(akq * 4 + 3) * 132 + ar] = bf_hi(av.y);
        Bs[bk * 64 + bc] = bv.x; Bs[bk * 64 + bc + 1] = bv.y;
        __syncthreads();
#pragma unroll
        for (int kk = 0; kk < 16; ++kk) {
            const f32x4 a4 = *(const LAS f32x4*)(As + kk * 132 + ty * 4);
            const f32x4 b4 = *(const LAS f32x4*)(Bs + kk * 64 + tx * 4);
#pragma unroll
            for (int i = 0; i < 4; ++i)
#pragma unroll
                for (int j = 0; j < 4; ++j) acc[i][j] += a4[i] * b4[j];
        }
    }
#pragma unroll
    for (int i = 0; i < 4; ++i)
#pragma unroll
        for (int j = 0; j < 4; ++j) f(ty * 4 + i, tx * 4 + j, acc[i][j]);
    __syncthreads();
}

__device__ __forceinline__ void cvt_item(const float* W, int N, int k0, int n0, bf16_t* dst, int Kd, int gu_perm) {
    const int tid = threadIdx.x, lane = tid & 63, wave = tid >> 6;
    const float* p = W + (size_t)(k0 + 8 * wave) * N + n0 + 4 * lane;
    f32x4 v[8];
#pragma unroll
    for (int i = 0; i < 8; ++i) v[i] = *(const f32x4*)(p + (size_t)i * N);
#pragma unroll
    for (int j = 0; j < 4; ++j) {
        const int n = n0 + 4 * lane + j;
        const int row = gu_perm ? (((n % DE) >> 7) * 256 + (n / DE) * 128 + (n & 127)) : n;
        u32x4 o; o.x = pk2(v[0][j], v[1][j]); o.y = pk2(v[2][j], v[3][j]); o.z = pk2(v[4][j], v[5][j]); o.w = pk2(v[6][j], v[7][j]);
        *(u32x4*)(dst + (size_t)row * Kd + k0 + 8 * wave) = o;
    }
}
__device__ __forceinline__ unsigned pk4_fp8(float a, float b, float c, float d) { unsigned w = __builtin_amdgcn_cvt_pk_fp8_f32(a, b, 0u, false); return __builtin_amdgcn_cvt_pk_fp8_f32(c, d, w, true); }
constexpr float BT_SCALE = 64.0f, Y_SCALE = 16.0f;
#ifndef SWIGLU_FOLD
#define SWIGLU_FOLD 1
#endif
constexpr float WGU_SCALE = 32.0f, WDN_SCALE = 64.0f;
#ifdef PROBE_PRO
__device__ __forceinline__ unsigned probe_mode() { extern __shared__ __attribute__((aligned(16))) unsigned char lds_raw_p[]; return *(volatile LAS unsigned*)((LAS unsigned char*)lds_raw_p + MISC_OFF + 60); }
#endif
__device__ __forceinline__ void cvt8_load(const float* W, int N, int k0, int n0, f32x4 (&v)[16]) {
    const int tid = threadIdx.x, lane = tid & 63, wave = tid >> 6;
    const float* p = W + (size_t)(k0 + 16 * wave) * N + n0 + 4 * lane;
#ifdef PROBE_PRO
    const unsigned pm = probe_mode();
    if (pm == 2) {
#pragma unroll
        for (int i = 0; i < 16; ++i) v[i] = (f32x4){1.f, 2.f, 3.f, (float)i};
        return; }
    if (pm == 3) {
#pragma unroll
        for (int i = 0; i < 16; ++i) v[i] = *(const f32x4*)(p + (size_t)i * N);
        return; }
#endif
#pragma unroll
    for (int i = 0; i < 16; ++i) v[i] = __builtin_nontemporal_load((const f32x4*)(p + (size_t)i * N));
}
__device__ __forceinline__ void cvt8_store(const f32x4 (&v)[16], int k0, int n0, unsigned char* dst, int Kd, int gu_perm, float scale, LAS unsigned char* T) {
    const int tid = threadIdx.x, lane = tid & 63, wave = tid >> 6;
#pragma unroll
    for (int j = 0; j < 4; ++j) {
        const int n = 4 * lane + j;
        u32x4 o;
        o.x = pk4_fp8(v[0][j] * scale, v[1][j] * scale, v[2][j] * scale, v[3][j] * scale); o.y = pk4_fp8(v[4][j] * scale, v[5][j] * scale, v[6][j] * scale, v[7][j] * scale);
        o.z = pk4_fp8(v[8][j] * scale, v[9][j] * scale, v[10][j] * scale, v[11][j] * scale); o.w = pk4_fp8(v[12][j] * scale, v[13][j] * scale, v[14][j] * scale, v[15][j] * scale);
        *(LAS u32x4*)(T + n * 128 + ((wave ^ (lane & 7)) << 4)) = o;
    }
    asm volatile("s_waitcnt lgkmcnt(0)" ::: "memory"); __builtin_amdgcn_s_barrier(); asm volatile("" ::: "memory");
#pragma unroll
    for (int i = 0; i < 4; ++i) {
        const int p = tid + NTHREADS * i, n = p >> 3, c = p & 7;
        const u32x4 x = *(const LAS u32x4*)(T + n * 128 + ((c ^ ((n >> 2) & 7)) << 4));
        const int ng = n0 + n;
        const int row = gu_perm ? (((ng % DE) >> 7) * 256 + (ng / DE) * 128 + (ng & 127)) : ng;
#ifdef PROBE_PRO
        const unsigned pm = probe_mode();
        if (pm == 1) { if (x.x == 0x12345678u && x.y == 0x9abcdef0u) __builtin_nontemporal_store(x, (u32x4*)(dst + (size_t)row * Kd + k0 + 16 * c)); continue; }
        if (pm == 4) { *(u32x4*)(dst + (size_t)row * Kd + k0 + 16 * c) = x; continue; }
#endif
        __builtin_nontemporal_store(x, (u32x4*)(dst + (size_t)row * Kd + k0 + 16 * c));
    }
}
constexpr int CV_GU = NE * 8 * 22, CV_DN = NE * 22 * 4, CV_ITEMS = CV_GU + CV_DN;
struct CvItem { const float* W; unsigned char* dst; int N, Kd, k0, n0, perm; float scale; };
__device__ __forceinline__ CvItem cv_decode(const float* wgu, const float* wdn, unsigned char* ws, int layer, int it) {
    CvItem c;
    if (it < CV_GU) { const int e = it / 176, q = it % 176, le = layer * NE + e; c.W = wgu + (size_t)le * D * 2 * DE; c.dst = ws + WS_WGU + (size_t)le * 2 * DE * D; c.N = 2 * DE; c.Kd = D; c.k0 = (q / 22) * 128; c.n0 = (q % 22) * 256; c.perm = 1; c.scale = (SWIGLU_FOLD && c.n0 < DE) ? WGU_SCALE * 1.4426950408889634f : WGU_SCALE; }
    else { const int r = it - CV_GU, e = r / 88, q = r % 88, le = layer * NE + e; c.W = wdn + (size_t)le * DE * D; c.dst = ws + WS_WDN + (size_t)le * D * DE; c.N = D; c.Kd = DE; c.k0 = (q / 4) * 128; c.n0 = (q % 4) * 256; c.perm = 0; c.scale = SWIGLU_FOLD ? WDN_SCALE * 0.6931471805599453f : WDN_SCALE; }
    return c;
}
__device__ __forceinline__ void cvt8_run(const Ctx& a, int layer, int first, int stride, int end, LAS unsigned char* lds) {
    const float* wgu = a.in(I_WGU); const float* wdn = a.in(I_WDN); unsigned char* ws = a.ws();
    f32x4 va[16], vb[16];
    int it = first;
    if (it < end) { const CvItem c = cv_decode(wgu, wdn, ws, layer, it); cvt8_load(c.W, c.N, c.k0, c.n0, va); }
    while (it < end) {
        int nx = it + stride;
        if (nx < end) { const CvItem c = cv_decode(wgu, wdn, ws, layer, nx); cvt8_load(c.W, c.N, c.k0, c.n0, vb); }
        { const CvItem c = cv_decode(wgu, wdn, ws, layer, it); cvt8_store(va, c.k0, c.n0, c.dst, c.Kd, c.perm, c.scale, lds); }
        it = nx; if (it >= end) break;
        nx = it + stride;
        if (nx < end) { const CvItem c = cv_decode(wgu, wdn, ws, layer, nx); cvt8_load(c.W, c.N, c.k0, c.n0, va); }
        { const CvItem c = cv_decode(wgu, wdn, ws, layer, it); cvt8_store(vb, c.k0, c.n0, c.dst, c.Kd, c.perm, c.scale, lds + 32768); }
        it = nx;
    }
    __syncthreads();
}
#ifndef CVT_HIDE
#define CVT_HIDE 1
#endif
#ifndef CVT_DEDICATED
#define CVT_DEDICATED 0
#endif
#ifndef CVQ_QKV
#define CVQ_QKV 1280
#endif
#ifndef CVQ_WO
#define CVQ_WO 896
#endif
#ifndef CVQ_GU0
#define CVQ_GU0 480
#endif
#ifndef CVQ_DN0
#define CVQ_DN0 960
#endif
#ifndef CVQ_WIN
#define CVQ_WIN 896
#endif
#ifndef CVQ_GATES
#define CVQ_GATES 1120
#endif
#ifndef CVQ_ATT
#define CVQ_ATT 256
#endif
#ifndef CVQ_TK1
#define CVQ_TK1 512
#endif
#ifndef CVQ_TK0
#define CVQ_TK0 0
#endif
#ifndef ATT_CVB
#define ATT_CVB 24
#endif
#if ATT_CVB > 0
#undef CVQ_ATT
#ifndef CVQ_ATT0N
#define CVQ_ATT0N (CV_ITEMS - CVQ_QKV - CVQ_WO - CVQ_TK0)
#endif
#ifndef CVQ_ATT1N
#define CVQ_ATT1N (CV_ITEMS - CVQ_GU0 - CVQ_DN0 - CVQ_WIN - CVQ_GATES - CVQ_TK1)
#endif
#define CVQ_ATT CVQ_ATT0N
#define CVQ_ATT1 CVQ_ATT1N
#else
#define CVQ_ATT1 0
#endif
#ifndef DED_MASK
#define DED_MASK 0
#endif
#ifndef CVQ_GU0L0
#define CVQ_GU0L0 0
#endif
#ifndef CVQ_GU0S
#define CVQ_GU0S 0
#endif
#ifndef CVQ_GU0T0
#define CVQ_GU0T0 0
#endif
constexpr int CV0_GUD = CVT_HIDE ? CV_ITEMS - CVQ_GU0L0 - CVQ_GU0T0 : CV_ITEMS, CV0_GUS = CV_ITEMS - CVQ_GU0L0;
static_assert(CV0_GUD >= CV_GU, "only down-projection items may be left to the gate_up phase");
static_assert(CVQ_GU0L0 == 0 || (DED_MASK & 32) || CVT_DEDICATED, "the gate_up phase converts them only with dedicated workgroups");
constexpr int CV0_QKV = 0, CV0_WO = CV0_QKV + CVQ_QKV, CV0_ATT = CV0_WO + CVQ_WO, CV0_TK = CV0_ATT + CVQ_ATT, CV0_PRO = CVT_HIDE ? CV0_TK + CVQ_TK0 : 0;
constexpr int CV1_GU0 = 0, CV1_DN0 = CV1_GU0 + CVQ_GU0, CV1_WIN = CV1_DN0 + CVQ_DN0, CV1_GATES = CV1_WIN + CVQ_WIN, CV1_TK = CV1_GATES + CVQ_GATES, CV1_ATT = CV1_TK + CVQ_TK1, CV1_PRO = CVT_HIDE ? CV1_ATT + CVQ_ATT1 : 0;
static_assert(CV0_PRO <= CV0_GUD && CV1_PRO <= CV_ITEMS, "conversion schedule");
__device__ __forceinline__ void cvt8_tail(const Ctx& a, LAS unsigned char* lds, int units, int G, int c, int layer, int base, int count) {
#if CVT_HIDE && FP8_MOE
    const int R = (units + G - 1) / G, first_idle = units - (R - 1) * G;
    if (first_idle >= G || count <= 0 || c < first_idle) return;
    cvt8_run(a, layer, base + (c - first_idle), G - first_idle, base + count, lds);
#endif
}
__device__ __forceinline__ int gemm_groups(int units, int G, int bit = 0) {
#if CVT_HIDE && FP8_MOE
    if (!(CVT_DEDICATED || (DED_MASK & bit))) return G;
    const int R = (units + G - 1) / G; int gp = ((units + R - 1) / R + 7) & ~7;
    return gp < G ? gp : G;
#else
    return G;
#endif
}
#ifndef DENSE_LATE
#define DENSE_LATE 1
#endif
constexpr int IT_DENSE_REST = 16 * 4 + 16 * 8 + 16 * 4 + 32;
__device__ __forceinline__ void cvt_dense_rest_item(const Ctx& a, int r) {
    constexpr int IT_WO = 16 * 4, IT_WIN = 16 * 8, IT_WOUT = 16 * 4;
    if (r < IT_WO) { cvt_item(a.in(I_WO), D, (r / 4) * 64, (r % 4) * 256, (bf16_t*)(a.ws() + WS_WO), D, 0); return; }
    r -= IT_WO;
    if (r < IT_WIN) { cvt_item(a.in(I_WIN), 2 * D, (r / 8) * 64, (r % 8) * 256, (bf16_t*)(a.ws() + WS_WIN), D, 0); return; }
    r -= IT_WIN;
    if (r < IT_WOUT) { cvt_item(a.in(I_WOUT), D, (r / 4) * 64, (r % 4) * 256, (bf16_t*)(a.ws() + WS_WOUT), D, 0); return; }
    r -= IT_WOUT;
    { const int m = r >> 1, kk = r & 1;
        cvt_item(a.in(I_WGATES) + (size_t)m * 128 * 256, 256, kk * 64, 0, (bf16_t*)(a.ws() + WS_WG) + (size_t)m * 256 * 128, 128, 0); }
}
__device__ __forceinline__ void ph_prologue(const Ctx& a, LAS unsigned char* lds) {
    const int tid = threadIdx.x, lane = tid & 63, wave = tid >> 6;
    if (blockIdx.x == gridDim.x - 1) {
        float* rope = (float*)(a.ws() + WS_ROPE);
        for (int i = tid; i < 1024; i += NTHREADS) { const int pos = i >> 4, f = i & 15; const float inv = powf(10000.0f, -(float)f / 16.0f); const float ang = (float)pos * inv; rope[i] = cosf(ang); rope[1024 + i] = sinf(ang); }
    }
    if (blockIdx.x == gridDim.x - 2 || gridDim.x == 1) {
        float* gt = (float*)(a.ws() + WS_GTAB); const float* lamp = a.in(I_LAM); const float* bgp = a.in(I_BGATES);
        for (int i = tid; i < 2 * D; i += NTHREADS) {
            const int d = i >> 10, ch = i & 1023, kb = ch >> 7, cc = ch & 127;
            const float cl = -8.0f * log1pf(expf(-lamp[i]));
            gt[(d * 4 + 0) * D + ch] = cl * 1.4426950408889634f; gt[(d * 4 + 1) * D + ch] = 2.0f * cl * 1.4426950408889634f;
            gt[(d * 4 + 2) * D + ch] = -1.4426950408889634f * bgp[(d * 8 + kb) * 256 + cc]; gt[(d * 4 + 3) * D + ch] = -1.4426950408889634f * bgp[(d * 8 + kb) * 256 + 128 + cc];
        }
    }
    for (int u = blockIdx.x; u < 256; u += gridDim.x) {
        LAS float* sl = (LAS float*)lds;
        LAS float* red = (LAS float*)(lds + 49152);
        const int layer = u >> 7, n0 = (u & 127) * 48;
        { const float* cin = a.in(I_C); const float* cctx = a.in(I_CCTX);
          for (int i = tid; i < 9 * 1024; i += NTHREADS) { const int r = i >> 10, k = i & 1023; const float v = r < 8 ? cin[r * 1024 + k] : cctx[k]; sl[k * 12 + r] = v / (1.f + expf(-v)); } }
        __syncthreads();
        const int kk = lane / 12, c4 = lane % 12; const bool act = lane < 60;
        const float* W = a.in(I_ADAW) + (size_t)layer * 1024 * 6144 + n0 + 4 * c4;
        f32x4 acc[9];
#pragma unroll
        for (int r = 0; r < 9; ++r) acc[r] = (f32x4){0.f, 0.f, 0.f, 0.f};
#pragma unroll 1
        for (int half = 0; half < 2; ++half) {
            f32x4 wv[13];
#pragma unroll
            for (int i = 0; i < 13; ++i) { const int ko = 5 * (half * 13 + i) + kk; wv[i] = (act && ko < 128) ? __builtin_nontemporal_load((const f32x4*)(W + (size_t)(wave * 128 + ko) * 6144)) : (f32x4){0.f, 0.f, 0.f, 0.f}; }
#pragma unroll
            for (int i = 0; i < 13; ++i) { const int ko = 5 * (half * 13 + i) + kk; const int k = wave * 128 + (ko < 128 ? ko : 0);
                const f32x4 s0 = *(const LAS f32x4*)(sl + k * 12), s1 = *(const LAS f32x4*)(sl + k * 12 + 4); const float s8 = sl[k * 12 + 8];
                acc[0] += wv[i] * s0.x; acc[1] += wv[i] * s0.y; acc[2] += wv[i] * s0.z; acc[3] += wv[i] * s0.w;
                acc[4] += wv[i] * s1.x; acc[5] += wv[i] * s1.y; acc[6] += wv[i] * s1.z; acc[7] += wv[i] * s1.w; acc[8] += wv[i] * s8; }
        }
        { LAS f32x4* rp = (LAS f32x4*)(red + (size_t)(wave * 64 + lane) * 36);
#pragma unroll
          for (int r = 0; r < 9; ++r) rp[r] = acc[r]; }
        __syncthreads();
        float* MOD = (float*)(a.ws() + WS_MOD); const float* adab = a.in(I_ADAB);
        for (int i = tid; i < 9 * 48; i += NTHREADS) {
            const int r = i / 48, col = i % 48, q = col >> 2, j = col & 3; float sacc = 0.f;
#pragma unroll
            for (int w = 0; w < 8; ++w)
#pragma unroll
                for (int g = 0; g < 5; ++g) sacc += red[(size_t)(w * 64 + g * 12 + q) * 36 + r * 4 + j];
            MOD[(size_t)(layer * 9 + r) * 6144 + n0 + col] = sacc + adab[layer * 6144 + n0 + col];
        }
        __syncthreads();
    }
#if ANY_FAST_GEMM
    constexpr int IT_QKV = 16 * 12, IT_WO = 16 * 4, IT_WIN = 16 * 8, IT_WOUT = 16 * 4, IT_G = 32;
#if FP8_MOE
    cvt8_run(a, 0, CV0_PRO + (int)blockIdx.x, (int)gridDim.x, CV0_GUD, lds);
    cvt8_run(a, 1, CV1_PRO + (int)blockIdx.x, (int)gridDim.x, CV_ITEMS, lds);
    constexpr int IT_GU = 0, IT_DN = 0;
#else
    constexpr int IT_GU1 = 16 * 22, IT_DN1 = 44 * 4;
    constexpr int IT_GU = 32 * IT_GU1, IT_DN = 32 * IT_DN1;
#endif
    constexpr int NITEMS = IT_GU + IT_DN + IT_QKV + ((DENSE_LATE && FAST_ATTN) ? 0 : IT_DENSE_REST);
    for (int it = blockIdx.x; it < NITEMS; it += gridDim.x) {
        int r = it;
#if !FP8_MOE
        if (r < IT_GU) { const int le = r / IT_GU1, q = r % IT_GU1;
            cvt_item(a.in(I_WGU) + (size_t)le * D * 2 * DE, 2 * DE, (q / 22) * 64, (q % 22) * 256, (bf16_t*)(a.ws() + WS_WGU) + (size_t)le * 2 * DE * D, D, 1); continue; }
        r -= IT_GU;
        if (r < IT_DN) { const int le = r / IT_DN1, q = r % IT_DN1;
            cvt_item(a.in(I_WDN) + (size_t)le * DE * D, D, (q / 4) * 64, (q % 4) * 256, (bf16_t*)(a.ws() + WS_WDN) + (size_t)le * D * DE, DE, 0); continue; }
#endif
        r -= IT_DN;
        if (r < IT_QKV) { cvt_item(a.in(I_WQKV), 3 * D, (r / 12) * 64, (r % 12) * 256, (bf16_t*)(a.ws() + WS_WQKV), D, 0); continue; }
        r -= IT_QKV;
#if !(DENSE_LATE && FAST_ATTN)
        cvt_dense_rest_item(a, r);
#endif
    }
#endif
}

__device__ __forceinline__ void ph_norm1_l0(const Ctx& a) {
    const int lane = threadIdx.x & 63, gw = blockIdx.x * NWAVES + (threadIdx.x >> 6), NGW = gridDim.x * NWAVES;
    unsigned char* ws = a.ws();
    bf16_t* XN = (bf16_t*)(ws + WS_XN); const float* X = a.in(I_X); const float* CX = a.in(I_CTX); const float* n1g = a.in(I_N1G);
    f32x4 v[4], nx[4];
    int row = gw;
    if (row < RT) load_row(row < RL ? X + (size_t)row * D : CX + (size_t)(row - RL) * D, lane, v);
    for (; row < RT; row += NGW) {
        const int rn = row + NGW;
        if (rn < RT) load_row(rn < RL ? X + (size_t)rn * D : CX + (size_t)(rn - RL) * D, lane, nx);
        const float* mp = (const float*)(ws + WS_MOD) + (size_t)mod_row(row) * 6144;
        rms_mod(v, n1g, mp + M_SH1, mp + M_SC1, lane);
        store_row_bf16(XN + (size_t)row * D, lane, v);
#pragma unroll
        for (int j = 0; j < 4; ++j) v[j] = nx[j];
    }
}
__device__ __forceinline__ float rs16(float (&s)[16], int lane) {
    float r8[8], r4[4], r2[2];
    const bool b3 = lane & 8, b2 = lane & 4;
#pragma unroll
    for (int i = 0; i < 8; ++i) { const auto rr = __builtin_amdgcn_permlane32_swap(__float_as_uint(s[i]), __float_as_uint(s[i + 8]), false, false); r8[i] = __uint_as_float(rr[0]) + __uint_as_float(rr[1]); }
#pragma unroll
    for (int i = 0; i < 4; ++i) { const auto rr = __builtin_amdgcn_permlane16_swap(__float_as_uint(r8[i]), __float_as_uint(r8[i + 4]), false, false); r4[i] = __uint_as_float(rr[0]) + __uint_as_float(rr[1]); }
#pragma unroll
    for (int i = 0; i < 2; ++i) { const float send = b3 ? r4[i] : r4[i + 2], keep = b3 ? r4[i + 2] : r4[i]; r2[i] = keep + DPPF(send, 0x128); }
    float r = (b2 ? r2[1] : r2[0]) + DPPF(b2 ? r2[0] : r2[1], 0x141);
    r += DPPF(r, 0xB1); r += DPPF(r, 0x4E);
    return r;
}
__device__ __forceinline__ void ph_norm2_router(const Ctx& a, LAS unsigned char* lds, int layer, int nrows) {
    const int tid = threadIdx.x, lane = tid & 63, gw = blockIdx.x * NWAVES + (tid >> 6), NGW = gridDim.x * NWAVES;
    LAS float* wrT = (LAS float*)lds;
    const float* wr = a.in(I_WR) + (size_t)layer * D * NE;
    { f32x4 wv[8];
#pragma unroll
      for (int j = 0; j < 8; ++j) wv[j] = *(const f32x4*)(wr + 4 * (tid + NTHREADS * j));
#pragma unroll
      for (int j = 0; j < 8; ++j) { const int i = 4 * (tid + NTHREADS * j), k = i >> 4, e0 = i & 15;
          wrT[(e0 + 0) * 1024 + k] = wv[j].x; wrT[(e0 + 1) * 1024 + k] = wv[j].y; wrT[(e0 + 2) * 1024 + k] = wv[j].z; wrT[(e0 + 3) * 1024 + k] = wv[j].w; } }
    __syncthreads();
    unsigned char* ws = a.ws();
    bf16_t* XN = (bf16_t*)(ws + WS_XN); const bf16_t* H = (const bf16_t*)(ws + WS_H);
    float* PL = (float*)(ws + WS_PROBS); float* PC = PL + NB * NE * SEQ;
    const float* n2g = a.in(I_N2G) + layer * D;
    const int elane = ((lane >> 5) & 1) * 8 + ((lane >> 4) & 1) * 4 + ((lane >> 3) & 1) * 2 + ((lane >> 2) & 1);
    f32x4 v0[4], v1[4], n0[4], n1[4];
    int p = gw;
    if (p < nrows / 2) { load_row_bf16(H + (size_t)(2 * p) * D, lane, v0); load_row_bf16(H + (size_t)(2 * p + 1) * D, lane, v1); }
    for (; p < nrows / 2; p += NGW) {
        const int pn = p + NGW;
        if (pn < nrows / 2) { load_row_bf16(H + (size_t)(2 * pn) * D, lane, n0); load_row_bf16(H + (size_t)(2 * pn + 1) * D, lane, n1); }
        const int row = 2 * p;
        const float* mp = (const float*)(ws + WS_MOD) + (size_t)(layer * 9 + mod_row(row)) * 6144;
        rms_mod(v0, n2g, mp + M_SH2, mp + M_SC2, lane); rms_mod(v1, n2g, mp + M_SH2, mp + M_SC2, lane);
#if FP8_MOE
        store_row_fp8((unsigned char*)XN + (size_t)row * D, lane, v0); store_row_fp8((unsigned char*)XN + (size_t)(row + 1) * D, lane, v1);
#else
        store_row_bf16(XN + (size_t)row * D, lane, v0); store_row_bf16(XN + (size_t)(row + 1) * D, lane, v1);
#endif
        float s0[16], s1[16];
#pragma unroll
        for (int e = 0; e < 16; ++e) {
            float a0 = 0.f, a1 = 0.f;
#pragma unroll
            for (int j = 0; j < 4; ++j) { const f32x4 w = *(const LAS f32x4*)(wrT + e * 1024 + 4 * lane + 256 * j);
                a0 += (v0[j].x * w.x + v0[j].y * w.y) + (v0[j].z * w.z + v0[j].w * w.w); a1 += (v1[j].x * w.x + v1[j].y * w.y) + (v1[j].z * w.z + v1[j].w * w.w); }
            s0[e] = a0; s1[e] = a1;
            if ((e & 3) == 3) asm volatile("" ::: "memory");
        }
        const float l0 = rs16(s0, lane), l1 = rs16(s1, lane);
        const float m0 = wave_max(l0), m1 = wave_max(l1);
        const float e0 = expf(l0 - m0), e1 = expf(l1 - m1);
        const float q0 = e0 / (wave_sum(e0) * 0.25f), q1 = e1 / (wave_sum(e1) * 0.25f);
        if ((lane & 3) == 0) {
            if (row < RL) { float* d = PL + ((size_t)(row >> 11) * NE + elane) * SEQ + (row & 2047); *(f32x2*)d = (f32x2){q0, q1}; }
            else { const int rc = row - RL; float* d = PC + ((size_t)(rc >> 8) * NE + elane) * CTXL + (rc & 255); *(f32x2*)d = (f32x2){q0, q1}; }
        }
#pragma unroll
        for (int j = 0; j < 4; ++j) { v0[j] = n0[j]; v1[j] = n1[j]; }
    }
    __syncthreads();
}
#ifndef ROUTER_MFMA
#define ROUTER_MFMA 1
#endif
#ifndef NR_DOT2
#define NR_DOT2 0
#endif
__device__ __forceinline__ void ph_norm2_router_mfma(const Ctx& a, LAS unsigned char* lds, int layer) {
    const int tid = threadIdx.x, lane = tid & 63, wave = __builtin_amdgcn_readfirstlane(tid >> 6), c = blockIdx.x;
    const int bpg = layer == 0 ? 28 : 32, ngrp = layer == 0 ? 9 : 8;
    const int grp = c / bpg, jb = c - grp * bpg;
    if (grp >= ngrp) return;
    const int tb = (128 * jb) / bpg, te = (128 * (jb + 1)) / bpg;
    unsigned char* ws = a.ws();
    unsigned char* XN8 = ws + WS_XN; const bf16_t* H = (const bf16_t*)(ws + WS_H);
    float* PL = (float*)(ws + WS_PROBS); float* PC = PL + NB * NE * SEQ;
    const float* n2g = a.in(I_N2G) + layer * D; const float* wr = a.in(I_WR) + (size_t)layer * D * NE;
    const float* mp = (const float*)(ws + WS_MOD) + (size_t)(layer * 9 + grp) * 6144;
    LAS unsigned short* WB = (LAS unsigned short*)lds;
    LAS float* GM = (LAS float*)(lds + 65536);
    LAS float* SH = (LAS float*)(lds + 65536 + 4096);
    LAS float* red = (LAS float*)(lds + 65536 + 8192);
    LAS float* cb = (LAS float*)(lds + 65536 + 8192 + 2048);
    const int tl = tb + wave; const bool has = tl < te;
    const int row0 = grp * SEQ + 16 * tl;
    const int r = lane & 15, q = lane >> 4;
    const bf16_t* hrow = H + (size_t)(row0 + r) * D + 16 * q;
    bf16x8 x[32];
    if (has) {
#pragma unroll
        for (int t = 0; t < 16; ++t) { x[2 * t] = *(const bf16x8*)(hrow + 64 * t); x[2 * t + 1] = *(const bf16x8*)(hrow + 64 * t + 8); }
    }
    if (tid < 256) { const f32x4 g4 = *(const f32x4*)(n2g + 4 * tid), s4 = *(const f32x4*)(mp + M_SC2 + 4 * tid), h4 = *(const f32x4*)(mp + M_SH2 + 4 * tid);
        *(LAS f32x4*)(GM + 4 * tid) = g4 * (1.0f + s4); *(LAS f32x4*)(SH + 4 * tid) = h4; }
    const int e = tid & 15;
    float w[4][8];
#pragma unroll
    for (int it = 0; it < 4; ++it)
#pragma unroll
        for (int j = 0; j < 8; ++j) w[it][j] = wr[(8 * ((tid >> 4) + 32 * it) + j) * 16 + e];
    __syncthreads();
    float rstd = 0.f;
    if (has) {
        float ss = 0.f;
#pragma unroll
        for (int s = 0; s < 32; ++s) {
#pragma unroll
            for (int j = 0; j < 8; ++j) { const float f = bf2f((bf16_t)x[s][j]); ss += f * f; }
        }
        ss += __shfl_xor(ss, 16); ss += __shfl_xor(ss, 32);
        rstd = 1.0f / sqrtf(ss * (1.0f / D) + EPS);
        unsigned char* xo = XN8 + (size_t)(row0 + r) * D + 16 * q;
#pragma unroll
        for (int t = 0; t < 16; ++t) {
            unsigned o[4];
#pragma unroll
            for (int u = 0; u < 4; ++u) {
                const f32x4 g4 = *(const LAS f32x4*)(GM + 64 * t + 16 * q + 4 * u) * rstd, h4 = *(const LAS f32x4*)(SH + 64 * t + 16 * q + 4 * u);
                const bf16x8 xv = x[2 * t + (u >> 1)]; const int j0 = 4 * (u & 1);
                o[u] = pk4_fp8(bf2f((bf16_t)xv[j0]) * g4.x + h4.x, bf2f((bf16_t)xv[j0 + 1]) * g4.y + h4.y, bf2f((bf16_t)xv[j0 + 2]) * g4.z + h4.z, bf2f((bf16_t)xv[j0 + 3]) * g4.w + h4.w);
            }
            *(u32x4*)(xo + 64 * t) = (u32x4){o[0], o[1], o[2], o[3]};
        }
    }
    { float pb = 0.f;
#pragma unroll
      for (int it = 0; it < 4; ++it) {
          const int ko = (tid >> 4) + 32 * it;
          const f32x4 ga = *(const LAS f32x4*)(GM + 8 * ko), gb = *(const LAS f32x4*)(GM + 8 * ko + 4), ha = *(const LAS f32x4*)(SH + 8 * ko), hb = *(const LAS f32x4*)(SH + 8 * ko + 4);
          pb += (w[it][0] * ha.x + w[it][1] * ha.y) + (w[it][2] * ha.z + w[it][3] * ha.w) + (w[it][4] * hb.x + w[it][5] * hb.y) + (w[it][6] * hb.z + w[it][7] * hb.w);
          const float wm[8] = {w[it][0] * ga.x, w[it][1] * ga.y, w[it][2] * ga.z, w[it][3] * ga.w, w[it][4] * gb.x, w[it][5] * gb.y, w[it][6] * gb.z, w[it][7] * gb.w};
          unsigned hi[8], lo[8];
#pragma unroll
          for (int j = 0; j < 8; ++j) { hi[j] = f2bf(wm[j]); lo[j] = f2bf(wm[j] - bf2f((bf16_t)hi[j])); }
          const int step = 2 * (ko >> 3) + (ko & 1), qq = (ko >> 1) & 3;
          const int base = ((step * 4 + qq) * 16 + e) * 8;
          *(LAS u32x4*)(WB + base) = (u32x4){hi[0] | (hi[1] << 16), hi[2] | (hi[3] << 16), hi[4] | (hi[5] << 16), hi[6] | (hi[7] << 16)};
          *(LAS u32x4*)(WB + 32 * 4 * 16 * 8 + base) = (u32x4){lo[0] | (lo[1] << 16), lo[2] | (lo[3] << 16), lo[4] | (lo[5] << 16), lo[6] | (lo[7] << 16)};
      }
      red[(tid >> 4) * 16 + e] = pb; }
    __syncthreads();
    if (tid < 16) { float sacc = 0.f;
#pragma unroll
        for (int i = 0; i < 32; ++i) sacc += red[i * 16 + tid];
        cb[tid] = sacc; }
    __syncthreads();
    if (has) {
        f32x4 acc = (f32x4){0.f, 0.f, 0.f, 0.f};
#pragma unroll
        for (int s = 0; s < 32; ++s) {
            const bf16x8 bh = *(const LAS bf16x8*)(WB + ((s * 4 + q) * 16 + r) * 8), bl = *(const LAS bf16x8*)(WB + 32 * 4 * 16 * 8 + ((s * 4 + q) * 16 + r) * 8);
            acc = __builtin_amdgcn_mfma_f32_16x16x32_bf16(x[s], bh, acc, 0, 0, 0); acc = __builtin_amdgcn_mfma_f32_16x16x32_bf16(x[s], bl, acc, 0, 0, 0);
        }
        const float cbv = cb[r];
        f32x4 pr4;
#pragma unroll
        for (int g = 0; g < 4; ++g) {
            const float lg = acc[g] * __shfl(rstd, 4 * q + g) + cbv;
            float mx = lg; mx = fmaxf(mx, DPPF(mx, 0xB1)); mx = fmaxf(mx, DPPF(mx, 0x4E)); mx = fmaxf(mx, DPPF(mx, 0x141)); mx = fmaxf(mx, DPPF(mx, 0x140));
            const float ex = expf(lg - mx);
            float sm = ex; sm += DPPF(sm, 0xB1); sm += DPPF(sm, 0x4E); sm += DPPF(sm, 0x141); sm += DPPF(sm, 0x140);
            pr4[g] = ex / sm;
        }
        float* pdst = grp < 8 ? PL + ((size_t)grp * NE + r) * SEQ + 16 * tl + 4 * q : PC + ((size_t)(tl >> 4) * NE + r) * CTXL + 16 * (tl & 15) + 4 * q;
#if NR_HANDOFF && TK_HANDOFF
        if ((int)gridDim.x == 256) {
#pragma unroll
            for (int g = 0; g < 4; ++g) __hip_atomic_store(pdst + g, pr4[g], __ATOMIC_RELAXED, __HIP_MEMORY_SCOPE_AGENT);
            asm volatile("s_waitcnt vmcnt(0)" ::: "memory");
            if (lane == 0) (void)__hip_atomic_fetch_add((unsigned*)(ws + WS_CTL) + CW_NRC + 64 * (9 * layer + grp), 1u, __ATOMIC_RELAXED, __HIP_MEMORY_SCOPE_AGENT);
        } else
#endif
        *(f32x4*)pdst = pr4;
    }
    __syncthreads();
}
#ifndef TOPK_WAVE
#define TOPK_WAVE 1
#endif
#define TOPK_W (TOPK_WAVE && GU_GATHER && FP8_MOE && FAST_GU)
#ifndef TK_VCOUNT
#define TK_VCOUNT 0
#endif
#ifndef TK_PRECHK
#define TK_PRECHK 1
#endif
#ifndef TOPK_BLOCKS
#define TOPK_BLOCKS 32
#endif
#ifndef SEL_LISTMAJOR
#define SEL_LISTMAJOR 0
#endif
__device__ __forceinline__ size_t sel_index(int row, int e) {
#if TOPK_W && SEL_LISTMAJOR
    return row < RL ? ((size_t)(row >> 11) * NE + e) * SEQ + (row & (SEQ - 1)) : (size_t)NB * NE * SEQ + ((size_t)((row - RL) >> 8) * NE + e) * CTXL + ((row - RL) & (CTXL - 1));
#else
    return (size_t)row * NE + e;
#endif
}
template <int NI>
__device__ __forceinline__ void topk_wave(const float* src, int cap, int* selt, float* gate, int* xrow, int rowbase, int lane, LAS unsigned* lv, unsigned* done, const unsigned* ready) {
    unsigned v[NI];
    if (ready) {
        if (lane == 0) { unsigned sp = 0; while (__hip_atomic_load(ready, __ATOMIC_RELAXED, __HIP_MEMORY_SCOPE_AGENT) < 128u && ++sp < (1u << 20)) __builtin_amdgcn_s_sleep(1); }
#pragma unroll
        for (int i = 0; i < NI; ++i) v[i] = __hip_atomic_load((const unsigned*)src + i * 64 + lane, __ATOMIC_RELAXED, __HIP_MEMORY_SCOPE_AGENT);
    } else {
#pragma unroll
        for (int i = 0; i < NI; ++i) v[i] = __float_as_uint(src[i * 64 + lane]);
    }
#pragma unroll
    for (int i = 0; i < NI; ++i) lv[i * 64 + lane] = v[i];
#if TK_VCOUNT
#define TK_COUNT(c, cand) do { int cl_ = 0; _Pragma("unroll") for (int i = 0; i < NI; ++i) cl_ += (v[i] >= (cand)) ? 1 : 0;                         \
        cl_ += __builtin_amdgcn_update_dpp(0, cl_, 0xB1, 0xF, 0xF, true); cl_ += __builtin_amdgcn_update_dpp(0, cl_, 0x4E, 0xF, 0xF, true); \
        cl_ += __builtin_amdgcn_update_dpp(0, cl_, 0x141, 0xF, 0xF, true); cl_ += __builtin_amdgcn_update_dpp(0, cl_, 0x140, 0xF, 0xF, true); \
        (c) = (__builtin_amdgcn_readlane(cl_, 0) + __builtin_amdgcn_readlane(cl_, 16)) + (__builtin_amdgcn_readlane(cl_, 32) + __builtin_amdgcn_readlane(cl_, 48)); } while (0)
#else
#define TK_COUNT(c, cand) do { int c_ = 0; _Pragma("unroll") for (int i = 0; i < NI; ++i) c_ += __popcll(__ballot(v[i] >= (cand))); (c) = c_; } while (0)
#endif
    unsigned prefix = 0u; int tg = 0, step0 = 1;
#if TK_PRECHK
    { int c; TK_COUNT(c, 0x3c000000u); if (c >= cap) { prefix = 0x3c000000u; step0 = 5; } }
#endif
#pragma unroll 1
    for (int step = step0; step < 32; ++step) {
        const unsigned cand = step < 31 ? (prefix | (1u << (30 - step))) : prefix + 1u; int c;
        TK_COUNT(c, cand);
        if (step < 31) { if (c == cap) { prefix = cand - 1u; tg = cap; break; }
                         if (c > cap) prefix = cand; }
        else tg = c;
    }
#undef TK_COUNT
    const int need = cap - tg; const unsigned long long lt = (1ull << lane) - 1ull;
    int slotbase = 0, eqseen = 0;
#pragma unroll 4
    for (int i = 0; i < NI; ++i) {
        const unsigned x = lv[i * 64 + lane];
        const bool gt = x > prefix, eq = x == prefix;
        const unsigned long long meq = __ballot(eq);
        const bool sl = gt || (eq && (eqseen + __popcll(meq & lt)) < need);
        const unsigned long long msel = __ballot(sl);
        const int slot = slotbase + __popcll(msel & lt), t = i * 64 + lane;
        selt[SEL_LISTMAJOR ? t : t * NE] = sl ? slot : -1;
        if (sl) { __hip_atomic_store(xrow + slot, rowbase + t, __ATOMIC_RELAXED, __HIP_MEMORY_SCOPE_AGENT); gate[slot] = __uint_as_float(x); }
        slotbase += __popcll(msel); eqseen += __popcll(meq);
    }
    asm volatile("s_waitcnt vmcnt(0)" ::: "memory");
    if (lane == 0) (void)__hip_atomic_fetch_add(done, 1u, __ATOMIC_RELAXED, __HIP_MEMORY_SCOPE_AGENT);
}
__device__ __forceinline__ void ph_topk_gather(const Ctx& a, LAS unsigned char* lds, int layer) {
    const int tid = threadIdx.x, lane = tid & 63, wave = tid >> 6;
    LAS int* idxl = (LAS int*)lds;
    LAS int* cnt = (LAS int*)(lds + 1024);
    unsigned char* ws = a.ws();
    const float* PL = (const float*)(ws + WS_PROBS); const float* PC = PL + NB * NE * SEQ;
    float* GATE = (float*)(ws + WS_GATE); int* SEL = (int*)(ws + WS_SEL); int* XROW = (int*)(ws + WS_XROW);
    const bf16_t* XN = (const bf16_t*)(ws + WS_XN); bf16_t* XG = (bf16_t*)(ws + WS_XG);
    const int nunits = layer == 0 ? 256 : 128, rpe = layer == 0 ? RPE0 : RPE1;
#if TOPK_W
    if ((int)gridDim.x == 256) {
        const int c = blockIdx.x;
        if (c < TOPK_BLOCKS) {
            constexpr int LPB = 128 / TOPK_BLOCKS;
            const int wv = __builtin_amdgcn_readfirstlane(wave);
            if (wv < LPB) { const int u = c * LPB + wv, b = u >> 4, e = u & 15; const int xgbase = e * rpe + b * CAPL;
                topk_wave<SEQ / 64>(PL + ((size_t)b * NE + e) * SEQ, CAPL, SEL + sel_index(b * SEQ, e), GATE + xgbase, XROW + xgbase, b * SEQ, lane, (LAS unsigned*)(lds + wv * 8192), (unsigned*)(ws + WS_CTL) + CW_TKC + 64 * (16 * layer + e), (NR_HANDOFF && TK_HANDOFF) ? (const unsigned*)(ws + WS_CTL) + CW_NRC + 64 * (9 * layer + b) : nullptr); }
            else if (wv >= 4 && wv < 4 + LPB && layer == 0) { const int u = c * LPB + wv - 4, b = u >> 4, e = u & 15; const int xgbase = e * rpe + NB * CAPL + b * CAPC;
                topk_wave<CTXL / 64>(PC + ((size_t)b * NE + e) * CTXL, CAPC, SEL + sel_index(RL + b * CTXL, e), GATE + xgbase, XROW + xgbase, RL + b * CTXL, lane, (LAS unsigned*)(lds + wv * 8192), (unsigned*)(ws + WS_CTL) + CW_TKC + 64 * (16 * layer + e), (NR_HANDOFF && TK_HANDOFF) ? (const unsigned*)(ws + WS_CTL) + CW_NRC + 64 * (9 * layer + 8) : nullptr); }
        } else {
#if CVT_HIDE
            if (layer == 1) cvt8_run(a, 1, CV1_TK + (c - TOPK_BLOCKS), 256 - TOPK_BLOCKS, CV1_TK + CVQ_TK1, lds);
            else cvt8_run(a, 0, CV0_TK + (c - TOPK_BLOCKS), 256 - TOPK_BLOCKS, CV0_TK + CVQ_TK0, lds);
#endif
        }
        return;
    }
#endif
    const unsigned long long lt = (1ull << lane) - 1ull;
    for (int u0 = blockIdx.x; u0 < nunits; u0 += gridDim.x) {
        const int u = layer == 0 ? ((u0 & 1) * 128 + (u0 >> 1)) : u0;
        const bool lat = u < 128; const int b = (u & 127) >> 4, e = u & 15;
        const int n = lat ? SEQ : CTXL, cap = lat ? CAPL : CAPC;
        const float* src = lat ? PL + ((size_t)b * NE + e) * SEQ : PC + ((size_t)b * NE + e) * CTXL;
        const int rowbase = lat ? b * SEQ : RL + b * CTXL;
        const int xgbase = e * rpe + (lat ? b * CAPL : NB * CAPL + b * CAPC);
        unsigned v[4];
#pragma unroll
        for (int i = 0; i < 4; ++i) { const int t = wave * 256 + i * 64 + lane; v[i] = t < n ? __float_as_uint(src[t]) : 0u; }
        unsigned prefix = 0u;
#pragma unroll 1
        for (int bit = 30; bit >= 0; --bit) {
            const unsigned cand = prefix | (1u << bit); int c = 0;
#pragma unroll
            for (int i = 0; i < 4; ++i) c += __popcll(__ballot(v[i] >= cand));
            LAS int* slot = cnt + (bit & 1) * 8;
            if (lane == 0) slot[wave] = c;
            __syncthreads();
            int tot = 0;
#pragma unroll
            for (int w = 0; w < 8; ++w) tot += slot[w];
            if (tot >= cap) prefix = cand;
        }
        int mg = 0, me = 0;
#pragma unroll
        for (int i = 0; i < 4; ++i) { mg += __popcll(__ballot(v[i] > prefix)); me += __popcll(__ballot(v[i] == prefix)); }
        if (lane == 0) { cnt[16 + wave] = mg; cnt[24 + wave] = me; }
        __syncthreads();
        int tg = 0, eqb = 0;
#pragma unroll
        for (int w = 0; w < 8; ++w) { tg += cnt[16 + w]; eqb += (w < wave) ? cnt[24 + w] : 0; }
        const int need = cap - tg;
        bool sel[4]; int ms = 0, eqseen = eqb;
#pragma unroll
        for (int i = 0; i < 4; ++i) {
            const bool gt = v[i] > prefix, eq = v[i] == prefix;
            const unsigned long long meq = __ballot(eq);
            sel[i] = gt || (eq && (eqseen + __popcll(meq & lt)) < need);
            ms += __popcll(__ballot(sel[i])); eqseen += __popcll(meq);
        }
        if (lane == 0) cnt[32 + wave] = ms;
        __syncthreads();
        int slotbase = 0;
#pragma unroll
        for (int w = 0; w < 8; ++w) slotbase += (w < wave) ? cnt[32 + w] : 0;
#pragma unroll
        for (int i = 0; i < 4; ++i) {
            const unsigned long long msel = __ballot(sel[i]);
            const int slot = slotbase + __popcll(msel & lt), t = wave * 256 + i * 64 + lane;
            if (t < n) SEL[sel_index(rowbase + t, e)] = sel[i] ? slot : -1;
#if GU_GATHER && FP8_MOE && FAST_GU
            if (sel[i]) { XROW[xgbase + slot] = rowbase + t; GATE[xgbase + slot] = __uint_as_float(v[i]); }
            slotbase += __popcll(msel);
        }
        __syncthreads();
        for (int slot = wave; slot < 0; slot += NWAVES) {
#else
            if (sel[i]) { idxl[slot] = t; GATE[xgbase + slot] = __uint_as_float(v[i]); }
            slotbase += __popcll(msel);
        }
        __syncthreads();
        for (int slot = wave; slot < cap; slot += NWAVES) {
#endif
            const int t = idxl[slot];
#if FP8_MOE
            ((u32x4*)((unsigned char*)XG + (size_t)(xgbase + slot) * D))[lane] = ((const u32x4*)((const unsigned char*)XN + (size_t)(rowbase + t) * D))[lane];
#else
            const u32x4* s = (const u32x4*)(XN + (size_t)(rowbase + t) * D);
            u32x4* d = (u32x4*)(XG + (size_t)(xgbase + slot) * D);
            d[lane] = s[lane]; d[lane + 64] = s[lane + 64];
#endif
        }
        __syncthreads();
    }
#if CVT_HIDE && FP8_MOE
    if (layer == 1 && (int)blockIdx.x >= 128 && (int)gridDim.x > 128)
        cvt8_run(a, 1, CV1_TK + ((int)blockIdx.x - 128), (int)gridDim.x - 128, CV1_TK + CVQ_TK1, lds);
    if (layer == 0 && ((int)blockIdx.x & 1) && (int)gridDim.x == 256)
        cvt8_run(a, 0, CV0_TK + ((int)blockIdx.x >> 1), 128, CV0_TK + CVQ_TK0, lds);
#endif
}
template <int MODE>
__device__ __forceinline__ void ph_combine(const Ctx& a, int layer, int nrows) {
    const int lane = threadIdx.x & 63, gw = blockIdx.x * NWAVES + (threadIdx.x >> 6), NGW = gridDim.x * NWAVES;
    bf16_t* H = (bf16_t*)(a.ws() + WS_H); const int* SEL = (const int*)(a.ws() + WS_SEL); const unsigned char* Y = a.ws() + WS_Y;
    const float* GATE = (const float*)(a.ws() + WS_GATE);
    bf16_t* XN = (bf16_t*)(a.ws() + WS_XN);
    const int rpe = layer == 0 ? RPE0 : RPE1;
    f32x4 v[4], vn[4]; int sel = -1, seln = -1;
    if (gw < nrows) { load_row_bf16(H + (size_t)gw * D, lane, v); sel = SEL[sel_index(gw, lane & 15)]; }
    for (int row = gw; row < nrows; row += NGW) {
        const int rnx = row + NGW;
        if (rnx < nrows) { load_row_bf16(H + (size_t)rnx * D, lane, vn); seln = SEL[sel_index(rnx, lane & 15)]; }
        const int mr = mod_row(row);
        const float* mp = mod_ptr(a, layer, mr);
        const int off = row < RL ? (row >> 11) * CAPL : NB * CAPL + ((row - RL) >> 8) * CAPC;
        f32x4 acc[4];
#pragma unroll
        for (int j = 0; j < 4; ++j) acc[j] = (f32x4){0.f, 0.f, 0.f, 0.f};
        unsigned mask = (unsigned)(__ballot(sel >= 0) & 0xffffull);
        int yw[4][4]; float gk[4];
#pragma unroll
        for (int k = 0; k < 4; ++k) {
            const bool on = mask != 0u; const int e = on ? __builtin_ctz(mask) : 0; mask = on ? (mask & (mask - 1u)) : 0u;
            const int sidx = __builtin_amdgcn_readlane(sel, e);
            const int yrow = on ? (e * rpe + off + sidx) : 0;
            const unsigned char* yr = Y + (size_t)yrow * D;
            gk[k] = on ? GATE[yrow] : 0.f;
#pragma unroll
            for (int j = 0; j < 4; ++j) { const int w = __builtin_nontemporal_load((const int*)(yr + 4 * lane + 256 * j)); yw[k][j] = on ? w : 0; }
        }
#pragma unroll
        for (int k = 0; k < 4; ++k)
#pragma unroll
            for (int j = 0; j < 4; ++j) { const f32x2 lo = __builtin_amdgcn_cvt_pk_f32_fp8(yw[k][j], false), hi2 = __builtin_amdgcn_cvt_pk_f32_fp8(yw[k][j], true);
                acc[j].x += gk[k] * lo.x; acc[j].y += gk[k] * lo.y; acc[j].z += gk[k] * hi2.x; acc[j].w += gk[k] * hi2.y; }
        while (mask != 0u) {
            const int e = __builtin_ctz(mask); mask &= mask - 1u;
            const int sidx = __builtin_amdgcn_readlane(sel, e);
            const int yrow = e * rpe + off + sidx; const float g1 = GATE[yrow];
            const unsigned char* yr = Y + (size_t)yrow * D;
#pragma unroll
            for (int j = 0; j < 4; ++j) { const int w = *(const int*)(yr + 4 * lane + 256 * j); const f32x2 lo = __builtin_amdgcn_cvt_pk_f32_fp8(w, false), hi2 = __builtin_amdgcn_cvt_pk_f32_fp8(w, true);
                acc[j].x += g1 * lo.x; acc[j].y += g1 * lo.y; acc[j].z += g1 * hi2.x; acc[j].w += g1 * hi2.y; }
        }
#pragma unroll
        for (int j = 0; j < 4; ++j) { const f32x4 g2 = *(const f32x4*)(mp + M_G2 + 4 * lane + 256 * j); v[j] = v[j] + g2 * (acc[j] * (1.0f / Y_SCALE)); }
        if (MODE == 0) {
            store_row_bf16(H + (size_t)row * D, lane, v);
            const float* mp1 = mod_ptr(a, 1, mr);
            rms_mod(v, a.in(I_N1G) + D, mp1 + M_SH1, mp1 + M_SC1, lane);
            store_row_bf16(XN + (size_t)row * D, lane, v);
        } else {
            rms_mod(v, a.in(I_FG), nullptr, nullptr, lane);
            { float* po = a.out() + (size_t)row * D;
#pragma unroll
              for (int j = 0; j < 4; ++j) __builtin_nontemporal_store(v[j], (f32x4*)(po + 4 * lane + 256 * j)); }
        }
#pragma unroll
        for (int j = 0; j < 4; ++j) v[j] = vn[j];
        sel = seln;
    }
}

__device__ __forceinline__ void ph_qkv_naive(const Ctx& a, LAS unsigned char* lds) {
    const bf16_t* XN = (const bf16_t*)(a.ws() + WS_XN); float* T = (float*)(a.ws() + WS_TMPF);
    for (int t = blockIdx.x; t < (RT / 128) * 48; t += gridDim.x) {
        const int tm = t / 48, tn = t % 48;
        naive_tile(XN + (size_t)tm * 128 * D, D, a.in(I_WQKV) + tn * 64, 3 * D, D, lds,
                   [&](int r, int c, float v) { T[(size_t)(tm * 128 + r) * 3072 + tn * 64 + c] = v; });
    }
}
__device__ __forceinline__ void ph_rope_naive(const Ctx& a) {
    const float* T = (const float*)(a.ws() + WS_TMPF); const float* rope = (const float*)(a.ws() + WS_ROPE);
    bf16_t* Q = (bf16_t*)(a.ws() + WS_Q); bf16_t* Kb = (bf16_t*)(a.ws() + WS_K); bf16_t* V = (bf16_t*)(a.ws() + WS_V);
    const size_t total = (size_t)RT * 3072, nth = (size_t)gridDim.x * NTHREADS;
    for (size_t i = (size_t)blockIdx.x * NTHREADS + threadIdx.x; i < total; i += nth) {
        const int row = (int)(i / 3072), c = (int)(i % 3072);
        if (c >= 2048) { V[(size_t)row * D + (c - 2048)] = (bf16_t)f2bf(T[i]); continue; }
        const int d = c & 63; if ((d & 31) >= 16) continue;
        float x1 = T[i], x2 = T[i + 16];
        if (row < RL) {
            const int t = row & 2047, axis = d >> 5, f = d & 15, pos = axis == 0 ? (t >> 6) : (t & 63);
            const float cs = rope[pos * 16 + f], sn = rope[1024 + pos * 16 + f];
            const float o1 = x1 * cs - x2 * sn, o2 = x2 * cs + x1 * sn; x1 = o1; x2 = o2;
        }
        if (c < 1024) { Q[(size_t)row * D + c] = (bf16_t)f2bf(x1 * QSCALE); Q[(size_t)row * D + c + 16] = (bf16_t)f2bf(x2 * QSCALE); }
        else { Kb[(size_t)row * D + c - 1024] = (bf16_t)f2bf(x1); Kb[(size_t)row * D + c - 1024 + 16] = (bf16_t)f2bf(x2); }
    }
}
template <int NIT>
__device__ __forceinline__ void naive_attn_item(const Ctx& a, int row, int h, float lam, LAS float* qs, int lane) {
    const bf16_t* Q = (const bf16_t*)(a.ws() + WS_Q); const bf16_t* Kb = (const bf16_t*)(a.ws() + WS_K); const bf16_t* V = (const bf16_t*)(a.ws() + WS_V);
    bf16_t* ATT = (bf16_t*)(a.ws() + WS_ATT);
    const int b = row < RL ? (row >> 11) : ((row - RL) >> 8);
    const int lat0 = b * SEQ, ctx0 = RL + b * CTXL;
    { const unsigned qq = *(const unsigned*)(Q + (size_t)row * D + h * 128 + 2 * lane); qs[2 * lane] = bf_lo(qq); qs[2 * lane + 1] = bf_hi(qq); }
    __builtin_amdgcn_fence(__ATOMIC_RELEASE, "wavefront"); __builtin_amdgcn_wave_barrier(); __builtin_amdgcn_fence(__ATOMIC_ACQUIRE, "wavefront");
#define NA_SCORE(it, d0, d1) do { const int kk_ = (it) * 64 + lane; \
        const int krow_ = (NIT == 36) ? (kk_ < SEQ ? lat0 + kk_ : ctx0 + kk_ - SEQ) : ctx0 + kk_; \
        const u32x4* kp_ = (const u32x4*)(Kb + (size_t)krow_ * D + h * 128); d0 = 0.f; d1 = 0.f; \
        _Pragma("unroll 4") for (int c = 0; c < 16; ++c) { const u32x4 kv = kp_[c]; \
            const f32x4 qa = *(const LAS f32x4*)(qs + 8 * c), qb = *(const LAS f32x4*)(qs + 8 * c + 4); \
            const float dd = (qa.x * bf_lo(kv.x) + qa.y * bf_hi(kv.x)) + (qa.z * bf_lo(kv.y) + qa.w * bf_hi(kv.y)) \
                           + (qb.x * bf_lo(kv.z) + qb.y * bf_hi(kv.z)) + (qb.z * bf_lo(kv.w) + qb.w * bf_hi(kv.w)); \
            if (c < 8) d0 += dd; else d1 += dd; } } while (0)
    float m0 = -3.0e38f, m1 = -3.0e38f, l0 = 0.f, l1 = 0.f;
#pragma unroll 1
    for (int it = 0; it < NIT; ++it) {
        float d0, d1; NA_SCORE(it, d0, d1);
        const float n0 = fmaxf(m0, d0), n1 = fmaxf(m1, d1);
        l0 = l0 * exp2f(m0 - n0) + exp2f(d0 - n0); l1 = l1 * exp2f(m1 - n1) + exp2f(d1 - n1); m0 = n0; m1 = n1;
    }
    { const float g0 = wave_max(m0), g1 = wave_max(m1); l0 = wave_sum(l0 * exp2f(m0 - g0)); l1 = wave_sum(l1 * exp2f(m1 - g1)); m0 = g0; m1 = g1; }
    const float i0 = 1.f / l0, i1 = lam / l1;
    float o0 = 0.f, o1 = 0.f;
#pragma unroll 1
    for (int it = 0; it < NIT; ++it) {
        float d0, d1; NA_SCORE(it, d0, d1);
        const int wbits = __float_as_int(exp2f(d0 - m0) * i0 - exp2f(d1 - m1) * i1);
#pragma unroll 4
        for (int src = 0; src < 64; ++src) {
            const float wv = __int_as_float(__builtin_amdgcn_readlane(wbits, src));
            const int kk = it * 64 + src;
            const int krow = (NIT == 36) ? (kk < SEQ ? lat0 + kk : ctx0 + kk - SEQ) : ctx0 + kk;
            const unsigned vv = *(const unsigned*)(V + (size_t)krow * D + h * 128 + 2 * lane);
            o0 += wv * bf_lo(vv); o1 += wv * bf_hi(vv);
        }
    }
#undef NA_SCORE
    const float ss = wave_sum(o0 * o0 + o1 * o1);
    const float rstd = 1.0f / sqrtf(ss * (1.0f / 128.0f) + EPS);
    const float g0 = a.in(I_SUBG)[2 * lane], g1 = a.in(I_SUBG)[2 * lane + 1];
    *(unsigned*)(ATT + (size_t)row * D + h * 128 + 2 * lane) = pk2(o0 * rstd * g0 * (1.0f - LAMBDA_INIT0), o1 * rstd * g1 * (1.0f - LAMBDA_INIT0));
}
__device__ __forceinline__ float diff_lambda(const Ctx& a, int lane) {
    const float s1 = wave_sum(a.in(I_LQ1)[lane] * a.in(I_LK1)[lane]), s2 = wave_sum(a.in(I_LQ2)[lane] * a.in(I_LK2)[lane]);
    return expf(s1) - expf(s2) + LAMBDA_INIT0;
}
__device__ __forceinline__ void ph_attn_naive(const Ctx& a, LAS unsigned char* lds) {
    const int lane = threadIdx.x & 63, wave = threadIdx.x >> 6, gw = blockIdx.x * NWAVES + wave, NGW = gridDim.x * NWAVES;
    LAS float* qs = (LAS float*)lds + wave * 128;
    const float lam = diff_lambda(a, lane);
    for (int item = gw; item < RT * 8; item += NGW) {
        const int h = item / RT, row = item % RT;
        if (row < RL) naive_attn_item<36>(a, row, h, lam, qs, lane); else naive_attn_item<4>(a, row, h, lam, qs, lane);
    }
}
__device__ __forceinline__ void ph_wo_naive(const Ctx& a, LAS unsigned char* lds) {
    const bf16_t* ATT = (const bf16_t*)(a.ws() + WS_ATT); bf16_t* H = (bf16_t*)(a.ws() + WS_H);
    for (int t = blockIdx.x; t < (RT / 128) * 16; t += gridDim.x) {
        const int tm = t / 16, tn = t % 16;
        naive_tile(ATT + (size_t)tm * 128 * D, D, a.in(I_WO) + tn * 64, D, D, lds, [&](int r, int c, float v) {
            const int row = tm * 128 + r, col = tn * 64 + c;
            const float base = row < RL ? a.in(I_X)[(size_t)row * D + col] : a.in(I_CTX)[(size_t)(row - RL) * D + col];
            H[(size_t)row * D + col] = (bf16_t)f2bf(base + mod_ptr(a, 0, mod_row(row))[M_G1 + col] * v); });
    }
}
__device__ __forceinline__ void ph_gu_naive(const Ctx& a, LAS unsigned char* lds, int layer) {
    const int rpe = layer == 0 ? RPE0 : RPE1, tpe = (rpe / 128) * 88;
    const bf16_t* XG = (const bf16_t*)(a.ws() + WS_XG); float* T = (float*)(a.ws() + WS_TMPF);
    for (int t = blockIdx.x; t < NE * tpe; t += gridDim.x) {
        const int e = t / tpe, q = t % tpe, tm = q / 88, tn = q % 88;
        const size_t row0 = (size_t)e * rpe + tm * 128;
        naive_tile(XG + row0 * D, D, a.in(I_WGU) + (size_t)(layer * NE + e) * D * 2 * DE + tn * 64, 2 * DE, D, lds,
                   [&](int r, int c, float v) { T[(row0 + r) * (2 * DE) + tn * 64 + c] = v; });
    }
}
__device__ __forceinline__ void ph_swiglu_naive(const Ctx& a, int layer) {
    const int rpe = layer == 0 ? RPE0 : RPE1;
    const float* T = (const float*)(a.ws() + WS_TMPF); bf16_t* ACT = (bf16_t*)(a.ws() + WS_ACT);
    const size_t total = (size_t)NE * rpe * DE, nth = (size_t)gridDim.x * NTHREADS;
    for (size_t i = (size_t)blockIdx.x * NTHREADS + threadIdx.x; i < total; i += nth) {
        const size_t row = i / DE; const int j = (int)(i % DE);
        const float g = T[row * (2 * DE) + j], u = T[row * (2 * DE) + DE + j];
        ACT[i] = (bf16_t)f2bf(g / (1.f + expf(-g)) * u);
    }
}
__device__ __forceinline__ void ph_dn_naive(const Ctx& a, LAS unsigned char* lds, int layer) {
    const int rpe = layer == 0 ? RPE0 : RPE1, tpe = (rpe / 128) * 16;
    const bf16_t* ACT = (const bf16_t*)(a.ws() + WS_ACT); unsigned char* Y = a.ws() + WS_Y; const float* GATE = (const float*)(a.ws() + WS_GATE);
    for (int t = blockIdx.x; t < NE * tpe; t += gridDim.x) {
        const int e = t / tpe, q = t % tpe, tm = q / 16, tn = q % 16;
        const size_t row0 = (size_t)e * rpe + tm * 128;
        naive_tile(ACT + row0 * DE, DE, a.in(I_WDN) + (size_t)(layer * NE + e) * DE * D + tn * 64, D, DE, lds,
                   [&](int r, int c, float v) { Y[(row0 + r) * D + tn * 64 + c] = (unsigned char)(pk4_fp8(v * Y_SCALE, 0.f, 0.f, 0.f) & 0xffu); });
    }
}
__device__ __forceinline__ void ph_win_naive(const Ctx& a, LAS unsigned char* lds) {
    const bf16_t* XN = (const bf16_t*)(a.ws() + WS_XN); bf16_t* YG = (bf16_t*)(a.ws() + WS_YG); bf16_t* XR = (bf16_t*)(a.ws() + WS_XR);
    const int TL = (RL / 128) * 32, TC = (RC / 128) * 16;
    for (int t = blockIdx.x; t < TL + TC; t += gridDim.x) {
        int tm, tn; if (t < TL) { tm = t / 32; tn = t % 32; } else { const int q = t - TL; tm = RL / 128 + q / 16; tn = 16 + q % 16; }
        naive_tile(XN + (size_t)tm * 128 * D, D, a.in(I_WIN) + tn * 64, 2 * D, D, lds, [&](int r, int c, float v) {
            const int row = tm * 128 + r, col = tn * 64 + c; const float x = v + a.in(I_BIN)[col];
            if (col < D) YG[(size_t)row * D + col] = (bf16_t)f2bf(gelu_tanh(x)); else XR[(size_t)row * D + col - D] = (bf16_t)f2bf(x); });
    }
}
__device__ __forceinline__ void ph_conv_naive(const Ctx& a) {
    const bf16_t* XR = (const bf16_t*)(a.ws() + WS_XR); bf16_t* XC = (bf16_t*)(a.ws() + WS_XC);
    const size_t total = (size_t)RT * D, nth = (size_t)gridDim.x * NTHREADS;
    for (size_t i = (size_t)blockIdx.x * NTHREADS + threadIdx.x; i < total; i += nth) {
        const int row = (int)(i >> 10), ch = (int)(i & 1023);
        const int t = row < RL ? (row & 2047) : ((row - RL) & 255), L = row < RL ? SEQ : CTXL;
        float v = a.in(I_CONVB)[ch];
#pragma unroll
        for (int j = 0; j < 4; ++j) { const int tt = t - 2 + j; if (tt >= 0 && tt < L) v += a.in(I_CONVW)[j * D + ch] * bf2f(XR[(size_t)(row - t + tt) * D + ch]); }
        XC[i] = (bf16_t)f2bf(v);
    }
}
__device__ __forceinline__ void ph_gates_naive(const Ctx& a, LAS unsigned char* lds) {
    const bf16_t* XC = (const bf16_t*)(a.ws() + WS_XC); float* T = (float*)(a.ws() + WS_TMPF);
    for (int t = blockIdx.x; t < 16 * (RT / 128) * 4; t += gridDim.x) {
        const int m = t / ((RT / 128) * 4), q = t % ((RT / 128) * 4), tm = q >> 2, tn = q & 3, d = m >> 3, kb = m & 7;
        naive_tile(XC + (size_t)tm * 128 * D + kb * 128, D, a.in(I_WGATES) + (size_t)m * 128 * 256 + tn * 64, 256, 128, lds,
                   [&](int r, int c, float v) { T[((size_t)d * RT + tm * 128 + r) * 2048 + kb * 256 + tn * 64 + c] = v; });
    }
}
__device__ __forceinline__ void ph_gate_elem_naive(const Ctx& a) {
    const float* T = (const float*)(a.ws() + WS_TMPF); const bf16_t* XC = (const bf16_t*)(a.ws() + WS_XC);
    bf16_t* LOGA = (bf16_t*)(a.ws() + WS_LOGA); unsigned char* BT = a.ws() + WS_BT;
    const size_t total = (size_t)2 * RT * D, nth = (size_t)gridDim.x * NTHREADS;
    for (size_t i = (size_t)blockIdx.x * NTHREADS + threadIdx.x; i < total; i += nth) {
        const int d = (int)(i / ((size_t)RT * D)); const size_t rc = i % ((size_t)RT * D); const int row = (int)(rc >> 10), ch = (int)(rc & 1023), kb = ch >> 7, cc = ch & 127;
        const float gr = T[((size_t)d * RT + row) * 2048 + kb * 256 + cc] + a.in(I_BGATES)[(d * 8 + kb) * 256 + cc];
        const float gi = T[((size_t)d * RT + row) * 2048 + kb * 256 + 128 + cc] + a.in(I_BGATES)[(d * 8 + kb) * 256 + 128 + cc];
        const float r = sigmoidf_(gr), ig = sigmoidf_(gi);
        const float lam = a.in(I_LAM)[d * D + ch];
        const float la = -8.0f * r * log1pf(expf(-lam));
        const float x = bf2f(XC[rc]);
        const float bt = sqrtf(-expm1f(2.0f * la)) * (ig * x);
        LOGA[i] = (bf16_t)f2bf(la * 1.4426950408889634f); BT[i] = (unsigned char)(pk4_fp8(bt * BT_SCALE, 0.f, 0.f, 0.f) & 0xffu);
    }
}
__device__ __forceinline__ void ph_wout_naive(const Ctx& a, LAS unsigned char* lds) {
    const bf16_t* HS = (const bf16_t*)(a.ws() + WS_HS); bf16_t* H = (bf16_t*)(a.ws() + WS_H);
    for (int t = blockIdx.x; t < (RL / 128) * 16; t += gridDim.x) {
        const int tm = t / 16, tn = t % 16;
        naive_tile(HS + (size_t)tm * 128 * D, D, a.in(I_WOUT) + tn * 64, D, D, lds, [&](int r, int c, float v) {
            const int row = tm * 128 + r, col = tn * 64 + c;
            H[(size_t)row * D + col] = (bf16_t)f2bf(bf2f(H[(size_t)row * D + col]) + mod_ptr(a, 1, row >> 11)[M_G1 + col] * v); });
    }
}

__device__ __forceinline__ int scan_row(int b, int dir, int c, int s) {
    const int p = c * SCH + s;
    if (dir == 0) return p < CTXL ? RL + b * CTXL + p : b * SEQ + (p - CTXL);
    return p < CTXL ? RL + b * CTXL + (CTXL - 1 - p) : b * SEQ + (SEQ - 1 - (p - CTXL));
}
__device__ __forceinline__ void ph_scan1(const Ctx& a) {
    const int lane = threadIdx.x & 63, gw = blockIdx.x * NWAVES + (threadIdx.x >> 6), NGW = gridDim.x * NWAVES;
    const bf16_t* LOGA = (const bf16_t*)(a.ws() + WS_LOGA); const unsigned char* BT = a.ws() + WS_BT;
    float* CP = (float*)(a.ws() + WS_CP); float* CB = (float*)(a.ws() + WS_CB);
    for (int item = gw; item < NB * 2 * NCH * 8; item += NGW) {
        const int cg = item & 7, c = (item >> 3) % NCH, bd = (item >> 3) / NCH, dir = bd & 1, b = bd >> 1;
        const int ch = cg * 128 + 2 * lane;
        float h0 = 0.f, h1 = 0.f, p0 = 0.f, p1 = 0.f;
#pragma unroll 1
        for (int sg = 0; sg < SCH; sg += 32) {
            unsigned la[32], bt[32];
#pragma unroll
            for (int i = 0; i < 32; ++i) { const size_t o = ((size_t)dir * RT + scan_row(b, dir, c, sg + i)) * D + ch; la[i] = *(const unsigned*)(LOGA + o); bt[i] = *(const unsigned short*)(BT + o); }
            asm volatile("" ::: "memory");
#pragma unroll
            for (int i = 0; i < 32; ++i) { const float l0 = bf_lo(la[i]), l1 = bf_hi(la[i]);
                const f32x2 bb = __builtin_amdgcn_cvt_pk_f32_fp8((int)bt[i], false);
                h0 = __builtin_amdgcn_exp2f(l0) * h0 + bb.x; h1 = __builtin_amdgcn_exp2f(l1) * h1 + bb.y; p0 += l0; p1 += l1; }
        }
        const size_t so = ((size_t)(b * 2 + dir) * NCH + c) * D + ch;
        *(f32x2*)(CP + so) = (f32x2){p0, p1}; *(f32x2*)(CB + so) = (f32x2){h0, h1};
    }
}
__device__ __forceinline__ void ph_scan2(const Ctx& a) {
    const int lane = threadIdx.x & 63, gw = blockIdx.x * NWAVES + (threadIdx.x >> 6), NGW = gridDim.x * NWAVES;
    const bf16_t* LOGA = (const bf16_t*)(a.ws() + WS_LOGA); const unsigned char* BT = a.ws() + WS_BT;
    const float* CP = (const float*)(a.ws() + WS_CP); const float* CB = (const float*)(a.ws() + WS_CB);
    const bf16_t* YG = (const bf16_t*)(a.ws() + WS_YG); bf16_t* HS = (bf16_t*)(a.ws() + WS_HS);
    constexpr int NLC = SEQ / SCH;
    for (int item = gw; item < NB * NLC * 8; item += NGW) {
        const int cg = item & 7, j = (item >> 3) % NLC, b = (item >> 3) / NLC;
        const int ch = cg * 128 + 2 * lane;
        const int cb = NCH_CTX + (NLC - 1 - j), cf = NCH_CTX + j;
        float hb0 = 0.f, hb1 = 0.f, hf0 = 0.f, hf1 = 0.f;
#pragma unroll 1
        for (int c0 = 0; c0 < NCH - 1; c0 += 12) {
            f32x2 pb[12], qb[12], pf[12], qf[12];
#pragma unroll
            for (int i = 0; i < 12; ++i) {
                const int c = c0 + i; const size_t sb_ = ((size_t)(b * 2 + 1) * NCH + c) * D + ch, sf_ = ((size_t)(b * 2 + 0) * NCH + c) * D + ch;
                const f32x2 z = (f32x2){0.f, 0.f};
                pb[i] = c < cb ? *(const f32x2*)(CP + sb_) : z; qb[i] = c < cb ? *(const f32x2*)(CB + sb_) : z;
                pf[i] = c < cf ? *(const f32x2*)(CP + sf_) : z; qf[i] = c < cf ? *(const f32x2*)(CB + sf_) : z;
            }
            asm volatile("" ::: "memory");
#pragma unroll
            for (int i = 0; i < 12; ++i) {
                hb0 = __builtin_amdgcn_exp2f(pb[i].x) * hb0 + qb[i].x; hb1 = __builtin_amdgcn_exp2f(pb[i].y) * hb1 + qb[i].y;
                hf0 = __builtin_amdgcn_exp2f(pf[i].x) * hf0 + qf[i].x; hf1 = __builtin_amdgcn_exp2f(pf[i].y) * hf1 + qf[i].y;
            }
        }
        float sb0[SCH], sb1[SCH];
#pragma unroll
        for (int sg = 0; sg < SCH; sg += 32) {
            unsigned la[32], bt[32];
#pragma unroll
            for (int i = 0; i < 32; ++i) { const size_t o = ((size_t)1 * RT + b * SEQ + j * SCH + (SCH - 1 - (sg + i))) * D + ch; la[i] = *(const unsigned*)(LOGA + o); bt[i] = *(const unsigned short*)(BT + o); }
            asm volatile("" ::: "memory");
#pragma unroll
            for (int i = 0; i < 32; ++i) {
                const f32x2 bb = __builtin_amdgcn_cvt_pk_f32_fp8((int)bt[i], false);
                hb0 = __builtin_amdgcn_exp2f(bf_lo(la[i])) * hb0 + bb.x; hb1 = __builtin_amdgcn_exp2f(bf_hi(la[i])) * hb1 + bb.y;
                sb0[SCH - 1 - (sg + i)] = hb0; sb1[SCH - 1 - (sg + i)] = hb1;
            }
        }
#pragma unroll
        for (int sg = 0; sg < SCH; sg += 16) {
            unsigned la[16], bt[16], yg[16];
#pragma unroll
            for (int i = 0; i < 16; ++i) { const size_t o = ((size_t)b * SEQ + j * SCH + sg + i) * D + ch; la[i] = __builtin_nontemporal_load((const unsigned*)(LOGA + o)); bt[i] = __builtin_nontemporal_load((const unsigned short*)(BT + o)); yg[i] = __builtin_nontemporal_load((const unsigned*)(YG + o)); }
            asm volatile("" ::: "memory");
#pragma unroll
            for (int i = 0; i < 16; ++i) {
                const size_t o = ((size_t)b * SEQ + j * SCH + sg + i) * D + ch;
                const f32x2 bb = __builtin_amdgcn_cvt_pk_f32_fp8((int)bt[i], false);
                hf0 = __builtin_amdgcn_exp2f(bf_lo(la[i])) * hf0 + bb.x; hf1 = __builtin_amdgcn_exp2f(bf_hi(la[i])) * hf1 + bb.y;
                *(unsigned*)(HS + o) = pk2(bf_lo(yg[i]) * ((hf0 + sb0[sg + i]) * (1.0f / BT_SCALE)), bf_hi(yg[i]) * ((hf1 + sb1[sg + i]) * (1.0f / BT_SCALE)));
            }
            asm volatile("" ::: "memory");
        }
    }
}
#define XB_TMO      128
#define XB_XCNT(j)  (256  + 64 * (j))
#define XB_XSUB(j)  (1280 + 64 * (j))
#define XB_XGEN(j)  (2304 + 64 * (j))
#define XB_TOP      3328
#define XB_TOPGEN   3392
#define XCD_BAR_WORDS 3456
#define XB_SPIN_CAP (1u << 18)

__device__ __forceinline__ unsigned xb_ld(unsigned* p)              { return __hip_atomic_load(p, __ATOMIC_RELAXED, __HIP_MEMORY_SCOPE_AGENT); }
__device__ __forceinline__ unsigned xb_add(unsigned* p, unsigned v) { return __hip_atomic_fetch_add(p, v, __ATOMIC_RELAXED, __HIP_MEMORY_SCOPE_AGENT); }
__device__ __forceinline__ unsigned xb_xcc_id() { return (unsigned)__builtin_amdgcn_s_getreg((3 << 11) | 20) & 0xFu; }
#define XB_SPIN(cond, bar) do { unsigned _sp = 0; while (cond) { __builtin_amdgcn_s_sleep(1); \
    if ((++_sp & 255u) == 0u) { if (xb_ld(&(bar)[XB_TMO])) break; if (_sp > XB_SPIN_CAP) { atomicAdd(&(bar)[XB_TMO], 1u); break; } } } } while (0)

struct XcdBarrier {
    unsigned* bar; unsigned x;
    volatile LAS unsigned* st;
};

__device__ __forceinline__ XcdBarrier xcd_barrier_post(unsigned* bar, volatile LAS unsigned* st) {
    XcdBarrier b; b.bar = bar; b.x = xb_xcc_id(); b.st = st;
    if (threadIdx.x == 0) (void)xb_add(&bar[XB_XCNT(b.x)], 1u);
    return b;
}
__device__ __forceinline__ void xcd_barrier_complete(unsigned* bar, unsigned x, unsigned& nloc, unsigned& nx) {
    const unsigned G = gridDim.x * gridDim.y * gridDim.z;
    unsigned sum, cnt, mine, sp = 0u;
    for (;;) {
        sum = 0u; cnt = 0u; mine = 0u;
#pragma unroll
        for (unsigned j = 0; j < 16; ++j) { const unsigned c = xb_ld(&bar[XB_XCNT(j)]); sum += c; cnt += (c > 0u) ? 1u : 0u; mine = (j == x) ? c : mine; }
        if (sum == G) break;
        __builtin_amdgcn_s_sleep(1);
        if ((++sp & 255u) == 0u) { if (xb_ld(&bar[XB_TMO])) break; if (sp > XB_SPIN_CAP) { atomicAdd(&bar[XB_TMO], 1u); break; } }
    }
    nloc = mine > 0u ? mine : 1u; nx = cnt > 0u ? cnt : 1u;
}

__device__ __forceinline__ void xcd_barrier(const XcdBarrier& b) {
    asm volatile("s_waitcnt vmcnt(0)" ::: "memory");
    __syncthreads();
    if (threadIdx.x == 0) {
        unsigned* bar = b.bar;
        __builtin_amdgcn_s_waitcnt(0);
        unsigned nloc = b.st[0], nx = b.st[1];
        if (nloc == 0u) { xcd_barrier_complete(bar, b.x, nloc, nx); b.st[0] = nloc; b.st[1] = nx; }
        const unsigned old = xb_add(&bar[XB_XSUB(b.x)], 1u);
        const unsigned gen = old / nloc;
        if (old + 1u == (gen + 1u) * nloc) {
            __builtin_amdgcn_fence(__ATOMIC_RELEASE, "agent");
            asm volatile("s_waitcnt vmcnt(0)" ::: "memory");
            const unsigned og = xb_add(&bar[XB_TOP], 1u);
            const unsigned tg = og / nx;
            if (og + 1u == (tg + 1u) * nx) xb_add(&bar[XB_TOPGEN], 1u);
            else XB_SPIN(xb_ld(&bar[XB_TOPGEN]) == tg, bar);
            __builtin_amdgcn_fence(__ATOMIC_ACQUIRE, "agent");
            xb_add(&bar[XB_XGEN(b.x)], 1u);
            asm volatile("s_waitcnt vmcnt(0)" ::: "memory");
        } else {
            XB_SPIN(xb_ld(&bar[XB_XGEN(b.x)]) == gen, bar);
            __builtin_amdgcn_fence(__ATOMIC_ACQUIRE, "agent");
            asm volatile("s_waitcnt vmcnt(0)" ::: "memory");
        }
    }
    __syncthreads();
}

__device__ __forceinline__ void xcd_barrier_arrive(const XcdBarrier& b) {
    asm volatile("s_waitcnt vmcnt(0)" ::: "memory");
    __syncthreads();
    if (threadIdx.x == 0) {
        unsigned* bar = b.bar;
        __builtin_amdgcn_s_waitcnt(0);
        unsigned nloc = b.st[0], nx = b.st[1];
        if (nloc == 0u) { xcd_barrier_complete(bar, b.x, nloc, nx); b.st[0] = nloc; b.st[1] = nx; }
        const unsigned old = xb_add(&bar[XB_XSUB(b.x)], 1u);
        const unsigned gen = old / nloc;
        unsigned flags = 0u, tg = 0u;
        if (old + 1u == (gen + 1u) * nloc) {
            __builtin_amdgcn_fence(__ATOMIC_RELEASE, "agent");
            asm volatile("s_waitcnt vmcnt(0)" ::: "memory");
            const unsigned og = xb_add(&bar[XB_TOP], 1u);
            tg = og / nx; flags = 1u;
            if (og + 1u == (tg + 1u) * nx) { xb_add(&bar[XB_TOPGEN], 1u); flags = 3u; }
        }
        b.st[2] = gen; b.st[3] = flags; b.st[4] = tg;
    }
    __syncthreads();
}
__device__ __forceinline__ void xcd_barrier_wait(const XcdBarrier& b) {
    asm volatile("s_waitcnt vmcnt(0)" ::: "memory");
    __syncthreads();
    if (threadIdx.x == 0) {
        unsigned* bar = b.bar;
        const unsigned gen = b.st[2], flags = b.st[3], tg = b.st[4];
        if (flags & 1u) {
            if (!(flags & 2u)) XB_SPIN(xb_ld(&bar[XB_TOPGEN]) == tg, bar);
            __builtin_amdgcn_fence(__ATOMIC_ACQUIRE, "agent");
            xb_add(&bar[XB_XGEN(b.x)], 1u);
            asm volatile("s_waitcnt vmcnt(0)" ::: "memory");
        } else {
            XB_SPIN(xb_ld(&bar[XB_XGEN(b.x)]) == gen, bar);
            __builtin_amdgcn_fence(__ATOMIC_ACQUIRE, "agent");
            asm volatile("s_waitcnt vmcnt(0)" ::: "memory");
        }
    }
    __syncthreads();
}

__device__ __forceinline__ int xcd_remap(long L, int n) { const int q = n / 8, r = n % 8, xcd = (int)(L % 8), off = (int)(L / 8); return (xcd < r ? xcd * (q + 1) : r * (q + 1) + (xcd - r) * q) + off; }
template <class Map> struct ListOrder {
    int nunits, G, c; Map map;
    __device__ __forceinline__ bool next(int i, pg8::Unit& u) const { const long L = (long)i * G + c; if (L >= nunits) return false; map(xcd_remap(L, nunits), u); return true; }
    __device__ __forceinline__ void a_ready(const pg8::Unit&) const {}
    __device__ __forceinline__ void done(const pg8::Unit&) const {}
};
#ifndef WGMG
#define WGMG 8
#endif
struct MapGrid { int nN; __device__ __forceinline__ void operator()(int w, pg8::Unit& u) const { const int nig = WGMG * nN; u.pm = (w / nig) * WGMG + (w % nig) % WGMG; u.pn = (w % nig) / WGMG; } };
struct MapMoe { int PM, NT; __device__ __forceinline__ void operator()(int w, pg8::Unit& u) const { const int per = PM * NT, e = w / per, rem = w % per; u.pm = e * PM + rem % PM; u.pn = e * NT + rem / PM; } };
struct MapWin { __device__ __forceinline__ void operator()(int w, pg8::Unit& u) const { if (w < 512) { u.pm = (w / 64) * 8 + (w % 64) % 8; u.pn = (w % 64) / 8; } else { const int q = w - 512; u.pm = 64 + q % 8; u.pn = 4 + q / 8; } } };

typedef pg8::f32x4 pf4;
__device__ __forceinline__ float fast_exp(float x) { return __builtin_amdgcn_exp2f(x * 1.4426950408889634f); }

struct EpiQKV {
    static constexpr bool PERM = true, AFTER_DRAIN = false;
    bf16_t* Q; const LAS float* rope;
    __device__ __forceinline__ void operator()(const pf4 (&acc)[2][2][4][2], const pg8::Unit& u, int wr, int wc, int fr, int fq) const {
        const int sec = u.pn >> 2; bf16_t* base = Q + (size_t)sec * ((WS_K - WS_Q) / 2);
        const bool lat = u.pm < 64, dorope = sec < 2 && lat; const int axis = wc & 1;
        const bool upper = fq >= 2;
        const int row0 = u.pm * 256 + wr * 64 + fr, col0 = (u.pn & 3) * 256 + wc * 32 + 8 * fq;
        const float sc = sec == 0 ? QSCALE : 1.0f;
#pragma unroll
        for (int ai = 0; ai < 2; ++ai)
#pragma unroll
            for (int m = 0; m < 4; ++m) {
                const int row = row0 + ai * 128 + m * 16;
                pf4 cs[2], sn[2];
#pragma unroll
                for (int n = 0; n < 2; ++n) { cs[n] = (pf4){1.f, 1.f, 1.f, 1.f}; sn[n] = (pf4){0.f, 0.f, 0.f, 0.f}; }
                if (dorope) { const int t = row & 2047, pos = axis ? (t & 63) : (t >> 6); const LAS float* rp = rope + pos * 16 + 8 * (fq & 1);
#pragma unroll
                    for (int n = 0; n < 2; ++n) { cs[n] = *(const LAS pf4*)(rp + 4 * n); sn[n] = *(const LAS pf4*)(rp + 1024 + 4 * n); } }
#pragma unroll
                for (int bj = 0; bj < 2; ++bj) {
                    pf4 o[2];
#pragma unroll
                    for (int n = 0; n < 2; ++n)
#pragma unroll
                        for (int j = 0; j < 4; ++j) {
                            const float own = acc[ai][bj][m][n][j];
                            float v = own;
                            if (dorope) {
                                const auto rr = __builtin_amdgcn_permlane32_swap(__float_as_uint(own), __float_as_uint(own), false, false);
                                const float other = __uint_as_float(upper ? rr[0] : rr[1]);
                                v = upper ? (own * cs[n][j] + other * sn[n][j]) : (own * cs[n][j] - other * sn[n][j]);
                            }
                            o[n][j] = v * sc;
                        }
                    u32x4 w; w.x = pk2(o[0][0], o[0][1]); w.y = pk2(o[0][2], o[0][3]); w.z = pk2(o[1][0], o[1][1]); w.w = pk2(o[1][2], o[1][3]);
                    st16_wt(base + (size_t)row * D + col0 + bj * 128, w);
                }
            }
    }
};
struct EpiResid {
    static constexpr bool PERM = true, AFTER_DRAIN = false;
    bf16_t* H; const float* x; const float* ctx; const float* mod; int layer;
    __device__ __forceinline__ void operator()(const pf4 (&acc)[2][2][4][2], const pg8::Unit& u, int wr, int wc, int fr, int fq) const {
        const bool lat = u.pm < 64;
        const float* xb = lat ? x + (size_t)u.pm * 256 * D : ctx + (size_t)(u.pm - 64) * 256 * D;
        const float* g = mod + (size_t)(layer * 9 + (lat ? (u.pm >> 3) : 8)) * 6144 + M_G1;
        bf16_t* out = H + (size_t)u.pm * 256 * D;
        const int r0 = wr * 64 + fr, col0 = u.pn * 256 + wc * 32 + 8 * fq;
        pf4 gv[2][2];
#pragma unroll
        for (int bj = 0; bj < 2; ++bj)
#pragma unroll
            for (int n = 0; n < 2; ++n) gv[bj][n] = *(const pf4*)(g + col0 + bj * 128 + 4 * n);
#pragma unroll
        for (int it = 0; it < 8; ++it) {
            const int ai = it >> 2, m = it & 3;
            const size_t ro = (size_t)(r0 + ai * 128 + m * 16) * D + col0;
#pragma unroll
            for (int bj = 0; bj < 2; ++bj) {
                pf4 b0, b1;
                if (layer == 0) { b0 = *(const pf4*)(xb + ro + bj * 128); b1 = *(const pf4*)(xb + ro + bj * 128 + 4); }
                else { const u32x4 hb = *(const u32x4*)(out + ro + bj * 128); b0 = (pf4){bf_lo(hb.x), bf_hi(hb.x), bf_lo(hb.y), bf_hi(hb.y)}; b1 = (pf4){bf_lo(hb.z), bf_hi(hb.z), bf_lo(hb.w), bf_hi(hb.w)}; }
                const pf4 o0 = b0 + gv[bj][0] * acc[ai][bj][m][0], o1 = b1 + gv[bj][1] * acc[ai][bj][m][1];
                u32x4 w; w.x = pk2(o0[0], o0[1]); w.y = pk2(o0[2], o0[3]); w.z = pk2(o1[0], o1[1]); w.w = pk2(o1[2], o1[3]);
                st16_wt(out + ro + bj * 128, w);
            }
        }
    }
};
struct EpiSwiGLU {
    static constexpr bool PERM = true, AFTER_DRAIN = false;
    bf16_t* ACT;
    __device__ __forceinline__ void operator()(const pf4 (&acc)[2][2][4][2], const pg8::Unit& u, int wr, int wc, int fr, int fq) const {
        const int ct = u.pn % 22;
        bf16_t* p0 = ACT + (size_t)(u.pm * 256 + wr * 64 + fr) * DE + ct * 128 + wc * 32 + 8 * fq;
#pragma unroll
        for (int ai = 0; ai < 2; ++ai)
#pragma unroll
            for (int m = 0; m < 4; ++m) {
                float o[8];
#pragma unroll
                for (int n = 0; n < 2; ++n)
#pragma unroll
                    for (int j = 0; j < 4; ++j) { const float g = acc[ai][0][m][n][j], uu = acc[ai][1][m][n][j]; o[n * 4 + j] = g * __builtin_amdgcn_rcpf(1.0f + fast_exp(-g)) * uu; }
                u32x4 w; w.x = pk2(o[0], o[1]); w.y = pk2(o[2], o[3]); w.z = pk2(o[4], o[5]); w.w = pk2(o[6], o[7]);
                *(u32x4*)(p0 + (size_t)(ai * 128 + m * 16) * DE) = w;
            }
    }
};
#ifndef DN_E8FOLD
#define DN_E8FOLD 1
#endif
struct EpiDown {
    static constexpr bool PERM = true, AFTER_DRAIN = false;
    unsigned char* Y;
    __device__ __forceinline__ void operator()(const pf4 (&acc)[2][2][4][2], const pg8::Unit& u, int wr, int wc, int fr, int fq) const {
        const int row0 = u.pm * 256 + wr * 64 + fr, col0 = (u.pn & 3) * 256 + wc * 32 + 8 * fq;
#pragma unroll
        for (int ai = 0; ai < 2; ++ai)
#pragma unroll
            for (int m = 0; m < 4; ++m) {
                const int row = row0 + ai * 128 + m * 16;
#pragma unroll
                for (int bj = 0; bj < 2; ++bj) {
                    #if FP8_MOE && DN_E8FOLD
                    const pf4 v0 = acc[ai][bj][m][0], v1 = acc[ai][bj][m][1];
#else
                    const pf4 v0 = acc[ai][bj][m][0] * Y_SCALE, v1 = acc[ai][bj][m][1] * Y_SCALE;
#endif
                    u32x2 w; w.x = pk4_fp8(v0[0], v0[1], v0[2], v0[3]); w.y = pk4_fp8(v1[0], v1[1], v1[2], v1[3]);
                    st8_wt(Y + (size_t)row * D + col0 + bj * 128, w);
                }
            }
    }
};
struct EpiWin {
    static constexpr bool PERM = true, AFTER_DRAIN = false;
    bf16_t *YG, *XR; const LAS float* bin;
    __device__ __forceinline__ void operator()(const pf4 (&acc)[2][2][4][2], const pg8::Unit& u, int wr, int wc, int fr, int fq) const {
        const bool yb = u.pn < 4; bf16_t* base = yb ? YG : XR;
        const int row0 = u.pm * 256 + wr * 64 + fr, colg = u.pn * 256 + wc * 32 + 8 * fq, col0 = (u.pn & 3) * 256 + wc * 32 + 8 * fq;
        pf4 bv[2][2];
#pragma unroll
        for (int bj = 0; bj < 2; ++bj)
#pragma unroll
            for (int n = 0; n < 2; ++n) bv[bj][n] = *(const LAS pf4*)(bin + colg + bj * 128 + 4 * n);
#pragma unroll
        for (int ai = 0; ai < 2; ++ai)
#pragma unroll
            for (int m = 0; m < 4; ++m) {
                const int row = row0 + ai * 128 + m * 16;
#pragma unroll
                for (int bj = 0; bj < 2; ++bj) {
                    pf4 v0 = acc[ai][bj][m][0] + bv[bj][0], v1 = acc[ai][bj][m][1] + bv[bj][1];
                    if (yb) {
#pragma unroll
                        for (int j = 0; j < 4; ++j) {
                            { const float x = v0[j], uu = 0.7978845608028654f * (x + 0.044715f * x * x * x); v0[j] = x * __builtin_amdgcn_rcpf(1.0f + fast_exp(-2.0f * uu)); }
                            { const float x = v1[j], uu = 0.7978845608028654f * (x + 0.044715f * x * x * x); v1[j] = x * __builtin_amdgcn_rcpf(1.0f + fast_exp(-2.0f * uu)); }
                        }
                    }
                    u32x4 w; w.x = pk2(v0[0], v0[1]); w.y = pk2(v0[2], v0[3]); w.z = pk2(v1[0], v1[1]); w.w = pk2(v1[2], v1[3]);
                    st16_wt(base + (size_t)row * D + col0 + bj * 128, w);
                }
            }
    }
};

#ifndef DENSE_ALIGN
#define DENSE_ALIGN true
#endif
#ifndef DENSE_SP2
#define DENSE_SP2 true
#endif
__device__ __forceinline__ void stagger_start(int ticks) {
    if (ticks > 0 && ((blockIdx.x >> 3) & 1)) { const unsigned long long t0 = __builtin_amdgcn_s_memrealtime(); while (__builtin_amdgcn_s_memrealtime() - t0 < (unsigned long long)ticks) __builtin_amdgcn_s_sleep(8); }
}
#ifndef STG_QKV
#define STG_QKV 0
#endif
#ifndef STG_GU
#define STG_GU 0
#endif
#ifndef STG_DN
#define STG_DN 0
#endif
#ifndef STG_WIN
#define STG_WIN 0
#endif
#ifndef STG_WO
#define STG_WO 0
#endif
#define PG8_RUN(EPI, SCHED, g, S, E) pg8::gemm_phase<EPI, SCHED, DENSE_ALIGN, DENSE_SP2>((PG8_LAS unsigned char*)lds, g, S, E)

__device__ __forceinline__ void ph_qkv_fast(const Ctx& a, LAS unsigned char* lds) {
    unsigned char* ws = a.ws();
    pg8::Gemm g{(const bf16_t*)(ws + WS_XN), (const bf16_t*)(ws + WS_WQKV), RT, 3 * D, D};
    const int Gq = gemm_groups(72 * 12, (int)gridDim.x, 1);
    if ((int)blockIdx.x >= Gq) { cvt8_run(a, 0, CV0_QKV + ((int)blockIdx.x - Gq), (int)gridDim.x - Gq, CV0_QKV + CVQ_QKV, lds); return; }
    ListOrder<MapGrid> S{72 * 12, Gq, (int)blockIdx.x, MapGrid{12}};
    static_assert(WS_V - WS_K == WS_K - WS_Q, "Q|K|V spacing");
    LAS float* rl = (LAS float*)(lds + ROPE_LDS);
    { const float* rg = (const float*)(ws + WS_ROPE); for (int i = threadIdx.x; i < 2048; i += NTHREADS) rl[i] = rg[i]; }
    __syncthreads();
    EpiQKV E{(bf16_t*)(ws + WS_Q), rl};
    stagger_start(STG_QKV);
    PG8_RUN(EpiQKV, ListOrder<MapGrid>, g, S, E);
    if (Gq == (int)gridDim.x) cvt8_tail(a, lds, 72 * 12, Gq, (int)blockIdx.x, 0, CV0_QKV, CVQ_QKV);
}
__device__ __forceinline__ void ph_wo_fast(const Ctx& a, LAS unsigned char* lds) {
    unsigned char* ws = a.ws();
    pg8::Gemm g{(const bf16_t*)(ws + WS_ATT), (const bf16_t*)(ws + WS_WO), RT, D, D};
    const int Gq = gemm_groups(72 * 4, (int)gridDim.x, 2);
    if ((int)blockIdx.x >= Gq) { cvt8_run(a, 0, CV0_WO + ((int)blockIdx.x - Gq), (int)gridDim.x - Gq, CV0_WO + CVQ_WO, lds); return; }
    ListOrder<MapGrid> S{72 * 4, Gq, (int)blockIdx.x, MapGrid{4}};
    EpiResid E{(bf16_t*)(ws + WS_H), a.in(I_X), a.in(I_CTX), (const float*)(ws + WS_MOD), 0};
    stagger_start(STG_WO);
    PG8_RUN(EpiResid, ListOrder<MapGrid>, g, S, E);
    if (Gq == (int)gridDim.x) cvt8_tail(a, lds, 72 * 4, Gq, (int)blockIdx.x, 0, CV0_WO, CVQ_WO);
}
__device__ __forceinline__ void ph_wout_fast(const Ctx& a, LAS unsigned char* lds) {
    unsigned char* ws = a.ws();
    pg8::Gemm g{(const bf16_t*)(ws + WS_HS), (const bf16_t*)(ws + WS_WOUT), RL, D, D};
    ListOrder<MapGrid> S{64 * 4, (int)gridDim.x, (int)blockIdx.x, MapGrid{4}};
    EpiResid E{(bf16_t*)(ws + WS_H), nullptr, nullptr, (const float*)(ws + WS_MOD), 1};
    PG8_RUN(EpiResid, ListOrder<MapGrid>, g, S, E);
}
#if FP8_MOE
#ifndef SWIGLU_RCP2
#define SWIGLU_RCP2 0
#endif
struct EpiSwiGLU8 {
    static constexpr bool PERM = true, AFTER_DRAIN = false;
    unsigned char* ACT;
    __device__ __forceinline__ void operator()(const pf4 (&acc)[2][2][4][2], const pg8::Unit& u, int wr, int wc, int fr, int fq) const {
        const int ct = u.pn % 22;
        unsigned char* p0 = ACT + (size_t)(u.pm * 256 + wr * 64 + fr) * DE + ct * 128 + wc * 32 + 8 * fq;
#pragma unroll
        for (int ai = 0; ai < 2; ++ai)
#pragma unroll
            for (int m = 0; m < 4; ++m) {
                float o[8];
#if SWIGLU_FOLD
                typedef float f2_t __attribute__((ext_vector_type(2)));
#pragma unroll
                for (int n = 0; n < 2; ++n)
#pragma unroll
                    for (int j = 0; j < 4; j += 2) {
                        const f2_t g2 = {acc[ai][0][m][n][j], acc[ai][0][m][n][j + 1]}, u2 = {acc[ai][1][m][n][j], acc[ai][1][m][n][j + 1]};
                        const f2_t e2 = {__builtin_amdgcn_exp2f(-g2.x), __builtin_amdgcn_exp2f(-g2.y)};
                        const f2_t d2 = e2 + (f2_t){1.0f, 1.0f};
#if SWIGLU_RCP2
                        const float q = __builtin_amdgcn_rcpf(d2.x * d2.y);
                        const f2_t r2 = (f2_t){d2.y, d2.x} * (f2_t){q, q};
#else
                        const f2_t r2 = {__builtin_amdgcn_rcpf(d2.x), __builtin_amdgcn_rcpf(d2.y)};
#endif
                        const f2_t o2 = (g2 * u2) * r2;
                        o[n * 4 + j] = o2.x; o[n * 4 + j + 1] = o2.y; }
#else
#pragma unroll
                for (int n = 0; n < 2; ++n)
#pragma unroll
                    for (int j = 0; j < 4; ++j) { const float g = acc[ai][0][m][n][j], uu = acc[ai][1][m][n][j]; o[n * 4 + j] = g * __builtin_amdgcn_rcpf(1.0f + fast_exp(-g)) * uu; }
#endif
                u32x2 w; w.x = pk4_fp8(o[0], o[1], o[2], o[3]); w.y = pk4_fp8(o[4], o[5], o[6], o[7]);
                st8_wt(p0 + (size_t)(ai * 128 + m * 16) * DE, w);
            }
    }
};
__device__ __forceinline__ void ph_gu_fast(const Ctx& a, LAS unsigned char* lds, int layer) {
    unsigned char* ws = a.ws(); const int PM = (layer == 0 ? RPE0 : RPE1) / 256;
    pg8::Gemm g{(const bf16_t*)(ws + (GU_GATHER ? WS_XN : WS_XG)), (const bf16_t*)(ws + WS_WGU + (size_t)layer * (WGU_LAYER / 2)), NE * PM * 256, NE * 2 * DE, D / 2, (const int*)(ws + WS_XROW),
                (TK_HANDOFF && TOPK_W && (int)gridDim.x == 256) ? (const unsigned*)(ws + WS_CTL) + CW_TKC + 64 * 16 * layer : nullptr, layer == 0 ? 16 : 8, PM};
    const int Gq = layer == 0 ? gemm_groups(NE * PM * 22, (int)gridDim.x, 32) : (int)gridDim.x;
    if ((int)blockIdx.x >= Gq) {
        cvt8_run(a, 0, CV0_GUS + ((int)blockIdx.x - Gq), (int)gridDim.x - Gq, CV_ITEMS, lds);
        cvt8_run(a, 1, CV1_GU0 + ((int)blockIdx.x - Gq), (int)gridDim.x - Gq, CV1_GU0 + CVQ_GU0S, lds);
        return; }
    ListOrder<MapMoe> S{NE * PM * 22, Gq, (int)blockIdx.x, MapMoe{PM, 22}};
    EpiSwiGLU8 E{ws + WS_ACT};
    stagger_start(STG_GU);
    pg8::gemm_phase<EpiSwiGLU8, ListOrder<MapMoe>, GU_ALIGN, true, 122, GU_GATHER != 0>((PG8_LAS unsigned char*)lds, g, S, E);
    if (layer == 0) { cvt8_tail(a, lds, NE * PM * 22, Gq, (int)blockIdx.x, 0, CV0_GUD, CVQ_GU0T0);
        cvt8_tail(a, lds, NE * PM * 22, Gq, (int)blockIdx.x, 1, CV1_GU0 + (Gq < (int)gridDim.x ? CVQ_GU0S : 0), CVQ_GU0 - (Gq < (int)gridDim.x ? CVQ_GU0S : 0)); }
}
__device__ __forceinline__ void ph_dn_fast(const Ctx& a, LAS unsigned char* lds, int layer) {
    unsigned char* ws = a.ws(); const int PM = (layer == 0 ? RPE0 : RPE1) / 256;
    pg8::Gemm g{(const bf16_t*)(ws + WS_ACT), (const bf16_t*)(ws + WS_WDN + (size_t)layer * (WDN_LAYER / 2)), NE * PM * 256, NE * D, DE / 2};
    const int Gq = layer == 0 ? gemm_groups(NE * PM * 4, (int)gridDim.x, 4) : (int)gridDim.x;
    if ((int)blockIdx.x >= Gq) { cvt8_run(a, 1, CV1_DN0 + ((int)blockIdx.x - Gq), (int)gridDim.x - Gq, CV1_DN0 + CVQ_DN0, lds); return; }
    ListOrder<MapMoe> S{NE * PM * 4, Gq, (int)blockIdx.x, MapMoe{PM, 4}};
    EpiDown E{ws + WS_Y};
    stagger_start(STG_DN);
    static_assert(Y_SCALE == 16.0f, "E8M0 125 = 2^-6 (weight scale) * 2^4 (Y_SCALE)");
    pg8::gemm_phase<EpiDown, ListOrder<MapMoe>, DN_ALIGN, true, DN_E8FOLD ? 125 : 121>((PG8_LAS unsigned char*)lds, g, S, E);
    if (layer == 0 && Gq == (int)gridDim.x) cvt8_tail(a, lds, NE * PM * 4, Gq, (int)blockIdx.x, 1, CV1_DN0, CVQ_DN0);
}
#else
__device__ __forceinline__ void ph_gu_fast(const Ctx& a, LAS unsigned char* lds, int layer) {
    unsigned char* ws = a.ws(); const int PM = (layer == 0 ? RPE0 : RPE1) / 256;
    pg8::Gemm g{(const bf16_t*)(ws + WS_XG), (const bf16_t*)(ws + WS_WGU + (size_t)layer * WGU_LAYER), NE * PM * 256, NE * 2 * DE, D};
    ListOrder<MapMoe> S{NE * PM * 22, (int)gridDim.x, (int)blockIdx.x, MapMoe{PM, 22}};
    EpiSwiGLU E{(bf16_t*)(ws + WS_ACT)};
    PG8_RUN(EpiSwiGLU, ListOrder<MapMoe>, g, S, E);
}
__device__ __forceinline__ void ph_dn_fast(const Ctx& a, LAS unsigned char* lds, int layer) {
    unsigned char* ws = a.ws(); const int PM = (layer == 0 ? RPE0 : RPE1) / 256;
    pg8::Gemm g{(const bf16_t*)(ws + WS_ACT), (const bf16_t*)(ws + WS_WDN + (size_t)layer * WDN_LAYER), NE * PM * 256, NE * D, DE};
    const int Gq = layer == 0 ? gemm_groups(NE * PM * 4, (int)gridDim.x, 4) : (int)gridDim.x;
    if ((int)blockIdx.x >= Gq) { cvt8_run(a, 1, CV1_DN0 + ((int)blockIdx.x - Gq), (int)gridDim.x - Gq, CV1_DN0 + CVQ_DN0, lds); return; }
    ListOrder<MapMoe> S{NE * PM * 4, Gq, (int)blockIdx.x, MapMoe{PM, 4}};
    EpiDown E{ws + WS_Y};
    PG8_RUN(EpiDown, ListOrder<MapMoe>, g, S, E);
}
#endif
__device__ __forceinline__ void ph_win_fast(const Ctx& a, LAS unsigned char* lds) {
    unsigned char* ws = a.ws();
    pg8::Gemm g{(const bf16_t*)(ws + WS_XN), (const bf16_t*)(ws + WS_WIN), RT, 2 * D, D};
    const int Gq = gemm_groups(512 + 32, (int)gridDim.x, 8);
    if ((int)blockIdx.x >= Gq) { cvt8_run(a, 1, CV1_WIN + ((int)blockIdx.x - Gq), (int)gridDim.x - Gq, CV1_WIN + CVQ_WIN, lds); return; }
    ListOrder<MapWin> S{512 + 32, Gq, (int)blockIdx.x, MapWin{}};
    LAS float* bl = (LAS float*)(lds + ROPE_LDS);
    { const float* bg = a.in(I_BIN); for (int i = threadIdx.x; i < 2 * D; i += NTHREADS) bl[i] = bg[i]; }
    __syncthreads();
    EpiWin E{(bf16_t*)(ws + WS_YG), (bf16_t*)(ws + WS_XR), bl};
    stagger_start(STG_WIN);
    PG8_RUN(EpiWin, ListOrder<MapWin>, g, S, E);
    if (Gq == (int)gridDim.x) cvt8_tail(a, lds, 512 + 32, Gq, (int)blockIdx.x, 1, CV1_WIN, CVQ_WIN);
}

#ifndef ATT_PKSUM
#define ATT_PKSUM 0
#endif
#ifndef ATT_TAIL_ALL
#define ATT_TAIL_ALL 1
#endif
namespace fa {
using bf16x8 = __attribute__((ext_vector_type(8))) short;
using s16x4  = __attribute__((ext_vector_type(4))) short;
using f32x16 = __attribute__((ext_vector_type(16))) float;
using u32x4v = __attribute__((ext_vector_type(4))) unsigned;
constexpr int SHM_V = 64 * 128 * 2, SHM_K = 64 * 128 * 2;
#ifndef ATT_THR
#define ATT_THR 11.5f
#endif
constexpr float THR_L2 = ATT_THR;
#define KSWZ(row, colB) ((row) * 256 + ((colB) ^ (((row) & 7) << 4)))
#define SBAR() __builtin_amdgcn_sched_barrier(0)
__device__ __forceinline__ int crow(int r, int hi) { return (r & 3) + 8 * (r >> 2) + 4 * hi; }
__device__ __forceinline__ unsigned cvtpk(float lo, float hi) { unsigned r; asm volatile("v_cvt_pk_bf16_f32 %0, %1, %2" : "=v"(r) : "v"(lo), "v"(hi)); return r; }
__device__ __forceinline__ void partialSM(f32x16& p0, f32x16& p1, float& m_reg, float& mn, float& alpha) {
  float pmax = p0[0];
#pragma unroll
  for (int r = 1; r < 16; ++r) pmax = fmaxf(pmax, p0[r]);
#pragma unroll
  for (int r = 0; r < 16; ++r) pmax = fmaxf(pmax, p1[r]);
  { auto rr = __builtin_amdgcn_permlane32_swap(__float_as_uint(pmax), __float_as_uint(pmax), false, false);
    pmax = fmaxf(__uint_as_float(rr[0]), __uint_as_float(rr[1])); }
  if (__builtin_expect(__all(pmax - m_reg <= THR_L2), 1)) { mn = m_reg; alpha = 1.f; }
  else { mn = fmaxf(m_reg, pmax); alpha = __builtin_amdgcn_exp2f(m_reg - mn); m_reg = mn; }
  { typedef float f2_t __attribute__((ext_vector_type(2))); const f2_t mn2 = {mn, mn};
#pragma unroll
    for (int r = 0; r < 16; r += 2) { const f2_t a_ = (f2_t){p0[r], p0[r + 1]} - mn2; p0[r] = a_.x; p0[r + 1] = a_.y; const f2_t b_ = (f2_t){p1[r], p1[r + 1]} - mn2; p1[r] = b_.x; p1[r + 1] = b_.y; } }
#pragma unroll
  for (int r = 0; r < 16; ++r) p0[r] = __builtin_amdgcn_exp2f(p0[r]);
}
__device__ __forceinline__ void finishSM(f32x16& p0, f32x16& p1, float alpha, float& l_reg, bf16x8& pa0, bf16x8& pa1, bf16x8& pa2, bf16x8& pa3) {
#pragma unroll
  for (int r = 0; r < 16; ++r) p1[r] = __builtin_amdgcn_exp2f(p1[r]);
#if ATT_PKSUM
  typedef float f2s_t __attribute__((ext_vector_type(2)));
  f2s_t ps2 = {p0[0], p0[1]};
#pragma unroll
  for (int r = 2; r < 16; r += 2) ps2 += (f2s_t){p0[r], p0[r + 1]};
#pragma unroll
  for (int r = 0; r < 16; r += 2) ps2 += (f2s_t){p1[r], p1[r + 1]};
  float ps = ps2.x + ps2.y;
#else
  float ps = 0;
#pragma unroll
  for (int r = 0; r < 16; ++r) ps += p0[r];
#pragma unroll
  for (int r = 0; r < 16; ++r) ps += p1[r];
#endif
  { auto rr = __builtin_amdgcn_permlane32_swap(__float_as_uint(ps), __float_as_uint(ps), false, false);
    ps = __uint_as_float(rr[0]) + __uint_as_float(rr[1]); }
  l_reg = l_reg * alpha + ps;
#define PK4(P, BASE, OUT) do { unsigned a0 = cvtpk(P[BASE + 0], P[BASE + 1]), a1 = cvtpk(P[BASE + 2], P[BASE + 3]);   \
    unsigned b0 = cvtpk(P[BASE + 4], P[BASE + 5]), b1 = cvtpk(P[BASE + 6], P[BASE + 7]);                              \
    auto r0 = __builtin_amdgcn_permlane32_swap(a0, b0, false, false); auto r1 = __builtin_amdgcn_permlane32_swap(a1, b1, false, false); \
    u32x4v w = {r0[0], r1[0], r0[1], r1[1]}; OUT = *reinterpret_cast<bf16x8*>(&w); } while (0)
  PK4(p0, 0, pa0); PK4(p0, 8, pa1); PK4(p1, 0, pa2); PK4(p1, 8, pa3);
#undef PK4
}
__device__ __forceinline__ void qkt(f32x16& p0, f32x16& p1, const LAS char* Ks, const bf16x8* qr, int r32, int hi, int s) {
  p0 = f32x16{}; p1 = f32x16{};
#pragma unroll
  for (int d0 = 0; d0 < 4; ++d0) { const int cb = (s * 64 + d0 * 16 + hi * 8) * 2;
    const bf16x8 b0 = *reinterpret_cast<const LAS bf16x8*>(Ks + KSWZ(r32, cb));
    const bf16x8 b1 = *reinterpret_cast<const LAS bf16x8*>(Ks + KSWZ(32 + r32, cb));
    p0 = __builtin_amdgcn_mfma_f32_32x32x16_bf16(b0, qr[d0], p0, 0, 0, 0);
    p1 = __builtin_amdgcn_mfma_f32_32x32x16_bf16(b1, qr[d0], p1, 0, 0, 0); }
}
__device__ __forceinline__ int v_st(int k, int c) { const int kk = (k & ~0xC) | ((k & 4) << 1) | ((k & 8) >> 1); return ((kk >> 3) * 4 + (c >> 5)) * 512 + ((kk & 7) * 32 + (c & 31)) * 2; }
__device__ __forceinline__ int v_rd_base(int lane) { return ((lane & 3) << 3) | (((lane >> 2) & 3) << 6) | (((lane >> 4) & 1) << 5) | (((lane >> 5) & 1) << 8); }
constexpr int v_rd_off(int d0, int ks, int half) { return d0 * 512 + ks * 4096 + half * 2048; }
template <int OFF> __device__ __forceinline__ s16x4 tr_read(int vb) {
  s16x4 r; asm volatile("ds_read_b64_tr_b16 %0, %1 offset:%2" : "=&v"(r) : "v"(vb), "i"(OFF) : "memory"); return r;
}
template <int D0> __device__ __forceinline__ void pv_one(f32x16& od, int vb, bf16x8 pa0, bf16x8 pa1, bf16x8 pa2, bf16x8 pa3) {
  const s16x4 l0 = tr_read<v_rd_off(D0, 0, 0)>(vb), h0 = tr_read<v_rd_off(D0, 0, 1)>(vb), l1 = tr_read<v_rd_off(D0, 1, 0)>(vb), h1 = tr_read<v_rd_off(D0, 1, 1)>(vb);
  const s16x4 l2 = tr_read<v_rd_off(D0, 2, 0)>(vb), h2 = tr_read<v_rd_off(D0, 2, 1)>(vb), l3 = tr_read<v_rd_off(D0, 3, 0)>(vb), h3 = tr_read<v_rd_off(D0, 3, 1)>(vb);
  asm volatile("s_waitcnt lgkmcnt(0)" ::: "memory"); SBAR();
#define PK(L, H) (bf16x8){L[0], L[1], L[2], L[3], H[0], H[1], H[2], H[3]}
  od = __builtin_amdgcn_mfma_f32_32x32x16_bf16(pa0, PK(l0, h0), od, 0, 0, 0);
  od = __builtin_amdgcn_mfma_f32_32x32x16_bf16(pa1, PK(l1, h1), od, 0, 0, 0);
  od = __builtin_amdgcn_mfma_f32_32x32x16_bf16(pa2, PK(l2, h2), od, 0, 0, 0);
  od = __builtin_amdgcn_mfma_f32_32x32x16_bf16(pa3, PK(l3, h3), od, 0, 0, 0);
#undef PK
}
__device__ __forceinline__ void pv_d0(f32x16* o, int vb, bf16x8 pa0, bf16x8 pa1, bf16x8 pa2, bf16x8 pa3) {
  pv_one<0>(o[0], vb, pa0, pa1, pa2, pa3); pv_one<1>(o[1], vb, pa0, pa1, pa2, pa3); pv_one<2>(o[2], vb, pa0, pa1, pa2, pa3); pv_one<3>(o[3], vb, pa0, pa1, pa2, pa3);
}

__device__ __forceinline__ int tile_row(bool latq, int b, int j) { return latq ? (j < 32 ? b * SEQ + 64 * j : RL + b * CTXL + 64 * (j - 32)) : RL + b * CTXL + 64 * j; }

__device__ __forceinline__ void attn_unit(const bf16_t* __restrict__ Qg, const bf16_t* __restrict__ Kg, const bf16_t* __restrict__ Vg, bf16_t* __restrict__ ATT,
                                          const float* subg, float lam, bool latq, int b, int h, int qrow0, LAS unsigned char* lds) {
  const int tid = threadIdx.x, wid = __builtin_amdgcn_readfirstlane(tid >> 6), lane = tid & 63, r32 = lane & 31, hi = lane >> 5, rg = wid >> 1, s = wid & 1;
  LAS char* V_lds = (LAS char*)lds; LAS char* K_lds = (LAS char*)lds + 2 * SHM_V;
  LAS float* ws = (LAS float*)(lds + 65536) + wid * 64; LAS float* li_l = ws; LAS float* al_l = ws + 32;
  const int NT = latq ? 36 : 4;
  float m_reg = -1e30f, l_reg = 0; f32x16 o[4] = {}; bf16x8 qr[4];
  const bf16_t* Qw = Qg + (size_t)(qrow0 + rg * 32 + r32) * D + h * 128 + s * 64 + hi * 8;
#pragma unroll
  for (int d0 = 0; d0 < 4; ++d0) qr[d0] = *reinterpret_cast<const bf16x8*>(Qw + d0 * 16);
  const int sr = tid >> 4, sc = (tid & 15) * 8, vst0 = v_st(sr, sc), vst1 = v_st(32 + sr, sc);
  const int vb0 = (int)(unsigned)(size_t)V_lds + v_rd_base(lane);
  const size_t hoff = (size_t)h * 128 + sc;
  struct { bf16x8 vs0, vs1, ks0, ks1; } sr_[2];
#define SLOAD(i, j) do { const size_t ro_ = (size_t)(tile_row(latq, b, (j)) + sr) * D + hoff; \
    sr_[i].vs0 = *reinterpret_cast<const bf16x8*>(Vg + ro_); sr_[i].vs1 = *reinterpret_cast<const bf16x8*>(Vg + ro_ + 32 * D); \
    sr_[i].ks0 = *reinterpret_cast<const bf16x8*>(Kg + ro_); sr_[i].ks1 = *reinterpret_cast<const bf16x8*>(Kg + ro_ + 32 * D); } while (0)
#define SWRITE(bb, i) do { *(LAS bf16x8*)(V_lds + (bb) * SHM_V + vst0) = sr_[i].vs0; *(LAS bf16x8*)(V_lds + (bb) * SHM_V + vst1) = sr_[i].vs1; const int kc = sc * 2; \
    *(LAS bf16x8*)(K_lds + (bb) * SHM_K + KSWZ(sr, kc)) = sr_[i].ks0; *(LAS bf16x8*)(K_lds + (bb) * SHM_K + KSWZ(32 + sr, kc)) = sr_[i].ks1; } while (0)
#define SWAIT() asm volatile("s_waitcnt vmcnt(4)" ::: "memory")
#define RESC(a_) do { if (__any((a_) < 1.f)) { if (hi == 0) al_l[r32] = (a_); asm volatile("s_waitcnt lgkmcnt(0)" ::: "memory"); \
    _Pragma("unroll") for (int d = 0; d < 4; ++d) _Pragma("unroll") for (int r = 0; r < 16; ++r) o[d][r] *= al_l[crow(r, hi)]; } } while (0)
  f32x16 pA0, pA1, pB0, pB1; float mnA, mnB, alA, alB; bf16x8 pa0, pa1, pa2, pa3;
  constexpr int SE = 0, SO = 1;
  SLOAD(SE, 0); asm volatile("s_waitcnt vmcnt(0)" ::: "memory"); SWRITE(0, SE); __syncthreads();
  qkt(pA0, pA1, K_lds, qr, r32, hi, s); partialSM(pA0, pA1, m_reg, mnA, alA);
  SLOAD(SO, 1); if (2 < NT) SLOAD(SE, 2);
  SWAIT(); SWRITE(1, SO); __syncthreads();
  for (int j = 1; j + 1 < NT; j += 2) {
    SBAR(); qkt(pB0, pB1, K_lds + SHM_K, qr, r32, hi, s);
    finishSM(pA0, pA1, alA, l_reg, pa0, pa1, pa2, pa3); SBAR();
    SLOAD(SO, j + 2); SBAR();
    pv_d0(o, vb0, pa0, pa1, pa2, pa3); partialSM(pB0, pB1, m_reg, mnB, alB);
    __syncthreads(); SWAIT(); SWRITE(0, SE);
    RESC(alB); __syncthreads();
    SBAR(); qkt(pA0, pA1, K_lds, qr, r32, hi, s);
    finishSM(pB0, pB1, alB, l_reg, pa0, pa1, pa2, pa3); SBAR();
    if (j + 3 < NT) SLOAD(SE, j + 3); SBAR();
    pv_d0(o, vb0 + SHM_V, pa0, pa1, pa2, pa3); partialSM(pA0, pA1, m_reg, mnA, alA);
    __syncthreads(); SWAIT(); SWRITE(1, SO);
    RESC(alA); __syncthreads();
  }
  SBAR(); qkt(pB0, pB1, K_lds + SHM_K, qr, r32, hi, s);
  finishSM(pA0, pA1, alA, l_reg, pa0, pa1, pa2, pa3); SBAR();
  pv_d0(o, vb0, pa0, pa1, pa2, pa3); partialSM(pB0, pB1, m_reg, mnB, alB);
  __syncthreads(); RESC(alB);
  finishSM(pB0, pB1, alB, l_reg, pa0, pa1, pa2, pa3); SBAR();
  pv_d0(o, vb0 + SHM_V, pa0, pa1, pa2, pa3);
#undef SLOAD
#undef SWRITE
#undef SWAIT
#undef RESC
  if (hi == 0) li_l[r32] = l_reg;
  asm volatile("s_waitcnt lgkmcnt(0)" ::: "memory");
  float rli[16];
#pragma unroll
  for (int r = 0; r < 16; ++r) rli[r] = __builtin_amdgcn_rcpf(li_l[crow(r, hi)]);
  __syncthreads();
  LAS float* X = (LAS float*)lds + rg * 4096;
  if (s == 1) {
#pragma unroll
    for (int r = 0; r < 16; ++r)
#pragma unroll
      for (int d0 = 0; d0 < 4; ++d0) X[crow(r, hi) * 128 + d0 * 32 + r32] = o[d0][r] * (rli[r] * lam);
  }
  __syncthreads();
  if (s == 0) {
    float rstd[16];
#pragma unroll
    for (int r = 0; r < 16; ++r) {
      float acc = 0.f;
#pragma unroll
      for (int d0 = 0; d0 < 4; ++d0) { const float v = o[d0][r] * rli[r] - X[crow(r, hi) * 128 + d0 * 32 + r32]; o[d0][r] = v; acc += v * v; }
#pragma unroll
      for (int off = 1; off < 32; off <<= 1) acc += __shfl_xor(acc, off);
      rstd[r] = 1.0f / sqrtf(acc * (1.0f / 128.0f) + EPS);
    }
    LAS bf16_t* stg = (LAS bf16_t*)(lds + 65536 + 2048) + rg * 4096;
    float gsc[4];
#pragma unroll
    for (int d0 = 0; d0 < 4; ++d0) gsc[d0] = subg[d0 * 32 + r32] * (1.0f - LAMBDA_INIT0);
#pragma unroll
    for (int r = 0; r < 16; ++r)
#pragma unroll
      for (int d0 = 0; d0 < 4; ++d0) stg[crow(r, hi) * 128 + d0 * 32 + r32] = (bf16_t)f2bf(o[d0][r] * rstd[r] * gsc[d0]);
    asm volatile("s_waitcnt lgkmcnt(0)" ::: "memory");
    bf16_t* Ow = ATT + (size_t)(qrow0 + rg * 32) * D + h * 128;
#pragma unroll
    for (int i = 0; i < 8; ++i) { const int row = i * 4 + (lane >> 4), ch = lane & 15; const u32x4v v = *(const LAS u32x4v*)(stg + row * 128 + ch * 8); *(u32x4v*)(Ow + (size_t)row * D + ch * 8) = v; }
  }
  __syncthreads();
}
#undef KSWZ
#undef SBAR
}

__device__ __forceinline__ void ph_attn_fast(const Ctx& a, LAS unsigned char* lds) {
    unsigned char* ws = a.ws();
    const bf16_t* Q = (const bf16_t*)(ws + WS_Q); const bf16_t* Kb = (const bf16_t*)(ws + WS_K); const bf16_t* V = (const bf16_t*)(ws + WS_V);
    bf16_t* ATT = (bf16_t*)(ws + WS_ATT); const float* subg = a.in(I_SUBG);
    const float lam = diff_lambda(a, threadIdx.x & 63);
    const int G = gridDim.x, c = blockIdx.x;
#if ATT_CVB > 0 && CVT_HIDE && FP8_MOE && DENSE_LATE && ANY_FAST_GEMM
    if (G == 256) {
        constexpr int Ga = 256 - ATT_CVB;
        if (c >= Ga) {
            for (int r = c - Ga; r < IT_DENSE_REST; r += ATT_CVB) cvt_dense_rest_item(a, r);
            __syncthreads();
            cvt8_run(a, 0, CV0_ATT + (c - Ga), ATT_CVB, CV0_ATT + CVQ_ATT, lds);
            cvt8_run(a, 1, CV1_ATT + (c - Ga), ATT_CVB, CV1_ATT + CVQ_ATT1, lds);
            return;
        }
        for (int i = 0;; ++i) {
            const int L = i * Ga + c; if (L >= 1152) break;
            if (L < 1024) { const int w = xcd_remap(L, 1024), bh = w >> 4, qb = w & 15, b = bh >> 3, h = bh & 7;
                fa::attn_unit(Q, Kb, V, ATT, subg, lam, true, b, h, b * SEQ + qb * 128, lds); }
            else { const int bh = (L - 1024) >> 1, qb = L & 1, b = bh >> 3, h = bh & 7;
                fa::attn_unit(Q, Kb, V, ATT, subg, lam, false, b, h, RL + b * CTXL + qb * 128, lds); }
        }
        return;
    }
#endif
    for (int i = 0;; ++i) {
        const long L = (long)i * G + c; if (L >= 1024) break;
        const int w = xcd_remap(L, 1024), bh = w >> 4, qb = w & 15, b = bh >> 3, h = bh & 7;
        fa::attn_unit(Q, Kb, V, ATT, subg, lam, true, b, h, b * SEQ + qb * 128, lds);
    }
    for (int L = c; L < 128; L += G) {
        const int bh = L >> 1, qb = L & 1, b = bh >> 3, h = bh & 7;
        fa::attn_unit(Q, Kb, V, ATT, subg, lam, false, b, h, RL + b * CTXL + qb * 128, lds);
    }
#if DENSE_LATE && ANY_FAST_GEMM
    if (c >= 128 && G > 128) { for (int r = c - 128; r < IT_DENSE_REST; r += G - 128) cvt_dense_rest_item(a, r); }
#endif
#if CVT_HIDE && FP8_MOE
#if ATT_TAIL_ALL
    if (G > 128) { __syncthreads(); cvt8_run(a, 0, CV0_ATT + c, G, CV0_ATT + CVQ_ATT, lds); }
#else
    if (c >= 128 && G > 128) { __syncthreads(); cvt8_run(a, 0, CV0_ATT + (c - 128), G - 128, CV0_ATT + CVQ_ATT, lds); }
#endif
#endif
}


#ifndef GATES_RCP2
#define GATES_RCP2 0
#endif
#ifndef GATES_PK
#define GATES_PK 1
#endif

__device__ __forceinline__ void ph_gates_fast(const Ctx& a, LAS unsigned char* lds) {
    unsigned char* ws = a.ws();
    const bf16_t* XR = (const bf16_t*)(ws + WS_XR); const bf16_t* WG = (const bf16_t*)(ws + WS_WG);
    bf16_t* LOGA = (bf16_t*)(ws + WS_LOGA); unsigned char* BT = ws + WS_BT;
    const float* convw = a.in(I_CONVW); const float* convb = a.in(I_CONVB); const float* gtab = (const float*)(ws + WS_GTAB);
    const int tid = threadIdx.x, wid = __builtin_amdgcn_readfirstlane(tid >> 6), lane = tid & 63, wr = wid >> 2, wc = wid & 3, fr = lane & 15, fq = lane >> 4;
    constexpr int HTB = pg8::HTB;
    const int aoff = pg8::lds_byte(wr * 64 + fr, fq * 8), boff = pg8::lds_byte(wc * 32 + fr, fq * 8);
    const int sc = tid & 15, rg8 = tid >> 4;
    unsigned bsrc[2];
#pragma unroll
    for (int i = 0; i < 2; ++i) { int R, C; pg8::stage_rc(tid * 16 + i * 8192, R, C); bsrc[i] = (unsigned)(((R & ~31) + pg8::perm32(R & 31)) * 128 + C) * 2u; }
    const unsigned ldsw = (unsigned)wid * 1024u;
#define GT_DMA_B(d_) do { const char* wb_ = (const char*)(WG + (size_t)((d_) * 8 + kb) * 256 * 128); \
        _Pragma("unroll") for (int kt_ = 0; kt_ < 2; ++kt_) _Pragma("unroll") for (int h_ = 0; h_ < 2; ++h_) _Pragma("unroll") for (int i_ = 0; i_ < 2; ++i_) \
            __builtin_amdgcn_global_load_lds((const unsigned*)(wb_ + (size_t)h_ * 128 * 256 + kt_ * 128 + bsrc[i_]), (LAS unsigned*)(lds + (4 + kt_ * 2 + h_) * HTB + ldsw + i_ * 8192), 16, 0, 0); } while (0)
    const int Gq = gemm_groups(72 * 8, (int)gridDim.x, 16);
    if ((int)blockIdx.x >= Gq) { cvt8_run(a, 1, CV1_GATES + ((int)blockIdx.x - Gq), (int)gridDim.x - Gq, CV1_GATES + CVQ_GATES, lds); return; }
    for (int u = blockIdx.x; u < 72 * 8; u += Gq) {
        const int kb = u & 7, rt = u >> 3;
        const bool lat = rt < 64; const int bsm = lat ? (rt >> 3) : (rt - 64), t0 = lat ? (rt & 7) * 256 : 0, L = lat ? SEQ : CTXL;
        const int seqbase = lat ? bsm * SEQ : RL + bsm * CTXL;
        GT_DMA_B(0);
        {
            const int ch0 = kb * 128 + sc * 8, r0 = rg8 * 8;
            u32x4 xin[11];
#pragma unroll
            for (int i = 0; i < 11; ++i) { const int tt = t0 + r0 - 2 + i; xin[i] = (tt >= 0 && tt < L) ? *(const u32x4*)(XR + (size_t)(seqbase + tt) * D + ch0) : (u32x4){0u, 0u, 0u, 0u}; }
            f32x4 cw[4][2], cb[2];
#pragma unroll
            for (int j = 0; j < 4; ++j) { cw[j][0] = *(const f32x4*)(convw + j * D + ch0); cw[j][1] = *(const f32x4*)(convw + j * D + ch0 + 4); }
            cb[0] = *(const f32x4*)(convb + ch0); cb[1] = *(const f32x4*)(convb + ch0 + 4);
#pragma unroll
            for (int k = 0; k < 8; ++k) {
                f32x4 o0 = cb[0], o1 = cb[1];
#pragma unroll
                for (int j = 0; j < 4; ++j) { const u32x4 x = xin[k + j];
                    o0 += cw[j][0] * (f32x4){bf_lo(x.x), bf_hi(x.x), bf_lo(x.y), bf_hi(x.y)}; o1 += cw[j][1] * (f32x4){bf_lo(x.z), bf_hi(x.z), bf_lo(x.w), bf_hi(x.w)}; }
                const int r = r0 + k;
                u32x4 w; w.x = pk2(o0[0], o0[1]); w.y = pk2(o0[2], o0[3]); w.z = pk2(o1[0], o1[1]); w.w = pk2(o1[2], o1[3]);
                *(LAS u32x4*)(lds + ((sc >> 3) * 2 + (r >> 7)) * HTB + pg8::lds_byte(r & 127, (sc & 7) * 8)) = w;
            }
        }
#pragma unroll 1
        for (int d = 0; d < 2; ++d) {
            asm volatile("s_waitcnt vmcnt(0)" ::: "memory");
            __syncthreads();
            pf4 acc[2][2][4][2];
#pragma unroll
            for (int ai = 0; ai < 2; ++ai)
#pragma unroll
                for (int bj = 0; bj < 2; ++bj)
#pragma unroll
                    for (int m = 0; m < 4; ++m)
#pragma unroll
                        for (int n = 0; n < 2; ++n) acc[ai][bj][m][n] = (pf4){0.f, 0.f, 0.f, 0.f};
#pragma unroll 1
            for (int kt = 0; kt < 2; ++kt)
#pragma unroll
                for (int ai = 0; ai < 2; ++ai) {
                    __builtin_amdgcn_sched_barrier(0);
                    pg8::bf16x8 At[4][2];
#pragma unroll
                    for (int m = 0; m < 4; ++m)
#pragma unroll
                        for (int k = 0; k < 2; ++k) At[m][k] = *(const LAS pg8::bf16x8*)(lds + (kt * 2 + ai) * HTB + aoff + m * 2048 + k * 1024);
#pragma unroll
                    for (int bj = 0; bj < 2; ++bj) {
                        pg8::bf16x8 Bf[2][2];
#pragma unroll
                        for (int n = 0; n < 2; ++n)
#pragma unroll
                            for (int k = 0; k < 2; ++k) Bf[n][k] = *(const LAS pg8::bf16x8*)(lds + (4 + kt * 2 + bj) * HTB + boff + n * 2048 + k * 1024);
#pragma unroll
                        for (int m = 0; m < 4; ++m)
#pragma unroll
                            for (int n = 0; n < 2; ++n)
#pragma unroll
                                for (int k = 0; k < 2; ++k) acc[ai][bj][m][n] = __builtin_amdgcn_mfma_f32_16x16x32_bf16(Bf[n][k], At[m][k], acc[ai][bj][m][n], 0, 0, 0);
                        __builtin_amdgcn_sched_barrier(0);
                    }
                }
            if (d == 0) { __syncthreads(); GT_DMA_B(1); }
            const int cc0 = wc * 32 + fq * 8;
            pf4 cl[2], c2[2], brn[2], bin[2];
#pragma unroll
            for (int n = 0; n < 2; ++n) { const float* g = gtab + (size_t)(d * 4) * D + kb * 128 + cc0 + 4 * n;
                cl[n] = *(const pf4*)g; c2[n] = *(const pf4*)(g + D); brn[n] = *(const pf4*)(g + 2 * D); bin[n] = *(const pf4*)(g + 3 * D); }
#pragma unroll
            for (int ai = 0; ai < 2; ++ai)
#pragma unroll
                for (int m = 0; m < 4; ++m) {
                    const int rl = wr * 64 + m * 16 + fr;
                    const int grow = seqbase + t0 + ai * 128 + rl;
                    float la[8], bt[8];
#pragma unroll
                    for (int n = 0; n < 2; ++n) {
                        const int cc = cc0 + 4 * n;
                        const u32x2 xw = *(const LAS u32x2*)(lds + ((cc >> 6) * 2 + ai) * HTB + pg8::lds_byte(rl, cc & 63));
                        const float xv[4] = {bf_lo(xw.x), bf_hi(xw.x), bf_lo(xw.y), bf_hi(xw.y)};
#if GATES_PK
                        typedef float f2_t __attribute__((ext_vector_type(2)));
                        const f2_t nl2 = {-1.4426950408889634f, -1.4426950408889634f}, one2 = {1.0f, 1.0f}, is2 = {1.0f / BT_SCALE, 1.0f / BT_SCALE};
#pragma unroll
                        for (int j = 0; j < 4; j += 2) {
                            const f2_t ar = (f2_t){acc[ai][0][m][n][j], acc[ai][0][m][n][j + 1]} * nl2 + (f2_t){brn[n][j], brn[n][j + 1]};
                            const f2_t ag = (f2_t){acc[ai][1][m][n][j], acc[ai][1][m][n][j + 1]} * nl2 + (f2_t){bin[n][j], bin[n][j + 1]};
                            const f2_t dr = (f2_t){__builtin_amdgcn_exp2f(ar.x), __builtin_amdgcn_exp2f(ar.y)} + one2;
                            const f2_t dg = (f2_t){__builtin_amdgcn_exp2f(ag.x), __builtin_amdgcn_exp2f(ag.y)} * is2 + is2;
#if GATES_RCP2
                            const f2_t qq = dr * dg; const f2_t q2 = {__builtin_amdgcn_rcpf(qq.x), __builtin_amdgcn_rcpf(qq.y)};
                            const f2_t r2 = dg * q2, g2 = dr * q2;
#else
                            const f2_t r2 = {__builtin_amdgcn_rcpf(dr.x), __builtin_amdgcn_rcpf(dr.y)}, g2 = {__builtin_amdgcn_rcpf(dg.x), __builtin_amdgcn_rcpf(dg.y)};
#endif
                            const f2_t tt = r2 * (f2_t){c2[n][j], c2[n][j + 1]};
                            const f2_t om = one2 - (f2_t){__builtin_amdgcn_exp2f(tt.x), __builtin_amdgcn_exp2f(tt.y)};
                            const f2_t l2 = r2 * (f2_t){cl[n][j], cl[n][j + 1]};
                            const f2_t b2 = (f2_t){__builtin_amdgcn_sqrtf(om.x), __builtin_amdgcn_sqrtf(om.y)} * (g2 * (f2_t){xv[j], xv[j + 1]});
                            la[n * 4 + j] = l2.x; la[n * 4 + j + 1] = l2.y; bt[n * 4 + j] = b2.x; bt[n * 4 + j + 1] = b2.y;
                        }
#else
#pragma unroll
                        for (int j = 0; j < 4; ++j) {
                            const float r = __builtin_amdgcn_rcpf(1.0f + __builtin_amdgcn_exp2f(fmaf(acc[ai][0][m][n][j], -1.4426950408889634f, brn[n][j])));
                            const float ig = __builtin_amdgcn_rcpf(1.0f + __builtin_amdgcn_exp2f(fmaf(acc[ai][1][m][n][j], -1.4426950408889634f, bin[n][j])));
                            const float om = 1.0f - __builtin_amdgcn_exp2f(r * c2[n][j]);
                            la[n * 4 + j] = r * cl[n][j]; bt[n * 4 + j] = __builtin_amdgcn_sqrtf(om) * (ig * xv[j]) * BT_SCALE;
                        }
#endif
                    }
                    const size_t o = ((size_t)d * RT + grow) * D + kb * 128 + cc0;
                    u32x4 w; w.x = pk2(la[0], la[1]); w.y = pk2(la[2], la[3]); w.z = pk2(la[4], la[5]); w.w = pk2(la[6], la[7]);
                    *(u32x4*)(LOGA + o) = w;
                    u32x2 wb; wb.x = pk4_fp8(bt[0], bt[1], bt[2], bt[3]); wb.y = pk4_fp8(bt[4], bt[5], bt[6], bt[7]);
                    *(u32x2*)(BT + o) = wb;
                }
        }
#if FUSE_SCAN1
        asm volatile("s_waitcnt vmcnt(0)" ::: "memory");
        __syncthreads();
        {
            const int dir = wid >> 2, lc = wid & 3, kc = (t0 >> 6) + lc;
            const int c = dir == 0 ? (lat ? NCH_CTX + kc : kc) : (lat ? NCH - 1 - kc : NCH_CTX - 1 - kc);
            const int ch = kb * 128 + 2 * lane;
            float* CP = (float*)(ws + WS_CP); float* CB = (float*)(ws + WS_CB);
            float h0 = 0.f, h1 = 0.f, p0 = 0.f, p1 = 0.f;
#pragma unroll 1
            for (int sg = 0; sg < SCH; sg += 32) {
                unsigned la[32], bt[32];
#pragma unroll
                for (int i = 0; i < 32; ++i) { const size_t o = ((size_t)dir * RT + scan_row(bsm, dir, c, sg + i)) * D + ch; la[i] = *(const unsigned*)(LOGA + o); bt[i] = *(const unsigned short*)(BT + o); }
                asm volatile("" ::: "memory");
#pragma unroll
                for (int i = 0; i < 32; ++i) { const float l0 = bf_lo(la[i]), l1 = bf_hi(la[i]); const f32x2 bb = __builtin_amdgcn_cvt_pk_f32_fp8((int)bt[i], false);
                    h0 = __builtin_amdgcn_exp2f(l0) * h0 + bb.x; h1 = __builtin_amdgcn_exp2f(l1) * h1 + bb.y; p0 += l0; p1 += l1; }
            }
            const size_t so = ((size_t)(bsm * 2 + dir) * NCH + c) * D + ch;
            *(f32x2*)(CP + so) = (f32x2){p0, p1}; *(f32x2*)(CB + so) = (f32x2){h0, h1};
        }
#endif
        __syncthreads();
    }
#undef GT_DMA_B
    if (Gq == (int)gridDim.x) cvt8_tail(a, lds, 72 * 8, Gq, (int)blockIdx.x, 1, CV1_GATES, CVQ_GATES);
}

constexpr int NPHASES = 25;
__host__ __device__ constexpr bool phase_enabled(int p) {
    return !((p == 3 && FAST_QKV) || (p == 9 && FAST_GU) || (p == 22 && FAST_GU) || (p == 13 && FAST_GATES) || (p == 15 && FAST_GATES) || (p == 16 && FAST_GATES && FUSE_SCAN1));
}

__global__ void __launch_bounds__(NTHREADS, 2) hybrid_fwd(Args args) {
    extern __shared__ __attribute__((aligned(16))) unsigned char lds_raw[];
    LAS unsigned char* lds = (LAS unsigned char*)lds_raw;
    volatile LAS unsigned* MISC = (volatile LAS unsigned*)(lds + MISC_OFF);
    const int lo = args.ph_lo, hi = args.ph_hi;
    if (threadIdx.x == 0) {
        LAS unsigned long long* la64 = (LAS unsigned long long*)(lds + ARGS_OFF);
#pragma unroll
        for (int i = 0; i < 27; ++i) la64[i] = (unsigned long long)args.in[i];
        la64[27] = (unsigned long long)args.out; la64[28] = (unsigned long long)args.ws;
    }
    Ctx ctx; ctx.la = (const LAS unsigned*)(lds + ARGS_OFF);
    if (threadIdx.x < 16) MISC[threadIdx.x] = 0u;
    __syncthreads();
#if MK_ONE_LAUNCH
    XcdBarrier bar = xcd_barrier_post((unsigned*)(ctx.ws() + WS_CTL) + CW_BAR, MISC + 8);
#define GRID_BAR() xcd_barrier(bar)
#else
#define GRID_BAR() do { } while (0)
#endif
#ifndef REP_MASK
#define REP_MASK 0u
#endif
#ifndef REP_N
#define REP_N 1
#endif
#define RUN(k, call) do { call; if constexpr (((REP_MASK) >> (k)) & 1u) { __syncthreads(); call; if constexpr (REP_N >= 2) { __syncthreads(); call; } if constexpr (REP_N >= 3) { __syncthreads(); call; } if constexpr (REP_N >= 4) { __syncthreads(); call; } } } while (0)
#define IN(k) (lo <= (k) && (k) < hi)
    const bool NRHO = MK_ONE_LAUNCH && NR_HANDOFF && TK_HANDOFF && TOPK_W && ROUTER_MFMA && FP8_MOE && gridDim.x == 256 && lo == 0 && hi == NPHASES;
#define SEAM(k) do { if ((k) + 1 < hi) GRID_BAR(); } while (0)

#ifdef PROBE_PRO
    if (IN(0)) { ph_prologue(ctx, lds); __syncthreads(); if (threadIdx.x == 0) MISC[15] = PROBE_PRO; __syncthreads(); ph_prologue(ctx, lds); __syncthreads(); if (threadIdx.x == 0) MISC[15] = 0u; __syncthreads(); SEAM(0); }
#else
    if (IN(0)) { RUN(0, ph_prologue(ctx, lds)); SEAM(0); }
#endif
    if (IN(1)) { RUN(1, ph_norm1_l0(ctx)); SEAM(1); }
    if (IN(2)) {
#if FAST_QKV
        RUN(2, ph_qkv_fast(ctx, lds));
#else
        RUN(2, ph_qkv_naive(ctx, lds));
#endif
        SEAM(2); }
#if !FAST_QKV
    if (IN(3)) { RUN(3, ph_rope_naive(ctx)); SEAM(3); }
#endif
    if (IN(4)) {
#if FAST_ATTN
        RUN(4, ph_attn_fast(ctx, lds));
#else
        RUN(4, ph_attn_naive(ctx, lds));
#endif
        SEAM(4); }
    if (IN(5)) {
#if FAST_WO
        RUN(5, ph_wo_fast(ctx, lds));
#else
        RUN(5, ph_wo_naive(ctx, lds));
#endif
        SEAM(5); }
    if (IN(6)) { RUN(6, (ROUTER_MFMA && FP8_MOE) ? ph_norm2_router_mfma(ctx, lds, 0) : ph_norm2_router(ctx, lds, 0, RT)); if (NRHO) xcd_barrier_arrive(bar); else SEAM(6); }
    if (IN(7)) { RUN(7, ph_topk_gather(ctx, lds, 0)); if (NRHO) xcd_barrier_wait(bar); else if (TK_HANDOFF && TOPK_W && gridDim.x == 256 && 8 < hi) __syncthreads(); else SEAM(7); }
    if (IN(8)) {
#if FAST_GU
        RUN(8, ph_gu_fast(ctx, lds, 0));
#else
        RUN(8, ph_gu_naive(ctx, lds, 0));
#endif
        SEAM(8); }
#if !FAST_GU
    if (IN(9)) { RUN(9, ph_swiglu_naive(ctx, 0)); SEAM(9); }
#endif
    if (IN(10)) {
#if FAST_DN
        RUN(10, ph_dn_fast(ctx, lds, 0));
#else
        RUN(10, ph_dn_naive(ctx, lds, 0));
#endif
        SEAM(10); }
    if (IN(11)) { RUN(11, ph_combine<0>(ctx, 0, RT)); SEAM(11); }
    if (IN(12)) {
#if FAST_WIN
        RUN(12, ph_win_fast(ctx, lds));
#else
        RUN(12, ph_win_naive(ctx, lds));
#endif
        SEAM(12); }
#if !FAST_GATES
    if (IN(13)) { RUN(13, ph_conv_naive(ctx)); SEAM(13); }
#endif
    if (IN(14)) {
#if FAST_GATES
        RUN(14, ph_gates_fast(ctx, lds));
#else
        RUN(14, ph_gates_naive(ctx, lds));
#endif
        SEAM(14); }
#if !FAST_GATES
    if (IN(15)) { RUN(15, ph_gate_elem_naive(ctx)); SEAM(15); }
#endif
#if !(FUSE_SCAN1 && FAST_GATES)
    if (IN(16)) { RUN(16, ph_scan1(ctx)); SEAM(16); }
#endif
    if (IN(17)) { RUN(17, ph_scan2(ctx)); SEAM(17); }
    if (IN(18)) {
#if FAST_WOUT
        RUN(18, ph_wout_fast(ctx, lds));
#else
        RUN(18, ph_wout_naive(ctx, lds));
#endif
        SEAM(18); }
    if (IN(19)) { RUN(19, (ROUTER_MFMA && FP8_MOE) ? ph_norm2_router_mfma(ctx, lds, 1) : ph_norm2_router(ctx, lds, 1, RL)); if (NRHO) xcd_barrier_arrive(bar); else SEAM(19); }
    if (IN(20)) { RUN(20, ph_topk_gather(ctx, lds, 1)); if (NRHO) xcd_barrier_wait(bar); else if (TK_HANDOFF && TOPK_W && gridDim.x == 256 && 21 < hi) __syncthreads(); else SEAM(20); }
    if (IN(21)) {
#if FAST_GU
        RUN(21, ph_gu_fast(ctx, lds, 1));
#else
        RUN(21, ph_gu_naive(ctx, lds, 1));
#endif
        SEAM(21); }
#if !FAST_GU
    if (IN(22)) { RUN(22, ph_swiglu_naive(ctx, 1)); SEAM(22); }
#endif
    if (IN(23)) {
#if FAST_DN
        RUN(23, ph_dn_fast(ctx, lds, 1));
#else
        RUN(23, ph_dn_naive(ctx, lds, 1));
#endif
        SEAM(23); }
    if (IN(24)) { RUN(24, ph_combine<1>(ctx, 1, RL)); }
#undef IN
#undef SEAM
#undef GRID_BAR
}

extern "C" void kernel_launch(void* const* d_in, const int* in_sizes, int n_in, void* d_out, int out_size, void* d_ws, size_t ws_size, hipStream_t stream) {
    static int grid = 0;
    if (grid == 0) {
        if (n_in != 27 || out_size != RL * D || ws_size < WS_END) { fprintf(stderr, "kernel_launch: unexpected shapes (n_in %d out %d ws %zu)\n", n_in, out_size, ws_size); grid = -1; return; }
        int dev = 0, cus = 0, per_cu = 0;
        if (hipGetDevice(&dev) != hipSuccess || hipDeviceGetAttribute(&cus, hipDeviceAttributeMultiprocessorCount, dev) != hipSuccess) { grid = -1; return; }
        if (hipFuncSetAttribute((const void*)hybrid_fwd, hipFuncAttributeMaxDynamicSharedMemorySize, LDS_BYTES) != hipSuccess) { fprintf(stderr, "kernel_launch: hipFuncSetAttribute failed\n"); grid = -1; return; }
        if (hipOccupancyMaxActiveBlocksPerMultiprocessor(&per_cu, (const void*)hybrid_fwd, NTHREADS, LDS_BYTES) != hipSuccess || per_cu < 1) { fprintf(stderr, "kernel_launch: occupancy query says %d\n", per_cu); }
        (void)hipGetLastError();
        grid = cus > 0 ? cus : 256;
    }
    if (grid < 0) return;
    if (hipMemsetAsync((char*)d_ws + WS_CTL, 0, CTL_ZERO_BYTES, stream) != hipSuccess) return;
    Args a{};
    for (int i = 0; i < 27; ++i) a.in[i] = (const float*)d_in[i];
    a.out = (float*)d_out; a.ws = (unsigned char*)d_ws;
#if MK_ONE_LAUNCH
    a.ph_lo = 0; a.ph_hi = NPHASES;
    hipLaunchKernelGGL(hybrid_fwd, dim3(grid), dim3(NTHREADS), LDS_BYTES, stream, a);
#else
    for (int p = 0; p < NPHASES; ++p) {
        if (!phase_enabled(p)) continue;
        a.ph_lo = p; a.ph_hi = p + 1;
        hipLaunchKernelGGL(hybrid_fwd, dim3(grid), dim3(NTHREADS), LDS_BYTES, stream, a);
    }
#endif
    const hipError_t le = hipPeekAtLastError();
    if (le != hipSuccess) fprintf(stderr, "kernel_launch: launch failed: %s\n", hipGetErrorName(le));
}
```
